# Optimizing an MI355X kernel written in HIP

```python
import math
import jax
import jax.numpy as jnp
from jax import lax
import numpy as np

D_MODEL = 1024
BATCH = 8
SEQ = 4096
DEPTH = 2

CTX_LEN = 256
GRID_W = 64
N_MIXERS = 4
GROUP_W = D_MODEL // N_MIXERS

RW_HEADS = 4
RW_HD = GROUP_W // RW_HEADS
RW_DECAY_LORA = 32
RW_AAA_LORA = 32
RW_GATE_LORA = 64
RW_GN_EPS = 64e-5

GD_HEADS = 4
GD_HD = GROUP_W // GD_HEADS
GD_CHUNK = 64
GD_CONV = 3
GD_NORM_EPS = 1e-6

HY_CONV = 3
HY_EMB = 33
HY_BANDS = (HY_EMB - 1) // 2
HY_FILTER_HIDDEN = 64
HY_ORDER = 2
HY_SIDES = 2
HY_TARGET = 1e-2
HY_SHORT_DECAY_PCT = 0.3
HY_LONG_DECAY_PCT = 1.5

S5_CH = 16
S5_GROUPS = GROUP_W // S5_CH
S5_STATE = 64

N_EXPERTS = 64
TOP_K = 8
N_GROUPS = 8
TOPK_GROUPS = 4
D_EXPERT = 256
ROUTED_SCALE = 2.5
MOE_BLOCK = 256

LN_EPS = 1e-5
DEEPNORM_ALPHA = (2 * DEPTH) ** 0.25
DEEPNORM_BETA = (8 * DEPTH) ** -0.25

RW_COLS = 3 * GROUP_W + 2 * RW_DECAY_LORA + 2 * RW_AAA_LORA + RW_GATE_LORA
GD_COLS = 4 * GROUP_W + 4 * GD_HEADS
HY_COLS = 3 * GROUP_W
S5_COLS = GROUP_W
D_IN = RW_COLS + GD_COLS + HY_COLS + S5_COLS
MIX_SPLIT = [RW_COLS, RW_COLS + GD_COLS, RW_COLS + GD_COLS + HY_COLS]
RW_SPLIT = [GROUP_W, 2 * GROUP_W, 3 * GROUP_W, 3 * GROUP_W + 2 * RW_DECAY_LORA,
            3 * GROUP_W + 2 * RW_DECAY_LORA + 2 * RW_AAA_LORA]
GD_SPLIT = [3 * GROUP_W, 4 * GROUP_W, 4 * GROUP_W + 2 * GD_HEADS]

kernel_name = 'hybrid_flow_backbone_rwkv_gdn_hyena_s5_moe'


def layer_norm(x, g, b):
    xf = x.astype(jnp.float32)
    mu = jnp.mean(xf, axis=-1, keepdims=True)
    var = jnp.mean(jnp.square(xf - mu), axis=-1, keepdims=True)
    return ((xf - mu) * lax.rsqrt(var + LN_EPS) * g + b).astype(x.dtype)


def l2_normalize(x):
    return x * lax.rsqrt(jnp.sum(x * x, axis=-1, keepdims=True) + 1e-12)


def split_heads(t, n_heads):
    return t.reshape(t.shape[:-1] + (n_heads, t.shape[-1] // n_heads))


def merge_heads(t):
    return t.reshape(t.shape[:-2] + (t.shape[-2] * t.shape[-1],))


def dwconv_centered(x, w):
    k = w.shape[0]
    return lax.conv_general_dilated(
        x, w[:, None, :].astype(x.dtype), window_strides=(1,), padding=[(k // 2, k // 2)],
        dimension_numbers=('NWC', 'WIO', 'NWC'), feature_group_count=x.shape[-1])


def swiglu(x, w1, w3, w2):
    return (jax.nn.silu(x @ w1) * (x @ w3)) @ w2


def rwkv7_prep(z, w0, w2, a0, a2, g2, k_k, k_a):
    z = z.astype(jnp.float32)
    r, k, v, wl, al, gl = jnp.split(z, RW_SPLIT, axis=-1)
    lead = z.shape[:-1]
    wl = wl.reshape(lead + (2, RW_DECAY_LORA))
    al = al.reshape(lead + (2, RW_AAA_LORA))
    wlog = -jax.nn.softplus(-(w0 + jnp.einsum('bldr,drc->bldc', jnp.tanh(wl), w2))) - 0.5
    decay = jnp.exp(-jnp.exp(wlog))
    a = jax.nn.sigmoid(a0 + jnp.einsum('bldr,drc->bldc', al, a2))
    g = jax.nn.sigmoid(gl) @ g2
    kk = l2_normalize(split_heads(k * k_k, RW_HEADS))
    kd = k[:, :, None, :] * (1.0 + (a - 1.0) * k_a)
    return (split_heads(r, RW_HEADS), split_heads(v, RW_HEADS), kk, split_heads(kd, RW_HEADS),
            split_heads(decay, RW_HEADS), split_heads(a, RW_HEADS), g)


def rwkv7_scan(r, w, k, v, a, b, s0, reverse):
    def step(s, inp):
        rt, wt, kt, vt, at, bt = inp
        sa = jnp.einsum('bhvk,bhk->bhv', s, at)
        s = s * wt[:, :, None, :] + sa[..., None] * bt[:, :, None, :] + vt[..., None] * kt[:, :, None, :]
        return s, jnp.einsum('bhvk,bhk->bhv', s, rt)
    xs = tuple(jnp.moveaxis(t, 1, 0) for t in (r, w, k, v, a, b))
    s, ys = lax.scan(step, s0, xs, reverse=reverse)
    return jnp.moveaxis(ys, 0, 1), s


def rwkv7_mixer(zc, zl, w0, w2, a0, a2, g2, k_k, k_a, r_k, gn_g, gn_b, need_ctx):
    seqs = (rwkv7_prep(zc, w0, w2, a0, a2, g2, k_k, k_a), rwkv7_prep(zl, w0, w2, a0, a2, g2, k_k, k_a))
    s0 = jnp.zeros((zl.shape[0], RW_HEADS, RW_HD, RW_HD), jnp.float32)
    y = [0.0, 0.0]
    bonus = [0.0, 0.0]
    for d in range(2):
        state = s0
        for j, (r, v, kk, kd, dec, a, _) in enumerate(seqs):
            yj, state = rwkv7_scan(r, dec[:, :, d], kd[:, :, d], v, -kk, kk * a[:, :, d], state, d == 1)
            y[j] = y[j] + yj
            bonus[j] = bonus[j] + jnp.sum(r * kd[:, :, d] * r_k, axis=-1, keepdims=True) * v

    def post(yj, bj, g):
        mu = jnp.mean(yj, axis=-1, keepdims=True)
        var = jnp.mean(jnp.square(yj - mu), axis=-1, keepdims=True)
        yn = merge_heads((yj - mu) * lax.rsqrt(var + RW_GN_EPS)) * gn_g + gn_b
        return (yn + merge_heads(bj)) * g

    out_l = post(y[1], bonus[1], seqs[1][6])
    out_c = post(y[0], bonus[0], seqs[0][6]) if need_ctx else None
    return out_c, out_l


def gdn_prep(z, conv_w, a_log, dt_bias):
    z = z.astype(jnp.float32)
    qkv, zg, al, bl = jnp.split(z, GD_SPLIT, axis=-1)
    q, k, v = jnp.split(jax.nn.silu(dwconv_centered(qkv, conv_w)), 3, axis=-1)
    q = l2_normalize(split_heads(q, GD_HEADS)) * (GD_HD ** -0.5)
    k = l2_normalize(split_heads(k, GD_HEADS))
    v = split_heads(v, GD_HEADS)
    lead = z.shape[:-1]
    g = -jnp.exp(a_log) * jax.nn.softplus(al.reshape(lead + (2, GD_HEADS)) + dt_bias)
    beta = jax.nn.sigmoid(bl.reshape(lead + (2, GD_HEADS)))
    return q, k, v, zg, g, beta


def gdn_chunked(q, k, v, g, beta, s0):
    bsz, seq, nh, _ = q.shape
    n = seq // GD_CHUNK

    def chunk(t):
        t = jnp.swapaxes(t, 1, 2)
        return t.reshape(t.shape[:2] + (n, GD_CHUNK) + t.shape[3:])

    q, k, v, g, beta = chunk(q), chunk(k), chunk(v), chunk(g), chunk(beta)
    gc = jnp.cumsum(g, axis=-1)
    incl = jnp.tril(jnp.ones((GD_CHUNK, GD_CHUNK), bool))
    strict = jnp.tril(jnp.ones((GD_CHUNK, GD_CHUNK), bool), -1)
    diff = gc[..., :, None] - gc[..., None, :]
    decay = jnp.where(incl, jnp.exp(jnp.where(incl, diff, 0.0)), 0.0)
    kb = k * beta[..., None]
    lmat = jnp.where(strict, jnp.einsum('bhncd,bhnsd->bhncs', kb, k) * decay, 0.0)
    amat = lmat + jnp.eye(GD_CHUNK, dtype=lmat.dtype)
    u = lax.linalg.triangular_solve(amat, v * beta[..., None], left_side=True, lower=True, unit_diagonal=True)
    w = lax.linalg.triangular_solve(amat, kb * jnp.exp(gc)[..., None], left_side=True, lower=True,
                                    unit_diagonal=True)
    attn = jnp.einsum('bhncd,bhnsd->bhncs', q, k) * decay
    qg = q * jnp.exp(gc)[..., None]
    kg = k * jnp.exp(gc[..., -1:] - gc)[..., None]
    glast = jnp.exp(gc[..., -1])

    def step(s, inp):
        u_i, w_i, qg_i, kg_i, at_i, gl_i = inp
        v_new = u_i - jnp.einsum('bhcd,bhde->bhce', w_i, s)
        o = jnp.einsum('bhcd,bhde->bhce', qg_i, s) + jnp.einsum('bhcs,bhse->bhce', at_i, v_new)
        s = s * gl_i[..., None, None] + jnp.einsum('bhcd,bhce->bhde', kg_i, v_new)
        return s, o

    xs = tuple(jnp.moveaxis(t, 2, 0) for t in (u, w, qg, kg, attn, glast))
    s, o = lax.scan(step, s0, xs)
    o = jnp.moveaxis(o, 0, 2).reshape(bsz, nh, seq, -1)
    return jnp.swapaxes(o, 1, 2), s


def gdn_mixer(zc, zl, conv_w, a_log, dt_bias, norm_g, need_ctx):
    seqs = (gdn_prep(zc, conv_w, a_log, dt_bias), gdn_prep(zl, conv_w, a_log, dt_bias))
    s0 = jnp.zeros((zl.shape[0], GD_HEADS, GD_HD, GD_HD), jnp.float32)
    o = [0.0, 0.0]
    for d in range(2):
        flip = (lambda t: jnp.flip(t, axis=1)) if d == 1 else (lambda t: t)
        state = s0
        for j, (q, k, v, _, g, beta) in enumerate(seqs):
            oj, state = gdn_chunked(flip(q), flip(k), flip(v), flip(g[:, :, d]), flip(beta[:, :, d]), state)
            o[j] = o[j] + flip(oj)

    def post(oj, zg):
        on = oj * lax.rsqrt(jnp.mean(jnp.square(oj), axis=-1, keepdims=True) + GD_NORM_EPS) * norm_g
        return merge_heads(on) * jax.nn.silu(zg)

    out_l = post(o[1], seqs[1][3])
    out_c = post(o[0], seqs[0][3]) if need_ctx else None
    return out_c, out_l


def hyena_filters(length, w1, b1, f1, w2, b2, f2, w3):
    t = jnp.linspace(0.0, 1.0, length, dtype=jnp.float32)[:, None]
    ang = (2.0 * math.pi / length) * jnp.arange(length, dtype=jnp.float32)[:, None]
    bands = jnp.linspace(1e-4, HY_BANDS - 1, HY_BANDS, dtype=jnp.float32)
    feat = jnp.concatenate([t, jnp.cos(bands * ang), -jnp.sin(bands * ang)], axis=-1)
    hid = jnp.sin(f1 * (feat @ w1 + b1))
    hid = jnp.sin(f2 * (hid @ w2 + b2))
    h = (hid @ w3).astype(jnp.float32).reshape(length, HY_ORDER, HY_SIDES, GROUP_W)
    deltas = jnp.abs(jnp.linspace(math.log(HY_TARGET) / HY_LONG_DECAY_PCT, math.log(HY_TARGET) / HY_SHORT_DECAY_PCT,
                                  GROUP_W, dtype=jnp.float32))
    return h * jnp.exp(-t[:, :, None, None] * deltas)


def two_sided_fftconv(u, h_fwd, h_bwd, skip):
    length = u.shape[1]
    taps = jnp.concatenate([h_fwd, jnp.zeros_like(h_fwd[:1]), jnp.flip(h_bwd[1:], axis=0)], axis=0)
    y = jnp.fft.irfft(jnp.fft.rfft(u, n=2 * length, axis=1) * jnp.fft.rfft(taps, axis=0)[None],
                      n=2 * length, axis=1)
    return y[:, :length] + u * skip


def hyena_branch(z, conv_w, conv_b, filt, skip):
    z = dwconv_centered(z.astype(jnp.float32), conv_w) + conv_b
    x1, x2, v = jnp.split(z, 3, axis=-1)
    y = x1 * two_sided_fftconv(v, filt[:, 0, 0], filt[:, 0, 1], skip[0])
    return x2 * two_sided_fftconv(y, filt[:, 1, 0], filt[:, 1, 1], skip[1])


def hyena_mixer(zc, zl, conv_w, conv_b, w1, b1, f1, w2, b2, f2, w3, skip, need_ctx):
    out_l = hyena_branch(zl, conv_w, conv_b, hyena_filters(zl.shape[1], w1, b1, f1, w2, b2, f2, w3), skip)
    out_c = None
    if need_ctx:
        out_c = hyena_branch(zc, conv_w, conv_b, hyena_filters(zc.shape[1], w1, b1, f1, w2, b2, f2, w3), skip)
    return out_c, out_l


def s5_discretize(lam_re, lam_im, log_step, b_re, b_im):
    lam_re, lam_im = lam_re.astype(jnp.float32), lam_im.astype(jnp.float32)
    dt = jnp.exp(log_step.astype(jnp.float32))[:, None]
    mag = jnp.exp(lam_re * dt)
    ab_re, ab_im = mag * jnp.cos(lam_im * dt), mag * jnp.sin(lam_im * dt)
    den = lam_re * lam_re + lam_im * lam_im
    co_re = ((ab_re - 1.0) * lam_re + ab_im * lam_im) / den
    co_im = (ab_im * lam_re - (ab_re - 1.0) * lam_im) / den
    bb_re = co_re[..., None] * b_re - co_im[..., None] * b_im
    bb_im = co_re[..., None] * b_im + co_im[..., None] * b_re
    return ab_re, ab_im, bb_re, bb_im


def complex_affine_combine(e1, e2):
    a1r, a1i, b1r, b1i = e1
    a2r, a2i, b2r, b2i = e2
    return (a1r * a2r - a1i * a2i, a1r * a2i + a1i * a2r,
            a2r * b1r - a2i * b1i + b2r, a2r * b1i + a2i * b1r + b2i)


def s5_scan(u, ab_re, ab_im, bb_re, bb_im, s0_re, s0_im, reverse):
    length = u.shape[0]
    bu_re = jnp.einsum('lbgh,gph->lbgp', u, bb_re)
    bu_im = jnp.einsum('lbgh,gph->lbgp', u, bb_im)
    first = length - 1 if reverse else 0
    bu_re = bu_re.at[first].add(ab_re * s0_re - ab_im * s0_im)
    bu_im = bu_im.at[first].add(ab_re * s0_im + ab_im * s0_re)
    a_re = jnp.broadcast_to(ab_re, (length, 1) + ab_re.shape)
    a_im = jnp.broadcast_to(ab_im, (length, 1) + ab_im.shape)
    _, _, x_re, x_im = lax.associative_scan(complex_affine_combine, (a_re, a_im, bu_re, bu_im),
                                            reverse=reverse, axis=0)
    return x_re, x_im


def s5_mixer(uc, ul, rows, lam_re, lam_im, log_step, b_re, b_im, c_re, c_im, d_skip, glu_w, glu_b, need_ctx):
    bsz, seq, _ = ul.shape
    ul_cm = ul.reshape(bsz, rows, GRID_W, GROUP_W).transpose(0, 2, 1, 3).reshape(bsz, seq, GROUP_W)

    def to_groups(t):
        return jnp.swapaxes(t.astype(jnp.float32), 0, 1).reshape(t.shape[1], bsz, S5_GROUPS, S5_CH)

    ug = (to_groups(uc), to_groups(ul_cm))
    zero = jnp.zeros((bsz, S5_GROUPS, S5_STATE), jnp.float32)
    y = [0.0, 0.0]
    for d in range(2):
        rev = d == 1
        ab_re, ab_im, bb_re, bb_im = s5_discretize(lam_re[d], lam_im[d], log_step[d], b_re[d], b_im[d])
        xc_re, xc_im = s5_scan(ug[0], ab_re, ab_im, bb_re, bb_im, zero, zero, rev)
        fin = 0 if rev else -1
        xl_re, xl_im = s5_scan(ug[1], ab_re, ab_im, bb_re, bb_im, xc_re[fin], xc_im[fin], rev)
        y[1] = y[1] + (jnp.einsum('lbgp,ghp->lbgh', xl_re, c_re[d]) - jnp.einsum('lbgp,ghp->lbgh', xl_im, c_im[d]))
        if need_ctx:
            y[0] = y[0] + (jnp.einsum('lbgp,ghp->lbgh', xc_re, c_re[d])
                           - jnp.einsum('lbgp,ghp->lbgh', xc_im, c_im[d]))

    def post(yj, uj):
        length = yj.shape[0]
        yj = yj + uj * d_skip.reshape(S5_GROUPS, S5_CH)
        yj = jnp.swapaxes(yj.reshape(length, bsz, GROUP_W), 0, 1)
        yj = jax.nn.gelu(yj, approximate=False)
        return yj * jax.nn.sigmoid(yj @ glu_w + glu_b)

    out_l = post(y[1], ug[1]).reshape(bsz, GRID_W, rows, GROUP_W).transpose(0, 2, 1, 3).reshape(bsz, seq, GROUP_W)
    out_c = post(y[0], ug[0]) if need_ctx else None
    return out_c, out_l


def routed_experts(h, idx, wts, w1, w3, w2):
    t, d = h.shape
    n_assign = t * TOP_K
    n_blocks = -(-n_assign // MOE_BLOCK) + N_EXPERTS
    flat_e = idx.reshape(-1)
    order = jnp.argsort(flat_e)
    sorted_e = flat_e[order]
    counts = jnp.zeros((N_EXPERTS,), jnp.int32).at[flat_e].add(1)
    padded = (counts + MOE_BLOCK - 1) // MOE_BLOCK * MOE_BLOCK
    pad_end = jnp.cumsum(padded)
    pad_start = pad_end - padded
    start = jnp.cumsum(counts) - counts
    dest = pad_start[sorted_e] + jnp.arange(n_assign, dtype=jnp.int32) - start[sorted_e]
    row_tok = jnp.full((n_blocks * MOE_BLOCK,), t, jnp.int32).at[dest].set((order // TOP_K).astype(jnp.int32))
    row_w = jnp.zeros((n_blocks * MOE_BLOCK,), jnp.float32).at[dest].set(wts.reshape(-1)[order])
    block_e = jnp.minimum(jnp.searchsorted(pad_end, jnp.arange(n_blocks, dtype=jnp.int32) * MOE_BLOCK,
                                           side='right'), N_EXPERTS - 1)
    h_pad = jnp.concatenate([h, jnp.zeros((1, d), h.dtype)], axis=0)

    def body(acc, blk):
        tok, wb, e = blk
        yb = swiglu(h_pad[tok], w1[e], w3[e], w2[e]).astype(jnp.float32) * wb[:, None]
        return acc.at[tok].add(yb), None

    acc, _ = lax.scan(body, jnp.zeros((t + 1, d), jnp.float32),
                      (row_tok.reshape(n_blocks, MOE_BLOCK), row_w.reshape(n_blocks, MOE_BLOCK), block_e))
    return acc[:t].astype(h.dtype)


def moe_ffn(h, router_w, router_b, w1, w3, w2, sw1, sw3, sw2):
    t = h.shape[0]
    scores = jax.nn.sigmoid((h @ router_w).astype(jnp.float32))
    biased = scores + router_b
    grp = biased.reshape(t, N_GROUPS, N_EXPERTS // N_GROUPS)
    grp_score = jnp.sum(lax.top_k(grp, 2)[0], axis=-1)
    _, gsel = lax.top_k(grp_score, TOPK_GROUPS)
    gmask = jnp.any(gsel[:, :, None] == jnp.arange(N_GROUPS)[None, None, :], axis=1)
    emask = jnp.repeat(gmask, N_EXPERTS // N_GROUPS, axis=1)
    _, idx = lax.top_k(jnp.where(emask, biased, -jnp.inf), TOP_K)
    wts = jnp.take_along_axis(scores, idx, axis=1)
    wts = wts / jnp.sum(wts, axis=-1, keepdims=True) * ROUTED_SCALE
    return routed_experts(h, idx, wts, w1, w3, w2) + swiglu(h, sw1, sw3, sw2)


def setup_inputs(seed: int = 0) -> dict:
    key = jax.random.key(seed)
    keys = iter(jax.random.split(key, 64))

    def nrm(shape, scale):
        return jax.random.normal(next(keys), shape, jnp.float32) * scale

    def unif(shape, lo, hi):
        return jax.random.uniform(next(keys), shape, jnp.float32, lo, hi)

    D, C, E, F = D_MODEL, GROUP_W, N_EXPERTS, D_EXPERT
    H = HY_FILTER_HIDDEN
    x = nrm((BATCH, SEQ, D), 1.0)
    c = nrm((BATCH, D), 1.0)
    ctx = nrm((BATCH, CTX_LEN, D), 1.0)
    c_ctx = nrm((D,), 1.0)
    dt = jnp.exp(unif((DEPTH, 2, GD_HEADS), math.log(1e-3), math.log(1e-1)))
    return {
        'x': x,
        'c': c,
        'ctx': ctx,
        'c_ctx': c_ctx,
        'ada_w': nrm((DEPTH, D, 6 * D), 0.5 * D ** -0.5),
        'ada_b': nrm((DEPTH, 6 * D), 0.02),
        'w_in': nrm((DEPTH, D, D_IN), D ** -0.5),
        'w_out': nrm((DEPTH, D, D), DEEPNORM_BETA * D ** -0.5),
        'ln_g': 1.0 + nrm((DEPTH, 2, D), 0.02),
        'ln_b': nrm((DEPTH, 2, D), 0.02),
        'rw_w0': unif((DEPTH, 2, C), -5.0, 0.0),
        'rw_w2': nrm((DEPTH, 2, RW_DECAY_LORA, C), 0.1),
        'rw_a0': nrm((DEPTH, 2, C), 0.1),
        'rw_a2': nrm((DEPTH, 2, RW_AAA_LORA, C), 0.1),
        'rw_g2': nrm((DEPTH, RW_GATE_LORA, C), RW_GATE_LORA ** -0.5),
        'rw_kk': 0.85 + nrm((DEPTH, C), 0.02),
        'rw_ka': 1.0 + nrm((DEPTH, C), 0.02),
        'rw_rk': nrm((DEPTH, RW_HEADS, RW_HD), 0.1),
        'rw_gn_g': 1.0 + nrm((DEPTH, C), 0.02),
        'rw_gn_b': nrm((DEPTH, C), 0.02),
        'gd_conv': nrm((DEPTH, GD_CONV, 3 * C), GD_CONV ** -0.5),
        'gd_alog': jnp.log(unif((DEPTH, 2, GD_HEADS), 1.0, 16.0)),
        'gd_dtb': dt + jnp.log(-jnp.expm1(-dt)),
        'gd_norm': 1.0 + nrm((DEPTH, GD_HD), 0.02),
        'hy_conv': nrm((DEPTH, HY_CONV, 3 * C), HY_CONV ** -0.5),
        'hy_conv_b': nrm((DEPTH, 3 * C), 0.02),
        'hy_w1': nrm((DEPTH, HY_EMB, H), HY_EMB ** -0.5),
        'hy_b1': nrm((DEPTH, H), 0.1),
        'hy_f1': 1.0 + nrm((DEPTH, H), 0.02),
        'hy_w2': nrm((DEPTH, H, H), H ** -0.5),
        'hy_b2': nrm((DEPTH, H), 0.1),
        'hy_f2': 1.0 + nrm((DEPTH, H), 0.02),
        'hy_w3': nrm((DEPTH, H, HY_ORDER * HY_SIDES * C), 0.05 * H ** -0.5),
        'hy_skip': nrm((DEPTH, HY_ORDER, C), 1.0),
        's5_lre': -0.5 + nrm((DEPTH, 2, S5_GROUPS, S5_STATE), 0.01),
        's5_lim': math.pi * jnp.arange(S5_STATE, dtype=jnp.float32) + nrm((DEPTH, 2, S5_GROUPS, S5_STATE), 0.01),
        's5_logstep': unif((DEPTH, 2, S5_GROUPS), math.log(1e-3), math.log(1e-1)),
        's5_bre': nrm((DEPTH, 2, S5_GROUPS, S5_STATE, S5_CH), (2 * S5_CH) ** -0.5),
        's5_bim': nrm((DEPTH, 2, S5_GROUPS, S5_STATE, S5_CH), (2 * S5_CH) ** -0.5),
        's5_cre': nrm((DEPTH, 2, S5_GROUPS, S5_CH, S5_STATE), 0.5),
        's5_cim': nrm((DEPTH, 2, S5_GROUPS, S5_CH, S5_STATE), 0.5),
        's5_d': nrm((DEPTH, C), 1.0),
        's5_glu_w': nrm((DEPTH, C, C), C ** -0.5),
        's5_glu_b': nrm((DEPTH, C), 0.02),
        'router_w': nrm((DEPTH, D, E), D ** -0.5),
        'router_b': nrm((DEPTH, E), 0.01),
        'ex_w1': nrm((DEPTH, E, D, F), D ** -0.5),
        'ex_w3': nrm((DEPTH, E, D, F), D ** -0.5),
        'ex_w2': nrm((DEPTH, E, F, D), DEEPNORM_BETA * F ** -0.5),
        'sh_w1': nrm((DEPTH, D, F), D ** -0.5),
        'sh_w3': nrm((DEPTH, D, F), D ** -0.5),
        'sh_w2': nrm((DEPTH, F, D), DEEPNORM_BETA * F ** -0.5),
    }


def reference(x, c, ctx, c_ctx, ada_w, ada_b, w_in, w_out, ln_g, ln_b,
              rw_w0, rw_w2, rw_a0, rw_a2, rw_g2, rw_kk, rw_ka, rw_rk, rw_gn_g, rw_gn_b,
              gd_conv, gd_alog, gd_dtb, gd_norm,
              hy_conv, hy_conv_b, hy_w1, hy_b1, hy_f1, hy_w2, hy_b2, hy_f2, hy_w3, hy_skip,
              s5_lre, s5_lim, s5_logstep, s5_bre, s5_bim, s5_cre, s5_cim, s5_d, s5_glu_w, s5_glu_b,
              router_w, router_b, ex_w1, ex_w3, ex_w2, sh_w1, sh_w3, sh_w2):
    d_model = x.shape[-1]
    rows = x.shape[1] // GRID_W
    xl, xc = x, ctx
    for i in range(DEPTH):
        need_ctx = i < DEPTH - 1
        mod_l = jax.nn.silu(c) @ ada_w[i] + ada_b[i]
        mod_c = jax.nn.silu(c_ctx) @ ada_w[i] + ada_b[i]
        sh1, sc1, ga1, sh2, sc2, ga2 = jnp.split(mod_l[:, None, :], 6, axis=-1)
        csh1, csc1, cga1, csh2, csc2, cga2 = jnp.split(mod_c, 6, axis=-1)

        zl = jnp.split((xl * (1.0 + sc1) + sh1) @ w_in[i], MIX_SPLIT, axis=-1)
        zc = jnp.split((xc * (1.0 + csc1) + csh1) @ w_in[i], MIX_SPLIT, axis=-1)
        rw_c, rw_l = rwkv7_mixer(zc[0], zl[0], rw_w0[i], rw_w2[i], rw_a0[i], rw_a2[i], rw_g2[i], rw_kk[i],
                                 rw_ka[i], rw_rk[i], rw_gn_g[i], rw_gn_b[i], need_ctx)
        gd_c, gd_l = gdn_mixer(zc[1], zl[1], gd_conv[i], gd_alog[i], gd_dtb[i], gd_norm[i], need_ctx)
        hy_c, hy_l = hyena_mixer(zc[2], zl[2], hy_conv[i], hy_conv_b[i], hy_w1[i], hy_b1[i], hy_f1[i],
                                 hy_w2[i], hy_b2[i], hy_f2[i], hy_w3[i], hy_skip[i], need_ctx)
        s5_c, s5_l = s5_mixer(zc[3], zl[3], rows, s5_lre[i], s5_lim[i], s5_logstep[i], s5_bre[i], s5_bim[i],
                              s5_cre[i], s5_cim[i], s5_d[i], s5_glu_w[i], s5_glu_b[i], need_ctx)
        ol = jnp.concatenate([rw_l, gd_l, hy_l, s5_l], axis=-1).astype(xl.dtype) @ w_out[i]
        xl = layer_norm(DEEPNORM_ALPHA * xl + ga1 * ol, ln_g[i, 0], ln_b[i, 0])
        if need_ctx:
            oc = jnp.concatenate([rw_c, gd_c, hy_c, s5_c], axis=-1).astype(xc.dtype) @ w_out[i]
            xc = layer_norm(DEEPNORM_ALPHA * xc + cga1 * oc, ln_g[i, 0], ln_b[i, 0])

        hl = (xl * (1.0 + sc2) + sh2).reshape(-1, d_model)
        if need_ctx:
            hc = (xc * (1.0 + csc2) + csh2).reshape(-1, d_model)
            f = moe_ffn(jnp.concatenate([hc, hl], axis=0), router_w[i], router_b[i], ex_w1[i], ex_w3[i],
                        ex_w2[i], sh_w1[i], sh_w3[i], sh_w2[i])
            fc, fl = f[:hc.shape[0]], f[hc.shape[0]:]
            xc = layer_norm(DEEPNORM_ALPHA * xc + cga2 * fc.reshape(xc.shape), ln_g[i, 1], ln_b[i, 1])
        else:
            fl = moe_ffn(hl, router_w[i], router_b[i], ex_w1[i], ex_w3[i], ex_w2[i], sh_w1[i], sh_w3[i],
                         sh_w2[i])
        xl = layer_norm(DEEPNORM_ALPHA * xl + ga2 * fl.reshape(xl.shape), ln_g[i, 1], ln_b[i, 1])
    return xl
```

```cpp
#include <hip/hip_runtime.h>
#include <hip/hip_bf16.h>
#include <stdint.h>
#include <stdio.h>

typedef unsigned short bf16_t;
using bf16x8 = __attribute__((ext_vector_type(8))) short;
using f32x4 = __attribute__((ext_vector_type(4))) float;

#define NTC 2048
#define NTL 32768
#define NT 34816
#define DM 1024
#define ZS 3024
#define COL_GD 960
#define COL_HY 2000
#define COL_S5 2768
#define NCHUNK 68
#define ALPHA 1.41421356237f
#define NTHREADS 256
#define LDS_BYTES 73728
#define LDS_USER 1024
#define SH_TILE_BASE 2240
#define ACT_ROWS ((SH_TILE_BASE + 272) * 128)

constexpr size_t al256(size_t x) { return (x + 255) & ~(size_t)255; }
constexpr size_t WS_CTL = 0;
constexpr size_t CTL_BYTES = 65536;
constexpr size_t WS_MOD = WS_CTL + CTL_BYTES;
constexpr size_t WS_S5A = al256(WS_MOD + 2 * 9 * 6144 * 4);
constexpr size_t WS_S5B = al256(WS_S5A + 2 * 2 * 16 * 64 * 4 * 4);
constexpr size_t WS_GLUT = al256(WS_S5B + 2 * 2 * 16 * 64 * 32 * 4);
constexpr size_t WS_WINT = al256(WS_GLUT + 2 * 256 * 256 * 2);
constexpr size_t WS_WOUTT = al256(WS_WINT + (size_t)3072 * 1024 * 2);
constexpr size_t WS_FILTL = al256(WS_WOUTT + (size_t)1024 * 1024 * 2);
constexpr size_t WS_FILTC = al256(WS_FILTL + (size_t)4 * 256 * 4096 * 4);
constexpr size_t WS_XC = al256(WS_FILTC + (size_t)4 * 256 * 256 * 4);
constexpr size_t WS_HBY = al256(WS_XC + (size_t)NTC * DM * 4);
constexpr size_t WS_CAT = al256(WS_HBY + (size_t)NT * DM * 2);
constexpr size_t WS_Z = al256(WS_CAT + (size_t)NT * DM * 2);
constexpr size_t WS_R1 = al256(WS_Z + (size_t)NT * ZS * 2);
constexpr size_t R1_RWP = 0;
constexpr size_t R1_GQ = (size_t)NT * 1024 * 2;
constexpr size_t R1_W13T = 0;
constexpr size_t R1_W2T = (size_t)65 * 512 * 1024 * 2;
constexpr size_t R1_BYTES = (size_t)NT * 1024 * 2 + (size_t)NT * 768 * 2;
constexpr size_t WS_KNORM = al256(WS_R1 + R1_BYTES);
constexpr size_t WS_GAB = al256(WS_KNORM + (size_t)NT * 4 * 4);
constexpr size_t WS_S5ST = al256(WS_GAB + (size_t)NT * 16 * 4);
constexpr size_t WS_AEP = al256(WS_S5ST + (size_t)8 * 68 * 2 * 16 * 64 * 2 * 4);
constexpr size_t WS_AW = al256(WS_AEP + (size_t)NT * 8 * 4);
constexpr size_t WS_RTOK = al256(WS_AW + (size_t)NT * 8 * 4);
constexpr size_t WS_RW = al256(WS_RTOK + (size_t)SH_TILE_BASE * 128 * 4);
constexpr size_t WS_TILEE = al256(WS_RW + (size_t)SH_TILE_BASE * 128 * 4);
constexpr size_t WS_END = al256(WS_TILEE + SH_TILE_BASE * 4);
static_assert(R1_W2T + (size_t)65 * 1024 * 256 * 2 <= R1_BYTES, "expert weights must fit R1");
static_assert((size_t)ACT_ROWS * 256 * 2 <= (size_t)NT * ZS * 2, "act must fit z");

#define CW_QUEUE(l) (4096 + 64 * (l))
#define CW_CNT(l) (4352 + 64 * (l))

#define XB_TMO      128
#define XB_XCNT(j)  (256  + 64 * (j))
#define XB_XSUB(j)  (1280 + 64 * (j))
#define XB_XGEN(j)  (2304 + 64 * (j))
#define XB_TOP      3328
#define XB_TOPGEN   3392
#define XCD_BAR_WORDS 3456
#define XB_SPIN_CAP (1u << 18)
#define LAS __attribute__((address_space(3)))

__device__ __forceinline__ unsigned xb_ld(unsigned* p)              { return __hip_atomic_load(p, __ATOMIC_RELAXED, __HIP_MEMORY_SCOPE_AGENT); }
__device__ __forceinline__ unsigned xb_add(unsigned* p, unsigned v) { return __hip_atomic_fetch_add(p, v, __ATOMIC_RELAXED, __HIP_MEMORY_SCOPE_AGENT); }
__device__ __forceinline__ unsigned xb_xcc_id() { return (unsigned)__builtin_amdgcn_s_getreg((3 << 11) | 20) & 0xFu; }
#define XB_SPIN(cond, bar) do { unsigned _sp = 0; while (cond) { __builtin_amdgcn_s_sleep(1); \
    if ((++_sp & 255u) == 0u) { if (xb_ld(&(bar)[XB_TMO])) break; if (_sp > XB_SPIN_CAP) { atomicAdd(&(bar)[XB_TMO], 1u); break; } } } } while (0)

struct XcdBarrier {
    unsigned* bar; unsigned x;
    volatile LAS unsigned* st;
};
__device__ __forceinline__ XcdBarrier xcd_barrier_post(unsigned* bar, volatile LAS unsigned* st) {
    XcdBarrier b; b.bar = bar; b.x = xb_xcc_id(); b.st = st;
    if (threadIdx.x == 0) (void)xb_add(&bar[XB_XCNT(b.x)], 1u);
    return b;
}
__device__ __forceinline__ void xcd_barrier_complete(unsigned* bar, unsigned x, unsigned& nloc, unsigned& nx) {
    const unsigned G = gridDim.x * gridDim.y * gridDim.z;
    unsigned sum, cnt, mine, sp = 0u;
    for (;;) {
        sum = 0u; cnt = 0u; mine = 0u;
#pragma unroll
        for (unsigned j = 0; j < 16; ++j) { const unsigned c = xb_ld(&bar[XB_XCNT(j)]); sum += c; cnt += (c > 0u) ? 1u : 0u; mine = (j == x) ? c : mine; }
        if (sum == G) break;
        __builtin_amdgcn_s_sleep(1);
        if ((++sp & 255u) == 0u) { if (xb_ld(&bar[XB_TMO])) break; if (sp > XB_SPIN_CAP) { atomicAdd(&bar[XB_TMO], 1u); break; } }
    }
    nloc = mine > 0u ? mine : 1u; nx = cnt > 0u ? cnt : 1u;
}
__device__ __forceinline__ void xcd_barrier(const XcdBarrier& b) {
    asm volatile("s_waitcnt vmcnt(0)" ::: "memory");
    __syncthreads();
    if (threadIdx.x == 0) {
        unsigned* bar = b.bar;
        __builtin_amdgcn_s_waitcnt(0);
        unsigned nloc = b.st[0], nx = b.st[1];
        if (nloc == 0u) { xcd_barrier_complete(bar, b.x, nloc, nx); b.st[0] = nloc; b.st[1] = nx; }
        const unsigned old = xb_add(&bar[XB_XSUB(b.x)], 1u);
        const unsigned gen = old / nloc;
        if (old + 1u == (gen + 1u) * nloc) {
            __builtin_amdgcn_fence(__ATOMIC_RELEASE, "agent");
            asm volatile("s_waitcnt vmcnt(0)" ::: "memory");
            const unsigned og = xb_add(&bar[XB_TOP], 1u);
            const unsigned tg = og / nx;
            if (og + 1u == (tg + 1u) * nx) xb_add(&bar[XB_TOPGEN], 1u);
            else XB_SPIN(xb_ld(&bar[XB_TOPGEN]) == tg, bar);
            __builtin_amdgcn_fence(__ATOMIC_ACQUIRE, "agent");
            xb_add(&bar[XB_XGEN(b.x)], 1u);
            asm volatile("s_waitcnt vmcnt(0)" ::: "memory");
        } else {
            XB_SPIN(xb_ld(&bar[XB_XGEN(b.x)]) == gen, bar);
            __builtin_amdgcn_fence(__ATOMIC_ACQUIRE, "agent");
            asm volatile("s_waitcnt vmcnt(0)" ::: "memory");
        }
    }
    __syncthreads();
}

struct KP {
    const float* in[52];
    float* out;
    char* ws;
    int ph_lo, ph_hi;
};
struct P {
    const __attribute__((address_space(3))) unsigned* tab;
    float* out;
    char* ws;
    __device__ __forceinline__ const float* in(int i) const {
        const unsigned lo = __builtin_amdgcn_readfirstlane(tab[2 * i]);
        const unsigned hi = __builtin_amdgcn_readfirstlane(tab[2 * i + 1]);
        return (const float*)(((unsigned long long)hi << 32) | (unsigned long long)lo);
    }
};
enum { I_X = 0, I_C, I_CTX, I_CCTX, I_ADAW, I_ADAB, I_WIN, I_WOUT, I_LNG, I_LNB,
       I_RW_W0, I_RW_W2, I_RW_A0, I_RW_A2, I_RW_G2, I_RW_KK, I_RW_KA, I_RW_RK, I_RW_GNG, I_RW_GNB,
       I_GD_CONV, I_GD_ALOG, I_GD_DTB, I_GD_NORM,
       I_HY_CONV, I_HY_CONVB, I_HY_W1, I_HY_B1, I_HY_F1, I_HY_W2, I_HY_B2, I_HY_F2, I_HY_W3, I_HY_SKIP,
       I_S5_LRE, I_S5_LIM, I_S5_LOGSTEP, I_S5_BRE, I_S5_BIM, I_S5_CRE, I_S5_CIM, I_S5_D, I_S5_GLUW, I_S5_GLUB,
       I_ROUTER_W, I_ROUTER_B, I_EX_W1, I_EX_W3, I_EX_W2, I_SH_W1, I_SH_W3, I_SH_W2 };

__device__ __forceinline__ bf16_t f2bf(float f) { unsigned u = __float_as_uint(f); u += 0x7fffu + ((u >> 16) & 1u); return (bf16_t)(u >> 16); }
__device__ __forceinline__ float bf2f(bf16_t h) { return __uint_as_float(((unsigned)h) << 16); }
__device__ __forceinline__ float bflo(unsigned u) { return __uint_as_float(u << 16); }
__device__ __forceinline__ float bfhi(unsigned u) { return __uint_as_float(u & 0xffff0000u); }
__device__ __forceinline__ unsigned pack2(float a, float b) { return (unsigned)f2bf(a) | ((unsigned)f2bf(b) << 16); }
__device__ __forceinline__ float sigm(float x) { return 1.f / (1.f + __expf(-x)); }
__device__ __forceinline__ float siluf(float x) { return x / (1.f + __expf(-x)); }
__device__ __forceinline__ float softplusf(float x) { return fmaxf(x, 0.f) + log1pf(__expf(-fabsf(x))); }
__device__ __forceinline__ float wave_sum(float v) {
#pragma unroll
    for (int o = 32; o >= 1; o >>= 1) v += __shfl_xor(v, o);
    return v;
}
template <int CTRL> __device__ __forceinline__ float dppf(float v) {
    return __int_as_float(__builtin_amdgcn_update_dpp(0, __float_as_int(v), CTRL, 0xF, 0xF, true));
}
__device__ __forceinline__ int otid() { int t = threadIdx.x; asm volatile("" : "+v"(t)); return t; }
__device__ __forceinline__ float* xrow(const P& p, int row) {
    return row < NTC ? (float*)(p.ws + WS_XC) + (size_t)row * DM : p.out + (size_t)(row - NTC) * DM;
}
__device__ __forceinline__ int row_mod(int row) { return row < NTC ? 8 : ((row - NTC) >> 12); }
__device__ __forceinline__ const float* modp(const P& p, int l, int r, int chunk) {
    return (const float*)(p.ws + WS_MOD) + ((size_t)(l * 9 + r) * 6144 + chunk * 1024);
}

__device__ __forceinline__ void gemm_tile(const bf16_t* __restrict__ A, int lda, int arow_a, int arow_b,
                                          const bf16_t* __restrict__ Bt, int ldb, int brow0, int K,
                                          char* lds, f32x4 (&acc)[4][4]) {
    const int tid = otid();
    const int wid = tid >> 6, lane = tid & 63, wr = wid >> 1, wc = wid & 1, fr = lane & 15, fq = lane >> 4;
    char* SA = lds; char* SB = lds + 8192;
    const int c8 = (tid & 3) * 8;
    const bf16_t* a0 = A + (size_t)arow_a * lda + c8;
    const bf16_t* a1 = A + (size_t)arow_b * lda + c8;
    const bf16_t* b0 = Bt + (size_t)(brow0 + (tid >> 2)) * ldb + c8;
    const bf16_t* b1 = Bt + (size_t)(brow0 + (tid >> 2) + 64) * ldb + c8;
#pragma unroll
    for (int m = 0; m < 4; ++m)
#pragma unroll
        for (int n = 0; n < 4; ++n) acc[m][n] = f32x4{0.f, 0.f, 0.f, 0.f};
    const int nk = K >> 5;
    for (int t = 0; t < nk; ++t) {
        const int ko = t * 32;
        __builtin_amdgcn_global_load_lds((const void*)(a0 + ko), (LAS void*)(SA + tid * 16), 16, 0, 0);
        __builtin_amdgcn_global_load_lds((const void*)(a1 + ko), (LAS void*)(SA + tid * 16 + 4096), 16, 0, 0);
        __builtin_amdgcn_global_load_lds((const void*)(b0 + ko), (LAS void*)(SB + tid * 16), 16, 0, 0);
        __builtin_amdgcn_global_load_lds((const void*)(b1 + ko), (LAS void*)(SB + tid * 16 + 4096), 16, 0, 0);
        asm volatile("s_waitcnt vmcnt(0)" ::: "memory");
        __syncthreads();
        bf16x8 af[4], bfr[4];
#pragma unroll
        for (int m = 0; m < 4; ++m) af[m] = *reinterpret_cast<const bf16x8*>(SA + (wr * 64 + m * 16 + fr) * 64 + fq * 16);
#pragma unroll
        for (int n = 0; n < 4; ++n) bfr[n] = *reinterpret_cast<const bf16x8*>(SB + (wc * 64 + n * 16 + fr) * 64 + fq * 16);
#pragma unroll
        for (int m = 0; m < 4; ++m)
#pragma unroll
            for (int n = 0; n < 4; ++n) acc[m][n] = __builtin_amdgcn_mfma_f32_16x16x32_bf16(af[m], bfr[n], acc[m][n], 0, 0, 0);
        __syncthreads();
    }
}

__device__ void ph0_mod_unit(const P& p, int u, char* lds) {
    const int l = u / 96, cg = u % 96, tid = otid();
    float* s = (float*)lds;
    float* red = s + 9 * 1024;
    const float* c = p.in(I_C); const float* cctx = p.in(I_CCTX);
    for (int i = tid; i < 9 * 1024; i += NTHREADS) { int r = i >> 10, k = i & 1023; float v = r < 8 ? c[r * 1024 + k] : cctx[k]; s[i] = v / (1.f + expf(-v)); }
    __syncthreads();
    const int kq = tid >> 6, j = tid & 63, col = cg * 64 + j;
    const float* w = p.in(I_ADAW) + (size_t)l * 1024 * 6144 + col;
    float acc[9];
#pragma unroll
    for (int r = 0; r < 9; ++r) acc[r] = 0.f;
#pragma unroll 4
    for (int k = kq * 256; k < kq * 256 + 256; ++k) {
        const float wv = w[(size_t)k * 6144];
#pragma unroll
        for (int r = 0; r < 9; ++r) acc[r] += s[r * 1024 + k] * wv;
    }
#pragma unroll
    for (int r = 0; r < 9; ++r) red[(kq * 9 + r) * 64 + j] = acc[r];
    __syncthreads();
    if (tid < 64) {
        float* mod = (float*)(p.ws + WS_MOD);
        const float bb = p.in(I_ADAB)[l * 6144 + col];
#pragma unroll
        for (int r = 0; r < 9; ++r) mod[(size_t)(l * 9 + r) * 6144 + col] = red[r * 64 + j] + red[(9 + r) * 64 + j] + red[(18 + r) * 64 + j] + red[(27 + r) * 64 + j] + bb;
    }
    __syncthreads();
}

__device__ void ph0_s5tab_unit(const P& p, int u) {
    const int tid = otid();
    if (tid >= 64) return;
    const int ldg = u;
    const int idx = ldg * 64 + tid;
    const double lre = (double)p.in(I_S5_LRE)[idx], lim = (double)p.in(I_S5_LIM)[idx];
    const double dt = exp((double)p.in(I_S5_LOGSTEP)[ldg]);
    const double mag = exp(lre * dt), ang = lim * dt;
    const double abr = mag * cos(ang), abi = mag * sin(ang);
    const double den = lre * lre + lim * lim;
    const double cor = ((abr - 1.0) * lre + abi * lim) / den;
    const double coi = (abi * lre - (abr - 1.0) * lim) / den;
    const double m64 = exp(64.0 * lre * dt), a64 = 64.0 * ang;
    float* A = (float*)(p.ws + WS_S5A) + (size_t)idx * 4;
    A[0] = (float)abr; A[1] = (float)abi; A[2] = (float)(m64 * cos(a64)); A[3] = (float)(m64 * sin(a64));
    float* B = (float*)(p.ws + WS_S5B) + (size_t)idx * 32;
    const float* bre = p.in(I_S5_BRE) + (size_t)idx * 16; const float* bim = p.in(I_S5_BIM) + (size_t)idx * 16;
#pragma unroll
    for (int h = 0; h < 16; ++h) {
        const double br = bre[h], bi = bim[h];
        B[h] = (float)(cor * br - coi * bi);
        B[16 + h] = (float)(cor * bi + coi * br);
    }
}

__device__ __forceinline__ int xmap(int mode, int c) {
    if (mode == 0) return c;
    const int j = c >> 6, cc = c & 63, wc = cc >> 5, pp = (cc & 31) >> 4, i = cc & 15;
    return j * 128 + wc * 64 + pp * 32 + i + (mode == 2 ? 16 : 0);
}
__device__ void xpose_tile(const float* __restrict__ src, int C, bf16_t* __restrict__ dst, int ldd, int mode, int tr, int tc, char* lds) {
    float* t = (float*)lds;
    const int tid = otid(), tx = tid & 63, ty = tid >> 6;
#pragma unroll
    for (int k = 0; k < 16; ++k) {
        const int rr = ty + 4 * k, r = tr * 64 + rr, c = tc * 64 + tx;
        t[rr * 65 + tx] = (c < C) ? src[(size_t)r * C + c] : 0.f;
    }
    __syncthreads();
#pragma unroll
    for (int k = 0; k < 16; ++k) {
        const int ci = ty + 4 * k, c = tc * 64 + ci;
        dst[(size_t)xmap(mode, c) * ldd + tr * 64 + tx] = f2bf(t[tx * 65 + ci]);
    }
    __syncthreads();
}

enum { M_INIT = 0, M_LN2NEXT = 1, M_LN1 = 2, M_FINAL = 3 };

template <int MODE>
__device__ void rows_unit(const P& p, int l, int u, char* lds) {
    const int tid = otid(), w = tid >> 6, lane = tid & 63;
    float* hbuf = (float*)lds;
    bf16_t* hb = (bf16_t*)(p.ws + WS_HBY);
#pragma unroll 1
    for (int rr = 0; rr < 2; ++rr) {
        const int rl = w * 2 + rr, row = u * 8 + rl;
        const int mr = row_mod(row);
        float v[16];
        float* xr = xrow(p, row);
        const float* src = (MODE == M_INIT) ? (row < NTC ? p.in(I_CTX) + (size_t)row * DM : p.in(I_X) + (size_t)(row - NTC) * DM) : xr;
#pragma unroll
        for (int i = 0; i < 4; ++i) {
            const float4 t = *reinterpret_cast<const float4*>(src + i * 256 + lane * 4);
            v[i * 4 + 0] = t.x; v[i * 4 + 1] = t.y; v[i * 4 + 2] = t.z; v[i * 4 + 3] = t.w;
        }
        if (MODE != M_INIT) {
            const int ll = (MODE == M_LN2NEXT) ? l - 1 : l;
            const int which = (MODE == M_LN1) ? 0 : 1;
            float s = 0.f;
#pragma unroll
            for (int i = 0; i < 16; ++i) s += v[i];
            const float mu = wave_sum(s) * (1.f / 1024.f);
            float q = 0.f;
#pragma unroll
            for (int i = 0; i < 16; ++i) { const float d = v[i] - mu; q += d * d; }
            const float rstd = rsqrtf(wave_sum(q) * (1.f / 1024.f) + 1e-5f);
            const float* g = p.in(I_LNG) + (size_t)(ll * 2 + which) * 1024;
            const float* bb = p.in(I_LNB) + (size_t)(ll * 2 + which) * 1024;
#pragma unroll
            for (int i = 0; i < 4; ++i) {
                const float4 gg = *reinterpret_cast<const float4*>(g + i * 256 + lane * 4);
                const float4 b4 = *reinterpret_cast<const float4*>(bb + i * 256 + lane * 4);
                v[i * 4 + 0] = (v[i * 4 + 0] - mu) * rstd * gg.x + b4.x;
                v[i * 4 + 1] = (v[i * 4 + 1] - mu) * rstd * gg.y + b4.y;
                v[i * 4 + 2] = (v[i * 4 + 2] - mu) * rstd * gg.z + b4.z;
                v[i * 4 + 3] = (v[i * 4 + 3] - mu) * rstd * gg.w + b4.w;
            }
        }
        if (MODE == M_FINAL) {
            if (row >= NTC) {
#pragma unroll
                for (int i = 0; i < 4; ++i) *reinterpret_cast<float4*>(xr + i * 256 + lane * 4) = make_float4(v[i * 4], v[i * 4 + 1], v[i * 4 + 2], v[i * 4 + 3]);
            }
            continue;
        }
        const float osc = (MODE == M_LN1) ? ALPHA : 1.f;
#pragma unroll
        for (int i = 0; i < 4; ++i) *reinterpret_cast<float4*>(xr + i * 256 + lane * 4) = make_float4(osc * v[i * 4], osc * v[i * 4 + 1], osc * v[i * 4 + 2], osc * v[i * 4 + 3]);
        const float* sh = modp(p, l, mr, (MODE == M_LN1) ? 3 : 0);
        const float* sc = modp(p, l, mr, (MODE == M_LN1) ? 4 : 1);
#pragma unroll
        for (int i = 0; i < 4; ++i) {
            const float4 s4 = *reinterpret_cast<const float4*>(sc + i * 256 + lane * 4);
            const float4 h4 = *reinterpret_cast<const float4*>(sh + i * 256 + lane * 4);
            const float h0 = v[i * 4 + 0] * (1.f + s4.x) + h4.x, h1 = v[i * 4 + 1] * (1.f + s4.y) + h4.y;
            const float h2 = v[i * 4 + 2] * (1.f + s4.z) + h4.z, h3 = v[i * 4 + 3] * (1.f + s4.w) + h4.w;
            uint2 pk; pk.x = pack2(h0, h1); pk.y = pack2(h2, h3);
            *reinterpret_cast<uint2*>(hb + (size_t)row * DM + i * 256 + lane * 4) = pk;
            if (MODE == M_LN1) *reinterpret_cast<float4*>(hbuf + rl * 1024 + i * 256 + lane * 4) = make_float4(h0, h1, h2, h3);
        }
    }
    if (MODE == M_LN1) {
        const float* rw = p.in(I_ROUTER_W) + (size_t)l * 1024 * 64 + lane;
        const float* h0p = hbuf + (w * 2) * 1024; const float* h1p = h0p + 1024;
        float a0 = 0.f, a1 = 0.f;
#pragma unroll 2
        for (int k = 0; k < 1024; k += 4) {
            const float4 x0 = *reinterpret_cast<const float4*>(h0p + k);
            const float4 x1 = *reinterpret_cast<const float4*>(h1p + k);
            const float w0 = rw[(size_t)(k + 0) * 64], w1 = rw[(size_t)(k + 1) * 64], w2 = rw[(size_t)(k + 2) * 64], w3 = rw[(size_t)(k + 3) * 64];
            a0 += x0.x * w0; a1 += x1.x * w0;
            a0 += x0.y * w1; a1 += x1.y * w1;
            a0 += x0.z * w2; a1 += x1.z * w2;
            a0 += x0.w * w3; a1 += x1.w * w3;
        }
        const float rbias = p.in(I_ROUTER_B)[l * 64 + lane];
        unsigned* cnt = (unsigned*)(p.ws + WS_CTL) + CW_CNT(l);
        int* aep = (int*)(p.ws + WS_AEP); float* aw = (float*)(p.ws + WS_AW);
#pragma unroll 1
        for (int rr = 0; rr < 2; ++rr) {
            const int row = u * 8 + w * 2 + rr;
            const float logit = rr ? a1 : a0;
            const float s = 1.f / (1.f + expf(-logit));
            const float bsd = s + rbias;
            float m1 = bsd;
            m1 = fmaxf(m1, __shfl_xor(m1, 1)); m1 = fmaxf(m1, __shfl_xor(m1, 2)); m1 = fmaxf(m1, __shfl_xor(m1, 4));
            const unsigned long long eqm = __ballot(bsd == m1);
            const int gbase = lane & ~7;
            const unsigned gbits = (unsigned)((eqm >> gbase) & 0xFFull);
            const int first = gbase + __builtin_ctz(gbits);
            float m2 = (lane == first) ? -INFINITY : bsd;
            m2 = fmaxf(m2, __shfl_xor(m2, 1)); m2 = fmaxf(m2, __shfl_xor(m2, 2)); m2 = fmaxf(m2, __shfl_xor(m2, 4));
            const float gs = m1 + m2;
            const int myg = lane >> 3;
            int grank = 0;
#pragma unroll
            for (int g2 = 0; g2 < 8; ++g2) { const float o = __shfl(gs, g2 * 8); grank += (o > gs || (o == gs && g2 < myg)) ? 1 : 0; }
            const bool gsel = grank < 4;
            const float msk = gsel ? bsd : -INFINITY;
            int erank = 0;
#pragma unroll
            for (int j = 0; j < 64; ++j) { const float o = __shfl(msk, j); erank += (o > msk || (o == msk && j < lane)) ? 1 : 0; }
            const bool sel = gsel && erank < 8;
            const float wsum = wave_sum(sel ? s : 0.f);
            const unsigned long long selm = __ballot(sel);
            if (sel) {
                const int slot = __popcll(selm & ((1ull << lane) - 1ull));
                const unsigned pos = atomicAdd(&cnt[lane], 1u);
                aep[(size_t)row * 8 + slot] = (int)((unsigned)lane << 24 | pos);
                aw[(size_t)row * 8 + slot] = s / wsum * 2.5f;
            }
        }
    }
}

__device__ void filt_unit(const P& p, int l, int u, char* lds) {
    const int tid = otid();
    float* feat = (float*)lds;
    float* h1 = feat + 4 * 36;
    float* h2 = h1 + 4 * 64;
    const int pp = tid >> 6, j = tid & 63;
    const int pi = u * 4 + pp;
    const int L = pi < 4096 ? 4096 : 256;
    const int t = pi < 4096 ? pi : pi - 4096;
    const double tt = (double)t / (double)(L - 1);
    if (j < 33) {
        float f;
        if (j == 0) f = (float)tt;
        else {
            const int k = (j - 1) & 15;
            const double band = 1e-4 + (double)k * ((15.0 - 1e-4) / 15.0);
            double ph = band * (double)t / (double)L;
            ph -= floor(ph);
            const double a = ph * 6.283185307179586;
            f = (j <= 16) ? (float)cos(a) : (float)(-sin(a));
        }
        feat[pp * 36 + j] = f;
    }
    __syncthreads();
    {
        const float* w1 = p.in(I_HY_W1) + (size_t)l * 33 * 64;
        float a = p.in(I_HY_B1)[l * 64 + j];
        for (int i = 0; i < 33; ++i) a += feat[pp * 36 + i] * w1[i * 64 + j];
        h1[pp * 64 + j] = sinf(p.in(I_HY_F1)[l * 64 + j] * a);
    }
    __syncthreads();
    {
        const float* w2 = p.in(I_HY_W2) + (size_t)l * 64 * 64;
        float a = p.in(I_HY_B2)[l * 64 + j];
        for (int i = 0; i < 64; ++i) a += h1[pp * 64 + i] * w2[i * 64 + j];
        h2[pp * 64 + j] = sinf(p.in(I_HY_F2)[l * 64 + j] * a);
    }
    __syncthreads();
    {
        const int c = tid;
        const float* w3 = p.in(I_HY_W3) + (size_t)l * 64 * 1024;
        float acc[4][4];
#pragma unroll
        for (int a = 0; a < 4; ++a)
#pragma unroll
            for (int b = 0; b < 4; ++b) acc[a][b] = 0.f;
        for (int i = 0; i < 64; ++i) {
            float wv[4];
#pragma unroll
            for (int os = 0; os < 4; ++os) wv[os] = w3[i * 1024 + os * 256 + c];
#pragma unroll
            for (int q = 0; q < 4; ++q) {
                const float hv = h2[q * 64 + i];
#pragma unroll
                for (int os = 0; os < 4; ++os) acc[q][os] += hv * wv[os];
            }
        }
        const float d0 = logf(0.01f) / 1.5f, d1 = logf(0.01f) / 0.3f;
        const float delta = fabsf(d0 + (d1 - d0) * ((float)c / 255.f));
#pragma unroll
        for (int q = 0; q < 4; ++q) {
            const int pq = u * 4 + q;
            const int Lq = pq < 4096 ? 4096 : 256;
            const int tq = pq < 4096 ? pq : pq - 4096;
            const float ttq = (float)tq / (float)(Lq - 1);
            const float dec = expf(-ttq * delta);
            float* F = (pq < 4096) ? (float*)(p.ws + WS_FILTL) : (float*)(p.ws + WS_FILTC);
#pragma unroll
            for (int os = 0; os < 4; ++os) F[((size_t)os * 256 + c) * Lq + tq] = acc[q][os] * dec;
        }
    }
    __syncthreads();
}

__device__ void rwkv_prep_unit(const P& p, int l, int u, char* lds) {
    const int tid = otid(), w = tid >> 6;
    float* tw = (float*)lds;
    float* al = tw + 32 * 64;
    const bf16_t* z = (const bf16_t*)(p.ws + WS_Z);
    bf16_t* rwp = (bf16_t*)(p.ws + WS_R1 + R1_RWP);
    float* knorm = (float*)(p.ws + WS_KNORM);
    const int row0 = u * 32;
#pragma unroll
    for (int i = 0; i < 8; ++i) {
        const int idx = tid + 256 * i, tok = idx >> 6, j = idx & 63;
        const bf16_t* zr = z + (size_t)(row0 + tok) * ZS;
        tw[idx] = tanhf(bf2f(zr[768 + j]));
        al[idx] = bf2f(zr[832 + j]);
    }
    __syncthreads();
    const int c = tid;
#pragma unroll 1
    for (int pass = 0; pass < 4; ++pass) {
        const int d = pass & 1;
        const bool isA = pass >= 2;
        const float* W2 = (isA ? p.in(I_RW_A2) : p.in(I_RW_W2)) + (size_t)((l * 2 + d) * 32) * 256 + c;
        const float base = (isA ? p.in(I_RW_A0) : p.in(I_RW_W0))[(l * 2 + d) * 256 + c];
        float wr[32];
#pragma unroll
        for (int r = 0; r < 32; ++r) wr[r] = W2[r * 256];
        const float* src = isA ? al : tw;
#pragma unroll 2
        for (int tok = 0; tok < 32; ++tok) {
            float a = base;
#pragma unroll
            for (int r = 0; r < 32; r += 4) {
                const float4 x = *reinterpret_cast<const float4*>(src + tok * 64 + d * 32 + r);
                a += x.x * wr[r] + x.y * wr[r + 1] + x.z * wr[r + 2] + x.w * wr[r + 3];
            }
            float o;
            if (isA) o = 1.f / (1.f + expf(-a));
            else o = expf(-softplusf(-a) - 0.5f);
            rwp[((size_t)(row0 + tok) * 4 + pass) * 256 + c] = f2bf(o);
        }
    }
    const float kkc = p.in(I_RW_KK)[l * 256 + c];
#pragma unroll 4
    for (int tok = 0; tok < 32; ++tok) {
        const float kv = bf2f(z[(size_t)(row0 + tok) * ZS + 256 + c]) * kkc;
        const float ss = wave_sum(kv * kv);
        if ((tid & 63) == 0) knorm[(size_t)(row0 + tok) * 4 + w] = rsqrtf(ss + 1e-12f);
    }
    __syncthreads();
}

__device__ void gdn_prep_unit(const P& p, int l, int u) {
    const int tid = otid();
    const bf16_t* z = (const bf16_t*)(p.ws + WS_Z);
    bf16_t* gq = (bf16_t*)(p.ws + WS_R1 + R1_GQ);
    float* gab = (float*)(p.ws + WS_GAB);
    const int row0 = u * 32;
    int seq0, seqL;
    if (row0 < NTC) { seq0 = row0 & ~255; seqL = 256; } else { seq0 = NTC + ((row0 - NTC) & ~4095); seqL = 4096; }
#pragma unroll 1
    for (int pz = 0; pz < 3; ++pz) {
        const int ch = pz * 256 + tid;
        const float w0 = p.in(I_GD_CONV)[(size_t)(l * 3 + 0) * 768 + ch], w1 = p.in(I_GD_CONV)[(size_t)(l * 3 + 1) * 768 + ch], w2 = p.in(I_GD_CONV)[(size_t)(l * 3 + 2) * 768 + ch];
        const bf16_t* zc = z + COL_GD + ch;
        float xm = (row0 - 1 >= seq0) ? bf2f(zc[(size_t)(row0 - 1) * ZS]) : 0.f;
        float x0 = bf2f(zc[(size_t)row0 * ZS]);
#pragma unroll 4
        for (int tok = 0; tok < 32; ++tok) {
            const int row = row0 + tok;
            const float xp = (row + 1 < seq0 + seqL) ? bf2f(zc[(size_t)(row + 1) * ZS]) : 0.f;
            float v = siluf(w0 * xm + w1 * x0 + w2 * xp);
            if (pz < 2) {
                const float ss = wave_sum(v * v);
                v *= rsqrtf(ss + 1e-12f) * (pz == 0 ? 0.125f : 1.f);
            }
            gq[(size_t)row * 768 + ch] = f2bf(v);
            xm = x0; x0 = xp;
        }
    }
    {
        const int tok = tid >> 3, dh = tid & 7;
        const int row = row0 + tok;
        const float alv = bf2f(z[(size_t)row * ZS + COL_GD + 1024 + dh]);
        const float blv = bf2f(z[(size_t)row * ZS + COL_GD + 1032 + dh]);
        const float g = -expf(p.in(I_GD_ALOG)[l * 8 + dh]) * softplusf(alv + p.in(I_GD_DTB)[l * 8 + dh]);
        gab[(size_t)row * 16 + dh] = expf(g);
        gab[(size_t)row * 16 + 8 + dh] = 1.f / (1.f + expf(-blv));
    }
}

__device__ __forceinline__ int s5_chain_row(int b, int d, int q) {
    if (q < 256) return b * 256 + (d ? 255 - q : q);
    int n = q - 256; if (d) n = 4095 - n;
    return NTC + b * 4096 + (n & 63) * 64 + (n >> 6);
}
__device__ __forceinline__ void s5_load_u(const bf16_t* zr, float* dst) {
    const uint4 a = *reinterpret_cast<const uint4*>(zr);
    const uint4 b = *reinterpret_cast<const uint4*>(zr + 8);
    *reinterpret_cast<float4*>(dst + 0) = make_float4(bflo(a.x), bfhi(a.x), bflo(a.y), bfhi(a.y));
    *reinterpret_cast<float4*>(dst + 4) = make_float4(bflo(a.z), bfhi(a.z), bflo(a.w), bfhi(a.w));
    *reinterpret_cast<float4*>(dst + 8) = make_float4(bflo(b.x), bfhi(b.x), bflo(b.y), bfhi(b.y));
    *reinterpret_cast<float4*>(dst + 12) = make_float4(bflo(b.z), bfhi(b.z), bflo(b.w), bfhi(b.w));
}

__device__ void s5_pre_unit(const P& p, int l, int u, char* lds) {
    const int tid = otid(), w = tid >> 6, lane = tid & 63;
    float* ust = (float*)lds + w * 1024;
    const int wt = u * 4 + w;
    const int d = wt & 1, g = (wt >> 1) & 15, rest = wt >> 5;
    const int cc = rest % NCHUNK, b = rest / NCHUNK;
    const bf16_t* z = (const bf16_t*)(p.ws + WS_Z);
    {
        const int row = s5_chain_row(b, d, cc * 64 + lane);
        s5_load_u(z + (size_t)row * ZS + COL_S5 + g * 16, ust + lane * 16);
    }
    const int tix = ((l * 2 + d) * 16 + g) * 64 + lane;
    const float4 A = *reinterpret_cast<const float4*>((const float*)(p.ws + WS_S5A) + (size_t)tix * 4);
    const float* Bp = (const float*)(p.ws + WS_S5B) + (size_t)tix * 32;
    float br[16], bi[16];
#pragma unroll
    for (int h = 0; h < 16; ++h) { br[h] = Bp[h]; bi[h] = Bp[16 + h]; }
    float xr = 0.f, xi = 0.f;
#pragma unroll 2
    for (int s = 0; s < 64; ++s) {
        float ur = 0.f, ui = 0.f;
#pragma unroll
        for (int h4 = 0; h4 < 4; ++h4) {
            const float4 uu = *reinterpret_cast<const float4*>(ust + s * 16 + h4 * 4);
            ur += br[h4 * 4] * uu.x + br[h4 * 4 + 1] * uu.y + br[h4 * 4 + 2] * uu.z + br[h4 * 4 + 3] * uu.w;
            ui += bi[h4 * 4] * uu.x + bi[h4 * 4 + 1] * uu.y + bi[h4 * 4 + 2] * uu.z + bi[h4 * 4 + 3] * uu.w;
        }
        const float nr = A.x * xr - A.y * xi + ur;
        const float ni = A.x * xi + A.y * xr + ui;
        xr = nr; xi = ni;
    }
    float* st = (float*)(p.ws + WS_S5ST) + ((((size_t)(b * NCHUNK + cc) * 2 + d) * 16 + g) * 64 + lane) * 2;
    st[0] = xr; st[1] = xi;
}

__device__ __forceinline__ float reduce16(const float (&t)[16], int lane) {
    float a[8];
    const bool hi8 = (lane & 8) != 0;
#pragma unroll
    for (int k = 0; k < 8; ++k) { const float keep = hi8 ? t[k + 8] : t[k]; const float send = hi8 ? t[k] : t[k + 8]; a[k] = keep + dppf<0x140>(send); }
    float b[4];
    const bool hi4 = (lane & 4) != 0;
#pragma unroll
    for (int k = 0; k < 4; ++k) { const float keep = hi4 ? a[k + 4] : a[k]; const float send = hi4 ? a[k] : a[k + 4]; b[k] = keep + dppf<0x141>(send); }
    float c[2];
    const bool hi2 = (lane & 2) != 0;
#pragma unroll
    for (int k = 0; k < 2; ++k) { const float keep = hi2 ? b[k + 2] : b[k]; const float send = hi2 ? b[k] : b[k + 2]; c[k] = keep + dppf<0x4E>(send); }
    const bool hi1 = (lane & 1) != 0;
    float r = (hi1 ? c[1] : c[0]) + dppf<0xB1>(hi1 ? c[0] : c[1]);
    r += __shfl_xor(r, 16);
    r += __shfl_xor(r, 32);
    return r;
}

__device__ void s5_main_unit(const P& p, int l, int u, char* lds) {
    const int tid = otid(), w = tid >> 6, lane = tid & 63;
    float* ust = (float*)lds + w * 2048;
    float* yst = ust + 1024;
    const int b = u / NCHUNK, tc = u % NCHUNK;
    bf16_t* z = (bf16_t*)(p.ws + WS_Z);
    const int myrow = (tc < 4) ? (b * 256 + tc * 64 + lane) : (NTC + b * 4096 + lane * 64 + (tc - 4));
#pragma unroll 1
    for (int gi = 0; gi < 4; ++gi) {
        const int g = w * 4 + gi;
        s5_load_u(z + (size_t)myrow * ZS + COL_S5 + g * 16, ust + lane * 16);
#pragma unroll 1
        for (int d = 0; d < 2; ++d) {
            const int tix = ((l * 2 + d) * 16 + g) * 64 + lane;
            const float4 A = *reinterpret_cast<const float4*>((const float*)(p.ws + WS_S5A) + (size_t)tix * 4);
            const float* Bp = (const float*)(p.ws + WS_S5B) + (size_t)tix * 32;
            float br[16], bi[16], cr[16], ci[16];
#pragma unroll
            for (int h = 0; h < 16; ++h) { br[h] = Bp[h]; bi[h] = Bp[16 + h]; }
            const float* crp = p.in(I_S5_CRE) + (size_t)((l * 2 + d) * 16 + g) * 1024 + lane;
            const float* cip = p.in(I_S5_CIM) + (size_t)((l * 2 + d) * 16 + g) * 1024 + lane;
#pragma unroll
            for (int h = 0; h < 16; ++h) { cr[h] = crp[h * 64]; ci[h] = cip[h * 64]; }
            const int cc = d ? ((tc < 4) ? 3 - tc : 71 - tc) : tc;
            float xr = 0.f, xi = 0.f;
            {
                const float* st = (const float*)(p.ws + WS_S5ST) + ((((size_t)(b * NCHUNK) * 2 + d) * 16 + g) * 64 + lane) * 2;
                for (int c2 = 0; c2 < cc; ++c2) {
                    const float2 sv = *reinterpret_cast<const float2*>(st + (size_t)c2 * (2 * 16 * 64 * 2));
                    const float nr = A.z * xr - A.w * xi + sv.x;
                    const float ni = A.z * xi + A.w * xr + sv.y;
                    xr = nr; xi = ni;
                }
            }
#pragma unroll 1
            for (int s = 0; s < 64; ++s) {
                const int i = d ? 63 - s : s;
                float ur = 0.f, ui = 0.f;
#pragma unroll
                for (int h4 = 0; h4 < 4; ++h4) {
                    const float4 uu = *reinterpret_cast<const float4*>(ust + i * 16 + h4 * 4);
                    ur += br[h4 * 4] * uu.x + br[h4 * 4 + 1] * uu.y + br[h4 * 4 + 2] * uu.z + br[h4 * 4 + 3] * uu.w;
                    ui += bi[h4 * 4] * uu.x + bi[h4 * 4 + 1] * uu.y + bi[h4 * 4 + 2] * uu.z + bi[h4 * 4 + 3] * uu.w;
                }
                const float nr = A.x * xr - A.y * xi + ur;
                const float ni = A.x * xi + A.y * xr + ui;
                xr = nr; xi = ni;
                float t[16];
#pragma unroll
                for (int h = 0; h < 16; ++h) t[h] = cr[h] * xr - ci[h] * xi;
                const float tot = reduce16(t, lane);
                if (lane < 16) { if (d == 0) yst[i * 16 + lane] = tot; else yst[i * 16 + lane] += tot; }
            }
        }
        {
            const float* dsk = p.in(I_S5_D) + l * 256 + g * 16;
            unsigned pk[8];
#pragma unroll
            for (int h = 0; h < 16; h += 2) {
                float y0 = yst[lane * 16 + h] + ust[lane * 16 + h] * dsk[h];
                float y1 = yst[lane * 16 + h + 1] + ust[lane * 16 + h + 1] * dsk[h + 1];
                y0 = 0.5f * y0 * (1.f + erff(y0 * 0.70710678118f));
                y1 = 0.5f * y1 * (1.f + erff(y1 * 0.70710678118f));
                pk[h >> 1] = pack2(y0, y1);
            }
            uint4* dst = reinterpret_cast<uint4*>(z + (size_t)myrow * ZS + COL_S5 + g * 16);
            dst[0] = make_uint4(pk[0], pk[1], pk[2], pk[3]);
            dst[1] = make_uint4(pk[4], pk[5], pk[6], pk[7]);
        }
    }
}

#define SB 16
__device__ __forceinline__ int scan_chain_row(int b, int d, int q) {
    if (q < 256) return b * 256 + (d ? 255 - q : q);
    const int t = q - 256;
    return NTC + b * 4096 + (d ? 4095 - t : t);
}
struct ScanRaw { uint2 r, k, v, e, a; float f0, f1; };

__device__ __forceinline__ void scan_load(const P& p, int m, int b, int h, int d, int q, int cg, ScanRaw& R) {
    const int row = scan_chain_row(b, d, q);
    const int c0 = h * 64 + cg * 4;
    if (m == 0) {
        const bf16_t* z = (const bf16_t*)(p.ws + WS_Z) + (size_t)row * ZS + c0;
        R.r = *reinterpret_cast<const uint2*>(z);
        R.k = *reinterpret_cast<const uint2*>(z + 256);
        R.v = *reinterpret_cast<const uint2*>(z + 512);
        const bf16_t* rw = (const bf16_t*)(p.ws + WS_R1 + R1_RWP) + (size_t)row * 1024 + c0;
        R.e = *reinterpret_cast<const uint2*>(rw + d * 256);
        R.a = *reinterpret_cast<const uint2*>(rw + (2 + d) * 256);
        R.f0 = ((const float*)(p.ws + WS_KNORM))[(size_t)row * 4 + h];
        R.f1 = 0.f;
    } else {
        const bf16_t* gq = (const bf16_t*)(p.ws + WS_R1 + R1_GQ) + (size_t)row * 768 + c0;
        R.r = *reinterpret_cast<const uint2*>(gq);
        R.k = *reinterpret_cast<const uint2*>(gq + 256);
        R.v = *reinterpret_cast<const uint2*>(gq + 512);
        R.e = make_uint2(0u, 0u); R.a = make_uint2(0u, 0u);
        const float* gab = (const float*)(p.ws + WS_GAB) + (size_t)row * 16;
        R.f0 = gab[d * 4 + h];
        R.f1 = gab[8 + d * 4 + h];
    }
}
__device__ __forceinline__ void scan_store(int m, const ScanRaw& R, float* dst  , const float (&kkp)[4], const float (&kap)[4]) {
    float r[4] = {bflo(R.r.x), bfhi(R.r.x), bflo(R.r.y), bfhi(R.r.y)};
    float k[4] = {bflo(R.k.x), bfhi(R.k.x), bflo(R.k.y), bfhi(R.k.y)};
    float v[4] = {bflo(R.v.x), bfhi(R.v.x), bflo(R.v.y), bfhi(R.v.y)};
    float ww[4], aa[4], bb[4], kk[4];
    if (m == 0) {
        float e[4] = {bflo(R.e.x), bfhi(R.e.x), bflo(R.e.y), bfhi(R.e.y)};
        float a[4] = {bflo(R.a.x), bfhi(R.a.x), bflo(R.a.y), bfhi(R.a.y)};
#pragma unroll
        for (int i = 0; i < 4; ++i) {
            ww[i] = __expf(-e[i]);
            kk[i] = k[i] * (1.f + (a[i] - 1.f) * kap[i]);
            const float kn = k[i] * kkp[i] * R.f0;
            aa[i] = -kn;
            bb[i] = kn * a[i];
        }
    } else {
        const float al = R.f0, be = R.f1;
#pragma unroll
        for (int i = 0; i < 4; ++i) { ww[i] = al; aa[i] = k[i]; bb[i] = -al * be * k[i]; kk[i] = be * k[i]; }
    }
    *reinterpret_cast<float4*>(dst + 0 * 64) = make_float4(ww[0], ww[1], ww[2], ww[3]);
    *reinterpret_cast<float4*>(dst + 1 * 64) = make_float4(aa[0], aa[1], aa[2], aa[3]);
    *reinterpret_cast<float4*>(dst + 2 * 64) = make_float4(bb[0], bb[1], bb[2], bb[3]);
    *reinterpret_cast<float4*>(dst + 3 * 64) = make_float4(kk[0], kk[1], kk[2], kk[3]);
    *reinterpret_cast<float4*>(dst + 4 * 64) = make_float4(r[0], r[1], r[2], r[3]);
    *reinterpret_cast<float4*>(dst + 5 * 64) = make_float4(v[0], v[1], v[2], v[3]);
}

__device__ void scan_unit(const P& p, int l, int u, char* lds) {
    const int tid = otid();
    const int chain = u >> 1, half = u & 1;
    const int m = chain >> 6, rem = chain & 63, b = rem >> 3, h = (rem >> 1) & 3, d = rem & 1;
    float* buf = (float*)lds;
    float* ybuf = buf + 2 * SB * 384;
    const int rl = tid >> 3, sub = tid & 7;
    const int st = tid >> 4, cg = tid & 15;
    float kkp[4], kap[4];
#pragma unroll
    for (int i = 0; i < 4; ++i) { kkp[i] = p.in(I_RW_KK)[l * 256 + h * 64 + cg * 4 + i]; kap[i] = p.in(I_RW_KA)[l * 256 + h * 64 + cg * 4 + i]; }
    bf16_t* ys = (bf16_t*)(p.ws + WS_HBY) + (size_t)(m * 2 + d) * NT * 256;
    float S[8];
#pragma unroll
    for (int j = 0; j < 8; ++j) S[j] = 0.f;
    ScanRaw R;
    scan_load(p, m, b, h, d, st, cg, R);
    scan_store(m, R, buf + (st * 6) * 64 + cg * 4, kkp, kap);
    __syncthreads();
    const int NB = 4352 / SB;
    __builtin_amdgcn_s_setprio(2);
#pragma unroll 1
    for (int bt = 0; bt < NB; ++bt) {
        const int par = bt & 1;
        if (bt + 1 < NB) scan_load(p, m, b, h, d, (bt + 1) * SB + st, cg, R);
        const float* cb = buf + par * (SB * 384);
        float* yb = ybuf + par * (SB * 32);
#pragma unroll 4
        for (int s = 0; s < SB; ++s) {
            const float* sb = cb + s * 384 + sub * 8;
            const float4 w0 = *reinterpret_cast<const float4*>(sb), w1 = *reinterpret_cast<const float4*>(sb + 4);
            const float4 a0 = *reinterpret_cast<const float4*>(sb + 64), a1 = *reinterpret_cast<const float4*>(sb + 68);
            const float4 b0 = *reinterpret_cast<const float4*>(sb + 128), b1 = *reinterpret_cast<const float4*>(sb + 132);
            const float4 k0 = *reinterpret_cast<const float4*>(sb + 192), k1 = *reinterpret_cast<const float4*>(sb + 196);
            const float4 r0 = *reinterpret_cast<const float4*>(sb + 256), r1 = *reinterpret_cast<const float4*>(sb + 260);
            const float vv = cb[s * 384 + 320 + half * 32 + rl];
            float sa = (S[0] * a0.x + S[1] * a0.y) + (S[2] * a0.z + S[3] * a0.w) + (S[4] * a1.x + S[5] * a1.y) + (S[6] * a1.z + S[7] * a1.w);
            sa += dppf<0xB1>(sa); sa += dppf<0x4E>(sa); sa += dppf<0x141>(sa);
            S[0] = S[0] * w0.x + sa * b0.x + vv * k0.x;
            S[1] = S[1] * w0.y + sa * b0.y + vv * k0.y;
            S[2] = S[2] * w0.z + sa * b0.z + vv * k0.z;
            S[3] = S[3] * w0.w + sa * b0.w + vv * k0.w;
            S[4] = S[4] * w1.x + sa * b1.x + vv * k1.x;
            S[5] = S[5] * w1.y + sa * b1.y + vv * k1.y;
            S[6] = S[6] * w1.z + sa * b1.z + vv * k1.z;
            S[7] = S[7] * w1.w + sa * b1.w + vv * k1.w;
            float y = (S[0] * r0.x + S[1] * r0.y) + (S[2] * r0.z + S[3] * r0.w) + (S[4] * r1.x + S[5] * r1.y) + (S[6] * r1.z + S[7] * r1.w);
            y += dppf<0xB1>(y); y += dppf<0x4E>(y); y += dppf<0x141>(y);
            if (sub == 0) yb[s * 32 + rl] = y;
        }
        if (bt + 1 < NB) scan_store(m, R, buf + (1 - par) * (SB * 384) + (st * 6) * 64 + cg * 4, kkp, kap);
        __syncthreads();
        {
            const int r2 = cg * 2;
            const int row = scan_chain_row(b, d, bt * SB + st);
            const unsigned pk = pack2(yb[st * 32 + r2], yb[st * 32 + r2 + 1]);
            *reinterpret_cast<unsigned*>(ys + (size_t)row * 256 + h * 64 + half * 32 + r2) = pk;
        }
    }
    __builtin_amdgcn_s_setprio(0);
    __syncthreads();
}

template <int L>
__device__ void hyena_unit(const P& p, int l, int u, char* lds) {
    constexpr int TPT = L / 256;
    const int tid = otid();
    const int c = u >> 2, bp = u & 3;
    float2* u2 = (float2*)lds;
    float* taps = (float*)(lds + (size_t)L * 8);
    const bf16_t* z = (const bf16_t*)(p.ws + WS_Z);
    bf16_t* cat = (bf16_t*)(p.ws + WS_CAT);
    const float* F = (L == 4096) ? (const float*)(p.ws + WS_FILTL) : (const float*)(p.ws + WS_FILTC);
    int base[2];
#pragma unroll
    for (int bb = 0; bb < 2; ++bb) { const int b = bp * 2 + bb; base[bb] = (L == 4096) ? NTC + b * 4096 : b * 256; }
    const int t0 = tid * TPT;
    const float* cw = p.in(I_HY_CONV) + (size_t)l * 3 * 768; const float* cb = p.in(I_HY_CONVB) + (size_t)l * 768;
    auto sconv = [&](int part, int bb, float (&o)[TPT]) {
        const int ch = part * 256 + c;
        const float w0 = cw[ch], w1 = cw[768 + ch], w2 = cw[1536 + ch], bs = cb[ch];
        const bf16_t* zc = z + (size_t)base[bb] * ZS + COL_HY + ch;
        float xm = (t0 > 0) ? bf2f(zc[(size_t)(t0 - 1) * ZS]) : 0.f;
        float x0 = bf2f(zc[(size_t)t0 * ZS]);
#pragma unroll
        for (int i = 0; i < TPT; ++i) {
            const int t = t0 + i;
            const float xp = (t + 1 < L) ? bf2f(zc[(size_t)(t + 1) * ZS]) : 0.f;
            o[i] = w0 * xm + w1 * x0 + w2 * xp + bs;
            xm = x0; x0 = xp;
        }
    };
    {
        float v0[TPT], v1[TPT];
        sconv(2, 0, v0); sconv(2, 1, v1);
#pragma unroll
        for (int i = 0; i < TPT; ++i) u2[t0 + i] = make_float2(v0[i], v1[i]);
    }
#pragma unroll 1
    for (int o = 0; o < 2; ++o) {
        const float* hf = F + ((size_t)(o * 2 + 0) * 256 + c) * L;
        const float* hbk = F + ((size_t)(o * 2 + 1) * 256 + c) * L;
        for (int k = tid; k < 2 * L; k += NTHREADS) {
            const int dd = k - (L - 1);
            taps[k] = (dd >= L) ? 0.f : (dd >= 0 ? hf[dd] : hbk[-dd]);
        }
        __syncthreads();
        float acc[TPT][2];
#pragma unroll
        for (int i = 0; i < TPT; ++i) { acc[i][0] = 0.f; acc[i][1] = 0.f; }
        if (L == 4096) {
#pragma unroll 1
            for (int s0 = 0; s0 < L; s0 += 16) {
                const int k0 = t0 - s0 + (L - 16);
                float W[32];
#pragma unroll
                for (int q = 0; q < 8; ++q) {
                    const float4 t4 = *reinterpret_cast<const float4*>(taps + k0 + q * 4);
                    W[q * 4] = t4.x; W[q * 4 + 1] = t4.y; W[q * 4 + 2] = t4.z; W[q * 4 + 3] = t4.w;
                }
#pragma unroll
                for (int j = 0; j < 16; ++j) {
                    const float2 uj = u2[s0 + j];
#pragma unroll
                    for (int i = 0; i < TPT; ++i) {
                        const float wv = W[(i - j + 15) & 31];
                        acc[i][0] += wv * uj.x; acc[i][1] += wv * uj.y;
                    }
                }
            }
        } else {
            for (int s = 0; s < L; ++s) {
                const float2 uj = u2[s];
                const float wv = taps[t0 - s + (L - 1)];
                acc[0][0] += wv * uj.x; acc[0][1] += wv * uj.y;
            }
        }
        const float sk = p.in(I_HY_SKIP)[(size_t)(l * 2 + o) * 256 + c];
        float res[TPT][2];
        {
            float g0[TPT], g1[TPT];
            sconv(o, 0, g0); sconv(o, 1, g1);
#pragma unroll
            for (int i = 0; i < TPT; ++i) {
                const float2 ut = u2[t0 + i];
                res[i][0] = g0[i] * (acc[i][0] + sk * ut.x);
                res[i][1] = g1[i] * (acc[i][1] + sk * ut.y);
            }
        }
        __syncthreads();
        if (o == 0) {
#pragma unroll
            for (int i = 0; i < TPT; ++i) u2[t0 + i] = make_float2(res[i][0], res[i][1]);
        } else {
#pragma unroll
            for (int i = 0; i < TPT; ++i) {
                cat[(size_t)(base[0] + t0 + i) * DM + 512 + c] = f2bf(res[i][0]);
                cat[(size_t)(base[1] + t0 + i) * DM + 512 + c] = f2bf(res[i][1]);
            }
        }
        __syncthreads();
    }
}

__device__ void rwkv_post_unit(const P& p, int l, int u, char* lds) {
    const int tid = otid(), c = tid;
    float* sg = (float*)lds;
    const bf16_t* z = (const bf16_t*)(p.ws + WS_Z);
    const bf16_t* rwp = (const bf16_t*)(p.ws + WS_R1 + R1_RWP);
    const bf16_t* ys = (const bf16_t*)(p.ws + WS_HBY);
    bf16_t* cat = (bf16_t*)(p.ws + WS_CAT);
    const int row0 = u * 32;
#pragma unroll
    for (int i = 0; i < 8; ++i) {
        const int idx = tid + 256 * i, tok = idx >> 6, j = idx & 63;
        sg[idx] = sigm(bf2f(z[(size_t)(row0 + tok) * ZS + 896 + j]));
    }
    __syncthreads();
    float g2r[64];
#pragma unroll
    for (int r = 0; r < 64; ++r) g2r[r] = p.in(I_RW_G2)[(size_t)(l * 64 + r) * 256 + c];
    const float ka = p.in(I_RW_KA)[l * 256 + c], rk = p.in(I_RW_RK)[l * 256 + c];
    const float gng = p.in(I_RW_GNG)[l * 256 + c], gnb = p.in(I_RW_GNB)[l * 256 + c];
#pragma unroll 2
    for (int tok = 0; tok < 32; ++tok) {
        const int row = row0 + tok;
        float g = 0.f;
#pragma unroll
        for (int r = 0; r < 64; r += 4) {
            const float4 x = *reinterpret_cast<const float4*>(sg + tok * 64 + r);
            g += x.x * g2r[r] + x.y * g2r[r + 1] + x.z * g2r[r + 2] + x.w * g2r[r + 3];
        }
        const float y = bf2f(ys[(size_t)row * 256 + c]) + bf2f(ys[(size_t)NT * 256 + (size_t)row * 256 + c]);
        const float mu = wave_sum(y) * (1.f / 64.f);
        const float dv = y - mu;
        const float var = wave_sum(dv * dv) * (1.f / 64.f);
        const float yn = dv * rsqrtf(var + 64e-5f) * gng + gnb;
        const bf16_t* zr = z + (size_t)row * ZS;
        const float r = bf2f(zr[c]), k = bf2f(zr[256 + c]), v = bf2f(zr[512 + c]);
        const float a0 = bf2f(rwp[((size_t)row * 4 + 2) * 256 + c]), a1 = bf2f(rwp[((size_t)row * 4 + 3) * 256 + c]);
        const float kd = k * (1.f + (a0 - 1.f) * ka) + k * (1.f + (a1 - 1.f) * ka);
        const float dot = wave_sum(r * kd * rk);
        cat[(size_t)row * DM + c] = f2bf((yn + dot * v) * g);
    }
    __syncthreads();
}

__device__ void gdn_post_unit(const P& p, int l, int u) {
    const int tid = otid(), c = tid;
    const bf16_t* z = (const bf16_t*)(p.ws + WS_Z);
    const bf16_t* ys = (const bf16_t*)(p.ws + WS_HBY) + (size_t)2 * NT * 256;
    bf16_t* cat = (bf16_t*)(p.ws + WS_CAT);
    const float ng = p.in(I_GD_NORM)[l * 64 + (c & 63)];
    const int row0 = u * 32;
#pragma unroll 4
    for (int tok = 0; tok < 32; ++tok) {
        const int row = row0 + tok;
        const float o = bf2f(ys[(size_t)row * 256 + c]) + bf2f(ys[(size_t)NT * 256 + (size_t)row * 256 + c]);
        const float ms = wave_sum(o * o) * (1.f / 64.f);
        const float zg = bf2f(z[(size_t)row * ZS + COL_GD + 768 + c]);
        cat[(size_t)row * DM + 256 + c] = f2bf(o * rsqrtf(ms + 1e-6f) * ng * siluf(zg));
    }
}

#define NPHASE 22
template <typename F>
__device__ __forceinline__ void strided(int n, F f) { for (int u = blockIdx.x; u < n; u += gridDim.x) f(u); }

__global__ void __launch_bounds__(NTHREADS, 2) fwd_kernel(KP kp) {
    extern __shared__ __attribute__((aligned(16))) char smem[];
    char* lds = smem + LDS_USER;
    const int tid = otid();
    if (tid == 0) *reinterpret_cast<uint4*>(smem) = make_uint4(0u, 0u, 0u, 0u);
    if (tid < 52) { const unsigned long long v = (unsigned long long)kp.in[tid]; ((unsigned*)(smem + 512))[2 * tid] = (unsigned)v; ((unsigned*)(smem + 512))[2 * tid + 1] = (unsigned)(v >> 32); }
    __syncthreads();
    P p; p.tab = (const __attribute__((address_space(3))) unsigned*)(smem + 512); p.out = kp.out; p.ws = kp.ws;
    unsigned* ctl = (unsigned*)(p.ws + WS_CTL);
    XcdBarrier bar = xcd_barrier_post(ctl, (volatile LAS unsigned*)smem);
    const int lo = kp.ph_lo, hi = kp.ph_hi;
#define PHASE_BEGIN(ph) if ((ph) >= lo && (ph) < hi) { if ((ph) > lo) { xcd_barrier(bar); }
#define PHASE_END }
#define LANE_IDS const int tid = otid(); const int wid = tid >> 6, lane = tid & 63, wr = wid >> 1, wc = wid & 1, fr = lane & 15, fq = lane >> 4; (void)wid; (void)lane; (void)wr; (void)wc; (void)fr; (void)fq;

    PHASE_BEGIN(0)
        strided(192 + 64 + 32, [&](int u) {
            if (u < 192) ph0_mod_unit(p, u, lds);
            else if (u < 256) ph0_s5tab_unit(p, u - 192);
            else { const int v = u - 256, ll = v >> 4, t = v & 15;
                   xpose_tile(p.in(I_S5_GLUW) + (size_t)ll * 65536, 256, (bf16_t*)(p.ws + WS_GLUT) + (size_t)ll * 65536, 256, 0, t >> 2, t & 3, lds); }
        });
    PHASE_END

#pragma unroll 1
    for (int l = 0; l < 2; ++l) {
        const int pb = 1 + 10 * l;
        PHASE_BEGIN(pb + 0)
            strided(4352 + 1088 + 768 + 256, [&](int u) {
                if (u < 4352) { if (l == 0) rows_unit<M_INIT>(p, l, u, lds); else rows_unit<M_LN2NEXT>(p, l, u, lds); }
                else if (u < 5440) filt_unit(p, l, u - 4352, lds);
                else if (u < 6208) { const int v = u - 5440; xpose_tile(p.in(I_WIN) + (size_t)l * 1024 * 3024, 3024, (bf16_t*)(p.ws + WS_WINT), 1024, 0, v / 48, v % 48, lds); }
                else { const int v = u - 6208; xpose_tile(p.in(I_WOUT) + (size_t)l * 1024 * 1024, 1024, (bf16_t*)(p.ws + WS_WOUTT), 1024, 0, v >> 4, v & 15, lds); }
            });
        PHASE_END
        PHASE_BEGIN(pb + 1)
            strided(272 * 24, [&](int u) {
                LANE_IDS
                const int mt = u / 24, nt = u % 24;
                f32x4 acc[4][4];
                gemm_tile((const bf16_t*)(p.ws + WS_HBY), DM, mt * 128 + (tid >> 2), mt * 128 + (tid >> 2) + 64,
                          (const bf16_t*)(p.ws + WS_WINT), DM, nt * 128, DM, lds, acc);
                bf16_t* z = (bf16_t*)(p.ws + WS_Z);
#pragma unroll
                for (int m = 0; m < 4; ++m)
#pragma unroll
                    for (int n = 0; n < 4; ++n) {
                        const int col = nt * 128 + wc * 64 + n * 16 + fr;
                        if (col < ZS) {
#pragma unroll
                            for (int j = 0; j < 4; ++j) z[(size_t)(mt * 128 + wr * 64 + m * 16 + fq * 4 + j) * ZS + col] = f2bf(acc[m][n][j]);
                        }
                    }
            });
        PHASE_END
        PHASE_BEGIN(pb + 2)
            strided(1088 + 1088 + 4352, [&](int u) {
                if (u < 1088) rwkv_prep_unit(p, l, u, lds);
                else if (u < 2176) gdn_prep_unit(p, l, u - 1088);
                else s5_pre_unit(p, l, u - 2176, lds);
            });
        PHASE_END
        PHASE_BEGIN(pb + 3)
            {
                int* qslot = (int*)(smem + 64);
                const int NU = 256 + 1024 + 544 + 1024;
                for (;;) {
                    if (tid == 0) *qslot = (int)atomicAdd(&ctl[CW_QUEUE(l)], 1u);
                    __syncthreads();
                    const int u = *qslot;
                    __syncthreads();
                    if (u >= NU) break;
                    if (u < 256) scan_unit(p, l, u, lds);
                    else if (u < 1280) hyena_unit<4096>(p, l, u - 256, lds);
                    else if (u < 1824) s5_main_unit(p, l, u - 1280, lds);
                    else hyena_unit<256>(p, l, u - 1824, lds);
                    __syncthreads();
                }
            }
        PHASE_END
        PHASE_BEGIN(pb + 4)
            strided(1088 + 1088 + 544, [&](int u) {
                if (u < 1088) rwkv_post_unit(p, l, u, lds);
                else if (u < 2176) gdn_post_unit(p, l, u - 1088);
                else {
                    LANE_IDS
                    const int v = u - 2176, mt = v >> 1, nt = v & 1;
                    f32x4 acc[4][4];
                    const bf16_t* A = (const bf16_t*)(p.ws + WS_Z) + COL_S5;
                    gemm_tile(A, ZS, mt * 128 + (tid >> 2), mt * 128 + (tid >> 2) + 64,
                              (const bf16_t*)(p.ws + WS_GLUT) + (size_t)l * 65536, 256, nt * 128, 256, lds, acc);
                    bf16_t* cat = (bf16_t*)(p.ws + WS_CAT);
#pragma unroll
                    for (int m = 0; m < 4; ++m)
#pragma unroll
                        for (int n = 0; n < 4; ++n) {
                            const int col = nt * 128 + wc * 64 + n * 16 + fr;
                            const float gb = p.in(I_S5_GLUB)[l * 256 + col];
#pragma unroll
                            for (int j = 0; j < 4; ++j) {
                                const int row = mt * 128 + wr * 64 + m * 16 + fq * 4 + j;
                                const float yg = bf2f(A[(size_t)row * ZS + col]);
                                cat[(size_t)row * DM + 768 + col] = f2bf(yg * sigm(acc[m][n][j] + gb));
                            }
                        }
                }
            });
        PHASE_END
        PHASE_BEGIN(pb + 5)
            strided(272 * 8 + 65 * 192, [&](int u) {
                if (u < 2176) {
                    LANE_IDS
                    const int mt = u >> 3, nt = u & 7;
                    f32x4 acc[4][4];
                    gemm_tile((const bf16_t*)(p.ws + WS_CAT), DM, mt * 128 + (tid >> 2), mt * 128 + (tid >> 2) + 64,
                              (const bf16_t*)(p.ws + WS_WOUTT), DM, nt * 128, DM, lds, acc);
#pragma unroll
                    for (int m = 0; m < 4; ++m)
#pragma unroll
                        for (int j = 0; j < 4; ++j) {
                            const int row = mt * 128 + wr * 64 + m * 16 + fq * 4 + j;
                            float* xr = xrow(p, row);
                            const float* ga = modp(p, l, row_mod(row), 2);
#pragma unroll
                            for (int n = 0; n < 4; ++n) {
                                const int col = nt * 128 + wc * 64 + n * 16 + fr;
                                xr[col] = ALPHA * xr[col] + ga[col] * acc[m][n][j];
                            }
                        }
                } else {
                    const int v = u - 2176, e = v / 192, t = v % 192, which = t >> 6, tt = t & 63;
                    bf16_t* W13 = (bf16_t*)(p.ws + WS_R1 + R1_W13T) + (size_t)e * 512 * 1024;
                    bf16_t* W2 = (bf16_t*)(p.ws + WS_R1 + R1_W2T) + (size_t)e * 1024 * 256;
                    if (which == 0) {
                        const float* src = (e < 64) ? p.in(I_EX_W1) + ((size_t)l * 64 + e) * 262144 : p.in(I_SH_W1) + (size_t)l * 262144;
                        xpose_tile(src, 256, W13, 1024, 1, tt >> 2, tt & 3, lds);
                    } else if (which == 1) {
                        const float* src = (e < 64) ? p.in(I_EX_W3) + ((size_t)l * 64 + e) * 262144 : p.in(I_SH_W3) + (size_t)l * 262144;
                        xpose_tile(src, 256, W13, 1024, 2, tt >> 2, tt & 3, lds);
                    } else {
                        const float* src = (e < 64) ? p.in(I_EX_W2) + ((size_t)l * 64 + e) * 262144 : p.in(I_SH_W2) + (size_t)l * 262144;
                        xpose_tile(src, 1024, W2, 256, 0, tt >> 4, tt & 15, lds);
                    }
                }
            });
        PHASE_END
        PHASE_BEGIN(pb + 6)
            strided(4352, [&](int u) { rows_unit<M_LN1>(p, l, u, lds); __syncthreads(); });
        PHASE_END
        PHASE_BEGIN(pb + 7)
            {
                int* tb = (int*)lds;
                const unsigned* cnt = ctl + CW_CNT(l);
                if (tid == 0) { int a = 0; for (int e = 0; e < 64; ++e) { tb[e] = a; a += ((int)xb_ld((unsigned*)&cnt[e]) + 127) >> 7; } tb[64] = a; }
                __syncthreads();
                const int* aep = (const int*)(p.ws + WS_AEP); const float* aw = (const float*)(p.ws + WS_AW);
                int* rtok = (int*)(p.ws + WS_RTOK); float* rwt = (float*)(p.ws + WS_RW); int* tile_e = (int*)(p.ws + WS_TILEE);
                for (int a = blockIdx.x * NTHREADS + tid; a < NT * 8; a += gridDim.x * NTHREADS) {
                    const unsigned v = (unsigned)aep[a];
                    const int e = v >> 24, pos = v & 0xFFFFFF;
                    const int dest = tb[e] * 128 + pos;
                    rtok[dest] = a >> 3; rwt[dest] = aw[a];
                }
                for (int e = blockIdx.x; e < 64; e += gridDim.x) {
                    const int c0 = (int)xb_ld((unsigned*)&cnt[e]), nt_e = (c0 + 127) >> 7;
                    for (int q = c0 + tid; q < nt_e * 128; q += NTHREADS) { rtok[tb[e] * 128 + q] = -1; rwt[tb[e] * 128 + q] = 0.f; }
                    for (int q = tid; q < nt_e; q += NTHREADS) tile_e[tb[e] + q] = e;
                }
                __syncthreads();
            }
        PHASE_END
        PHASE_BEGIN(pb + 8)
            {
                int* sh = (int*)(smem + 128);
                if (tid == 0) { const unsigned* cnt = ctl + CW_CNT(l); int a = 0; for (int e = 0; e < 64; ++e) a += ((int)xb_ld((unsigned*)&cnt[e]) + 127) >> 7; *sh = a; }
                __syncthreads();
                const int ntr = *sh;
                const int* rtok = (const int*)(p.ws + WS_RTOK); const int* tile_e = (const int*)(p.ws + WS_TILEE);
                strided((ntr + 272) * 4, [&](int u) {
                    LANE_IDS
                    const int tile = u >> 2, jn = u & 3;
                    int e, ra, rb, obase;
                    if (tile < ntr) {
                        e = tile_e[tile]; obase = tile * 128;
                        ra = rtok[obase + (tid >> 2)]; rb = rtok[obase + (tid >> 2) + 64];
                        ra = ra < 0 ? 0 : ra; rb = rb < 0 ? 0 : rb;
                    } else {
                        const int stt = tile - ntr; e = 64; obase = (SH_TILE_BASE + stt) * 128;
                        ra = stt * 128 + (tid >> 2); rb = ra + 64;
                    }
                    f32x4 acc[4][4];
                    gemm_tile((const bf16_t*)(p.ws + WS_HBY), DM, ra, rb,
                              (const bf16_t*)(p.ws + WS_R1 + R1_W13T) + (size_t)e * 512 * 1024, DM, jn * 128, DM, lds, acc);
                    bf16_t* act = (bf16_t*)(p.ws + WS_Z);
#pragma unroll
                    for (int m = 0; m < 4; ++m)
#pragma unroll
                        for (int pp = 0; pp < 2; ++pp)
#pragma unroll
                            for (int j = 0; j < 4; ++j) {
                                const float g = acc[m][2 * pp][j], uu = acc[m][2 * pp + 1][j];
                                const int orow = obase + wr * 64 + m * 16 + fq * 4 + j;
                                const int col = jn * 64 + wc * 32 + pp * 16 + fr;
                                act[(size_t)orow * 256 + col] = f2bf(siluf(g) * uu);
                            }
                });
            }
        PHASE_END
        PHASE_BEGIN(pb + 9)
            {
                int* sh = (int*)(smem + 128);
                if (tid == 0) { const unsigned* cnt = ctl + CW_CNT(l); int a = 0; for (int e = 0; e < 64; ++e) a += ((int)xb_ld((unsigned*)&cnt[e]) + 127) >> 7; *sh = a; }
                __syncthreads();
                const int ntr = *sh;
                const int* rtok = (const int*)(p.ws + WS_RTOK); const float* rwt = (const float*)(p.ws + WS_RW); const int* tile_e = (const int*)(p.ws + WS_TILEE);
                strided((ntr + 272) * 8, [&](int u) {
                    LANE_IDS
                    const int tile = u >> 3, nt = u & 7;
                    int e, obase;
                    if (tile < ntr) { e = tile_e[tile]; obase = tile * 128; }
                    else { e = 64; obase = (SH_TILE_BASE + tile - ntr) * 128; }
                    f32x4 acc[4][4];
                    gemm_tile((const bf16_t*)(p.ws + WS_Z), 256, obase + (tid >> 2), obase + (tid >> 2) + 64,
                              (const bf16_t*)(p.ws + WS_R1 + R1_W2T) + (size_t)e * 1024 * 256, 256, nt * 128, 256, lds, acc);
#pragma unroll
                    for (int m = 0; m < 4; ++m)
#pragma unroll
                        for (int j = 0; j < 4; ++j) {
                            const int orl = wr * 64 + m * 16 + fq * 4 + j;
                            int tok; float wgt;
                            if (tile < ntr) { tok = rtok[obase + orl]; wgt = rwt[obase + orl]; }
                            else { tok = (tile - ntr) * 128 + orl; wgt = 1.f; }
                            if (tok >= 0) {
                                float* xr = xrow(p, tok);
                                const float* ga = modp(p, l, row_mod(tok), 5);
#pragma unroll
                                for (int n = 0; n < 4; ++n) {
                                    const int col = nt * 128 + wc * 64 + n * 16 + fr;
                                    unsafeAtomicAdd(xr + col, ga[col] * wgt * acc[m][n][j]);
                                }
                            }
                        }
                });
            }
        PHASE_END
    }
    PHASE_BEGIN(21)
        strided(4352, [&](int u) { rows_unit<M_FINAL>(p, 1, u, lds); });
    PHASE_END
}

#ifndef N_LAUNCH_MODE
#define N_LAUNCH_MODE 1
#endif
extern "C" void kernel_launch(void* const* d_in, const int* in_sizes, int n_in, void* d_out, int out_size, void* d_ws, size_t ws_size, hipStream_t stream) {
    static int grid = 0;
    if (grid == 0) {
        if (n_in != 52 || out_size != NTL * DM || ws_size < WS_END) { fprintf(stderr, "kernel_launch: unexpected shapes (n_in %d out %d ws %zu need %zu)\n", n_in, out_size, ws_size, (size_t)WS_END); grid = -1; return; }
        int dev = 0, cus = 0, per_cu = 0;
        hipGetDevice(&dev);
        hipDeviceGetAttribute(&cus, hipDeviceAttributeMultiprocessorCount, dev);
        hipFuncSetAttribute((const void*)fwd_kernel, hipFuncAttributeMaxDynamicSharedMemorySize, LDS_BYTES);
        hipOccupancyMaxActiveBlocksPerMultiprocessor(&per_cu, (const void*)fwd_kernel, NTHREADS, LDS_BYTES);
        (void)hipGetLastError();
        if (per_cu < 1) per_cu = 1;
        if (per_cu > 2) per_cu = 2;
        grid = cus * per_cu;
    }
    if (grid < 0) return;
    hipMemsetAsync((char*)d_ws + WS_CTL, 0, CTL_BYTES, stream);
    KP p{};
    for (int i = 0; i < 52; ++i) p.in[i] = (const float*)d_in[i];
    p.out = (float*)d_out; p.ws = (char*)d_ws;
#if N_LAUNCH_MODE == 1
    p.ph_lo = 0; p.ph_hi = NPHASE;
    hipLaunchKernelGGL(fwd_kernel, dim3(grid), dim3(NTHREADS), LDS_BYTES, stream, p);
#else
    for (int ph = 0; ph < NPHASE; ++ph) {
        p.ph_lo = ph; p.ph_hi = ph + 1;
        hipLaunchKernelGGL(fwd_kernel, dim3(grid), dim3(NTHREADS), LDS_BYTES, stream, p);
    }
#endif
}
```

```cpp
#include <hip/hip_runtime.h>
#include <hip/hip_bf16.h>
#include <hip/hip_fp16.h>
#include <stdint.h>
#include <stdio.h>

typedef unsigned short bf16_t;
using bf16x8 = __attribute__((ext_vector_type(8))) short;
using f32x4 = __attribute__((ext_vector_type(4))) float;

#define NTC 2048
#define NTL 32768
#define NT 34816
#define DM 1024
#define ZS 3024
#define COL_GD 960
#define COL_HY 2000
#define COL_S5 2768
#define NCHUNK 68
#define ALPHA 1.41421356237f
#define NTHREADS 256
#define LDS_BYTES 73728
#define LDS_USER 1024
#define SH_TILE_BASE 2240
#define ACT_ROWS ((SH_TILE_BASE + 272) * 128)

constexpr size_t al256(size_t x) { return (x + 255) & ~(size_t)255; }
constexpr size_t WS_CTL = 0;
constexpr size_t CTL_BYTES = 65536;
constexpr size_t WS_MOD = WS_CTL + CTL_BYTES;
constexpr size_t WS_S5A = al256(WS_MOD + 2 * 9 * 6144 * 4);
constexpr size_t WS_S5B = al256(WS_S5A + 2 * 2 * 16 * 64 * 4 * 4);
constexpr size_t WS_GLUT = al256(WS_S5B + 2 * 2 * 16 * 64 * 32 * 4);
constexpr size_t WS_WINT = al256(WS_GLUT + 2 * 256 * 256 * 2);
constexpr size_t WS_WOUTT = al256(WS_WINT + (size_t)3072 * 1024 * 2);
constexpr size_t WS_FILTL = al256(WS_WOUTT + (size_t)1024 * 1024 * 2);
constexpr size_t WS_FILTC = al256(WS_FILTL + (size_t)4 * 256 * 4096 * 4);
constexpr size_t WS_XC = al256(WS_FILTC + (size_t)4 * 256 * 256 * 4);
constexpr size_t WS_HBY = al256(WS_XC + (size_t)NTC * DM * 4);
constexpr size_t WS_CAT = al256(WS_HBY + (size_t)NT * DM * 2);
constexpr size_t WS_Z = al256(WS_CAT + (size_t)NT * DM * 2);
constexpr size_t WS_R1 = al256(WS_Z + (size_t)NT * ZS * 2);
constexpr size_t R1_RWP = 0;
constexpr size_t R1_GQ = (size_t)NT * 1024 * 2;
constexpr size_t R1_W13T = 0;
constexpr size_t R1_W2T = (size_t)65 * 512 * 1024 * 2;
constexpr size_t R1_BYTES = (size_t)NT * 1024 * 2 + (size_t)NT * 768 * 2;
constexpr size_t WS_KNORM = al256(WS_R1 + R1_BYTES);
constexpr size_t WS_GAB = al256(WS_KNORM + (size_t)NT * 4 * 4);
constexpr size_t WS_S5ST = al256(WS_GAB + (size_t)NT * 16 * 4);
constexpr size_t WS_AEP = al256(WS_S5ST + (size_t)8 * 68 * 2 * 16 * 64 * 2 * 4);
constexpr size_t WS_AW = al256(WS_AEP + (size_t)NT * 8 * 4);
constexpr size_t WS_RTOK = al256(WS_AW + (size_t)NT * 8 * 4);
constexpr size_t WS_RW = al256(WS_RTOK + (size_t)SH_TILE_BASE * 128 * 4);
constexpr size_t WS_TILEE = al256(WS_RW + (size_t)SH_TILE_BASE * 128 * 4);
constexpr size_t WS_HYT = al256(WS_TILEE + SH_TILE_BASE * 4);
constexpr size_t WS_END = al256(WS_HYT + (size_t)8 * 768 * 4096 * 2);
static_assert(R1_W2T + (size_t)65 * 1024 * 256 * 2 <= R1_BYTES, "expert weights must fit R1");
static_assert((size_t)ACT_ROWS * 256 * 2 <= (size_t)NT * ZS * 2, "act must fit z");

#define CW_QUEUE(l) (4096 + 64 * (l))
#define CW_CNT(l) (4352 + 64 * (l))

#define XB_TMO      128
#define XB_XCNT(j)  (256  + 64 * (j))
#define XB_XSUB(j)  (1280 + 64 * (j))
#define XB_XGEN(j)  (2304 + 64 * (j))
#define XB_TOP      3328
#define XB_TOPGEN   3392
#define XCD_BAR_WORDS 3456
#define XB_SPIN_CAP (1u << 18)
#define LAS __attribute__((address_space(3)))

__device__ __forceinline__ unsigned xb_ld(unsigned* p)              { return __hip_atomic_load(p, __ATOMIC_RELAXED, __HIP_MEMORY_SCOPE_AGENT); }
__device__ __forceinline__ unsigned xb_add(unsigned* p, unsigned v) { return __hip_atomic_fetch_add(p, v, __ATOMIC_RELAXED, __HIP_MEMORY_SCOPE_AGENT); }
__device__ __forceinline__ unsigned xb_xcc_id() { return (unsigned)__builtin_amdgcn_s_getreg((3 << 11) | 20) & 0xFu; }
#define XB_SPIN(cond, bar) do { unsigned _sp = 0; while (cond) { __builtin_amdgcn_s_sleep(1); \
    if ((++_sp & 255u) == 0u) { if (xb_ld(&(bar)[XB_TMO])) break; if (_sp > XB_SPIN_CAP) { atomicAdd(&(bar)[XB_TMO], 1u); break; } } } } while (0)

struct XcdBarrier {
    unsigned* bar; unsigned x;
    volatile LAS unsigned* st;
};
__device__ __forceinline__ XcdBarrier xcd_barrier_post(unsigned* bar, volatile LAS unsigned* st) {
    XcdBarrier b; b.bar = bar; b.x = xb_xcc_id(); b.st = st;
    if (threadIdx.x == 0) (void)xb_add(&bar[XB_XCNT(b.x)], 1u);
    return b;
}
__device__ __forceinline__ void xcd_barrier_complete(unsigned* bar, unsigned x, unsigned& nloc, unsigned& nx) {
    const unsigned G = gridDim.x * gridDim.y * gridDim.z;
    unsigned sum, cnt, mine, sp = 0u;
    for (;;) {
        sum = 0u; cnt = 0u; mine = 0u;
#pragma unroll
        for (unsigned j = 0; j < 16; ++j) { const unsigned c = xb_ld(&bar[XB_XCNT(j)]); sum += c; cnt += (c > 0u) ? 1u : 0u; mine = (j == x) ? c : mine; }
        if (sum == G) break;
        __builtin_amdgcn_s_sleep(1);
        if ((++sp & 255u) == 0u) { if (xb_ld(&bar[XB_TMO])) break; if (sp > XB_SPIN_CAP) { atomicAdd(&bar[XB_TMO], 1u); break; } }
    }
    nloc = mine > 0u ? mine : 1u; nx = cnt > 0u ? cnt : 1u;
}
__device__ __forceinline__ void xcd_barrier(const XcdBarrier& b) {
    asm volatile("s_waitcnt vmcnt(0)" ::: "memory");
    __syncthreads();
    if (threadIdx.x == 0) {
        unsigned* bar = b.bar;
        __builtin_amdgcn_s_waitcnt(0);
        unsigned nloc = b.st[0], nx = b.st[1];
        if (nloc == 0u) { xcd_barrier_complete(bar, b.x, nloc, nx); b.st[0] = nloc; b.st[1] = nx; }
        const unsigned old = xb_add(&bar[XB_XSUB(b.x)], 1u);
        const unsigned gen = old / nloc;
        if (old + 1u == (gen + 1u) * nloc) {
            __builtin_amdgcn_fence(__ATOMIC_RELEASE, "agent");
            asm volatile("s_waitcnt vmcnt(0)" ::: "memory");
            const unsigned og = xb_add(&bar[XB_TOP], 1u);
            const unsigned tg = og / nx;
            if (og + 1u == (tg + 1u) * nx) xb_add(&bar[XB_TOPGEN], 1u);
            else XB_SPIN(xb_ld(&bar[XB_TOPGEN]) == tg, bar);
            __builtin_amdgcn_fence(__ATOMIC_ACQUIRE, "agent");
            xb_add(&bar[XB_XGEN(b.x)], 1u);
            asm volatile("s_waitcnt vmcnt(0)" ::: "memory");
        } else {
            XB_SPIN(xb_ld(&bar[XB_XGEN(b.x)]) == gen, bar);
            __builtin_amdgcn_fence(__ATOMIC_ACQUIRE, "agent");
            asm volatile("s_waitcnt vmcnt(0)" ::: "memory");
        }
    }
    __syncthreads();
}

struct KP {
    const float* in[52];
    float* out;
    char* ws;
    int ph_lo, ph_hi, rep, pad_;
};
struct P {
    const __attribute__((address_space(3))) unsigned* tab;
    float* out;
    char* ws;
    __device__ __forceinline__ const float* in(int i) const {
        const unsigned lo = __builtin_amdgcn_readfirstlane(tab[2 * i]);
        const unsigned hi = __builtin_amdgcn_readfirstlane(tab[2 * i + 1]);
        return (const float*)(((unsigned long long)hi << 32) | (unsigned long long)lo);
    }
};
enum { I_X = 0, I_C, I_CTX, I_CCTX, I_ADAW, I_ADAB, I_WIN, I_WOUT, I_LNG, I_LNB,
       I_RW_W0, I_RW_W2, I_RW_A0, I_RW_A2, I_RW_G2, I_RW_KK, I_RW_KA, I_RW_RK, I_RW_GNG, I_RW_GNB,
       I_GD_CONV, I_GD_ALOG, I_GD_DTB, I_GD_NORM,
       I_HY_CONV, I_HY_CONVB, I_HY_W1, I_HY_B1, I_HY_F1, I_HY_W2, I_HY_B2, I_HY_F2, I_HY_W3, I_HY_SKIP,
       I_S5_LRE, I_S5_LIM, I_S5_LOGSTEP, I_S5_BRE, I_S5_BIM, I_S5_CRE, I_S5_CIM, I_S5_D, I_S5_GLUW, I_S5_GLUB,
       I_ROUTER_W, I_ROUTER_B, I_EX_W1, I_EX_W3, I_EX_W2, I_SH_W1, I_SH_W3, I_SH_W2 };

__device__ __forceinline__ bf16_t f2bf(float f) { unsigned u = __float_as_uint(f); u += 0x7fffu + ((u >> 16) & 1u); return (bf16_t)(u >> 16); }
__device__ __forceinline__ float bf2f(bf16_t h) { return __uint_as_float(((unsigned)h) << 16); }
__device__ __forceinline__ float bflo(unsigned u) { return __uint_as_float(u << 16); }
__device__ __forceinline__ float bfhi(unsigned u) { return __uint_as_float(u & 0xffff0000u); }
__device__ __forceinline__ unsigned pack2(float a, float b) { return (unsigned)f2bf(a) | ((unsigned)f2bf(b) << 16); }
__device__ __forceinline__ float sigm(float x) { return 1.f / (1.f + __expf(-x)); }
__device__ __forceinline__ float siluf(float x) { return x / (1.f + __expf(-x)); }
__device__ __forceinline__ float softplusf(float x) { return fmaxf(x, 0.f) + log1pf(__expf(-fabsf(x))); }
__device__ __forceinline__ float wave_sum(float v) {
#pragma unroll
    for (int o = 32; o >= 1; o >>= 1) v += __shfl_xor(v, o);
    return v;
}
template <int CTRL> __device__ __forceinline__ float dppf(float v) {
    return __int_as_float(__builtin_amdgcn_update_dpp(0, __float_as_int(v), CTRL, 0xF, 0xF, true));
}
__device__ __forceinline__ int otid() { int t = threadIdx.x; asm volatile("" : "+v"(t)); return t; }
__device__ __forceinline__ float* xrow(const P& p, int row) {
    return row < NTC ? (float*)(p.ws + WS_XC) + (size_t)row * DM : p.out + (size_t)(row - NTC) * DM;
}
__device__ __forceinline__ int row_mod(int row) { return row < NTC ? 8 : ((row - NTC) >> 12); }
__device__ __forceinline__ const float* modp(const P& p, int l, int r, int chunk) {
    return (const float*)(p.ws + WS_MOD) + ((size_t)(l * 9 + r) * 6144 + chunk * 1024);
}

__device__ __forceinline__ void gemm_tile(const bf16_t* __restrict__ A, int lda, int arow_a, int arow_b,
                                          const bf16_t* __restrict__ Bt, int ldb, int brow0, int K,
                                          char* lds, f32x4 (&acc)[4][4]) {
    const int tid = otid();
    const int wid = tid >> 6, lane = tid & 63, wr = wid >> 1, wc = wid & 1, fr = lane & 15, fq = lane >> 4;
    char* SA = lds; char* SB = lds + 8192;
    const int c8 = (tid & 3) * 8;
    const bf16_t* a0 = A + (size_t)arow_a * lda + c8;
    const bf16_t* a1 = A + (size_t)arow_b * lda + c8;
    const bf16_t* b0 = Bt + (size_t)(brow0 + (tid >> 2)) * ldb + c8;
    const bf16_t* b1 = Bt + (size_t)(brow0 + (tid >> 2) + 64) * ldb + c8;
#pragma unroll
    for (int m = 0; m < 4; ++m)
#pragma unroll
        for (int n = 0; n < 4; ++n) acc[m][n] = f32x4{0.f, 0.f, 0.f, 0.f};
    const int nk = K >> 5;
    for (int t = 0; t < nk; ++t) {
        const int ko = t * 32;
        __builtin_amdgcn_global_load_lds((const void*)(a0 + ko), (LAS void*)(SA + tid * 16), 16, 0, 0);
        __builtin_amdgcn_global_load_lds((const void*)(a1 + ko), (LAS void*)(SA + tid * 16 + 4096), 16, 0, 0);
        __builtin_amdgcn_global_load_lds((const void*)(b0 + ko), (LAS void*)(SB + tid * 16), 16, 0, 0);
        __builtin_amdgcn_global_load_lds((const void*)(b1 + ko), (LAS void*)(SB + tid * 16 + 4096), 16, 0, 0);
        asm volatile("s_waitcnt vmcnt(0)" ::: "memory");
        __syncthreads();
        bf16x8 af[4], bfr[4];
#pragma unroll
        for (int m = 0; m < 4; ++m) af[m] = *reinterpret_cast<const bf16x8*>(SA + (wr * 64 + m * 16 + fr) * 64 + fq * 16);
#pragma unroll
        for (int n = 0; n < 4; ++n) bfr[n] = *reinterpret_cast<const bf16x8*>(SB + (wc * 64 + n * 16 + fr) * 64 + fq * 16);
#pragma unroll
        for (int m = 0; m < 4; ++m)
#pragma unroll
            for (int n = 0; n < 4; ++n) acc[m][n] = __builtin_amdgcn_mfma_f32_16x16x32_bf16(af[m], bfr[n], acc[m][n], 0, 0, 0);
        __syncthreads();
    }
}

__device__ void ph0_mod_unit(const P& p, int u, char* lds) {
    const int l = u / 96, cg = u % 96, tid = otid();
    float* s = (float*)lds;
    float* red = s + 9 * 1024;
    const float* c = p.in(I_C); const float* cctx = p.in(I_CCTX);
    for (int i = tid; i < 9 * 1024; i += NTHREADS) { int r = i >> 10, k = i & 1023; float v = r < 8 ? c[r * 1024 + k] : cctx[k]; s[i] = v / (1.f + expf(-v)); }
    __syncthreads();
    const int kq = tid >> 6, j = tid & 63, col = cg * 64 + j;
    const float* w = p.in(I_ADAW) + (size_t)l * 1024 * 6144 + col;
    float acc[9];
#pragma unroll
    for (int r = 0; r < 9; ++r) acc[r] = 0.f;
#pragma unroll 4
    for (int k = kq * 256; k < kq * 256 + 256; ++k) {
        const float wv = w[(size_t)k * 6144];
#pragma unroll
        for (int r = 0; r < 9; ++r) acc[r] += s[r * 1024 + k] * wv;
    }
#pragma unroll
    for (int r = 0; r < 9; ++r) red[(kq * 9 + r) * 64 + j] = acc[r];
    __syncthreads();
    if (tid < 64) {
        float* mod = (float*)(p.ws + WS_MOD);
        const float bb = p.in(I_ADAB)[l * 6144 + col];
#pragma unroll
        for (int r = 0; r < 9; ++r) mod[(size_t)(l * 9 + r) * 6144 + col] = red[r * 64 + j] + red[(9 + r) * 64 + j] + red[(18 + r) * 64 + j] + red[(27 + r) * 64 + j] + bb;
    }
    __syncthreads();
}

__device__ void ph0_s5tab_unit(const P& p, int u) {
    const int tid = otid();
    if (tid >= 64) return;
    const int ldg = u;
    const int idx = ldg * 64 + tid;
    const double lre = (double)p.in(I_S5_LRE)[idx], lim = (double)p.in(I_S5_LIM)[idx];
    const double dt = (double)expf(p.in(I_S5_LOGSTEP)[ldg]);
    const float mag = expf((float)(lre * dt));
    double rev = lim * dt * 0.15915494309189535; rev -= floor(rev);
    float sn, cs; sincospif(2.f * (float)rev, &sn, &cs);
    const double abr = (double)(mag * cs), abi = (double)(mag * sn);
    const double den = lre * lre + lim * lim;
    const double cor = ((abr - 1.0) * lre + abi * lim) / den;
    const double coi = (abi * lre - (abr - 1.0) * lim) / den;
    const float m64f = expf((float)(64.0 * lre * dt));
    double rev64 = 64.0 * lim * dt * 0.15915494309189535; rev64 -= floor(rev64);
    float sn64, cs64; sincospif(2.f * (float)rev64, &sn64, &cs64);
    float* A = (float*)(p.ws + WS_S5A) + (size_t)idx * 4;
    A[0] = (float)abr; A[1] = (float)abi; A[2] = m64f * cs64; A[3] = m64f * sn64;
    float* B = (float*)(p.ws + WS_S5B) + (size_t)idx * 32;
    const float* bre = p.in(I_S5_BRE) + (size_t)idx * 16; const float* bim = p.in(I_S5_BIM) + (size_t)idx * 16;
#pragma unroll
    for (int h = 0; h < 16; ++h) {
        const double br = bre[h], bi = bim[h];
        B[h] = (float)(cor * br - coi * bi);
        B[16 + h] = (float)(cor * bi + coi * br);
    }
}

__device__ __forceinline__ int xmap(int mode, int c) {
    if (mode == 0) return c;
    const int j = c >> 6, cc = c & 63, wc = cc >> 5, pp = (cc & 31) >> 4, i = cc & 15;
    return j * 128 + wc * 64 + pp * 32 + i + (mode == 2 ? 16 : 0);
}
__device__ void xpose_tile(const float* __restrict__ src, int C, bf16_t* __restrict__ dst, int ldd, int mode, int tr, int tc, char* lds) {
    float* t = (float*)lds;
    const int tid = otid(), tx = tid & 63, ty = tid >> 6;
#pragma unroll
    for (int k = 0; k < 16; ++k) {
        const int rr = ty + 4 * k, r = tr * 64 + rr, c = tc * 64 + tx;
        t[rr * 65 + tx] = (c < C) ? src[(size_t)r * C + c] : 0.f;
    }
    __syncthreads();
#pragma unroll
    for (int k = 0; k < 16; ++k) {
        const int ci = ty + 4 * k, c = tc * 64 + ci;
        dst[(size_t)xmap(mode, c) * ldd + tr * 64 + tx] = f2bf(t[tx * 65 + ci]);
    }
    __syncthreads();
}

enum { M_INIT = 0, M_LN2NEXT = 1, M_LN1 = 2, M_FINAL = 3 };

template <int MODE>
__device__ void rows_unit(const P& p, int l, int u, char* lds) {
    const int tid = otid(), w = tid >> 6, lane = tid & 63;
    float* hbuf = (float*)lds;
    bf16_t* hb = (bf16_t*)(p.ws + WS_HBY);
#pragma unroll 1
    for (int rr = 0; rr < 2; ++rr) {
        const int rl = w * 2 + rr, row = u * 8 + rl;
        const int mr = row_mod(row);
        float v[16];
        float* xr = xrow(p, row);
        const float* src = (MODE == M_INIT) ? (row < NTC ? p.in(I_CTX) + (size_t)row * DM : p.in(I_X) + (size_t)(row - NTC) * DM) : xr;
#pragma unroll
        for (int i = 0; i < 4; ++i) {
            const float4 t = *reinterpret_cast<const float4*>(src + i * 256 + lane * 4);
            v[i * 4 + 0] = t.x; v[i * 4 + 1] = t.y; v[i * 4 + 2] = t.z; v[i * 4 + 3] = t.w;
        }
        if (MODE != M_INIT) {
            const int ll = (MODE == M_LN2NEXT) ? l - 1 : l;
            const int which = (MODE == M_LN1) ? 0 : 1;
            float s = 0.f;
#pragma unroll
            for (int i = 0; i < 16; ++i) s += v[i];
            const float mu = wave_sum(s) * (1.f / 1024.f);
            float q = 0.f;
#pragma unroll
            for (int i = 0; i < 16; ++i) { const float d = v[i] - mu; q += d * d; }
            const float rstd = rsqrtf(wave_sum(q) * (1.f / 1024.f) + 1e-5f);
            const float* g = p.in(I_LNG) + (size_t)(ll * 2 + which) * 1024;
            const float* bb = p.in(I_LNB) + (size_t)(ll * 2 + which) * 1024;
#pragma unroll
            for (int i = 0; i < 4; ++i) {
                const float4 gg = *reinterpret_cast<const float4*>(g + i * 256 + lane * 4);
                const float4 b4 = *reinterpret_cast<const float4*>(bb + i * 256 + lane * 4);
                v[i * 4 + 0] = (v[i * 4 + 0] - mu) * rstd * gg.x + b4.x;
                v[i * 4 + 1] = (v[i * 4 + 1] - mu) * rstd * gg.y + b4.y;
                v[i * 4 + 2] = (v[i * 4 + 2] - mu) * rstd * gg.z + b4.z;
                v[i * 4 + 3] = (v[i * 4 + 3] - mu) * rstd * gg.w + b4.w;
            }
        }
        if (MODE == M_FINAL) {
            if (row >= NTC) {
#pragma unroll
                for (int i = 0; i < 4; ++i) *reinterpret_cast<float4*>(xr + i * 256 + lane * 4) = make_float4(v[i * 4], v[i * 4 + 1], v[i * 4 + 2], v[i * 4 + 3]);
            }
            continue;
        }
        const float osc = (MODE == M_LN1) ? ALPHA : 1.f;
#pragma unroll
        for (int i = 0; i < 4; ++i) *reinterpret_cast<float4*>(xr + i * 256 + lane * 4) = make_float4(osc * v[i * 4], osc * v[i * 4 + 1], osc * v[i * 4 + 2], osc * v[i * 4 + 3]);
        const float* sh = modp(p, l, mr, (MODE == M_LN1) ? 3 : 0);
        const float* sc = modp(p, l, mr, (MODE == M_LN1) ? 4 : 1);
#pragma unroll
        for (int i = 0; i < 4; ++i) {
            const float4 s4 = *reinterpret_cast<const float4*>(sc + i * 256 + lane * 4);
            const float4 h4 = *reinterpret_cast<const float4*>(sh + i * 256 + lane * 4);
            const float h0 = v[i * 4 + 0] * (1.f + s4.x) + h4.x, h1 = v[i * 4 + 1] * (1.f + s4.y) + h4.y;
            const float h2 = v[i * 4 + 2] * (1.f + s4.z) + h4.z, h3 = v[i * 4 + 3] * (1.f + s4.w) + h4.w;
            uint2 pk; pk.x = pack2(h0, h1); pk.y = pack2(h2, h3);
            *reinterpret_cast<uint2*>(hb + (size_t)row * DM + i * 256 + lane * 4) = pk;
            if (MODE == M_LN1) *reinterpret_cast<float4*>(hbuf + rl * 1024 + i * 256 + lane * 4) = make_float4(h0, h1, h2, h3);
        }
    }
    if (MODE == M_LN1) {
        const float* rw = p.in(I_ROUTER_W) + (size_t)l * 1024 * 64 + lane;
        const float* h0p = hbuf + (w * 2) * 1024; const float* h1p = h0p + 1024;
        float a0 = 0.f, a1 = 0.f;
#pragma unroll 2
        for (int k = 0; k < 1024; k += 4) {
            const float4 x0 = *reinterpret_cast<const float4*>(h0p + k);
            const float4 x1 = *reinterpret_cast<const float4*>(h1p + k);
            const float w0 = rw[(size_t)(k + 0) * 64], w1 = rw[(size_t)(k + 1) * 64], w2 = rw[(size_t)(k + 2) * 64], w3 = rw[(size_t)(k + 3) * 64];
            a0 += x0.x * w0; a1 += x1.x * w0;
            a0 += x0.y * w1; a1 += x1.y * w1;
            a0 += x0.z * w2; a1 += x1.z * w2;
            a0 += x0.w * w3; a1 += x1.w * w3;
        }
        const float rbias = p.in(I_ROUTER_B)[l * 64 + lane];
        unsigned* cnt = (unsigned*)(p.ws + WS_CTL) + CW_CNT(l);
        int* aep = (int*)(p.ws + WS_AEP); float* aw = (float*)(p.ws + WS_AW);
#pragma unroll 1
        for (int rr = 0; rr < 2; ++rr) {
            const int row = u * 8 + w * 2 + rr;
            const float logit = rr ? a1 : a0;
            const float s = 1.f / (1.f + expf(-logit));
            const float bsd = s + rbias;
            float m1 = bsd;
            m1 = fmaxf(m1, __shfl_xor(m1, 1)); m1 = fmaxf(m1, __shfl_xor(m1, 2)); m1 = fmaxf(m1, __shfl_xor(m1, 4));
            const unsigned long long eqm = __ballot(bsd == m1);
            const int gbase = lane & ~7;
            const unsigned gbits = (unsigned)((eqm >> gbase) & 0xFFull);
            const int first = gbase + __builtin_ctz(gbits);
            float m2 = (lane == first) ? -INFINITY : bsd;
            m2 = fmaxf(m2, __shfl_xor(m2, 1)); m2 = fmaxf(m2, __shfl_xor(m2, 2)); m2 = fmaxf(m2, __shfl_xor(m2, 4));
            const float gs = m1 + m2;
            const int myg = lane >> 3;
            int grank = 0;
#pragma unroll
            for (int g2 = 0; g2 < 8; ++g2) { const float o = __shfl(gs, g2 * 8); grank += (o > gs || (o == gs && g2 < myg)) ? 1 : 0; }
            const bool gsel = grank < 4;
            const float msk = gsel ? bsd : -INFINITY;
            int erank = 0;
#pragma unroll
            for (int j = 0; j < 64; ++j) { const float o = __shfl(msk, j); erank += (o > msk || (o == msk && j < lane)) ? 1 : 0; }
            const bool sel = gsel && erank < 8;
            const float wsum = wave_sum(sel ? s : 0.f);
            const unsigned long long selm = __ballot(sel);
            if (sel) {
                const int slot = __popcll(selm & ((1ull << lane) - 1ull));
                const unsigned pos = atomicAdd(&cnt[lane], 1u);
                aep[(size_t)row * 8 + slot] = (int)((unsigned)lane << 24 | pos);
                aw[(size_t)row * 8 + slot] = s / wsum * 2.5f;
            }
        }
    }
}

__device__ void filt_unit(const P& p, int l, int u, char* lds) {
    const int tid = otid();
    float* feat = (float*)lds;
    float* h1 = feat + 4 * 36;
    float* h2 = h1 + 4 * 64;
    const int pp = tid >> 6, j = tid & 63;
    const int pi = u * 4 + pp;
    const int L = pi < 4096 ? 4096 : 256;
    const int t = pi < 4096 ? pi : pi - 4096;
    const float tt = (float)t / (float)(L - 1);
    if (j < 33) {
        float f;
        if (j == 0) f = tt;
        else {
            const int k = (j - 1) & 15;
            const float band = 1e-4f + (float)k * ((15.0f - 1e-4f) / 15.0f);
            float ph = band * (float)t * (1.f / (float)L);
            ph -= floorf(ph);
            float sn, cs; sincospif(2.f * ph, &sn, &cs);
            f = (j <= 16) ? cs : -sn;
        }
        feat[pp * 36 + j] = f;
    }
    __syncthreads();
    {
        const float* w1 = p.in(I_HY_W1) + (size_t)l * 33 * 64;
        float a = p.in(I_HY_B1)[l * 64 + j];
        for (int i = 0; i < 33; ++i) a += feat[pp * 36 + i] * w1[i * 64 + j];
        h1[pp * 64 + j] = sinf(p.in(I_HY_F1)[l * 64 + j] * a);
    }
    __syncthreads();
    {
        const float* w2 = p.in(I_HY_W2) + (size_t)l * 64 * 64;
        float a = p.in(I_HY_B2)[l * 64 + j];
        for (int i = 0; i < 64; ++i) a += h1[pp * 64 + i] * w2[i * 64 + j];
        h2[pp * 64 + j] = sinf(p.in(I_HY_F2)[l * 64 + j] * a);
    }
    __syncthreads();
    {
        const int c = tid;
        const float* w3 = p.in(I_HY_W3) + (size_t)l * 64 * 1024;
        float acc[4][4];
#pragma unroll
        for (int a = 0; a < 4; ++a)
#pragma unroll
            for (int b = 0; b < 4; ++b) acc[a][b] = 0.f;
        for (int i = 0; i < 64; ++i) {
            float wv[4];
#pragma unroll
            for (int os = 0; os < 4; ++os) wv[os] = w3[i * 1024 + os * 256 + c];
#pragma unroll
            for (int q = 0; q < 4; ++q) {
                const float hv = h2[q * 64 + i];
#pragma unroll
                for (int os = 0; os < 4; ++os) acc[q][os] += hv * wv[os];
            }
        }
        const float d0 = logf(0.01f) / 1.5f, d1 = logf(0.01f) / 0.3f;
        const float delta = fabsf(d0 + (d1 - d0) * ((float)c / 255.f));
#pragma unroll
        for (int q = 0; q < 4; ++q) {
            const int pq = u * 4 + q;
            const int Lq = pq < 4096 ? 4096 : 256;
            const int tq = pq < 4096 ? pq : pq - 4096;
            const float ttq = (float)tq / (float)(Lq - 1);
            const float dec = expf(-ttq * delta);
            float* F = (pq < 4096) ? (float*)(p.ws + WS_FILTL) : (float*)(p.ws + WS_FILTC);
#pragma unroll
            for (int os = 0; os < 4; ++os) {
                if (pq < 4096) F[((size_t)((os >> 1) * 256 + c) * 2 + (os & 1)) * 4096 + tq] = acc[q][os] * dec;
                else F[((size_t)os * 256 + c) * Lq + tq] = acc[q][os] * dec;
            }
        }
    }
    __syncthreads();
}

__device__ void rwkv_prep_unit(const P& p, int l, int u, char* lds) {
    const int tid = otid(), w = tid >> 6;
    float* tw = (float*)lds;
    float* al = tw + 32 * 64;
    const bf16_t* z = (const bf16_t*)(p.ws + WS_Z);
    bf16_t* rwp = (bf16_t*)(p.ws + WS_R1 + R1_RWP);
    float* knorm = (float*)(p.ws + WS_KNORM);
    const int row0 = u * 32;
#pragma unroll
    for (int i = 0; i < 8; ++i) {
        const int idx = tid + 256 * i, tok = idx >> 6, j = idx & 63;
        const bf16_t* zr = z + (size_t)(row0 + tok) * ZS;
        tw[idx] = tanhf(bf2f(zr[768 + j]));
        al[idx] = bf2f(zr[832 + j]);
    }
    __syncthreads();
    const int c = tid;
#pragma unroll 1
    for (int pass = 0; pass < 4; ++pass) {
        const int d = pass & 1;
        const bool isA = pass >= 2;
        const float* W2 = (isA ? p.in(I_RW_A2) : p.in(I_RW_W2)) + (size_t)((l * 2 + d) * 32) * 256 + c;
        const float base = (isA ? p.in(I_RW_A0) : p.in(I_RW_W0))[(l * 2 + d) * 256 + c];
        float wr[32];
#pragma unroll
        for (int r = 0; r < 32; ++r) wr[r] = W2[r * 256];
        const float* src = isA ? al : tw;
#pragma unroll 2
        for (int tok = 0; tok < 32; ++tok) {
            float a = base;
#pragma unroll
            for (int r = 0; r < 32; r += 4) {
                const float4 x = *reinterpret_cast<const float4*>(src + tok * 64 + d * 32 + r);
                a += x.x * wr[r] + x.y * wr[r + 1] + x.z * wr[r + 2] + x.w * wr[r + 3];
            }
            float o;
            if (isA) o = 1.f / (1.f + expf(-a));
            else o = expf(-softplusf(-a) - 0.5f);
            rwp[((size_t)(row0 + tok) * 4 + pass) * 256 + c] = f2bf(o);
        }
    }
    const float kkc = p.in(I_RW_KK)[l * 256 + c];
#pragma unroll 4
    for (int tok = 0; tok < 32; ++tok) {
        const float kv = bf2f(z[(size_t)(row0 + tok) * ZS + 256 + c]) * kkc;
        const float ss = wave_sum(kv * kv);
        if ((tid & 63) == 0) knorm[(size_t)(row0 + tok) * 4 + w] = rsqrtf(ss + 1e-12f);
    }
    __syncthreads();
}

__device__ void gdn_prep_unit(const P& p, int l, int u) {
    const int tid = otid();
    const bf16_t* z = (const bf16_t*)(p.ws + WS_Z);
    bf16_t* gq = (bf16_t*)(p.ws + WS_R1 + R1_GQ);
    float* gab = (float*)(p.ws + WS_GAB);
    const int row0 = u * 32;
    int seq0, seqL;
    if (row0 < NTC) { seq0 = row0 & ~255; seqL = 256; } else { seq0 = NTC + ((row0 - NTC) & ~4095); seqL = 4096; }
#pragma unroll 1
    for (int pz = 0; pz < 3; ++pz) {
        const int ch = pz * 256 + tid;
        const float w0 = p.in(I_GD_CONV)[(size_t)(l * 3 + 0) * 768 + ch], w1 = p.in(I_GD_CONV)[(size_t)(l * 3 + 1) * 768 + ch], w2 = p.in(I_GD_CONV)[(size_t)(l * 3 + 2) * 768 + ch];
        const bf16_t* zc = z + COL_GD + ch;
        float xm = (row0 - 1 >= seq0) ? bf2f(zc[(size_t)(row0 - 1) * ZS]) : 0.f;
        float x0 = bf2f(zc[(size_t)row0 * ZS]);
#pragma unroll 4
        for (int tok = 0; tok < 32; ++tok) {
            const int row = row0 + tok;
            const float xp = (row + 1 < seq0 + seqL) ? bf2f(zc[(size_t)(row + 1) * ZS]) : 0.f;
            float v = siluf(w0 * xm + w1 * x0 + w2 * xp);
            if (pz < 2) {
                const float ss = wave_sum(v * v);
                v *= rsqrtf(ss + 1e-12f) * (pz == 0 ? 0.125f : 1.f);
            }
            gq[(size_t)row * 768 + ch] = f2bf(v);
            xm = x0; x0 = xp;
        }
    }
    {
        const int tok = tid >> 3, dh = tid & 7;
        const int row = row0 + tok;
        const float alv = bf2f(z[(size_t)row * ZS + COL_GD + 1024 + dh]);
        const float blv = bf2f(z[(size_t)row * ZS + COL_GD + 1032 + dh]);
        const float g = -expf(p.in(I_GD_ALOG)[l * 8 + dh]) * softplusf(alv + p.in(I_GD_DTB)[l * 8 + dh]);
        gab[(size_t)row * 16 + dh] = expf(g);
        gab[(size_t)row * 16 + 8 + dh] = 1.f / (1.f + expf(-blv));
    }
}

__device__ __forceinline__ int s5_chain_row(int b, int d, int q) {
    if (q < 256) return b * 256 + (d ? 255 - q : q);
    int n = q - 256; if (d) n = 4095 - n;
    return NTC + b * 4096 + (n & 63) * 64 + (n >> 6);
}
__device__ __forceinline__ void s5_load_u(const bf16_t* zr, float* dst) {
    const uint4 a = *reinterpret_cast<const uint4*>(zr);
    const uint4 b = *reinterpret_cast<const uint4*>(zr + 8);
    *reinterpret_cast<float4*>(dst + 0) = make_float4(bflo(a.x), bfhi(a.x), bflo(a.y), bfhi(a.y));
    *reinterpret_cast<float4*>(dst + 4) = make_float4(bflo(a.z), bfhi(a.z), bflo(a.w), bfhi(a.w));
    *reinterpret_cast<float4*>(dst + 8) = make_float4(bflo(b.x), bfhi(b.x), bflo(b.y), bfhi(b.y));
    *reinterpret_cast<float4*>(dst + 12) = make_float4(bflo(b.z), bfhi(b.z), bflo(b.w), bfhi(b.w));
}

__device__ void s5_pre_unit(const P& p, int l, int u, char* lds) {
    const int tid = otid(), w = tid >> 6, lane = tid & 63;
    float* ust = (float*)lds + w * 1024;
    const int wt = u * 4 + w;
    const int d = wt & 1, g = (wt >> 1) & 15, rest = wt >> 5;
    const int cc = rest % NCHUNK, b = rest / NCHUNK;
    const bf16_t* z = (const bf16_t*)(p.ws + WS_Z);
    {
        const int row = s5_chain_row(b, d, cc * 64 + lane);
        s5_load_u(z + (size_t)row * ZS + COL_S5 + g * 16, ust + lane * 16);
    }
    const int tix = ((l * 2 + d) * 16 + g) * 64 + lane;
    const float4 A = *reinterpret_cast<const float4*>((const float*)(p.ws + WS_S5A) + (size_t)tix * 4);
    const float* Bp = (const float*)(p.ws + WS_S5B) + (size_t)tix * 32;
    float br[16], bi[16];
#pragma unroll
    for (int h = 0; h < 16; ++h) { br[h] = Bp[h]; bi[h] = Bp[16 + h]; }
    float xr = 0.f, xi = 0.f;
#pragma unroll 2
    for (int s = 0; s < 64; ++s) {
        float ur = 0.f, ui = 0.f;
#pragma unroll
        for (int h4 = 0; h4 < 4; ++h4) {
            const float4 uu = *reinterpret_cast<const float4*>(ust + s * 16 + h4 * 4);
            ur += br[h4 * 4] * uu.x + br[h4 * 4 + 1] * uu.y + br[h4 * 4 + 2] * uu.z + br[h4 * 4 + 3] * uu.w;
            ui += bi[h4 * 4] * uu.x + bi[h4 * 4 + 1] * uu.y + bi[h4 * 4 + 2] * uu.z + bi[h4 * 4 + 3] * uu.w;
        }
        const float nr = A.x * xr - A.y * xi + ur;
        const float ni = A.x * xi + A.y * xr + ui;
        xr = nr; xi = ni;
    }
    float* st = (float*)(p.ws + WS_S5ST) + ((((size_t)(b * NCHUNK + cc) * 2 + d) * 16 + g) * 64 + lane) * 2;
    st[0] = xr; st[1] = xi;
}

__device__ __forceinline__ float reduce16(const float (&t)[16], int lane) {
    float a[8];
    const bool hi8 = (lane & 8) != 0;
#pragma unroll
    for (int k = 0; k < 8; ++k) { const float keep = hi8 ? t[k + 8] : t[k]; const float send = hi8 ? t[k] : t[k + 8]; a[k] = keep + dppf<0x140>(send); }
    float b[4];
    const bool hi4 = (lane & 4) != 0;
#pragma unroll
    for (int k = 0; k < 4; ++k) { const float keep = hi4 ? a[k + 4] : a[k]; const float send = hi4 ? a[k] : a[k + 4]; b[k] = keep + dppf<0x141>(send); }
    float c[2];
    const bool hi2 = (lane & 2) != 0;
#pragma unroll
    for (int k = 0; k < 2; ++k) { const float keep = hi2 ? b[k + 2] : b[k]; const float send = hi2 ? b[k] : b[k + 2]; c[k] = keep + dppf<0x4E>(send); }
    const bool hi1 = (lane & 1) != 0;
    float r = (hi1 ? c[1] : c[0]) + dppf<0xB1>(hi1 ? c[0] : c[1]);
    r += __shfl_xor(r, 16);
    r += __shfl_xor(r, 32);
    return r;
}

__device__ void s5_main_unit(const P& p, int l, int u, char* lds) {
    const int tid = otid(), w = tid >> 6, lane = tid & 63;
    float* ust = (float*)lds + w * 2048;
    float* yst = ust + 1024;
    const int b = u / NCHUNK, tc = u % NCHUNK;
    bf16_t* z = (bf16_t*)(p.ws + WS_Z);
    const int myrow = (tc < 4) ? (b * 256 + tc * 64 + lane) : (NTC + b * 4096 + lane * 64 + (tc - 4));
#pragma unroll 1
    for (int gi = 0; gi < 4; ++gi) {
        const int g = w * 4 + gi;
        s5_load_u(z + (size_t)myrow * ZS + COL_S5 + g * 16, ust + lane * 16);
#pragma unroll 1
        for (int d = 0; d < 2; ++d) {
            const int tix = ((l * 2 + d) * 16 + g) * 64 + lane;
            const float4 A = *reinterpret_cast<const float4*>((const float*)(p.ws + WS_S5A) + (size_t)tix * 4);
            const float* Bp = (const float*)(p.ws + WS_S5B) + (size_t)tix * 32;
            float br[16], bi[16], cr[16], ci[16];
#pragma unroll
            for (int h = 0; h < 16; ++h) { br[h] = Bp[h]; bi[h] = Bp[16 + h]; }
            const float* crp = p.in(I_S5_CRE) + (size_t)((l * 2 + d) * 16 + g) * 1024 + lane;
            const float* cip = p.in(I_S5_CIM) + (size_t)((l * 2 + d) * 16 + g) * 1024 + lane;
#pragma unroll
            for (int h = 0; h < 16; ++h) { cr[h] = crp[h * 64]; ci[h] = cip[h * 64]; }
            const int cc = d ? ((tc < 4) ? 3 - tc : 71 - tc) : tc;
            float xr = 0.f, xi = 0.f;
            {
                const float* st = (const float*)(p.ws + WS_S5ST) + ((((size_t)(b * NCHUNK) * 2 + d) * 16 + g) * 64 + lane) * 2;
                for (int c2 = 0; c2 < cc; ++c2) {
                    const float2 sv = *reinterpret_cast<const float2*>(st + (size_t)c2 * (2 * 16 * 64 * 2));
                    const float nr = A.z * xr - A.w * xi + sv.x;
                    const float ni = A.z * xi + A.w * xr + sv.y;
                    xr = nr; xi = ni;
                }
            }
#pragma unroll 1
            for (int s = 0; s < 64; ++s) {
                const int i = d ? 63 - s : s;
                float ur = 0.f, ui = 0.f;
#pragma unroll
                for (int h4 = 0; h4 < 4; ++h4) {
                    const float4 uu = *reinterpret_cast<const float4*>(ust + i * 16 + h4 * 4);
                    ur += br[h4 * 4] * uu.x + br[h4 * 4 + 1] * uu.y + br[h4 * 4 + 2] * uu.z + br[h4 * 4 + 3] * uu.w;
                    ui += bi[h4 * 4] * uu.x + bi[h4 * 4 + 1] * uu.y + bi[h4 * 4 + 2] * uu.z + bi[h4 * 4 + 3] * uu.w;
                }
                const float nr = A.x * xr - A.y * xi + ur;
                const float ni = A.x * xi + A.y * xr + ui;
                xr = nr; xi = ni;
                float t[16];
#pragma unroll
                for (int h = 0; h < 16; ++h) t[h] = cr[h] * xr - ci[h] * xi;
                const float tot = reduce16(t, lane);
                if (lane < 16) { if (d == 0) yst[i * 16 + lane] = tot; else yst[i * 16 + lane] += tot; }
            }
        }
        {
            const float* dsk = p.in(I_S5_D) + l * 256 + g * 16;
            unsigned pk[8];
#pragma unroll
            for (int h = 0; h < 16; h += 2) {
                float y0 = yst[lane * 16 + h] + ust[lane * 16 + h] * dsk[h];
                float y1 = yst[lane * 16 + h + 1] + ust[lane * 16 + h + 1] * dsk[h + 1];
                y0 = 0.5f * y0 * (1.f + erff(y0 * 0.70710678118f));
                y1 = 0.5f * y1 * (1.f + erff(y1 * 0.70710678118f));
                pk[h >> 1] = pack2(y0, y1);
            }
            uint4* dst = reinterpret_cast<uint4*>(z + (size_t)myrow * ZS + COL_S5 + g * 16);
            dst[0] = make_uint4(pk[0], pk[1], pk[2], pk[3]);
            dst[1] = make_uint4(pk[4], pk[5], pk[6], pk[7]);
        }
    }
}

#define SB 16
__device__ __forceinline__ int scan_chain_row(int b, int d, int q) {
    if (q < 256) return b * 256 + (d ? 255 - q : q);
    const int t = q - 256;
    return NTC + b * 4096 + (d ? 4095 - t : t);
}
struct ScanRaw { uint2 r, k, v, e, a; float f0, f1; };

__device__ __forceinline__ void scan_load(const P& p, int m, int b, int h, int d, int q, int cg, ScanRaw& R) {
    const int row = scan_chain_row(b, d, q);
    const int c0 = h * 64 + cg * 4;
    if (m == 0) {
        const bf16_t* z = (const bf16_t*)(p.ws + WS_Z) + (size_t)row * ZS + c0;
        R.r = *reinterpret_cast<const uint2*>(z);
        R.k = *reinterpret_cast<const uint2*>(z + 256);
        R.v = *reinterpret_cast<const uint2*>(z + 512);
        const bf16_t* rw = (const bf16_t*)(p.ws + WS_R1 + R1_RWP) + (size_t)row * 1024 + c0;
        R.e = *reinterpret_cast<const uint2*>(rw + d * 256);
        R.a = *reinterpret_cast<const uint2*>(rw + (2 + d) * 256);
        R.f0 = ((const float*)(p.ws + WS_KNORM))[(size_t)row * 4 + h];
        R.f1 = 0.f;
    } else {
        const bf16_t* gq = (const bf16_t*)(p.ws + WS_R1 + R1_GQ) + (size_t)row * 768 + c0;
        R.r = *reinterpret_cast<const uint2*>(gq);
        R.k = *reinterpret_cast<const uint2*>(gq + 256);
        R.v = *reinterpret_cast<const uint2*>(gq + 512);
        R.e = make_uint2(0u, 0u); R.a = make_uint2(0u, 0u);
        const float* gab = (const float*)(p.ws + WS_GAB) + (size_t)row * 16;
        R.f0 = gab[d * 4 + h];
        R.f1 = gab[8 + d * 4 + h];
    }
}
__device__ __forceinline__ void scan_store(int m, const ScanRaw& R, float* dst  , const float (&kkp)[4], const float (&kap)[4]) {
    float r[4] = {bflo(R.r.x), bfhi(R.r.x), bflo(R.r.y), bfhi(R.r.y)};
    float k[4] = {bflo(R.k.x), bfhi(R.k.x), bflo(R.k.y), bfhi(R.k.y)};
    float v[4] = {bflo(R.v.x), bfhi(R.v.x), bflo(R.v.y), bfhi(R.v.y)};
    float ww[4], aa[4], bb[4], kk[4];
    if (m == 0) {
        float e[4] = {bflo(R.e.x), bfhi(R.e.x), bflo(R.e.y), bfhi(R.e.y)};
        float a[4] = {bflo(R.a.x), bfhi(R.a.x), bflo(R.a.y), bfhi(R.a.y)};
#pragma unroll
        for (int i = 0; i < 4; ++i) {
            ww[i] = __expf(-e[i]);
            kk[i] = k[i] * (1.f + (a[i] - 1.f) * kap[i]);
            const float kn = k[i] * kkp[i] * R.f0;
            aa[i] = -kn;
            bb[i] = kn * a[i];
        }
    } else {
        const float al = R.f0, be = R.f1;
#pragma unroll
        for (int i = 0; i < 4; ++i) { ww[i] = al; aa[i] = k[i]; bb[i] = -al * be * k[i]; kk[i] = be * k[i]; }
    }
    *reinterpret_cast<float4*>(dst + 0 * 64) = make_float4(ww[0], ww[1], ww[2], ww[3]);
    *reinterpret_cast<float4*>(dst + 1 * 64) = make_float4(aa[0], aa[1], aa[2], aa[3]);
    *reinterpret_cast<float4*>(dst + 2 * 64) = make_float4(bb[0], bb[1], bb[2], bb[3]);
    *reinterpret_cast<float4*>(dst + 3 * 64) = make_float4(kk[0], kk[1], kk[2], kk[3]);
    *reinterpret_cast<float4*>(dst + 4 * 64) = make_float4(r[0], r[1], r[2], r[3]);
    *reinterpret_cast<float4*>(dst + 5 * 64) = make_float4(v[0], v[1], v[2], v[3]);
}

__device__ void scan_unit(const P& p, int l, int u, char* lds) {
    const int tid = otid();
    const int chain = u >> 1, half = u & 1;
    const int m = chain >> 6, rem = chain & 63, b = rem >> 3, h = (rem >> 1) & 3, d = rem & 1;
    float* buf = (float*)lds;
    float* ybuf = buf + 2 * SB * 384;
    const int rl = tid >> 3, sub = tid & 7;
    const int st = tid >> 4, cg = tid & 15;
    float kkp[4], kap[4];
#pragma unroll
    for (int i = 0; i < 4; ++i) { kkp[i] = p.in(I_RW_KK)[l * 256 + h * 64 + cg * 4 + i]; kap[i] = p.in(I_RW_KA)[l * 256 + h * 64 + cg * 4 + i]; }
    bf16_t* ys = (bf16_t*)(p.ws + WS_HBY) + (size_t)(m * 2 + d) * NT * 256;
    float S[8];
#pragma unroll
    for (int j = 0; j < 8; ++j) S[j] = 0.f;
    ScanRaw R;
    scan_load(p, m, b, h, d, st, cg, R);
    scan_store(m, R, buf + (st * 6) * 64 + cg * 4, kkp, kap);
    __syncthreads();
    const int NB = 4352 / SB;
    __builtin_amdgcn_s_setprio(2);
#pragma unroll 1
    for (int bt = 0; bt < NB; ++bt) {
        const int par = bt & 1;
        if (bt + 1 < NB) scan_load(p, m, b, h, d, (bt + 1) * SB + st, cg, R);
        const float* cb = buf + par * (SB * 384);
        float* yb = ybuf + par * (SB * 32);
        {
            const float* sb0 = cb + sub * 8;
            const float* vb0 = cb + 320 + half * 32 + rl;
            float4 nw0 = *reinterpret_cast<const float4*>(sb0), nw1 = *reinterpret_cast<const float4*>(sb0 + 4);
            float4 na0 = *reinterpret_cast<const float4*>(sb0 + 64), na1 = *reinterpret_cast<const float4*>(sb0 + 68);
            float4 nb0 = *reinterpret_cast<const float4*>(sb0 + 128), nb1 = *reinterpret_cast<const float4*>(sb0 + 132);
            float4 nk0 = *reinterpret_cast<const float4*>(sb0 + 192), nk1 = *reinterpret_cast<const float4*>(sb0 + 196);
            float4 nr0 = *reinterpret_cast<const float4*>(sb0 + 256), nr1 = *reinterpret_cast<const float4*>(sb0 + 260);
            float nvv = vb0[0];
#pragma unroll
            for (int s = 0; s < SB; ++s) {
                const float4 w0 = nw0, w1 = nw1, a0 = na0, a1 = na1, b0 = nb0, b1 = nb1, k0 = nk0, k1 = nk1, r0 = nr0, r1 = nr1;
                const float vv = nvv;
                if (s + 1 < SB) {
                    const float* sb = sb0 + (s + 1) * 384;
                    nw0 = *reinterpret_cast<const float4*>(sb); nw1 = *reinterpret_cast<const float4*>(sb + 4);
                    na0 = *reinterpret_cast<const float4*>(sb + 64); na1 = *reinterpret_cast<const float4*>(sb + 68);
                    nb0 = *reinterpret_cast<const float4*>(sb + 128); nb1 = *reinterpret_cast<const float4*>(sb + 132);
                    nk0 = *reinterpret_cast<const float4*>(sb + 192); nk1 = *reinterpret_cast<const float4*>(sb + 196);
                    nr0 = *reinterpret_cast<const float4*>(sb + 256); nr1 = *reinterpret_cast<const float4*>(sb + 260);
                    nvv = vb0[(s + 1) * 384];
                }
                __builtin_amdgcn_sched_barrier(0);
                float sa = (S[0] * a0.x + S[1] * a0.y) + (S[2] * a0.z + S[3] * a0.w) + (S[4] * a1.x + S[5] * a1.y) + (S[6] * a1.z + S[7] * a1.w);
                sa += dppf<0xB1>(sa); sa += dppf<0x4E>(sa); sa += dppf<0x141>(sa);
                S[0] = S[0] * w0.x + sa * b0.x + vv * k0.x;
                S[1] = S[1] * w0.y + sa * b0.y + vv * k0.y;
                S[2] = S[2] * w0.z + sa * b0.z + vv * k0.z;
                S[3] = S[3] * w0.w + sa * b0.w + vv * k0.w;
                S[4] = S[4] * w1.x + sa * b1.x + vv * k1.x;
                S[5] = S[5] * w1.y + sa * b1.y + vv * k1.y;
                S[6] = S[6] * w1.z + sa * b1.z + vv * k1.z;
                S[7] = S[7] * w1.w + sa * b1.w + vv * k1.w;
                float y = (S[0] * r0.x + S[1] * r0.y) + (S[2] * r0.z + S[3] * r0.w) + (S[4] * r1.x + S[5] * r1.y) + (S[6] * r1.z + S[7] * r1.w);
                y += dppf<0xB1>(y); y += dppf<0x4E>(y); y += dppf<0x141>(y);
                yb[s * 32 + rl] = y;
            }
        }
        if (bt + 1 < NB) scan_store(m, R, buf + (1 - par) * (SB * 384) + (st * 6) * 64 + cg * 4, kkp, kap);
        __syncthreads();
        {
            const int r2 = cg * 2;
            const int row = scan_chain_row(b, d, bt * SB + st);
            const unsigned pk = pack2(yb[st * 32 + r2], yb[st * 32 + r2 + 1]);
            *reinterpret_cast<unsigned*>(ys + (size_t)row * 256 + h * 64 + half * 32 + r2) = pk;
        }
    }
    __builtin_amdgcn_s_setprio(0);
    __syncthreads();
}

template <int L>
__device__ void hyena_unit(const P& p, int l, int u, char* lds) {
    constexpr int TPT = L / 256;
    const int tid = otid();
    const int c = u >> 2, bp = u & 3;
    float2* u2 = (float2*)lds;
    float* taps = (float*)(lds + (size_t)L * 8);
    const bf16_t* z = (const bf16_t*)(p.ws + WS_Z);
    bf16_t* cat = (bf16_t*)(p.ws + WS_CAT);
    const float* F = (L == 4096) ? (const float*)(p.ws + WS_FILTL) : (const float*)(p.ws + WS_FILTC);
    int base[2];
#pragma unroll
    for (int bb = 0; bb < 2; ++bb) { const int b = bp * 2 + bb; base[bb] = (L == 4096) ? NTC + b * 4096 : b * 256; }
    const int t0 = tid * TPT;
    const float* cw = p.in(I_HY_CONV) + (size_t)l * 3 * 768; const float* cb = p.in(I_HY_CONVB) + (size_t)l * 768;
    auto sconv = [&](int part, int bb, float (&o)[TPT]) {
        const int ch = part * 256 + c;
        const float w0 = cw[ch], w1 = cw[768 + ch], w2 = cw[1536 + ch], bs = cb[ch];
        const bf16_t* zc = z + (size_t)base[bb] * ZS + COL_HY + ch;
        float xm = (t0 > 0) ? bf2f(zc[(size_t)(t0 - 1) * ZS]) : 0.f;
        float x0 = bf2f(zc[(size_t)t0 * ZS]);
#pragma unroll
        for (int i = 0; i < TPT; ++i) {
            const int t = t0 + i;
            const float xp = (t + 1 < L) ? bf2f(zc[(size_t)(t + 1) * ZS]) : 0.f;
            o[i] = w0 * xm + w1 * x0 + w2 * xp + bs;
            xm = x0; x0 = xp;
        }
    };
    {
        float v0[TPT], v1[TPT];
        sconv(2, 0, v0); sconv(2, 1, v1);
#pragma unroll
        for (int i = 0; i < TPT; ++i) u2[t0 + i] = make_float2(v0[i], v1[i]);
    }
#pragma unroll 1
    for (int o = 0; o < 2; ++o) {
        const float* hf = F + ((size_t)(o * 2 + 0) * 256 + c) * L;
        const float* hbk = F + ((size_t)(o * 2 + 1) * 256 + c) * L;
        for (int k = tid; k < 2 * L; k += NTHREADS) {
            const int dd = k - (L - 1);
            taps[k] = (dd >= L) ? 0.f : (dd >= 0 ? hf[dd] : hbk[-dd]);
        }
        __syncthreads();
        float acc[TPT][2];
#pragma unroll
        for (int i = 0; i < TPT; ++i) { acc[i][0] = 0.f; acc[i][1] = 0.f; }
        if (L == 4096) {
#pragma unroll 1
            for (int s0 = 0; s0 < L; s0 += 16) {
                const int k0 = t0 - s0 + (L - 16);
                float W[32];
#pragma unroll
                for (int q = 0; q < 8; ++q) {
                    const float4 t4 = *reinterpret_cast<const float4*>(taps + k0 + q * 4);
                    W[q * 4] = t4.x; W[q * 4 + 1] = t4.y; W[q * 4 + 2] = t4.z; W[q * 4 + 3] = t4.w;
                }
#pragma unroll
                for (int j = 0; j < 16; ++j) {
                    const float2 uj = u2[s0 + j];
#pragma unroll
                    for (int i = 0; i < TPT; ++i) {
                        const float wv = W[(i - j + 15) & 31];
                        acc[i][0] += wv * uj.x; acc[i][1] += wv * uj.y;
                    }
                }
            }
        } else {
            for (int s = 0; s < L; ++s) {
                const float2 uj = u2[s];
                const float wv = taps[t0 - s + (L - 1)];
                acc[0][0] += wv * uj.x; acc[0][1] += wv * uj.y;
            }
        }
        const float sk = p.in(I_HY_SKIP)[(size_t)(l * 2 + o) * 256 + c];
        float res[TPT][2];
        {
            float g0[TPT], g1[TPT];
            sconv(o, 0, g0); sconv(o, 1, g1);
#pragma unroll
            for (int i = 0; i < TPT; ++i) {
                const float2 ut = u2[t0 + i];
                res[i][0] = g0[i] * (acc[i][0] + sk * ut.x);
                res[i][1] = g1[i] * (acc[i][1] + sk * ut.y);
            }
        }
        __syncthreads();
        if (o == 0) {
#pragma unroll
            for (int i = 0; i < TPT; ++i) u2[t0 + i] = make_float2(res[i][0], res[i][1]);
        } else {
#pragma unroll
            for (int i = 0; i < TPT; ++i) {
                cat[(size_t)(base[0] + t0 + i) * DM + 512 + c] = f2bf(res[i][0]);
                cat[(size_t)(base[1] + t0 + i) * DM + 512 + c] = f2bf(res[i][1]);
            }
        }
        __syncthreads();
    }
}


#define FFT_BS 272
__device__ __forceinline__ int fphys(int d2, int d1, int d0) { return d2 * FFT_BS + d1 * 17 + d0; }
__device__ __forceinline__ float2 cmulf(float2 a, float2 b) { return make_float2(a.x * b.x - a.y * b.y, a.x * b.y + a.y * b.x); }
__device__ static constexpr float C32T[16] = {1.000000000e+00f, 9.807852804e-01f, 9.238795325e-01f, 8.314696123e-01f, 7.071067812e-01f, 5.555702330e-01f, 3.826834324e-01f, 1.950903220e-01f, 6.123233996e-17f, -1.950903220e-01f, -3.826834324e-01f, -5.555702330e-01f, -7.071067812e-01f, -8.314696123e-01f, -9.238795325e-01f, -9.807852804e-01f};
__device__ static constexpr float S32T[16] = {0.000000000e+00f, 1.950903220e-01f, 3.826834324e-01f, 5.555702330e-01f, 7.071067812e-01f, 8.314696123e-01f, 9.238795325e-01f, 9.807852804e-01f, 1.000000000e+00f, 9.807852804e-01f, 9.238795325e-01f, 8.314696123e-01f, 7.071067812e-01f, 5.555702330e-01f, 3.826834324e-01f, 1.950903220e-01f};
template <int LOG> __device__ __forceinline__ constexpr int brev(int i) { int r = 0; for (int b = 0; b < LOG; ++b) r |= ((i >> b) & 1) << (LOG - 1 - b); return r; }
template <int R, bool INV> __device__ __forceinline__ void dftR(float2 (&v)[R]) {
    constexpr int LOG = (R == 32) ? 5 : 4;
    float2 t[R];
#pragma unroll
    for (int i = 0; i < R; ++i) t[brev<LOG>(i)] = v[i];
#pragma unroll
    for (int st = 1; st <= LOG; ++st) {
        const int len = 1 << st, half = len >> 1;
#pragma unroll
        for (int i = 0; i < R; i += len)
#pragma unroll
            for (int j = 0; j < half; ++j) {
                const int tw = j * (32 / len);
                const float2 a = t[i + j], b = t[i + j + half];
                float2 bw;
                if (tw == 0) bw = b;
                else if (tw == 8) bw = INV ? make_float2(-b.y, b.x) : make_float2(b.y, -b.x);
                else { const float wr = C32T[tw], wi = INV ? S32T[tw] : -S32T[tw]; bw = make_float2(b.x * wr - b.y * wi, b.x * wi + b.y * wr); }
                t[i + j] = make_float2(a.x + bw.x, a.y + bw.y);
                t[i + j + half] = make_float2(a.x - bw.x, a.y - bw.y);
            }
    }
#pragma unroll
    for (int i = 0; i < R; ++i) v[i] = t[i];
}
template <int R> __device__ __forceinline__ void twiddle_pow(float2 (&v)[R], float2 first, float2 base) {
    float2 w = first;
#pragma unroll
    for (int k = 0; k < R; ++k) { v[k] = cmulf(v[k], w); w = cmulf(w, base); }
}
__device__ __forceinline__ float2 cispi(float x) { float sn, cs; sincospif(x, &sn, &cs); return make_float2(cs, sn); }

__device__ __forceinline__ void fft_fwd_A_B1(float2 (&v)[32], float2* buf, int tid_in) {
    int tid = tid_in; asm volatile("" : "+v"(tid));
    const int a = tid >> 4, b = tid & 15;
    dftR<32, false>(v);
    twiddle_pow<32>(v, make_float2(1.f, 0.f), cispi(-2.f * (float)tid * (1.f / 8192.f)));
#pragma unroll
    for (int k1 = 0; k1 < 32; ++k1) buf[fphys(k1, a, b)] = v[k1];
    __syncthreads();
#pragma unroll 1
    for (int j = 0; j < 2; ++j) {
        const int g = tid + 256 * j, k1 = g >> 4, bb = g & 15;
        float2 w[16];
#pragma unroll
        for (int aa = 0; aa < 16; ++aa) w[aa] = buf[fphys(k1, aa, bb)];
        dftR<16, false>(w);
        twiddle_pow<16>(w, make_float2(1.f, 0.f), cispi(-2.f * (float)bb * (1.f / 256.f)));
#pragma unroll
        for (int ka = 0; ka < 16; ++ka) buf[fphys(k1, ka, bb)] = w[ka];
    }
    __syncthreads();
}
__device__ __forceinline__ void fft_inv_B1_A(float2 (&v)[32], float2* buf, int tid_in) {
    int tid = tid_in; asm volatile("" : "+v"(tid));
#pragma unroll 1
    for (int j = 0; j < 2; ++j) {
        const int g = tid + 256 * j, k1 = g >> 4, bb = g & 15;
        float2 w[16];
#pragma unroll
        for (int ka = 0; ka < 16; ++ka) w[ka] = buf[fphys(k1, ka, bb)];
        dftR<16, true>(w);
        twiddle_pow<16>(w, cispi(2.f * (float)(k1 * bb) * (1.f / 8192.f)), cispi(2.f * (float)k1 * (1.f / 512.f)));
#pragma unroll
        for (int aa = 0; aa < 16; ++aa) buf[fphys(k1, aa, bb)] = w[aa];
    }
    __syncthreads();
    const int a = tid >> 4, b = tid & 15;
#pragma unroll
    for (int k1 = 0; k1 < 32; ++k1) v[k1] = buf[fphys(k1, a, b)];
    dftR<32, true>(v);
}

__device__ void hfft_unit(const P& p, int l, int u, char* lds) {
    const int tid = otid();
    float2* buf = (float2*)lds;
    float* F = (float*)(p.ws + WS_FILTL) + (size_t)u * 8192;
    float2 v[32];
#pragma unroll
    for (int n1 = 0; n1 < 32; ++n1) {
        const int n = 256 * n1 + tid;
        float x;
        if (n1 < 16) x = F[n];
        else x = (n == 4096) ? 0.f : F[4096 + (8192 - n)];
        if (n == 0) x += p.in(I_HY_SKIP)[(size_t)l * 512 + u];
        v[n1] = make_float2(x, 0.f);
    }
    fft_fwd_A_B1(v, buf, tid);
    __half2* H = (__half2*)F;
#pragma unroll 1
    for (int j = 0; j < 2; ++j) {
        const int g = tid + 256 * j, k1 = g >> 4, ka = g & 15;
        float2 w[16];
#pragma unroll
        for (int bb = 0; bb < 16; ++bb) w[bb] = buf[fphys(k1, ka, bb)];
        dftR<16, false>(w);
        unsigned pk[16];
#pragma unroll
        for (int kb = 0; kb < 16; ++kb) { const __half2 h = __floats2half2_rn(w[kb].x, w[kb].y); pk[kb] = *reinterpret_cast<const unsigned*>(&h); }
        uint4* dst = reinterpret_cast<uint4*>(H + (size_t)g * 16);
        dst[0] = make_uint4(pk[0], pk[1], pk[2], pk[3]); dst[1] = make_uint4(pk[4], pk[5], pk[6], pk[7]);
        dst[2] = make_uint4(pk[8], pk[9], pk[10], pk[11]); dst[3] = make_uint4(pk[12], pk[13], pk[14], pk[15]);
    }
    __syncthreads();
}

__device__ void hyena_prep_unit(const P& p, int l, int u, char* lds) {
    const int tid = otid();
    bf16_t* tile = (bf16_t*)lds;
    const int b = u >> 6, t0 = (u & 63) * 64;
    const bf16_t* z = (const bf16_t*)(p.ws + WS_Z) + (size_t)(NTC + b * 4096) * ZS + COL_HY;
    bf16_t* hyT = (bf16_t*)(p.ws + WS_HYT);
    const float* cw = p.in(I_HY_CONV) + (size_t)l * 3 * 768; const float* cb = p.in(I_HY_CONVB) + (size_t)l * 768;
#pragma unroll 1
    for (int part = 0; part < 3; ++part) {
        const int ch = part * 256 + tid;
        const float w0 = cw[ch], w1 = cw[768 + ch], w2 = cw[1536 + ch], bs = cb[ch];
        const bf16_t* zc = z + ch;
        float xm = (t0 > 0) ? bf2f(zc[(size_t)(t0 - 1) * ZS]) : 0.f;
        float x0 = bf2f(zc[(size_t)t0 * ZS]);
#pragma unroll 8
        for (int i = 0; i < 64; ++i) {
            const int t = t0 + i;
            const float xp = (t + 1 < 4096) ? bf2f(zc[(size_t)(t + 1) * ZS]) : 0.f;
            tile[tid * 72 + i] = f2bf(w0 * xm + w1 * x0 + w2 * xp + bs);
            xm = x0; x0 = xp;
        }
        __syncthreads();
#pragma unroll
        for (int k = 0; k < 8; ++k) {
            const int chl = (tid >> 3) + 32 * k, seg = tid & 7;
            const uint4 val = *reinterpret_cast<const uint4*>(tile + chl * 72 + seg * 8);
            *reinterpret_cast<uint4*>(hyT + ((size_t)(b * 3 + part) * 256 + chl) * 4096 + t0 + seg * 8) = val;
        }
        __syncthreads();
    }
}

template <int O>
__device__ __forceinline__ void hyena_conv_pass(const P& p, int c, int bp, int tid, float2 (&v)[32], float2* buf) {
    const bf16_t* hyT = (const bf16_t*)(p.ws + WS_HYT);
#pragma unroll
    for (int j = 16; j < 32; ++j) v[j] = make_float2(0.f, 0.f);
    fft_fwd_A_B1(v, buf, tid);
    const __half2* H = (const __half2*)((const float*)(p.ws + WS_FILTL) + (size_t)(O * 256 + c) * 8192);
    int tm = tid; asm volatile("" : "+v"(tm));
#pragma unroll 1
    for (int j = 0; j < 2; ++j) {
        const int g = tm + 256 * j, k1 = g >> 4, ka = g & 15;
        float2 w[16];
#pragma unroll
        for (int bb = 0; bb < 16; ++bb) w[bb] = buf[fphys(k1, ka, bb)];
        dftR<16, false>(w);
        const uint4* hp = reinterpret_cast<const uint4*>(H + (size_t)g * 16);
        unsigned hk[16];
#pragma unroll
        for (int q = 0; q < 4; ++q) { const uint4 t4 = hp[q]; hk[q * 4] = t4.x; hk[q * 4 + 1] = t4.y; hk[q * 4 + 2] = t4.z; hk[q * 4 + 3] = t4.w; }
#pragma unroll
        for (int kb = 0; kb < 16; ++kb) { const float2 hf = __half22float2(*reinterpret_cast<const __half2*>(&hk[kb])); w[kb] = cmulf(w[kb], hf); }
        dftR<16, true>(w);
        twiddle_pow<16>(w, make_float2(1.f, 0.f), cispi(2.f * (float)ka * (1.f / 256.f)));
#pragma unroll
        for (int bb = 0; bb < 16; ++bb) buf[fphys(k1, ka, bb)] = w[bb];
    }
    __syncthreads();
    fft_inv_B1_A(v, buf, tid);
    asm volatile("" ::: "memory");
    int tq = tid; asm volatile("" : "+v"(tq));
    const bf16_t* g0 = hyT + ((size_t)((bp * 2 + 0) * 3 + O) * 256 + c) * 4096 + tq;
    const bf16_t* g1 = hyT + ((size_t)((bp * 2 + 1) * 3 + O) * 256 + c) * 4096 + tq;
    const float sc = 1.f / 8192.f;
#pragma unroll
    for (int j = 0; j < 16; ++j) {
        const float ga = bf2f(g0[256 * j]) * sc, gb = bf2f(g1[256 * j]) * sc;
        v[j] = make_float2(ga * v[j].x, gb * v[j].y);
    }
    __syncthreads();
}

__device__ void hyena_fft_unit(const P& p, int l, int u, char* lds) {
    const int tid = otid();
    const int c = u >> 2, bp = u & 3;
    float2* buf = (float2*)lds;
    const bf16_t* hyT = (const bf16_t*)(p.ws + WS_HYT);
    bf16_t* cat = (bf16_t*)(p.ws + WS_CAT);
    float2 v[32];
    {
        const bf16_t* v0p = hyT + ((size_t)((bp * 2 + 0) * 3 + 2) * 256 + c) * 4096 + tid;
        const bf16_t* v1p = hyT + ((size_t)((bp * 2 + 1) * 3 + 2) * 256 + c) * 4096 + tid;
#pragma unroll
        for (int j = 0; j < 16; ++j) v[j] = make_float2(bf2f(v0p[256 * j]), bf2f(v1p[256 * j]));
    }
    hyena_conv_pass<0>(p, c, bp, tid, v, buf);
    hyena_conv_pass<1>(p, c, bp, tid, v, buf);
    int tq = tid; asm volatile("" : "+v"(tq));
#pragma unroll
    for (int j = 0; j < 16; ++j) {
        const int t = tq + 256 * j;
        cat[(size_t)(NTC + (bp * 2 + 0) * 4096 + t) * DM + 512 + c] = f2bf(v[j].x);
        cat[(size_t)(NTC + (bp * 2 + 1) * 4096 + t) * DM + 512 + c] = f2bf(v[j].y);
    }
}

__device__ void rwkv_post_unit(const P& p, int l, int u, char* lds) {
    const int tid = otid(), c = tid;
    float* sg = (float*)lds;
    const bf16_t* z = (const bf16_t*)(p.ws + WS_Z);
    const bf16_t* rwp = (const bf16_t*)(p.ws + WS_R1 + R1_RWP);
    const bf16_t* ys = (const bf16_t*)(p.ws + WS_HBY);
    bf16_t* cat = (bf16_t*)(p.ws + WS_CAT);
    const int row0 = u * 32;
#pragma unroll
    for (int i = 0; i < 8; ++i) {
        const int idx = tid + 256 * i, tok = idx >> 6, j = idx & 63;
        sg[idx] = sigm(bf2f(z[(size_t)(row0 + tok) * ZS + 896 + j]));
    }
    __syncthreads();
    float g2r[64];
#pragma unroll
    for (int r = 0; r < 64; ++r) g2r[r] = p.in(I_RW_G2)[(size_t)(l * 64 + r) * 256 + c];
    const float ka = p.in(I_RW_KA)[l * 256 + c], rk = p.in(I_RW_RK)[l * 256 + c];
    const float gng = p.in(I_RW_GNG)[l * 256 + c], gnb = p.in(I_RW_GNB)[l * 256 + c];
#pragma unroll 2
    for (int tok = 0; tok < 32; ++tok) {
        const int row = row0 + tok;
        float g = 0.f;
#pragma unroll
        for (int r = 0; r < 64; r += 4) {
            const float4 x = *reinterpret_cast<const float4*>(sg + tok * 64 + r);
            g += x.x * g2r[r] + x.y * g2r[r + 1] + x.z * g2r[r + 2] + x.w * g2r[r + 3];
        }
        const float y = bf2f(ys[(size_t)row * 256 + c]) + bf2f(ys[(size_t)NT * 256 + (size_t)row * 256 + c]);
        const float mu = wave_sum(y) * (1.f / 64.f);
        const float dv = y - mu;
        const float var = wave_sum(dv * dv) * (1.f / 64.f);
        const float yn = dv * rsqrtf(var + 64e-5f) * gng + gnb;
        const bf16_t* zr = z + (size_t)row * ZS;
        const float r = bf2f(zr[c]), k = bf2f(zr[256 + c]), v = bf2f(zr[512 + c]);
        const float a0 = bf2f(rwp[((size_t)row * 4 + 2) * 256 + c]), a1 = bf2f(rwp[((size_t)row * 4 + 3) * 256 + c]);
        const float kd = k * (1.f + (a0 - 1.f) * ka) + k * (1.f + (a1 - 1.f) * ka);
        const float dot = wave_sum(r * kd * rk);
        cat[(size_t)row * DM + c] = f2bf((yn + dot * v) * g);
    }
    __syncthreads();
}

__device__ void gdn_post_unit(const P& p, int l, int u) {
    const int tid = otid(), c = tid;
    const bf16_t* z = (const bf16_t*)(p.ws + WS_Z);
    const bf16_t* ys = (const bf16_t*)(p.ws + WS_HBY) + (size_t)2 * NT * 256;
    bf16_t* cat = (bf16_t*)(p.ws + WS_CAT);
    const float ng = p.in(I_GD_NORM)[l * 64 + (c & 63)];
    const int row0 = u * 32;
#pragma unroll 4
    for (int tok = 0; tok < 32; ++tok) {
        const int row = row0 + tok;
        const float o = bf2f(ys[(size_t)row * 256 + c]) + bf2f(ys[(size_t)NT * 256 + (size_t)row * 256 + c]);
        const float ms = wave_sum(o * o) * (1.f / 64.f);
        const float zg = bf2f(z[(size_t)row * ZS + COL_GD + 768 + c]);
        cat[(size_t)row * DM + 256 + c] = f2bf(o * rsqrtf(ms + 1e-6f) * ng * siluf(zg));
    }
}

#define NPHASE 22
template <typename F>
__device__ __forceinline__ void strided(int n, F f) { for (int u = blockIdx.x; u < n; u += gridDim.x) f(u); }

__global__ void __launch_bounds__(NTHREADS, 2) fwd_kernel(KP kp) {
    extern __shared__ __attribute__((aligned(16))) char smem[];
    char* lds = smem + LDS_USER;
    {
    const int tid = otid();
    if (tid == 0) *reinterpret_cast<uint4*>(smem) = make_uint4(0u, 0u, 0u, 0u);
    if (tid < 52) { const unsigned long long v = (unsigned long long)kp.in[tid]; ((unsigned*)(smem + 512))[2 * tid] = (unsigned)v; ((unsigned*)(smem + 512))[2 * tid + 1] = (unsigned)(v >> 32); }
    }
    __syncthreads();
    P p; p.tab = (const __attribute__((address_space(3))) unsigned*)(smem + 512); p.out = kp.out; p.ws = kp.ws;
    unsigned* ctl = (unsigned*)(p.ws + WS_CTL);
    XcdBarrier bar = xcd_barrier_post(ctl, (volatile LAS unsigned*)smem);
    const int lo = kp.ph_lo, hi = kp.ph_hi;
#define PHASE_BEGIN(ph) if ((ph) >= lo && (ph) < hi) { if ((ph) > lo) { xcd_barrier(bar); }
#define PHASE_END }
#define LANE_IDS const int tid = otid(); const int wid = tid >> 6, lane = tid & 63, wr = wid >> 1, wc = wid & 1, fr = lane & 15, fq = lane >> 4; (void)wid; (void)lane; (void)wr; (void)wc; (void)fr; (void)fq;

    PHASE_BEGIN(0)
        strided(192 + 64 + 32, [&](int u) {
            if (u < 192) ph0_mod_unit(p, u, lds);
            else if (u < 256) ph0_s5tab_unit(p, u - 192);
            else { const int v = u - 256, ll = v >> 4, t = v & 15;
                   xpose_tile(p.in(I_S5_GLUW) + (size_t)ll * 65536, 256, (bf16_t*)(p.ws + WS_GLUT) + (size_t)ll * 65536, 256, 0, t >> 2, t & 3, lds); }
        });
    PHASE_END

#pragma unroll 1
    for (int l = 0; l < 2; ++l) {
        const int pb = 1 + 10 * l;
        PHASE_BEGIN(pb + 0)
            strided(4352 + 1088 + 768 + 256, [&](int u) {
                if (u < 4352) { if (l == 0) rows_unit<M_INIT>(p, l, u, lds); else rows_unit<M_LN2NEXT>(p, l, u, lds); }
                else if (u < 5440) filt_unit(p, l, u - 4352, lds);
                else if (u < 6208) { const int v = u - 5440; xpose_tile(p.in(I_WIN) + (size_t)l * 1024 * 3024, 3024, (bf16_t*)(p.ws + WS_WINT), 1024, 0, v / 48, v % 48, lds); }
                else { const int v = u - 6208; xpose_tile(p.in(I_WOUT) + (size_t)l * 1024 * 1024, 1024, (bf16_t*)(p.ws + WS_WOUTT), 1024, 0, v >> 4, v & 15, lds); }
            });
        PHASE_END
        PHASE_BEGIN(pb + 1)
            strided(272 * 24, [&](int u) {
                LANE_IDS
                const int mt = u / 24, nt = u % 24;
                f32x4 acc[4][4];
                gemm_tile((const bf16_t*)(p.ws + WS_HBY), DM, mt * 128 + (tid >> 2), mt * 128 + (tid >> 2) + 64,
                          (const bf16_t*)(p.ws + WS_WINT), DM, nt * 128, DM, lds, acc);
                bf16_t* z = (bf16_t*)(p.ws + WS_Z);
#pragma unroll
                for (int m = 0; m < 4; ++m)
#pragma unroll
                    for (int n = 0; n < 4; ++n) {
                        const int col = nt * 128 + wc * 64 + n * 16 + fr;
                        if (col < ZS) {
#pragma unroll
                            for (int j = 0; j < 4; ++j) z[(size_t)(mt * 128 + wr * 64 + m * 16 + fq * 4 + j) * ZS + col] = f2bf(acc[m][n][j]);
                        }
                    }
            });
        PHASE_END
        PHASE_BEGIN(pb + 2)
            strided(512 + 512 + 1088 + 1088 + 4352, [&](int u) {
                if (u < 512) hfft_unit(p, l, u, lds);
                else if (u < 1024) hyena_prep_unit(p, l, u - 512, lds);
                else if (u < 2112) rwkv_prep_unit(p, l, u - 1024, lds);
                else if (u < 3200) gdn_prep_unit(p, l, u - 2112);
                else s5_pre_unit(p, l, u - 3200, lds);
            });
        PHASE_END
        PHASE_BEGIN(pb + 3)
            {
                int* qslot = (int*)(smem + 64);
                const int NU = 256 + 1024 + 544 + 1024;
                for (;;) {
                    if (otid() == 0) *qslot = (int)atomicAdd(&ctl[CW_QUEUE(l) + kp.rep], 1u);
                    __syncthreads();
                    const int u = *qslot;
                    __syncthreads();
                    if (u >= NU) break;
                    if (u < 256) scan_unit(p, l, u, lds);
                    else if (u < 1280) hyena_fft_unit(p, l, u - 256, lds);
                    else if (u < 1824) { if (kp.rep == 0) s5_main_unit(p, l, u - 1280, lds); }
                    else hyena_unit<256>(p, l, u - 1824, lds);
                    __syncthreads();
                }
            }
        PHASE_END
        PHASE_BEGIN(pb + 4)
            strided(1088 + 1088 + 544, [&](int u) {
                if (u < 1088) rwkv_post_unit(p, l, u, lds);
                else if (u < 2176) gdn_post_unit(p, l, u - 1088);
                else {
                    LANE_IDS
                    const int v = u - 2176, mt = v >> 1, nt = v & 1;
                    f32x4 acc[4][4];
                    const bf16_t* A = (const bf16_t*)(p.ws + WS_Z) + COL_S5;
                    gemm_tile(A, ZS, mt * 128 + (tid >> 2), mt * 128 + (tid >> 2) + 64,
                              (const bf16_t*)(p.ws + WS_GLUT) + (size_t)l * 65536, 256, nt * 128, 256, lds, acc);
                    bf16_t* cat = (bf16_t*)(p.ws + WS_CAT);
#pragma unroll
                    for (int m = 0; m < 4; ++m)
#pragma unroll
                        for (int n = 0; n < 4; ++n) {
                            const int col = nt * 128 + wc * 64 + n * 16 + fr;
                            const float gb = p.in(I_S5_GLUB)[l * 256 + col];
#pragma unroll
                            for (int j = 0; j < 4; ++j) {
                                const int row = mt * 128 + wr * 64 + m * 16 + fq * 4 + j;
                                const float yg = bf2f(A[(size_t)row * ZS + col]);
                                cat[(size_t)row * DM + 768 + col] = f2bf(yg * sigm(acc[m][n][j] + gb));
                            }
                        }
                }
            });
        PHASE_END
        PHASE_BEGIN(pb + 5)
            strided(272 * 8 + 65 * 192, [&](int u) {
                if (u < 2176) {
                    LANE_IDS
                    const int mt = u >> 3, nt = u & 7;
                    f32x4 acc[4][4];
                    gemm_tile((const bf16_t*)(p.ws + WS_CAT), DM, mt * 128 + (tid >> 2), mt * 128 + (tid >> 2) + 64,
                              (const bf16_t*)(p.ws + WS_WOUTT), DM, nt * 128, DM, lds, acc);
#pragma unroll
                    for (int m = 0; m < 4; ++m)
#pragma unroll
                        for (int j = 0; j < 4; ++j) {
                            const int row = mt * 128 + wr * 64 + m * 16 + fq * 4 + j;
                            float* xr = xrow(p, row);
                            const float* ga = modp(p, l, row_mod(row), 2);
#pragma unroll
                            for (int n = 0; n < 4; ++n) {
                                const int col = nt * 128 + wc * 64 + n * 16 + fr;
                                xr[col] = ALPHA * xr[col] + ga[col] * acc[m][n][j];
                            }
                        }
                } else {
                    const int v = u - 2176, e = v / 192, t = v % 192, which = t >> 6, tt = t & 63;
                    bf16_t* W13 = (bf16_t*)(p.ws + WS_R1 + R1_W13T) + (size_t)e * 512 * 1024;
                    bf16_t* W2 = (bf16_t*)(p.ws + WS_R1 + R1_W2T) + (size_t)e * 1024 * 256;
                    if (which == 0) {
                        const float* src = (e < 64) ? p.in(I_EX_W1) + ((size_t)l * 64 + e) * 262144 : p.in(I_SH_W1) + (size_t)l * 262144;
                        xpose_tile(src, 256, W13, 1024, 1, tt >> 2, tt & 3, lds);
                    } else if (which == 1) {
                        const float* src = (e < 64) ? p.in(I_EX_W3) + ((size_t)l * 64 + e) * 262144 : p.in(I_SH_W3) + (size_t)l * 262144;
                        xpose_tile(src, 256, W13, 1024, 2, tt >> 2, tt & 3, lds);
                    } else {
                        const float* src = (e < 64) ? p.in(I_EX_W2) + ((size_t)l * 64 + e) * 262144 : p.in(I_SH_W2) + (size_t)l * 262144;
                        xpose_tile(src, 1024, W2, 256, 0, tt >> 4, tt & 15, lds);
                    }
                }
            });
        PHASE_END
        PHASE_BEGIN(pb + 6)
            strided(4352, [&](int u) { rows_unit<M_LN1>(p, l, u, lds); __syncthreads(); });
        PHASE_END
        PHASE_BEGIN(pb + 7)
            {
                int* tb = (int*)lds;
                const int tid = otid();
                const unsigned* cnt = ctl + CW_CNT(l);
                if (tid == 0) { int a = 0; for (int e = 0; e < 64; ++e) { tb[e] = a; a += ((int)xb_ld((unsigned*)&cnt[e]) + 127) >> 7; } tb[64] = a; }
                __syncthreads();
                const int* aep = (const int*)(p.ws + WS_AEP); const float* aw = (const float*)(p.ws + WS_AW);
                int* rtok = (int*)(p.ws + WS_RTOK); float* rwt = (float*)(p.ws + WS_RW); int* tile_e = (int*)(p.ws + WS_TILEE);
                for (int a = blockIdx.x * NTHREADS + tid; a < NT * 8; a += gridDim.x * NTHREADS) {
                    const unsigned v = (unsigned)aep[a];
                    const int e = v >> 24, pos = v & 0xFFFFFF;
                    const int dest = tb[e] * 128 + pos;
                    rtok[dest] = a >> 3; rwt[dest] = aw[a];
                }
                for (int e = blockIdx.x; e < 64; e += gridDim.x) {
                    const int c0 = (int)xb_ld((unsigned*)&cnt[e]), nt_e = (c0 + 127) >> 7;
                    for (int q = c0 + tid; q < nt_e * 128; q += NTHREADS) { rtok[tb[e] * 128 + q] = -1; rwt[tb[e] * 128 + q] = 0.f; }
                    for (int q = tid; q < nt_e; q += NTHREADS) tile_e[tb[e] + q] = e;
                }
                __syncthreads();
            }
        PHASE_END
        PHASE_BEGIN(pb + 8)
            {
                int* sh = (int*)(smem + 128);
                if (otid() == 0) { const unsigned* cnt = ctl + CW_CNT(l); int a = 0; for (int e = 0; e < 64; ++e) a += ((int)xb_ld((unsigned*)&cnt[e]) + 127) >> 7; *sh = a; }
                __syncthreads();
                const int ntr = *sh;
                const int* rtok = (const int*)(p.ws + WS_RTOK); const int* tile_e = (const int*)(p.ws + WS_TILEE);
                strided((ntr + 272) * 4, [&](int u) {
                    LANE_IDS
                    const int tile = u >> 2, jn = u & 3;
                    int e, ra, rb, obase;
                    if (tile < ntr) {
                        e = tile_e[tile]; obase = tile * 128;
                        ra = rtok[obase + (tid >> 2)]; rb = rtok[obase + (tid >> 2) + 64];
                        ra = ra < 0 ? 0 : ra; rb = rb < 0 ? 0 : rb;
                    } else {
                        const int stt = tile - ntr; e = 64; obase = (SH_TILE_BASE + stt) * 128;
                        ra = stt * 128 + (tid >> 2); rb = ra + 64;
                    }
                    f32x4 acc[4][4];
                    gemm_tile((const bf16_t*)(p.ws + WS_HBY), DM, ra, rb,
                              (const bf16_t*)(p.ws + WS_R1 + R1_W13T) + (size_t)e * 512 * 1024, DM, jn * 128, DM, lds, acc);
                    bf16_t* act = (bf16_t*)(p.ws + WS_Z);
#pragma unroll
                    for (int m = 0; m < 4; ++m)
#pragma unroll
                        for (int pp = 0; pp < 2; ++pp)
#pragma unroll
                            for (int j = 0; j < 4; ++j) {
                                const float g = acc[m][2 * pp][j], uu = acc[m][2 * pp + 1][j];
                                const int orow = obase + wr * 64 + m * 16 + fq * 4 + j;
                                const int col = jn * 64 + wc * 32 + pp * 16 + fr;
                                act[(size_t)orow * 256 + col] = f2bf(siluf(g) * uu);
                            }
                });
            }
        PHASE_END
        PHASE_BEGIN(pb + 9)
            {
                int* sh = (int*)(smem + 128);
                if (otid() == 0) { const unsigned* cnt = ctl + CW_CNT(l); int a = 0; for (int e = 0; e < 64; ++e) a += ((int)xb_ld((unsigned*)&cnt[e]) + 127) >> 7; *sh = a; }
                __syncthreads();
                const int ntr = *sh;
                const int* rtok = (const int*)(p.ws + WS_RTOK); const float* rwt = (const float*)(p.ws + WS_RW); const int* tile_e = (const int*)(p.ws + WS_TILEE);
                strided((ntr + 272) * 8, [&](int u) {
                    LANE_IDS
                    const int tile = u >> 3, nt = u & 7;
                    int e, obase;
                    if (tile < ntr) { e = tile_e[tile]; obase = tile * 128; }
                    else { e = 64; obase = (SH_TILE_BASE + tile - ntr) * 128; }
                    f32x4 acc[4][4];
                    gemm_tile((const bf16_t*)(p.ws + WS_Z), 256, obase + (tid >> 2), obase + (tid >> 2) + 64,
                              (const bf16_t*)(p.ws + WS_R1 + R1_W2T) + (size_t)e * 1024 * 256, 256, nt * 128, 256, lds, acc);
#pragma unroll
                    for (int m = 0; m < 4; ++m)
#pragma unroll
                        for (int j = 0; j < 4; ++j) {
                            const int orl = wr * 64 + m * 16 + fq * 4 + j;
                            int tok; float wgt;
                            if (tile < ntr) { tok = rtok[obase + orl]; wgt = rwt[obase + orl]; }
                            else { tok = (tile - ntr) * 128 + orl; wgt = 1.f; }
                            if (tok >= 0) {
                                float* xr = xrow(p, tok);
                                const float* ga = modp(p, l, row_mod(tok), 5);
#pragma unroll
                                for (int n = 0; n < 4; ++n) {
                                    const int col = nt * 128 + wc * 64 + n * 16 + fr;
                                    unsafeAtomicAdd(xr + col, ga[col] * wgt * acc[m][n][j]);
                                }
                            }
                        }
                });
            }
        PHASE_END
    }
    PHASE_BEGIN(21)
        strided(4352, [&](int u) { rows_unit<M_FINAL>(p, 1, u, lds); });
    PHASE_END
}

#ifndef N_LAUNCH_MODE
#define N_LAUNCH_MODE 1
#endif
extern "C" void kernel_launch(void* const* d_in, const int* in_sizes, int n_in, void* d_out, int out_size, void* d_ws, size_t ws_size, hipStream_t stream) {
    static int grid = 0;
    if (grid == 0) {
        if (n_in != 52 || out_size != NTL * DM || ws_size < WS_END) { fprintf(stderr, "kernel_launch: unexpected shapes (n_in %d out %d ws %zu need %zu)\n", n_in, out_size, ws_size, (size_t)WS_END); grid = -1; return; }
        int dev = 0, cus = 0, per_cu = 0;
        hipGetDevice(&dev);
        hipDeviceGetAttribute(&cus, hipDeviceAttributeMultiprocessorCount, dev);
        hipFuncSetAttribute((const void*)fwd_kernel, hipFuncAttributeMaxDynamicSharedMemorySize, LDS_BYTES);
        hipOccupancyMaxActiveBlocksPerMultiprocessor(&per_cu, (const void*)fwd_kernel, NTHREADS, LDS_BYTES);
        (void)hipGetLastError();
        if (per_cu < 1) per_cu = 1;
        if (per_cu > 2) per_cu = 2;
        grid = cus * per_cu;
    }
    if (grid < 0) return;
    hipMemsetAsync((char*)d_ws + WS_CTL, 0, CTL_BYTES, stream);
    KP p{};
    for (int i = 0; i < 52; ++i) p.in[i] = (const float*)d_in[i];
    p.out = (float*)d_out; p.ws = (char*)d_ws;
#if defined(PROBE_PH)
    for (int ph = 0; ph < NPHASE; ++ph) {
        const int reps = (ph == PROBE_PH) ? 1 + PROBE_N : 1;
        for (int r = 0; r < reps; ++r) { p.ph_lo = ph; p.ph_hi = ph + 1; p.rep = r; hipLaunchKernelGGL(fwd_kernel, dim3(grid), dim3(NTHREADS), LDS_BYTES, stream, p); }
    }
#elif N_LAUNCH_MODE == 1
    p.ph_lo = 0; p.ph_hi = NPHASE;
    hipLaunchKernelGGL(fwd_kernel, dim3(grid), dim3(NTHREADS), LDS_BYTES, stream, p);
#else
    for (int ph = 0; ph < NPHASE; ++ph) {
        p.ph_lo = ph; p.ph_hi = ph + 1;
        hipLaunchKernelGGL(fwd_kernel, dim3(grid), dim3(NTHREADS), LDS_BYTES, stream, p);
    }
#endif
}
```

```cpp
#include <hip/hip_runtime.h>
#include <hip/hip_bf16.h>
#include <hip/hip_fp16.h>
#include <stdint.h>
#include <stdio.h>

typedef unsigned short bf16_t;
using bf16x8 = __attribute__((ext_vector_type(8))) short;
using f32x4 = __attribute__((ext_vector_type(4))) float;

#define NTC 2048
#define NTL 32768
#define NT 34816
#define DM 1024
#define ZS 3024
#define COL_GD 960
#define COL_HY 2000
#define COL_S5 2768
#define NCHUNK 68
#define ALPHA 1.41421356237f
#define NTHREADS 256
#define LDS_BYTES 73728
#define LDS_USER 1024
#define SH_TILE_BASE 2240
#define ACT_ROWS ((SH_TILE_BASE + 272) * 128)

constexpr size_t al256(size_t x) { return (x + 255) & ~(size_t)255; }
constexpr size_t WS_CTL = 0;
constexpr size_t CTL_BYTES = 65536;
constexpr size_t WS_MOD = WS_CTL + CTL_BYTES;
constexpr size_t WS_S5A = al256(WS_MOD + 2 * 9 * 6144 * 4);
constexpr size_t WS_S5B = al256(WS_S5A + 2 * 2 * 16 * 64 * 4 * 4);
constexpr size_t WS_GLUT = al256(WS_S5B + 2 * 2 * 16 * 64 * 32 * 4);
constexpr size_t WS_WINT = al256(WS_GLUT + 2 * 256 * 256 * 2);
constexpr size_t WS_WOUTT = al256(WS_WINT + (size_t)3072 * 1024 * 2);
constexpr size_t WS_FILTL = al256(WS_WOUTT + (size_t)1024 * 1024 * 2);
constexpr size_t WS_FILTC = al256(WS_FILTL + (size_t)4 * 256 * 4096 * 4);
constexpr size_t WS_XC = al256(WS_FILTC + (size_t)4 * 256 * 256 * 4);
constexpr size_t WS_HBY = al256(WS_XC + (size_t)NTC * DM * 4);
constexpr size_t WS_CAT = al256(WS_HBY + (size_t)NT * DM * 2);
constexpr size_t WS_Z = al256(WS_CAT + (size_t)NT * DM * 2);
constexpr size_t WS_R1 = al256(WS_Z + (size_t)NT * ZS * 2);
constexpr size_t R1_RWP = 0;
constexpr size_t R1_GQ = (size_t)NT * 1024 * 2;
constexpr size_t R1_W13T = 0;
constexpr size_t R1_W2T = (size_t)65 * 512 * 1024 * 2;
constexpr size_t R1_BYTES = (size_t)NT * 1024 * 2 + (size_t)NT * 768 * 2;
constexpr size_t WS_KNORM = al256(WS_R1 + R1_BYTES);
constexpr size_t WS_GAB = al256(WS_KNORM + (size_t)NT * 4 * 4);
constexpr size_t WS_S5ST = al256(WS_GAB + (size_t)NT * 16 * 4);
constexpr size_t WS_AEP = al256(WS_S5ST + (size_t)8 * 68 * 2 * 16 * 64 * 2 * 4);
constexpr size_t WS_AW = al256(WS_AEP + (size_t)NT * 8 * 4);
constexpr size_t WS_RTOK = al256(WS_AW + (size_t)NT * 8 * 4);
constexpr size_t WS_RW = al256(WS_RTOK + (size_t)SH_TILE_BASE * 128 * 4);
constexpr size_t WS_TILEE = al256(WS_RW + (size_t)SH_TILE_BASE * 128 * 4);
constexpr size_t WS_HYT = al256(WS_TILEE + SH_TILE_BASE * 4);
constexpr size_t WS_END = al256(WS_HYT + (size_t)8 * 768 * 4096 * 2);
static_assert(R1_W2T + (size_t)65 * 1024 * 256 * 2 <= R1_BYTES, "expert weights must fit R1");
constexpr size_t ACT_BYTES = (size_t)ACT_ROWS * 256 * 2;
constexpr size_t WS_ACT = WS_Z + ((((size_t)NT * ZS * 2 - ACT_BYTES) >> 8) << 8);
constexpr size_t WS_Y2 = WS_HBY;
static_assert(WS_Y2 + ACT_BYTES <= WS_ACT, "y2 must not reach act");

#define CW_QUEUE(l) (4096 + 64 * (l))
#define CW_CNT(l) (4352 + 64 * (l))

#define XB_TMO      128
#define XB_XCNT(j)  (256  + 64 * (j))
#define XB_XSUB(j)  (1280 + 64 * (j))
#define XB_XGEN(j)  (2304 + 64 * (j))
#define XB_TOP      3328
#define XB_TOPGEN   3392
#define XCD_BAR_WORDS 3456
#define XB_SPIN_CAP (1u << 18)
#define LAS __attribute__((address_space(3)))

__device__ __forceinline__ unsigned xb_ld(unsigned* p)              { return __hip_atomic_load(p, __ATOMIC_RELAXED, __HIP_MEMORY_SCOPE_AGENT); }
__device__ __forceinline__ unsigned xb_add(unsigned* p, unsigned v) { return __hip_atomic_fetch_add(p, v, __ATOMIC_RELAXED, __HIP_MEMORY_SCOPE_AGENT); }
__device__ __forceinline__ unsigned xb_xcc_id() { return (unsigned)__builtin_amdgcn_s_getreg((3 << 11) | 20) & 0xFu; }
#define XB_SPIN(cond, bar) do { unsigned _sp = 0; while (cond) { __builtin_amdgcn_s_sleep(1); \
    if ((++_sp & 255u) == 0u) { if (xb_ld(&(bar)[XB_TMO])) break; if (_sp > XB_SPIN_CAP) { atomicAdd(&(bar)[XB_TMO], 1u); break; } } } } while (0)

struct XcdBarrier {
    unsigned* bar; unsigned x;
    volatile LAS unsigned* st;
};
__device__ __forceinline__ XcdBarrier xcd_barrier_post(unsigned* bar, volatile LAS unsigned* st) {
    XcdBarrier b; b.bar = bar; b.x = xb_xcc_id(); b.st = st;
    if (threadIdx.x == 0) (void)xb_add(&bar[XB_XCNT(b.x)], 1u);
    return b;
}
__device__ __forceinline__ void xcd_barrier_complete(unsigned* bar, unsigned x, unsigned& nloc, unsigned& nx) {
    const unsigned G = gridDim.x * gridDim.y * gridDim.z;
    unsigned sum, cnt, mine, sp = 0u;
    for (;;) {
        sum = 0u; cnt = 0u; mine = 0u;
#pragma unroll
        for (unsigned j = 0; j < 16; ++j) { const unsigned c = xb_ld(&bar[XB_XCNT(j)]); sum += c; cnt += (c > 0u) ? 1u : 0u; mine = (j == x) ? c : mine; }
        if (sum == G) break;
        __builtin_amdgcn_s_sleep(1);
        if ((++sp & 255u) == 0u) { if (xb_ld(&bar[XB_TMO])) break; if (sp > XB_SPIN_CAP) { atomicAdd(&bar[XB_TMO], 1u); break; } }
    }
    nloc = mine > 0u ? mine : 1u; nx = cnt > 0u ? cnt : 1u;
}
__device__ __forceinline__ void xcd_barrier(const XcdBarrier& b) {
    asm volatile("s_waitcnt vmcnt(0)" ::: "memory");
    __syncthreads();
    if (threadIdx.x == 0) {
        unsigned* bar = b.bar;
        __builtin_amdgcn_s_waitcnt(0);
        unsigned nloc = b.st[0], nx = b.st[1];
        if (nloc == 0u) { xcd_barrier_complete(bar, b.x, nloc, nx); b.st[0] = nloc; b.st[1] = nx; }
        const unsigned old = xb_add(&bar[XB_XSUB(b.x)], 1u);
        const unsigned gen = old / nloc;
        if (old + 1u == (gen + 1u) * nloc) {
            __builtin_amdgcn_fence(__ATOMIC_RELEASE, "agent");
            asm volatile("s_waitcnt vmcnt(0)" ::: "memory");
            const unsigned og = xb_add(&bar[XB_TOP], 1u);
            const unsigned tg = og / nx;
            if (og + 1u == (tg + 1u) * nx) xb_add(&bar[XB_TOPGEN], 1u);
            else XB_SPIN(xb_ld(&bar[XB_TOPGEN]) == tg, bar);
            __builtin_amdgcn_fence(__ATOMIC_ACQUIRE, "agent");
            xb_add(&bar[XB_XGEN(b.x)], 1u);
            asm volatile("s_waitcnt vmcnt(0)" ::: "memory");
        } else {
            XB_SPIN(xb_ld(&bar[XB_XGEN(b.x)]) == gen, bar);
            __builtin_amdgcn_fence(__ATOMIC_ACQUIRE, "agent");
            asm volatile("s_waitcnt vmcnt(0)" ::: "memory");
        }
    }
    __syncthreads();
}

struct KP {
    const float* in[52];
    float* out;
    char* ws;
    int ph_lo, ph_hi, rep, pad_;
};
struct P {
    const __attribute__((address_space(3))) unsigned* tab;
    float* out;
    char* ws;
    __device__ __forceinline__ const float* in(int i) const {
        const unsigned lo = __builtin_amdgcn_readfirstlane(tab[2 * i]);
        const unsigned hi = __builtin_amdgcn_readfirstlane(tab[2 * i + 1]);
        return (const float*)(((unsigned long long)hi << 32) | (unsigned long long)lo);
    }
};
enum { I_X = 0, I_C, I_CTX, I_CCTX, I_ADAW, I_ADAB, I_WIN, I_WOUT, I_LNG, I_LNB,
       I_RW_W0, I_RW_W2, I_RW_A0, I_RW_A2, I_RW_G2, I_RW_KK, I_RW_KA, I_RW_RK, I_RW_GNG, I_RW_GNB,
       I_GD_CONV, I_GD_ALOG, I_GD_DTB, I_GD_NORM,
       I_HY_CONV, I_HY_CONVB, I_HY_W1, I_HY_B1, I_HY_F1, I_HY_W2, I_HY_B2, I_HY_F2, I_HY_W3, I_HY_SKIP,
       I_S5_LRE, I_S5_LIM, I_S5_LOGSTEP, I_S5_BRE, I_S5_BIM, I_S5_CRE, I_S5_CIM, I_S5_D, I_S5_GLUW, I_S5_GLUB,
       I_ROUTER_W, I_ROUTER_B, I_EX_W1, I_EX_W3, I_EX_W2, I_SH_W1, I_SH_W3, I_SH_W2 };

__device__ __forceinline__ bf16_t f2bf(float f) { unsigned u = __float_as_uint(f); u += 0x7fffu + ((u >> 16) & 1u); return (bf16_t)(u >> 16); }
__device__ __forceinline__ float bf2f(bf16_t h) { return __uint_as_float(((unsigned)h) << 16); }
__device__ __forceinline__ float bflo(unsigned u) { return __uint_as_float(u << 16); }
__device__ __forceinline__ float bfhi(unsigned u) { return __uint_as_float(u & 0xffff0000u); }
__device__ __forceinline__ unsigned pack2(float a, float b) { return (unsigned)f2bf(a) | ((unsigned)f2bf(b) << 16); }
__device__ __forceinline__ float sigm(float x) { return 1.f / (1.f + __expf(-x)); }
__device__ __forceinline__ float siluf(float x) { return x / (1.f + __expf(-x)); }
__device__ __forceinline__ float softplusf(float x) { return fmaxf(x, 0.f) + log1pf(__expf(-fabsf(x))); }
__device__ __forceinline__ float wave_sum(float v) {
#pragma unroll
    for (int o = 32; o >= 1; o >>= 1) v += __shfl_xor(v, o);
    return v;
}
template <int CTRL> __device__ __forceinline__ float dppf(float v) {
    return __int_as_float(__builtin_amdgcn_update_dpp(0, __float_as_int(v), CTRL, 0xF, 0xF, true));
}
__device__ __forceinline__ int otid() { int t = threadIdx.x; asm volatile("" : "+v"(t)); return t; }
__device__ __forceinline__ float* xrow(const P& p, int row) {
    return row < NTC ? (float*)(p.ws + WS_XC) + (size_t)row * DM : p.out + (size_t)(row - NTC) * DM;
}
__device__ __forceinline__ int row_mod(int row) { return row < NTC ? 8 : ((row - NTC) >> 12); }
__device__ __forceinline__ const float* modp(const P& p, int l, int r, int chunk) {
    return (const float*)(p.ws + WS_MOD) + ((size_t)(l * 9 + r) * 6144 + chunk * 1024);
}

__device__ __forceinline__ void gemm_tile(const bf16_t* __restrict__ A, int lda, int arow_a, int arow_b,
                                          const bf16_t* __restrict__ Bt, int ldb, int brow0, int K,
                                          char* lds, f32x4 (&acc)[4][4]) {
    const int tid = otid();
    const int wid = tid >> 6, lane = tid & 63, wr = wid >> 1, wc = wid & 1, fr = lane & 15, fq = lane >> 4;
    char* SA = lds; char* SB = lds + 8192;
    const int c8 = (tid & 3) * 8;
    const bf16_t* a0 = A + (size_t)arow_a * lda + c8;
    const bf16_t* a1 = A + (size_t)arow_b * lda + c8;
    const bf16_t* b0 = Bt + (size_t)(brow0 + (tid >> 2)) * ldb + c8;
    const bf16_t* b1 = Bt + (size_t)(brow0 + (tid >> 2) + 64) * ldb + c8;
#pragma unroll
    for (int m = 0; m < 4; ++m)
#pragma unroll
        for (int n = 0; n < 4; ++n) acc[m][n] = f32x4{0.f, 0.f, 0.f, 0.f};
    const int nk = K >> 5;
    for (int t = 0; t < nk; ++t) {
        const int ko = t * 32;
        __builtin_amdgcn_global_load_lds((const void*)(a0 + ko), (LAS void*)(SA + tid * 16), 16, 0, 0);
        __builtin_amdgcn_global_load_lds((const void*)(a1 + ko), (LAS void*)(SA + tid * 16 + 4096), 16, 0, 0);
        __builtin_amdgcn_global_load_lds((const void*)(b0 + ko), (LAS void*)(SB + tid * 16), 16, 0, 0);
        __builtin_amdgcn_global_load_lds((const void*)(b1 + ko), (LAS void*)(SB + tid * 16 + 4096), 16, 0, 0);
        asm volatile("s_waitcnt vmcnt(0)" ::: "memory");
        __syncthreads();
        bf16x8 af[4], bfr[4];
#pragma unroll
        for (int m = 0; m < 4; ++m) af[m] = *reinterpret_cast<const bf16x8*>(SA + (wr * 64 + m * 16 + fr) * 64 + fq * 16);
#pragma unroll
        for (int n = 0; n < 4; ++n) bfr[n] = *reinterpret_cast<const bf16x8*>(SB + (wc * 64 + n * 16 + fr) * 64 + fq * 16);
#pragma unroll
        for (int m = 0; m < 4; ++m)
#pragma unroll
            for (int n = 0; n < 4; ++n) acc[m][n] = __builtin_amdgcn_mfma_f32_16x16x32_bf16(af[m], bfr[n], acc[m][n], 0, 0, 0);
        __syncthreads();
    }
}

__device__ __forceinline__ void ph0_mod_unit(const P& p, int u, char* lds) {
    const int l = u / 96, cg = u % 96, tid = otid();
    float* s = (float*)lds;
    float* red = s + 9 * 1024;
    const float* c = p.in(I_C); const float* cctx = p.in(I_CCTX);
    for (int i = tid; i < 9 * 1024; i += NTHREADS) { int r = i >> 10, k = i & 1023; float v = r < 8 ? c[r * 1024 + k] : cctx[k]; s[i] = v / (1.f + expf(-v)); }
    __syncthreads();
    const int kq = tid >> 6, j = tid & 63, col = cg * 64 + j;
    const float* w = p.in(I_ADAW) + (size_t)l * 1024 * 6144 + col;
    float acc[9];
#pragma unroll
    for (int r = 0; r < 9; ++r) acc[r] = 0.f;
#pragma unroll 4
    for (int k = kq * 256; k < kq * 256 + 256; ++k) {
        const float wv = w[(size_t)k * 6144];
#pragma unroll
        for (int r = 0; r < 9; ++r) acc[r] += s[r * 1024 + k] * wv;
    }
#pragma unroll
    for (int r = 0; r < 9; ++r) red[(kq * 9 + r) * 64 + j] = acc[r];
    __syncthreads();
    if (tid < 64) {
        float* mod = (float*)(p.ws + WS_MOD);
        const float bb = p.in(I_ADAB)[l * 6144 + col];
#pragma unroll
        for (int r = 0; r < 9; ++r) mod[(size_t)(l * 9 + r) * 6144 + col] = red[r * 64 + j] + red[(9 + r) * 64 + j] + red[(18 + r) * 64 + j] + red[(27 + r) * 64 + j] + bb;
    }
    __syncthreads();
}

__device__ __forceinline__ void ph0_s5tab_unit(const P& p, int u) {
    const int tid = otid();
    if (tid >= 64) return;
    const int ldg = u;
    const int idx = ldg * 64 + tid;
    const double lre = (double)p.in(I_S5_LRE)[idx], lim = (double)p.in(I_S5_LIM)[idx];
    const double dt = (double)expf(p.in(I_S5_LOGSTEP)[ldg]);
    const float mag = expf((float)(lre * dt));
    double rev = lim * dt * 0.15915494309189535; rev -= floor(rev);
    float sn, cs; sincospif(2.f * (float)rev, &sn, &cs);
    const double abr = (double)(mag * cs), abi = (double)(mag * sn);
    const double den = lre * lre + lim * lim;
    const double cor = ((abr - 1.0) * lre + abi * lim) / den;
    const double coi = (abi * lre - (abr - 1.0) * lim) / den;
    const float m64f = expf((float)(64.0 * lre * dt));
    double rev64 = 64.0 * lim * dt * 0.15915494309189535; rev64 -= floor(rev64);
    float sn64, cs64; sincospif(2.f * (float)rev64, &sn64, &cs64);
    float* A = (float*)(p.ws + WS_S5A) + (size_t)idx * 4;
    A[0] = (float)abr; A[1] = (float)abi; A[2] = m64f * cs64; A[3] = m64f * sn64;
    float* B = (float*)(p.ws + WS_S5B) + (size_t)idx * 32;
    const float* bre = p.in(I_S5_BRE) + (size_t)idx * 16; const float* bim = p.in(I_S5_BIM) + (size_t)idx * 16;
#pragma unroll
    for (int h = 0; h < 16; ++h) {
        const double br = bre[h], bi = bim[h];
        B[h] = (float)(cor * br - coi * bi);
        B[16 + h] = (float)(cor * bi + coi * br);
    }
}

__device__ __forceinline__ int xmap(int mode, int c) {
    if (mode == 0) return c;
    const int j = c >> 6, cc = c & 63, wc = cc >> 5, pp = (cc & 31) >> 4, i = cc & 15;
    return j * 128 + wc * 64 + pp * 32 + i + (mode == 2 ? 16 : 0);
}
__device__ __forceinline__ void xpose_tile(const float* __restrict__ src, int C, bf16_t* __restrict__ dst, int ldd, int mode, int tr, int tc, char* lds) {
    float* t = (float*)lds;
    const int tid = otid(), tx = tid & 63, ty = tid >> 6;
#pragma unroll
    for (int k = 0; k < 16; ++k) {
        const int rr = ty + 4 * k, r = tr * 64 + rr, c = tc * 64 + tx;
        t[rr * 65 + tx] = (c < C) ? src[(size_t)r * C + c] : 0.f;
    }
    __syncthreads();
#pragma unroll
    for (int k = 0; k < 16; ++k) {
        const int ci = ty + 4 * k, c = tc * 64 + ci;
        dst[(size_t)xmap(mode, c) * ldd + tr * 64 + tx] = f2bf(t[tx * 65 + ci]);
    }
    __syncthreads();
}

enum { M_INIT = 0, M_LN2NEXT = 1, M_LN1 = 2, M_FINAL = 3 };

template <int MODE>
__device__ __forceinline__ void rows_unit(const P& p, int l, int u, char* lds, bool dry = false) {
    const int tid = otid(), w = tid >> 6, lane = tid & 63;
    float* hbuf = (float*)lds;
    bf16_t* hb = (bf16_t*)(p.ws + WS_HBY);
#pragma unroll 1
    for (int rr = 0; rr < 2; ++rr) {
        const int rl = w * 2 + rr, row = u * 8 + rl;
        const int mr = row_mod(row);
        float v[16];
        float* xr = xrow(p, row);
        const float* src = (MODE == M_INIT) ? (row < NTC ? p.in(I_CTX) + (size_t)row * DM : p.in(I_X) + (size_t)(row - NTC) * DM) : xr;
#pragma unroll
        for (int i = 0; i < 4; ++i) {
            const float4 t = *reinterpret_cast<const float4*>(src + i * 256 + lane * 4);
            v[i * 4 + 0] = t.x; v[i * 4 + 1] = t.y; v[i * 4 + 2] = t.z; v[i * 4 + 3] = t.w;
        }
        if (MODE != M_INIT) {
            const int ll = (MODE == M_LN2NEXT) ? l - 1 : l;
            const int which = (MODE == M_LN1) ? 0 : 1;
            float s = 0.f;
#pragma unroll
            for (int i = 0; i < 16; ++i) s += v[i];
            const float mu = wave_sum(s) * (1.f / 1024.f);
            float q = 0.f;
#pragma unroll
            for (int i = 0; i < 16; ++i) { const float d = v[i] - mu; q += d * d; }
            const float rstd = rsqrtf(wave_sum(q) * (1.f / 1024.f) + 1e-5f);
            const float* g = p.in(I_LNG) + (size_t)(ll * 2 + which) * 1024;
            const float* bb = p.in(I_LNB) + (size_t)(ll * 2 + which) * 1024;
#pragma unroll
            for (int i = 0; i < 4; ++i) {
                const float4 gg = *reinterpret_cast<const float4*>(g + i * 256 + lane * 4);
                const float4 b4 = *reinterpret_cast<const float4*>(bb + i * 256 + lane * 4);
                v[i * 4 + 0] = (v[i * 4 + 0] - mu) * rstd * gg.x + b4.x;
                v[i * 4 + 1] = (v[i * 4 + 1] - mu) * rstd * gg.y + b4.y;
                v[i * 4 + 2] = (v[i * 4 + 2] - mu) * rstd * gg.z + b4.z;
                v[i * 4 + 3] = (v[i * 4 + 3] - mu) * rstd * gg.w + b4.w;
            }
        }
        if (MODE == M_FINAL) {
            if (row >= NTC) {
#pragma unroll
                for (int i = 0; i < 4; ++i) *reinterpret_cast<float4*>(xr + i * 256 + lane * 4) = make_float4(v[i * 4], v[i * 4 + 1], v[i * 4 + 2], v[i * 4 + 3]);
            }
            continue;
        }
        const float osc = (MODE == M_LN1) ? ALPHA : 1.f;
#pragma unroll
        for (int i = 0; i < 4; ++i) if (!dry) *reinterpret_cast<float4*>(xr + i * 256 + lane * 4) = make_float4(osc * v[i * 4], osc * v[i * 4 + 1], osc * v[i * 4 + 2], osc * v[i * 4 + 3]);
        const float* sh = modp(p, l, mr, (MODE == M_LN1) ? 3 : 0);
        const float* sc = modp(p, l, mr, (MODE == M_LN1) ? 4 : 1);
#pragma unroll
        for (int i = 0; i < 4; ++i) {
            const float4 s4 = *reinterpret_cast<const float4*>(sc + i * 256 + lane * 4);
            const float4 h4 = *reinterpret_cast<const float4*>(sh + i * 256 + lane * 4);
            const float h0 = v[i * 4 + 0] * (1.f + s4.x) + h4.x, h1 = v[i * 4 + 1] * (1.f + s4.y) + h4.y;
            const float h2 = v[i * 4 + 2] * (1.f + s4.z) + h4.z, h3 = v[i * 4 + 3] * (1.f + s4.w) + h4.w;
            uint2 pk; pk.x = pack2(h0, h1); pk.y = pack2(h2, h3);
            if (!dry) *reinterpret_cast<uint2*>(hb + (size_t)row * DM + i * 256 + lane * 4) = pk;
            if (MODE == M_LN1) *reinterpret_cast<float4*>(hbuf + rl * 1024 + i * 256 + lane * 4) = make_float4(h0, h1, h2, h3);
        }
    }
    if (MODE == M_LN1) {
        const float* rw = p.in(I_ROUTER_W) + (size_t)l * 1024 * 64 + lane;
        const float* h0p = hbuf + (w * 2) * 1024; const float* h1p = h0p + 1024;
        float a0 = 0.f, a1 = 0.f;
#pragma unroll 2
        for (int k = 0; k < 1024; k += 4) {
            const float4 x0 = *reinterpret_cast<const float4*>(h0p + k);
            const float4 x1 = *reinterpret_cast<const float4*>(h1p + k);
            const float w0 = rw[(size_t)(k + 0) * 64], w1 = rw[(size_t)(k + 1) * 64], w2 = rw[(size_t)(k + 2) * 64], w3 = rw[(size_t)(k + 3) * 64];
            a0 += x0.x * w0; a1 += x1.x * w0;
            a0 += x0.y * w1; a1 += x1.y * w1;
            a0 += x0.z * w2; a1 += x1.z * w2;
            a0 += x0.w * w3; a1 += x1.w * w3;
        }
        const float rbias = p.in(I_ROUTER_B)[l * 64 + lane];
        unsigned* cnt = (unsigned*)(p.ws + WS_CTL) + CW_CNT(l);
        int* aep = (int*)(p.ws + WS_AEP); float* aw = (float*)(p.ws + WS_AW);
#pragma unroll 1
        for (int rr = 0; rr < 2; ++rr) {
            const int row = u * 8 + w * 2 + rr;
            const float logit = rr ? a1 : a0;
            const float s = 1.f / (1.f + expf(-logit));
            const float bsd = s + rbias;
            float m1 = bsd;
            m1 = fmaxf(m1, __shfl_xor(m1, 1)); m1 = fmaxf(m1, __shfl_xor(m1, 2)); m1 = fmaxf(m1, __shfl_xor(m1, 4));
            const unsigned long long eqm = __ballot(bsd == m1);
            const int gbase = lane & ~7;
            const unsigned gbits = (unsigned)((eqm >> gbase) & 0xFFull);
            const int first = gbase + __builtin_ctz(gbits);
            float m2 = (lane == first) ? -INFINITY : bsd;
            m2 = fmaxf(m2, __shfl_xor(m2, 1)); m2 = fmaxf(m2, __shfl_xor(m2, 2)); m2 = fmaxf(m2, __shfl_xor(m2, 4));
            const float gs = m1 + m2;
            const int myg = lane >> 3;
            int grank = 0;
#pragma unroll
            for (int g2 = 0; g2 < 8; ++g2) { const float o = __shfl(gs, g2 * 8); grank += (o > gs || (o == gs && g2 < myg)) ? 1 : 0; }
            const bool gsel = grank < 4;
            const float msk = gsel ? bsd : -INFINITY;
            int erank = 0;
#pragma unroll
            for (int j = 0; j < 64; ++j) { const float o = __shfl(msk, j); erank += (o > msk || (o == msk && j < lane)) ? 1 : 0; }
            const bool sel = gsel && erank < 8;
            const float wsum = wave_sum(sel ? s : 0.f);
            const unsigned long long selm = __ballot(sel);
            if (sel && !dry) {
                const int slot = __popcll(selm & ((1ull << lane) - 1ull));
                const unsigned pos = atomicAdd(&cnt[lane], 1u);
                aep[(size_t)row * 8 + slot] = (int)((unsigned)lane << 24 | pos);
                aw[(size_t)row * 8 + slot] = s / wsum * 2.5f;
            }
        }
    }
}

__device__ __forceinline__ void filt_unit(const P& p, int l, int u, char* lds) {
    const int tid = otid();
    float* feat = (float*)lds;
    float* h1 = feat + 4 * 36;
    float* h2 = h1 + 4 * 64;
    const int pp = tid >> 6, j = tid & 63;
    const int pi = u * 4 + pp;
    const int L = pi < 4096 ? 4096 : 256;
    const int t = pi < 4096 ? pi : pi - 4096;
    const float tt = (float)t / (float)(L - 1);
    if (j < 33) {
        float f;
        if (j == 0) f = tt;
        else {
            const int k = (j - 1) & 15;
            const float band = 1e-4f + (float)k * ((15.0f - 1e-4f) / 15.0f);
            float ph = band * (float)t * (1.f / (float)L);
            ph -= floorf(ph);
            float sn, cs; sincospif(2.f * ph, &sn, &cs);
            f = (j <= 16) ? cs : -sn;
        }
        feat[pp * 36 + j] = f;
    }
    __syncthreads();
    {
        const float* w1 = p.in(I_HY_W1) + (size_t)l * 33 * 64;
        float a = p.in(I_HY_B1)[l * 64 + j];
        for (int i = 0; i < 33; ++i) a += feat[pp * 36 + i] * w1[i * 64 + j];
        h1[pp * 64 + j] = sinf(p.in(I_HY_F1)[l * 64 + j] * a);
    }
    __syncthreads();
    {
        const float* w2 = p.in(I_HY_W2) + (size_t)l * 64 * 64;
        float a = p.in(I_HY_B2)[l * 64 + j];
        for (int i = 0; i < 64; ++i) a += h1[pp * 64 + i] * w2[i * 64 + j];
        h2[pp * 64 + j] = sinf(p.in(I_HY_F2)[l * 64 + j] * a);
    }
    __syncthreads();
    {
        const int c = tid;
        const float* w3 = p.in(I_HY_W3) + (size_t)l * 64 * 1024;
        float acc[4][4];
#pragma unroll
        for (int a = 0; a < 4; ++a)
#pragma unroll
            for (int b = 0; b < 4; ++b) acc[a][b] = 0.f;
        for (int i = 0; i < 64; ++i) {
            float wv[4];
#pragma unroll
            for (int os = 0; os < 4; ++os) wv[os] = w3[i * 1024 + os * 256 + c];
#pragma unroll
            for (int q = 0; q < 4; ++q) {
                const float hv = h2[q * 64 + i];
#pragma unroll
                for (int os = 0; os < 4; ++os) acc[q][os] += hv * wv[os];
            }
        }
        const float d0 = logf(0.01f) / 1.5f, d1 = logf(0.01f) / 0.3f;
        const float delta = fabsf(d0 + (d1 - d0) * ((float)c / 255.f));
#pragma unroll
        for (int q = 0; q < 4; ++q) {
            const int pq = u * 4 + q;
            const int Lq = pq < 4096 ? 4096 : 256;
            const int tq = pq < 4096 ? pq : pq - 4096;
            const float ttq = (float)tq / (float)(Lq - 1);
            const float dec = expf(-ttq * delta);
            float* F = (pq < 4096) ? (float*)(p.ws + WS_FILTL) : (float*)(p.ws + WS_FILTC);
#pragma unroll
            for (int os = 0; os < 4; ++os) {
                if (pq < 4096) F[((size_t)((os >> 1) * 256 + c) * 2 + (os & 1)) * 4096 + tq] = acc[q][os] * dec;
                else F[((size_t)os * 256 + c) * Lq + tq] = acc[q][os] * dec;
            }
        }
    }
    __syncthreads();
}

__device__ __forceinline__ void rwkv_prep_unit(const P& p, int l, int u, char* lds) {
    const int tid = otid(), w = tid >> 6;
    float* tw = (float*)lds;
    float* al = tw + 32 * 64;
    const bf16_t* z = (const bf16_t*)(p.ws + WS_Z);
    bf16_t* rwp = (bf16_t*)(p.ws + WS_R1 + R1_RWP);
    float* knorm = (float*)(p.ws + WS_KNORM);
    const int row0 = u * 32;
#pragma unroll
    for (int i = 0; i < 8; ++i) {
        const int idx = tid + 256 * i, tok = idx >> 6, j = idx & 63;
        const bf16_t* zr = z + (size_t)(row0 + tok) * ZS;
        tw[idx] = tanhf(bf2f(zr[768 + j]));
        al[idx] = bf2f(zr[832 + j]);
    }
    __syncthreads();
    const int c = tid;
#pragma unroll 1
    for (int pass = 0; pass < 4; ++pass) {
        const int d = pass & 1;
        const bool isA = pass >= 2;
        const float* W2 = (isA ? p.in(I_RW_A2) : p.in(I_RW_W2)) + (size_t)((l * 2 + d) * 32) * 256 + c;
        const float base = (isA ? p.in(I_RW_A0) : p.in(I_RW_W0))[(l * 2 + d) * 256 + c];
        float wr[32];
#pragma unroll
        for (int r = 0; r < 32; ++r) wr[r] = W2[r * 256];
        const float* src = isA ? al : tw;
#pragma unroll 2
        for (int tok = 0; tok < 32; ++tok) {
            float a = base;
#pragma unroll
            for (int r = 0; r < 32; r += 4) {
                const float4 x = *reinterpret_cast<const float4*>(src + tok * 64 + d * 32 + r);
                a += x.x * wr[r] + x.y * wr[r + 1] + x.z * wr[r + 2] + x.w * wr[r + 3];
            }
            float o;
            if (isA) o = 1.f / (1.f + expf(-a));
            else o = expf(-softplusf(-a) - 0.5f);
            rwp[((size_t)(row0 + tok) * 4 + pass) * 256 + c] = f2bf(o);
        }
    }
    const float kkc = p.in(I_RW_KK)[l * 256 + c];
#pragma unroll 4
    for (int tok = 0; tok < 32; ++tok) {
        const float kv = bf2f(z[(size_t)(row0 + tok) * ZS + 256 + c]) * kkc;
        const float ss = wave_sum(kv * kv);
        if ((tid & 63) == 0) knorm[(size_t)(row0 + tok) * 4 + w] = rsqrtf(ss + 1e-12f);
    }
    __syncthreads();
}

__device__ __forceinline__ void gdn_prep_unit(const P& p, int l, int u) {
    const int tid = otid();
    const bf16_t* z = (const bf16_t*)(p.ws + WS_Z);
    bf16_t* gq = (bf16_t*)(p.ws + WS_R1 + R1_GQ);
    float* gab = (float*)(p.ws + WS_GAB);
    const int row0 = u * 32;
    int seq0, seqL;
    if (row0 < NTC) { seq0 = row0 & ~255; seqL = 256; } else { seq0 = NTC + ((row0 - NTC) & ~4095); seqL = 4096; }
#pragma unroll 1
    for (int pz = 0; pz < 3; ++pz) {
        const int ch = pz * 256 + tid;
        const float w0 = p.in(I_GD_CONV)[(size_t)(l * 3 + 0) * 768 + ch], w1 = p.in(I_GD_CONV)[(size_t)(l * 3 + 1) * 768 + ch], w2 = p.in(I_GD_CONV)[(size_t)(l * 3 + 2) * 768 + ch];
        const bf16_t* zc = z + COL_GD + ch;
        float xm = (row0 - 1 >= seq0) ? bf2f(zc[(size_t)(row0 - 1) * ZS]) : 0.f;
        float x0 = bf2f(zc[(size_t)row0 * ZS]);
#pragma unroll 4
        for (int tok = 0; tok < 32; ++tok) {
            const int row = row0 + tok;
            const float xp = (row + 1 < seq0 + seqL) ? bf2f(zc[(size_t)(row + 1) * ZS]) : 0.f;
            float v = siluf(w0 * xm + w1 * x0 + w2 * xp);
            if (pz < 2) {
                const float ss = wave_sum(v * v);
                v *= rsqrtf(ss + 1e-12f) * (pz == 0 ? 0.125f : 1.f);
            }
            gq[(size_t)row * 768 + ch] = f2bf(v);
            xm = x0; x0 = xp;
        }
    }
    {
        const int tok = tid >> 3, dh = tid & 7;
        const int row = row0 + tok;
        const float alv = bf2f(z[(size_t)row * ZS + COL_GD + 1024 + dh]);
        const float blv = bf2f(z[(size_t)row * ZS + COL_GD + 1032 + dh]);
        const float g = -expf(p.in(I_GD_ALOG)[l * 8 + dh]) * softplusf(alv + p.in(I_GD_DTB)[l * 8 + dh]);
        gab[(size_t)row * 16 + dh] = expf(g);
        gab[(size_t)row * 16 + 8 + dh] = 1.f / (1.f + expf(-blv));
    }
}

__device__ __forceinline__ int s5_chain_row(int b, int d, int q) {
    if (q < 256) return b * 256 + (d ? 255 - q : q);
    int n = q - 256; if (d) n = 4095 - n;
    return NTC + b * 4096 + (n & 63) * 64 + (n >> 6);
}
__device__ __forceinline__ void s5_load_u(const bf16_t* zr, float* dst) {
    const uint4 a = *reinterpret_cast<const uint4*>(zr);
    const uint4 b = *reinterpret_cast<const uint4*>(zr + 8);
    *reinterpret_cast<float4*>(dst + 0) = make_float4(bflo(a.x), bfhi(a.x), bflo(a.y), bfhi(a.y));
    *reinterpret_cast<float4*>(dst + 4) = make_float4(bflo(a.z), bfhi(a.z), bflo(a.w), bfhi(a.w));
    *reinterpret_cast<float4*>(dst + 8) = make_float4(bflo(b.x), bfhi(b.x), bflo(b.y), bfhi(b.y));
    *reinterpret_cast<float4*>(dst + 12) = make_float4(bflo(b.z), bfhi(b.z), bflo(b.w), bfhi(b.w));
}

__device__ __forceinline__ void s5_pre_unit(const P& p, int l, int u, char* lds) {
    const int tid = otid(), w = tid >> 6, lane = tid & 63;
    float* ust = (float*)lds + w * 1024;
    const int wt = u * 4 + w;
    const int d = wt & 1, g = (wt >> 1) & 15, rest = wt >> 5;
    const int cc = rest % NCHUNK, b = rest / NCHUNK;
    const bf16_t* z = (const bf16_t*)(p.ws + WS_Z);
    {
        const int row = s5_chain_row(b, d, cc * 64 + lane);
        s5_load_u(z + (size_t)row * ZS + COL_S5 + g * 16, ust + lane * 16);
    }
    const int tix = ((l * 2 + d) * 16 + g) * 64 + lane;
    const float4 A = *reinterpret_cast<const float4*>((const float*)(p.ws + WS_S5A) + (size_t)tix * 4);
    const float* Bp = (const float*)(p.ws + WS_S5B) + (size_t)tix * 32;
    float br[16], bi[16];
#pragma unroll
    for (int h = 0; h < 16; ++h) { br[h] = Bp[h]; bi[h] = Bp[16 + h]; }
    float xr = 0.f, xi = 0.f;
#pragma unroll 2
    for (int s = 0; s < 64; ++s) {
        float ur = 0.f, ui = 0.f;
#pragma unroll
        for (int h4 = 0; h4 < 4; ++h4) {
            const float4 uu = *reinterpret_cast<const float4*>(ust + s * 16 + h4 * 4);
            ur += br[h4 * 4] * uu.x + br[h4 * 4 + 1] * uu.y + br[h4 * 4 + 2] * uu.z + br[h4 * 4 + 3] * uu.w;
            ui += bi[h4 * 4] * uu.x + bi[h4 * 4 + 1] * uu.y + bi[h4 * 4 + 2] * uu.z + bi[h4 * 4 + 3] * uu.w;
        }
        const float nr = A.x * xr - A.y * xi + ur;
        const float ni = A.x * xi + A.y * xr + ui;
        xr = nr; xi = ni;
    }
    float* st = (float*)(p.ws + WS_S5ST) + ((((size_t)(b * NCHUNK + cc) * 2 + d) * 16 + g) * 64 + lane) * 2;
    st[0] = xr; st[1] = xi;
}

__device__ __forceinline__ float reduce16(const float (&t)[16], int lane) {
    float a[8];
    const bool hi8 = (lane & 8) != 0;
#pragma unroll
    for (int k = 0; k < 8; ++k) { const float keep = hi8 ? t[k + 8] : t[k]; const float send = hi8 ? t[k] : t[k + 8]; a[k] = keep + dppf<0x140>(send); }
    float b[4];
    const bool hi4 = (lane & 4) != 0;
#pragma unroll
    for (int k = 0; k < 4; ++k) { const float keep = hi4 ? a[k + 4] : a[k]; const float send = hi4 ? a[k] : a[k + 4]; b[k] = keep + dppf<0x141>(send); }
    float c[2];
    const bool hi2 = (lane & 2) != 0;
#pragma unroll
    for (int k = 0; k < 2; ++k) { const float keep = hi2 ? b[k + 2] : b[k]; const float send = hi2 ? b[k] : b[k + 2]; c[k] = keep + dppf<0x4E>(send); }
    const bool hi1 = (lane & 1) != 0;
    float r = (hi1 ? c[1] : c[0]) + dppf<0xB1>(hi1 ? c[0] : c[1]);
    r += __shfl_xor(r, 16);
    r += __shfl_xor(r, 32);
    return r;
}

__device__ __forceinline__ void s5_main_unit(const P& p, int l, int u, char* lds) {
    const int tid = otid(), w = tid >> 6, lane = tid & 63;
    float* ust = (float*)lds + w * 2048;
    float* yst = ust + 1024;
    const int b = u / NCHUNK, tc = u % NCHUNK;
    bf16_t* z = (bf16_t*)(p.ws + WS_Z);
    const int myrow = (tc < 4) ? (b * 256 + tc * 64 + lane) : (NTC + b * 4096 + lane * 64 + (tc - 4));
#pragma unroll 1
    for (int gi = 0; gi < 4; ++gi) {
        const int g = w * 4 + gi;
        s5_load_u(z + (size_t)myrow * ZS + COL_S5 + g * 16, ust + lane * 16);
#pragma unroll 1
        for (int d = 0; d < 2; ++d) {
            const int tix = ((l * 2 + d) * 16 + g) * 64 + lane;
            const float4 A = *reinterpret_cast<const float4*>((const float*)(p.ws + WS_S5A) + (size_t)tix * 4);
            const float* Bp = (const float*)(p.ws + WS_S5B) + (size_t)tix * 32;
            float br[16], bi[16], cr[16], ci[16];
#pragma unroll
            for (int h = 0; h < 16; ++h) { br[h] = Bp[h]; bi[h] = Bp[16 + h]; }
            const float* crp = p.in(I_S5_CRE) + (size_t)((l * 2 + d) * 16 + g) * 1024 + lane;
            const float* cip = p.in(I_S5_CIM) + (size_t)((l * 2 + d) * 16 + g) * 1024 + lane;
#pragma unroll
            for (int h = 0; h < 16; ++h) { cr[h] = crp[h * 64]; ci[h] = cip[h * 64]; }
            const int cc = d ? ((tc < 4) ? 3 - tc : 71 - tc) : tc;
            float xr = 0.f, xi = 0.f;
            {
                const float* st = (const float*)(p.ws + WS_S5ST) + ((((size_t)(b * NCHUNK) * 2 + d) * 16 + g) * 64 + lane) * 2;
                for (int c2 = 0; c2 < cc; ++c2) {
                    const float2 sv = *reinterpret_cast<const float2*>(st + (size_t)c2 * (2 * 16 * 64 * 2));
                    const float nr = A.z * xr - A.w * xi + sv.x;
                    const float ni = A.z * xi + A.w * xr + sv.y;
                    xr = nr; xi = ni;
                }
            }
#pragma unroll 1
            for (int s = 0; s < 64; ++s) {
                const int i = d ? 63 - s : s;
                float ur = 0.f, ui = 0.f;
#pragma unroll
                for (int h4 = 0; h4 < 4; ++h4) {
                    const float4 uu = *reinterpret_cast<const float4*>(ust + i * 16 + h4 * 4);
                    ur += br[h4 * 4] * uu.x + br[h4 * 4 + 1] * uu.y + br[h4 * 4 + 2] * uu.z + br[h4 * 4 + 3] * uu.w;
                    ui += bi[h4 * 4] * uu.x + bi[h4 * 4 + 1] * uu.y + bi[h4 * 4 + 2] * uu.z + bi[h4 * 4 + 3] * uu.w;
                }
                const float nr = A.x * xr - A.y * xi + ur;
                const float ni = A.x * xi + A.y * xr + ui;
                xr = nr; xi = ni;
                float t[16];
#pragma unroll
                for (int h = 0; h < 16; ++h) t[h] = cr[h] * xr - ci[h] * xi;
                const float tot = reduce16(t, lane);
                if (lane < 16) { if (d == 0) yst[i * 16 + lane] = tot; else yst[i * 16 + lane] += tot; }
            }
        }
        {
            const float* dsk = p.in(I_S5_D) + l * 256 + g * 16;
            unsigned pk[8];
#pragma unroll
            for (int h = 0; h < 16; h += 2) {
                float y0 = yst[lane * 16 + h] + ust[lane * 16 + h] * dsk[h];
                float y1 = yst[lane * 16 + h + 1] + ust[lane * 16 + h + 1] * dsk[h + 1];
                y0 = 0.5f * y0 * (1.f + erff(y0 * 0.70710678118f));
                y1 = 0.5f * y1 * (1.f + erff(y1 * 0.70710678118f));
                pk[h >> 1] = pack2(y0, y1);
            }
            uint4* dst = reinterpret_cast<uint4*>(z + (size_t)myrow * ZS + COL_S5 + g * 16);
            dst[0] = make_uint4(pk[0], pk[1], pk[2], pk[3]);
            dst[1] = make_uint4(pk[4], pk[5], pk[6], pk[7]);
        }
    }
}

#define SB 16
__device__ __forceinline__ int scan_chain_row(int b, int d, int q) {
    if (q < 256) return b * 256 + (d ? 255 - q : q);
    const int t = q - 256;
    return NTC + b * 4096 + (d ? 4095 - t : t);
}
struct ScanRaw { uint2 r, k, v, e, a; float f0, f1; };

__device__ __forceinline__ void scan_load(const P& p, int m, int b, int h, int d, int q, int cg, ScanRaw& R) {
    const int row = scan_chain_row(b, d, q);
    const int c0 = h * 64 + cg * 4;
    if (m == 0) {
        const bf16_t* z = (const bf16_t*)(p.ws + WS_Z) + (size_t)row * ZS + c0;
        R.r = *reinterpret_cast<const uint2*>(z);
        R.k = *reinterpret_cast<const uint2*>(z + 256);
        R.v = *reinterpret_cast<const uint2*>(z + 512);
        const bf16_t* rw = (const bf16_t*)(p.ws + WS_R1 + R1_RWP) + (size_t)row * 1024 + c0;
        R.e = *reinterpret_cast<const uint2*>(rw + d * 256);
        R.a = *reinterpret_cast<const uint2*>(rw + (2 + d) * 256);
        R.f0 = ((const float*)(p.ws + WS_KNORM))[(size_t)row * 4 + h];
        R.f1 = 0.f;
    } else {
        const bf16_t* gq = (const bf16_t*)(p.ws + WS_R1 + R1_GQ) + (size_t)row * 768 + c0;
        R.r = *reinterpret_cast<const uint2*>(gq);
        R.k = *reinterpret_cast<const uint2*>(gq + 256);
        R.v = *reinterpret_cast<const uint2*>(gq + 512);
        R.e = make_uint2(0u, 0u); R.a = make_uint2(0u, 0u);
        const float* gab = (const float*)(p.ws + WS_GAB) + (size_t)row * 16;
        R.f0 = gab[d * 4 + h];
        R.f1 = gab[8 + d * 4 + h];
    }
}
__device__ __forceinline__ void scan_store(int m, const ScanRaw& R, float* dst  , const float (&kkp)[4], const float (&kap)[4]) {
    float r[4] = {bflo(R.r.x), bfhi(R.r.x), bflo(R.r.y), bfhi(R.r.y)};
    float k[4] = {bflo(R.k.x), bfhi(R.k.x), bflo(R.k.y), bfhi(R.k.y)};
    float v[4] = {bflo(R.v.x), bfhi(R.v.x), bflo(R.v.y), bfhi(R.v.y)};
    float ww[4], aa[4], bb[4], kk[4];
    if (m == 0) {
        float e[4] = {bflo(R.e.x), bfhi(R.e.x), bflo(R.e.y), bfhi(R.e.y)};
        float a[4] = {bflo(R.a.x), bfhi(R.a.x), bflo(R.a.y), bfhi(R.a.y)};
#pragma unroll
        for (int i = 0; i < 4; ++i) {
            ww[i] = __expf(-e[i]);
            kk[i] = k[i] * (1.f + (a[i] - 1.f) * kap[i]);
            const float kn = k[i] * kkp[i] * R.f0;
            aa[i] = -kn;
            bb[i] = kn * a[i];
        }
    } else {
        const float al = R.f0, be = R.f1;
#pragma unroll
        for (int i = 0; i < 4; ++i) { ww[i] = al; aa[i] = k[i]; bb[i] = -al * be * k[i]; kk[i] = be * k[i]; }
    }
    *reinterpret_cast<float4*>(dst + 0 * 64) = make_float4(ww[0], ww[1], ww[2], ww[3]);
    *reinterpret_cast<float4*>(dst + 1 * 64) = make_float4(aa[0], aa[1], aa[2], aa[3]);
    *reinterpret_cast<float4*>(dst + 2 * 64) = make_float4(bb[0], bb[1], bb[2], bb[3]);
    *reinterpret_cast<float4*>(dst + 3 * 64) = make_float4(kk[0], kk[1], kk[2], kk[3]);
    *reinterpret_cast<float4*>(dst + 4 * 64) = make_float4(r[0], r[1], r[2], r[3]);
    *reinterpret_cast<float4*>(dst + 5 * 64) = make_float4(v[0], v[1], v[2], v[3]);
}

__device__ __forceinline__ void scan_unit(const P& p, int l, int u, char* lds) {
    const int tid = otid();
    const int chain = u >> 1, half = u & 1;
    const int m = chain >> 6, rem = chain & 63, b = rem >> 3, h = (rem >> 1) & 3, d = rem & 1;
    float* buf = (float*)lds;
    float* ybuf = buf + 2 * SB * 384;
    const int rl = tid >> 3, sub = tid & 7;
    const int st = tid >> 4, cg = tid & 15;
    float kkp[4], kap[4];
#pragma unroll
    for (int i = 0; i < 4; ++i) { kkp[i] = p.in(I_RW_KK)[l * 256 + h * 64 + cg * 4 + i]; kap[i] = p.in(I_RW_KA)[l * 256 + h * 64 + cg * 4 + i]; }
    bf16_t* ys = (bf16_t*)(p.ws + WS_HBY) + (size_t)(m * 2 + d) * NT * 256;
    float S[8];
#pragma unroll
    for (int j = 0; j < 8; ++j) S[j] = 0.f;
    ScanRaw R;
    scan_load(p, m, b, h, d, st, cg, R);
    scan_store(m, R, buf + (st * 6) * 64 + cg * 4, kkp, kap);
    __syncthreads();
    const int NB = 4352 / SB;
    __builtin_amdgcn_s_setprio(2);
#pragma unroll 1
    for (int bt = 0; bt < NB; ++bt) {
        const int par = bt & 1;
        if (bt + 1 < NB) scan_load(p, m, b, h, d, (bt + 1) * SB + st, cg, R);
        const float* cb = buf + par * (SB * 384);
        float* yb = ybuf + par * (SB * 32);
        {
            const float* sb0 = cb + sub * 8;
            const float* vb0 = cb + 320 + half * 32 + rl;
            float4 nw0 = *reinterpret_cast<const float4*>(sb0), nw1 = *reinterpret_cast<const float4*>(sb0 + 4);
            float4 na0 = *reinterpret_cast<const float4*>(sb0 + 64), na1 = *reinterpret_cast<const float4*>(sb0 + 68);
            float4 nb0 = *reinterpret_cast<const float4*>(sb0 + 128), nb1 = *reinterpret_cast<const float4*>(sb0 + 132);
            float4 nk0 = *reinterpret_cast<const float4*>(sb0 + 192), nk1 = *reinterpret_cast<const float4*>(sb0 + 196);
            float4 nr0 = *reinterpret_cast<const float4*>(sb0 + 256), nr1 = *reinterpret_cast<const float4*>(sb0 + 260);
            float nvv = vb0[0];
#pragma unroll
            for (int s = 0; s < SB; ++s) {
                const float4 w0 = nw0, w1 = nw1, a0 = na0, a1 = na1, b0 = nb0, b1 = nb1, k0 = nk0, k1 = nk1, r0 = nr0, r1 = nr1;
                const float vv = nvv;
                if (s + 1 < SB) {
                    const float* sb = sb0 + (s + 1) * 384;
                    nw0 = *reinterpret_cast<const float4*>(sb); nw1 = *reinterpret_cast<const float4*>(sb + 4);
                    na0 = *reinterpret_cast<const float4*>(sb + 64); na1 = *reinterpret_cast<const float4*>(sb + 68);
                    nb0 = *reinterpret_cast<const float4*>(sb + 128); nb1 = *reinterpret_cast<const float4*>(sb + 132);
                    nk0 = *reinterpret_cast<const float4*>(sb + 192); nk1 = *reinterpret_cast<const float4*>(sb + 196);
                    nr0 = *reinterpret_cast<const float4*>(sb + 256); nr1 = *reinterpret_cast<const float4*>(sb + 260);
                    nvv = vb0[(s + 1) * 384];
                }
                __builtin_amdgcn_sched_barrier(0);
                float sa = (S[0] * a0.x + S[1] * a0.y) + (S[2] * a0.z + S[3] * a0.w) + (S[4] * a1.x + S[5] * a1.y) + (S[6] * a1.z + S[7] * a1.w);
                sa += dppf<0xB1>(sa); sa += dppf<0x4E>(sa); sa += dppf<0x141>(sa);
                S[0] = S[0] * w0.x + sa * b0.x + vv * k0.x;
                S[1] = S[1] * w0.y + sa * b0.y + vv * k0.y;
                S[2] = S[2] * w0.z + sa * b0.z + vv * k0.z;
                S[3] = S[3] * w0.w + sa * b0.w + vv * k0.w;
                S[4] = S[4] * w1.x + sa * b1.x + vv * k1.x;
                S[5] = S[5] * w1.y + sa * b1.y + vv * k1.y;
                S[6] = S[6] * w1.z + sa * b1.z + vv * k1.z;
                S[7] = S[7] * w1.w + sa * b1.w + vv * k1.w;
                float y = (S[0] * r0.x + S[1] * r0.y) + (S[2] * r0.z + S[3] * r0.w) + (S[4] * r1.x + S[5] * r1.y) + (S[6] * r1.z + S[7] * r1.w);
                y += dppf<0xB1>(y); y += dppf<0x4E>(y); y += dppf<0x141>(y);
                yb[s * 32 + rl] = y;
            }
        }
        if (bt + 1 < NB) scan_store(m, R, buf + (1 - par) * (SB * 384) + (st * 6) * 64 + cg * 4, kkp, kap);
        __syncthreads();
        {
            const int r2 = cg * 2;
            const int row = scan_chain_row(b, d, bt * SB + st);
            const unsigned pk = pack2(yb[st * 32 + r2], yb[st * 32 + r2 + 1]);
            *reinterpret_cast<unsigned*>(ys + (size_t)row * 256 + h * 64 + half * 32 + r2) = pk;
        }
    }
    __builtin_amdgcn_s_setprio(0);
    __syncthreads();
}

template <int L>
__device__ __forceinline__ void hyena_unit(const P& p, int l, int u, char* lds) {
    constexpr int TPT = L / 256;
    const int tid = otid();
    const int c = u >> 2, bp = u & 3;
    float2* u2 = (float2*)lds;
    float* taps = (float*)(lds + (size_t)L * 8);
    const bf16_t* z = (const bf16_t*)(p.ws + WS_Z);
    bf16_t* cat = (bf16_t*)(p.ws + WS_CAT);
    const float* F = (L == 4096) ? (const float*)(p.ws + WS_FILTL) : (const float*)(p.ws + WS_FILTC);
    int base[2];
#pragma unroll
    for (int bb = 0; bb < 2; ++bb) { const int b = bp * 2 + bb; base[bb] = (L == 4096) ? NTC + b * 4096 : b * 256; }
    const int t0 = tid * TPT;
    const float* cw = p.in(I_HY_CONV) + (size_t)l * 3 * 768; const float* cb = p.in(I_HY_CONVB) + (size_t)l * 768;
    auto sconv = [&](int part, int bb, float (&o)[TPT]) {
        const int ch = part * 256 + c;
        const float w0 = cw[ch], w1 = cw[768 + ch], w2 = cw[1536 + ch], bs = cb[ch];
        const bf16_t* zc = z + (size_t)base[bb] * ZS + COL_HY + ch;
        float xm = (t0 > 0) ? bf2f(zc[(size_t)(t0 - 1) * ZS]) : 0.f;
        float x0 = bf2f(zc[(size_t)t0 * ZS]);
#pragma unroll
        for (int i = 0; i < TPT; ++i) {
            const int t = t0 + i;
            const float xp = (t + 1 < L) ? bf2f(zc[(size_t)(t + 1) * ZS]) : 0.f;
            o[i] = w0 * xm + w1 * x0 + w2 * xp + bs;
            xm = x0; x0 = xp;
        }
    };
    {
        float v0[TPT], v1[TPT];
        sconv(2, 0, v0); sconv(2, 1, v1);
#pragma unroll
        for (int i = 0; i < TPT; ++i) u2[t0 + i] = make_float2(v0[i], v1[i]);
    }
#pragma unroll 1
    for (int o = 0; o < 2; ++o) {
        const float* hf = F + ((size_t)(o * 2 + 0) * 256 + c) * L;
        const float* hbk = F + ((size_t)(o * 2 + 1) * 256 + c) * L;
        for (int k = tid; k < 2 * L; k += NTHREADS) {
            const int dd = k - (L - 1);
            taps[k] = (dd >= L) ? 0.f : (dd >= 0 ? hf[dd] : hbk[-dd]);
        }
        __syncthreads();
        float acc[TPT][2];
#pragma unroll
        for (int i = 0; i < TPT; ++i) { acc[i][0] = 0.f; acc[i][1] = 0.f; }
        if (L == 4096) {
#pragma unroll 1
            for (int s0 = 0; s0 < L; s0 += 16) {
                const int k0 = t0 - s0 + (L - 16);
                float W[32];
#pragma unroll
                for (int q = 0; q < 8; ++q) {
                    const float4 t4 = *reinterpret_cast<const float4*>(taps + k0 + q * 4);
                    W[q * 4] = t4.x; W[q * 4 + 1] = t4.y; W[q * 4 + 2] = t4.z; W[q * 4 + 3] = t4.w;
                }
#pragma unroll
                for (int j = 0; j < 16; ++j) {
                    const float2 uj = u2[s0 + j];
#pragma unroll
                    for (int i = 0; i < TPT; ++i) {
                        const float wv = W[(i - j + 15) & 31];
                        acc[i][0] += wv * uj.x; acc[i][1] += wv * uj.y;
                    }
                }
            }
        } else {
            for (int s = 0; s < L; ++s) {
                const float2 uj = u2[s];
                const float wv = taps[t0 - s + (L - 1)];
                acc[0][0] += wv * uj.x; acc[0][1] += wv * uj.y;
            }
        }
        const float sk = p.in(I_HY_SKIP)[(size_t)(l * 2 + o) * 256 + c];
        float res[TPT][2];
        {
            float g0[TPT], g1[TPT];
            sconv(o, 0, g0); sconv(o, 1, g1);
#pragma unroll
            for (int i = 0; i < TPT; ++i) {
                const float2 ut = u2[t0 + i];
                res[i][0] = g0[i] * (acc[i][0] + sk * ut.x);
                res[i][1] = g1[i] * (acc[i][1] + sk * ut.y);
            }
        }
        __syncthreads();
        if (o == 0) {
#pragma unroll
            for (int i = 0; i < TPT; ++i) u2[t0 + i] = make_float2(res[i][0], res[i][1]);
        } else {
#pragma unroll
            for (int i = 0; i < TPT; ++i) {
                cat[(size_t)(base[0] + t0 + i) * DM + 512 + c] = f2bf(res[i][0]);
                cat[(size_t)(base[1] + t0 + i) * DM + 512 + c] = f2bf(res[i][1]);
            }
        }
        __syncthreads();
    }
}


#define FFT_BS 272
__device__ __forceinline__ int fphys(int d2, int d1, int d0) { return d2 * FFT_BS + d1 * 17 + d0; }
__device__ __forceinline__ float2 cmulf(float2 a, float2 b) { return make_float2(a.x * b.x - a.y * b.y, a.x * b.y + a.y * b.x); }
__device__ static constexpr float C32T[16] = {1.000000000e+00f, 9.807852804e-01f, 9.238795325e-01f, 8.314696123e-01f, 7.071067812e-01f, 5.555702330e-01f, 3.826834324e-01f, 1.950903220e-01f, 6.123233996e-17f, -1.950903220e-01f, -3.826834324e-01f, -5.555702330e-01f, -7.071067812e-01f, -8.314696123e-01f, -9.238795325e-01f, -9.807852804e-01f};
__device__ static constexpr float S32T[16] = {0.000000000e+00f, 1.950903220e-01f, 3.826834324e-01f, 5.555702330e-01f, 7.071067812e-01f, 8.314696123e-01f, 9.238795325e-01f, 9.807852804e-01f, 1.000000000e+00f, 9.807852804e-01f, 9.238795325e-01f, 8.314696123e-01f, 7.071067812e-01f, 5.555702330e-01f, 3.826834324e-01f, 1.950903220e-01f};
template <int LOG> __device__ __forceinline__ constexpr int brev(int i) { int r = 0; for (int b = 0; b < LOG; ++b) r |= ((i >> b) & 1) << (LOG - 1 - b); return r; }
template <int R, bool INV> __device__ __forceinline__ void dftR(float2 (&v)[R]) {
    constexpr int LOG = (R == 32) ? 5 : 4;
    float2 t[R];
#pragma unroll
    for (int i = 0; i < R; ++i) t[brev<LOG>(i)] = v[i];
#pragma unroll
    for (int st = 1; st <= LOG; ++st) {
        const int len = 1 << st, half = len >> 1;
#pragma unroll
        for (int i = 0; i < R; i += len)
#pragma unroll
            for (int j = 0; j < half; ++j) {
                const int tw = j * (32 / len);
                const float2 a = t[i + j], b = t[i + j + half];
                float2 bw;
                if (tw == 0) bw = b;
                else if (tw == 8) bw = INV ? make_float2(-b.y, b.x) : make_float2(b.y, -b.x);
                else { const float wr = C32T[tw], wi = INV ? S32T[tw] : -S32T[tw]; bw = make_float2(b.x * wr - b.y * wi, b.x * wi + b.y * wr); }
                t[i + j] = make_float2(a.x + bw.x, a.y + bw.y);
                t[i + j + half] = make_float2(a.x - bw.x, a.y - bw.y);
            }
    }
#pragma unroll
    for (int i = 0; i < R; ++i) v[i] = t[i];
}
template <int R> __device__ __forceinline__ void twiddle_pow(float2 (&v)[R], float2 first, float2 base) {
    float2 w = first;
#pragma unroll
    for (int k = 0; k < R; ++k) { v[k] = cmulf(v[k], w); w = cmulf(w, base); }
}
__device__ __forceinline__ float2 cispi(float x) { float sn, cs; sincospif(x, &sn, &cs); return make_float2(cs, sn); }

__device__ __forceinline__ void fft_fwd_A_B1(float2 (&v)[32], float2* buf, int tid_in) {
    int tid = tid_in; asm volatile("" : "+v"(tid));
    const int a = tid >> 4, b = tid & 15;
    dftR<32, false>(v);
    twiddle_pow<32>(v, make_float2(1.f, 0.f), cispi(-2.f * (float)tid * (1.f / 8192.f)));
#pragma unroll
    for (int k1 = 0; k1 < 32; ++k1) buf[fphys(k1, a, b)] = v[k1];
    __syncthreads();
#pragma unroll 1
    for (int j = 0; j < 2; ++j) {
        const int g = tid + 256 * j, k1 = g >> 4, bb = g & 15;
        float2 w[16];
#pragma unroll
        for (int aa = 0; aa < 16; ++aa) w[aa] = buf[fphys(k1, aa, bb)];
        dftR<16, false>(w);
        twiddle_pow<16>(w, make_float2(1.f, 0.f), cispi(-2.f * (float)bb * (1.f / 256.f)));
#pragma unroll
        for (int ka = 0; ka < 16; ++ka) buf[fphys(k1, ka, bb)] = w[ka];
    }
    __syncthreads();
}
__device__ __forceinline__ void fft_inv_B1_A(float2 (&v)[32], float2* buf, int tid_in) {
    int tid = tid_in; asm volatile("" : "+v"(tid));
#pragma unroll 1
    for (int j = 0; j < 2; ++j) {
        const int g = tid + 256 * j, k1 = g >> 4, bb = g & 15;
        float2 w[16];
#pragma unroll
        for (int ka = 0; ka < 16; ++ka) w[ka] = buf[fphys(k1, ka, bb)];
        dftR<16, true>(w);
        twiddle_pow<16>(w, cispi(2.f * (float)(k1 * bb) * (1.f / 8192.f)), cispi(2.f * (float)k1 * (1.f / 512.f)));
#pragma unroll
        for (int aa = 0; aa < 16; ++aa) buf[fphys(k1, aa, bb)] = w[aa];
    }
    __syncthreads();
    const int a = tid >> 4, b = tid & 15;
#pragma unroll
    for (int k1 = 0; k1 < 32; ++k1) v[k1] = buf[fphys(k1, a, b)];
    dftR<32, true>(v);
}

__device__ __forceinline__ void hfft_unit(const P& p, int l, int u, char* lds) {
    const int tid = otid();
    float2* buf = (float2*)lds;
    float* F = (float*)(p.ws + WS_FILTL) + (size_t)u * 8192;
    float2 v[32];
#pragma unroll
    for (int n1 = 0; n1 < 32; ++n1) {
        const int n = 256 * n1 + tid;
        float x;
        if (n1 < 16) x = F[n];
        else x = (n == 4096) ? 0.f : F[4096 + (8192 - n)];
        if (n == 0) x += p.in(I_HY_SKIP)[(size_t)l * 512 + u];
        v[n1] = make_float2(x, 0.f);
    }
    fft_fwd_A_B1(v, buf, tid);
    __half2* H = (__half2*)F;
#pragma unroll 1
    for (int j = 0; j < 2; ++j) {
        const int g = tid + 256 * j, k1 = g >> 4, ka = g & 15;
        float2 w[16];
#pragma unroll
        for (int bb = 0; bb < 16; ++bb) w[bb] = buf[fphys(k1, ka, bb)];
        dftR<16, false>(w);
        unsigned pk[16];
#pragma unroll
        for (int kb = 0; kb < 16; ++kb) { const __half2 h = __floats2half2_rn(w[kb].x, w[kb].y); pk[kb] = *reinterpret_cast<const unsigned*>(&h); }
        uint4* dst = reinterpret_cast<uint4*>(H + (size_t)g * 16);
        dst[0] = make_uint4(pk[0], pk[1], pk[2], pk[3]); dst[1] = make_uint4(pk[4], pk[5], pk[6], pk[7]);
        dst[2] = make_uint4(pk[8], pk[9], pk[10], pk[11]); dst[3] = make_uint4(pk[12], pk[13], pk[14], pk[15]);
    }
    __syncthreads();
}

__device__ __forceinline__ void hyena_prep_unit(const P& p, int l, int u, char* lds) {
    const int tid = otid();
    bf16_t* tile = (bf16_t*)lds;
    const int b = u >> 6, t0 = (u & 63) * 64;
    const bf16_t* z = (const bf16_t*)(p.ws + WS_Z) + (size_t)(NTC + b * 4096) * ZS + COL_HY;
    bf16_t* hyT = (bf16_t*)(p.ws + WS_HYT);
    const float* cw = p.in(I_HY_CONV) + (size_t)l * 3 * 768; const float* cb = p.in(I_HY_CONVB) + (size_t)l * 768;
#pragma unroll 1
    for (int part = 0; part < 3; ++part) {
        const int ch = part * 256 + tid;
        const float w0 = cw[ch], w1 = cw[768 + ch], w2 = cw[1536 + ch], bs = cb[ch];
        const bf16_t* zc = z + ch;
        float xm = (t0 > 0) ? bf2f(zc[(size_t)(t0 - 1) * ZS]) : 0.f;
        float x0 = bf2f(zc[(size_t)t0 * ZS]);
#pragma unroll 8
        for (int i = 0; i < 64; ++i) {
            const int t = t0 + i;
            const float xp = (t + 1 < 4096) ? bf2f(zc[(size_t)(t + 1) * ZS]) : 0.f;
            tile[tid * 72 + i] = f2bf(w0 * xm + w1 * x0 + w2 * xp + bs);
            xm = x0; x0 = xp;
        }
        __syncthreads();
#pragma unroll
        for (int k = 0; k < 8; ++k) {
            const int chl = (tid >> 3) + 32 * k, seg = tid & 7;
            const uint4 val = *reinterpret_cast<const uint4*>(tile + chl * 72 + seg * 8);
            *reinterpret_cast<uint4*>(hyT + ((size_t)(b * 3 + part) * 256 + chl) * 4096 + t0 + seg * 8) = val;
        }
        __syncthreads();
    }
}

template <int O>
__device__ __forceinline__ void hyena_conv_pass(const P& p, int c, int bp, int tid, float2 (&v)[32], float2* buf) {
    const bf16_t* hyT = (const bf16_t*)(p.ws + WS_HYT);
#pragma unroll
    for (int j = 16; j < 32; ++j) v[j] = make_float2(0.f, 0.f);
    fft_fwd_A_B1(v, buf, tid);
    const __half2* H = (const __half2*)((const float*)(p.ws + WS_FILTL) + (size_t)(O * 256 + c) * 8192);
    int tm = tid; asm volatile("" : "+v"(tm));
#pragma unroll 1
    for (int j = 0; j < 2; ++j) {
        const int g = tm + 256 * j, k1 = g >> 4, ka = g & 15;
        float2 w[16];
#pragma unroll
        for (int bb = 0; bb < 16; ++bb) w[bb] = buf[fphys(k1, ka, bb)];
        dftR<16, false>(w);
        const uint4* hp = reinterpret_cast<const uint4*>(H + (size_t)g * 16);
        unsigned hk[16];
#pragma unroll
        for (int q = 0; q < 4; ++q) { const uint4 t4 = hp[q]; hk[q * 4] = t4.x; hk[q * 4 + 1] = t4.y; hk[q * 4 + 2] = t4.z; hk[q * 4 + 3] = t4.w; }
#pragma unroll
        for (int kb = 0; kb < 16; ++kb) { const float2 hf = __half22float2(*reinterpret_cast<const __half2*>(&hk[kb])); w[kb] = cmulf(w[kb], hf); }
        dftR<16, true>(w);
        twiddle_pow<16>(w, make_float2(1.f, 0.f), cispi(2.f * (float)ka * (1.f / 256.f)));
#pragma unroll
        for (int bb = 0; bb < 16; ++bb) buf[fphys(k1, ka, bb)] = w[bb];
    }
    __syncthreads();
    fft_inv_B1_A(v, buf, tid);
    asm volatile("" ::: "memory");
    int tq = tid; asm volatile("" : "+v"(tq));
    const bf16_t* g0 = hyT + ((size_t)((bp * 2 + 0) * 3 + O) * 256 + c) * 4096 + tq;
    const bf16_t* g1 = hyT + ((size_t)((bp * 2 + 1) * 3 + O) * 256 + c) * 4096 + tq;
    const float sc = 1.f / 8192.f;
#pragma unroll
    for (int j = 0; j < 16; ++j) {
        const float ga = bf2f(g0[256 * j]) * sc, gb = bf2f(g1[256 * j]) * sc;
        v[j] = make_float2(ga * v[j].x, gb * v[j].y);
    }
    __syncthreads();
}

__device__ __forceinline__ void hyena_fft_unit(const P& p, int l, int u, char* lds) {
    const int tid = otid();
    const int c = u >> 2, bp = u & 3;
    float2* buf = (float2*)lds;
    const bf16_t* hyT = (const bf16_t*)(p.ws + WS_HYT);
    bf16_t* cat = (bf16_t*)(p.ws + WS_CAT);
    float2 v[32];
    {
        const bf16_t* v0p = hyT + ((size_t)((bp * 2 + 0) * 3 + 2) * 256 + c) * 4096 + tid;
        const bf16_t* v1p = hyT + ((size_t)((bp * 2 + 1) * 3 + 2) * 256 + c) * 4096 + tid;
#pragma unroll
        for (int j = 0; j < 16; ++j) v[j] = make_float2(bf2f(v0p[256 * j]), bf2f(v1p[256 * j]));
    }
    hyena_conv_pass<0>(p, c, bp, tid, v, buf);
    hyena_conv_pass<1>(p, c, bp, tid, v, buf);
    int tq = tid; asm volatile("" : "+v"(tq));
#pragma unroll
    for (int j = 0; j < 16; ++j) {
        const int t = tq + 256 * j;
        cat[(size_t)(NTC + (bp * 2 + 0) * 4096 + t) * DM + 512 + c] = f2bf(v[j].x);
        cat[(size_t)(NTC + (bp * 2 + 1) * 4096 + t) * DM + 512 + c] = f2bf(v[j].y);
    }
}

__device__ __forceinline__ void rwkv_post_unit(const P& p, int l, int u, char* lds) {
    const int tid = otid(), c = tid;
    float* sg = (float*)lds;
    const bf16_t* z = (const bf16_t*)(p.ws + WS_Z);
    const bf16_t* rwp = (const bf16_t*)(p.ws + WS_R1 + R1_RWP);
    const bf16_t* ys = (const bf16_t*)(p.ws + WS_HBY);
    bf16_t* cat = (bf16_t*)(p.ws + WS_CAT);
    const int row0 = u * 32;
#pragma unroll
    for (int i = 0; i < 8; ++i) {
        const int idx = tid + 256 * i, tok = idx >> 6, j = idx & 63;
        sg[idx] = sigm(bf2f(z[(size_t)(row0 + tok) * ZS + 896 + j]));
    }
    __syncthreads();
    float g2r[64];
#pragma unroll
    for (int r = 0; r < 64; ++r) g2r[r] = p.in(I_RW_G2)[(size_t)(l * 64 + r) * 256 + c];
    const float ka = p.in(I_RW_KA)[l * 256 + c], rk = p.in(I_RW_RK)[l * 256 + c];
    const float gng = p.in(I_RW_GNG)[l * 256 + c], gnb = p.in(I_RW_GNB)[l * 256 + c];
#pragma unroll 2
    for (int tok = 0; tok < 32; ++tok) {
        const int row = row0 + tok;
        float g = 0.f;
#pragma unroll
        for (int r = 0; r < 64; r += 4) {
            const float4 x = *reinterpret_cast<const float4*>(sg + tok * 64 + r);
            g += x.x * g2r[r] + x.y * g2r[r + 1] + x.z * g2r[r + 2] + x.w * g2r[r + 3];
        }
        const float y = bf2f(ys[(size_t)row * 256 + c]) + bf2f(ys[(size_t)NT * 256 + (size_t)row * 256 + c]);
        const float mu = wave_sum(y) * (1.f / 64.f);
        const float dv = y - mu;
        const float var = wave_sum(dv * dv) * (1.f / 64.f);
        const float yn = dv * rsqrtf(var + 64e-5f) * gng + gnb;
        const bf16_t* zr = z + (size_t)row * ZS;
        const float r = bf2f(zr[c]), k = bf2f(zr[256 + c]), v = bf2f(zr[512 + c]);
        const float a0 = bf2f(rwp[((size_t)row * 4 + 2) * 256 + c]), a1 = bf2f(rwp[((size_t)row * 4 + 3) * 256 + c]);
        const float kd = k * (1.f + (a0 - 1.f) * ka) + k * (1.f + (a1 - 1.f) * ka);
        const float dot = wave_sum(r * kd * rk);
        cat[(size_t)row * DM + c] = f2bf((yn + dot * v) * g);
    }
    __syncthreads();
}

__device__ __forceinline__ void gdn_post_unit(const P& p, int l, int u) {
    const int tid = otid(), c = tid;
    const bf16_t* z = (const bf16_t*)(p.ws + WS_Z);
    const bf16_t* ys = (const bf16_t*)(p.ws + WS_HBY) + (size_t)2 * NT * 256;
    bf16_t* cat = (bf16_t*)(p.ws + WS_CAT);
    const float ng = p.in(I_GD_NORM)[l * 64 + (c & 63)];
    const int row0 = u * 32;
#pragma unroll 4
    for (int tok = 0; tok < 32; ++tok) {
        const int row = row0 + tok;
        const float o = bf2f(ys[(size_t)row * 256 + c]) + bf2f(ys[(size_t)NT * 256 + (size_t)row * 256 + c]);
        const float ms = wave_sum(o * o) * (1.f / 64.f);
        const float zg = bf2f(z[(size_t)row * ZS + COL_GD + 768 + c]);
        cat[(size_t)row * DM + 256 + c] = f2bf(o * rsqrtf(ms + 1e-6f) * ng * siluf(zg));
    }
}

#define NPHASE 36
template <typename F>
__device__ __forceinline__ void strided(int n, F f) { for (int u = blockIdx.x; u < n; u += gridDim.x) f(u); }

__global__ void __launch_bounds__(NTHREADS, 2) fwd_kernel(KP kp) {
    extern __shared__ __attribute__((aligned(16))) char smem[];
    char* lds = smem + LDS_USER;
    {
    const int tid = otid();
    if (tid == 0) *reinterpret_cast<uint4*>(smem) = make_uint4(0u, 0u, 0u, 0u);
    if (tid < 52) { const unsigned long long v = (unsigned long long)kp.in[tid]; ((unsigned*)(smem + 512))[2 * tid] = (unsigned)v; ((unsigned*)(smem + 512))[2 * tid + 1] = (unsigned)(v >> 32); }
    }
    __syncthreads();
    P p; p.tab = (const __attribute__((address_space(3))) unsigned*)(smem + 512); p.out = kp.out; p.ws = kp.ws;
    unsigned* ctl = (unsigned*)(p.ws + WS_CTL);
    XcdBarrier bar = xcd_barrier_post(ctl, (volatile LAS unsigned*)smem);
    const int lo = kp.ph_lo, hi = kp.ph_hi;
#define PHASE_BEGIN(ph) if ((ph) >= lo && (ph) < hi) { if ((ph) > lo) { xcd_barrier(bar); }
#define PHASE_END }
#define LANE_IDS const int tid = otid(); const int wid = tid >> 6, lane = tid & 63, wr = wid >> 1, wc = wid & 1, fr = lane & 15, fq = lane >> 4; (void)wid; (void)lane; (void)wr; (void)wc; (void)fr; (void)fq;

    PHASE_BEGIN(0)
        strided(192 + 64 + 32, [&](int u) {
            if (u < 192) ph0_mod_unit(p, u, lds);
            else if (u < 256) ph0_s5tab_unit(p, u - 192);
            else { const int v = u - 256, ll = v >> 4, t = v & 15;
                   xpose_tile(p.in(I_S5_GLUW) + (size_t)ll * 65536, 256, (bf16_t*)(p.ws + WS_GLUT) + (size_t)ll * 65536, 256, 0, t >> 2, t & 3, lds); }
        });
    PHASE_END

#pragma unroll 1
    for (int l = 0; l < 2; ++l) {
        const int pb = 1 + 17 * l;
        PHASE_BEGIN(pb + 0)
            strided(4352 + 1088 + 768 + 256, [&](int u) {
                if (u < 4352) { if (l == 0) rows_unit<M_INIT>(p, l, u, lds); else rows_unit<M_LN2NEXT>(p, l, u, lds); }
                else if (u < 5440) filt_unit(p, l, u - 4352, lds);
                else if (u < 6208) { const int v = u - 5440; xpose_tile(p.in(I_WIN) + (size_t)l * 1024 * 3024, 3024, (bf16_t*)(p.ws + WS_WINT), 1024, 0, v / 48, v % 48, lds); }
                else { const int v = u - 6208; xpose_tile(p.in(I_WOUT) + (size_t)l * 1024 * 1024, 1024, (bf16_t*)(p.ws + WS_WOUTT), 1024, 0, v >> 4, v & 15, lds); }
            });
        PHASE_END
        PHASE_BEGIN(pb + 1)
            strided(272 * 24, [&](int u) {
                LANE_IDS
                const int mt = u / 24, nt = u % 24;
                f32x4 acc[4][4];
                gemm_tile((const bf16_t*)(p.ws + WS_HBY), DM, mt * 128 + (tid >> 2), mt * 128 + (tid >> 2) + 64,
                          (const bf16_t*)(p.ws + WS_WINT), DM, nt * 128, DM, lds, acc);
                bf16_t* z = (bf16_t*)(p.ws + WS_Z);
#pragma unroll
                for (int m = 0; m < 4; ++m)
#pragma unroll
                    for (int n = 0; n < 4; ++n) {
                        const int col = nt * 128 + wc * 64 + n * 16 + fr;
                        if (col < ZS) {
#pragma unroll
                            for (int j = 0; j < 4; ++j) z[(size_t)(mt * 128 + wr * 64 + m * 16 + fq * 4 + j) * ZS + col] = f2bf(acc[m][n][j]);
                        }
                    }
            });
        PHASE_END
        PHASE_BEGIN(pb + 2)
            strided(512 + 512 + 1088 + 1088 + 4352, [&](int u) {
                if (u < 512) hfft_unit(p, l, u, lds);
                else if (u < 1024) hyena_prep_unit(p, l, u - 512, lds);
                else if (u < 2112) rwkv_prep_unit(p, l, u - 1024, lds);
                else if (u < 3200) gdn_prep_unit(p, l, u - 2112);
                else s5_pre_unit(p, l, u - 3200, lds);
            });
        PHASE_END
        PHASE_BEGIN(pb + 3)
            {
                int* qslot = (int*)(smem + 64);
                const int NU = 256 + 1024 + 544 + 1024;
                for (;;) {
                    if (otid() == 0) *qslot = (int)atomicAdd(&ctl[CW_QUEUE(l) + kp.rep], 1u);
                    __syncthreads();
                    const int u = *qslot;
                    __syncthreads();
                    if (u >= NU) break;
                    if (u < 256) scan_unit(p, l, u, lds);
                    else if (u < 1280) hyena_fft_unit(p, l, u - 256, lds);
                    else if (u < 1824) { if (kp.rep == 0) s5_main_unit(p, l, u - 1280, lds); }
                    else hyena_unit<256>(p, l, u - 1824, lds);
                    __syncthreads();
                }
            }
        PHASE_END
        PHASE_BEGIN(pb + 4)
            strided(1088 + 1088 + 544, [&](int u) {
                if (u < 1088) rwkv_post_unit(p, l, u, lds);
                else if (u < 2176) gdn_post_unit(p, l, u - 1088);
                else {
                    LANE_IDS
                    const int v = u - 2176, mt = v >> 1, nt = v & 1;
                    f32x4 acc[4][4];
                    const bf16_t* A = (const bf16_t*)(p.ws + WS_Z) + COL_S5;
                    gemm_tile(A, ZS, mt * 128 + (tid >> 2), mt * 128 + (tid >> 2) + 64,
                              (const bf16_t*)(p.ws + WS_GLUT) + (size_t)l * 65536, 256, nt * 128, 256, lds, acc);
                    bf16_t* cat = (bf16_t*)(p.ws + WS_CAT);
#pragma unroll
                    for (int m = 0; m < 4; ++m)
#pragma unroll
                        for (int n = 0; n < 4; ++n) {
                            const int col = nt * 128 + wc * 64 + n * 16 + fr;
                            const float gb = p.in(I_S5_GLUB)[l * 256 + col];
#pragma unroll
                            for (int j = 0; j < 4; ++j) {
                                const int row = mt * 128 + wr * 64 + m * 16 + fq * 4 + j;
                                const float yg = bf2f(A[(size_t)row * ZS + col]);
                                cat[(size_t)row * DM + 768 + col] = f2bf(yg * sigm(acc[m][n][j] + gb));
                            }
                        }
                }
            });
        PHASE_END
        PHASE_BEGIN(pb + 5)
            strided(272 * 8 + 65 * 192, [&](int u) {
                if (u < 2176) {
                    LANE_IDS
                    const int mt = u >> 3, nt = u & 7;
                    f32x4 acc[4][4];
                    gemm_tile((const bf16_t*)(p.ws + WS_CAT), DM, mt * 128 + (tid >> 2), mt * 128 + (tid >> 2) + 64,
                              (const bf16_t*)(p.ws + WS_WOUTT), DM, nt * 128, DM, lds, acc);
#pragma unroll
                    for (int m = 0; m < 4; ++m)
#pragma unroll
                        for (int j = 0; j < 4; ++j) {
                            const int row = mt * 128 + wr * 64 + m * 16 + fq * 4 + j;
                            float* xr = xrow(p, row);
                            const float* ga = modp(p, l, row_mod(row), 2);
#pragma unroll
                            for (int n = 0; n < 4; ++n) {
                                const int col = nt * 128 + wc * 64 + n * 16 + fr;
                                if (kp.rep == 0) xr[col] = ALPHA * xr[col] + ga[col] * acc[m][n][j];
                            }
                        }
                } else {
                    const int v = u - 2176, e = v / 192, t = v % 192, which = t >> 6, tt = t & 63;
                    bf16_t* W13 = (bf16_t*)(p.ws + WS_R1 + R1_W13T) + (size_t)e * 512 * 1024;
                    bf16_t* W2 = (bf16_t*)(p.ws + WS_R1 + R1_W2T) + (size_t)e * 1024 * 256;
                    if (which == 0) {
                        const float* src = (e < 64) ? p.in(I_EX_W1) + ((size_t)l * 64 + e) * 262144 : p.in(I_SH_W1) + (size_t)l * 262144;
                        xpose_tile(src, 256, W13, 1024, 1, tt >> 2, tt & 3, lds);
                    } else if (which == 1) {
                        const float* src = (e < 64) ? p.in(I_EX_W3) + ((size_t)l * 64 + e) * 262144 : p.in(I_SH_W3) + (size_t)l * 262144;
                        xpose_tile(src, 256, W13, 1024, 2, tt >> 2, tt & 3, lds);
                    } else {
                        const float* src = (e < 64) ? p.in(I_EX_W2) + ((size_t)l * 64 + e) * 262144 : p.in(I_SH_W2) + (size_t)l * 262144;
                        xpose_tile(src, 1024, W2, 256, 0, tt >> 4, tt & 15, lds);
                    }
                }
            });
        PHASE_END
        PHASE_BEGIN(pb + 6)
            strided(4352, [&](int u) { rows_unit<M_LN1>(p, l, u, lds, kp.rep > 0); __syncthreads(); });
        PHASE_END
        PHASE_BEGIN(pb + 7)
            {
                int* tb = (int*)lds;
                const int tid = otid();
                const unsigned* cnt = ctl + CW_CNT(l);
                if (tid == 0) { int a = 0; for (int e = 0; e < 64; ++e) { tb[e] = a; a += ((int)xb_ld((unsigned*)&cnt[e]) + 127) >> 7; } tb[64] = a; }
                __syncthreads();
                const int* aep = (const int*)(p.ws + WS_AEP); const float* aw = (const float*)(p.ws + WS_AW);
                int* rtok = (int*)(p.ws + WS_RTOK); float* rwt = (float*)(p.ws + WS_RW); int* tile_e = (int*)(p.ws + WS_TILEE);
                for (int a = blockIdx.x * NTHREADS + tid; a < NT * 8; a += gridDim.x * NTHREADS) {
                    const unsigned v = (unsigned)aep[a];
                    const int e = v >> 24, pos = v & 0xFFFFFF;
                    const int dest = tb[e] * 128 + pos;
                    rtok[dest] = a >> 3; rwt[dest] = aw[a];
                }
                for (int e = blockIdx.x; e < 64; e += gridDim.x) {
                    const int c0 = (int)xb_ld((unsigned*)&cnt[e]), nt_e = (c0 + 127) >> 7;
                    for (int q = c0 + tid; q < nt_e * 128; q += NTHREADS) { rtok[tb[e] * 128 + q] = -1; rwt[tb[e] * 128 + q] = 0.f; }
                    for (int q = tid; q < nt_e; q += NTHREADS) tile_e[tb[e] + q] = e;
                }
                __syncthreads();
            }
        PHASE_END
        PHASE_BEGIN(pb + 8)
            {
                int* sh = (int*)(smem + 128);
                if (otid() == 0) { const unsigned* cnt = ctl + CW_CNT(l); int a = 0; for (int e = 0; e < 64; ++e) a += ((int)xb_ld((unsigned*)&cnt[e]) + 127) >> 7; *sh = a; }
                __syncthreads();
                const int ntr = *sh;
                const int* rtok = (const int*)(p.ws + WS_RTOK); const int* tile_e = (const int*)(p.ws + WS_TILEE);
                strided((ntr + 272) * 4, [&](int u) {
                    LANE_IDS
                    const int tile = u >> 2, jn = u & 3;
                    int e, ra, rb, obase;
                    if (tile < ntr) {
                        e = tile_e[tile]; obase = tile * 128;
                        ra = rtok[obase + (tid >> 2)]; rb = rtok[obase + (tid >> 2) + 64];
                        ra = ra < 0 ? 0 : ra; rb = rb < 0 ? 0 : rb;
                    } else {
                        const int stt = tile - ntr; e = 64; obase = (SH_TILE_BASE + stt) * 128;
                        ra = stt * 128 + (tid >> 2); rb = ra + 64;
                    }
                    f32x4 acc[4][4];
                    gemm_tile((const bf16_t*)(p.ws + WS_HBY), DM, ra, rb,
                              (const bf16_t*)(p.ws + WS_R1 + R1_W13T) + (size_t)e * 512 * 1024, DM, jn * 128, DM, lds, acc);
                    bf16_t* act = (bf16_t*)(p.ws + WS_ACT);
#pragma unroll
                    for (int m = 0; m < 4; ++m)
#pragma unroll
                        for (int pp = 0; pp < 2; ++pp)
#pragma unroll
                            for (int j = 0; j < 4; ++j) {
                                const float g = acc[m][2 * pp][j], uu = acc[m][2 * pp + 1][j];
                                const int orow = obase + wr * 64 + m * 16 + fq * 4 + j;
                                const int col = jn * 64 + wc * 32 + pp * 16 + fr;
                                act[(size_t)orow * 256 + col] = f2bf(siluf(g) * uu);
                            }
                });
            }
        PHASE_END
#pragma unroll 1
        for (int sl = 0; sl < 4; ++sl) {
            PHASE_BEGIN(pb + 9 + 2 * sl)
            {
                int* sh = (int*)(smem + 128);
                if (otid() == 0) { const unsigned* cnt = ctl + CW_CNT(l); int a = 0; for (int e = 0; e < 64; ++e) a += ((int)xb_ld((unsigned*)&cnt[e]) + 127) >> 7; *sh = a; }
                __syncthreads();
                const int ntr = *sh;
                const int* tile_e = (const int*)(p.ws + WS_TILEE);
                strided((ntr + 272) * 2, [&](int u) {
                    LANE_IDS
                    const int tile = u >> 1, nt2 = u & 1;
                    int e, obase;
                    if (tile < ntr) { e = tile_e[tile]; obase = tile * 128; }
                    else { e = 64; obase = (SH_TILE_BASE + tile - ntr) * 128; }
                    f32x4 acc[4][4];
                    gemm_tile((const bf16_t*)(p.ws + WS_ACT), 256, obase + (tid >> 2), obase + (tid >> 2) + 64,
                              (const bf16_t*)(p.ws + WS_R1 + R1_W2T) + (size_t)e * 1024 * 256, 256, sl * 256 + nt2 * 128, 256, lds, acc);
                    bf16_t* y2 = (bf16_t*)(p.ws + WS_Y2);
#pragma unroll
                    for (int m = 0; m < 4; ++m)
#pragma unroll
                        for (int j = 0; j < 4; ++j) {
                            const int orow = obase + wr * 64 + m * 16 + fq * 4 + j;
#pragma unroll
                            for (int n = 0; n < 4; ++n) y2[(size_t)orow * 256 + nt2 * 128 + wc * 64 + n * 16 + fr] = f2bf(acc[m][n][j]);
                        }
                });
            }
            PHASE_END
            PHASE_BEGIN(pb + 10 + 2 * sl)
            {
                int* tb = (int*)lds;
                const int tid = otid();
                const unsigned* cnt = ctl + CW_CNT(l);
                if (tid == 0) { int a = 0; for (int e = 0; e < 64; ++e) { tb[e] = a; a += ((int)xb_ld((unsigned*)&cnt[e]) + 127) >> 7; } tb[64] = a; }
                __syncthreads();
                const int* aep = (const int*)(p.ws + WS_AEP); const float* aw = (const float*)(p.ws + WS_AW);
                const bf16_t* y2 = (const bf16_t*)(p.ws + WS_Y2);
                const int tl = tid >> 5, cg = tid & 31;
                for (int grp = blockIdx.x; grp < NT / 8; grp += gridDim.x) {
                    const int tok = grp * 8 + tl;
                    float a8[8];
                    {
                        const uint4 sv = *reinterpret_cast<const uint4*>(y2 + ((size_t)(SH_TILE_BASE * 128 + tok)) * 256 + cg * 8);
                        a8[0] = bflo(sv.x); a8[1] = bfhi(sv.x); a8[2] = bflo(sv.y); a8[3] = bfhi(sv.y);
                        a8[4] = bflo(sv.z); a8[5] = bfhi(sv.z); a8[6] = bflo(sv.w); a8[7] = bfhi(sv.w);
                    }
#pragma unroll
                    for (int k = 0; k < 8; ++k) {
                        const unsigned v = (unsigned)aep[(size_t)tok * 8 + k];
                        const float wk = aw[(size_t)tok * 8 + k];
                        const int dest = tb[v >> 24] * 128 + (int)(v & 0xFFFFFFu);
                        const uint4 yv = *reinterpret_cast<const uint4*>(y2 + (size_t)dest * 256 + cg * 8);
                        a8[0] += wk * bflo(yv.x); a8[1] += wk * bfhi(yv.x); a8[2] += wk * bflo(yv.y); a8[3] += wk * bfhi(yv.y);
                        a8[4] += wk * bflo(yv.z); a8[5] += wk * bfhi(yv.z); a8[6] += wk * bflo(yv.w); a8[7] += wk * bfhi(yv.w);
                    }
                    float* xr = xrow(p, tok) + sl * 256 + cg * 8;
                    const float* ga = modp(p, l, row_mod(tok), 5) + sl * 256 + cg * 8;
                    float4 x0 = *reinterpret_cast<const float4*>(xr), x1 = *reinterpret_cast<const float4*>(xr + 4);
                    const float4 g0 = *reinterpret_cast<const float4*>(ga), g1 = *reinterpret_cast<const float4*>(ga + 4);
                    x0.x += g0.x * a8[0]; x0.y += g0.y * a8[1]; x0.z += g0.z * a8[2]; x0.w += g0.w * a8[3];
                    x1.x += g1.x * a8[4]; x1.y += g1.y * a8[5]; x1.z += g1.z * a8[6]; x1.w += g1.w * a8[7];
                    *reinterpret_cast<float4*>(xr) = x0; *reinterpret_cast<float4*>(xr + 4) = x1;
                }
                __syncthreads();
            }
            PHASE_END
        }
    }
    PHASE_BEGIN(35)
        strided(4352, [&](int u) { rows_unit<M_FINAL>(p, 1, u, lds); });
    PHASE_END
}

#ifndef N_LAUNCH_MODE
#define N_LAUNCH_MODE 1
#endif
extern "C" void kernel_launch(void* const* d_in, const int* in_sizes, int n_in, void* d_out, int out_size, void* d_ws, size_t ws_size, hipStream_t stream) {
    static int grid = 0;
    if (grid == 0) {
        if (n_in != 52 || out_size != NTL * DM || ws_size < WS_END) { fprintf(stderr, "kernel_launch: unexpected shapes (n_in %d out %d ws %zu need %zu)\n", n_in, out_size, ws_size, (size_t)WS_END); grid = -1; return; }
        int dev = 0, cus = 0, per_cu = 0;
        hipGetDevice(&dev);
        hipDeviceGetAttribute(&cus, hipDeviceAttributeMultiprocessorCount, dev);
        hipFuncSetAttribute((const void*)fwd_kernel, hipFuncAttributeMaxDynamicSharedMemorySize, LDS_BYTES);
        hipOccupancyMaxActiveBlocksPerMultiprocessor(&per_cu, (const void*)fwd_kernel, NTHREADS, LDS_BYTES);
        (void)hipGetLastError();
        if (per_cu < 1) per_cu = 1;
        if (per_cu > 2) per_cu = 2;
        grid = cus * per_cu;
    }
    if (grid < 0) return;
    hipMemsetAsync((char*)d_ws + WS_CTL, 0, CTL_BYTES, stream);
    KP p{};
    for (int i = 0; i < 52; ++i) p.in[i] = (const float*)d_in[i];
    p.out = (float*)d_out; p.ws = (char*)d_ws;
#if defined(PROBE_PH)
    for (int ph = 0; ph < NPHASE; ++ph) {
        const int reps = (ph == PROBE_PH) ? 1 + PROBE_N : 1;
        for (int r = 0; r < reps; ++r) { p.ph_lo = ph; p.ph_hi = ph + 1; p.rep = r; hipLaunchKernelGGL(fwd_kernel, dim3(grid), dim3(NTHREADS), LDS_BYTES, stream, p); }
    }
#elif N_LAUNCH_MODE == 1
    p.ph_lo = 0; p.ph_hi = NPHASE;
    hipLaunchKernelGGL(fwd_kernel, dim3(grid), dim3(NTHREADS), LDS_BYTES, stream, p);
#else
    for (int ph = 0; ph < NPHASE; ++ph) {
        p.ph_lo = ph; p.ph_hi = ph + 1;
        hipLaunchKernelGGL(fwd_kernel, dim3(grid), dim3(NTHREADS), LDS_BYTES, stream, p);
    }
#endif
}
```

```cpp
#include <hip/hip_runtime.h>
#include <hip/hip_bf16.h>
#include <hip/hip_fp16.h>
#include <stdint.h>
#include <stdio.h>

typedef unsigned short bf16_t;
using bf16x8 = __attribute__((ext_vector_type(8))) short;
using f32x4 = __attribute__((ext_vector_type(4))) float;

#define NTC 2048
#define NTL 32768
#define NT 34816
#define DM 1024
#define ZS 3024
#define COL_GD 960
#define COL_HY 2000
#define COL_S5 2768
#define NCHUNK 68
#define ALPHA 1.41421356237f
#define NTHREADS 256
#define LDS_BYTES 73728
#define LDS_USER 1024
#define SH_TILE_BASE 2240
#define ACT_ROWS ((SH_TILE_BASE + 272) * 128)

constexpr size_t al256(size_t x) { return (x + 255) & ~(size_t)255; }
constexpr size_t WS_CTL = 0;
constexpr size_t CTL_BYTES = 65536;
constexpr size_t WS_MOD = WS_CTL + CTL_BYTES;
constexpr size_t WS_S5A = al256(WS_MOD + 2 * 9 * 6144 * 4);
constexpr size_t WS_S5B = al256(WS_S5A + 2 * 2 * 16 * 64 * 4 * 4);
constexpr size_t WS_GLUT = al256(WS_S5B + 2 * 2 * 16 * 64 * 32 * 4);
constexpr size_t WS_WINT = al256(WS_GLUT + 2 * 256 * 256 * 2);
constexpr size_t WS_WOUTT = al256(WS_WINT + (size_t)3072 * 1024 * 2);
constexpr size_t WS_FILTL = al256(WS_WOUTT + (size_t)1024 * 1024 * 2);
constexpr size_t WS_FILTC = al256(WS_FILTL + (size_t)4 * 256 * 4096 * 4);
constexpr size_t WS_XC = al256(WS_FILTC + (size_t)4 * 256 * 256 * 4);
constexpr size_t WS_HBY = al256(WS_XC + (size_t)NTC * DM * 4);
constexpr size_t WS_CAT = al256(WS_HBY + (size_t)NT * DM * 2);
constexpr size_t WS_Z = al256(WS_CAT + (size_t)NT * DM * 2);
constexpr size_t WS_R1 = al256(WS_Z + (size_t)NT * ZS * 2);
constexpr size_t R1_RWP = 0;
constexpr size_t R1_GQ = (size_t)NT * 1024 * 2;
constexpr size_t R1_W13T = 0;
constexpr size_t R1_W2T = (size_t)65 * 512 * 1024 * 2;
constexpr size_t R1_BYTES = (size_t)NT * 1024 * 2 + (size_t)NT * 768 * 2;
constexpr size_t WS_KNORM = al256(WS_R1 + R1_BYTES);
constexpr size_t WS_GAB = al256(WS_KNORM + (size_t)NT * 4 * 4);
constexpr size_t WS_S5ST = al256(WS_GAB + (size_t)NT * 16 * 4);
constexpr size_t WS_AEP = al256(WS_S5ST + (size_t)8 * 68 * 2 * 16 * 64 * 2 * 4);
constexpr size_t WS_AW = al256(WS_AEP + (size_t)NT * 8 * 4);
constexpr size_t WS_RTOK = al256(WS_AW + (size_t)NT * 8 * 4);
constexpr size_t WS_RW = al256(WS_RTOK + (size_t)SH_TILE_BASE * 128 * 4);
constexpr size_t WS_TILEE = al256(WS_RW + (size_t)SH_TILE_BASE * 128 * 4);
constexpr size_t WS_HYT = al256(WS_TILEE + SH_TILE_BASE * 4);
constexpr size_t WS_END = al256(WS_HYT + (size_t)8 * 768 * 4096 * 2);
static_assert(R1_W2T + (size_t)65 * 1024 * 256 * 2 <= R1_BYTES, "expert weights must fit R1");
constexpr size_t ACT_BYTES = (size_t)ACT_ROWS * 256 * 2;
constexpr size_t WS_ACT = WS_Z + ((((size_t)NT * ZS * 2 - ACT_BYTES) >> 8) << 8);
constexpr size_t WS_Y2 = WS_HBY;
static_assert(WS_Y2 + ACT_BYTES <= WS_ACT, "y2 must not reach act");

#define CW_QUEUE(l) (4096 + 64 * (l))
#define CW_CNT(l) (4352 + 64 * (l))

#define XB_TMO      128
#define XB_XCNT(j)  (256  + 64 * (j))
#define XB_XSUB(j)  (1280 + 64 * (j))
#define XB_XGEN(j)  (2304 + 64 * (j))
#define XB_TOP      3328
#define XB_TOPGEN   3392
#define XCD_BAR_WORDS 3456
#define XB_SPIN_CAP (1u << 18)
#define LAS __attribute__((address_space(3)))

__device__ __forceinline__ unsigned xb_ld(unsigned* p)              { return __hip_atomic_load(p, __ATOMIC_RELAXED, __HIP_MEMORY_SCOPE_AGENT); }
__device__ __forceinline__ unsigned xb_add(unsigned* p, unsigned v) { return __hip_atomic_fetch_add(p, v, __ATOMIC_RELAXED, __HIP_MEMORY_SCOPE_AGENT); }
__device__ __forceinline__ unsigned xb_xcc_id() { return (unsigned)__builtin_amdgcn_s_getreg((3 << 11) | 20) & 0xFu; }
#define XB_SPIN(cond, bar) do { unsigned _sp = 0; while (cond) { __builtin_amdgcn_s_sleep(1); \
    if ((++_sp & 255u) == 0u) { if (xb_ld(&(bar)[XB_TMO])) break; if (_sp > XB_SPIN_CAP) { atomicAdd(&(bar)[XB_TMO], 1u); break; } } } } while (0)

struct XcdBarrier {
    unsigned* bar; unsigned x;
    volatile LAS unsigned* st;
};
__device__ __forceinline__ XcdBarrier xcd_barrier_post(unsigned* bar, volatile LAS unsigned* st) {
    XcdBarrier b; b.bar = bar; b.x = xb_xcc_id(); b.st = st;
    if (threadIdx.x == 0) (void)xb_add(&bar[XB_XCNT(b.x)], 1u);
    return b;
}
__device__ __forceinline__ void xcd_barrier_complete(unsigned* bar, unsigned x, unsigned& nloc, unsigned& nx) {
    const unsigned G = gridDim.x * gridDim.y * gridDim.z;
    unsigned sum, cnt, mine, sp = 0u;
    for (;;) {
        sum = 0u; cnt = 0u; mine = 0u;
#pragma unroll
        for (unsigned j = 0; j < 16; ++j) { const unsigned c = xb_ld(&bar[XB_XCNT(j)]); sum += c; cnt += (c > 0u) ? 1u : 0u; mine = (j == x) ? c : mine; }
        if (sum == G) break;
        __builtin_amdgcn_s_sleep(1);
        if ((++sp & 255u) == 0u) { if (xb_ld(&bar[XB_TMO])) break; if (sp > XB_SPIN_CAP) { atomicAdd(&bar[XB_TMO], 1u); break; } }
    }
    nloc = mine > 0u ? mine : 1u; nx = cnt > 0u ? cnt : 1u;
}
__device__ __forceinline__ void xcd_barrier(const XcdBarrier& b) {
    asm volatile("s_waitcnt vmcnt(0)" ::: "memory");
    __syncthreads();
    if (threadIdx.x == 0) {
        unsigned* bar = b.bar;
        __builtin_amdgcn_s_waitcnt(0);
        unsigned nloc = b.st[0], nx = b.st[1];
        if (nloc == 0u) { xcd_barrier_complete(bar, b.x, nloc, nx); b.st[0] = nloc; b.st[1] = nx; }
        const unsigned old = xb_add(&bar[XB_XSUB(b.x)], 1u);
        const unsigned gen = old / nloc;
        if (old + 1u == (gen + 1u) * nloc) {
            __builtin_amdgcn_fence(__ATOMIC_RELEASE, "agent");
            asm volatile("s_waitcnt vmcnt(0)" ::: "memory");
            const unsigned og = xb_add(&bar[XB_TOP], 1u);
            const unsigned tg = og / nx;
            if (og + 1u == (tg + 1u) * nx) xb_add(&bar[XB_TOPGEN], 1u);
            else XB_SPIN(xb_ld(&bar[XB_TOPGEN]) == tg, bar);
            __builtin_amdgcn_fence(__ATOMIC_ACQUIRE, "agent");
            xb_add(&bar[XB_XGEN(b.x)], 1u);
            asm volatile("s_waitcnt vmcnt(0)" ::: "memory");
        } else {
            XB_SPIN(xb_ld(&bar[XB_XGEN(b.x)]) == gen, bar);
            __builtin_amdgcn_fence(__ATOMIC_ACQUIRE, "agent");
            asm volatile("s_waitcnt vmcnt(0)" ::: "memory");
        }
    }
    __syncthreads();
}

struct KP {
    const float* in[52];
    float* out;
    char* ws;
    int ph_lo, ph_hi, rep, pad_;
};
struct P {
    const __attribute__((address_space(3))) unsigned* tab;
    float* out;
    char* ws;
    __device__ __forceinline__ const float* in(int i) const {
        const unsigned lo = __builtin_amdgcn_readfirstlane(tab[2 * i]);
        const unsigned hi = __builtin_amdgcn_readfirstlane(tab[2 * i + 1]);
        return (const float*)(((unsigned long long)hi << 32) | (unsigned long long)lo);
    }
};
enum { I_X = 0, I_C, I_CTX, I_CCTX, I_ADAW, I_ADAB, I_WIN, I_WOUT, I_LNG, I_LNB,
       I_RW_W0, I_RW_W2, I_RW_A0, I_RW_A2, I_RW_G2, I_RW_KK, I_RW_KA, I_RW_RK, I_RW_GNG, I_RW_GNB,
       I_GD_CONV, I_GD_ALOG, I_GD_DTB, I_GD_NORM,
       I_HY_CONV, I_HY_CONVB, I_HY_W1, I_HY_B1, I_HY_F1, I_HY_W2, I_HY_B2, I_HY_F2, I_HY_W3, I_HY_SKIP,
       I_S5_LRE, I_S5_LIM, I_S5_LOGSTEP, I_S5_BRE, I_S5_BIM, I_S5_CRE, I_S5_CIM, I_S5_D, I_S5_GLUW, I_S5_GLUB,
       I_ROUTER_W, I_ROUTER_B, I_EX_W1, I_EX_W3, I_EX_W2, I_SH_W1, I_SH_W3, I_SH_W2 };

__device__ __forceinline__ bf16_t f2bf(float f) { unsigned u = __float_as_uint(f); u += 0x7fffu + ((u >> 16) & 1u); return (bf16_t)(u >> 16); }
__device__ __forceinline__ float bf2f(bf16_t h) { return __uint_as_float(((unsigned)h) << 16); }
__device__ __forceinline__ float bflo(unsigned u) { return __uint_as_float(u << 16); }
__device__ __forceinline__ float bfhi(unsigned u) { return __uint_as_float(u & 0xffff0000u); }
__device__ __forceinline__ unsigned pack2(float a, float b) { return (unsigned)f2bf(a) | ((unsigned)f2bf(b) << 16); }
__device__ __forceinline__ float sigm(float x) { return 1.f / (1.f + __expf(-x)); }
__device__ __forceinline__ float siluf(float x) { return x / (1.f + __expf(-x)); }
__device__ __forceinline__ float softplusf(float x) { return fmaxf(x, 0.f) + log1pf(__expf(-fabsf(x))); }
__device__ __forceinline__ float wave_sum(float v) {
#pragma unroll
    for (int o = 32; o >= 1; o >>= 1) v += __shfl_xor(v, o);
    return v;
}
template <int CTRL> __device__ __forceinline__ float dppf(float v) {
    return __int_as_float(__builtin_amdgcn_update_dpp(0, __float_as_int(v), CTRL, 0xF, 0xF, true));
}
__device__ __forceinline__ int otid() { int t = threadIdx.x; asm volatile("" : "+v"(t)); return t; }
__device__ __forceinline__ float* xrow(const P& p, int row) {
    return row < NTC ? (float*)(p.ws + WS_XC) + (size_t)row * DM : p.out + (size_t)(row - NTC) * DM;
}
__device__ __forceinline__ int row_mod(int row) { return row < NTC ? 8 : ((row - NTC) >> 12); }
__device__ __forceinline__ const float* modp(const P& p, int l, int r, int chunk) {
    return (const float*)(p.ws + WS_MOD) + ((size_t)(l * 9 + r) * 6144 + chunk * 1024);
}

struct ARows { int r[4]; };
__device__ __forceinline__ ARows arows_lin(int base, int tid) { ARows a; a.r[0] = base + (tid >> 3); a.r[1] = a.r[0] + 32; a.r[2] = a.r[0] + 64; a.r[3] = a.r[0] + 96; return a; }
__device__ __forceinline__ void gemm_tile(const bf16_t* __restrict__ A, int lda, const ARows& ar,
                                          const bf16_t* __restrict__ Bt, int ldb, int brow0, int K,
                                          char* lds, f32x4 (&acc)[4][4]) {
    const int tid = otid();
    const int wid = tid >> 6, lane = tid & 63, wr = wid >> 1, wc = wid & 1, fr = lane & 15, fq = lane >> 4;
    const int gc = ((tid & 7) ^ ((tid >> 3) & 7)) * 8;
    const bf16_t* ap[4]; const bf16_t* bp[4];
#pragma unroll
    for (int i = 0; i < 4; ++i) {
        ap[i] = A + (size_t)ar.r[i] * lda + gc;
        bp[i] = Bt + (size_t)(brow0 + (tid >> 3) + 32 * i) * ldb + gc;
    }
#pragma unroll
    for (int m = 0; m < 4; ++m)
#pragma unroll
        for (int n = 0; n < 4; ++n) acc[m][n] = f32x4{0.f, 0.f, 0.f, 0.f};
    const int nk = K >> 6;
    auto stage = [&](int t, int buf) {
        char* SA = lds + buf * 32768; char* SB = SA + 16384;
        const int ko = t * 64;
#pragma unroll
        for (int i = 0; i < 4; ++i) {
            __builtin_amdgcn_global_load_lds((const void*)(ap[i] + ko), (LAS void*)(SA + tid * 16 + i * 4096), 16, 0, 0);
            __builtin_amdgcn_global_load_lds((const void*)(bp[i] + ko), (LAS void*)(SB + tid * 16 + i * 4096), 16, 0, 0);
        }
    };
    stage(0, 0);
    asm volatile("s_waitcnt vmcnt(0)" ::: "memory");
    __syncthreads();
    const int sw = fr & 7;
    for (int t = 0; t < nk; ++t) {
        const int buf = t & 1;
        if (t + 1 < nk) stage(t + 1, buf ^ 1);
        const char* SA = lds + buf * 32768; const char* SB = SA + 16384;
#pragma unroll
        for (int ks = 0; ks < 2; ++ks) {
            const int co = ((ks * 4 + fq) ^ sw) * 16;
            bf16x8 af[4], bfr[4];
#pragma unroll
            for (int m = 0; m < 4; ++m) af[m] = *reinterpret_cast<const bf16x8*>(SA + (wr * 64 + m * 16 + fr) * 128 + co);
#pragma unroll
            for (int n = 0; n < 4; ++n) bfr[n] = *reinterpret_cast<const bf16x8*>(SB + (wc * 64 + n * 16 + fr) * 128 + co);
#pragma unroll
            for (int m = 0; m < 4; ++m)
#pragma unroll
                for (int n = 0; n < 4; ++n) acc[m][n] = __builtin_amdgcn_mfma_f32_16x16x32_bf16(af[m], bfr[n], acc[m][n], 0, 0, 0);
        }
        asm volatile("s_waitcnt vmcnt(0)" ::: "memory");
        __syncthreads();
    }
}

__device__ __forceinline__ void ph0_mod_unit(const P& p, int u, char* lds) {
    const int l = u / 96, cg = u % 96, tid = otid();
    float* s = (float*)lds;
    float* red = s + 9 * 1024;
    const float* c = p.in(I_C); const float* cctx = p.in(I_CCTX);
    for (int i = tid; i < 9 * 1024; i += NTHREADS) { int r = i >> 10, k = i & 1023; float v = r < 8 ? c[r * 1024 + k] : cctx[k]; s[i] = v / (1.f + expf(-v)); }
    __syncthreads();
    const int kq = tid >> 6, j = tid & 63, col = cg * 64 + j;
    const float* w = p.in(I_ADAW) + (size_t)l * 1024 * 6144 + col;
    float acc[9];
#pragma unroll
    for (int r = 0; r < 9; ++r) acc[r] = 0.f;
#pragma unroll 4
    for (int k = kq * 256; k < kq * 256 + 256; ++k) {
        const float wv = w[(size_t)k * 6144];
#pragma unroll
        for (int r = 0; r < 9; ++r) acc[r] += s[r * 1024 + k] * wv;
    }
#pragma unroll
    for (int r = 0; r < 9; ++r) red[(kq * 9 + r) * 64 + j] = acc[r];
    __syncthreads();
    if (tid < 64) {
        float* mod = (float*)(p.ws + WS_MOD);
        const float bb = p.in(I_ADAB)[l * 6144 + col];
#pragma unroll
        for (int r = 0; r < 9; ++r) mod[(size_t)(l * 9 + r) * 6144 + col] = red[r * 64 + j] + red[(9 + r) * 64 + j] + red[(18 + r) * 64 + j] + red[(27 + r) * 64 + j] + bb;
    }
    __syncthreads();
}

__device__ __forceinline__ void ph0_s5tab_unit(const P& p, int u) {
    const int tid = otid();
    if (tid >= 64) return;
    const int ldg = u;
    const int idx = ldg * 64 + tid;
    const double lre = (double)p.in(I_S5_LRE)[idx], lim = (double)p.in(I_S5_LIM)[idx];
    const double dt = (double)expf(p.in(I_S5_LOGSTEP)[ldg]);
    const float mag = expf((float)(lre * dt));
    double rev = lim * dt * 0.15915494309189535; rev -= floor(rev);
    float sn, cs; sincospif(2.f * (float)rev, &sn, &cs);
    const double abr = (double)(mag * cs), abi = (double)(mag * sn);
    const double den = lre * lre + lim * lim;
    const double cor = ((abr - 1.0) * lre + abi * lim) / den;
    const double coi = (abi * lre - (abr - 1.0) * lim) / den;
    const float m64f = expf((float)(64.0 * lre * dt));
    double rev64 = 64.0 * lim * dt * 0.15915494309189535; rev64 -= floor(rev64);
    float sn64, cs64; sincospif(2.f * (float)rev64, &sn64, &cs64);
    float* A = (float*)(p.ws + WS_S5A) + (size_t)idx * 4;
    A[0] = (float)abr; A[1] = (float)abi; A[2] = m64f * cs64; A[3] = m64f * sn64;
    float* B = (float*)(p.ws + WS_S5B) + (size_t)idx * 32;
    const float* bre = p.in(I_S5_BRE) + (size_t)idx * 16; const float* bim = p.in(I_S5_BIM) + (size_t)idx * 16;
#pragma unroll
    for (int h = 0; h < 16; ++h) {
        const double br = bre[h], bi = bim[h];
        B[h] = (float)(cor * br - coi * bi);
        B[16 + h] = (float)(cor * bi + coi * br);
    }
}

__device__ __forceinline__ int xmap(int mode, int c) {
    if (mode == 0) return c;
    const int j = c >> 6, cc = c & 63, wc = cc >> 5, pp = (cc & 31) >> 4, i = cc & 15;
    return j * 128 + wc * 64 + pp * 32 + i + (mode == 2 ? 16 : 0);
}
__device__ __forceinline__ void xpose_tile(const float* __restrict__ src, int C, bf16_t* __restrict__ dst, int ldd, int mode, int tr, int tc, char* lds) {
    float* t = (float*)lds;
    const int tid = otid(), tx = tid & 63, ty = tid >> 6;
#pragma unroll
    for (int k = 0; k < 16; ++k) {
        const int rr = ty + 4 * k, r = tr * 64 + rr, c = tc * 64 + tx;
        t[rr * 65 + tx] = (c < C) ? src[(size_t)r * C + c] : 0.f;
    }
    __syncthreads();
#pragma unroll
    for (int k = 0; k < 16; ++k) {
        const int ci = ty + 4 * k, c = tc * 64 + ci;
        dst[(size_t)xmap(mode, c) * ldd + tr * 64 + tx] = f2bf(t[tx * 65 + ci]);
    }
    __syncthreads();
}

enum { M_INIT = 0, M_LN2NEXT = 1, M_LN1 = 2, M_FINAL = 3 };

template <int MODE>
__device__ __forceinline__ void rows_unit(const P& p, int l, int u, char* lds, bool dry = false) {
    const int tid = otid(), w = tid >> 6, lane = tid & 63;
    float* hbuf = (float*)lds;
    bf16_t* hb = (bf16_t*)(p.ws + WS_HBY);
#pragma unroll 1
    for (int rr = 0; rr < 2; ++rr) {
        const int rl = w * 2 + rr, row = u * 8 + rl;
        const int mr = row_mod(row);
        float v[16];
        float* xr = xrow(p, row);
        const float* src = (MODE == M_INIT) ? (row < NTC ? p.in(I_CTX) + (size_t)row * DM : p.in(I_X) + (size_t)(row - NTC) * DM) : xr;
#pragma unroll
        for (int i = 0; i < 4; ++i) {
            const float4 t = *reinterpret_cast<const float4*>(src + i * 256 + lane * 4);
            v[i * 4 + 0] = t.x; v[i * 4 + 1] = t.y; v[i * 4 + 2] = t.z; v[i * 4 + 3] = t.w;
        }
        if (MODE != M_INIT) {
            const int ll = (MODE == M_LN2NEXT) ? l - 1 : l;
            const int which = (MODE == M_LN1) ? 0 : 1;
            float s = 0.f;
#pragma unroll
            for (int i = 0; i < 16; ++i) s += v[i];
            const float mu = wave_sum(s) * (1.f / 1024.f);
            float q = 0.f;
#pragma unroll
            for (int i = 0; i < 16; ++i) { const float d = v[i] - mu; q += d * d; }
            const float rstd = rsqrtf(wave_sum(q) * (1.f / 1024.f) + 1e-5f);
            const float* g = p.in(I_LNG) + (size_t)(ll * 2 + which) * 1024;
            const float* bb = p.in(I_LNB) + (size_t)(ll * 2 + which) * 1024;
#pragma unroll
            for (int i = 0; i < 4; ++i) {
                const float4 gg = *reinterpret_cast<const float4*>(g + i * 256 + lane * 4);
                const float4 b4 = *reinterpret_cast<const float4*>(bb + i * 256 + lane * 4);
                v[i * 4 + 0] = (v[i * 4 + 0] - mu) * rstd * gg.x + b4.x;
                v[i * 4 + 1] = (v[i * 4 + 1] - mu) * rstd * gg.y + b4.y;
                v[i * 4 + 2] = (v[i * 4 + 2] - mu) * rstd * gg.z + b4.z;
                v[i * 4 + 3] = (v[i * 4 + 3] - mu) * rstd * gg.w + b4.w;
            }
        }
        if (MODE == M_FINAL) {
            if (row >= NTC) {
#pragma unroll
                for (int i = 0; i < 4; ++i) *reinterpret_cast<float4*>(xr + i * 256 + lane * 4) = make_float4(v[i * 4], v[i * 4 + 1], v[i * 4 + 2], v[i * 4 + 3]);
            }
            continue;
        }
        const float osc = (MODE == M_LN1) ? ALPHA : 1.f;
#pragma unroll
        for (int i = 0; i < 4; ++i) if (!dry) *reinterpret_cast<float4*>(xr + i * 256 + lane * 4) = make_float4(osc * v[i * 4], osc * v[i * 4 + 1], osc * v[i * 4 + 2], osc * v[i * 4 + 3]);
        const float* sh = modp(p, l, mr, (MODE == M_LN1) ? 3 : 0);
        const float* sc = modp(p, l, mr, (MODE == M_LN1) ? 4 : 1);
#pragma unroll
        for (int i = 0; i < 4; ++i) {
            const float4 s4 = *reinterpret_cast<const float4*>(sc + i * 256 + lane * 4);
            const float4 h4 = *reinterpret_cast<const float4*>(sh + i * 256 + lane * 4);
            const float h0 = v[i * 4 + 0] * (1.f + s4.x) + h4.x, h1 = v[i * 4 + 1] * (1.f + s4.y) + h4.y;
            const float h2 = v[i * 4 + 2] * (1.f + s4.z) + h4.z, h3 = v[i * 4 + 3] * (1.f + s4.w) + h4.w;
            uint2 pk; pk.x = pack2(h0, h1); pk.y = pack2(h2, h3);
            if (!dry) *reinterpret_cast<uint2*>(hb + (size_t)row * DM + i * 256 + lane * 4) = pk;
            if (MODE == M_LN1) *reinterpret_cast<float4*>(hbuf + rl * 1024 + i * 256 + lane * 4) = make_float4(h0, h1, h2, h3);
        }
    }
    if (MODE == M_LN1) {
        const float* rw = p.in(I_ROUTER_W) + (size_t)l * 1024 * 64 + lane;
        const float* h0p = hbuf + (w * 2) * 1024; const float* h1p = h0p + 1024;
        float a0 = 0.f, a1 = 0.f;
#pragma unroll 2
        for (int k = 0; k < 1024; k += 4) {
            const float4 x0 = *reinterpret_cast<const float4*>(h0p + k);
            const float4 x1 = *reinterpret_cast<const float4*>(h1p + k);
            const float w0 = rw[(size_t)(k + 0) * 64], w1 = rw[(size_t)(k + 1) * 64], w2 = rw[(size_t)(k + 2) * 64], w3 = rw[(size_t)(k + 3) * 64];
            a0 += x0.x * w0; a1 += x1.x * w0;
            a0 += x0.y * w1; a1 += x1.y * w1;
            a0 += x0.z * w2; a1 += x1.z * w2;
            a0 += x0.w * w3; a1 += x1.w * w3;
        }
        const float rbias = p.in(I_ROUTER_B)[l * 64 + lane];
        unsigned* cnt = (unsigned*)(p.ws + WS_CTL) + CW_CNT(l);
        int* aep = (int*)(p.ws + WS_AEP); float* aw = (float*)(p.ws + WS_AW);
#pragma unroll 1
        for (int rr = 0; rr < 2; ++rr) {
            const int row = u * 8 + w * 2 + rr;
            const float logit = rr ? a1 : a0;
            const float s = 1.f / (1.f + expf(-logit));
            const float bsd = s + rbias;
            float m1 = bsd;
            m1 = fmaxf(m1, __shfl_xor(m1, 1)); m1 = fmaxf(m1, __shfl_xor(m1, 2)); m1 = fmaxf(m1, __shfl_xor(m1, 4));
            const unsigned long long eqm = __ballot(bsd == m1);
            const int gbase = lane & ~7;
            const unsigned gbits = (unsigned)((eqm >> gbase) & 0xFFull);
            const int first = gbase + __builtin_ctz(gbits);
            float m2 = (lane == first) ? -INFINITY : bsd;
            m2 = fmaxf(m2, __shfl_xor(m2, 1)); m2 = fmaxf(m2, __shfl_xor(m2, 2)); m2 = fmaxf(m2, __shfl_xor(m2, 4));
            const float gs = m1 + m2;
            const int myg = lane >> 3;
            int grank = 0;
#pragma unroll
            for (int g2 = 0; g2 < 8; ++g2) { const float o = __shfl(gs, g2 * 8); grank += (o > gs || (o == gs && g2 < myg)) ? 1 : 0; }
            const bool gsel = grank < 4;
            const float msk = gsel ? bsd : -INFINITY;
            int erank = 0;
#pragma unroll
            for (int j = 0; j < 64; ++j) { const float o = __shfl(msk, j); erank += (o > msk || (o == msk && j < lane)) ? 1 : 0; }
            const bool sel = gsel && erank < 8;
            const float wsum = wave_sum(sel ? s : 0.f);
            const unsigned long long selm = __ballot(sel);
            if (sel && !dry) {
                const int slot = __popcll(selm & ((1ull << lane) - 1ull));
                const unsigned pos = atomicAdd(&cnt[lane], 1u);
                aep[(size_t)row * 8 + slot] = (int)((unsigned)lane << 24 | pos);
                aw[(size_t)row * 8 + slot] = s / wsum * 2.5f;
            }
        }
    }
}

__device__ __forceinline__ void filt_unit(const P& p, int l, int u, char* lds) {
    const int tid = otid();
    float* feat = (float*)lds;
    float* h1 = feat + 4 * 36;
    float* h2 = h1 + 4 * 64;
    const int pp = tid >> 6, j = tid & 63;
    const int pi = u * 4 + pp;
    const int L = pi < 4096 ? 4096 : 256;
    const int t = pi < 4096 ? pi : pi - 4096;
    const float tt = (float)t / (float)(L - 1);
    if (j < 33) {
        float f;
        if (j == 0) f = tt;
        else {
            const int k = (j - 1) & 15;
            const float band = 1e-4f + (float)k * ((15.0f - 1e-4f) / 15.0f);
            float ph = band * (float)t * (1.f / (float)L);
            ph -= floorf(ph);
            float sn, cs; sincospif(2.f * ph, &sn, &cs);
            f = (j <= 16) ? cs : -sn;
        }
        feat[pp * 36 + j] = f;
    }
    __syncthreads();
    {
        const float* w1 = p.in(I_HY_W1) + (size_t)l * 33 * 64;
        float a = p.in(I_HY_B1)[l * 64 + j];
        for (int i = 0; i < 33; ++i) a += feat[pp * 36 + i] * w1[i * 64 + j];
        h1[pp * 64 + j] = sinf(p.in(I_HY_F1)[l * 64 + j] * a);
    }
    __syncthreads();
    {
        const float* w2 = p.in(I_HY_W2) + (size_t)l * 64 * 64;
        float a = p.in(I_HY_B2)[l * 64 + j];
        for (int i = 0; i < 64; ++i) a += h1[pp * 64 + i] * w2[i * 64 + j];
        h2[pp * 64 + j] = sinf(p.in(I_HY_F2)[l * 64 + j] * a);
    }
    __syncthreads();
    {
        const int c = tid;
        const float* w3 = p.in(I_HY_W3) + (size_t)l * 64 * 1024;
        float acc[4][4];
#pragma unroll
        for (int a = 0; a < 4; ++a)
#pragma unroll
            for (int b = 0; b < 4; ++b) acc[a][b] = 0.f;
        for (int i = 0; i < 64; ++i) {
            float wv[4];
#pragma unroll
            for (int os = 0; os < 4; ++os) wv[os] = w3[i * 1024 + os * 256 + c];
#pragma unroll
            for (int q = 0; q < 4; ++q) {
                const float hv = h2[q * 64 + i];
#pragma unroll
                for (int os = 0; os < 4; ++os) acc[q][os] += hv * wv[os];
            }
        }
        const float d0 = logf(0.01f) / 1.5f, d1 = logf(0.01f) / 0.3f;
        const float delta = fabsf(d0 + (d1 - d0) * ((float)c / 255.f));
#pragma unroll
        for (int q = 0; q < 4; ++q) {
            const int pq = u * 4 + q;
            const int Lq = pq < 4096 ? 4096 : 256;
            const int tq = pq < 4096 ? pq : pq - 4096;
            const float ttq = (float)tq / (float)(Lq - 1);
            const float dec = expf(-ttq * delta);
            float* F = (pq < 4096) ? (float*)(p.ws + WS_FILTL) : (float*)(p.ws + WS_FILTC);
#pragma unroll
            for (int os = 0; os < 4; ++os) {
                if (pq < 4096) F[((size_t)((os >> 1) * 256 + c) * 2 + (os & 1)) * 4096 + tq] = acc[q][os] * dec;
                else F[((size_t)os * 256 + c) * Lq + tq] = acc[q][os] * dec;
            }
        }
    }
    __syncthreads();
}

__device__ __forceinline__ void rwkv_prep_unit(const P& p, int l, int u, char* lds) {
    const int tid = otid(), w = tid >> 6;
    float* tw = (float*)lds;
    float* al = tw + 32 * 64;
    const bf16_t* z = (const bf16_t*)(p.ws + WS_Z);
    bf16_t* rwp = (bf16_t*)(p.ws + WS_R1 + R1_RWP);
    float* knorm = (float*)(p.ws + WS_KNORM);
    const int row0 = u * 32;
#pragma unroll
    for (int i = 0; i < 8; ++i) {
        const int idx = tid + 256 * i, tok = idx >> 6, j = idx & 63;
        const bf16_t* zr = z + (size_t)(row0 + tok) * ZS;
        tw[idx] = tanhf(bf2f(zr[768 + j]));
        al[idx] = bf2f(zr[832 + j]);
    }
    __syncthreads();
    const int c = tid;
#pragma unroll 1
    for (int pass = 0; pass < 4; ++pass) {
        const int d = pass & 1;
        const bool isA = pass >= 2;
        const float* W2 = (isA ? p.in(I_RW_A2) : p.in(I_RW_W2)) + (size_t)((l * 2 + d) * 32) * 256 + c;
        const float base = (isA ? p.in(I_RW_A0) : p.in(I_RW_W0))[(l * 2 + d) * 256 + c];
        float wr[32];
#pragma unroll
        for (int r = 0; r < 32; ++r) wr[r] = W2[r * 256];
        const float* src = isA ? al : tw;
#pragma unroll 2
        for (int tok = 0; tok < 32; ++tok) {
            float a = base;
#pragma unroll
            for (int r = 0; r < 32; r += 4) {
                const float4 x = *reinterpret_cast<const float4*>(src + tok * 64 + d * 32 + r);
                a += x.x * wr[r] + x.y * wr[r + 1] + x.z * wr[r + 2] + x.w * wr[r + 3];
            }
            float o;
            if (isA) o = 1.f / (1.f + expf(-a));
            else o = expf(-softplusf(-a) - 0.5f);
            rwp[((size_t)(row0 + tok) * 4 + pass) * 256 + c] = f2bf(o);
        }
    }
    const float kkc = p.in(I_RW_KK)[l * 256 + c];
#pragma unroll 4
    for (int tok = 0; tok < 32; ++tok) {
        const float kv = bf2f(z[(size_t)(row0 + tok) * ZS + 256 + c]) * kkc;
        const float ss = wave_sum(kv * kv);
        if ((tid & 63) == 0) knorm[(size_t)(row0 + tok) * 4 + w] = rsqrtf(ss + 1e-12f);
    }
    __syncthreads();
}

__device__ __forceinline__ void gdn_prep_unit(const P& p, int l, int u) {
    const int tid = otid();
    const bf16_t* z = (const bf16_t*)(p.ws + WS_Z);
    bf16_t* gq = (bf16_t*)(p.ws + WS_R1 + R1_GQ);
    float* gab = (float*)(p.ws + WS_GAB);
    const int row0 = u * 32;
    int seq0, seqL;
    if (row0 < NTC) { seq0 = row0 & ~255; seqL = 256; } else { seq0 = NTC + ((row0 - NTC) & ~4095); seqL = 4096; }
#pragma unroll 1
    for (int pz = 0; pz < 3; ++pz) {
        const int ch = pz * 256 + tid;
        const float w0 = p.in(I_GD_CONV)[(size_t)(l * 3 + 0) * 768 + ch], w1 = p.in(I_GD_CONV)[(size_t)(l * 3 + 1) * 768 + ch], w2 = p.in(I_GD_CONV)[(size_t)(l * 3 + 2) * 768 + ch];
        const bf16_t* zc = z + COL_GD + ch;
        float xm = (row0 - 1 >= seq0) ? bf2f(zc[(size_t)(row0 - 1) * ZS]) : 0.f;
        float x0 = bf2f(zc[(size_t)row0 * ZS]);
#pragma unroll 4
        for (int tok = 0; tok < 32; ++tok) {
            const int row = row0 + tok;
            const float xp = (row + 1 < seq0 + seqL) ? bf2f(zc[(size_t)(row + 1) * ZS]) : 0.f;
            float v = siluf(w0 * xm + w1 * x0 + w2 * xp);
            if (pz < 2) {
                const float ss = wave_sum(v * v);
                v *= rsqrtf(ss + 1e-12f) * (pz == 0 ? 0.125f : 1.f);
            }
            gq[(size_t)row * 768 + ch] = f2bf(v);
            xm = x0; x0 = xp;
        }
    }
    {
        const int tok = tid >> 3, dh = tid & 7;
        const int row = row0 + tok;
        const float alv = bf2f(z[(size_t)row * ZS + COL_GD + 1024 + dh]);
        const float blv = bf2f(z[(size_t)row * ZS + COL_GD + 1032 + dh]);
        const float g = -expf(p.in(I_GD_ALOG)[l * 8 + dh]) * softplusf(alv + p.in(I_GD_DTB)[l * 8 + dh]);
        gab[(size_t)row * 16 + dh] = expf(g);
        gab[(size_t)row * 16 + 8 + dh] = 1.f / (1.f + expf(-blv));
    }
}

__device__ __forceinline__ int s5_chain_row(int b, int d, int q) {
    if (q < 256) return b * 256 + (d ? 255 - q : q);
    int n = q - 256; if (d) n = 4095 - n;
    return NTC + b * 4096 + (n & 63) * 64 + (n >> 6);
}
__device__ __forceinline__ void s5_load_u(const bf16_t* zr, float* dst) {
    const uint4 a = *reinterpret_cast<const uint4*>(zr);
    const uint4 b = *reinterpret_cast<const uint4*>(zr + 8);
    *reinterpret_cast<float4*>(dst + 0) = make_float4(bflo(a.x), bfhi(a.x), bflo(a.y), bfhi(a.y));
    *reinterpret_cast<float4*>(dst + 4) = make_float4(bflo(a.z), bfhi(a.z), bflo(a.w), bfhi(a.w));
    *reinterpret_cast<float4*>(dst + 8) = make_float4(bflo(b.x), bfhi(b.x), bflo(b.y), bfhi(b.y));
    *reinterpret_cast<float4*>(dst + 12) = make_float4(bflo(b.z), bfhi(b.z), bflo(b.w), bfhi(b.w));
}

__device__ __forceinline__ void s5_pre_unit(const P& p, int l, int u, char* lds) {
    const int tid = otid(), w = tid >> 6, lane = tid & 63;
    float* ust = (float*)lds + w * 1024;
    const int wt = u * 4 + w;
    const int d = wt & 1, g = (wt >> 1) & 15, rest = wt >> 5;
    const int cc = rest % NCHUNK, b = rest / NCHUNK;
    const bf16_t* z = (const bf16_t*)(p.ws + WS_Z);
    {
        const int row = s5_chain_row(b, d, cc * 64 + lane);
        s5_load_u(z + (size_t)row * ZS + COL_S5 + g * 16, ust + lane * 16);
    }
    const int tix = ((l * 2 + d) * 16 + g) * 64 + lane;
    const float4 A = *reinterpret_cast<const float4*>((const float*)(p.ws + WS_S5A) + (size_t)tix * 4);
    const float* Bp = (const float*)(p.ws + WS_S5B) + (size_t)tix * 32;
    float br[16], bi[16];
#pragma unroll
    for (int h = 0; h < 16; ++h) { br[h] = Bp[h]; bi[h] = Bp[16 + h]; }
    float xr = 0.f, xi = 0.f;
#pragma unroll 2
    for (int s = 0; s < 64; ++s) {
        float ur = 0.f, ui = 0.f;
#pragma unroll
        for (int h4 = 0; h4 < 4; ++h4) {
            const float4 uu = *reinterpret_cast<const float4*>(ust + s * 16 + h4 * 4);
            ur += br[h4 * 4] * uu.x + br[h4 * 4 + 1] * uu.y + br[h4 * 4 + 2] * uu.z + br[h4 * 4 + 3] * uu.w;
            ui += bi[h4 * 4] * uu.x + bi[h4 * 4 + 1] * uu.y + bi[h4 * 4 + 2] * uu.z + bi[h4 * 4 + 3] * uu.w;
        }
        const float nr = A.x * xr - A.y * xi + ur;
        const float ni = A.x * xi + A.y * xr + ui;
        xr = nr; xi = ni;
    }
    float* st = (float*)(p.ws + WS_S5ST) + ((((size_t)(b * NCHUNK + cc) * 2 + d) * 16 + g) * 64 + lane) * 2;
    st[0] = xr; st[1] = xi;
}

__device__ __forceinline__ float reduce16(const float (&t)[16], int lane) {
    float a[8];
    const bool hi8 = (lane & 8) != 0;
#pragma unroll
    for (int k = 0; k < 8; ++k) { const float keep = hi8 ? t[k + 8] : t[k]; const float send = hi8 ? t[k] : t[k + 8]; a[k] = keep + dppf<0x140>(send); }
    float b[4];
    const bool hi4 = (lane & 4) != 0;
#pragma unroll
    for (int k = 0; k < 4; ++k) { const float keep = hi4 ? a[k + 4] : a[k]; const float send = hi4 ? a[k] : a[k + 4]; b[k] = keep + dppf<0x141>(send); }
    float c[2];
    const bool hi2 = (lane & 2) != 0;
#pragma unroll
    for (int k = 0; k < 2; ++k) { const float keep = hi2 ? b[k + 2] : b[k]; const float send = hi2 ? b[k] : b[k + 2]; c[k] = keep + dppf<0x4E>(send); }
    const bool hi1 = (lane & 1) != 0;
    float r = (hi1 ? c[1] : c[0]) + dppf<0xB1>(hi1 ? c[0] : c[1]);
    r += __shfl_xor(r, 16);
    r += __shfl_xor(r, 32);
    return r;
}

__device__ __forceinline__ void s5_main_unit(const P& p, int l, int u, char* lds) {
    const int tid = otid(), w = tid >> 6, lane = tid & 63;
    float* ust = (float*)lds + w * 2048;
    float* yst = ust + 1024;
    const int b = u / NCHUNK, tc = u % NCHUNK;
    bf16_t* z = (bf16_t*)(p.ws + WS_Z);
    const int myrow = (tc < 4) ? (b * 256 + tc * 64 + lane) : (NTC + b * 4096 + lane * 64 + (tc - 4));
#pragma unroll 1
    for (int gi = 0; gi < 4; ++gi) {
        const int g = w * 4 + gi;
        s5_load_u(z + (size_t)myrow * ZS + COL_S5 + g * 16, ust + lane * 16);
#pragma unroll 1
        for (int d = 0; d < 2; ++d) {
            const int tix = ((l * 2 + d) * 16 + g) * 64 + lane;
            const float4 A = *reinterpret_cast<const float4*>((const float*)(p.ws + WS_S5A) + (size_t)tix * 4);
            const float* Bp = (const float*)(p.ws + WS_S5B) + (size_t)tix * 32;
            float br[16], bi[16], cr[16], ci[16];
#pragma unroll
            for (int h = 0; h < 16; ++h) { br[h] = Bp[h]; bi[h] = Bp[16 + h]; }
            const float* crp = p.in(I_S5_CRE) + (size_t)((l * 2 + d) * 16 + g) * 1024 + lane;
            const float* cip = p.in(I_S5_CIM) + (size_t)((l * 2 + d) * 16 + g) * 1024 + lane;
#pragma unroll
            for (int h = 0; h < 16; ++h) { cr[h] = crp[h * 64]; ci[h] = cip[h * 64]; }
            const int cc = d ? ((tc < 4) ? 3 - tc : 71 - tc) : tc;
            float xr = 0.f, xi = 0.f;
            {
                const float* st = (const float*)(p.ws + WS_S5ST) + ((((size_t)(b * NCHUNK) * 2 + d) * 16 + g) * 64 + lane) * 2;
                for (int c2 = 0; c2 < cc; ++c2) {
                    const float2 sv = *reinterpret_cast<const float2*>(st + (size_t)c2 * (2 * 16 * 64 * 2));
                    const float nr = A.z * xr - A.w * xi + sv.x;
                    const float ni = A.z * xi + A.w * xr + sv.y;
                    xr = nr; xi = ni;
                }
            }
#pragma unroll 1
            for (int s = 0; s < 64; ++s) {
                const int i = d ? 63 - s : s;
                float ur = 0.f, ui = 0.f;
#pragma unroll
                for (int h4 = 0; h4 < 4; ++h4) {
                    const float4 uu = *reinterpret_cast<const float4*>(ust + i * 16 + h4 * 4);
                    ur += br[h4 * 4] * uu.x + br[h4 * 4 + 1] * uu.y + br[h4 * 4 + 2] * uu.z + br[h4 * 4 + 3] * uu.w;
                    ui += bi[h4 * 4] * uu.x + bi[h4 * 4 + 1] * uu.y + bi[h4 * 4 + 2] * uu.z + bi[h4 * 4 + 3] * uu.w;
                }
                const float nr = A.x * xr - A.y * xi + ur;
                const float ni = A.x * xi + A.y * xr + ui;
                xr = nr; xi = ni;
                float t[16];
#pragma unroll
                for (int h = 0; h < 16; ++h) t[h] = cr[h] * xr - ci[h] * xi;
                const float tot = reduce16(t, lane);
                if (lane < 16) { if (d == 0) yst[i * 16 + lane] = tot; else yst[i * 16 + lane] += tot; }
            }
        }
        {
            const float* dsk = p.in(I_S5_D) + l * 256 + g * 16;
            unsigned pk[8];
#pragma unroll
            for (int h = 0; h < 16; h += 2) {
                float y0 = yst[lane * 16 + h] + ust[lane * 16 + h] * dsk[h];
                float y1 = yst[lane * 16 + h + 1] + ust[lane * 16 + h + 1] * dsk[h + 1];
                y0 = 0.5f * y0 * (1.f + erff(y0 * 0.70710678118f));
                y1 = 0.5f * y1 * (1.f + erff(y1 * 0.70710678118f));
                pk[h >> 1] = pack2(y0, y1);
            }
            uint4* dst = reinterpret_cast<uint4*>(z + (size_t)myrow * ZS + COL_S5 + g * 16);
            dst[0] = make_uint4(pk[0], pk[1], pk[2], pk[3]);
            dst[1] = make_uint4(pk[4], pk[5], pk[6], pk[7]);
        }
    }
}

#define SB 16
__device__ __forceinline__ int scan_chain_row(int b, int d, int q) {
    if (q < 256) return b * 256 + (d ? 255 - q : q);
    const int t = q - 256;
    return NTC + b * 4096 + (d ? 4095 - t : t);
}
struct ScanRaw { uint2 r, k, v, e, a; float f0, f1; };

__device__ __forceinline__ void scan_load(const P& p, int m, int b, int h, int d, int q, int cg, ScanRaw& R) {
    const int row = scan_chain_row(b, d, q);
    const int c0 = h * 64 + cg * 4;
    if (m == 0) {
        const bf16_t* z = (const bf16_t*)(p.ws + WS_Z) + (size_t)row * ZS + c0;
        R.r = *reinterpret_cast<const uint2*>(z);
        R.k = *reinterpret_cast<const uint2*>(z + 256);
        R.v = *reinterpret_cast<const uint2*>(z + 512);
        const bf16_t* rw = (const bf16_t*)(p.ws + WS_R1 + R1_RWP) + (size_t)row * 1024 + c0;
        R.e = *reinterpret_cast<const uint2*>(rw + d * 256);
        R.a = *reinterpret_cast<const uint2*>(rw + (2 + d) * 256);
        R.f0 = ((const float*)(p.ws + WS_KNORM))[(size_t)row * 4 + h];
        R.f1 = 0.f;
    } else {
        const bf16_t* gq = (const bf16_t*)(p.ws + WS_R1 + R1_GQ) + (size_t)row * 768 + c0;
        R.r = *reinterpret_cast<const uint2*>(gq);
        R.k = *reinterpret_cast<const uint2*>(gq + 256);
        R.v = *reinterpret_cast<const uint2*>(gq + 512);
        R.e = make_uint2(0u, 0u); R.a = make_uint2(0u, 0u);
        const float* gab = (const float*)(p.ws + WS_GAB) + (size_t)row * 16;
        R.f0 = gab[d * 4 + h];
        R.f1 = gab[8 + d * 4 + h];
    }
}
__device__ __forceinline__ void scan_store(int m, const ScanRaw& R, float* dst  , const float (&kkp)[4], const float (&kap)[4]) {
    float r[4] = {bflo(R.r.x), bfhi(R.r.x), bflo(R.r.y), bfhi(R.r.y)};
    float k[4] = {bflo(R.k.x), bfhi(R.k.x), bflo(R.k.y), bfhi(R.k.y)};
    float v[4] = {bflo(R.v.x), bfhi(R.v.x), bflo(R.v.y), bfhi(R.v.y)};
    float ww[4], aa[4], bb[4], kk[4];
    if (m == 0) {
        float e[4] = {bflo(R.e.x), bfhi(R.e.x), bflo(R.e.y), bfhi(R.e.y)};
        float a[4] = {bflo(R.a.x), bfhi(R.a.x), bflo(R.a.y), bfhi(R.a.y)};
#pragma unroll
        for (int i = 0; i < 4; ++i) {
            ww[i] = __expf(-e[i]);
            kk[i] = k[i] * (1.f + (a[i] - 1.f) * kap[i]);
            const float kn = k[i] * kkp[i] * R.f0;
            aa[i] = -kn;
            bb[i] = kn * a[i];
        }
    } else {
        const float al = R.f0, be = R.f1;
#pragma unroll
        for (int i = 0; i < 4; ++i) { ww[i] = al; aa[i] = k[i]; bb[i] = -al * be * k[i]; kk[i] = be * k[i]; }
    }
    *reinterpret_cast<float4*>(dst + 0 * 64) = make_float4(ww[0], ww[1], ww[2], ww[3]);
    *reinterpret_cast<float4*>(dst + 1 * 64) = make_float4(aa[0], aa[1], aa[2], aa[3]);
    *reinterpret_cast<float4*>(dst + 2 * 64) = make_float4(bb[0], bb[1], bb[2], bb[3]);
    *reinterpret_cast<float4*>(dst + 3 * 64) = make_float4(kk[0], kk[1], kk[2], kk[3]);
    *reinterpret_cast<float4*>(dst + 4 * 64) = make_float4(r[0], r[1], r[2], r[3]);
    *reinterpret_cast<float4*>(dst + 5 * 64) = make_float4(v[0], v[1], v[2], v[3]);
}

__device__ __forceinline__ void scan_unit(const P& p, int l, int u, char* lds) {
    const int tid = otid();
    const int chain = u >> 1, half = u & 1;
    const int m = chain >> 6, rem = chain & 63, b = rem >> 3, h = (rem >> 1) & 3, d = rem & 1;
    float* buf = (float*)lds;
    float* ybuf = buf + 2 * SB * 384;
    const int rl = tid >> 3, sub = tid & 7;
    const int st = tid >> 4, cg = tid & 15;
    float kkp[4], kap[4];
#pragma unroll
    for (int i = 0; i < 4; ++i) { kkp[i] = p.in(I_RW_KK)[l * 256 + h * 64 + cg * 4 + i]; kap[i] = p.in(I_RW_KA)[l * 256 + h * 64 + cg * 4 + i]; }
    bf16_t* ys = (bf16_t*)(p.ws + WS_HBY) + (size_t)(m * 2 + d) * NT * 256;
    float S[8];
#pragma unroll
    for (int j = 0; j < 8; ++j) S[j] = 0.f;
    ScanRaw R;
    scan_load(p, m, b, h, d, st, cg, R);
    scan_store(m, R, buf + (st * 6) * 64 + cg * 4, kkp, kap);
    __syncthreads();
    const int NB = 4352 / SB;
    __builtin_amdgcn_s_setprio(2);
#pragma unroll 1
    for (int bt = 0; bt < NB; ++bt) {
        const int par = bt & 1;
        if (bt + 1 < NB) scan_load(p, m, b, h, d, (bt + 1) * SB + st, cg, R);
        const float* cb = buf + par * (SB * 384);
        float* yb = ybuf + par * (SB * 32);
        {
            const float* sb0 = cb + sub * 8;
            const float* vb0 = cb + 320 + half * 32 + rl;
            float4 nw0 = *reinterpret_cast<const float4*>(sb0), nw1 = *reinterpret_cast<const float4*>(sb0 + 4);
            float4 na0 = *reinterpret_cast<const float4*>(sb0 + 64), na1 = *reinterpret_cast<const float4*>(sb0 + 68);
            float4 nb0 = *reinterpret_cast<const float4*>(sb0 + 128), nb1 = *reinterpret_cast<const float4*>(sb0 + 132);
            float4 nk0 = *reinterpret_cast<const float4*>(sb0 + 192), nk1 = *reinterpret_cast<const float4*>(sb0 + 196);
            float4 nr0 = *reinterpret_cast<const float4*>(sb0 + 256), nr1 = *reinterpret_cast<const float4*>(sb0 + 260);
            float nvv = vb0[0];
#pragma unroll
            for (int s = 0; s < SB; ++s) {
                const float4 w0 = nw0, w1 = nw1, a0 = na0, a1 = na1, b0 = nb0, b1 = nb1, k0 = nk0, k1 = nk1, r0 = nr0, r1 = nr1;
                const float vv = nvv;
                if (s + 1 < SB) {
                    const float* sb = sb0 + (s + 1) * 384;
                    nw0 = *reinterpret_cast<const float4*>(sb); nw1 = *reinterpret_cast<const float4*>(sb + 4);
                    na0 = *reinterpret_cast<const float4*>(sb + 64); na1 = *reinterpret_cast<const float4*>(sb + 68);
                    nb0 = *reinterpret_cast<const float4*>(sb + 128); nb1 = *reinterpret_cast<const float4*>(sb + 132);
                    nk0 = *reinterpret_cast<const float4*>(sb + 192); nk1 = *reinterpret_cast<const float4*>(sb + 196);
                    nr0 = *reinterpret_cast<const float4*>(sb + 256); nr1 = *reinterpret_cast<const float4*>(sb + 260);
                    nvv = vb0[(s + 1) * 384];
                }
                __builtin_amdgcn_sched_barrier(0);
                float sa = (S[0] * a0.x + S[1] * a0.y) + (S[2] * a0.z + S[3] * a0.w) + (S[4] * a1.x + S[5] * a1.y) + (S[6] * a1.z + S[7] * a1.w);
                sa += dppf<0xB1>(sa); sa += dppf<0x4E>(sa); sa += dppf<0x141>(sa);
                S[0] = S[0] * w0.x + sa * b0.x + vv * k0.x;
                S[1] = S[1] * w0.y + sa * b0.y + vv * k0.y;
                S[2] = S[2] * w0.z + sa * b0.z + vv * k0.z;
                S[3] = S[3] * w0.w + sa * b0.w + vv * k0.w;
                S[4] = S[4] * w1.x + sa * b1.x + vv * k1.x;
                S[5] = S[5] * w1.y + sa * b1.y + vv * k1.y;
                S[6] = S[6] * w1.z + sa * b1.z + vv * k1.z;
                S[7] = S[7] * w1.w + sa * b1.w + vv * k1.w;
                float y = (S[0] * r0.x + S[1] * r0.y) + (S[2] * r0.z + S[3] * r0.w) + (S[4] * r1.x + S[5] * r1.y) + (S[6] * r1.z + S[7] * r1.w);
                y += dppf<0xB1>(y); y += dppf<0x4E>(y); y += dppf<0x141>(y);
                yb[s * 32 + rl] = y;
            }
        }
        if (bt + 1 < NB) scan_store(m, R, buf + (1 - par) * (SB * 384) + (st * 6) * 64 + cg * 4, kkp, kap);
        __syncthreads();
        {
            const int r2 = cg * 2;
            const int row = scan_chain_row(b, d, bt * SB + st);
            const unsigned pk = pack2(yb[st * 32 + r2], yb[st * 32 + r2 + 1]);
            *reinterpret_cast<unsigned*>(ys + (size_t)row * 256 + h * 64 + half * 32 + r2) = pk;
        }
    }
    __builtin_amdgcn_s_setprio(0);
    __syncthreads();
}

template <int L>
__device__ __forceinline__ void hyena_unit(const P& p, int l, int u, char* lds) {
    constexpr int TPT = L / 256;
    const int tid = otid();
    const int c = u >> 2, bp = u & 3;
    float2* u2 = (float2*)lds;
    float* taps = (float*)(lds + (size_t)L * 8);
    const bf16_t* z = (const bf16_t*)(p.ws + WS_Z);
    bf16_t* cat = (bf16_t*)(p.ws + WS_CAT);
    const float* F = (L == 4096) ? (const float*)(p.ws + WS_FILTL) : (const float*)(p.ws + WS_FILTC);
    int base[2];
#pragma unroll
    for (int bb = 0; bb < 2; ++bb) { const int b = bp * 2 + bb; base[bb] = (L == 4096) ? NTC + b * 4096 : b * 256; }
    const int t0 = tid * TPT;
    const float* cw = p.in(I_HY_CONV) + (size_t)l * 3 * 768; const float* cb = p.in(I_HY_CONVB) + (size_t)l * 768;
    auto sconv = [&](int part, int bb, float (&o)[TPT]) {
        const int ch = part * 256 + c;
        const float w0 = cw[ch], w1 = cw[768 + ch], w2 = cw[1536 + ch], bs = cb[ch];
        const bf16_t* zc = z + (size_t)base[bb] * ZS + COL_HY + ch;
        float xm = (t0 > 0) ? bf2f(zc[(size_t)(t0 - 1) * ZS]) : 0.f;
        float x0 = bf2f(zc[(size_t)t0 * ZS]);
#pragma unroll
        for (int i = 0; i < TPT; ++i) {
            const int t = t0 + i;
            const float xp = (t + 1 < L) ? bf2f(zc[(size_t)(t + 1) * ZS]) : 0.f;
            o[i] = w0 * xm + w1 * x0 + w2 * xp + bs;
            xm = x0; x0 = xp;
        }
    };
    {
        float v0[TPT], v1[TPT];
        sconv(2, 0, v0); sconv(2, 1, v1);
#pragma unroll
        for (int i = 0; i < TPT; ++i) u2[t0 + i] = make_float2(v0[i], v1[i]);
    }
#pragma unroll 1
    for (int o = 0; o < 2; ++o) {
        const float* hf = F + ((size_t)(o * 2 + 0) * 256 + c) * L;
        const float* hbk = F + ((size_t)(o * 2 + 1) * 256 + c) * L;
        for (int k = tid; k < 2 * L; k += NTHREADS) {
            const int dd = k - (L - 1);
            taps[k] = (dd >= L) ? 0.f : (dd >= 0 ? hf[dd] : hbk[-dd]);
        }
        __syncthreads();
        float acc[TPT][2];
#pragma unroll
        for (int i = 0; i < TPT; ++i) { acc[i][0] = 0.f; acc[i][1] = 0.f; }
        if (L == 4096) {
#pragma unroll 1
            for (int s0 = 0; s0 < L; s0 += 16) {
                const int k0 = t0 - s0 + (L - 16);
                float W[32];
#pragma unroll
                for (int q = 0; q < 8; ++q) {
                    const float4 t4 = *reinterpret_cast<const float4*>(taps + k0 + q * 4);
                    W[q * 4] = t4.x; W[q * 4 + 1] = t4.y; W[q * 4 + 2] = t4.z; W[q * 4 + 3] = t4.w;
                }
#pragma unroll
                for (int j = 0; j < 16; ++j) {
                    const float2 uj = u2[s0 + j];
#pragma unroll
                    for (int i = 0; i < TPT; ++i) {
                        const float wv = W[(i - j + 15) & 31];
                        acc[i][0] += wv * uj.x; acc[i][1] += wv * uj.y;
                    }
                }
            }
        } else {
            for (int s = 0; s < L; ++s) {
                const float2 uj = u2[s];
                const float wv = taps[t0 - s + (L - 1)];
                acc[0][0] += wv * uj.x; acc[0][1] += wv * uj.y;
            }
        }
        const float sk = p.in(I_HY_SKIP)[(size_t)(l * 2 + o) * 256 + c];
        float res[TPT][2];
        {
            float g0[TPT], g1[TPT];
            sconv(o, 0, g0); sconv(o, 1, g1);
#pragma unroll
            for (int i = 0; i < TPT; ++i) {
                const float2 ut = u2[t0 + i];
                res[i][0] = g0[i] * (acc[i][0] + sk * ut.x);
                res[i][1] = g1[i] * (acc[i][1] + sk * ut.y);
            }
        }
        __syncthreads();
        if (o == 0) {
#pragma unroll
            for (int i = 0; i < TPT; ++i) u2[t0 + i] = make_float2(res[i][0], res[i][1]);
        } else {
#pragma unroll
            for (int i = 0; i < TPT; ++i) {
                cat[(size_t)(base[0] + t0 + i) * DM + 512 + c] = f2bf(res[i][0]);
                cat[(size_t)(base[1] + t0 + i) * DM + 512 + c] = f2bf(res[i][1]);
            }
        }
        __syncthreads();
    }
}


#define FFT_BS 272
__device__ __forceinline__ int fphys(int d2, int d1, int d0) { return d2 * FFT_BS + d1 * 17 + d0; }
__device__ __forceinline__ float2 cmulf(float2 a, float2 b) { return make_float2(a.x * b.x - a.y * b.y, a.x * b.y + a.y * b.x); }
__device__ static constexpr float C32T[16] = {1.000000000e+00f, 9.807852804e-01f, 9.238795325e-01f, 8.314696123e-01f, 7.071067812e-01f, 5.555702330e-01f, 3.826834324e-01f, 1.950903220e-01f, 6.123233996e-17f, -1.950903220e-01f, -3.826834324e-01f, -5.555702330e-01f, -7.071067812e-01f, -8.314696123e-01f, -9.238795325e-01f, -9.807852804e-01f};
__device__ static constexpr float S32T[16] = {0.000000000e+00f, 1.950903220e-01f, 3.826834324e-01f, 5.555702330e-01f, 7.071067812e-01f, 8.314696123e-01f, 9.238795325e-01f, 9.807852804e-01f, 1.000000000e+00f, 9.807852804e-01f, 9.238795325e-01f, 8.314696123e-01f, 7.071067812e-01f, 5.555702330e-01f, 3.826834324e-01f, 1.950903220e-01f};
template <int LOG> __device__ __forceinline__ constexpr int brev(int i) { int r = 0; for (int b = 0; b < LOG; ++b) r |= ((i >> b) & 1) << (LOG - 1 - b); return r; }
template <int R, bool INV> __device__ __forceinline__ void dftR(float2 (&v)[R]) {
    constexpr int LOG = (R == 32) ? 5 : 4;
    float2 t[R];
#pragma unroll
    for (int i = 0; i < R; ++i) t[brev<LOG>(i)] = v[i];
#pragma unroll
    for (int st = 1; st <= LOG; ++st) {
        const int len = 1 << st, half = len >> 1;
#pragma unroll
        for (int i = 0; i < R; i += len)
#pragma unroll
            for (int j = 0; j < half; ++j) {
                const int tw = j * (32 / len);
                const float2 a = t[i + j], b = t[i + j + half];
                float2 bw;
                if (tw == 0) bw = b;
                else if (tw == 8) bw = INV ? make_float2(-b.y, b.x) : make_float2(b.y, -b.x);
                else { const float wr = C32T[tw], wi = INV ? S32T[tw] : -S32T[tw]; bw = make_float2(b.x * wr - b.y * wi, b.x * wi + b.y * wr); }
                t[i + j] = make_float2(a.x + bw.x, a.y + bw.y);
                t[i + j + half] = make_float2(a.x - bw.x, a.y - bw.y);
            }
    }
#pragma unroll
    for (int i = 0; i < R; ++i) v[i] = t[i];
}
template <int R> __device__ __forceinline__ void twiddle_pow(float2 (&v)[R], float2 first, float2 base) {
    float2 w = first;
#pragma unroll
    for (int k = 0; k < R; ++k) { v[k] = cmulf(v[k], w); w = cmulf(w, base); }
}
__device__ __forceinline__ float2 cispi(float x) { float sn, cs; sincospif(x, &sn, &cs); return make_float2(cs, sn); }

__device__ __forceinline__ void fft_fwd_A_B1(float2 (&v)[32], float2* buf, int tid_in) {
    int tid = tid_in; asm volatile("" : "+v"(tid));
    const int a = tid >> 4, b = tid & 15;
    dftR<32, false>(v);
    twiddle_pow<32>(v, make_float2(1.f, 0.f), cispi(-2.f * (float)tid * (1.f / 8192.f)));
#pragma unroll
    for (int k1 = 0; k1 < 32; ++k1) buf[fphys(k1, a, b)] = v[k1];
    __syncthreads();
#pragma unroll 1
    for (int j = 0; j < 2; ++j) {
        const int g = tid + 256 * j, k1 = g >> 4, bb = g & 15;
        float2 w[16];
#pragma unroll
        for (int aa = 0; aa < 16; ++aa) w[aa] = buf[fphys(k1, aa, bb)];
        dftR<16, false>(w);
        twiddle_pow<16>(w, make_float2(1.f, 0.f), cispi(-2.f * (float)bb * (1.f / 256.f)));
#pragma unroll
        for (int ka = 0; ka < 16; ++ka) buf[fphys(k1, ka, bb)] = w[ka];
    }
    __syncthreads();
}
__device__ __forceinline__ void fft_inv_B1_A(float2 (&v)[32], float2* buf, int tid_in) {
    int tid = tid_in; asm volatile("" : "+v"(tid));
#pragma unroll 1
    for (int j = 0; j < 2; ++j) {
        const int g = tid + 256 * j, k1 = g >> 4, bb = g & 15;
        float2 w[16];
#pragma unroll
        for (int ka = 0; ka < 16; ++ka) w[ka] = buf[fphys(k1, ka, bb)];
        dftR<16, true>(w);
        twiddle_pow<16>(w, cispi(2.f * (float)(k1 * bb) * (1.f / 8192.f)), cispi(2.f * (float)k1 * (1.f / 512.f)));
#pragma unroll
        for (int aa = 0; aa < 16; ++aa) buf[fphys(k1, aa, bb)] = w[aa];
    }
    __syncthreads();
    const int a = tid >> 4, b = tid & 15;
#pragma unroll
    for (int k1 = 0; k1 < 32; ++k1) v[k1] = buf[fphys(k1, a, b)];
    dftR<32, true>(v);
}

__device__ __forceinline__ void hfft_unit(const P& p, int l, int u, char* lds) {
    const int tid = otid();
    float2* buf = (float2*)lds;
    float* F = (float*)(p.ws + WS_FILTL) + (size_t)u * 8192;
    float2 v[32];
#pragma unroll
    for (int n1 = 0; n1 < 32; ++n1) {
        const int n = 256 * n1 + tid;
        float x;
        if (n1 < 16) x = F[n];
        else x = (n == 4096) ? 0.f : F[4096 + (8192 - n)];
        if (n == 0) x += p.in(I_HY_SKIP)[(size_t)l * 512 + u];
        v[n1] = make_float2(x, 0.f);
    }
    fft_fwd_A_B1(v, buf, tid);
    __half2* H = (__half2*)F;
#pragma unroll 1
    for (int j = 0; j < 2; ++j) {
        const int g = tid + 256 * j, k1 = g >> 4, ka = g & 15;
        float2 w[16];
#pragma unroll
        for (int bb = 0; bb < 16; ++bb) w[bb] = buf[fphys(k1, ka, bb)];
        dftR<16, false>(w);
        unsigned pk[16];
#pragma unroll
        for (int kb = 0; kb < 16; ++kb) { const __half2 h = __floats2half2_rn(w[kb].x, w[kb].y); pk[kb] = *reinterpret_cast<const unsigned*>(&h); }
        uint4* dst = reinterpret_cast<uint4*>(H + (size_t)g * 16);
        dst[0] = make_uint4(pk[0], pk[1], pk[2], pk[3]); dst[1] = make_uint4(pk[4], pk[5], pk[6], pk[7]);
        dst[2] = make_uint4(pk[8], pk[9], pk[10], pk[11]); dst[3] = make_uint4(pk[12], pk[13], pk[14], pk[15]);
    }
    __syncthreads();
}

__device__ __forceinline__ void hyena_prep_unit(const P& p, int l, int u, char* lds) {
    const int tid = otid();
    bf16_t* tile = (bf16_t*)lds;
    const int b = u >> 6, t0 = (u & 63) * 64;
    const bf16_t* z = (const bf16_t*)(p.ws + WS_Z) + (size_t)(NTC + b * 4096) * ZS + COL_HY;
    bf16_t* hyT = (bf16_t*)(p.ws + WS_HYT);
    const float* cw = p.in(I_HY_CONV) + (size_t)l * 3 * 768; const float* cb = p.in(I_HY_CONVB) + (size_t)l * 768;
#pragma unroll 1
    for (int part = 0; part < 3; ++part) {
        const int ch = part * 256 + tid;
        const float w0 = cw[ch], w1 = cw[768 + ch], w2 = cw[1536 + ch], bs = cb[ch];
        const bf16_t* zc = z + ch;
        float xm = (t0 > 0) ? bf2f(zc[(size_t)(t0 - 1) * ZS]) : 0.f;
        float x0 = bf2f(zc[(size_t)t0 * ZS]);
#pragma unroll 8
        for (int i = 0; i < 64; ++i) {
            const int t = t0 + i;
            const float xp = (t + 1 < 4096) ? bf2f(zc[(size_t)(t + 1) * ZS]) : 0.f;
            tile[tid * 72 + i] = f2bf(w0 * xm + w1 * x0 + w2 * xp + bs);
            xm = x0; x0 = xp;
        }
        __syncthreads();
#pragma unroll
        for (int k = 0; k < 8; ++k) {
            const int chl = (tid >> 3) + 32 * k, seg = tid & 7;
            const uint4 val = *reinterpret_cast<const uint4*>(tile + chl * 72 + seg * 8);
            *reinterpret_cast<uint4*>(hyT + ((size_t)(b * 3 + part) * 256 + chl) * 4096 + t0 + seg * 8) = val;
        }
        __syncthreads();
    }
}

template <int O>
__device__ __forceinline__ void hyena_conv_pass(const P& p, int c, int bp, int tid, float2 (&v)[32], float2* buf) {
    const bf16_t* hyT = (const bf16_t*)(p.ws + WS_HYT);
#pragma unroll
    for (int j = 16; j < 32; ++j) v[j] = make_float2(0.f, 0.f);
    fft_fwd_A_B1(v, buf, tid);
    const __half2* H = (const __half2*)((const float*)(p.ws + WS_FILTL) + (size_t)(O * 256 + c) * 8192);
    int tm = tid; asm volatile("" : "+v"(tm));
#pragma unroll 1
    for (int j = 0; j < 2; ++j) {
        const int g = tm + 256 * j, k1 = g >> 4, ka = g & 15;
        float2 w[16];
#pragma unroll
        for (int bb = 0; bb < 16; ++bb) w[bb] = buf[fphys(k1, ka, bb)];
        dftR<16, false>(w);
        const uint4* hp = reinterpret_cast<const uint4*>(H + (size_t)g * 16);
        unsigned hk[16];
#pragma unroll
        for (int q = 0; q < 4; ++q) { const uint4 t4 = hp[q]; hk[q * 4] = t4.x; hk[q * 4 + 1] = t4.y; hk[q * 4 + 2] = t4.z; hk[q * 4 + 3] = t4.w; }
#pragma unroll
        for (int kb = 0; kb < 16; ++kb) { const float2 hf = __half22float2(*reinterpret_cast<const __half2*>(&hk[kb])); w[kb] = cmulf(w[kb], hf); }
        dftR<16, true>(w);
        twiddle_pow<16>(w, make_float2(1.f, 0.f), cispi(2.f * (float)ka * (1.f / 256.f)));
#pragma unroll
        for (int bb = 0; bb < 16; ++bb) buf[fphys(k1, ka, bb)] = w[bb];
    }
    __syncthreads();
    fft_inv_B1_A(v, buf, tid);
    asm volatile("" ::: "memory");
    int tq = tid; asm volatile("" : "+v"(tq));
    const bf16_t* g0 = hyT + ((size_t)((bp * 2 + 0) * 3 + O) * 256 + c) * 4096 + tq;
    const bf16_t* g1 = hyT + ((size_t)((bp * 2 + 1) * 3 + O) * 256 + c) * 4096 + tq;
    const float sc = 1.f / 8192.f;
#pragma unroll
    for (int j = 0; j < 16; ++j) {
        const float ga = bf2f(g0[256 * j]) * sc, gb = bf2f(g1[256 * j]) * sc;
        v[j] = make_float2(ga * v[j].x, gb * v[j].y);
    }
    __syncthreads();
}

__device__ __forceinline__ void hyena_fft_unit(const P& p, int l, int u, char* lds) {
    const int tid = otid();
    const int c = u >> 2, bp = u & 3;
    float2* buf = (float2*)lds;
    const bf16_t* hyT = (const bf16_t*)(p.ws + WS_HYT);
    bf16_t* cat = (bf16_t*)(p.ws + WS_CAT);
    float2 v[32];
    {
        const bf16_t* v0p = hyT + ((size_t)((bp * 2 + 0) * 3 + 2) * 256 + c) * 4096 + tid;
        const bf16_t* v1p = hyT + ((size_t)((bp * 2 + 1) * 3 + 2) * 256 + c) * 4096 + tid;
#pragma unroll
        for (int j = 0; j < 16; ++j) v[j] = make_float2(bf2f(v0p[256 * j]), bf2f(v1p[256 * j]));
    }
    hyena_conv_pass<0>(p, c, bp, tid, v, buf);
    hyena_conv_pass<1>(p, c, bp, tid, v, buf);
    int tq = tid; asm volatile("" : "+v"(tq));
#pragma unroll
    for (int j = 0; j < 16; ++j) {
        const int t = tq + 256 * j;
        cat[(size_t)(NTC + (bp * 2 + 0) * 4096 + t) * DM + 512 + c] = f2bf(v[j].x);
        cat[(size_t)(NTC + (bp * 2 + 1) * 4096 + t) * DM + 512 + c] = f2bf(v[j].y);
    }
}

__device__ __forceinline__ void rwkv_post_unit(const P& p, int l, int u, char* lds) {
    const int tid = otid(), c = tid;
    float* sg = (float*)lds;
    const bf16_t* z = (const bf16_t*)(p.ws + WS_Z);
    const bf16_t* rwp = (const bf16_t*)(p.ws + WS_R1 + R1_RWP);
    const bf16_t* ys = (const bf16_t*)(p.ws + WS_HBY);
    bf16_t* cat = (bf16_t*)(p.ws + WS_CAT);
    const int row0 = u * 32;
#pragma unroll
    for (int i = 0; i < 8; ++i) {
        const int idx = tid + 256 * i, tok = idx >> 6, j = idx & 63;
        sg[idx] = sigm(bf2f(z[(size_t)(row0 + tok) * ZS + 896 + j]));
    }
    __syncthreads();
    float g2r[64];
#pragma unroll
    for (int r = 0; r < 64; ++r) g2r[r] = p.in(I_RW_G2)[(size_t)(l * 64 + r) * 256 + c];
    const float ka = p.in(I_RW_KA)[l * 256 + c], rk = p.in(I_RW_RK)[l * 256 + c];
    const float gng = p.in(I_RW_GNG)[l * 256 + c], gnb = p.in(I_RW_GNB)[l * 256 + c];
#pragma unroll 2
    for (int tok = 0; tok < 32; ++tok) {
        const int row = row0 + tok;
        float g = 0.f;
#pragma unroll
        for (int r = 0; r < 64; r += 4) {
            const float4 x = *reinterpret_cast<const float4*>(sg + tok * 64 + r);
            g += x.x * g2r[r] + x.y * g2r[r + 1] + x.z * g2r[r + 2] + x.w * g2r[r + 3];
        }
        const float y = bf2f(ys[(size_t)row * 256 + c]) + bf2f(ys[(size_t)NT * 256 + (size_t)row * 256 + c]);
        const float mu = wave_sum(y) * (1.f / 64.f);
        const float dv = y - mu;
        const float var = wave_sum(dv * dv) * (1.f / 64.f);
        const float yn = dv * rsqrtf(var + 64e-5f) * gng + gnb;
        const bf16_t* zr = z + (size_t)row * ZS;
        const float r = bf2f(zr[c]), k = bf2f(zr[256 + c]), v = bf2f(zr[512 + c]);
        const float a0 = bf2f(rwp[((size_t)row * 4 + 2) * 256 + c]), a1 = bf2f(rwp[((size_t)row * 4 + 3) * 256 + c]);
        const float kd = k * (1.f + (a0 - 1.f) * ka) + k * (1.f + (a1 - 1.f) * ka);
        const float dot = wave_sum(r * kd * rk);
        cat[(size_t)row * DM + c] = f2bf((yn + dot * v) * g);
    }
    __syncthreads();
}

__device__ __forceinline__ void gdn_post_unit(const P& p, int l, int u) {
    const int tid = otid(), c = tid;
    const bf16_t* z = (const bf16_t*)(p.ws + WS_Z);
    const bf16_t* ys = (const bf16_t*)(p.ws + WS_HBY) + (size_t)2 * NT * 256;
    bf16_t* cat = (bf16_t*)(p.ws + WS_CAT);
    const float ng = p.in(I_GD_NORM)[l * 64 + (c & 63)];
    const int row0 = u * 32;
#pragma unroll 4
    for (int tok = 0; tok < 32; ++tok) {
        const int row = row0 + tok;
        const float o = bf2f(ys[(size_t)row * 256 + c]) + bf2f(ys[(size_t)NT * 256 + (size_t)row * 256 + c]);
        const float ms = wave_sum(o * o) * (1.f / 64.f);
        const float zg = bf2f(z[(size_t)row * ZS + COL_GD + 768 + c]);
        cat[(size_t)row * DM + 256 + c] = f2bf(o * rsqrtf(ms + 1e-6f) * ng * siluf(zg));
    }
}

#define NPHASE 36
template <typename F>
__device__ __forceinline__ void strided(int n, F f) { for (int u = blockIdx.x; u < n; u += gridDim.x) f(u); }

__global__ void __launch_bounds__(NTHREADS, 2) fwd_kernel(KP kp) {
    extern __shared__ __attribute__((aligned(16))) char smem[];
    char* lds = smem + LDS_USER;
    {
    const int tid = otid();
    if (tid == 0) *reinterpret_cast<uint4*>(smem) = make_uint4(0u, 0u, 0u, 0u);
    if (tid < 52) { const unsigned long long v = (unsigned long long)kp.in[tid]; ((unsigned*)(smem + 512))[2 * tid] = (unsigned)v; ((unsigned*)(smem + 512))[2 * tid + 1] = (unsigned)(v >> 32); }
    }
    __syncthreads();
    P p; p.tab = (const __attribute__((address_space(3))) unsigned*)(smem + 512); p.out = kp.out; p.ws = kp.ws;
    unsigned* ctl = (unsigned*)(p.ws + WS_CTL);
    XcdBarrier bar = xcd_barrier_post(ctl, (volatile LAS unsigned*)smem);
    const int lo = kp.ph_lo, hi = kp.ph_hi;
#define PHASE_BEGIN(ph) if ((ph) >= lo && (ph) < hi) { if ((ph) > lo) { xcd_barrier(bar); }
#define PHASE_END }
#define LANE_IDS const int tid = otid(); const int wid = tid >> 6, lane = tid & 63, wr = wid >> 1, wc = wid & 1, fr = lane & 15, fq = lane >> 4; (void)wid; (void)lane; (void)wr; (void)wc; (void)fr; (void)fq;

    PHASE_BEGIN(0)
        strided(192 + 64 + 32, [&](int u) {
            if (u < 192) ph0_mod_unit(p, u, lds);
            else if (u < 256) ph0_s5tab_unit(p, u - 192);
            else { const int v = u - 256, ll = v >> 4, t = v & 15;
                   xpose_tile(p.in(I_S5_GLUW) + (size_t)ll * 65536, 256, (bf16_t*)(p.ws + WS_GLUT) + (size_t)ll * 65536, 256, 0, t >> 2, t & 3, lds); }
        });
    PHASE_END

#pragma unroll 1
    for (int l = 0; l < 2; ++l) {
        const int pb = 1 + 17 * l;
        PHASE_BEGIN(pb + 0)
            strided(4352 + 1088 + 768 + 256, [&](int u) {
                if (u < 4352) { if (l == 0) rows_unit<M_INIT>(p, l, u, lds); else rows_unit<M_LN2NEXT>(p, l, u, lds); }
                else if (u < 5440) filt_unit(p, l, u - 4352, lds);
                else if (u < 6208) { const int v = u - 5440; xpose_tile(p.in(I_WIN) + (size_t)l * 1024 * 3024, 3024, (bf16_t*)(p.ws + WS_WINT), 1024, 0, v / 48, v % 48, lds); }
                else { const int v = u - 6208; xpose_tile(p.in(I_WOUT) + (size_t)l * 1024 * 1024, 1024, (bf16_t*)(p.ws + WS_WOUTT), 1024, 0, v >> 4, v & 15, lds); }
            });
        PHASE_END
        PHASE_BEGIN(pb + 1)
            strided(272 * 24, [&](int u) {
                LANE_IDS
                const int mt = u / 24, nt = u % 24;
                f32x4 acc[4][4];
                gemm_tile((const bf16_t*)(p.ws + WS_HBY), DM, arows_lin(mt * 128, tid),
                          (const bf16_t*)(p.ws + WS_WINT), DM, nt * 128, DM, lds, acc);
                bf16_t* z = (bf16_t*)(p.ws + WS_Z);
#pragma unroll
                for (int m = 0; m < 4; ++m)
#pragma unroll
                    for (int n = 0; n < 4; ++n) {
                        const int col = nt * 128 + wc * 64 + n * 16 + fr;
                        if (col < ZS) {
#pragma unroll
                            for (int j = 0; j < 4; ++j) z[(size_t)(mt * 128 + wr * 64 + m * 16 + fq * 4 + j) * ZS + col] = f2bf(acc[m][n][j]);
                        }
                    }
            });
        PHASE_END
        PHASE_BEGIN(pb + 2)
            strided(512 + 512 + 1088 + 1088 + 4352, [&](int u) {
                if (u < 512) hfft_unit(p, l, u, lds);
                else if (u < 1024) hyena_prep_unit(p, l, u - 512, lds);
                else if (u < 2112) rwkv_prep_unit(p, l, u - 1024, lds);
                else if (u < 3200) gdn_prep_unit(p, l, u - 2112);
                else s5_pre_unit(p, l, u - 3200, lds);
            });
        PHASE_END
        PHASE_BEGIN(pb + 3)
            {
                int* qslot = (int*)(smem + 64);
                const int NU = 256 + 1024 + 544 + 1024;
                for (;;) {
                    if (otid() == 0) *qslot = (int)atomicAdd(&ctl[CW_QUEUE(l) + kp.rep], 1u);
                    __syncthreads();
                    const int u = *qslot;
                    __syncthreads();
                    if (u >= NU) break;
                    if (u < 256) scan_unit(p, l, u, lds);
                    else if (u < 1280) hyena_fft_unit(p, l, u - 256, lds);
                    else if (u < 1824) { if (kp.rep == 0) s5_main_unit(p, l, u - 1280, lds); }
                    else hyena_unit<256>(p, l, u - 1824, lds);
                    __syncthreads();
                }
            }
        PHASE_END
        PHASE_BEGIN(pb + 4)
            strided(1088 + 1088 + 544, [&](int u) {
                if (u < 1088) rwkv_post_unit(p, l, u, lds);
                else if (u < 2176) gdn_post_unit(p, l, u - 1088);
                else {
                    LANE_IDS
                    const int v = u - 2176, mt = v >> 1, nt = v & 1;
                    f32x4 acc[4][4];
                    const bf16_t* A = (const bf16_t*)(p.ws + WS_Z) + COL_S5;
                    gemm_tile(A, ZS, arows_lin(mt * 128, tid),
                              (const bf16_t*)(p.ws + WS_GLUT) + (size_t)l * 65536, 256, nt * 128, 256, lds, acc);
                    bf16_t* cat = (bf16_t*)(p.ws + WS_CAT);
#pragma unroll
                    for (int m = 0; m < 4; ++m)
#pragma unroll
                        for (int n = 0; n < 4; ++n) {
                            const int col = nt * 128 + wc * 64 + n * 16 + fr;
                            const float gb = p.in(I_S5_GLUB)[l * 256 + col];
#pragma unroll
                            for (int j = 0; j < 4; ++j) {
                                const int row = mt * 128 + wr * 64 + m * 16 + fq * 4 + j;
                                const float yg = bf2f(A[(size_t)row * ZS + col]);
                                cat[(size_t)row * DM + 768 + col] = f2bf(yg * sigm(acc[m][n][j] + gb));
                            }
                        }
                }
            });
        PHASE_END
        PHASE_BEGIN(pb + 5)
            strided(272 * 8 + 65 * 192, [&](int u) {
                if (u < 2176) {
                    LANE_IDS
                    const int mt = u >> 3, nt = u & 7;
                    f32x4 acc[4][4];
                    gemm_tile((const bf16_t*)(p.ws + WS_CAT), DM, arows_lin(mt * 128, tid),
                              (const bf16_t*)(p.ws + WS_WOUTT), DM, nt * 128, DM, lds, acc);
#pragma unroll
                    for (int m = 0; m < 4; ++m)
#pragma unroll
                        for (int j = 0; j < 4; ++j) {
                            const int row = mt * 128 + wr * 64 + m * 16 + fq * 4 + j;
                            float* xr = xrow(p, row);
                            const float* ga = modp(p, l, row_mod(row), 2);
#pragma unroll
                            for (int n = 0; n < 4; ++n) {
                                const int col = nt * 128 + wc * 64 + n * 16 + fr;
                                if (kp.rep == 0) xr[col] = ALPHA * xr[col] + ga[col] * acc[m][n][j];
                            }
                        }
                } else {
                    const int v = u - 2176, e = v / 192, t = v % 192, which = t >> 6, tt = t & 63;
                    bf16_t* W13 = (bf16_t*)(p.ws + WS_R1 + R1_W13T) + (size_t)e * 512 * 1024;
                    bf16_t* W2 = (bf16_t*)(p.ws + WS_R1 + R1_W2T) + (size_t)e * 1024 * 256;
                    if (which == 0) {
                        const float* src = (e < 64) ? p.in(I_EX_W1) + ((size_t)l * 64 + e) * 262144 : p.in(I_SH_W1) + (size_t)l * 262144;
                        xpose_tile(src, 256, W13, 1024, 1, tt >> 2, tt & 3, lds);
                    } else if (which == 1) {
                        const float* src = (e < 64) ? p.in(I_EX_W3) + ((size_t)l * 64 + e) * 262144 : p.in(I_SH_W3) + (size_t)l * 262144;
                        xpose_tile(src, 256, W13, 1024, 2, tt >> 2, tt & 3, lds);
                    } else {
                        const float* src = (e < 64) ? p.in(I_EX_W2) + ((size_t)l * 64 + e) * 262144 : p.in(I_SH_W2) + (size_t)l * 262144;
                        xpose_tile(src, 1024, W2, 256, 0, tt >> 4, tt & 15, lds);
                    }
                }
            });
        PHASE_END
        PHASE_BEGIN(pb + 6)
            strided(4352, [&](int u) { rows_unit<M_LN1>(p, l, u, lds, kp.rep > 0); __syncthreads(); });
        PHASE_END
        PHASE_BEGIN(pb + 7)
            {
                int* tb = (int*)lds;
                const int tid = otid();
                const unsigned* cnt = ctl + CW_CNT(l);
                if (tid == 0) { int a = 0; for (int e = 0; e < 64; ++e) { tb[e] = a; a += ((int)xb_ld((unsigned*)&cnt[e]) + 127) >> 7; } tb[64] = a; }
                __syncthreads();
                const int* aep = (const int*)(p.ws + WS_AEP); const float* aw = (const float*)(p.ws + WS_AW);
                int* rtok = (int*)(p.ws + WS_RTOK); float* rwt = (float*)(p.ws + WS_RW); int* tile_e = (int*)(p.ws + WS_TILEE);
                for (int a = blockIdx.x * NTHREADS + tid; a < NT * 8; a += gridDim.x * NTHREADS) {
                    const unsigned v = (unsigned)aep[a];
                    const int e = v >> 24, pos = v & 0xFFFFFF;
                    const int dest = tb[e] * 128 + pos;
                    rtok[dest] = a >> 3; rwt[dest] = aw[a];
                }
                for (int e = blockIdx.x; e < 64; e += gridDim.x) {
                    const int c0 = (int)xb_ld((unsigned*)&cnt[e]), nt_e = (c0 + 127) >> 7;
                    for (int q = c0 + tid; q < nt_e * 128; q += NTHREADS) { rtok[tb[e] * 128 + q] = -1; rwt[tb[e] * 128 + q] = 0.f; }
                    for (int q = tid; q < nt_e; q += NTHREADS) tile_e[tb[e] + q] = e;
                }
                __syncthreads();
            }
        PHASE_END
        PHASE_BEGIN(pb + 8)
            {
                int* sh = (int*)(smem + 128);
                if (otid() == 0) { const unsigned* cnt = ctl + CW_CNT(l); int a = 0; for (int e = 0; e < 64; ++e) a += ((int)xb_ld((unsigned*)&cnt[e]) + 127) >> 7; *sh = a; }
                __syncthreads();
                const int ntr = *sh;
                const int* rtok = (const int*)(p.ws + WS_RTOK); const int* tile_e = (const int*)(p.ws + WS_TILEE);
                strided((ntr + 272) * 4, [&](int u) {
                    LANE_IDS
                    const int tile = u >> 2, jn = u & 3;
                    int e, obase; ARows ar;
                    if (tile < ntr) {
                        e = tile_e[tile]; obase = tile * 128;
#pragma unroll
                        for (int i = 0; i < 4; ++i) { const int r = rtok[obase + (tid >> 3) + 32 * i]; ar.r[i] = r < 0 ? 0 : r; }
                    } else {
                        const int stt = tile - ntr; e = 64; obase = (SH_TILE_BASE + stt) * 128;
                        ar = arows_lin(stt * 128, tid);
                    }
                    f32x4 acc[4][4];
                    gemm_tile((const bf16_t*)(p.ws + WS_HBY), DM, ar,
                              (const bf16_t*)(p.ws + WS_R1 + R1_W13T) + (size_t)e * 512 * 1024, DM, jn * 128, DM, lds, acc);
                    bf16_t* act = (bf16_t*)(p.ws + WS_ACT);
#pragma unroll
                    for (int m = 0; m < 4; ++m)
#pragma unroll
                        for (int pp = 0; pp < 2; ++pp)
#pragma unroll
                            for (int j = 0; j < 4; ++j) {
                                const float g = acc[m][2 * pp][j], uu = acc[m][2 * pp + 1][j];
                                const int orow = obase + wr * 64 + m * 16 + fq * 4 + j;
                                const int col = jn * 64 + wc * 32 + pp * 16 + fr;
                                act[(size_t)orow * 256 + col] = f2bf(siluf(g) * uu);
                            }
                });
            }
        PHASE_END
#pragma unroll 1
        for (int sl = 0; sl < 4; ++sl) {
            PHASE_BEGIN(pb + 9 + 2 * sl)
            {
                int* sh = (int*)(smem + 128);
                if (otid() == 0) { const unsigned* cnt = ctl + CW_CNT(l); int a = 0; for (int e = 0; e < 64; ++e) a += ((int)xb_ld((unsigned*)&cnt[e]) + 127) >> 7; *sh = a; }
                __syncthreads();
                const int ntr = *sh;
                const int* tile_e = (const int*)(p.ws + WS_TILEE);
                strided((ntr + 272) * 2, [&](int u) {
                    LANE_IDS
                    const int tile = u >> 1, nt2 = u & 1;
                    int e, obase;
                    if (tile < ntr) { e = tile_e[tile]; obase = tile * 128; }
                    else { e = 64; obase = (SH_TILE_BASE + tile - ntr) * 128; }
                    f32x4 acc[4][4];
                    gemm_tile((const bf16_t*)(p.ws + WS_ACT), 256, arows_lin(obase, tid),
                              (const bf16_t*)(p.ws + WS_R1 + R1_W2T) + (size_t)e * 1024 * 256, 256, sl * 256 + nt2 * 128, 256, lds, acc);
                    bf16_t* y2 = (bf16_t*)(p.ws + WS_Y2);
#pragma unroll
                    for (int m = 0; m < 4; ++m)
#pragma unroll
                        for (int j = 0; j < 4; ++j) {
                            const int orow = obase + wr * 64 + m * 16 + fq * 4 + j;
#pragma unroll
                            for (int n = 0; n < 4; ++n) y2[(size_t)orow * 256 + nt2 * 128 + wc * 64 + n * 16 + fr] = f2bf(acc[m][n][j]);
                        }
                });
            }
            PHASE_END
            PHASE_BEGIN(pb + 10 + 2 * sl)
            {
                int* tb = (int*)lds;
                const int tid = otid();
                const unsigned* cnt = ctl + CW_CNT(l);
                if (tid == 0) { int a = 0; for (int e = 0; e < 64; ++e) { tb[e] = a; a += ((int)xb_ld((unsigned*)&cnt[e]) + 127) >> 7; } tb[64] = a; }
                __syncthreads();
                const int* aep = (const int*)(p.ws + WS_AEP); const float* aw = (const float*)(p.ws + WS_AW);
                const bf16_t* y2 = (const bf16_t*)(p.ws + WS_Y2);
                const int tl = tid >> 5, cg = tid & 31;
                for (int grp = blockIdx.x; grp < NT / 8; grp += gridDim.x) {
                    const int tok = grp * 8 + tl;
                    float a8[8];
                    {
                        const uint4 sv = *reinterpret_cast<const uint4*>(y2 + ((size_t)(SH_TILE_BASE * 128 + tok)) * 256 + cg * 8);
                        a8[0] = bflo(sv.x); a8[1] = bfhi(sv.x); a8[2] = bflo(sv.y); a8[3] = bfhi(sv.y);
                        a8[4] = bflo(sv.z); a8[5] = bfhi(sv.z); a8[6] = bflo(sv.w); a8[7] = bfhi(sv.w);
                    }
#pragma unroll
                    for (int k = 0; k < 8; ++k) {
                        const unsigned v = (unsigned)aep[(size_t)tok * 8 + k];
                        const float wk = aw[(size_t)tok * 8 + k];
                        const int dest = tb[v >> 24] * 128 + (int)(v & 0xFFFFFFu);
                        const uint4 yv = *reinterpret_cast<const uint4*>(y2 + (size_t)dest * 256 + cg * 8);
                        a8[0] += wk * bflo(yv.x); a8[1] += wk * bfhi(yv.x); a8[2] += wk * bflo(yv.y); a8[3] += wk * bfhi(yv.y);
                        a8[4] += wk * bflo(yv.z); a8[5] += wk * bfhi(yv.z); a8[6] += wk * bflo(yv.w); a8[7] += wk * bfhi(yv.w);
                    }
                    float* xr = xrow(p, tok) + sl * 256 + cg * 8;
                    const float* ga = modp(p, l, row_mod(tok), 5) + sl * 256 + cg * 8;
                    float4 x0 = *reinterpret_cast<const float4*>(xr), x1 = *reinterpret_cast<const float4*>(xr + 4);
                    const float4 g0 = *reinterpret_cast<const float4*>(ga), g1 = *reinterpret_cast<const float4*>(ga + 4);
                    x0.x += g0.x * a8[0]; x0.y += g0.y * a8[1]; x0.z += g0.z * a8[2]; x0.w += g0.w * a8[3];
                    x1.x += g1.x * a8[4]; x1.y += g1.y * a8[5]; x1.z += g1.z * a8[6]; x1.w += g1.w * a8[7];
                    if (kp.rep == 0) { *reinterpret_cast<float4*>(xr) = x0; *reinterpret_cast<float4*>(xr + 4) = x1; }
                }
                __syncthreads();
            }
            PHASE_END
        }
    }
    PHASE_BEGIN(35)
        strided(4352, [&](int u) { rows_unit<M_FINAL>(p, 1, u, lds); });
    PHASE_END
}

#ifndef N_LAUNCH_MODE
#define N_LAUNCH_MODE 1
#endif
extern "C" void kernel_launch(void* const* d_in, const int* in_sizes, int n_in, void* d_out, int out_size, void* d_ws, size_t ws_size, hipStream_t stream) {
    static int grid = 0;
    if (grid == 0) {
        if (n_in != 52 || out_size != NTL * DM || ws_size < WS_END) { fprintf(stderr, "kernel_launch: unexpected shapes (n_in %d out %d ws %zu need %zu)\n", n_in, out_size, ws_size, (size_t)WS_END); grid = -1; return; }
        int dev = 0, cus = 0, per_cu = 0;
        hipGetDevice(&dev);
        hipDeviceGetAttribute(&cus, hipDeviceAttributeMultiprocessorCount, dev);
        hipFuncSetAttribute((const void*)fwd_kernel, hipFuncAttributeMaxDynamicSharedMemorySize, LDS_BYTES);
        hipOccupancyMaxActiveBlocksPerMultiprocessor(&per_cu, (const void*)fwd_kernel, NTHREADS, LDS_BYTES);
        (void)hipGetLastError();
        if (per_cu < 1) per_cu = 1;
        if (per_cu > 2) per_cu = 2;
        grid = cus * per_cu;
    }
    if (grid < 0) return;
    hipMemsetAsync((char*)d_ws + WS_CTL, 0, CTL_BYTES, stream);
    KP p{};
    for (int i = 0; i < 52; ++i) p.in[i] = (const float*)d_in[i];
    p.out = (float*)d_out; p.ws = (char*)d_ws;
#if defined(PROBE_PH)
    for (int ph = 0; ph < NPHASE; ++ph) {
        const int reps = (ph == PROBE_PH) ? 1 + PROBE_N : 1;
        for (int r = 0; r < reps; ++r) { p.ph_lo = ph; p.ph_hi = ph + 1; p.rep = r; hipLaunchKernelGGL(fwd_kernel, dim3(grid), dim3(NTHREADS), LDS_BYTES, stream, p); }
    }
#elif N_LAUNCH_MODE == 1
    p.ph_lo = 0; p.ph_hi = NPHASE;
    hipLaunchKernelGGL(fwd_kernel, dim3(grid), dim3(NTHREADS), LDS_BYTES, stream, p);
#else
    for (int ph = 0; ph < NPHASE; ++ph) {
        p.ph_lo = ph; p.ph_hi = ph + 1;
        hipLaunchKernelGGL(fwd_kernel, dim3(grid), dim3(NTHREADS), LDS_BYTES, stream, p);
    }
#endif
}
```

```cpp
#include <hip/hip_runtime.h>
#include <hip/hip_bf16.h>
#include <hip/hip_fp16.h>
#include <stdint.h>
#include <stdio.h>

typedef unsigned short bf16_t;
using bf16x8 = __attribute__((ext_vector_type(8))) short;
using f32x4 = __attribute__((ext_vector_type(4))) float;

#define NTC 2048
#define NTL 32768
#define NT 34816
#define DM 1024
#define ZS 3024
#define COL_GD 960
#define COL_HY 2000
#define COL_S5 2768
#define NCHUNK 68
#define ALPHA 1.41421356237f
#define NTHREADS 256
#define LDS_BYTES 73728
#define LDS_USER 1024
#define SH_TILE_BASE 2240
#define ACT_ROWS ((SH_TILE_BASE + 272) * 128)

constexpr size_t al256(size_t x) { return (x + 255) & ~(size_t)255; }
constexpr size_t WS_CTL = 0;
constexpr size_t CTL_BYTES = 65536;
constexpr size_t WS_MOD = WS_CTL + CTL_BYTES;
constexpr size_t WS_S5A = al256(WS_MOD + 2 * 9 * 6144 * 4);
constexpr size_t WS_S5B = al256(WS_S5A + 2 * 2 * 16 * 64 * 4 * 4);
constexpr size_t WS_GLUT = al256(WS_S5B + 2 * 2 * 16 * 64 * 32 * 4);
constexpr size_t WS_WINT = al256(WS_GLUT + 2 * 256 * 256 * 2);
constexpr size_t WS_WOUTT = al256(WS_WINT + (size_t)3072 * 1024 * 2);
constexpr size_t WS_FILTL = al256(WS_WOUTT + (size_t)1024 * 1024 * 2);
constexpr size_t WS_FILTC = al256(WS_FILTL + (size_t)4 * 256 * 4096 * 4);
constexpr size_t WS_XC = al256(WS_FILTC + (size_t)4 * 256 * 256 * 4);
constexpr size_t WS_HBY = al256(WS_XC + (size_t)NTC * DM * 4);
constexpr size_t WS_CAT = al256(WS_HBY + (size_t)NT * DM * 2);
constexpr size_t WS_Z = al256(WS_CAT + (size_t)NT * DM * 2);
constexpr size_t WS_R1 = al256(WS_Z + (size_t)NT * ZS * 2);
constexpr size_t R1_RWP = 0;
constexpr size_t R1_GQ = (size_t)NT * 1024 * 2;
constexpr size_t R1_W13T = 0;
constexpr size_t R1_W2T = (size_t)65 * 512 * 1024 * 2;
constexpr size_t R1_BYTES = (size_t)NT * 1024 * 2 + (size_t)NT * 768 * 2;
constexpr size_t WS_KNORM = al256(WS_R1 + R1_BYTES);
constexpr size_t WS_GAB = al256(WS_KNORM + (size_t)NT * 4 * 4);
constexpr size_t WS_S5ST = al256(WS_GAB + (size_t)NT * 16 * 4);
constexpr size_t WS_AEP = al256(WS_S5ST + (size_t)8 * 68 * 2 * 16 * 64 * 2 * 4);
constexpr size_t WS_AW = al256(WS_AEP + (size_t)NT * 8 * 4);
constexpr size_t WS_RTOK = al256(WS_AW + (size_t)NT * 8 * 4);
constexpr size_t WS_RW = al256(WS_RTOK + (size_t)SH_TILE_BASE * 128 * 4);
constexpr size_t WS_TILEE = al256(WS_RW + (size_t)SH_TILE_BASE * 128 * 4);
constexpr size_t WS_HYT = al256(WS_TILEE + SH_TILE_BASE * 4);
constexpr size_t WS_END = al256(WS_HYT + (size_t)8 * 768 * 4096 * 2);
static_assert(R1_W2T + (size_t)65 * 1024 * 256 * 2 <= R1_BYTES, "expert weights must fit R1");
constexpr size_t ACT_BYTES = (size_t)ACT_ROWS * 256 * 2;
constexpr size_t WS_ACT = WS_Z + ((((size_t)NT * ZS * 2 - ACT_BYTES) >> 8) << 8);
constexpr size_t WS_Y2 = WS_HBY;
static_assert(WS_Y2 + ACT_BYTES <= WS_ACT, "y2 must not reach act");

#define CW_QUEUE(l) (4096 + 64 * (l))
#define CW_CNT(l) (4352 + 64 * (l))
#define CW_CUCNT(l) (8192 + 4096 * (l))

#define XB_TMO      128
#define XB_XCNT(j)  (256  + 64 * (j))
#define XB_XSUB(j)  (1280 + 64 * (j))
#define XB_XGEN(j)  (2304 + 64 * (j))
#define XB_TOP      3328
#define XB_TOPGEN   3392
#define XCD_BAR_WORDS 3456
#define XB_SPIN_CAP (1u << 18)
#define LAS __attribute__((address_space(3)))

__device__ __forceinline__ unsigned xb_ld(unsigned* p)              { return __hip_atomic_load(p, __ATOMIC_RELAXED, __HIP_MEMORY_SCOPE_AGENT); }
__device__ __forceinline__ unsigned xb_add(unsigned* p, unsigned v) { return __hip_atomic_fetch_add(p, v, __ATOMIC_RELAXED, __HIP_MEMORY_SCOPE_AGENT); }
__device__ __forceinline__ unsigned xb_xcc_id() { return (unsigned)__builtin_amdgcn_s_getreg((3 << 11) | 20) & 0xFu; }
#define XB_SPIN(cond, bar) do { unsigned _sp = 0; while (cond) { __builtin_amdgcn_s_sleep(1); \
    if ((++_sp & 255u) == 0u) { if (xb_ld(&(bar)[XB_TMO])) break; if (_sp > XB_SPIN_CAP) { atomicAdd(&(bar)[XB_TMO], 1u); break; } } } } while (0)

struct XcdBarrier {
    unsigned* bar; unsigned x;
    volatile LAS unsigned* st;
};
__device__ __forceinline__ XcdBarrier xcd_barrier_post(unsigned* bar, volatile LAS unsigned* st) {
    XcdBarrier b; b.bar = bar; b.x = xb_xcc_id(); b.st = st;
    if (threadIdx.x == 0) (void)xb_add(&bar[XB_XCNT(b.x)], 1u);
    return b;
}
__device__ __forceinline__ void xcd_barrier_complete(unsigned* bar, unsigned x, unsigned& nloc, unsigned& nx) {
    const unsigned G = gridDim.x * gridDim.y * gridDim.z;
    unsigned sum, cnt, mine, sp = 0u;
    for (;;) {
        sum = 0u; cnt = 0u; mine = 0u;
#pragma unroll
        for (unsigned j = 0; j < 16; ++j) { const unsigned c = xb_ld(&bar[XB_XCNT(j)]); sum += c; cnt += (c > 0u) ? 1u : 0u; mine = (j == x) ? c : mine; }
        if (sum == G) break;
        __builtin_amdgcn_s_sleep(1);
        if ((++sp & 255u) == 0u) { if (xb_ld(&bar[XB_TMO])) break; if (sp > XB_SPIN_CAP) { atomicAdd(&bar[XB_TMO], 1u); break; } }
    }
    nloc = mine > 0u ? mine : 1u; nx = cnt > 0u ? cnt : 1u;
}
__device__ __forceinline__ void xcd_barrier(const XcdBarrier& b) {
    asm volatile("s_waitcnt vmcnt(0)" ::: "memory");
    __syncthreads();
    if (threadIdx.x == 0) {
        unsigned* bar = b.bar;
        __builtin_amdgcn_s_waitcnt(0);
        unsigned nloc = b.st[0], nx = b.st[1];
        if (nloc == 0u) { xcd_barrier_complete(bar, b.x, nloc, nx); b.st[0] = nloc; b.st[1] = nx; }
        const unsigned old = xb_add(&bar[XB_XSUB(b.x)], 1u);
        const unsigned gen = old / nloc;
        if (old + 1u == (gen + 1u) * nloc) {
            __builtin_amdgcn_fence(__ATOMIC_RELEASE, "agent");
            asm volatile("s_waitcnt vmcnt(0)" ::: "memory");
            const unsigned og = xb_add(&bar[XB_TOP], 1u);
            const unsigned tg = og / nx;
            if (og + 1u == (tg + 1u) * nx) xb_add(&bar[XB_TOPGEN], 1u);
            else XB_SPIN(xb_ld(&bar[XB_TOPGEN]) == tg, bar);
            __builtin_amdgcn_fence(__ATOMIC_ACQUIRE, "agent");
            xb_add(&bar[XB_XGEN(b.x)], 1u);
            asm volatile("s_waitcnt vmcnt(0)" ::: "memory");
        } else {
            XB_SPIN(xb_ld(&bar[XB_XGEN(b.x)]) == gen, bar);
            __builtin_amdgcn_fence(__ATOMIC_ACQUIRE, "agent");
            asm volatile("s_waitcnt vmcnt(0)" ::: "memory");
        }
    }
    __syncthreads();
}

struct KP {
    const float* in[52];
    float* out;
    char* ws;
    int ph_lo, ph_hi, rep, pad_;
};
struct P {
    const __attribute__((address_space(3))) unsigned* tab;
    float* out;
    char* ws;
    __device__ __forceinline__ const float* in(int i) const {
        const unsigned lo = __builtin_amdgcn_readfirstlane(tab[2 * i]);
        const unsigned hi = __builtin_amdgcn_readfirstlane(tab[2 * i + 1]);
        return (const float*)(((unsigned long long)hi << 32) | (unsigned long long)lo);
    }
};
enum { I_X = 0, I_C, I_CTX, I_CCTX, I_ADAW, I_ADAB, I_WIN, I_WOUT, I_LNG, I_LNB,
       I_RW_W0, I_RW_W2, I_RW_A0, I_RW_A2, I_RW_G2, I_RW_KK, I_RW_KA, I_RW_RK, I_RW_GNG, I_RW_GNB,
       I_GD_CONV, I_GD_ALOG, I_GD_DTB, I_GD_NORM,
       I_HY_CONV, I_HY_CONVB, I_HY_W1, I_HY_B1, I_HY_F1, I_HY_W2, I_HY_B2, I_HY_F2, I_HY_W3, I_HY_SKIP,
       I_S5_LRE, I_S5_LIM, I_S5_LOGSTEP, I_S5_BRE, I_S5_BIM, I_S5_CRE, I_S5_CIM, I_S5_D, I_S5_GLUW, I_S5_GLUB,
       I_ROUTER_W, I_ROUTER_B, I_EX_W1, I_EX_W3, I_EX_W2, I_SH_W1, I_SH_W3, I_SH_W2 };

__device__ __forceinline__ bf16_t f2bf(float f) { unsigned u = __float_as_uint(f); u += 0x7fffu + ((u >> 16) & 1u); return (bf16_t)(u >> 16); }
__device__ __forceinline__ float bf2f(bf16_t h) { return __uint_as_float(((unsigned)h) << 16); }
__device__ __forceinline__ float bflo(unsigned u) { return __uint_as_float(u << 16); }
__device__ __forceinline__ float bfhi(unsigned u) { return __uint_as_float(u & 0xffff0000u); }
__device__ __forceinline__ unsigned pack2(float a, float b) { return (unsigned)f2bf(a) | ((unsigned)f2bf(b) << 16); }
__device__ __forceinline__ float sigm(float x) { return 1.f / (1.f + __expf(-x)); }
__device__ __forceinline__ float siluf(float x) { return x / (1.f + __expf(-x)); }
__device__ __forceinline__ float softplusf(float x) { return fmaxf(x, 0.f) + log1pf(__expf(-fabsf(x))); }
__device__ __forceinline__ float wave_sum(float v) {
#pragma unroll
    for (int o = 32; o >= 1; o >>= 1) v += __shfl_xor(v, o);
    return v;
}
template <int CTRL> __device__ __forceinline__ float dppf(float v) {
    return __int_as_float(__builtin_amdgcn_update_dpp(0, __float_as_int(v), CTRL, 0xF, 0xF, true));
}
__device__ __forceinline__ int otid() { int t = threadIdx.x; asm volatile("" : "+v"(t)); return t; }
__device__ __forceinline__ float* xrow(const P& p, int row) {
    return row < NTC ? (float*)(p.ws + WS_XC) + (size_t)row * DM : p.out + (size_t)(row - NTC) * DM;
}
__device__ __forceinline__ int row_mod(int row) { return row < NTC ? 8 : ((row - NTC) >> 12); }
__device__ __forceinline__ const float* modp(const P& p, int l, int r, int chunk) {
    return (const float*)(p.ws + WS_MOD) + ((size_t)(l * 9 + r) * 6144 + chunk * 1024);
}

struct ARows { int r[4]; };
__device__ __forceinline__ ARows arows_lin(int base, int tid) { ARows a; a.r[0] = base + (tid >> 3); a.r[1] = a.r[0] + 32; a.r[2] = a.r[0] + 64; a.r[3] = a.r[0] + 96; return a; }
__device__ __forceinline__ void gemm_tile(const bf16_t* __restrict__ A, int lda, const ARows& ar,
                                          const bf16_t* __restrict__ Bt, int ldb, int brow0, int K,
                                          char* lds, f32x4 (&acc)[4][4]) {
    const int tid = otid();
    const int wid = tid >> 6, lane = tid & 63, wr = wid >> 1, wc = wid & 1, fr = lane & 15, fq = lane >> 4;
    const int gc = ((tid & 7) ^ ((tid >> 3) & 7)) * 8;
    const bf16_t* ap[4]; const bf16_t* bp[4];
#pragma unroll
    for (int i = 0; i < 4; ++i) {
        ap[i] = A + (size_t)ar.r[i] * lda + gc;
        bp[i] = Bt + (size_t)(brow0 + (tid >> 3) + 32 * i) * ldb + gc;
    }
#pragma unroll
    for (int m = 0; m < 4; ++m)
#pragma unroll
        for (int n = 0; n < 4; ++n) acc[m][n] = f32x4{0.f, 0.f, 0.f, 0.f};
    const int nk = K >> 6;
    auto stage = [&](int t, int buf) {
        char* SA = lds + buf * 32768; char* SB = SA + 16384;
        const int ko = t * 64;
#pragma unroll
        for (int i = 0; i < 4; ++i) {
            __builtin_amdgcn_global_load_lds((const void*)(ap[i] + ko), (LAS void*)(SA + tid * 16 + i * 4096), 16, 0, 0);
            __builtin_amdgcn_global_load_lds((const void*)(bp[i] + ko), (LAS void*)(SB + tid * 16 + i * 4096), 16, 0, 0);
        }
    };
    stage(0, 0);
    asm volatile("s_waitcnt vmcnt(0)" ::: "memory");
    __syncthreads();
    const int sw = fr & 7;
    for (int t = 0; t < nk; ++t) {
        const int buf = t & 1;
        if (t + 1 < nk) stage(t + 1, buf ^ 1);
        const char* SA = lds + buf * 32768; const char* SB = SA + 16384;
#pragma unroll
        for (int ks = 0; ks < 2; ++ks) {
            const int co = ((ks * 4 + fq) ^ sw) * 16;
            bf16x8 af[4], bfr[4];
#pragma unroll
            for (int m = 0; m < 4; ++m) af[m] = *reinterpret_cast<const bf16x8*>(SA + (wr * 64 + m * 16 + fr) * 128 + co);
#pragma unroll
            for (int n = 0; n < 4; ++n) bfr[n] = *reinterpret_cast<const bf16x8*>(SB + (wc * 64 + n * 16 + fr) * 128 + co);
#pragma unroll
            for (int m = 0; m < 4; ++m)
#pragma unroll
                for (int n = 0; n < 4; ++n) acc[m][n] = __builtin_amdgcn_mfma_f32_16x16x32_bf16(af[m], bfr[n], acc[m][n], 0, 0, 0);
        }
        asm volatile("s_waitcnt vmcnt(0)" ::: "memory");
        __syncthreads();
    }
}

__device__ __forceinline__ void ph0_mod_unit(const P& p, int u, char* lds) {
    const int l = u / 96, cg = u % 96, tid = otid();
    float* s = (float*)lds;
    float* red = s + 9 * 1024;
    const float* c = p.in(I_C); const float* cctx = p.in(I_CCTX);
    for (int i = tid; i < 9 * 1024; i += NTHREADS) { int r = i >> 10, k = i & 1023; float v = r < 8 ? c[r * 1024 + k] : cctx[k]; s[i] = v / (1.f + expf(-v)); }
    __syncthreads();
    const int kq = tid >> 6, j = tid & 63, col = cg * 64 + j;
    const float* w = p.in(I_ADAW) + (size_t)l * 1024 * 6144 + col;
    float acc[9];
#pragma unroll
    for (int r = 0; r < 9; ++r) acc[r] = 0.f;
#pragma unroll 4
    for (int k = kq * 256; k < kq * 256 + 256; ++k) {
        const float wv = w[(size_t)k * 6144];
#pragma unroll
        for (int r = 0; r < 9; ++r) acc[r] += s[r * 1024 + k] * wv;
    }
#pragma unroll
    for (int r = 0; r < 9; ++r) red[(kq * 9 + r) * 64 + j] = acc[r];
    __syncthreads();
    if (tid < 64) {
        float* mod = (float*)(p.ws + WS_MOD);
        const float bb = p.in(I_ADAB)[l * 6144 + col];
#pragma unroll
        for (int r = 0; r < 9; ++r) mod[(size_t)(l * 9 + r) * 6144 + col] = red[r * 64 + j] + red[(9 + r) * 64 + j] + red[(18 + r) * 64 + j] + red[(27 + r) * 64 + j] + bb;
    }
    __syncthreads();
}

__device__ __forceinline__ void ph0_s5tab_unit(const P& p, int u) {
    const int tid = otid();
    if (tid >= 64) return;
    const int ldg = u;
    const int idx = ldg * 64 + tid;
    const double lre = (double)p.in(I_S5_LRE)[idx], lim = (double)p.in(I_S5_LIM)[idx];
    const double dt = (double)expf(p.in(I_S5_LOGSTEP)[ldg]);
    const float mag = expf((float)(lre * dt));
    double rev = lim * dt * 0.15915494309189535; rev -= floor(rev);
    float sn, cs; sincospif(2.f * (float)rev, &sn, &cs);
    const double abr = (double)(mag * cs), abi = (double)(mag * sn);
    const double den = lre * lre + lim * lim;
    const double cor = ((abr - 1.0) * lre + abi * lim) / den;
    const double coi = (abi * lre - (abr - 1.0) * lim) / den;
    const float m64f = expf((float)(64.0 * lre * dt));
    double rev64 = 64.0 * lim * dt * 0.15915494309189535; rev64 -= floor(rev64);
    float sn64, cs64; sincospif(2.f * (float)rev64, &sn64, &cs64);
    float* A = (float*)(p.ws + WS_S5A) + (size_t)idx * 4;
    A[0] = (float)abr; A[1] = (float)abi; A[2] = m64f * cs64; A[3] = m64f * sn64;
    float* B = (float*)(p.ws + WS_S5B) + (size_t)idx * 32;
    const float* bre = p.in(I_S5_BRE) + (size_t)idx * 16; const float* bim = p.in(I_S5_BIM) + (size_t)idx * 16;
#pragma unroll
    for (int h = 0; h < 16; ++h) {
        const double br = bre[h], bi = bim[h];
        B[h] = (float)(cor * br - coi * bi);
        B[16 + h] = (float)(cor * bi + coi * br);
    }
}

__device__ __forceinline__ int xmap(int mode, int c) {
    if (mode == 0) return c;
    const int j = c >> 6, cc = c & 63, wc = cc >> 5, pp = (cc & 31) >> 4, i = cc & 15;
    return j * 128 + wc * 64 + pp * 32 + i + (mode == 2 ? 16 : 0);
}
__device__ __forceinline__ void xpose_tile(const float* __restrict__ src, int C, bf16_t* __restrict__ dst, int ldd, int mode, int tr, int tc, char* lds) {
    float* t = (float*)lds;
    const int tid = otid();
    {
        const int c4 = (tid & 15) * 4, c = tc * 64 + c4;
#pragma unroll
        for (int k = 0; k < 4; ++k) {
            const int r = (tid >> 4) + 16 * k;
            float4 v = make_float4(0.f, 0.f, 0.f, 0.f);
            if (c < C) v = *reinterpret_cast<const float4*>(src + (size_t)(tr * 64 + r) * C + c);
            t[(c4 + 0) * 65 + r] = v.x; t[(c4 + 1) * 65 + r] = v.y; t[(c4 + 2) * 65 + r] = v.z; t[(c4 + 3) * 65 + r] = v.w;
        }
    }
    __syncthreads();
#pragma unroll
    for (int k = 0; k < 2; ++k) {
        const int ci = (tid >> 3) + 32 * k, r8 = (tid & 7) * 8;
        const float* tp = t + ci * 65 + r8;
        uint4 o;
        o.x = pack2(tp[0], tp[1]); o.y = pack2(tp[2], tp[3]); o.z = pack2(tp[4], tp[5]); o.w = pack2(tp[6], tp[7]);
        *reinterpret_cast<uint4*>(dst + (size_t)xmap(mode, tc * 64 + ci) * ldd + tr * 64 + r8) = o;
    }
    __syncthreads();
}

enum { M_INIT = 0, M_LN2NEXT = 1, M_LN1 = 2, M_FINAL = 3 };

template <int MODE>
__device__ __forceinline__ void rows_unit(const P& p, int l, int u, char* lds, bool dry = false) {
    const int tid = otid(), w = tid >> 6, lane = tid & 63;
    float* hbuf = (float*)lds;
    bf16_t* hb = (bf16_t*)(p.ws + WS_HBY);
#pragma unroll 1
    for (int rr = 0; rr < 2; ++rr) {
        const int rl = w * 2 + rr, row = u * 8 + rl;
        const int mr = row_mod(row);
        float v[16];
        float* xr = xrow(p, row);
        const float* src = (MODE == M_INIT) ? (row < NTC ? p.in(I_CTX) + (size_t)row * DM : p.in(I_X) + (size_t)(row - NTC) * DM) : xr;
#pragma unroll
        for (int i = 0; i < 4; ++i) {
            const float4 t = *reinterpret_cast<const float4*>(src + i * 256 + lane * 4);
            v[i * 4 + 0] = t.x; v[i * 4 + 1] = t.y; v[i * 4 + 2] = t.z; v[i * 4 + 3] = t.w;
        }
        if (MODE != M_INIT) {
            const int ll = (MODE == M_LN2NEXT) ? l - 1 : l;
            const int which = (MODE == M_LN1) ? 0 : 1;
            float s = 0.f;
#pragma unroll
            for (int i = 0; i < 16; ++i) s += v[i];
            const float mu = wave_sum(s) * (1.f / 1024.f);
            float q = 0.f;
#pragma unroll
            for (int i = 0; i < 16; ++i) { const float d = v[i] - mu; q += d * d; }
            const float rstd = rsqrtf(wave_sum(q) * (1.f / 1024.f) + 1e-5f);
            const float* g = p.in(I_LNG) + (size_t)(ll * 2 + which) * 1024;
            const float* bb = p.in(I_LNB) + (size_t)(ll * 2 + which) * 1024;
#pragma unroll
            for (int i = 0; i < 4; ++i) {
                const float4 gg = *reinterpret_cast<const float4*>(g + i * 256 + lane * 4);
                const float4 b4 = *reinterpret_cast<const float4*>(bb + i * 256 + lane * 4);
                v[i * 4 + 0] = (v[i * 4 + 0] - mu) * rstd * gg.x + b4.x;
                v[i * 4 + 1] = (v[i * 4 + 1] - mu) * rstd * gg.y + b4.y;
                v[i * 4 + 2] = (v[i * 4 + 2] - mu) * rstd * gg.z + b4.z;
                v[i * 4 + 3] = (v[i * 4 + 3] - mu) * rstd * gg.w + b4.w;
            }
        }
        if (MODE == M_FINAL) {
            if (row >= NTC) {
#pragma unroll
                for (int i = 0; i < 4; ++i) *reinterpret_cast<float4*>(xr + i * 256 + lane * 4) = make_float4(v[i * 4], v[i * 4 + 1], v[i * 4 + 2], v[i * 4 + 3]);
            }
            continue;
        }
        const float osc = (MODE == M_LN1) ? ALPHA : 1.f;
#pragma unroll
        for (int i = 0; i < 4; ++i) { float4 o4 = make_float4(osc * v[i * 4], osc * v[i * 4 + 1], osc * v[i * 4 + 2], osc * v[i * 4 + 3]); if (dry) o4 = *reinterpret_cast<const float4*>(src + i * 256 + lane * 4); *reinterpret_cast<float4*>(xr + i * 256 + lane * 4) = o4; }
        const float* sh = modp(p, l, mr, (MODE == M_LN1) ? 3 : 0);
        const float* sc = modp(p, l, mr, (MODE == M_LN1) ? 4 : 1);
#pragma unroll
        for (int i = 0; i < 4; ++i) {
            const float4 s4 = *reinterpret_cast<const float4*>(sc + i * 256 + lane * 4);
            const float4 h4 = *reinterpret_cast<const float4*>(sh + i * 256 + lane * 4);
            const float h0 = v[i * 4 + 0] * (1.f + s4.x) + h4.x, h1 = v[i * 4 + 1] * (1.f + s4.y) + h4.y;
            const float h2 = v[i * 4 + 2] * (1.f + s4.z) + h4.z, h3 = v[i * 4 + 3] * (1.f + s4.w) + h4.w;
            uint2 pk; pk.x = pack2(h0, h1); pk.y = pack2(h2, h3);
            if (!dry) *reinterpret_cast<uint2*>(hb + (size_t)row * DM + i * 256 + lane * 4) = pk;
            if (MODE == M_LN1) *reinterpret_cast<float4*>(hbuf + rl * 1024 + i * 256 + lane * 4) = make_float4(h0, h1, h2, h3);
        }
    }
    if (MODE == M_LN1) {
        float* part = hbuf + 8 * 1024;
        __syncthreads();
        {
            const float* rw = p.in(I_ROUTER_W) + (size_t)l * 1024 * 64 + lane;
            float ac[8];
#pragma unroll
            for (int r = 0; r < 8; ++r) ac[r] = 0.f;
#pragma unroll 2
            for (int k = w * 256; k < w * 256 + 256; k += 4) {
                const float w0 = rw[(size_t)(k + 0) * 64], w1 = rw[(size_t)(k + 1) * 64], w2 = rw[(size_t)(k + 2) * 64], w3 = rw[(size_t)(k + 3) * 64];
#pragma unroll
                for (int r = 0; r < 8; ++r) {
                    const float4 x = *reinterpret_cast<const float4*>(hbuf + r * 1024 + k);
                    ac[r] += x.x * w0 + x.y * w1 + x.z * w2 + x.w * w3;
                }
            }
#pragma unroll
            for (int r = 0; r < 8; ++r) part[(w * 8 + r) * 64 + lane] = ac[r];
        }
        __syncthreads();
        float a0, a1;
        {
            const int r0 = w * 2, r1 = w * 2 + 1;
            a0 = part[(0 * 8 + r0) * 64 + lane] + part[(1 * 8 + r0) * 64 + lane] + part[(2 * 8 + r0) * 64 + lane] + part[(3 * 8 + r0) * 64 + lane];
            a1 = part[(0 * 8 + r1) * 64 + lane] + part[(1 * 8 + r1) * 64 + lane] + part[(2 * 8 + r1) * 64 + lane] + part[(3 * 8 + r1) * 64 + lane];
        }
        const float rbias = p.in(I_ROUTER_B)[l * 64 + lane];
        unsigned* cnt = (unsigned*)(p.ws + WS_CTL) + CW_CNT(l);
        int* aep = (int*)(p.ws + WS_AEP); float* aw = (float*)(p.ws + WS_AW);
#pragma unroll 1
        for (int rr = 0; rr < 2; ++rr) {
            const int row = u * 8 + w * 2 + rr;
            const float logit = rr ? a1 : a0;
            const float s = 1.f / (1.f + expf(-logit));
            const float bsd = s + rbias;
            float m1 = bsd;
            m1 = fmaxf(m1, __shfl_xor(m1, 1)); m1 = fmaxf(m1, __shfl_xor(m1, 2)); m1 = fmaxf(m1, __shfl_xor(m1, 4));
            const unsigned long long eqm = __ballot(bsd == m1);
            const int gbase = lane & ~7;
            const unsigned gbits = (unsigned)((eqm >> gbase) & 0xFFull);
            const int first = gbase + __builtin_ctz(gbits);
            float m2 = (lane == first) ? -INFINITY : bsd;
            m2 = fmaxf(m2, __shfl_xor(m2, 1)); m2 = fmaxf(m2, __shfl_xor(m2, 2)); m2 = fmaxf(m2, __shfl_xor(m2, 4));
            const float gs = m1 + m2;
            const int myg = lane >> 3;
            int grank = 0;
#pragma unroll
            for (int g2 = 0; g2 < 8; ++g2) { const float o = __shfl(gs, g2 * 8); grank += (o > gs || (o == gs && g2 < myg)) ? 1 : 0; }
            const bool gsel = grank < 4;
            const float msk = gsel ? bsd : -INFINITY;
            int erank = 0;
#pragma unroll
            for (int j = 0; j < 64; ++j) { const float o = __shfl(msk, j); erank += (o > msk || (o == msk && j < lane)) ? 1 : 0; }
            const bool sel = gsel && erank < 8;
            const float wsum = wave_sum(sel ? s : 0.f);
            const unsigned long long selm = __ballot(sel);
            if (sel && !dry) {
                const int slot = __popcll(selm & ((1ull << lane) - 1ull));
                const unsigned pos = atomicAdd(&cnt[lane], 1u);
                aep[(size_t)row * 8 + slot] = (int)((unsigned)lane << 24 | pos);
                aw[(size_t)row * 8 + slot] = s / wsum * 2.5f;
            }
        }
    }
}

__device__ __forceinline__ void filt_unit(const P& p, int l, int u, char* lds) {
    const int tid = otid();
    float* feat = (float*)lds;
    float* h1 = feat + 4 * 36;
    float* h2 = h1 + 4 * 64;
    const int pp = tid >> 6, j = tid & 63;
    const int pi = u * 4 + pp;
    const int L = pi < 4096 ? 4096 : 256;
    const int t = pi < 4096 ? pi : pi - 4096;
    const float tt = (float)t / (float)(L - 1);
    if (j < 33) {
        float f;
        if (j == 0) f = tt;
        else {
            const int k = (j - 1) & 15;
            const float band = 1e-4f + (float)k * ((15.0f - 1e-4f) / 15.0f);
            float ph = band * (float)t * (1.f / (float)L);
            ph -= floorf(ph);
            float sn, cs; sincospif(2.f * ph, &sn, &cs);
            f = (j <= 16) ? cs : -sn;
        }
        feat[pp * 36 + j] = f;
    }
    __syncthreads();
    {
        const float* w1 = p.in(I_HY_W1) + (size_t)l * 33 * 64;
        float a = p.in(I_HY_B1)[l * 64 + j];
        for (int i = 0; i < 33; ++i) a += feat[pp * 36 + i] * w1[i * 64 + j];
        h1[pp * 64 + j] = sinf(p.in(I_HY_F1)[l * 64 + j] * a);
    }
    __syncthreads();
    {
        const float* w2 = p.in(I_HY_W2) + (size_t)l * 64 * 64;
        float a = p.in(I_HY_B2)[l * 64 + j];
        for (int i = 0; i < 64; ++i) a += h1[pp * 64 + i] * w2[i * 64 + j];
        h2[pp * 64 + j] = sinf(p.in(I_HY_F2)[l * 64 + j] * a);
    }
    __syncthreads();
    {
        const int c = tid;
        const float* w3 = p.in(I_HY_W3) + (size_t)l * 64 * 1024;
        float acc[4][4];
#pragma unroll
        for (int a = 0; a < 4; ++a)
#pragma unroll
            for (int b = 0; b < 4; ++b) acc[a][b] = 0.f;
        for (int i = 0; i < 64; ++i) {
            float wv[4];
#pragma unroll
            for (int os = 0; os < 4; ++os) wv[os] = w3[i * 1024 + os * 256 + c];
#pragma unroll
            for (int q = 0; q < 4; ++q) {
                const float hv = h2[q * 64 + i];
#pragma unroll
                for (int os = 0; os < 4; ++os) acc[q][os] += hv * wv[os];
            }
        }
        const float d0 = logf(0.01f) / 1.5f, d1 = logf(0.01f) / 0.3f;
        const float delta = fabsf(d0 + (d1 - d0) * ((float)c / 255.f));
#pragma unroll
        for (int q = 0; q < 4; ++q) {
            const int pq = u * 4 + q;
            const int Lq = pq < 4096 ? 4096 : 256;
            const int tq = pq < 4096 ? pq : pq - 4096;
            const float ttq = (float)tq / (float)(Lq - 1);
            const float dec = expf(-ttq * delta);
            float* F = (pq < 4096) ? (float*)(p.ws + WS_FILTL) : (float*)(p.ws + WS_FILTC);
#pragma unroll
            for (int os = 0; os < 4; ++os) {
                if (pq < 4096) F[((size_t)((os >> 1) * 256 + c) * 2 + (os & 1)) * 4096 + tq] = acc[q][os] * dec;
                else F[((size_t)os * 256 + c) * Lq + tq] = acc[q][os] * dec;
            }
        }
    }
    __syncthreads();
}

__device__ __forceinline__ void rwkv_prep_unit(const P& p, int l, int u, char* lds) {
    const int tid = otid(), w = tid >> 6;
    float* tw = (float*)lds;
    float* al = tw + 32 * 64;
    const bf16_t* z = (const bf16_t*)(p.ws + WS_Z);
    bf16_t* rwp = (bf16_t*)(p.ws + WS_R1 + R1_RWP);
    float* knorm = (float*)(p.ws + WS_KNORM);
    const int row0 = u * 32;
#pragma unroll
    for (int i = 0; i < 8; ++i) {
        const int idx = tid + 256 * i, tok = idx >> 6, j = idx & 63;
        const bf16_t* zr = z + (size_t)(row0 + tok) * ZS;
        tw[idx] = tanhf(bf2f(zr[768 + j]));
        al[idx] = bf2f(zr[832 + j]);
    }
    __syncthreads();
    const int c = tid;
#pragma unroll 1
    for (int pass = 0; pass < 4; ++pass) {
        const int d = pass & 1;
        const bool isA = pass >= 2;
        const float* W2 = (isA ? p.in(I_RW_A2) : p.in(I_RW_W2)) + (size_t)((l * 2 + d) * 32) * 256 + c;
        const float base = (isA ? p.in(I_RW_A0) : p.in(I_RW_W0))[(l * 2 + d) * 256 + c];
        float wr[32];
#pragma unroll
        for (int r = 0; r < 32; ++r) wr[r] = W2[r * 256];
        const float* src = isA ? al : tw;
#pragma unroll 2
        for (int tok = 0; tok < 32; ++tok) {
            float a = base;
#pragma unroll
            for (int r = 0; r < 32; r += 4) {
                const float4 x = *reinterpret_cast<const float4*>(src + tok * 64 + d * 32 + r);
                a += x.x * wr[r] + x.y * wr[r + 1] + x.z * wr[r + 2] + x.w * wr[r + 3];
            }
            float o;
            if (isA) o = 1.f / (1.f + expf(-a));
            else o = expf(-softplusf(-a) - 0.5f);
            rwp[((size_t)(row0 + tok) * 4 + pass) * 256 + c] = f2bf(o);
        }
    }
    const float kkc = p.in(I_RW_KK)[l * 256 + c];
#pragma unroll 4
    for (int tok = 0; tok < 32; ++tok) {
        const float kv = bf2f(z[(size_t)(row0 + tok) * ZS + 256 + c]) * kkc;
        const float ss = wave_sum(kv * kv);
        if ((tid & 63) == 0) knorm[(size_t)(row0 + tok) * 4 + w] = rsqrtf(ss + 1e-12f);
    }
    __syncthreads();
}

__device__ __forceinline__ void gdn_prep_unit(const P& p, int l, int u) {
    const int tid = otid();
    const bf16_t* z = (const bf16_t*)(p.ws + WS_Z);
    bf16_t* gq = (bf16_t*)(p.ws + WS_R1 + R1_GQ);
    float* gab = (float*)(p.ws + WS_GAB);
    const int row0 = u * 32;
    int seq0, seqL;
    if (row0 < NTC) { seq0 = row0 & ~255; seqL = 256; } else { seq0 = NTC + ((row0 - NTC) & ~4095); seqL = 4096; }
#pragma unroll 1
    for (int pz = 0; pz < 3; ++pz) {
        const int ch = pz * 256 + tid;
        const float w0 = p.in(I_GD_CONV)[(size_t)(l * 3 + 0) * 768 + ch], w1 = p.in(I_GD_CONV)[(size_t)(l * 3 + 1) * 768 + ch], w2 = p.in(I_GD_CONV)[(size_t)(l * 3 + 2) * 768 + ch];
        const bf16_t* zc = z + COL_GD + ch;
        float xm = (row0 - 1 >= seq0) ? bf2f(zc[(size_t)(row0 - 1) * ZS]) : 0.f;
        float x0 = bf2f(zc[(size_t)row0 * ZS]);
#pragma unroll 4
        for (int tok = 0; tok < 32; ++tok) {
            const int row = row0 + tok;
            const float xp = (row + 1 < seq0 + seqL) ? bf2f(zc[(size_t)(row + 1) * ZS]) : 0.f;
            float v = siluf(w0 * xm + w1 * x0 + w2 * xp);
            if (pz < 2) {
                const float ss = wave_sum(v * v);
                v *= rsqrtf(ss + 1e-12f) * (pz == 0 ? 0.125f : 1.f);
            }
            gq[(size_t)row * 768 + ch] = f2bf(v);
            xm = x0; x0 = xp;
        }
    }
    {
        const int tok = tid >> 3, dh = tid & 7;
        const int row = row0 + tok;
        const float alv = bf2f(z[(size_t)row * ZS + COL_GD + 1024 + dh]);
        const float blv = bf2f(z[(size_t)row * ZS + COL_GD + 1032 + dh]);
        const float g = -expf(p.in(I_GD_ALOG)[l * 8 + dh]) * softplusf(alv + p.in(I_GD_DTB)[l * 8 + dh]);
        gab[(size_t)row * 16 + dh] = expf(g);
        gab[(size_t)row * 16 + 8 + dh] = 1.f / (1.f + expf(-blv));
    }
}

__device__ __forceinline__ int s5_chain_row(int b, int d, int q) {
    if (q < 256) return b * 256 + (d ? 255 - q : q);
    int n = q - 256; if (d) n = 4095 - n;
    return NTC + b * 4096 + (n & 63) * 64 + (n >> 6);
}
__device__ __forceinline__ void s5_load_u(const bf16_t* zr, float* dst) {
    const uint4 a = *reinterpret_cast<const uint4*>(zr);
    const uint4 b = *reinterpret_cast<const uint4*>(zr + 8);
    *reinterpret_cast<float4*>(dst + 0) = make_float4(bflo(a.x), bfhi(a.x), bflo(a.y), bfhi(a.y));
    *reinterpret_cast<float4*>(dst + 4) = make_float4(bflo(a.z), bfhi(a.z), bflo(a.w), bfhi(a.w));
    *reinterpret_cast<float4*>(dst + 8) = make_float4(bflo(b.x), bfhi(b.x), bflo(b.y), bfhi(b.y));
    *reinterpret_cast<float4*>(dst + 12) = make_float4(bflo(b.z), bfhi(b.z), bflo(b.w), bfhi(b.w));
}

__device__ __forceinline__ void s5_pre_unit(const P& p, int l, int u, char* lds) {
    const int tid = otid(), w = tid >> 6, lane = tid & 63;
    float* ust = (float*)lds + w * 1024;
    const int wt = u * 4 + w;
    const int d = wt & 1, g = (wt >> 1) & 15, rest = wt >> 5;
    const int cc = rest % NCHUNK, b = rest / NCHUNK;
    const bf16_t* z = (const bf16_t*)(p.ws + WS_Z);
    {
        const int row = s5_chain_row(b, d, cc * 64 + lane);
        s5_load_u(z + (size_t)row * ZS + COL_S5 + g * 16, ust + lane * 16);
    }
    const int tix = ((l * 2 + d) * 16 + g) * 64 + lane;
    const float4 A = *reinterpret_cast<const float4*>((const float*)(p.ws + WS_S5A) + (size_t)tix * 4);
    const float* Bp = (const float*)(p.ws + WS_S5B) + (size_t)tix * 32;
    float br[16], bi[16];
#pragma unroll
    for (int h = 0; h < 16; ++h) { br[h] = Bp[h]; bi[h] = Bp[16 + h]; }
    float xr = 0.f, xi = 0.f;
#pragma unroll 2
    for (int s = 0; s < 64; ++s) {
        float ur = 0.f, ui = 0.f;
#pragma unroll
        for (int h4 = 0; h4 < 4; ++h4) {
            const float4 uu = *reinterpret_cast<const float4*>(ust + s * 16 + h4 * 4);
            ur += br[h4 * 4] * uu.x + br[h4 * 4 + 1] * uu.y + br[h4 * 4 + 2] * uu.z + br[h4 * 4 + 3] * uu.w;
            ui += bi[h4 * 4] * uu.x + bi[h4 * 4 + 1] * uu.y + bi[h4 * 4 + 2] * uu.z + bi[h4 * 4 + 3] * uu.w;
        }
        const float nr = A.x * xr - A.y * xi + ur;
        const float ni = A.x * xi + A.y * xr + ui;
        xr = nr; xi = ni;
    }
    float* st = (float*)(p.ws + WS_S5ST) + ((((size_t)(b * NCHUNK + cc) * 2 + d) * 16 + g) * 64 + lane) * 2;
    st[0] = xr; st[1] = xi;
}

__device__ __forceinline__ float reduce16(const float (&t)[16], int lane) {
    float a[8];
    const bool hi8 = (lane & 8) != 0;
#pragma unroll
    for (int k = 0; k < 8; ++k) { const float keep = hi8 ? t[k + 8] : t[k]; const float send = hi8 ? t[k] : t[k + 8]; a[k] = keep + dppf<0x140>(send); }
    float b[4];
    const bool hi4 = (lane & 4) != 0;
#pragma unroll
    for (int k = 0; k < 4; ++k) { const float keep = hi4 ? a[k + 4] : a[k]; const float send = hi4 ? a[k] : a[k + 4]; b[k] = keep + dppf<0x141>(send); }
    float c[2];
    const bool hi2 = (lane & 2) != 0;
#pragma unroll
    for (int k = 0; k < 2; ++k) { const float keep = hi2 ? b[k + 2] : b[k]; const float send = hi2 ? b[k] : b[k + 2]; c[k] = keep + dppf<0x4E>(send); }
    const bool hi1 = (lane & 1) != 0;
    float r = (hi1 ? c[1] : c[0]) + dppf<0xB1>(hi1 ? c[0] : c[1]);
    r += __shfl_xor(r, 16);
    r += __shfl_xor(r, 32);
    return r;
}

__device__ __forceinline__ void s5_main_unit(const P& p, int l, int u, char* lds) {
    const int tid = otid(), w = tid >> 6, lane = tid & 63;
    float* ust = (float*)lds + w * 2048;
    float* yst = ust + 1024;
    const int b = u / NCHUNK, tc = u % NCHUNK;
    bf16_t* z = (bf16_t*)(p.ws + WS_Z);
    const int myrow = (tc < 4) ? (b * 256 + tc * 64 + lane) : (NTC + b * 4096 + lane * 64 + (tc - 4));
#pragma unroll 1
    for (int gi = 0; gi < 4; ++gi) {
        const int g = w * 4 + gi;
        s5_load_u(z + (size_t)myrow * ZS + COL_S5 + g * 16, ust + lane * 16);
#pragma unroll 1
        for (int d = 0; d < 2; ++d) {
            const int tix = ((l * 2 + d) * 16 + g) * 64 + lane;
            const float4 A = *reinterpret_cast<const float4*>((const float*)(p.ws + WS_S5A) + (size_t)tix * 4);
            const float* Bp = (const float*)(p.ws + WS_S5B) + (size_t)tix * 32;
            float br[16], bi[16], cr[16], ci[16];
#pragma unroll
            for (int h = 0; h < 16; ++h) { br[h] = Bp[h]; bi[h] = Bp[16 + h]; }
            const float* crp = p.in(I_S5_CRE) + (size_t)((l * 2 + d) * 16 + g) * 1024 + lane;
            const float* cip = p.in(I_S5_CIM) + (size_t)((l * 2 + d) * 16 + g) * 1024 + lane;
#pragma unroll
            for (int h = 0; h < 16; ++h) { cr[h] = crp[h * 64]; ci[h] = cip[h * 64]; }
            const int cc = d ? ((tc < 4) ? 3 - tc : 71 - tc) : tc;
            float xr = 0.f, xi = 0.f;
            {
                const float* st = (const float*)(p.ws + WS_S5ST) + ((((size_t)(b * NCHUNK) * 2 + d) * 16 + g) * 64 + lane) * 2;
                for (int c2 = 0; c2 < cc; ++c2) {
                    const float2 sv = *reinterpret_cast<const float2*>(st + (size_t)c2 * (2 * 16 * 64 * 2));
                    const float nr = A.z * xr - A.w * xi + sv.x;
                    const float ni = A.z * xi + A.w * xr + sv.y;
                    xr = nr; xi = ni;
                }
            }
#pragma unroll 1
            for (int s = 0; s < 64; ++s) {
                const int i = d ? 63 - s : s;
                float ur = 0.f, ui = 0.f;
#pragma unroll
                for (int h4 = 0; h4 < 4; ++h4) {
                    const float4 uu = *reinterpret_cast<const float4*>(ust + i * 16 + h4 * 4);
                    ur += br[h4 * 4] * uu.x + br[h4 * 4 + 1] * uu.y + br[h4 * 4 + 2] * uu.z + br[h4 * 4 + 3] * uu.w;
                    ui += bi[h4 * 4] * uu.x + bi[h4 * 4 + 1] * uu.y + bi[h4 * 4 + 2] * uu.z + bi[h4 * 4 + 3] * uu.w;
                }
                const float nr = A.x * xr - A.y * xi + ur;
                const float ni = A.x * xi + A.y * xr + ui;
                xr = nr; xi = ni;
                float t[16];
#pragma unroll
                for (int h = 0; h < 16; ++h) t[h] = cr[h] * xr - ci[h] * xi;
                const float tot = reduce16(t, lane);
                if (lane < 16) { if (d == 0) yst[i * 16 + lane] = tot; else yst[i * 16 + lane] += tot; }
            }
        }
        {
            const float* dsk = p.in(I_S5_D) + l * 256 + g * 16;
            unsigned pk[8];
#pragma unroll
            for (int h = 0; h < 16; h += 2) {
                float y0 = yst[lane * 16 + h] + ust[lane * 16 + h] * dsk[h];
                float y1 = yst[lane * 16 + h + 1] + ust[lane * 16 + h + 1] * dsk[h + 1];
                y0 = 0.5f * y0 * (1.f + erff(y0 * 0.70710678118f));
                y1 = 0.5f * y1 * (1.f + erff(y1 * 0.70710678118f));
                pk[h >> 1] = pack2(y0, y1);
            }
            uint4* dst = reinterpret_cast<uint4*>(z + (size_t)myrow * ZS + COL_S5 + g * 16);
            dst[0] = make_uint4(pk[0], pk[1], pk[2], pk[3]);
            dst[1] = make_uint4(pk[4], pk[5], pk[6], pk[7]);
        }
    }
}

#define SB 16
__device__ __forceinline__ int scan_chain_row(int b, int d, int q) {
    if (q < 256) return b * 256 + (d ? 255 - q : q);
    const int t = q - 256;
    return NTC + b * 4096 + (d ? 4095 - t : t);
}
struct ScanRaw { uint2 r, k, v, e, a; float f0, f1; };

__device__ __forceinline__ void scan_load(const P& p, int m, int b, int h, int d, int q, int cg, ScanRaw& R) {
    const int row = scan_chain_row(b, d, q);
    const int c0 = h * 64 + cg * 4;
    if (m == 0) {
        const bf16_t* z = (const bf16_t*)(p.ws + WS_Z) + (size_t)row * ZS + c0;
        R.r = *reinterpret_cast<const uint2*>(z);
        R.k = *reinterpret_cast<const uint2*>(z + 256);
        R.v = *reinterpret_cast<const uint2*>(z + 512);
        const bf16_t* rw = (const bf16_t*)(p.ws + WS_R1 + R1_RWP) + (size_t)row * 1024 + c0;
        R.e = *reinterpret_cast<const uint2*>(rw + d * 256);
        R.a = *reinterpret_cast<const uint2*>(rw + (2 + d) * 256);
        R.f0 = ((const float*)(p.ws + WS_KNORM))[(size_t)row * 4 + h];
        R.f1 = 0.f;
    } else {
        const bf16_t* gq = (const bf16_t*)(p.ws + WS_R1 + R1_GQ) + (size_t)row * 768 + c0;
        R.r = *reinterpret_cast<const uint2*>(gq);
        R.k = *reinterpret_cast<const uint2*>(gq + 256);
        R.v = *reinterpret_cast<const uint2*>(gq + 512);
        R.e = make_uint2(0u, 0u); R.a = make_uint2(0u, 0u);
        const float* gab = (const float*)(p.ws + WS_GAB) + (size_t)row * 16;
        R.f0 = gab[d * 4 + h];
        R.f1 = gab[8 + d * 4 + h];
    }
}
__device__ __forceinline__ void scan_store(int m, const ScanRaw& R, float* dst  , const float (&kkp)[4], const float (&kap)[4]) {
    float r[4] = {bflo(R.r.x), bfhi(R.r.x), bflo(R.r.y), bfhi(R.r.y)};
    float k[4] = {bflo(R.k.x), bfhi(R.k.x), bflo(R.k.y), bfhi(R.k.y)};
    float v[4] = {bflo(R.v.x), bfhi(R.v.x), bflo(R.v.y), bfhi(R.v.y)};
    float ww[4], aa[4], bb[4], kk[4];
    if (m == 0) {
        float e[4] = {bflo(R.e.x), bfhi(R.e.x), bflo(R.e.y), bfhi(R.e.y)};
        float a[4] = {bflo(R.a.x), bfhi(R.a.x), bflo(R.a.y), bfhi(R.a.y)};
#pragma unroll
        for (int i = 0; i < 4; ++i) {
            ww[i] = __expf(-e[i]);
            kk[i] = k[i] * (1.f + (a[i] - 1.f) * kap[i]);
            const float kn = k[i] * kkp[i] * R.f0;
            aa[i] = -kn;
            bb[i] = kn * a[i];
        }
    } else {
        const float al = R.f0, be = R.f1;
#pragma unroll
        for (int i = 0; i < 4; ++i) { ww[i] = al; aa[i] = k[i]; bb[i] = -al * be * k[i]; kk[i] = be * k[i]; }
    }
    *reinterpret_cast<float4*>(dst + 0 * 64) = make_float4(ww[0], ww[1], ww[2], ww[3]);
    *reinterpret_cast<float4*>(dst + 1 * 64) = make_float4(aa[0], aa[1], aa[2], aa[3]);
    *reinterpret_cast<float4*>(dst + 2 * 64) = make_float4(bb[0], bb[1], bb[2], bb[3]);
    *reinterpret_cast<float4*>(dst + 3 * 64) = make_float4(kk[0], kk[1], kk[2], kk[3]);
    *reinterpret_cast<float4*>(dst + 4 * 64) = make_float4(r[0], r[1], r[2], r[3]);
    *reinterpret_cast<float4*>(dst + 5 * 64) = make_float4(v[0], v[1], v[2], v[3]);
}

__device__ __forceinline__ void scan_unit(const P& p, int l, int u, char* lds) {
    const int tid = otid();
    const int chain = u >> 1, half = u & 1;
    const int m = chain >> 6, rem = chain & 63, b = rem >> 3, h = (rem >> 1) & 3, d = rem & 1;
    float* buf = (float*)lds;
    float* ybuf = buf + 2 * SB * 384;
    const int rp = tid >> 4, sub = tid & 15;
    const int st = tid >> 4, cg = tid & 15;
    float kkp[4], kap[4];
#pragma unroll
    for (int i = 0; i < 4; ++i) { kkp[i] = p.in(I_RW_KK)[l * 256 + h * 64 + cg * 4 + i]; kap[i] = p.in(I_RW_KA)[l * 256 + h * 64 + cg * 4 + i]; }
    bf16_t* ys = (bf16_t*)(p.ws + WS_HBY) + (size_t)(m * 2 + d) * NT * 256;
    float SA[4] = {0.f, 0.f, 0.f, 0.f}, SBv[4] = {0.f, 0.f, 0.f, 0.f};
    ScanRaw R, R2;
    scan_load(p, m, b, h, d, st, cg, R);
    scan_store(m, R, buf + (st * 6) * 64 + cg * 4, kkp, kap);
    scan_load(p, m, b, h, d, SB + st, cg, R);
    __syncthreads();
    const int NB = 4352 / SB;
    __builtin_amdgcn_s_setprio(2);
#pragma unroll 1
    for (int bt = 0; bt < NB; ++bt) {
        const int par = bt & 1;
        if (bt + 2 < NB) scan_load(p, m, b, h, d, (bt + 2) * SB + st, cg, R2);
        const float* cb = buf + par * (SB * 384);
        float* yb = ybuf + par * (SB * 32);
        {
            const float* sb0 = cb + sub * 4;
            const float* vb0 = cb + 320 + half * 32 + rp;
            float4 nw = *reinterpret_cast<const float4*>(sb0), na = *reinterpret_cast<const float4*>(sb0 + 64), nb = *reinterpret_cast<const float4*>(sb0 + 128);
            float4 nk = *reinterpret_cast<const float4*>(sb0 + 192), nr = *reinterpret_cast<const float4*>(sb0 + 256);
            float nvA = vb0[0], nvB = vb0[16];
#pragma unroll
            for (int s = 0; s < SB; ++s) {
                const float4 w = nw, a = na, bq = nb, k = nk, r = nr;
                const float vA = nvA, vB = nvB;
                if (s + 1 < SB) {
                    const float* sb = sb0 + (s + 1) * 384;
                    nw = *reinterpret_cast<const float4*>(sb); na = *reinterpret_cast<const float4*>(sb + 64); nb = *reinterpret_cast<const float4*>(sb + 128);
                    nk = *reinterpret_cast<const float4*>(sb + 192); nr = *reinterpret_cast<const float4*>(sb + 256);
                    nvA = vb0[(s + 1) * 384]; nvB = vb0[(s + 1) * 384 + 16];
                }
                __builtin_amdgcn_sched_barrier(0);
                float sa = (SA[0] * a.x + SA[1] * a.y) + (SA[2] * a.z + SA[3] * a.w);
                float sb2 = (SBv[0] * a.x + SBv[1] * a.y) + (SBv[2] * a.z + SBv[3] * a.w);
                sa += dppf<0xB1>(sa); sb2 += dppf<0xB1>(sb2);
                sa += dppf<0x4E>(sa); sb2 += dppf<0x4E>(sb2);
                sa += dppf<0x141>(sa); sb2 += dppf<0x141>(sb2);
                sa += dppf<0x140>(sa); sb2 += dppf<0x140>(sb2);
                SA[0] = SA[0] * w.x + sa * bq.x + vA * k.x;  SBv[0] = SBv[0] * w.x + sb2 * bq.x + vB * k.x;
                SA[1] = SA[1] * w.y + sa * bq.y + vA * k.y;  SBv[1] = SBv[1] * w.y + sb2 * bq.y + vB * k.y;
                SA[2] = SA[2] * w.z + sa * bq.z + vA * k.z;  SBv[2] = SBv[2] * w.z + sb2 * bq.z + vB * k.z;
                SA[3] = SA[3] * w.w + sa * bq.w + vA * k.w;  SBv[3] = SBv[3] * w.w + sb2 * bq.w + vB * k.w;
                float yA = (SA[0] * r.x + SA[1] * r.y) + (SA[2] * r.z + SA[3] * r.w);
                float yB = (SBv[0] * r.x + SBv[1] * r.y) + (SBv[2] * r.z + SBv[3] * r.w);
                yA += dppf<0xB1>(yA); yB += dppf<0xB1>(yB);
                yA += dppf<0x4E>(yA); yB += dppf<0x4E>(yB);
                yA += dppf<0x141>(yA); yB += dppf<0x141>(yB);
                yA += dppf<0x140>(yA); yB += dppf<0x140>(yB);
                yb[s * 32 + rp] = yA; yb[s * 32 + 16 + rp] = yB;
            }
        }
        if (bt + 1 < NB) scan_store(m, R, buf + (1 - par) * (SB * 384) + (st * 6) * 64 + cg * 4, kkp, kap);
        R = R2;
        __syncthreads();
        {
            const int r2 = cg * 2;
            const int row = scan_chain_row(b, d, bt * SB + st);
            const unsigned pk = pack2(yb[st * 32 + r2], yb[st * 32 + r2 + 1]);
            *reinterpret_cast<unsigned*>(ys + (size_t)row * 256 + h * 64 + half * 32 + r2) = pk;
        }
    }
    __builtin_amdgcn_s_setprio(0);
    __syncthreads();
}

template <int L>
__device__ __forceinline__ void hyena_unit(const P& p, int l, int u, char* lds) {
    constexpr int TPT = L / 256;
    const int tid = otid();
    const int c = u >> 2, bp = u & 3;
    float2* u2 = (float2*)lds;
    float* taps = (float*)(lds + (size_t)L * 8);
    const bf16_t* z = (const bf16_t*)(p.ws + WS_Z);
    bf16_t* cat = (bf16_t*)(p.ws + WS_CAT);
    const float* F = (L == 4096) ? (const float*)(p.ws + WS_FILTL) : (const float*)(p.ws + WS_FILTC);
    int base[2];
#pragma unroll
    for (int bb = 0; bb < 2; ++bb) { const int b = bp * 2 + bb; base[bb] = (L == 4096) ? NTC + b * 4096 : b * 256; }
    const int t0 = tid * TPT;
    const float* cw = p.in(I_HY_CONV) + (size_t)l * 3 * 768; const float* cb = p.in(I_HY_CONVB) + (size_t)l * 768;
    auto sconv = [&](int part, int bb, float (&o)[TPT]) {
        const int ch = part * 256 + c;
        const float w0 = cw[ch], w1 = cw[768 + ch], w2 = cw[1536 + ch], bs = cb[ch];
        const bf16_t* zc = z + (size_t)base[bb] * ZS + COL_HY + ch;
        float xm = (t0 > 0) ? bf2f(zc[(size_t)(t0 - 1) * ZS]) : 0.f;
        float x0 = bf2f(zc[(size_t)t0 * ZS]);
#pragma unroll
        for (int i = 0; i < TPT; ++i) {
            const int t = t0 + i;
            const float xp = (t + 1 < L) ? bf2f(zc[(size_t)(t + 1) * ZS]) : 0.f;
            o[i] = w0 * xm + w1 * x0 + w2 * xp + bs;
            xm = x0; x0 = xp;
        }
    };
    {
        float v0[TPT], v1[TPT];
        sconv(2, 0, v0); sconv(2, 1, v1);
#pragma unroll
        for (int i = 0; i < TPT; ++i) u2[t0 + i] = make_float2(v0[i], v1[i]);
    }
#pragma unroll 1
    for (int o = 0; o < 2; ++o) {
        const float* hf = F + ((size_t)(o * 2 + 0) * 256 + c) * L;
        const float* hbk = F + ((size_t)(o * 2 + 1) * 256 + c) * L;
        for (int k = tid; k < 2 * L; k += NTHREADS) {
            const int dd = k - (L - 1);
            taps[k] = (dd >= L) ? 0.f : (dd >= 0 ? hf[dd] : hbk[-dd]);
        }
        __syncthreads();
        float acc[TPT][2];
#pragma unroll
        for (int i = 0; i < TPT; ++i) { acc[i][0] = 0.f; acc[i][1] = 0.f; }
        if (L == 4096) {
#pragma unroll 1
            for (int s0 = 0; s0 < L; s0 += 16) {
                const int k0 = t0 - s0 + (L - 16);
                float W[32];
#pragma unroll
                for (int q = 0; q < 8; ++q) {
                    const float4 t4 = *reinterpret_cast<const float4*>(taps + k0 + q * 4);
                    W[q * 4] = t4.x; W[q * 4 + 1] = t4.y; W[q * 4 + 2] = t4.z; W[q * 4 + 3] = t4.w;
                }
#pragma unroll
                for (int j = 0; j < 16; ++j) {
                    const float2 uj = u2[s0 + j];
#pragma unroll
                    for (int i = 0; i < TPT; ++i) {
                        const float wv = W[(i - j + 15) & 31];
                        acc[i][0] += wv * uj.x; acc[i][1] += wv * uj.y;
                    }
                }
            }
        } else {
            for (int s = 0; s < L; ++s) {
                const float2 uj = u2[s];
                const float wv = taps[t0 - s + (L - 1)];
                acc[0][0] += wv * uj.x; acc[0][1] += wv * uj.y;
            }
        }
        const float sk = p.in(I_HY_SKIP)[(size_t)(l * 2 + o) * 256 + c];
        float res[TPT][2];
        {
            float g0[TPT], g1[TPT];
            sconv(o, 0, g0); sconv(o, 1, g1);
#pragma unroll
            for (int i = 0; i < TPT; ++i) {
                const float2 ut = u2[t0 + i];
                res[i][0] = g0[i] * (acc[i][0] + sk * ut.x);
                res[i][1] = g1[i] * (acc[i][1] + sk * ut.y);
            }
        }
        __syncthreads();
        if (o == 0) {
#pragma unroll
            for (int i = 0; i < TPT; ++i) u2[t0 + i] = make_float2(res[i][0], res[i][1]);
        } else {
#pragma unroll
            for (int i = 0; i < TPT; ++i) {
                cat[(size_t)(base[0] + t0 + i) * DM + 512 + c] = f2bf(res[i][0]);
                cat[(size_t)(base[1] + t0 + i) * DM + 512 + c] = f2bf(res[i][1]);
            }
        }
        __syncthreads();
    }
}


#define FFT_BS 272
__device__ __forceinline__ int fphys(int d2, int d1, int d0) { return d2 * FFT_BS + d1 * 17 + d0; }
__device__ __forceinline__ float2 cmulf(float2 a, float2 b) { return make_float2(a.x * b.x - a.y * b.y, a.x * b.y + a.y * b.x); }
__device__ static constexpr float C32T[16] = {1.000000000e+00f, 9.807852804e-01f, 9.238795325e-01f, 8.314696123e-01f, 7.071067812e-01f, 5.555702330e-01f, 3.826834324e-01f, 1.950903220e-01f, 6.123233996e-17f, -1.950903220e-01f, -3.826834324e-01f, -5.555702330e-01f, -7.071067812e-01f, -8.314696123e-01f, -9.238795325e-01f, -9.807852804e-01f};
__device__ static constexpr float S32T[16] = {0.000000000e+00f, 1.950903220e-01f, 3.826834324e-01f, 5.555702330e-01f, 7.071067812e-01f, 8.314696123e-01f, 9.238795325e-01f, 9.807852804e-01f, 1.000000000e+00f, 9.807852804e-01f, 9.238795325e-01f, 8.314696123e-01f, 7.071067812e-01f, 5.555702330e-01f, 3.826834324e-01f, 1.950903220e-01f};
template <int LOG> __device__ __forceinline__ constexpr int brev(int i) { int r = 0; for (int b = 0; b < LOG; ++b) r |= ((i >> b) & 1) << (LOG - 1 - b); return r; }
template <int R, bool INV> __device__ __forceinline__ void dftR(float2 (&v)[R]) {
    constexpr int LOG = (R == 32) ? 5 : 4;
    float2 t[R];
#pragma unroll
    for (int i = 0; i < R; ++i) t[brev<LOG>(i)] = v[i];
#pragma unroll
    for (int st = 1; st <= LOG; ++st) {
        const int len = 1 << st, half = len >> 1;
#pragma unroll
        for (int i = 0; i < R; i += len)
#pragma unroll
            for (int j = 0; j < half; ++j) {
                const int tw = j * (32 / len);
                const float2 a = t[i + j], b = t[i + j + half];
                float2 bw;
                if (tw == 0) bw = b;
                else if (tw == 8) bw = INV ? make_float2(-b.y, b.x) : make_float2(b.y, -b.x);
                else { const float wr = C32T[tw], wi = INV ? S32T[tw] : -S32T[tw]; bw = make_float2(b.x * wr - b.y * wi, b.x * wi + b.y * wr); }
                t[i + j] = make_float2(a.x + bw.x, a.y + bw.y);
                t[i + j + half] = make_float2(a.x - bw.x, a.y - bw.y);
            }
    }
#pragma unroll
    for (int i = 0; i < R; ++i) v[i] = t[i];
}
template <int R> __device__ __forceinline__ void twiddle_pow(float2 (&v)[R], float2 first, float2 base) {
    float2 w = first;
#pragma unroll
    for (int k = 0; k < R; ++k) { v[k] = cmulf(v[k], w); w = cmulf(w, base); }
}
__device__ __forceinline__ float2 cispi(float x) { float sn, cs; sincospif(x, &sn, &cs); return make_float2(cs, sn); }

__device__ __forceinline__ void fft_fwd_A_B1(float2 (&v)[32], float2* buf, int tid_in) {
    int tid = tid_in; asm volatile("" : "+v"(tid));
    const int a = tid >> 4, b = tid & 15;
    dftR<32, false>(v);
    twiddle_pow<32>(v, make_float2(1.f, 0.f), cispi(-2.f * (float)tid * (1.f / 8192.f)));
#pragma unroll
    for (int k1 = 0; k1 < 32; ++k1) buf[fphys(k1, a, b)] = v[k1];
    __syncthreads();
#pragma unroll 1
    for (int j = 0; j < 2; ++j) {
        const int g = tid + 256 * j, k1 = g >> 4, bb = g & 15;
        float2 w[16];
#pragma unroll
        for (int aa = 0; aa < 16; ++aa) w[aa] = buf[fphys(k1, aa, bb)];
        dftR<16, false>(w);
        twiddle_pow<16>(w, make_float2(1.f, 0.f), cispi(-2.f * (float)bb * (1.f / 256.f)));
#pragma unroll
        for (int ka = 0; ka < 16; ++ka) buf[fphys(k1, ka, bb)] = w[ka];
    }
    __syncthreads();
}
__device__ __forceinline__ void fft_inv_B1_A(float2 (&v)[32], float2* buf, int tid_in) {
    int tid = tid_in; asm volatile("" : "+v"(tid));
#pragma unroll 1
    for (int j = 0; j < 2; ++j) {
        const int g = tid + 256 * j, k1 = g >> 4, bb = g & 15;
        float2 w[16];
#pragma unroll
        for (int ka = 0; ka < 16; ++ka) w[ka] = buf[fphys(k1, ka, bb)];
        dftR<16, true>(w);
        twiddle_pow<16>(w, cispi(2.f * (float)(k1 * bb) * (1.f / 8192.f)), cispi(2.f * (float)k1 * (1.f / 512.f)));
#pragma unroll
        for (int aa = 0; aa < 16; ++aa) buf[fphys(k1, aa, bb)] = w[aa];
    }
    __syncthreads();
    const int a = tid >> 4, b = tid & 15;
#pragma unroll
    for (int k1 = 0; k1 < 32; ++k1) v[k1] = buf[fphys(k1, a, b)];
    dftR<32, true>(v);
}

__device__ __forceinline__ void hfft_unit(const P& p, int l, int u, char* lds) {
    const int tid = otid();
    float2* buf = (float2*)lds;
    float* F = (float*)(p.ws + WS_FILTL) + (size_t)u * 8192;
    float2 v[32];
#pragma unroll
    for (int n1 = 0; n1 < 32; ++n1) {
        const int n = 256 * n1 + tid;
        float x;
        if (n1 < 16) x = F[n];
        else x = (n == 4096) ? 0.f : F[4096 + (8192 - n)];
        if (n == 0) x += p.in(I_HY_SKIP)[(size_t)l * 512 + u];
        v[n1] = make_float2(x, 0.f);
    }
    fft_fwd_A_B1(v, buf, tid);
    __half2* H = (__half2*)F;
#pragma unroll 1
    for (int j = 0; j < 2; ++j) {
        const int g = tid + 256 * j, k1 = g >> 4, ka = g & 15;
        float2 w[16];
#pragma unroll
        for (int bb = 0; bb < 16; ++bb) w[bb] = buf[fphys(k1, ka, bb)];
        dftR<16, false>(w);
        unsigned pk[16];
#pragma unroll
        for (int kb = 0; kb < 16; ++kb) { const __half2 h = __floats2half2_rn(w[kb].x, w[kb].y); pk[kb] = *reinterpret_cast<const unsigned*>(&h); }
        uint4* dst = reinterpret_cast<uint4*>(H + (size_t)g * 16);
        dst[0] = make_uint4(pk[0], pk[1], pk[2], pk[3]); dst[1] = make_uint4(pk[4], pk[5], pk[6], pk[7]);
        dst[2] = make_uint4(pk[8], pk[9], pk[10], pk[11]); dst[3] = make_uint4(pk[12], pk[13], pk[14], pk[15]);
    }
    __syncthreads();
}

__device__ __forceinline__ void hyena_prep_unit(const P& p, int l, int u, char* lds) {
    const int tid = otid();
    bf16_t* tile = (bf16_t*)lds;
    const int b = u >> 6, t0 = (u & 63) * 64;
    const bf16_t* z = (const bf16_t*)(p.ws + WS_Z) + (size_t)(NTC + b * 4096) * ZS + COL_HY;
    bf16_t* hyT = (bf16_t*)(p.ws + WS_HYT);
    const float* cw = p.in(I_HY_CONV) + (size_t)l * 3 * 768; const float* cb = p.in(I_HY_CONVB) + (size_t)l * 768;
#pragma unroll 1
    for (int part = 0; part < 3; ++part) {
        const int ch = part * 256 + tid;
        const float w0 = cw[ch], w1 = cw[768 + ch], w2 = cw[1536 + ch], bs = cb[ch];
        const bf16_t* zc = z + ch;
        float xm = (t0 > 0) ? bf2f(zc[(size_t)(t0 - 1) * ZS]) : 0.f;
        float x0 = bf2f(zc[(size_t)t0 * ZS]);
#pragma unroll 8
        for (int i = 0; i < 64; ++i) {
            const int t = t0 + i;
            const float xp = (t + 1 < 4096) ? bf2f(zc[(size_t)(t + 1) * ZS]) : 0.f;
            tile[tid * 72 + i] = f2bf(w0 * xm + w1 * x0 + w2 * xp + bs);
            xm = x0; x0 = xp;
        }
        __syncthreads();
#pragma unroll
        for (int k = 0; k < 8; ++k) {
            const int chl = (tid >> 3) + 32 * k, seg = tid & 7;
            const uint4 val = *reinterpret_cast<const uint4*>(tile + chl * 72 + seg * 8);
            *reinterpret_cast<uint4*>(hyT + ((size_t)(b * 3 + part) * 256 + chl) * 4096 + t0 + seg * 8) = val;
        }
        __syncthreads();
    }
}

template <int O>
__device__ __forceinline__ void hyena_conv_pass(const P& p, int c, int bp, int tid, float2 (&v)[32], float2* buf) {
    const bf16_t* hyT = (const bf16_t*)(p.ws + WS_HYT);
#pragma unroll
    for (int j = 16; j < 32; ++j) v[j] = make_float2(0.f, 0.f);
    fft_fwd_A_B1(v, buf, tid);
    const __half2* H = (const __half2*)((const float*)(p.ws + WS_FILTL) + (size_t)(O * 256 + c) * 8192);
    int tm = tid; asm volatile("" : "+v"(tm));
#pragma unroll 1
    for (int j = 0; j < 2; ++j) {
        const int g = tm + 256 * j, k1 = g >> 4, ka = g & 15;
        float2 w[16];
#pragma unroll
        for (int bb = 0; bb < 16; ++bb) w[bb] = buf[fphys(k1, ka, bb)];
        dftR<16, false>(w);
        const uint4* hp = reinterpret_cast<const uint4*>(H + (size_t)g * 16);
        unsigned hk[16];
#pragma unroll
        for (int q = 0; q < 4; ++q) { const uint4 t4 = hp[q]; hk[q * 4] = t4.x; hk[q * 4 + 1] = t4.y; hk[q * 4 + 2] = t4.z; hk[q * 4 + 3] = t4.w; }
#pragma unroll
        for (int kb = 0; kb < 16; ++kb) { const float2 hf = __half22float2(*reinterpret_cast<const __half2*>(&hk[kb])); w[kb] = cmulf(w[kb], hf); }
        dftR<16, true>(w);
        twiddle_pow<16>(w, make_float2(1.f, 0.f), cispi(2.f * (float)ka * (1.f / 256.f)));
#pragma unroll
        for (int bb = 0; bb < 16; ++bb) buf[fphys(k1, ka, bb)] = w[bb];
    }
    __syncthreads();
    fft_inv_B1_A(v, buf, tid);
    asm volatile("" ::: "memory");
    int tq = tid; asm volatile("" : "+v"(tq));
    const bf16_t* g0 = hyT + ((size_t)((bp * 2 + 0) * 3 + O) * 256 + c) * 4096 + tq;
    const bf16_t* g1 = hyT + ((size_t)((bp * 2 + 1) * 3 + O) * 256 + c) * 4096 + tq;
    const float sc = 1.f / 8192.f;
#pragma unroll
    for (int j = 0; j < 16; ++j) {
        const float ga = bf2f(g0[256 * j]) * sc, gb = bf2f(g1[256 * j]) * sc;
        v[j] = make_float2(ga * v[j].x, gb * v[j].y);
    }
    __syncthreads();
}

__device__ __forceinline__ void hyena_fft_unit(const P& p, int l, int u, char* lds) {
    const int tid = otid();
    const int c = u >> 2, bp = u & 3;
    float2* buf = (float2*)lds;
    const bf16_t* hyT = (const bf16_t*)(p.ws + WS_HYT);
    bf16_t* cat = (bf16_t*)(p.ws + WS_CAT);
    float2 v[32];
    {
        const bf16_t* v0p = hyT + ((size_t)((bp * 2 + 0) * 3 + 2) * 256 + c) * 4096 + tid;
        const bf16_t* v1p = hyT + ((size_t)((bp * 2 + 1) * 3 + 2) * 256 + c) * 4096 + tid;
#pragma unroll
        for (int j = 0; j < 16; ++j) v[j] = make_float2(bf2f(v0p[256 * j]), bf2f(v1p[256 * j]));
    }
    hyena_conv_pass<0>(p, c, bp, tid, v, buf);
    hyena_conv_pass<1>(p, c, bp, tid, v, buf);
    int tq = tid; asm volatile("" : "+v"(tq));
#pragma unroll
    for (int j = 0; j < 16; ++j) {
        const int t = tq + 256 * j;
        cat[(size_t)(NTC + (bp * 2 + 0) * 4096 + t) * DM + 512 + c] = f2bf(v[j].x);
        cat[(size_t)(NTC + (bp * 2 + 1) * 4096 + t) * DM + 512 + c] = f2bf(v[j].y);
    }
}

__device__ __forceinline__ void rwkv_post_unit(const P& p, int l, int u, char* lds) {
    const int tid = otid(), c = tid;
    float* sg = (float*)lds;
    const bf16_t* z = (const bf16_t*)(p.ws + WS_Z);
    const bf16_t* rwp = (const bf16_t*)(p.ws + WS_R1 + R1_RWP);
    const bf16_t* ys = (const bf16_t*)(p.ws + WS_HBY);
    bf16_t* cat = (bf16_t*)(p.ws + WS_CAT);
    const int row0 = u * 32;
#pragma unroll
    for (int i = 0; i < 8; ++i) {
        const int idx = tid + 256 * i, tok = idx >> 6, j = idx & 63;
        sg[idx] = sigm(bf2f(z[(size_t)(row0 + tok) * ZS + 896 + j]));
    }
    __syncthreads();
    float g2r[64];
#pragma unroll
    for (int r = 0; r < 64; ++r) g2r[r] = p.in(I_RW_G2)[(size_t)(l * 64 + r) * 256 + c];
    const float ka = p.in(I_RW_KA)[l * 256 + c], rk = p.in(I_RW_RK)[l * 256 + c];
    const float gng = p.in(I_RW_GNG)[l * 256 + c], gnb = p.in(I_RW_GNB)[l * 256 + c];
#pragma unroll 2
    for (int tok = 0; tok < 32; ++tok) {
        const int row = row0 + tok;
        float g = 0.f;
#pragma unroll
        for (int r = 0; r < 64; r += 4) {
            const float4 x = *reinterpret_cast<const float4*>(sg + tok * 64 + r);
            g += x.x * g2r[r] + x.y * g2r[r + 1] + x.z * g2r[r + 2] + x.w * g2r[r + 3];
        }
        const float y = bf2f(ys[(size_t)row * 256 + c]) + bf2f(ys[(size_t)NT * 256 + (size_t)row * 256 + c]);
        const float mu = wave_sum(y) * (1.f / 64.f);
        const float dv = y - mu;
        const float var = wave_sum(dv * dv) * (1.f / 64.f);
        const float yn = dv * rsqrtf(var + 64e-5f) * gng + gnb;
        const bf16_t* zr = z + (size_t)row * ZS;
        const float r = bf2f(zr[c]), k = bf2f(zr[256 + c]), v = bf2f(zr[512 + c]);
        const float a0 = bf2f(rwp[((size_t)row * 4 + 2) * 256 + c]), a1 = bf2f(rwp[((size_t)row * 4 + 3) * 256 + c]);
        const float kd = k * (1.f + (a0 - 1.f) * ka) + k * (1.f + (a1 - 1.f) * ka);
        const float dot = wave_sum(r * kd * rk);
        cat[(size_t)row * DM + c] = f2bf((yn + dot * v) * g);
    }
    __syncthreads();
}

__device__ __forceinline__ void gdn_post_unit(const P& p, int l, int u) {
    const int tid = otid(), c = tid;
    const bf16_t* z = (const bf16_t*)(p.ws + WS_Z);
    const bf16_t* ys = (const bf16_t*)(p.ws + WS_HBY) + (size_t)2 * NT * 256;
    bf16_t* cat = (bf16_t*)(p.ws + WS_CAT);
    const float ng = p.in(I_GD_NORM)[l * 64 + (c & 63)];
    const int row0 = u * 32;
#pragma unroll 4
    for (int tok = 0; tok < 32; ++tok) {
        const int row = row0 + tok;
        const float o = bf2f(ys[(size_t)row * 256 + c]) + bf2f(ys[(size_t)NT * 256 + (size_t)row * 256 + c]);
        const float ms = wave_sum(o * o) * (1.f / 64.f);
        const float zg = bf2f(z[(size_t)row * ZS + COL_GD + 768 + c]);
        cat[(size_t)row * DM + 256 + c] = f2bf(o * rsqrtf(ms + 1e-6f) * ng * siluf(zg));
    }
}


__device__ __forceinline__ void load_tile_bases(unsigned* ctl, int l, int* tb) {
    const int tid = otid();
    __syncthreads();
    if (tid < 64) tb[66 + tid] = ((int)xb_ld(&ctl[CW_CNT(l) + tid]) + 127) >> 7;
    __syncthreads();
    if (tid == 0) { int a = 0; for (int e = 0; e < 64; ++e) { tb[e] = a; a += tb[66 + e]; } tb[64] = a; }
    __syncthreads();
}

#define NPHASE 36
template <typename F>
__device__ __forceinline__ void strided(int n, F f) { for (int u = blockIdx.x; u < n; u += gridDim.x) f(u); }

__global__ void __launch_bounds__(NTHREADS, 2) fwd_kernel(KP kp) {
    extern __shared__ __attribute__((aligned(16))) char smem[];
    char* lds = smem + LDS_USER;
    {
    const int tid = otid();
    if (tid == 0) *reinterpret_cast<uint4*>(smem) = make_uint4(0u, 0u, 0u, 0u);
    if (tid < 52) { const unsigned long long v = (unsigned long long)kp.in[tid]; ((unsigned*)(smem + 512))[2 * tid] = (unsigned)v; ((unsigned*)(smem + 512))[2 * tid + 1] = (unsigned)(v >> 32); }
    }
    __syncthreads();
    P p; p.tab = (const __attribute__((address_space(3))) unsigned*)(smem + 512); p.out = kp.out; p.ws = kp.ws;
    unsigned* ctl = (unsigned*)(p.ws + WS_CTL);
    XcdBarrier bar = xcd_barrier_post(ctl, (volatile LAS unsigned*)smem);
    const int lo = kp.ph_lo, hi = kp.ph_hi;
#define PHASE_BEGIN(ph) if ((ph) >= lo && (ph) < hi) { if ((ph) > lo) { xcd_barrier(bar); }
#define PHASE_END }
#define LANE_IDS const int tid = otid(); const int wid = tid >> 6, lane = tid & 63, wr = wid >> 1, wc = wid & 1, fr = lane & 15, fq = lane >> 4; (void)wid; (void)lane; (void)wr; (void)wc; (void)fr; (void)fq;

    PHASE_BEGIN(0)
        strided(192 + 64 + 32, [&](int u) {
            if (u < 192) ph0_mod_unit(p, u, lds);
            else if (u < 256) ph0_s5tab_unit(p, u - 192);
            else { const int v = u - 256, ll = v >> 4, t = v & 15;
                   xpose_tile(p.in(I_S5_GLUW) + (size_t)ll * 65536, 256, (bf16_t*)(p.ws + WS_GLUT) + (size_t)ll * 65536, 256, 0, t >> 2, t & 3, lds); }
        });
    PHASE_END

#pragma unroll 1
    for (int l = 0; l < 2; ++l) {
        const int pb = 1 + 17 * l;
        PHASE_BEGIN(pb + 0)
            strided(4352 + 1088 + 768 + 256, [&](int u) {
                if (u < 4352) { if (l == 0) rows_unit<M_INIT>(p, l, u, lds); else rows_unit<M_LN2NEXT>(p, l, u, lds); }
                else if (u < 5440) filt_unit(p, l, u - 4352, lds);
                else if (u < 6208) { const int v = u - 5440; xpose_tile(p.in(I_WIN) + (size_t)l * 1024 * 3024, 3024, (bf16_t*)(p.ws + WS_WINT), 1024, 0, v / 48, v % 48, lds); }
                else { const int v = u - 6208; xpose_tile(p.in(I_WOUT) + (size_t)l * 1024 * 1024, 1024, (bf16_t*)(p.ws + WS_WOUTT), 1024, 0, v >> 4, v & 15, lds); }
            });
        PHASE_END
        PHASE_BEGIN(pb + 1)
            strided(272 * 24, [&](int u) {
                LANE_IDS
                const int mt = u / 24, nt = u % 24;
                f32x4 acc[4][4];
                gemm_tile((const bf16_t*)(p.ws + WS_HBY), DM, arows_lin(mt * 128, tid),
                          (const bf16_t*)(p.ws + WS_WINT), DM, nt * 128, DM, lds, acc);
                bf16_t* z = (bf16_t*)(p.ws + WS_Z);
#pragma unroll
                for (int m = 0; m < 4; ++m)
#pragma unroll
                    for (int n = 0; n < 4; ++n) {
                        const int col = nt * 128 + wc * 64 + n * 16 + fr;
                        if (col < ZS) {
#pragma unroll
                            for (int j = 0; j < 4; ++j) z[(size_t)(mt * 128 + wr * 64 + m * 16 + fq * 4 + j) * ZS + col] = f2bf(acc[m][n][j]);
                        }
                    }
            });
        PHASE_END
        PHASE_BEGIN(pb + 2)
            strided(512 + 512 + 1088 + 1088 + 4352, [&](int u) {
                if (u < 512) { if (kp.rep == 0) hfft_unit(p, l, u, lds); }
                else if (u < 1024) hyena_prep_unit(p, l, u - 512, lds);
                else if (u < 2112) rwkv_prep_unit(p, l, u - 1024, lds);
                else if (u < 3200) gdn_prep_unit(p, l, u - 2112);
                else s5_pre_unit(p, l, u - 3200, lds);
            });
        PHASE_END
        PHASE_BEGIN(pb + 3)
            {
                int* qslot = (int*)(smem + 64);
                const int NO = 1024 + 544 + 1024;
                if (otid() == 0) {
                    const unsigned hw = (unsigned)__builtin_amdgcn_s_getreg((7 << 11) | (8 << 6) | 4);
                    const unsigned cuix = ((xb_xcc_id() & 15u) << 8) | (hw & 255u);
                    qslot[1] = (atomicAdd(&ctl[CW_CUCNT(l) + cuix], 1u) == 0u) ? 0 : 1;
                }
                __syncthreads();
                for (;;) {
                    if (otid() == 0) {
                        int stage = qslot[1], t = -1;
                        while (t < 0 && stage < 3) {
                            if (stage == 1) { const int q = (int)atomicAdd(&ctl[CW_QUEUE(l) + 16], 1u); if (q < NO) t = 256 + q; else stage = 2; }
                            else { const int q = (int)atomicAdd(&ctl[CW_QUEUE(l)], 1u); if (q < 256) t = q; else stage = (stage == 0) ? 1 : 3; }
                        }
                        qslot[1] = stage; qslot[0] = t;
                    }
                    __syncthreads();
                    const int u = qslot[0];
                    __syncthreads();
                    if (u < 0) break;
                    if (u < 256) scan_unit(p, l, u, lds);
                    else if (u < 1280) hyena_fft_unit(p, l, u - 256, lds);
                    else if (u < 1824) s5_main_unit(p, l, u - 1280, lds);
                    else hyena_unit<256>(p, l, u - 1824, lds);
                    __syncthreads();
                }
            }
        PHASE_END
        PHASE_BEGIN(pb + 4)
            strided(1088 + 1088 + 544, [&](int u) {
                if (u < 1088) rwkv_post_unit(p, l, u, lds);
                else if (u < 2176) gdn_post_unit(p, l, u - 1088);
                else {
                    LANE_IDS
                    const int v = u - 2176, mt = v >> 1, nt = v & 1;
                    f32x4 acc[4][4];
                    const bf16_t* A = (const bf16_t*)(p.ws + WS_Z) + COL_S5;
                    gemm_tile(A, ZS, arows_lin(mt * 128, tid),
                              (const bf16_t*)(p.ws + WS_GLUT) + (size_t)l * 65536, 256, nt * 128, 256, lds, acc);
                    bf16_t* cat = (bf16_t*)(p.ws + WS_CAT);
#pragma unroll
                    for (int m = 0; m < 4; ++m)
#pragma unroll
                        for (int n = 0; n < 4; ++n) {
                            const int col = nt * 128 + wc * 64 + n * 16 + fr;
                            const float gb = p.in(I_S5_GLUB)[l * 256 + col];
#pragma unroll
                            for (int j = 0; j < 4; ++j) {
                                const int row = mt * 128 + wr * 64 + m * 16 + fq * 4 + j;
                                const float yg = bf2f(A[(size_t)row * ZS + col]);
                                cat[(size_t)row * DM + 768 + col] = f2bf(yg * sigm(acc[m][n][j] + gb));
                            }
                        }
                }
            });
        PHASE_END
        PHASE_BEGIN(pb + 5)
            strided(272 * 8 + 65 * 192, [&](int u) {
                if (u < 2176) {
                    LANE_IDS
                    const int mt = u >> 3, nt = u & 7;
                    f32x4 acc[4][4];
                    gemm_tile((const bf16_t*)(p.ws + WS_CAT), DM, arows_lin(mt * 128, tid),
                              (const bf16_t*)(p.ws + WS_WOUTT), DM, nt * 128, DM, lds, acc);
#pragma unroll
                    for (int m = 0; m < 4; ++m)
#pragma unroll
                        for (int j = 0; j < 4; ++j) {
                            const int row = mt * 128 + wr * 64 + m * 16 + fq * 4 + j;
                            float* xr = xrow(p, row);
                            const float* ga = modp(p, l, row_mod(row), 2);
#pragma unroll
                            for (int n = 0; n < 4; ++n) {
                                const int col = nt * 128 + wc * 64 + n * 16 + fr;
                                { const float ca = kp.rep ? 1.f : ALPHA, cb2 = kp.rep ? 0.f : 1.f; xr[col] = ca * xr[col] + cb2 * ga[col] * acc[m][n][j]; }
                            }
                        }
                } else {
                    const int v = u - 2176, e = v / 192, t = v % 192, which = t >> 6, tt = t & 63;
                    bf16_t* W13 = (bf16_t*)(p.ws + WS_R1 + R1_W13T) + (size_t)e * 512 * 1024;
                    bf16_t* W2 = (bf16_t*)(p.ws + WS_R1 + R1_W2T) + (size_t)e * 1024 * 256;
                    if (which == 0) {
                        const float* src = (e < 64) ? p.in(I_EX_W1) + ((size_t)l * 64 + e) * 262144 : p.in(I_SH_W1) + (size_t)l * 262144;
                        xpose_tile(src, 256, W13, 1024, 1, tt >> 2, tt & 3, lds);
                    } else if (which == 1) {
                        const float* src = (e < 64) ? p.in(I_EX_W3) + ((size_t)l * 64 + e) * 262144 : p.in(I_SH_W3) + (size_t)l * 262144;
                        xpose_tile(src, 256, W13, 1024, 2, tt >> 2, tt & 3, lds);
                    } else {
                        const float* src = (e < 64) ? p.in(I_EX_W2) + ((size_t)l * 64 + e) * 262144 : p.in(I_SH_W2) + (size_t)l * 262144;
                        xpose_tile(src, 1024, W2, 256, 0, tt >> 4, tt & 15, lds);
                    }
                }
            });
        PHASE_END
        PHASE_BEGIN(pb + 6)
            strided(4352, [&](int u) { rows_unit<M_LN1>(p, l, u, lds, kp.rep > 0); __syncthreads(); });
        PHASE_END
        PHASE_BEGIN(pb + 7)
            {
                int* tb = (int*)lds;
                const int tid = otid();
                const unsigned* cnt = ctl + CW_CNT(l);
                load_tile_bases(ctl, l, tb);
                const int* aep = (const int*)(p.ws + WS_AEP); const float* aw = (const float*)(p.ws + WS_AW);
                int* rtok = (int*)(p.ws + WS_RTOK); float* rwt = (float*)(p.ws + WS_RW); int* tile_e = (int*)(p.ws + WS_TILEE);
                for (int a = blockIdx.x * NTHREADS + tid; a < NT * 8; a += gridDim.x * NTHREADS) {
                    const unsigned v = (unsigned)aep[a];
                    const int e = v >> 24, pos = v & 0xFFFFFF;
                    const int dest = tb[e] * 128 + pos;
                    rtok[dest] = a >> 3; rwt[dest] = aw[a];
                }
                for (int e = blockIdx.x; e < 64; e += gridDim.x) {
                    const int c0 = (int)xb_ld((unsigned*)&cnt[e]), nt_e = (c0 + 127) >> 7;
                    for (int q = c0 + tid; q < nt_e * 128; q += NTHREADS) { rtok[tb[e] * 128 + q] = -1; rwt[tb[e] * 128 + q] = 0.f; }
                    for (int q = tid; q < nt_e; q += NTHREADS) tile_e[tb[e] + q] = e;
                }
                __syncthreads();
            }
        PHASE_END
        PHASE_BEGIN(pb + 8)
            {
                load_tile_bases(ctl, l, (int*)lds);
                const int ntr = ((int*)lds)[64];
                __syncthreads();
                const int* rtok = (const int*)(p.ws + WS_RTOK); const int* tile_e = (const int*)(p.ws + WS_TILEE);
                strided((ntr + 272) * 4, [&](int u) {
                    LANE_IDS
                    const int tile = u >> 2, jn = u & 3;
                    int e, obase; ARows ar;
                    if (tile < ntr) {
                        e = tile_e[tile]; obase = tile * 128;
#pragma unroll
                        for (int i = 0; i < 4; ++i) { const int r = rtok[obase + (tid >> 3) + 32 * i]; ar.r[i] = r < 0 ? 0 : r; }
                    } else {
                        const int stt = tile - ntr; e = 64; obase = (SH_TILE_BASE + stt) * 128;
                        ar = arows_lin(stt * 128, tid);
                    }
                    f32x4 acc[4][4];
                    gemm_tile((const bf16_t*)(p.ws + WS_HBY), DM, ar,
                              (const bf16_t*)(p.ws + WS_R1 + R1_W13T) + (size_t)e * 512 * 1024, DM, jn * 128, DM, lds, acc);
                    bf16_t* act = (bf16_t*)(p.ws + WS_ACT);
#pragma unroll
                    for (int m = 0; m < 4; ++m)
#pragma unroll
                        for (int pp = 0; pp < 2; ++pp)
#pragma unroll
                            for (int j = 0; j < 4; ++j) {
                                const float g = acc[m][2 * pp][j], uu = acc[m][2 * pp + 1][j];
                                const int orow = obase + wr * 64 + m * 16 + fq * 4 + j;
                                const int col = jn * 64 + wc * 32 + pp * 16 + fr;
                                act[(size_t)orow * 256 + col] = f2bf(siluf(g) * uu);
                            }
                });
            }
        PHASE_END
#pragma unroll 1
        for (int sl = 0; sl < 4; ++sl) {
            PHASE_BEGIN(pb + 9 + 2 * sl)
            {
                load_tile_bases(ctl, l, (int*)lds);
                const int ntr = ((int*)lds)[64];
                __syncthreads();
                const int* tile_e = (const int*)(p.ws + WS_TILEE);
                strided((ntr + 272) * 2, [&](int u) {
                    LANE_IDS
                    const int tile = u >> 1, nt2 = u & 1;
                    int e, obase;
                    if (tile < ntr) { e = tile_e[tile]; obase = tile * 128; }
                    else { e = 64; obase = (SH_TILE_BASE + tile - ntr) * 128; }
                    f32x4 acc[4][4];
                    gemm_tile((const bf16_t*)(p.ws + WS_ACT), 256, arows_lin(obase, tid),
                              (const bf16_t*)(p.ws + WS_R1 + R1_W2T) + (size_t)e * 1024 * 256, 256, sl * 256 + nt2 * 128, 256, lds, acc);
                    bf16_t* y2 = (bf16_t*)(p.ws + WS_Y2);
#pragma unroll
                    for (int m = 0; m < 4; ++m)
#pragma unroll
                        for (int j = 0; j < 4; ++j) {
                            const int orow = obase + wr * 64 + m * 16 + fq * 4 + j;
#pragma unroll
                            for (int n = 0; n < 4; ++n) y2[(size_t)orow * 256 + nt2 * 128 + wc * 64 + n * 16 + fr] = f2bf(acc[m][n][j]);
                        }
                });
            }
            PHASE_END
            PHASE_BEGIN(pb + 10 + 2 * sl)
            {
                int* tb = (int*)lds;
                const int tid = otid();
                const unsigned* cnt = ctl + CW_CNT(l);
                load_tile_bases(ctl, l, tb);
                const int* aep = (const int*)(p.ws + WS_AEP); const float* aw = (const float*)(p.ws + WS_AW);
                const bf16_t* y2 = (const bf16_t*)(p.ws + WS_Y2);
                const int tl = tid >> 5, cg = tid & 31;
                for (int grp = blockIdx.x; grp < NT / 8; grp += gridDim.x) {
                    const int tok = grp * 8 + tl;
                    float a8[8];
                    {
                        const uint4 sv = *reinterpret_cast<const uint4*>(y2 + ((size_t)(SH_TILE_BASE * 128 + tok)) * 256 + cg * 8);
                        a8[0] = bflo(sv.x); a8[1] = bfhi(sv.x); a8[2] = bflo(sv.y); a8[3] = bfhi(sv.y);
                        a8[4] = bflo(sv.z); a8[5] = bfhi(sv.z); a8[6] = bflo(sv.w); a8[7] = bfhi(sv.w);
                    }
#pragma unroll
                    for (int k = 0; k < 8; ++k) {
                        const unsigned v = (unsigned)aep[(size_t)tok * 8 + k];
                        const float wk = aw[(size_t)tok * 8 + k];
                        const int dest = tb[v >> 24] * 128 + (int)(v & 0xFFFFFFu);
                        const uint4 yv = *reinterpret_cast<const uint4*>(y2 + (size_t)dest * 256 + cg * 8);
                        a8[0] += wk * bflo(yv.x); a8[1] += wk * bfhi(yv.x); a8[2] += wk * bflo(yv.y); a8[3] += wk * bfhi(yv.y);
                        a8[4] += wk * bflo(yv.z); a8[5] += wk * bfhi(yv.z); a8[6] += wk * bflo(yv.w); a8[7] += wk * bfhi(yv.w);
                    }
                    float* xr = xrow(p, tok) + sl * 256 + cg * 8;
                    const float* ga = modp(p, l, row_mod(tok), 5) + sl * 256 + cg * 8;
                    float4 x0 = *reinterpret_cast<const float4*>(xr), x1 = *reinterpret_cast<const float4*>(xr + 4);
                    const float4 g0 = *reinterpret_cast<const float4*>(ga), g1 = *reinterpret_cast<const float4*>(ga + 4);
                    const float rs = kp.rep ? 0.f : 1.f;
                    x0.x += rs * g0.x * a8[0]; x0.y += rs * g0.y * a8[1]; x0.z += rs * g0.z * a8[2]; x0.w += rs * g0.w * a8[3];
                    x1.x += rs * g1.x * a8[4]; x1.y += rs * g1.y * a8[5]; x1.z += rs * g1.z * a8[6]; x1.w += rs * g1.w * a8[7];
                    *reinterpret_cast<float4*>(xr) = x0; *reinterpret_cast<float4*>(xr + 4) = x1;
                }
                __syncthreads();
            }
            PHASE_END
        }
    }
    PHASE_BEGIN(35)
        strided(4352, [&](int u) { rows_unit<M_FINAL>(p, 1, u, lds); });
    PHASE_END
}

#ifndef N_LAUNCH_MODE
#define N_LAUNCH_MODE 1
#endif
extern "C" void kernel_launch(void* const* d_in, const int* in_sizes, int n_in, void* d_out, int out_size, void* d_ws, size_t ws_size, hipStream_t stream) {
    static int grid = 0;
    if (grid == 0) {
        if (n_in != 52 || out_size != NTL * DM || ws_size < WS_END) { fprintf(stderr, "kernel_launch: unexpected shapes (n_in %d out %d ws %zu need %zu)\n", n_in, out_size, ws_size, (size_t)WS_END); grid = -1; return; }
        int dev = 0, cus = 0, per_cu = 0;
        hipGetDevice(&dev);
        hipDeviceGetAttribute(&cus, hipDeviceAttributeMultiprocessorCount, dev);
        hipFuncSetAttribute((const void*)fwd_kernel, hipFuncAttributeMaxDynamicSharedMemorySize, LDS_BYTES);
        hipOccupancyMaxActiveBlocksPerMultiprocessor(&per_cu, (const void*)fwd_kernel, NTHREADS, LDS_BYTES);
        (void)hipGetLastError();
        if (per_cu < 1) per_cu = 1;
        if (per_cu > 2) per_cu = 2;
        grid = cus * per_cu;
    }
    if (grid < 0) return;
    hipMemsetAsync((char*)d_ws + WS_CTL, 0, CTL_BYTES, stream);
    KP p{};
    for (int i = 0; i < 52; ++i) p.in[i] = (const float*)d_in[i];
    p.out = (float*)d_out; p.ws = (char*)d_ws;
#if defined(PROBE_PH)
    for (int ph = 0; ph < NPHASE; ++ph) {
        const int reps = (ph == PROBE_PH) ? 1 + PROBE_N : 1;
        for (int r = 0; r < reps; ++r) { p.ph_lo = ph; p.ph_hi = ph + 1; p.rep = r; hipLaunchKernelGGL(fwd_kernel, dim3(grid), dim3(NTHREADS), LDS_BYTES, stream, p); }
    }
#elif N_LAUNCH_MODE == 1
    p.ph_lo = 0; p.ph_hi = NPHASE;
    hipLaunchKernelGGL(fwd_kernel, dim3(grid), dim3(NTHREADS), LDS_BYTES, stream, p);
#else
    for (int ph = 0; ph < NPHASE; ++ph) {
        p.ph_lo = ph; p.ph_hi = ph + 1;
        hipLaunchKernelGGL(fwd_kernel, dim3(grid), dim3(NTHREADS), LDS_BYTES, stream, p);
    }
#endif
}
```

```cpp
#include <hip/hip_runtime.h>
#include <hip/hip_bf16.h>
#include <hip/hip_fp16.h>
#include <stdint.h>
#include <stdio.h>

typedef unsigned short bf16_t;
using bf16x8 = __attribute__((ext_vector_type(8))) short;
using f32x4 = __attribute__((ext_vector_type(4))) float;
using f32x2 = __attribute__((ext_vector_type(2))) float;

#define NTC 2048
#define NTL 32768
#define NT 34816
#define DM 1024
#define ZS 3024
#define COL_GD 960
#define COL_HY 2000
#define COL_S5 2768
#define NCHUNK 68
#define ALPHA 1.41421356237f
#define NTHREADS 256
#define LDS_BYTES 73728
#define LDS_USER 1024
#define SH_TILE_BASE 2240
#define ACT_ROWS ((SH_TILE_BASE + 272) * 128)

constexpr size_t al256(size_t x) { return (x + 255) & ~(size_t)255; }
constexpr size_t WS_CTL = 0;
constexpr size_t CTL_BYTES = 65536;
constexpr size_t WS_MOD = WS_CTL + CTL_BYTES;
constexpr size_t WS_S5A = al256(WS_MOD + 2 * 9 * 6144 * 4);
constexpr size_t WS_S5B = al256(WS_S5A + 2 * 2 * 16 * 64 * 4 * 4);
constexpr size_t WS_GLUT = al256(WS_S5B + 2 * 2 * 16 * 64 * 32 * 4);
constexpr size_t WS_WINT = al256(WS_GLUT + 2 * 256 * 256 * 2);
constexpr size_t WS_WOUTT = al256(WS_WINT + (size_t)3072 * 1024 * 2);
constexpr size_t WS_FILTL = al256(WS_WOUTT + (size_t)1024 * 1024 * 2);
constexpr size_t WS_FILTC = al256(WS_FILTL + (size_t)4 * 256 * 4096 * 4);
constexpr size_t WS_XC = al256(WS_FILTC + (size_t)4 * 256 * 256 * 4);
constexpr size_t WS_HBY = al256(WS_XC + (size_t)NTC * DM * 4);
constexpr size_t WS_CAT = al256(WS_HBY + (size_t)NT * DM * 2);
constexpr size_t WS_Z = al256(WS_CAT + (size_t)NT * DM * 2);
constexpr size_t WS_R1 = al256(WS_Z + (size_t)NT * ZS * 2);
constexpr size_t R1_RWP = 0;
constexpr size_t R1_GQ = (size_t)NT * 1024 * 2;
constexpr size_t R1_W13T = 0;
constexpr size_t R1_W2T = (size_t)65 * 512 * 1024 * 2;
constexpr size_t R1_BYTES = (size_t)NT * 1024 * 2 + (size_t)NT * 768 * 2;
constexpr size_t WS_KNORM = al256(WS_R1 + R1_BYTES);
constexpr size_t WS_GAB = al256(WS_KNORM + (size_t)NT * 4 * 4);
constexpr size_t WS_S5ST = al256(WS_GAB + (size_t)NT * 16 * 4);
constexpr size_t WS_AEP = al256(WS_S5ST + (size_t)8 * 68 * 2 * 16 * 64 * 2 * 4);
constexpr size_t WS_AW = al256(WS_AEP + (size_t)NT * 8 * 4);
constexpr size_t WS_RTOK = al256(WS_AW + (size_t)NT * 8 * 4);
constexpr size_t WS_RW = al256(WS_RTOK + (size_t)SH_TILE_BASE * 128 * 4);
constexpr size_t WS_TILEE = al256(WS_RW + (size_t)SH_TILE_BASE * 128 * 4);
constexpr size_t WS_HYT = al256(WS_TILEE + SH_TILE_BASE * 4);
constexpr size_t WS_END = al256(WS_HYT + (size_t)8 * 768 * 4096 * 2);
static_assert(R1_W2T + (size_t)65 * 1024 * 256 * 2 <= R1_BYTES, "expert weights must fit R1");
constexpr size_t ACT_BYTES = (size_t)ACT_ROWS * 256 * 2;
constexpr size_t WS_ACT = WS_Z + ((((size_t)NT * ZS * 2 - ACT_BYTES) >> 8) << 8);
constexpr size_t WS_Y2 = WS_HBY;
static_assert(WS_Y2 + ACT_BYTES <= WS_ACT, "y2 must not reach act");

#define CW_QUEUE(l) (4096 + 64 * (l))
#define CW_CNT(l) (4352 + 64 * (l))
#define CW_CUCNT(l) (8192 + 4096 * (l))

#define XB_TMO      128
#define XB_XCNT(j)  (256  + 64 * (j))
#define XB_XSUB(j)  (1280 + 64 * (j))
#define XB_XGEN(j)  (2304 + 64 * (j))
#define XB_TOP      3328
#define XB_TOPGEN   3392
#define XCD_BAR_WORDS 3456
#define XB_SPIN_CAP (1u << 18)
#define LAS __attribute__((address_space(3)))

__device__ __forceinline__ unsigned xb_ld(unsigned* p)              { return __hip_atomic_load(p, __ATOMIC_RELAXED, __HIP_MEMORY_SCOPE_AGENT); }
__device__ __forceinline__ unsigned xb_add(unsigned* p, unsigned v) { return __hip_atomic_fetch_add(p, v, __ATOMIC_RELAXED, __HIP_MEMORY_SCOPE_AGENT); }
__device__ __forceinline__ unsigned xb_xcc_id() { return (unsigned)__builtin_amdgcn_s_getreg((3 << 11) | 20) & 0xFu; }
#define XB_SPIN(cond, bar) do { unsigned _sp = 0; while (cond) { __builtin_amdgcn_s_sleep(1); \
    if ((++_sp & 255u) == 0u) { if (xb_ld(&(bar)[XB_TMO])) break; if (_sp > XB_SPIN_CAP) { atomicAdd(&(bar)[XB_TMO], 1u); break; } } } } while (0)

struct XcdBarrier {
    unsigned* bar; unsigned x;
    volatile LAS unsigned* st;
};
__device__ __forceinline__ XcdBarrier xcd_barrier_post(unsigned* bar, volatile LAS unsigned* st) {
    XcdBarrier b; b.bar = bar; b.x = xb_xcc_id(); b.st = st;
    if (threadIdx.x == 0) (void)xb_add(&bar[XB_XCNT(b.x)], 1u);
    return b;
}
__device__ __forceinline__ void xcd_barrier_complete(unsigned* bar, unsigned x, unsigned& nloc, unsigned& nx) {
    const unsigned G = gridDim.x * gridDim.y * gridDim.z;
    unsigned sum, cnt, mine, sp = 0u;
    for (;;) {
        sum = 0u; cnt = 0u; mine = 0u;
#pragma unroll
        for (unsigned j = 0; j < 16; ++j) { const unsigned c = xb_ld(&bar[XB_XCNT(j)]); sum += c; cnt += (c > 0u) ? 1u : 0u; mine = (j == x) ? c : mine; }
        if (sum == G) break;
        __builtin_amdgcn_s_sleep(1);
        if ((++sp & 255u) == 0u) { if (xb_ld(&bar[XB_TMO])) break; if (sp > XB_SPIN_CAP) { atomicAdd(&bar[XB_TMO], 1u); break; } }
    }
    nloc = mine > 0u ? mine : 1u; nx = cnt > 0u ? cnt : 1u;
}
__device__ __forceinline__ void xcd_barrier(const XcdBarrier& b) {
    asm volatile("s_waitcnt vmcnt(0)" ::: "memory");
    __syncthreads();
    if (threadIdx.x == 0) {
        unsigned* bar = b.bar;
        __builtin_amdgcn_s_waitcnt(0);
        unsigned nloc = b.st[0], nx = b.st[1];
        if (nloc == 0u) { xcd_barrier_complete(bar, b.x, nloc, nx); b.st[0] = nloc; b.st[1] = nx; }
        const unsigned old = xb_add(&bar[XB_XSUB(b.x)], 1u);
        const unsigned gen = old / nloc;
        if (old + 1u == (gen + 1u) * nloc) {
            __builtin_amdgcn_fence(__ATOMIC_RELEASE, "agent");
            asm volatile("s_waitcnt vmcnt(0)" ::: "memory");
            const unsigned og = xb_add(&bar[XB_TOP], 1u);
            const unsigned tg = og / nx;
            if (og + 1u == (tg + 1u) * nx) xb_add(&bar[XB_TOPGEN], 1u);
            else XB_SPIN(xb_ld(&bar[XB_TOPGEN]) == tg, bar);
            __builtin_amdgcn_fence(__ATOMIC_ACQUIRE, "agent");
            xb_add(&bar[XB_XGEN(b.x)], 1u);
            asm volatile("s_waitcnt vmcnt(0)" ::: "memory");
        } else {
            XB_SPIN(xb_ld(&bar[XB_XGEN(b.x)]) == gen, bar);
            __builtin_amdgcn_fence(__ATOMIC_ACQUIRE, "agent");
            asm volatile("s_waitcnt vmcnt(0)" ::: "memory");
        }
    }
    __syncthreads();
}

struct KP {
    const float* in[52];
    float* out;
    char* ws;
    int ph_lo, ph_hi, rep, pad_;
};
struct P {
    const __attribute__((address_space(3))) unsigned* tab;
    float* out;
    char* ws;
    __device__ __forceinline__ const float* in(int i) const {
        const unsigned lo = __builtin_amdgcn_readfirstlane(tab[2 * i]);
        const unsigned hi = __builtin_amdgcn_readfirstlane(tab[2 * i + 1]);
        return (const float*)(((unsigned long long)hi << 32) | (unsigned long long)lo);
    }
};
enum { I_X = 0, I_C, I_CTX, I_CCTX, I_ADAW, I_ADAB, I_WIN, I_WOUT, I_LNG, I_LNB,
       I_RW_W0, I_RW_W2, I_RW_A0, I_RW_A2, I_RW_G2, I_RW_KK, I_RW_KA, I_RW_RK, I_RW_GNG, I_RW_GNB,
       I_GD_CONV, I_GD_ALOG, I_GD_DTB, I_GD_NORM,
       I_HY_CONV, I_HY_CONVB, I_HY_W1, I_HY_B1, I_HY_F1, I_HY_W2, I_HY_B2, I_HY_F2, I_HY_W3, I_HY_SKIP,
       I_S5_LRE, I_S5_LIM, I_S5_LOGSTEP, I_S5_BRE, I_S5_BIM, I_S5_CRE, I_S5_CIM, I_S5_D, I_S5_GLUW, I_S5_GLUB,
       I_ROUTER_W, I_ROUTER_B, I_EX_W1, I_EX_W3, I_EX_W2, I_SH_W1, I_SH_W3, I_SH_W2 };

__device__ __forceinline__ bf16_t f2bf(float f) { unsigned u = __float_as_uint(f); u += 0x7fffu + ((u >> 16) & 1u); return (bf16_t)(u >> 16); }
__device__ __forceinline__ float bf2f(bf16_t h) { return __uint_as_float(((unsigned)h) << 16); }
__device__ __forceinline__ float bflo(unsigned u) { return __uint_as_float(u << 16); }
__device__ __forceinline__ float bfhi(unsigned u) { return __uint_as_float(u & 0xffff0000u); }
__device__ __forceinline__ unsigned pack2(float a, float b) { return (unsigned)f2bf(a) | ((unsigned)f2bf(b) << 16); }
__device__ __forceinline__ float sigm(float x) { return 1.f / (1.f + __expf(-x)); }
__device__ __forceinline__ float siluf(float x) { return x / (1.f + __expf(-x)); }
__device__ __forceinline__ float softplusf(float x) { return fmaxf(x, 0.f) + log1pf(__expf(-fabsf(x))); }
__device__ __forceinline__ float wave_sum(float v) {
#pragma unroll
    for (int o = 32; o >= 1; o >>= 1) v += __shfl_xor(v, o);
    return v;
}
template <int CTRL> __device__ __forceinline__ float dppf(float v) {
    return __int_as_float(__builtin_amdgcn_update_dpp(0, __float_as_int(v), CTRL, 0xF, 0xF, true));
}
__device__ __forceinline__ int otid() { int t = threadIdx.x; asm volatile("" : "+v"(t)); return t; }
__device__ __forceinline__ float* xrow(const P& p, int row) {
    return row < NTC ? (float*)(p.ws + WS_XC) + (size_t)row * DM : p.out + (size_t)(row - NTC) * DM;
}
__device__ __forceinline__ int row_mod(int row) { return row < NTC ? 8 : ((row - NTC) >> 12); }
__device__ __forceinline__ const float* modp(const P& p, int l, int r, int chunk) {
    return (const float*)(p.ws + WS_MOD) + ((size_t)(l * 9 + r) * 6144 + chunk * 1024);
}

struct ARows { int r[4]; };
__device__ __forceinline__ ARows arows_lin(int base, int tid) { ARows a; a.r[0] = base + (tid >> 3); a.r[1] = a.r[0] + 32; a.r[2] = a.r[0] + 64; a.r[3] = a.r[0] + 96; return a; }
__device__ __forceinline__ void gemm_tile(const bf16_t* __restrict__ A, int lda, const ARows& ar,
                                          const bf16_t* __restrict__ Bt, int ldb, int brow0, int K,
                                          char* lds, f32x4 (&acc)[4][4]) {
    const int tid = otid();
    const int wid = tid >> 6, lane = tid & 63, wr = wid >> 1, wc = wid & 1, fr = lane & 15, fq = lane >> 4;
    const int gc = ((tid & 7) ^ ((tid >> 3) & 7)) * 8;
    const bf16_t* ap[4]; const bf16_t* bp[4];
#pragma unroll
    for (int i = 0; i < 4; ++i) {
        ap[i] = A + (size_t)ar.r[i] * lda + gc;
        bp[i] = Bt + (size_t)(brow0 + (tid >> 3) + 32 * i) * ldb + gc;
    }
#pragma unroll
    for (int m = 0; m < 4; ++m)
#pragma unroll
        for (int n = 0; n < 4; ++n) acc[m][n] = f32x4{0.f, 0.f, 0.f, 0.f};
    const int nk = K >> 6;
    auto stage = [&](int t, int buf) {
        char* SA = lds + buf * 32768; char* SB = SA + 16384;
        const int ko = t * 64;
#pragma unroll
        for (int i = 0; i < 4; ++i) {
            __builtin_amdgcn_global_load_lds((const void*)(ap[i] + ko), (LAS void*)(SA + tid * 16 + i * 4096), 16, 0, 0);
            __builtin_amdgcn_global_load_lds((const void*)(bp[i] + ko), (LAS void*)(SB + tid * 16 + i * 4096), 16, 0, 0);
        }
    };
    stage(0, 0);
    asm volatile("s_waitcnt vmcnt(0)" ::: "memory");
    __syncthreads();
    const int sw = fr & 7;
    for (int t = 0; t < nk; ++t) {
        const int buf = t & 1;
        if (t + 1 < nk) stage(t + 1, buf ^ 1);
        const char* SA = lds + buf * 32768; const char* SB = SA + 16384;
#pragma unroll
        for (int ks = 0; ks < 2; ++ks) {
            const int co = ((ks * 4 + fq) ^ sw) * 16;
            bf16x8 af[4], bfr[4];
#pragma unroll
            for (int m = 0; m < 4; ++m) af[m] = *reinterpret_cast<const bf16x8*>(SA + (wr * 64 + m * 16 + fr) * 128 + co);
#pragma unroll
            for (int n = 0; n < 4; ++n) bfr[n] = *reinterpret_cast<const bf16x8*>(SB + (wc * 64 + n * 16 + fr) * 128 + co);
#pragma unroll
            for (int m = 0; m < 4; ++m)
#pragma unroll
                for (int n = 0; n < 4; ++n) acc[m][n] = __builtin_amdgcn_mfma_f32_16x16x32_bf16(af[m], bfr[n], acc[m][n], 0, 0, 0);
        }
        asm volatile("s_waitcnt vmcnt(0)" ::: "memory");
        __syncthreads();
    }
}

__device__ __forceinline__ void ph0_mod_unit(const P& p, int u, char* lds) {
    const int l = u / 96, cg = u % 96, tid = otid();
    float* s = (float*)lds;
    float* red = s + 9 * 1024;
    const float* c = p.in(I_C); const float* cctx = p.in(I_CCTX);
    for (int i = tid; i < 9 * 1024; i += NTHREADS) { int r = i >> 10, k = i & 1023; float v = r < 8 ? c[r * 1024 + k] : cctx[k]; s[i] = v / (1.f + expf(-v)); }
    __syncthreads();
    const int kq = tid >> 6, j = tid & 63, col = cg * 64 + j;
    const float* w = p.in(I_ADAW) + (size_t)l * 1024 * 6144 + col;
    float acc[9];
#pragma unroll
    for (int r = 0; r < 9; ++r) acc[r] = 0.f;
#pragma unroll 4
    for (int k = kq * 256; k < kq * 256 + 256; ++k) {
        const float wv = w[(size_t)k * 6144];
#pragma unroll
        for (int r = 0; r < 9; ++r) acc[r] += s[r * 1024 + k] * wv;
    }
#pragma unroll
    for (int r = 0; r < 9; ++r) red[(kq * 9 + r) * 64 + j] = acc[r];
    __syncthreads();
    if (tid < 64) {
        float* mod = (float*)(p.ws + WS_MOD);
        const float bb = p.in(I_ADAB)[l * 6144 + col];
#pragma unroll
        for (int r = 0; r < 9; ++r) mod[(size_t)(l * 9 + r) * 6144 + col] = red[r * 64 + j] + red[(9 + r) * 64 + j] + red[(18 + r) * 64 + j] + red[(27 + r) * 64 + j] + bb;
    }
    __syncthreads();
}

__device__ __forceinline__ void ph0_s5tab_unit(const P& p, int u) {
    const int tid = otid();
    if (tid >= 64) return;
    const int ldg = u;
    const int idx = ldg * 64 + tid;
    const double lre = (double)p.in(I_S5_LRE)[idx], lim = (double)p.in(I_S5_LIM)[idx];
    const double dt = (double)expf(p.in(I_S5_LOGSTEP)[ldg]);
    const float mag = expf((float)(lre * dt));
    double rev = lim * dt * 0.15915494309189535; rev -= floor(rev);
    float sn, cs; sincospif(2.f * (float)rev, &sn, &cs);
    const double abr = (double)(mag * cs), abi = (double)(mag * sn);
    const double den = lre * lre + lim * lim;
    const double cor = ((abr - 1.0) * lre + abi * lim) / den;
    const double coi = (abi * lre - (abr - 1.0) * lim) / den;
    const float m64f = expf((float)(64.0 * lre * dt));
    double rev64 = 64.0 * lim * dt * 0.15915494309189535; rev64 -= floor(rev64);
    float sn64, cs64; sincospif(2.f * (float)rev64, &sn64, &cs64);
    float* A = (float*)(p.ws + WS_S5A) + (size_t)idx * 4;
    A[0] = (float)abr; A[1] = (float)abi; A[2] = m64f * cs64; A[3] = m64f * sn64;
    float* B = (float*)(p.ws + WS_S5B) + (size_t)idx * 32;
    const float* bre = p.in(I_S5_BRE) + (size_t)idx * 16; const float* bim = p.in(I_S5_BIM) + (size_t)idx * 16;
#pragma unroll
    for (int h = 0; h < 16; ++h) {
        const double br = bre[h], bi = bim[h];
        B[h] = (float)(cor * br - coi * bi);
        B[16 + h] = (float)(cor * bi + coi * br);
    }
}

__device__ __forceinline__ int xmap(int mode, int c) {
    if (mode == 0) return c;
    const int j = c >> 6, cc = c & 63, wc = cc >> 5, pp = (cc & 31) >> 4, i = cc & 15;
    return j * 128 + wc * 64 + pp * 32 + i + (mode == 2 ? 16 : 0);
}
__device__ __forceinline__ void xpose_tile(const float* __restrict__ src, int C, bf16_t* __restrict__ dst, int ldd, int mode, int tr, int tc, char* lds) {
    float* t = (float*)lds;
    const int tid = otid();
    {
        const int c4 = (tid & 15) * 4, c = tc * 64 + c4;
#pragma unroll
        for (int k = 0; k < 4; ++k) {
            const int r = (tid >> 4) + 16 * k;
            float4 v = make_float4(0.f, 0.f, 0.f, 0.f);
            if (c < C) v = *reinterpret_cast<const float4*>(src + (size_t)(tr * 64 + r) * C + c);
            t[(c4 + 0) * 65 + r] = v.x; t[(c4 + 1) * 65 + r] = v.y; t[(c4 + 2) * 65 + r] = v.z; t[(c4 + 3) * 65 + r] = v.w;
        }
    }
    __syncthreads();
#pragma unroll
    for (int k = 0; k < 2; ++k) {
        const int ci = (tid >> 3) + 32 * k, r8 = (tid & 7) * 8;
        const float* tp = t + ci * 65 + r8;
        uint4 o;
        o.x = pack2(tp[0], tp[1]); o.y = pack2(tp[2], tp[3]); o.z = pack2(tp[4], tp[5]); o.w = pack2(tp[6], tp[7]);
        *reinterpret_cast<uint4*>(dst + (size_t)xmap(mode, tc * 64 + ci) * ldd + tr * 64 + r8) = o;
    }
    __syncthreads();
}

enum { M_INIT = 0, M_LN2NEXT = 1, M_LN1 = 2, M_FINAL = 3 };

template <int MODE>
__device__ __forceinline__ void rows_unit(const P& p, int l, int u, char* lds, bool dry = false) {
    const int tid = otid(), w = tid >> 6, lane = tid & 63;
    float* hbuf = (float*)lds;
    bf16_t* hb = (bf16_t*)(p.ws + WS_HBY);
#pragma unroll 1
    for (int rr = 0; rr < 2; ++rr) {
        const int rl = w * 2 + rr, row = u * 8 + rl;
        const int mr = row_mod(row);
        float v[16];
        float* xr = xrow(p, row);
        const float* src = (MODE == M_INIT) ? (row < NTC ? p.in(I_CTX) + (size_t)row * DM : p.in(I_X) + (size_t)(row - NTC) * DM) : xr;
#pragma unroll
        for (int i = 0; i < 4; ++i) {
            const float4 t = *reinterpret_cast<const float4*>(src + i * 256 + lane * 4);
            v[i * 4 + 0] = t.x; v[i * 4 + 1] = t.y; v[i * 4 + 2] = t.z; v[i * 4 + 3] = t.w;
        }
        if (MODE != M_INIT) {
            const int ll = (MODE == M_LN2NEXT) ? l - 1 : l;
            const int which = (MODE == M_LN1) ? 0 : 1;
            float s = 0.f;
#pragma unroll
            for (int i = 0; i < 16; ++i) s += v[i];
            const float mu = wave_sum(s) * (1.f / 1024.f);
            float q = 0.f;
#pragma unroll
            for (int i = 0; i < 16; ++i) { const float d = v[i] - mu; q += d * d; }
            const float rstd = rsqrtf(wave_sum(q) * (1.f / 1024.f) + 1e-5f);
            const float* g = p.in(I_LNG) + (size_t)(ll * 2 + which) * 1024;
            const float* bb = p.in(I_LNB) + (size_t)(ll * 2 + which) * 1024;
#pragma unroll
            for (int i = 0; i < 4; ++i) {
                const float4 gg = *reinterpret_cast<const float4*>(g + i * 256 + lane * 4);
                const float4 b4 = *reinterpret_cast<const float4*>(bb + i * 256 + lane * 4);
                v[i * 4 + 0] = (v[i * 4 + 0] - mu) * rstd * gg.x + b4.x;
                v[i * 4 + 1] = (v[i * 4 + 1] - mu) * rstd * gg.y + b4.y;
                v[i * 4 + 2] = (v[i * 4 + 2] - mu) * rstd * gg.z + b4.z;
                v[i * 4 + 3] = (v[i * 4 + 3] - mu) * rstd * gg.w + b4.w;
            }
        }
        if (MODE == M_FINAL) {
            if (row >= NTC) {
#pragma unroll
                for (int i = 0; i < 4; ++i) *reinterpret_cast<float4*>(xr + i * 256 + lane * 4) = make_float4(v[i * 4], v[i * 4 + 1], v[i * 4 + 2], v[i * 4 + 3]);
            }
            continue;
        }
        const float osc = (MODE == M_LN1) ? ALPHA : 1.f;
#pragma unroll
        for (int i = 0; i < 4; ++i) { float4 o4 = make_float4(osc * v[i * 4], osc * v[i * 4 + 1], osc * v[i * 4 + 2], osc * v[i * 4 + 3]); if (dry) o4 = *reinterpret_cast<const float4*>(src + i * 256 + lane * 4); *reinterpret_cast<float4*>(xr + i * 256 + lane * 4) = o4; }
        const float* sh = modp(p, l, mr, (MODE == M_LN1) ? 3 : 0);
        const float* sc = modp(p, l, mr, (MODE == M_LN1) ? 4 : 1);
#pragma unroll
        for (int i = 0; i < 4; ++i) {
            const float4 s4 = *reinterpret_cast<const float4*>(sc + i * 256 + lane * 4);
            const float4 h4 = *reinterpret_cast<const float4*>(sh + i * 256 + lane * 4);
            const float h0 = v[i * 4 + 0] * (1.f + s4.x) + h4.x, h1 = v[i * 4 + 1] * (1.f + s4.y) + h4.y;
            const float h2 = v[i * 4 + 2] * (1.f + s4.z) + h4.z, h3 = v[i * 4 + 3] * (1.f + s4.w) + h4.w;
            uint2 pk; pk.x = pack2(h0, h1); pk.y = pack2(h2, h3);
            if (!dry) *reinterpret_cast<uint2*>(hb + (size_t)row * DM + i * 256 + lane * 4) = pk;
            if (MODE == M_LN1) *reinterpret_cast<float4*>(hbuf + rl * 1024 + i * 256 + lane * 4) = make_float4(h0, h1, h2, h3);
        }
    }
    if (MODE == M_LN1) {
        float* part = hbuf + 8 * 1024;
        __syncthreads();
        {
            const float* rw = p.in(I_ROUTER_W) + (size_t)l * 1024 * 64 + lane;
            float ac[8];
#pragma unroll
            for (int r = 0; r < 8; ++r) ac[r] = 0.f;
#pragma unroll 2
            for (int k = w * 256; k < w * 256 + 256; k += 4) {
                const float w0 = rw[(size_t)(k + 0) * 64], w1 = rw[(size_t)(k + 1) * 64], w2 = rw[(size_t)(k + 2) * 64], w3 = rw[(size_t)(k + 3) * 64];
#pragma unroll
                for (int r = 0; r < 8; ++r) {
                    const float4 x = *reinterpret_cast<const float4*>(hbuf + r * 1024 + k);
                    ac[r] += x.x * w0 + x.y * w1 + x.z * w2 + x.w * w3;
                }
            }
#pragma unroll
            for (int r = 0; r < 8; ++r) part[(w * 8 + r) * 64 + lane] = ac[r];
        }
        __syncthreads();
        float a0, a1;
        {
            const int r0 = w * 2, r1 = w * 2 + 1;
            a0 = part[(0 * 8 + r0) * 64 + lane] + part[(1 * 8 + r0) * 64 + lane] + part[(2 * 8 + r0) * 64 + lane] + part[(3 * 8 + r0) * 64 + lane];
            a1 = part[(0 * 8 + r1) * 64 + lane] + part[(1 * 8 + r1) * 64 + lane] + part[(2 * 8 + r1) * 64 + lane] + part[(3 * 8 + r1) * 64 + lane];
        }
        const float rbias = p.in(I_ROUTER_B)[l * 64 + lane];
        unsigned* cnt = (unsigned*)(p.ws + WS_CTL) + CW_CNT(l);
        int* aep = (int*)(p.ws + WS_AEP); float* aw = (float*)(p.ws + WS_AW);
#pragma unroll 1
        for (int rr = 0; rr < 2; ++rr) {
            const int row = u * 8 + w * 2 + rr;
            const float logit = rr ? a1 : a0;
            const float s = 1.f / (1.f + expf(-logit));
            const float bsd = s + rbias;
            float m1 = bsd;
            m1 = fmaxf(m1, __shfl_xor(m1, 1)); m1 = fmaxf(m1, __shfl_xor(m1, 2)); m1 = fmaxf(m1, __shfl_xor(m1, 4));
            const unsigned long long eqm = __ballot(bsd == m1);
            const int gbase = lane & ~7;
            const unsigned gbits = (unsigned)((eqm >> gbase) & 0xFFull);
            const int first = gbase + __builtin_ctz(gbits);
            float m2 = (lane == first) ? -INFINITY : bsd;
            m2 = fmaxf(m2, __shfl_xor(m2, 1)); m2 = fmaxf(m2, __shfl_xor(m2, 2)); m2 = fmaxf(m2, __shfl_xor(m2, 4));
            const float gs = m1 + m2;
            const int myg = lane >> 3;
            int grank = 0;
#pragma unroll
            for (int g2 = 0; g2 < 8; ++g2) { const float o = __shfl(gs, g2 * 8); grank += (o > gs || (o == gs && g2 < myg)) ? 1 : 0; }
            const bool gsel = grank < 4;
            const float msk = gsel ? bsd : -INFINITY;
            int erank = 0;
#pragma unroll
            for (int j = 0; j < 64; ++j) { const float o = __shfl(msk, j); erank += (o > msk || (o == msk && j < lane)) ? 1 : 0; }
            const bool sel = gsel && erank < 8;
            const float wsum = wave_sum(sel ? s : 0.f);
            const unsigned long long selm = __ballot(sel);
            if (sel && !dry) {
                const int slot = __popcll(selm & ((1ull << lane) - 1ull));
                const unsigned pos = atomicAdd(&cnt[lane], 1u);
                aep[(size_t)row * 8 + slot] = (int)((unsigned)lane << 24 | pos);
                aw[(size_t)row * 8 + slot] = s / wsum * 2.5f;
            }
        }
    }
}

__device__ __forceinline__ void filt_unit(const P& p, int l, int u, char* lds) {
    const int tid = otid();
    float* feat = (float*)lds;
    float* h1 = feat + 4 * 36;
    float* h2 = h1 + 4 * 64;
    const int pp = tid >> 6, j = tid & 63;
    const int pi = u * 4 + pp;
    const int L = pi < 4096 ? 4096 : 256;
    const int t = pi < 4096 ? pi : pi - 4096;
    const float tt = (float)t / (float)(L - 1);
    if (j < 33) {
        float f;
        if (j == 0) f = tt;
        else {
            const int k = (j - 1) & 15;
            const float band = 1e-4f + (float)k * ((15.0f - 1e-4f) / 15.0f);
            float ph = band * (float)t * (1.f / (float)L);
            ph -= floorf(ph);
            float sn, cs; sincospif(2.f * ph, &sn, &cs);
            f = (j <= 16) ? cs : -sn;
        }
        feat[pp * 36 + j] = f;
    }
    __syncthreads();
    {
        const float* w1 = p.in(I_HY_W1) + (size_t)l * 33 * 64;
        float a = p.in(I_HY_B1)[l * 64 + j];
        for (int i = 0; i < 33; ++i) a += feat[pp * 36 + i] * w1[i * 64 + j];
        h1[pp * 64 + j] = sinf(p.in(I_HY_F1)[l * 64 + j] * a);
    }
    __syncthreads();
    {
        const float* w2 = p.in(I_HY_W2) + (size_t)l * 64 * 64;
        float a = p.in(I_HY_B2)[l * 64 + j];
        for (int i = 0; i < 64; ++i) a += h1[pp * 64 + i] * w2[i * 64 + j];
        h2[pp * 64 + j] = sinf(p.in(I_HY_F2)[l * 64 + j] * a);
    }
    __syncthreads();
    {
        const int c = tid;
        const float* w3 = p.in(I_HY_W3) + (size_t)l * 64 * 1024;
        float acc[4][4];
#pragma unroll
        for (int a = 0; a < 4; ++a)
#pragma unroll
            for (int b = 0; b < 4; ++b) acc[a][b] = 0.f;
        for (int i = 0; i < 64; ++i) {
            float wv[4];
#pragma unroll
            for (int os = 0; os < 4; ++os) wv[os] = w3[i * 1024 + os * 256 + c];
#pragma unroll
            for (int q = 0; q < 4; ++q) {
                const float hv = h2[q * 64 + i];
#pragma unroll
                for (int os = 0; os < 4; ++os) acc[q][os] += hv * wv[os];
            }
        }
        const float d0 = logf(0.01f) / 1.5f, d1 = logf(0.01f) / 0.3f;
        const float delta = fabsf(d0 + (d1 - d0) * ((float)c / 255.f));
#pragma unroll
        for (int q = 0; q < 4; ++q) {
            const int pq = u * 4 + q;
            const int Lq = pq < 4096 ? 4096 : 256;
            const int tq = pq < 4096 ? pq : pq - 4096;
            const float ttq = (float)tq / (float)(Lq - 1);
            const float dec = expf(-ttq * delta);
            float* F = (pq < 4096) ? (float*)(p.ws + WS_FILTL) : (float*)(p.ws + WS_FILTC);
#pragma unroll
            for (int os = 0; os < 4; ++os) {
                if (pq < 4096) F[((size_t)((os >> 1) * 256 + c) * 2 + (os & 1)) * 4096 + tq] = acc[q][os] * dec;
                else F[((size_t)os * 256 + c) * Lq + tq] = acc[q][os] * dec;
            }
        }
    }
    __syncthreads();
}

__device__ __forceinline__ void rwkv_prep_unit(const P& p, int l, int u, char* lds) {
    const int tid = otid(), w = tid >> 6;
    float* tw = (float*)lds;
    float* al = tw + 32 * 64;
    const bf16_t* z = (const bf16_t*)(p.ws + WS_Z);
    bf16_t* rwp = (bf16_t*)(p.ws + WS_R1 + R1_RWP);
    float* knorm = (float*)(p.ws + WS_KNORM);
    const int row0 = u * 32;
#pragma unroll
    for (int i = 0; i < 8; ++i) {
        const int idx = tid + 256 * i, tok = idx >> 6, j = idx & 63;
        const bf16_t* zr = z + (size_t)(row0 + tok) * ZS;
        tw[idx] = tanhf(bf2f(zr[768 + j]));
        al[idx] = bf2f(zr[832 + j]);
    }
    __syncthreads();
    const int c = tid;
#pragma unroll 1
    for (int pass = 0; pass < 4; ++pass) {
        const int d = pass & 1;
        const bool isA = pass >= 2;
        const float* W2 = (isA ? p.in(I_RW_A2) : p.in(I_RW_W2)) + (size_t)((l * 2 + d) * 32) * 256 + c;
        const float base = (isA ? p.in(I_RW_A0) : p.in(I_RW_W0))[(l * 2 + d) * 256 + c];
        float wr[32];
#pragma unroll
        for (int r = 0; r < 32; ++r) wr[r] = W2[r * 256];
        const float* src = isA ? al : tw;
#pragma unroll 2
        for (int tok = 0; tok < 32; ++tok) {
            float a = base;
#pragma unroll
            for (int r = 0; r < 32; r += 4) {
                const float4 x = *reinterpret_cast<const float4*>(src + tok * 64 + d * 32 + r);
                a += x.x * wr[r] + x.y * wr[r + 1] + x.z * wr[r + 2] + x.w * wr[r + 3];
            }
            float o;
            if (isA) o = 1.f / (1.f + expf(-a));
            else o = expf(-softplusf(-a) - 0.5f);
            rwp[((size_t)(row0 + tok) * 4 + pass) * 256 + c] = f2bf(o);
        }
    }
    const float kkc = p.in(I_RW_KK)[l * 256 + c];
#pragma unroll 4
    for (int tok = 0; tok < 32; ++tok) {
        const float kv = bf2f(z[(size_t)(row0 + tok) * ZS + 256 + c]) * kkc;
        const float ss = wave_sum(kv * kv);
        if ((tid & 63) == 0) knorm[(size_t)(row0 + tok) * 4 + w] = rsqrtf(ss + 1e-12f);
    }
    __syncthreads();
}

__device__ __forceinline__ void gdn_prep_unit(const P& p, int l, int u) {
    const int tid = otid();
    const bf16_t* z = (const bf16_t*)(p.ws + WS_Z);
    bf16_t* gq = (bf16_t*)(p.ws + WS_R1 + R1_GQ);
    float* gab = (float*)(p.ws + WS_GAB);
    const int row0 = u * 32;
    int seq0, seqL;
    if (row0 < NTC) { seq0 = row0 & ~255; seqL = 256; } else { seq0 = NTC + ((row0 - NTC) & ~4095); seqL = 4096; }
#pragma unroll 1
    for (int pz = 0; pz < 3; ++pz) {
        const int ch = pz * 256 + tid;
        const float w0 = p.in(I_GD_CONV)[(size_t)(l * 3 + 0) * 768 + ch], w1 = p.in(I_GD_CONV)[(size_t)(l * 3 + 1) * 768 + ch], w2 = p.in(I_GD_CONV)[(size_t)(l * 3 + 2) * 768 + ch];
        const bf16_t* zc = z + COL_GD + ch;
        float xm = (row0 - 1 >= seq0) ? bf2f(zc[(size_t)(row0 - 1) * ZS]) : 0.f;
        float x0 = bf2f(zc[(size_t)row0 * ZS]);
#pragma unroll 4
        for (int tok = 0; tok < 32; ++tok) {
            const int row = row0 + tok;
            const float xp = (row + 1 < seq0 + seqL) ? bf2f(zc[(size_t)(row + 1) * ZS]) : 0.f;
            float v = siluf(w0 * xm + w1 * x0 + w2 * xp);
            if (pz < 2) {
                const float ss = wave_sum(v * v);
                v *= rsqrtf(ss + 1e-12f) * (pz == 0 ? 0.125f : 1.f);
            }
            gq[(size_t)row * 768 + ch] = f2bf(v);
            xm = x0; x0 = xp;
        }
    }
    {
        const int tok = tid >> 3, dh = tid & 7;
        const int row = row0 + tok;
        const float alv = bf2f(z[(size_t)row * ZS + COL_GD + 1024 + dh]);
        const float blv = bf2f(z[(size_t)row * ZS + COL_GD + 1032 + dh]);
        const float g = -expf(p.in(I_GD_ALOG)[l * 8 + dh]) * softplusf(alv + p.in(I_GD_DTB)[l * 8 + dh]);
        gab[(size_t)row * 16 + dh] = expf(g);
        gab[(size_t)row * 16 + 8 + dh] = 1.f / (1.f + expf(-blv));
    }
}

__device__ __forceinline__ int s5_chain_row(int b, int d, int q) {
    if (q < 256) return b * 256 + (d ? 255 - q : q);
    int n = q - 256; if (d) n = 4095 - n;
    return NTC + b * 4096 + (n & 63) * 64 + (n >> 6);
}
__device__ __forceinline__ void s5_load_u(const bf16_t* zr, float* dst) {
    const uint4 a = *reinterpret_cast<const uint4*>(zr);
    const uint4 b = *reinterpret_cast<const uint4*>(zr + 8);
    *reinterpret_cast<float4*>(dst + 0) = make_float4(bflo(a.x), bfhi(a.x), bflo(a.y), bfhi(a.y));
    *reinterpret_cast<float4*>(dst + 4) = make_float4(bflo(a.z), bfhi(a.z), bflo(a.w), bfhi(a.w));
    *reinterpret_cast<float4*>(dst + 8) = make_float4(bflo(b.x), bfhi(b.x), bflo(b.y), bfhi(b.y));
    *reinterpret_cast<float4*>(dst + 12) = make_float4(bflo(b.z), bfhi(b.z), bflo(b.w), bfhi(b.w));
}

__device__ __forceinline__ void s5_pre_unit(const P& p, int l, int u, char* lds) {
    const int tid = otid(), w = tid >> 6, lane = tid & 63;
    float* ust = (float*)lds + w * 1024;
    const int wt = u * 4 + w;
    const int d = wt & 1, g = (wt >> 1) & 15, rest = wt >> 5;
    const int cc = rest % NCHUNK, b = rest / NCHUNK;
    const bf16_t* z = (const bf16_t*)(p.ws + WS_Z);
    {
        const int row = s5_chain_row(b, d, cc * 64 + lane);
        s5_load_u(z + (size_t)row * ZS + COL_S5 + g * 16, ust + lane * 16);
    }
    const int tix = ((l * 2 + d) * 16 + g) * 64 + lane;
    const float4 A = *reinterpret_cast<const float4*>((const float*)(p.ws + WS_S5A) + (size_t)tix * 4);
    const float* Bp = (const float*)(p.ws + WS_S5B) + (size_t)tix * 32;
    float br[16], bi[16];
#pragma unroll
    for (int h = 0; h < 16; ++h) { br[h] = Bp[h]; bi[h] = Bp[16 + h]; }
    float xr = 0.f, xi = 0.f;
#pragma unroll 2
    for (int s = 0; s < 64; ++s) {
        float ur = 0.f, ui = 0.f;
#pragma unroll
        for (int h4 = 0; h4 < 4; ++h4) {
            const float4 uu = *reinterpret_cast<const float4*>(ust + s * 16 + h4 * 4);
            ur += br[h4 * 4] * uu.x + br[h4 * 4 + 1] * uu.y + br[h4 * 4 + 2] * uu.z + br[h4 * 4 + 3] * uu.w;
            ui += bi[h4 * 4] * uu.x + bi[h4 * 4 + 1] * uu.y + bi[h4 * 4 + 2] * uu.z + bi[h4 * 4 + 3] * uu.w;
        }
        const float nr = A.x * xr - A.y * xi + ur;
        const float ni = A.x * xi + A.y * xr + ui;
        xr = nr; xi = ni;
    }
    float* st = (float*)(p.ws + WS_S5ST) + ((((size_t)(b * NCHUNK + cc) * 2 + d) * 16 + g) * 64 + lane) * 2;
    st[0] = xr; st[1] = xi;
}

__device__ __forceinline__ float reduce16(const float (&t)[16], int lane) {
    float a[8];
    const bool hi8 = (lane & 8) != 0;
#pragma unroll
    for (int k = 0; k < 8; ++k) { const float keep = hi8 ? t[k + 8] : t[k]; const float send = hi8 ? t[k] : t[k + 8]; a[k] = keep + dppf<0x140>(send); }
    float b[4];
    const bool hi4 = (lane & 4) != 0;
#pragma unroll
    for (int k = 0; k < 4; ++k) { const float keep = hi4 ? a[k + 4] : a[k]; const float send = hi4 ? a[k] : a[k + 4]; b[k] = keep + dppf<0x141>(send); }
    float c[2];
    const bool hi2 = (lane & 2) != 0;
#pragma unroll
    for (int k = 0; k < 2; ++k) { const float keep = hi2 ? b[k + 2] : b[k]; const float send = hi2 ? b[k] : b[k + 2]; c[k] = keep + dppf<0x4E>(send); }
    const bool hi1 = (lane & 1) != 0;
    float r = (hi1 ? c[1] : c[0]) + dppf<0xB1>(hi1 ? c[0] : c[1]);
    r += __shfl_xor(r, 16);
    r += __shfl_xor(r, 32);
    return r;
}

__device__ __forceinline__ void s5_main_unit(const P& p, int l, int u, char* lds) {
    const int tid = otid(), w = tid >> 6, lane = tid & 63;
    char* wl = lds + w * 12800;
    float* ust = (float*)wl;
    char* xbuf = wl + 4096;
    float* yst = (float*)xbuf;
    const int b = u / NCHUNK, tc = u % NCHUNK;
    bf16_t* z = (bf16_t*)(p.ws + WS_Z);
    const int myrow = (tc < 4) ? (b * 256 + tc * 64 + lane) : (NTC + b * 4096 + lane * 64 + (tc - 4));
    const int fr = lane & 15, fq = lane >> 4;
#pragma unroll 1
    for (int gi = 0; gi < 4; ++gi) {
        const int g = w * 4 + gi;
        s5_load_u(z + (size_t)myrow * ZS + COL_S5 + g * 16, ust + lane * 16);
        f32x4 yacc[4];
#pragma unroll
        for (int mf = 0; mf < 4; ++mf) yacc[mf] = f32x4{0.f, 0.f, 0.f, 0.f};
#pragma unroll 1
        for (int d = 0; d < 2; ++d) {
            const int tix = ((l * 2 + d) * 16 + g) * 64 + lane;
            const float4 A = *reinterpret_cast<const float4*>((const float*)(p.ws + WS_S5A) + (size_t)tix * 4);
            const float* Bp = (const float*)(p.ws + WS_S5B) + (size_t)tix * 32;
            f32x2 bb[16];
#pragma unroll
            for (int h = 0; h < 16; ++h) bb[h] = f32x2{Bp[h], Bp[16 + h]};
            bf16x8 cfrag[4];
            {
                const float* crp = p.in(I_S5_CRE) + (size_t)((l * 2 + d) * 16 + g) * 1024 + fr * 64;
                const float* cip = p.in(I_S5_CIM) + (size_t)((l * 2 + d) * 16 + g) * 1024 + fr * 64;
#pragma unroll
                for (int ks = 0; ks < 4; ++ks) {
                    const int k0 = (ks & 1) * 32 + fq * 8;
                    const float* src = (ks < 2) ? crp + k0 : cip + k0;
                    const float sg = (ks < 2) ? 1.f : -1.f;
                    const float4 c0 = *reinterpret_cast<const float4*>(src), c1 = *reinterpret_cast<const float4*>(src + 4);
                    cfrag[ks][0] = (short)f2bf(sg * c0.x); cfrag[ks][1] = (short)f2bf(sg * c0.y); cfrag[ks][2] = (short)f2bf(sg * c0.z); cfrag[ks][3] = (short)f2bf(sg * c0.w);
                    cfrag[ks][4] = (short)f2bf(sg * c1.x); cfrag[ks][5] = (short)f2bf(sg * c1.y); cfrag[ks][6] = (short)f2bf(sg * c1.z); cfrag[ks][7] = (short)f2bf(sg * c1.w);
                }
            }
            const int cc = d ? ((tc < 4) ? 3 - tc : 71 - tc) : tc;
            float xr = 0.f, xi = 0.f;
            {
                const float* st = (const float*)(p.ws + WS_S5ST) + ((((size_t)(b * NCHUNK) * 2 + d) * 16 + g) * 64 + lane) * 2;
                for (int c0 = 0; c0 < cc; c0 += 8) {
                    float2 sv[8];
#pragma unroll
                    for (int q = 0; q < 8; ++q) {
                        const int c2 = (c0 + q < cc) ? c0 + q : cc - 1;
                        sv[q] = *reinterpret_cast<const float2*>(st + (size_t)c2 * (2 * 16 * 64 * 2));
                    }
#pragma unroll
                    for (int q = 0; q < 8; ++q) {
                        if (c0 + q < cc) {
                            const float nr = A.z * xr - A.w * xi + sv[q].x;
                            const float ni = A.z * xi + A.w * xr + sv[q].y;
                            xr = nr; xi = ni;
                        }
                    }
                }
            }
#pragma unroll 1
            for (int hf = 0; hf < 2; ++hf) {
                const int hbase = (d ? 1 - hf : hf) * 32;
#pragma unroll 4
                for (int s = 0; s < 32; ++s) {
                    const int il = d ? 31 - s : s;
                    const float* up = ust + (hbase + il) * 16;
                    f32x2 bu = f32x2{0.f, 0.f};
#pragma unroll
                    for (int h4 = 0; h4 < 4; ++h4) {
                        const float4 uu = *reinterpret_cast<const float4*>(up + h4 * 4);
                        bu += bb[h4 * 4] * uu.x + bb[h4 * 4 + 1] * uu.y + bb[h4 * 4 + 2] * uu.z + bb[h4 * 4 + 3] * uu.w;
                    }
                    const float nr = A.x * xr - A.y * xi + bu.x;
                    const float ni = A.x * xi + A.y * xr + bu.y;
                    xr = nr; xi = ni;
                    *reinterpret_cast<bf16_t*>(xbuf + il * 272 + lane * 2) = f2bf(xr);
                    *reinterpret_cast<bf16_t*>(xbuf + il * 272 + 128 + lane * 2) = f2bf(xi);
                }
#pragma unroll
                for (int mfl = 0; mfl < 2; ++mfl) {
                    f32x4 acc = yacc[0];
                    const int mf = (hbase >> 4) + mfl;
                    acc = (mf == 0) ? yacc[0] : (mf == 1) ? yacc[1] : (mf == 2) ? yacc[2] : yacc[3];
#pragma unroll
                    for (int ks = 0; ks < 4; ++ks) {
                        const bf16x8 af = *reinterpret_cast<const bf16x8*>(xbuf + (mfl * 16 + fr) * 272 + ks * 64 + fq * 16);
                        acc = __builtin_amdgcn_mfma_f32_16x16x32_bf16(af, cfrag[ks], acc, 0, 0, 0);
                    }
                    if (mf == 0) yacc[0] = acc; else if (mf == 1) yacc[1] = acc; else if (mf == 2) yacc[2] = acc; else yacc[3] = acc;
                }
            }
        }
#pragma unroll
        for (int mf = 0; mf < 4; ++mf)
#pragma unroll
            for (int j = 0; j < 4; ++j) yst[(mf * 16 + fq * 4 + j) * 16 + fr] = yacc[mf][j];
        {
            const float* dsk = p.in(I_S5_D) + l * 256 + g * 16;
            unsigned pk[8];
#pragma unroll
            for (int h = 0; h < 16; h += 2) {
                float y0 = yst[lane * 16 + h] + ust[lane * 16 + h] * dsk[h];
                float y1 = yst[lane * 16 + h + 1] + ust[lane * 16 + h + 1] * dsk[h + 1];
                y0 = 0.5f * y0 * (1.f + erff(y0 * 0.70710678118f));
                y1 = 0.5f * y1 * (1.f + erff(y1 * 0.70710678118f));
                pk[h >> 1] = pack2(y0, y1);
            }
            uint4* dst = reinterpret_cast<uint4*>(z + (size_t)myrow * ZS + COL_S5 + g * 16);
            dst[0] = make_uint4(pk[0], pk[1], pk[2], pk[3]);
            dst[1] = make_uint4(pk[4], pk[5], pk[6], pk[7]);
        }
    }
}

#define SB 16
__device__ __forceinline__ int scan_chain_row(int b, int d, int q) {
    if (q < 256) return b * 256 + (d ? 255 - q : q);
    const int t = q - 256;
    return NTC + b * 4096 + (d ? 4095 - t : t);
}
struct ScanRaw { uint2 r, k, v, e, a; float f0, f1; };

__device__ __forceinline__ void scan_load(const P& p, int m, int b, int h, int d, int q, int cg, ScanRaw& R) {
    const int row = scan_chain_row(b, d, q);
    const int c0 = h * 64 + cg * 4;
    if (m == 0) {
        const bf16_t* z = (const bf16_t*)(p.ws + WS_Z) + (size_t)row * ZS + c0;
        R.r = *reinterpret_cast<const uint2*>(z);
        R.k = *reinterpret_cast<const uint2*>(z + 256);
        R.v = *reinterpret_cast<const uint2*>(z + 512);
        const bf16_t* rw = (const bf16_t*)(p.ws + WS_R1 + R1_RWP) + (size_t)row * 1024 + c0;
        R.e = *reinterpret_cast<const uint2*>(rw + d * 256);
        R.a = *reinterpret_cast<const uint2*>(rw + (2 + d) * 256);
        R.f0 = ((const float*)(p.ws + WS_KNORM))[(size_t)row * 4 + h];
        R.f1 = 0.f;
    } else {
        const bf16_t* gq = (const bf16_t*)(p.ws + WS_R1 + R1_GQ) + (size_t)row * 768 + c0;
        R.r = *reinterpret_cast<const uint2*>(gq);
        R.k = *reinterpret_cast<const uint2*>(gq + 256);
        R.v = *reinterpret_cast<const uint2*>(gq + 512);
        R.e = make_uint2(0u, 0u); R.a = make_uint2(0u, 0u);
        const float* gab = (const float*)(p.ws + WS_GAB) + (size_t)row * 16;
        R.f0 = gab[d * 4 + h];
        R.f1 = gab[8 + d * 4 + h];
    }
}
__device__ __forceinline__ void scan_store(int m, const ScanRaw& R, float* dst  , const float (&kkp)[4], const float (&kap)[4]) {
    float r[4] = {bflo(R.r.x), bfhi(R.r.x), bflo(R.r.y), bfhi(R.r.y)};
    float k[4] = {bflo(R.k.x), bfhi(R.k.x), bflo(R.k.y), bfhi(R.k.y)};
    float v[4] = {bflo(R.v.x), bfhi(R.v.x), bflo(R.v.y), bfhi(R.v.y)};
    float ww[4], aa[4], bb[4], kk[4];
    if (m == 0) {
        float e[4] = {bflo(R.e.x), bfhi(R.e.x), bflo(R.e.y), bfhi(R.e.y)};
        float a[4] = {bflo(R.a.x), bfhi(R.a.x), bflo(R.a.y), bfhi(R.a.y)};
#pragma unroll
        for (int i = 0; i < 4; ++i) {
            ww[i] = __expf(-e[i]);
            kk[i] = k[i] * (1.f + (a[i] - 1.f) * kap[i]);
            const float kn = k[i] * kkp[i] * R.f0;
            aa[i] = -kn;
            bb[i] = kn * a[i];
        }
    } else {
        const float al = R.f0, be = R.f1;
#pragma unroll
        for (int i = 0; i < 4; ++i) { ww[i] = al; aa[i] = k[i]; bb[i] = -al * be * k[i]; kk[i] = be * k[i]; }
    }
    *reinterpret_cast<float4*>(dst + 0 * 64) = make_float4(ww[0], ww[1], ww[2], ww[3]);
    *reinterpret_cast<float4*>(dst + 1 * 64) = make_float4(aa[0], aa[1], aa[2], aa[3]);
    *reinterpret_cast<float4*>(dst + 2 * 64) = make_float4(bb[0], bb[1], bb[2], bb[3]);
    *reinterpret_cast<float4*>(dst + 3 * 64) = make_float4(kk[0], kk[1], kk[2], kk[3]);
    *reinterpret_cast<float4*>(dst + 4 * 64) = make_float4(r[0], r[1], r[2], r[3]);
    *reinterpret_cast<float4*>(dst + 5 * 64) = make_float4(v[0], v[1], v[2], v[3]);
}

__device__ __forceinline__ void scan_unit(const P& p, int l, int u, char* lds) {
    const int tid = otid();
    const int chain = u >> 1, half = u & 1;
    const int m = chain >> 6, rem = chain & 63, b = rem >> 3, h = (rem >> 1) & 3, d = rem & 1;
    float* buf = (float*)lds;
    float* ybuf = buf + 2 * SB * 384;
    const int rp = tid >> 4, sub = tid & 15;
    const int st = tid >> 4, cg = tid & 15;
    float kkp[4], kap[4];
#pragma unroll
    for (int i = 0; i < 4; ++i) { kkp[i] = p.in(I_RW_KK)[l * 256 + h * 64 + cg * 4 + i]; kap[i] = p.in(I_RW_KA)[l * 256 + h * 64 + cg * 4 + i]; }
    bf16_t* ys = (bf16_t*)(p.ws + WS_HBY) + (size_t)(m * 2 + d) * NT * 256;
    f32x2 S2[4];
#pragma unroll
    for (int j = 0; j < 4; ++j) S2[j] = f32x2{0.f, 0.f};
    ScanRaw R, R2;
    scan_load(p, m, b, h, d, st, cg, R);
    scan_store(m, R, buf + (st * 6) * 64 + cg * 4, kkp, kap);
    scan_load(p, m, b, h, d, SB + st, cg, R);
    __syncthreads();
    const int NB = 4352 / SB;
    __builtin_amdgcn_s_setprio(2);
    auto batch = [&](int bt, ScanRaw& Rld, ScanRaw& Rst) {
        const int par = bt & 1;
        if (bt + 2 < NB) scan_load(p, m, b, h, d, (bt + 2) * SB + st, cg, Rld);
        const float* cb = buf + par * (SB * 384);
        float* yb = ybuf + par * (SB * 32);
        {
            const float* sb0 = cb + sub * 4;
            const float* vb0 = cb + 320 + half * 32 + rp;
            float4 nw = *reinterpret_cast<const float4*>(sb0), na = *reinterpret_cast<const float4*>(sb0 + 64), nb = *reinterpret_cast<const float4*>(sb0 + 128);
            float4 nk = *reinterpret_cast<const float4*>(sb0 + 192), nr = *reinterpret_cast<const float4*>(sb0 + 256);
            float nvA = vb0[0], nvB = vb0[16];
#pragma unroll
            for (int s = 0; s < SB; ++s) {
                const float4 w = nw, a = na, bq = nb, k = nk, r = nr;
                const float vA = nvA, vB = nvB;
                if (s + 1 < SB) {
                    const float* sb = sb0 + (s + 1) * 384;
                    nw = *reinterpret_cast<const float4*>(sb); na = *reinterpret_cast<const float4*>(sb + 64); nb = *reinterpret_cast<const float4*>(sb + 128);
                    nk = *reinterpret_cast<const float4*>(sb + 192); nr = *reinterpret_cast<const float4*>(sb + 256);
                    nvA = vb0[(s + 1) * 384]; nvB = vb0[(s + 1) * 384 + 16];
                }
                __builtin_amdgcn_sched_barrier(0);
                const f32x2 v2 = {vA, vB};
                f32x2 sa2 = (S2[0] * a.x + S2[1] * a.y) + (S2[2] * a.z + S2[3] * a.w);
                float sa = sa2.x, sb2 = sa2.y;
                sa += dppf<0xB1>(sa); sb2 += dppf<0xB1>(sb2);
                sa += dppf<0x4E>(sa); sb2 += dppf<0x4E>(sb2);
                sa += dppf<0x141>(sa); sb2 += dppf<0x141>(sb2);
                sa += dppf<0x140>(sa); sb2 += dppf<0x140>(sb2);
                sa2.x = sa; sa2.y = sb2;
                S2[0] = S2[0] * w.x + sa2 * bq.x + v2 * k.x;
                S2[1] = S2[1] * w.y + sa2 * bq.y + v2 * k.y;
                S2[2] = S2[2] * w.z + sa2 * bq.z + v2 * k.z;
                S2[3] = S2[3] * w.w + sa2 * bq.w + v2 * k.w;
                const f32x2 y2 = (S2[0] * r.x + S2[1] * r.y) + (S2[2] * r.z + S2[3] * r.w);
                float yA = y2.x, yB = y2.y;
                yA += dppf<0xB1>(yA); yB += dppf<0xB1>(yB);
                yA += dppf<0x4E>(yA); yB += dppf<0x4E>(yB);
                yA += dppf<0x141>(yA); yB += dppf<0x141>(yB);
                yA += dppf<0x140>(yA); yB += dppf<0x140>(yB);
                yb[s * 32 + rp] = yA; yb[s * 32 + 16 + rp] = yB;
            }
        }
        if (bt + 1 < NB) scan_store(m, Rst, buf + (1 - par) * (SB * 384) + (st * 6) * 64 + cg * 4, kkp, kap);
        __syncthreads();
        {
            const int r2 = cg * 2;
            const int row = scan_chain_row(b, d, bt * SB + st);
            const unsigned pk = pack2(yb[st * 32 + r2], yb[st * 32 + r2 + 1]);
            *reinterpret_cast<unsigned*>(ys + (size_t)row * 256 + h * 64 + half * 32 + r2) = pk;
        }
    };
#pragma unroll 1
    for (int bt = 0; bt < NB; bt += 2) { batch(bt, R2, R); batch(bt + 1, R, R2); }
    __builtin_amdgcn_s_setprio(0);
    __syncthreads();
}

template <int L>
__device__ __forceinline__ void hyena_unit(const P& p, int l, int u, char* lds) {
    constexpr int TPT = L / 256;
    const int tid = otid();
    const int c = u >> 2, bp = u & 3;
    float2* u2 = (float2*)lds;
    float* taps = (float*)(lds + (size_t)L * 8);
    const bf16_t* z = (const bf16_t*)(p.ws + WS_Z);
    bf16_t* cat = (bf16_t*)(p.ws + WS_CAT);
    const float* F = (L == 4096) ? (const float*)(p.ws + WS_FILTL) : (const float*)(p.ws + WS_FILTC);
    int base[2];
#pragma unroll
    for (int bb = 0; bb < 2; ++bb) { const int b = bp * 2 + bb; base[bb] = (L == 4096) ? NTC + b * 4096 : b * 256; }
    const int t0 = tid * TPT;
    const float* cw = p.in(I_HY_CONV) + (size_t)l * 3 * 768; const float* cb = p.in(I_HY_CONVB) + (size_t)l * 768;
    auto sconv = [&](int part, int bb, float (&o)[TPT]) {
        const int ch = part * 256 + c;
        const float w0 = cw[ch], w1 = cw[768 + ch], w2 = cw[1536 + ch], bs = cb[ch];
        const bf16_t* zc = z + (size_t)base[bb] * ZS + COL_HY + ch;
        float xm = (t0 > 0) ? bf2f(zc[(size_t)(t0 - 1) * ZS]) : 0.f;
        float x0 = bf2f(zc[(size_t)t0 * ZS]);
#pragma unroll
        for (int i = 0; i < TPT; ++i) {
            const int t = t0 + i;
            const float xp = (t + 1 < L) ? bf2f(zc[(size_t)(t + 1) * ZS]) : 0.f;
            o[i] = w0 * xm + w1 * x0 + w2 * xp + bs;
            xm = x0; x0 = xp;
        }
    };
    {
        float v0[TPT], v1[TPT];
        sconv(2, 0, v0); sconv(2, 1, v1);
#pragma unroll
        for (int i = 0; i < TPT; ++i) u2[t0 + i] = make_float2(v0[i], v1[i]);
    }
#pragma unroll 1
    for (int o = 0; o < 2; ++o) {
        const float* hf = F + ((size_t)(o * 2 + 0) * 256 + c) * L;
        const float* hbk = F + ((size_t)(o * 2 + 1) * 256 + c) * L;
        for (int k = tid; k < 2 * L; k += NTHREADS) {
            const int dd = k - (L - 1);
            taps[k] = (dd >= L) ? 0.f : (dd >= 0 ? hf[dd] : hbk[-dd]);
        }
        __syncthreads();
        float acc[TPT][2];
#pragma unroll
        for (int i = 0; i < TPT; ++i) { acc[i][0] = 0.f; acc[i][1] = 0.f; }
        if (L == 4096) {
#pragma unroll 1
            for (int s0 = 0; s0 < L; s0 += 16) {
                const int k0 = t0 - s0 + (L - 16);
                float W[32];
#pragma unroll
                for (int q = 0; q < 8; ++q) {
                    const float4 t4 = *reinterpret_cast<const float4*>(taps + k0 + q * 4);
                    W[q * 4] = t4.x; W[q * 4 + 1] = t4.y; W[q * 4 + 2] = t4.z; W[q * 4 + 3] = t4.w;
                }
#pragma unroll
                for (int j = 0; j < 16; ++j) {
                    const float2 uj = u2[s0 + j];
#pragma unroll
                    for (int i = 0; i < TPT; ++i) {
                        const float wv = W[(i - j + 15) & 31];
                        acc[i][0] += wv * uj.x; acc[i][1] += wv * uj.y;
                    }
                }
            }
        } else {
            for (int s = 0; s < L; ++s) {
                const float2 uj = u2[s];
                const float wv = taps[t0 - s + (L - 1)];
                acc[0][0] += wv * uj.x; acc[0][1] += wv * uj.y;
            }
        }
        const float sk = p.in(I_HY_SKIP)[(size_t)(l * 2 + o) * 256 + c];
        float res[TPT][2];
        {
            float g0[TPT], g1[TPT];
            sconv(o, 0, g0); sconv(o, 1, g1);
#pragma unroll
            for (int i = 0; i < TPT; ++i) {
                const float2 ut = u2[t0 + i];
                res[i][0] = g0[i] * (acc[i][0] + sk * ut.x);
                res[i][1] = g1[i] * (acc[i][1] + sk * ut.y);
            }
        }
        __syncthreads();
        if (o == 0) {
#pragma unroll
            for (int i = 0; i < TPT; ++i) u2[t0 + i] = make_float2(res[i][0], res[i][1]);
        } else {
#pragma unroll
            for (int i = 0; i < TPT; ++i) {
                cat[(size_t)(base[0] + t0 + i) * DM + 512 + c] = f2bf(res[i][0]);
                cat[(size_t)(base[1] + t0 + i) * DM + 512 + c] = f2bf(res[i][1]);
            }
        }
        __syncthreads();
    }
}


#define FFT_BS 272
__device__ __forceinline__ int fphys(int d2, int d1, int d0) { return d2 * FFT_BS + d1 * 17 + d0; }
__device__ __forceinline__ float2 cmulf(float2 a, float2 b) { return make_float2(a.x * b.x - a.y * b.y, a.x * b.y + a.y * b.x); }
__device__ static constexpr float C32T[16] = {1.000000000e+00f, 9.807852804e-01f, 9.238795325e-01f, 8.314696123e-01f, 7.071067812e-01f, 5.555702330e-01f, 3.826834324e-01f, 1.950903220e-01f, 6.123233996e-17f, -1.950903220e-01f, -3.826834324e-01f, -5.555702330e-01f, -7.071067812e-01f, -8.314696123e-01f, -9.238795325e-01f, -9.807852804e-01f};
__device__ static constexpr float S32T[16] = {0.000000000e+00f, 1.950903220e-01f, 3.826834324e-01f, 5.555702330e-01f, 7.071067812e-01f, 8.314696123e-01f, 9.238795325e-01f, 9.807852804e-01f, 1.000000000e+00f, 9.807852804e-01f, 9.238795325e-01f, 8.314696123e-01f, 7.071067812e-01f, 5.555702330e-01f, 3.826834324e-01f, 1.950903220e-01f};
template <int LOG> __device__ __forceinline__ constexpr int brev(int i) { int r = 0; for (int b = 0; b < LOG; ++b) r |= ((i >> b) & 1) << (LOG - 1 - b); return r; }
template <int R, bool INV> __device__ __forceinline__ void dftR(float2 (&v)[R]) {
    constexpr int LOG = (R == 32) ? 5 : 4;
    float2 t[R];
#pragma unroll
    for (int i = 0; i < R; ++i) t[brev<LOG>(i)] = v[i];
#pragma unroll
    for (int st = 1; st <= LOG; ++st) {
        const int len = 1 << st, half = len >> 1;
#pragma unroll
        for (int i = 0; i < R; i += len)
#pragma unroll
            for (int j = 0; j < half; ++j) {
                const int tw = j * (32 / len);
                const float2 a = t[i + j], b = t[i + j + half];
                float2 bw;
                if (tw == 0) bw = b;
                else if (tw == 8) bw = INV ? make_float2(-b.y, b.x) : make_float2(b.y, -b.x);
                else { const float wr = C32T[tw], wi = INV ? S32T[tw] : -S32T[tw]; bw = make_float2(b.x * wr - b.y * wi, b.x * wi + b.y * wr); }
                t[i + j] = make_float2(a.x + bw.x, a.y + bw.y);
                t[i + j + half] = make_float2(a.x - bw.x, a.y - bw.y);
            }
    }
#pragma unroll
    for (int i = 0; i < R; ++i) v[i] = t[i];
}
template <int R> __device__ __forceinline__ void twiddle_pow(float2 (&v)[R], float2 first, float2 base) {
    float2 w = first;
#pragma unroll
    for (int k = 0; k < R; ++k) { v[k] = cmulf(v[k], w); w = cmulf(w, base); }
}
__device__ __forceinline__ float2 cispi(float x) { float sn, cs; sincospif(x, &sn, &cs); return make_float2(cs, sn); }

__device__ __forceinline__ void fft_fwd_A_B1(float2 (&v)[32], float2* buf, int tid_in) {
    int tid = tid_in; asm volatile("" : "+v"(tid));
    const int a = tid >> 4, b = tid & 15;
    dftR<32, false>(v);
    twiddle_pow<32>(v, make_float2(1.f, 0.f), cispi(-2.f * (float)tid * (1.f / 8192.f)));
#pragma unroll
    for (int k1 = 0; k1 < 32; ++k1) buf[fphys(k1, a, b)] = v[k1];
    __syncthreads();
#pragma unroll 1
    for (int j = 0; j < 2; ++j) {
        const int g = tid + 256 * j, k1 = g >> 4, bb = g & 15;
        float2 w[16];
#pragma unroll
        for (int aa = 0; aa < 16; ++aa) w[aa] = buf[fphys(k1, aa, bb)];
        dftR<16, false>(w);
        twiddle_pow<16>(w, make_float2(1.f, 0.f), cispi(-2.f * (float)bb * (1.f / 256.f)));
#pragma unroll
        for (int ka = 0; ka < 16; ++ka) buf[fphys(k1, ka, bb)] = w[ka];
    }
    __syncthreads();
}
__device__ __forceinline__ void fft_inv_B1_A(float2 (&v)[32], float2* buf, int tid_in) {
    int tid = tid_in; asm volatile("" : "+v"(tid));
#pragma unroll 1
    for (int j = 0; j < 2; ++j) {
        const int g = tid + 256 * j, k1 = g >> 4, bb = g & 15;
        float2 w[16];
#pragma unroll
        for (int ka = 0; ka < 16; ++ka) w[ka] = buf[fphys(k1, ka, bb)];
        dftR<16, true>(w);
        twiddle_pow<16>(w, cispi(2.f * (float)(k1 * bb) * (1.f / 8192.f)), cispi(2.f * (float)k1 * (1.f / 512.f)));
#pragma unroll
        for (int aa = 0; aa < 16; ++aa) buf[fphys(k1, aa, bb)] = w[aa];
    }
    __syncthreads();
    const int a = tid >> 4, b = tid & 15;
#pragma unroll
    for (int k1 = 0; k1 < 32; ++k1) v[k1] = buf[fphys(k1, a, b)];
    dftR<32, true>(v);
}

__device__ __forceinline__ void hfft_unit(const P& p, int l, int u, char* lds) {
    const int tid = otid();
    float2* buf = (float2*)lds;
    float* F = (float*)(p.ws + WS_FILTL) + (size_t)u * 8192;
    float2 v[32];
#pragma unroll
    for (int n1 = 0; n1 < 32; ++n1) {
        const int n = 256 * n1 + tid;
        float x;
        if (n1 < 16) x = F[n];
        else x = (n == 4096) ? 0.f : F[4096 + (8192 - n)];
        if (n == 0) x += p.in(I_HY_SKIP)[(size_t)l * 512 + u];
        v[n1] = make_float2(x, 0.f);
    }
    fft_fwd_A_B1(v, buf, tid);
    __half2* H = (__half2*)F;
#pragma unroll 1
    for (int j = 0; j < 2; ++j) {
        const int g = tid + 256 * j, k1 = g >> 4, ka = g & 15;
        float2 w[16];
#pragma unroll
        for (int bb = 0; bb < 16; ++bb) w[bb] = buf[fphys(k1, ka, bb)];
        dftR<16, false>(w);
        unsigned pk[16];
#pragma unroll
        for (int kb = 0; kb < 16; ++kb) { const __half2 h = __floats2half2_rn(w[kb].x, w[kb].y); pk[kb] = *reinterpret_cast<const unsigned*>(&h); }
        uint4* dst = reinterpret_cast<uint4*>(H + (size_t)g * 16);
        dst[0] = make_uint4(pk[0], pk[1], pk[2], pk[3]); dst[1] = make_uint4(pk[4], pk[5], pk[6], pk[7]);
        dst[2] = make_uint4(pk[8], pk[9], pk[10], pk[11]); dst[3] = make_uint4(pk[12], pk[13], pk[14], pk[15]);
    }
    __syncthreads();
}

__device__ __forceinline__ void hyena_prep_unit(const P& p, int l, int u, char* lds) {
    const int tid = otid();
    bf16_t* tile = (bf16_t*)lds;
    const int b = u >> 6, t0 = (u & 63) * 64;
    const bf16_t* z = (const bf16_t*)(p.ws + WS_Z) + (size_t)(NTC + b * 4096) * ZS + COL_HY;
    bf16_t* hyT = (bf16_t*)(p.ws + WS_HYT);
    const float* cw = p.in(I_HY_CONV) + (size_t)l * 3 * 768; const float* cb = p.in(I_HY_CONVB) + (size_t)l * 768;
#pragma unroll 1
    for (int part = 0; part < 3; ++part) {
        const int ch = part * 256 + tid;
        const float w0 = cw[ch], w1 = cw[768 + ch], w2 = cw[1536 + ch], bs = cb[ch];
        const bf16_t* zc = z + ch;
        float xm = (t0 > 0) ? bf2f(zc[(size_t)(t0 - 1) * ZS]) : 0.f;
        float x0 = bf2f(zc[(size_t)t0 * ZS]);
#pragma unroll 8
        for (int i = 0; i < 64; ++i) {
            const int t = t0 + i;
            const float xp = (t + 1 < 4096) ? bf2f(zc[(size_t)(t + 1) * ZS]) : 0.f;
            tile[tid * 72 + i] = f2bf(w0 * xm + w1 * x0 + w2 * xp + bs);
            xm = x0; x0 = xp;
        }
        __syncthreads();
#pragma unroll
        for (int k = 0; k < 8; ++k) {
            const int chl = (tid >> 3) + 32 * k, seg = tid & 7;
            const uint4 val = *reinterpret_cast<const uint4*>(tile + chl * 72 + seg * 8);
            *reinterpret_cast<uint4*>(hyT + ((size_t)(b * 3 + part) * 256 + chl) * 4096 + t0 + seg * 8) = val;
        }
        __syncthreads();
    }
}

template <int O>
__device__ __forceinline__ void hyena_conv_pass(const P& p, int c, int bp, int tid, float2 (&v)[32], float2* buf) {
    const bf16_t* hyT = (const bf16_t*)(p.ws + WS_HYT);
#pragma unroll
    for (int j = 16; j < 32; ++j) v[j] = make_float2(0.f, 0.f);
    fft_fwd_A_B1(v, buf, tid);
    const __half2* H = (const __half2*)((const float*)(p.ws + WS_FILTL) + (size_t)(O * 256 + c) * 8192);
    int tm = tid; asm volatile("" : "+v"(tm));
#pragma unroll 1
    for (int j = 0; j < 2; ++j) {
        const int g = tm + 256 * j, k1 = g >> 4, ka = g & 15;
        float2 w[16];
#pragma unroll
        for (int bb = 0; bb < 16; ++bb) w[bb] = buf[fphys(k1, ka, bb)];
        dftR<16, false>(w);
        const uint4* hp = reinterpret_cast<const uint4*>(H + (size_t)g * 16);
        unsigned hk[16];
#pragma unroll
        for (int q = 0; q < 4; ++q) { const uint4 t4 = hp[q]; hk[q * 4] = t4.x; hk[q * 4 + 1] = t4.y; hk[q * 4 + 2] = t4.z; hk[q * 4 + 3] = t4.w; }
#pragma unroll
        for (int kb = 0; kb < 16; ++kb) { const float2 hf = __half22float2(*reinterpret_cast<const __half2*>(&hk[kb])); w[kb] = cmulf(w[kb], hf); }
        dftR<16, true>(w);
        twiddle_pow<16>(w, make_float2(1.f, 0.f), cispi(2.f * (float)ka * (1.f / 256.f)));
#pragma unroll
        for (int bb = 0; bb < 16; ++bb) buf[fphys(k1, ka, bb)] = w[bb];
    }
    __syncthreads();
    fft_inv_B1_A(v, buf, tid);
    asm volatile("" ::: "memory");
    int tq = tid; asm volatile("" : "+v"(tq));
    const bf16_t* g0 = hyT + ((size_t)((bp * 2 + 0) * 3 + O) * 256 + c) * 4096 + tq;
    const bf16_t* g1 = hyT + ((size_t)((bp * 2 + 1) * 3 + O) * 256 + c) * 4096 + tq;
    const float sc = 1.f / 8192.f;
#pragma unroll
    for (int j = 0; j < 16; ++j) {
        const float ga = bf2f(g0[256 * j]) * sc, gb = bf2f(g1[256 * j]) * sc;
        v[j] = make_float2(ga * v[j].x, gb * v[j].y);
    }
    __syncthreads();
}

__device__ __forceinline__ void hyena_fft_unit(const P& p, int l, int u, char* lds) {
    const int tid = otid();
    const int c = u >> 2, bp = u & 3;
    float2* buf = (float2*)lds;
    const bf16_t* hyT = (const bf16_t*)(p.ws + WS_HYT);
    bf16_t* cat = (bf16_t*)(p.ws + WS_CAT);
    float2 v[32];
    {
        const bf16_t* v0p = hyT + ((size_t)((bp * 2 + 0) * 3 + 2) * 256 + c) * 4096 + tid;
        const bf16_t* v1p = hyT + ((size_t)((bp * 2 + 1) * 3 + 2) * 256 + c) * 4096 + tid;
#pragma unroll
        for (int j = 0; j < 16; ++j) v[j] = make_float2(bf2f(v0p[256 * j]), bf2f(v1p[256 * j]));
    }
    hyena_conv_pass<0>(p, c, bp, tid, v, buf);
    hyena_conv_pass<1>(p, c, bp, tid, v, buf);
    int tq = tid; asm volatile("" : "+v"(tq));
#pragma unroll
    for (int j = 0; j < 16; ++j) {
        const int t = tq + 256 * j;
        cat[(size_t)(NTC + (bp * 2 + 0) * 4096 + t) * DM + 512 + c] = f2bf(v[j].x);
        cat[(size_t)(NTC + (bp * 2 + 1) * 4096 + t) * DM + 512 + c] = f2bf(v[j].y);
    }
}

__device__ __forceinline__ void rwkv_post_unit(const P& p, int l, int u, char* lds) {
    const int tid = otid(), c = tid;
    float* sg = (float*)lds;
    const bf16_t* z = (const bf16_t*)(p.ws + WS_Z);
    const bf16_t* rwp = (const bf16_t*)(p.ws + WS_R1 + R1_RWP);
    const bf16_t* ys = (const bf16_t*)(p.ws + WS_HBY);
    bf16_t* cat = (bf16_t*)(p.ws + WS_CAT);
    const int row0 = u * 32;
#pragma unroll
    for (int i = 0; i < 8; ++i) {
        const int idx = tid + 256 * i, tok = idx >> 6, j = idx & 63;
        sg[idx] = sigm(bf2f(z[(size_t)(row0 + tok) * ZS + 896 + j]));
    }
    __syncthreads();
    float g2r[64];
#pragma unroll
    for (int r = 0; r < 64; ++r) g2r[r] = p.in(I_RW_G2)[(size_t)(l * 64 + r) * 256 + c];
    const float ka = p.in(I_RW_KA)[l * 256 + c], rk = p.in(I_RW_RK)[l * 256 + c];
    const float gng = p.in(I_RW_GNG)[l * 256 + c], gnb = p.in(I_RW_GNB)[l * 256 + c];
#pragma unroll 2
    for (int tok = 0; tok < 32; ++tok) {
        const int row = row0 + tok;
        float g = 0.f;
#pragma unroll
        for (int r = 0; r < 64; r += 4) {
            const float4 x = *reinterpret_cast<const float4*>(sg + tok * 64 + r);
            g += x.x * g2r[r] + x.y * g2r[r + 1] + x.z * g2r[r + 2] + x.w * g2r[r + 3];
        }
        const float y = bf2f(ys[(size_t)row * 256 + c]) + bf2f(ys[(size_t)NT * 256 + (size_t)row * 256 + c]);
        const float mu = wave_sum(y) * (1.f / 64.f);
        const float dv = y - mu;
        const float var = wave_sum(dv * dv) * (1.f / 64.f);
        const float yn = dv * rsqrtf(var + 64e-5f) * gng + gnb;
        const bf16_t* zr = z + (size_t)row * ZS;
        const float r = bf2f(zr[c]), k = bf2f(zr[256 + c]), v = bf2f(zr[512 + c]);
        const float a0 = bf2f(rwp[((size_t)row * 4 + 2) * 256 + c]), a1 = bf2f(rwp[((size_t)row * 4 + 3) * 256 + c]);
        const float kd = k * (1.f + (a0 - 1.f) * ka) + k * (1.f + (a1 - 1.f) * ka);
        const float dot = wave_sum(r * kd * rk);
        cat[(size_t)row * DM + c] = f2bf((yn + dot * v) * g);
    }
    __syncthreads();
}

__device__ __forceinline__ void gdn_post_unit(const P& p, int l, int u) {
    const int tid = otid(), c = tid;
    const bf16_t* z = (const bf16_t*)(p.ws + WS_Z);
    const bf16_t* ys = (const bf16_t*)(p.ws + WS_HBY) + (size_t)2 * NT * 256;
    bf16_t* cat = (bf16_t*)(p.ws + WS_CAT);
    const float ng = p.in(I_GD_NORM)[l * 64 + (c & 63)];
    const int row0 = u * 32;
#pragma unroll 4
    for (int tok = 0; tok < 32; ++tok) {
        const int row = row0 + tok;
        const float o = bf2f(ys[(size_t)row * 256 + c]) + bf2f(ys[(size_t)NT * 256 + (size_t)row * 256 + c]);
        const float ms = wave_sum(o * o) * (1.f / 64.f);
        const float zg = bf2f(z[(size_t)row * ZS + COL_GD + 768 + c]);
        cat[(size_t)row * DM + 256 + c] = f2bf(o * rsqrtf(ms + 1e-6f) * ng * siluf(zg));
    }
}


__device__ __forceinline__ void load_tile_bases(unsigned* ctl, int l, int* tb) {
    const int tid = otid();
    __syncthreads();
    if (tid < 64) tb[66 + tid] = ((int)xb_ld(&ctl[CW_CNT(l) + tid]) + 127) >> 7;
    __syncthreads();
    if (tid == 0) { int a = 0; for (int e = 0; e < 64; ++e) { tb[e] = a; a += tb[66 + e]; } tb[64] = a; }
    __syncthreads();
}

#define NPHASE 36
template <typename F>
__device__ __forceinline__ void strided(int n, F f) { for (int u = blockIdx.x; u < n; u += gridDim.x) f(u); }

__global__ void __launch_bounds__(NTHREADS, 2) fwd_kernel(KP kp) {
    extern __shared__ __attribute__((aligned(16))) char smem[];
    char* lds = smem + LDS_USER;
    {
    const int tid = otid();
    if (tid == 0) *reinterpret_cast<uint4*>(smem) = make_uint4(0u, 0u, 0u, 0u);
    if (tid < 52) { const unsigned long long v = (unsigned long long)kp.in[tid]; ((unsigned*)(smem + 512))[2 * tid] = (unsigned)v; ((unsigned*)(smem + 512))[2 * tid + 1] = (unsigned)(v >> 32); }
    }
    __syncthreads();
    P p; p.tab = (const __attribute__((address_space(3))) unsigned*)(smem + 512); p.out = kp.out; p.ws = kp.ws;
    unsigned* ctl = (unsigned*)(p.ws + WS_CTL);
    XcdBarrier bar = xcd_barrier_post(ctl, (volatile LAS unsigned*)smem);
    const int lo = kp.ph_lo, hi = kp.ph_hi;
#define PHASE_BEGIN(ph) if ((ph) >= lo && (ph) < hi) { if ((ph) > lo) { xcd_barrier(bar); }
#define PHASE_END }
#define LANE_IDS const int tid = otid(); const int wid = tid >> 6, lane = tid & 63, wr = wid >> 1, wc = wid & 1, fr = lane & 15, fq = lane >> 4; (void)wid; (void)lane; (void)wr; (void)wc; (void)fr; (void)fq;

    PHASE_BEGIN(0)
        strided(192 + 64 + 32, [&](int u) {
            if (u < 192) ph0_mod_unit(p, u, lds);
            else if (u < 256) ph0_s5tab_unit(p, u - 192);
            else { const int v = u - 256, ll = v >> 4, t = v & 15;
                   xpose_tile(p.in(I_S5_GLUW) + (size_t)ll * 65536, 256, (bf16_t*)(p.ws + WS_GLUT) + (size_t)ll * 65536, 256, 0, t >> 2, t & 3, lds); }
        });
    PHASE_END

#pragma unroll 1
    for (int l = 0; l < 2; ++l) {
        const int pb = 1 + 17 * l;
        PHASE_BEGIN(pb + 0)
            strided(4352 + 1088 + 768 + 256, [&](int u) {
                if (u < 4352) { if (l == 0) rows_unit<M_INIT>(p, l, u, lds); else rows_unit<M_LN2NEXT>(p, l, u, lds); }
                else if (u < 5440) filt_unit(p, l, u - 4352, lds);
                else if (u < 6208) { const int v = u - 5440; xpose_tile(p.in(I_WIN) + (size_t)l * 1024 * 3024, 3024, (bf16_t*)(p.ws + WS_WINT), 1024, 0, v / 48, v % 48, lds); }
                else { const int v = u - 6208; xpose_tile(p.in(I_WOUT) + (size_t)l * 1024 * 1024, 1024, (bf16_t*)(p.ws + WS_WOUTT), 1024, 0, v >> 4, v & 15, lds); }
            });
        PHASE_END
        PHASE_BEGIN(pb + 1)
            strided(272 * 24, [&](int u) {
                LANE_IDS
                const int mt = u / 24, nt = u % 24;
                f32x4 acc[4][4];
                gemm_tile((const bf16_t*)(p.ws + WS_HBY), DM, arows_lin(mt * 128, tid),
                          (const bf16_t*)(p.ws + WS_WINT), DM, nt * 128, DM, lds, acc);
                bf16_t* z = (bf16_t*)(p.ws + WS_Z);
#pragma unroll
                for (int m = 0; m < 4; ++m)
#pragma unroll
                    for (int n = 0; n < 4; ++n) {
                        const int col = nt * 128 + wc * 64 + n * 16 + fr;
                        if (col < ZS) {
#pragma unroll
                            for (int j = 0; j < 4; ++j) z[(size_t)(mt * 128 + wr * 64 + m * 16 + fq * 4 + j) * ZS + col] = f2bf(acc[m][n][j]);
                        }
                    }
            });
        PHASE_END
        PHASE_BEGIN(pb + 2)
            strided(512 + 512 + 1088 + 1088 + 4352, [&](int u) {
                if (u < 512) { if (kp.rep == 0) hfft_unit(p, l, u, lds); }
                else if (u < 1024) hyena_prep_unit(p, l, u - 512, lds);
                else if (u < 2112) rwkv_prep_unit(p, l, u - 1024, lds);
                else if (u < 3200) gdn_prep_unit(p, l, u - 2112);
                else s5_pre_unit(p, l, u - 3200, lds);
            });
        PHASE_END
        PHASE_BEGIN(pb + 3)
            {
                int* qslot = (int*)(smem + 64);
                const int NO = 1024 + 544 + 1024;
                if (otid() == 0) {
                    const unsigned hw = (unsigned)__builtin_amdgcn_s_getreg((7 << 11) | (8 << 6) | 4);
                    const unsigned cuix = ((xb_xcc_id() & 15u) << 8) | (hw & 255u);
                    qslot[1] = (atomicAdd(&ctl[CW_CUCNT(l) + cuix], 1u) % 2u == 0u) ? 0 : 1;
                }
                __syncthreads();
                for (;;) {
                    if (otid() == 0) {
                        int stage = qslot[1], t = -1;
                        while (t < 0 && stage < 3) {
                            if (stage == 1) { const int q = (int)atomicAdd(&ctl[CW_QUEUE(l) + 16 + kp.rep], 1u); if (q < NO) t = 256 + (q < 544 ? 1024 + q : (q < 1568 ? q - 544 : q)); else stage = 2; }
                            else { const int q = (int)atomicAdd(&ctl[CW_QUEUE(l) + kp.rep], 1u); if (q < 256) t = q; else stage = (stage == 0) ? 1 : 3; }
                        }
                        qslot[1] = stage; qslot[0] = t;
                    }
                    __syncthreads();
                    const int u = qslot[0];
                    __syncthreads();
                    if (u < 0) break;
                    if (u < 256) { if (kp.rep != 2) scan_unit(p, l, u, lds); }
                    else if (kp.rep == 1) {}
                    else if (u < 1280) hyena_fft_unit(p, l, u - 256, lds);
                    else if (u < 1824) { if (kp.rep == 0) s5_main_unit(p, l, u - 1280, lds); }
                    else hyena_unit<256>(p, l, u - 1824, lds);
                    __syncthreads();
                }
            }
        PHASE_END
        PHASE_BEGIN(pb + 4)
            strided(1088 + 1088 + 544, [&](int u) {
                if (u < 1088) rwkv_post_unit(p, l, u, lds);
                else if (u < 2176) gdn_post_unit(p, l, u - 1088);
                else {
                    LANE_IDS
                    const int v = u - 2176, mt = v >> 1, nt = v & 1;
                    f32x4 acc[4][4];
                    const bf16_t* A = (const bf16_t*)(p.ws + WS_Z) + COL_S5;
                    gemm_tile(A, ZS, arows_lin(mt * 128, tid),
                              (const bf16_t*)(p.ws + WS_GLUT) + (size_t)l * 65536, 256, nt * 128, 256, lds, acc);
                    bf16_t* cat = (bf16_t*)(p.ws + WS_CAT);
#pragma unroll
                    for (int m = 0; m < 4; ++m)
#pragma unroll
                        for (int n = 0; n < 4; ++n) {
                            const int col = nt * 128 + wc * 64 + n * 16 + fr;
                            const float gb = p.in(I_S5_GLUB)[l * 256 + col];
#pragma unroll
                            for (int j = 0; j < 4; ++j) {
                                const int row = mt * 128 + wr * 64 + m * 16 + fq * 4 + j;
                                const float yg = bf2f(A[(size_t)row * ZS + col]);
                                cat[(size_t)row * DM + 768 + col] = f2bf(yg * sigm(acc[m][n][j] + gb));
                            }
                        }
                }
            });
        PHASE_END
        PHASE_BEGIN(pb + 5)
            strided(272 * 8 + 65 * 192, [&](int u) {
                if (u < 2176) {
                    LANE_IDS
                    const int mt = u >> 3, nt = u & 7;
                    f32x4 acc[4][4];
                    gemm_tile((const bf16_t*)(p.ws + WS_CAT), DM, arows_lin(mt * 128, tid),
                              (const bf16_t*)(p.ws + WS_WOUTT), DM, nt * 128, DM, lds, acc);
#pragma unroll
                    for (int m = 0; m < 4; ++m)
#pragma unroll
                        for (int j = 0; j < 4; ++j) {
                            const int row = mt * 128 + wr * 64 + m * 16 + fq * 4 + j;
                            float* xr = xrow(p, row);
                            const float* ga = modp(p, l, row_mod(row), 2);
#pragma unroll
                            for (int n = 0; n < 4; ++n) {
                                const int col = nt * 128 + wc * 64 + n * 16 + fr;
                                { const float ca = kp.rep ? 1.f : ALPHA, cb2 = kp.rep ? 0.f : 1.f; xr[col] = ca * xr[col] + cb2 * ga[col] * acc[m][n][j]; }
                            }
                        }
                } else {
                    const int v = u - 2176, e = v / 192, t = v % 192, which = t >> 6, tt = t & 63;
                    bf16_t* W13 = (bf16_t*)(p.ws + WS_R1 + R1_W13T) + (size_t)e * 512 * 1024;
                    bf16_t* W2 = (bf16_t*)(p.ws + WS_R1 + R1_W2T) + (size_t)e * 1024 * 256;
                    if (which == 0) {
                        const float* src = (e < 64) ? p.in(I_EX_W1) + ((size_t)l * 64 + e) * 262144 : p.in(I_SH_W1) + (size_t)l * 262144;
                        xpose_tile(src, 256, W13, 1024, 1, tt >> 2, tt & 3, lds);
                    } else if (which == 1) {
                        const float* src = (e < 64) ? p.in(I_EX_W3) + ((size_t)l * 64 + e) * 262144 : p.in(I_SH_W3) + (size_t)l * 262144;
                        xpose_tile(src, 256, W13, 1024, 2, tt >> 2, tt & 3, lds);
                    } else {
                        const float* src = (e < 64) ? p.in(I_EX_W2) + ((size_t)l * 64 + e) * 262144 : p.in(I_SH_W2) + (size_t)l * 262144;
                        xpose_tile(src, 1024, W2, 256, 0, tt >> 4, tt & 15, lds);
                    }
                }
            });
        PHASE_END
        PHASE_BEGIN(pb + 6)
            strided(4352, [&](int u) { rows_unit<M_LN1>(p, l, u, lds, kp.rep > 0); __syncthreads(); });
        PHASE_END
        PHASE_BEGIN(pb + 7)
            {
                int* tb = (int*)lds;
                const int tid = otid();
                const unsigned* cnt = ctl + CW_CNT(l);
                load_tile_bases(ctl, l, tb);
                const int* aep = (const int*)(p.ws + WS_AEP); const float* aw = (const float*)(p.ws + WS_AW);
                int* rtok = (int*)(p.ws + WS_RTOK); float* rwt = (float*)(p.ws + WS_RW); int* tile_e = (int*)(p.ws + WS_TILEE);
                for (int a = blockIdx.x * NTHREADS + tid; a < NT * 8; a += gridDim.x * NTHREADS) {
                    const unsigned v = (unsigned)aep[a];
                    const int e = v >> 24, pos = v & 0xFFFFFF;
                    const int dest = tb[e] * 128 + pos;
                    rtok[dest] = a >> 3; rwt[dest] = aw[a];
                }
                for (int e = blockIdx.x; e < 64; e += gridDim.x) {
                    const int c0 = (int)xb_ld((unsigned*)&cnt[e]), nt_e = (c0 + 127) >> 7;
                    for (int q = c0 + tid; q < nt_e * 128; q += NTHREADS) { rtok[tb[e] * 128 + q] = -1; rwt[tb[e] * 128 + q] = 0.f; }
                    for (int q = tid; q < nt_e; q += NTHREADS) tile_e[tb[e] + q] = e;
                }
                __syncthreads();
            }
        PHASE_END
        PHASE_BEGIN(pb + 8)
            {
                load_tile_bases(ctl, l, (int*)lds);
                const int ntr = ((int*)lds)[64];
                __syncthreads();
                const int* rtok = (const int*)(p.ws + WS_RTOK); const int* tile_e = (const int*)(p.ws + WS_TILEE);
                strided((ntr + 272) * 4, [&](int u) {
                    LANE_IDS
                    const int tile = u >> 2, jn = u & 3;
                    int e, obase; ARows ar;
                    if (tile < ntr) {
                        e = tile_e[tile]; obase = tile * 128;
#pragma unroll
                        for (int i = 0; i < 4; ++i) { const int r = rtok[obase + (tid >> 3) + 32 * i]; ar.r[i] = r < 0 ? 0 : r; }
                    } else {
                        const int stt = tile - ntr; e = 64; obase = (SH_TILE_BASE + stt) * 128;
                        ar = arows_lin(stt * 128, tid);
                    }
                    f32x4 acc[4][4];
                    gemm_tile((const bf16_t*)(p.ws + WS_HBY), DM, ar,
                              (const bf16_t*)(p.ws + WS_R1 + R1_W13T) + (size_t)e * 512 * 1024, DM, jn * 128, DM, lds, acc);
                    bf16_t* act = (bf16_t*)(p.ws + WS_ACT);
#pragma unroll
                    for (int m = 0; m < 4; ++m)
#pragma unroll
                        for (int pp = 0; pp < 2; ++pp)
#pragma unroll
                            for (int j = 0; j < 4; ++j) {
                                const float g = acc[m][2 * pp][j], uu = acc[m][2 * pp + 1][j];
                                const int orow = obase + wr * 64 + m * 16 + fq * 4 + j;
                                const int col = jn * 64 + wc * 32 + pp * 16 + fr;
                                act[(size_t)orow * 256 + col] = f2bf(siluf(g) * uu);
                            }
                });
            }
        PHASE_END
#pragma unroll 1
        for (int sl = 0; sl < 4; ++sl) {
            PHASE_BEGIN(pb + 9 + 2 * sl)
            {
                load_tile_bases(ctl, l, (int*)lds);
                const int ntr = ((int*)lds)[64];
                __syncthreads();
                const int* tile_e = (const int*)(p.ws + WS_TILEE);
                strided((ntr + 272) * 2, [&](int u) {
                    LANE_IDS
                    const int tile = u >> 1, nt2 = u & 1;
                    int e, obase;
                    if (tile < ntr) { e = tile_e[tile]; obase = tile * 128; }
                    else { e = 64; obase = (SH_TILE_BASE + tile - ntr) * 128; }
                    f32x4 acc[4][4];
                    gemm_tile((const bf16_t*)(p.ws + WS_ACT), 256, arows_lin(obase, tid),
                              (const bf16_t*)(p.ws + WS_R1 + R1_W2T) + (size_t)e * 1024 * 256, 256, sl * 256 + nt2 * 128, 256, lds, acc);
                    bf16_t* y2 = (bf16_t*)(p.ws + WS_Y2);
#pragma unroll
                    for (int m = 0; m < 4; ++m)
#pragma unroll
                        for (int j = 0; j < 4; ++j) {
                            const int orow = obase + wr * 64 + m * 16 + fq * 4 + j;
#pragma unroll
                            for (int n = 0; n < 4; ++n) y2[(size_t)orow * 256 + nt2 * 128 + wc * 64 + n * 16 + fr] = f2bf(acc[m][n][j]);
                        }
                });
            }
            PHASE_END
            PHASE_BEGIN(pb + 10 + 2 * sl)
            {
                int* tb = (int*)lds;
                const int tid = otid();
                const unsigned* cnt = ctl + CW_CNT(l);
                load_tile_bases(ctl, l, tb);
                const int* aep = (const int*)(p.ws + WS_AEP); const float* aw = (const float*)(p.ws + WS_AW);
                const bf16_t* y2 = (const bf16_t*)(p.ws + WS_Y2);
                const int tl = tid >> 5, cg = tid & 31;
                for (int grp = blockIdx.x; grp < NT / 8; grp += gridDim.x) {
                    const int tok = grp * 8 + tl;
                    float a8[8];
                    {
                        const uint4 sv = *reinterpret_cast<const uint4*>(y2 + ((size_t)(SH_TILE_BASE * 128 + tok)) * 256 + cg * 8);
                        a8[0] = bflo(sv.x); a8[1] = bfhi(sv.x); a8[2] = bflo(sv.y); a8[3] = bfhi(sv.y);
                        a8[4] = bflo(sv.z); a8[5] = bfhi(sv.z); a8[6] = bflo(sv.w); a8[7] = bfhi(sv.w);
                    }
#pragma unroll
                    for (int k = 0; k < 8; ++k) {
                        const unsigned v = (unsigned)aep[(size_t)tok * 8 + k];
                        const float wk = aw[(size_t)tok * 8 + k];
                        const int dest = tb[v >> 24] * 128 + (int)(v & 0xFFFFFFu);
                        const uint4 yv = *reinterpret_cast<const uint4*>(y2 + (size_t)dest * 256 + cg * 8);
                        a8[0] += wk * bflo(yv.x); a8[1] += wk * bfhi(yv.x); a8[2] += wk * bflo(yv.y); a8[3] += wk * bfhi(yv.y);
                        a8[4] += wk * bflo(yv.z); a8[5] += wk * bfhi(yv.z); a8[6] += wk * bflo(yv.w); a8[7] += wk * bfhi(yv.w);
                    }
                    float* xr = xrow(p, tok) + sl * 256 + cg * 8;
                    const float* ga = modp(p, l, row_mod(tok), 5) + sl * 256 + cg * 8;
                    float4 x0 = *reinterpret_cast<const float4*>(xr), x1 = *reinterpret_cast<const float4*>(xr + 4);
                    const float4 g0 = *reinterpret_cast<const float4*>(ga), g1 = *reinterpret_cast<const float4*>(ga + 4);
                    const float rs = kp.rep ? 0.f : 1.f;
                    x0.x += rs * g0.x * a8[0]; x0.y += rs * g0.y * a8[1]; x0.z += rs * g0.z * a8[2]; x0.w += rs * g0.w * a8[3];
                    x1.x += rs * g1.x * a8[4]; x1.y += rs * g1.y * a8[5]; x1.z += rs * g1.z * a8[6]; x1.w += rs * g1.w * a8[7];
                    *reinterpret_cast<float4*>(xr) = x0; *reinterpret_cast<float4*>(xr + 4) = x1;
                }
                __syncthreads();
            }
            PHASE_END
        }
    }
#if defined(PROBE_PH)
    if (lo >= 100) {
        float a0 = (float)otid(), a1 = a0 + 1.f, a2 = a0 + 2.f, a3 = a0 + 3.f, a4 = a0 + 4.f, a5 = a0 + 5.f, a6 = a0 + 6.f, a7 = a0 + 7.f;
        const float m = 0.999f, c = 0.5f;
        for (int it = 0; it < 10000; ++it) {
            if (lo == 100) {
#pragma unroll
                for (int q = 0; q < 64; ++q) asm volatile("v_fma_f32 %0, %0, %1, %2" : "+v"(a0) : "v"(m), "v"(c));
            } else {
#pragma unroll
                for (int q = 0; q < 8; ++q) {
                    asm volatile("v_fma_f32 %0, %0, %1, %2" : "+v"(a0) : "v"(m), "v"(c)); asm volatile("v_fma_f32 %0, %0, %1, %2" : "+v"(a1) : "v"(m), "v"(c));
                    asm volatile("v_fma_f32 %0, %0, %1, %2" : "+v"(a2) : "v"(m), "v"(c)); asm volatile("v_fma_f32 %0, %0, %1, %2" : "+v"(a3) : "v"(m), "v"(c));
                    asm volatile("v_fma_f32 %0, %0, %1, %2" : "+v"(a4) : "v"(m), "v"(c)); asm volatile("v_fma_f32 %0, %0, %1, %2" : "+v"(a5) : "v"(m), "v"(c));
                    asm volatile("v_fma_f32 %0, %0, %1, %2" : "+v"(a6) : "v"(m), "v"(c)); asm volatile("v_fma_f32 %0, %0, %1, %2" : "+v"(a7) : "v"(m), "v"(c));
                }
            }
        }
        if (a0 + a1 + a2 + a3 + a4 + a5 + a6 + a7 == 12345.678f) ctl[60] = 1u;
    }
#endif
    PHASE_BEGIN(35)
        strided(4352, [&](int u) { rows_unit<M_FINAL>(p, 1, u, lds); });
    PHASE_END
}

#ifndef N_LAUNCH_MODE
#define N_LAUNCH_MODE 1
#endif
extern "C" void kernel_launch(void* const* d_in, const int* in_sizes, int n_in, void* d_out, int out_size, void* d_ws, size_t ws_size, hipStream_t stream) {
    static int grid = 0;
    if (grid == 0) {
        if (n_in != 52 || out_size != NTL * DM || ws_size < WS_END) { fprintf(stderr, "kernel_launch: unexpected shapes (n_in %d out %d ws %zu need %zu)\n", n_in, out_size, ws_size, (size_t)WS_END); grid = -1; return; }
        int dev = 0, cus = 0, per_cu = 0;
        hipGetDevice(&dev);
        hipDeviceGetAttribute(&cus, hipDeviceAttributeMultiprocessorCount, dev);
        hipFuncSetAttribute((const void*)fwd_kernel, hipFuncAttributeMaxDynamicSharedMemorySize, LDS_BYTES);
        hipOccupancyMaxActiveBlocksPerMultiprocessor(&per_cu, (const void*)fwd_kernel, NTHREADS, LDS_BYTES);
        (void)hipGetLastError();
        if (per_cu < 1) per_cu = 1;
        if (per_cu > 2) per_cu = 2;
        grid = cus * per_cu;
    }
    if (grid < 0) return;
    hipMemsetAsync((char*)d_ws + WS_CTL, 0, CTL_BYTES, stream);
    KP p{};
    for (int i = 0; i < 52; ++i) p.in[i] = (const float*)d_in[i];
    p.out = (float*)d_out; p.ws = (char*)d_ws;
#if defined(PROBE_PH)
    for (int ph = 0; ph < NPHASE; ++ph) {
        const int reps = (ph == PROBE_PH) ? 1 + PROBE_N : 1;
        for (int r = 0; r < reps; ++r) { p.ph_lo = ph; p.ph_hi = ph + 1; p.rep = r; hipLaunchKernelGGL(fwd_kernel, dim3(grid), dim3(NTHREADS), LDS_BYTES, stream, p); }
    }
    if (PROBE_PH >= 100) { p.ph_lo = PROBE_PH; p.ph_hi = PROBE_PH + 1; p.rep = 0; hipLaunchKernelGGL(fwd_kernel, dim3(PROBE_N), dim3(NTHREADS), LDS_BYTES, stream, p); }
#elif N_LAUNCH_MODE == 1
    p.ph_lo = 0; p.ph_hi = NPHASE;
    hipLaunchKernelGGL(fwd_kernel, dim3(grid), dim3(NTHREADS), LDS_BYTES, stream, p);
#else
    for (int ph = 0; ph < NPHASE; ++ph) {
        p.ph_lo = ph; p.ph_hi = ph + 1;
        hipLaunchKernelGGL(fwd_kernel, dim3(grid), dim3(NTHREADS), LDS_BYTES, stream, p);
    }
#endif
}
```

```cpp
#include <hip/hip_runtime.h>
#include <hip/hip_bf16.h>
#include <hip/hip_fp16.h>
#include <stdint.h>
#include <stdio.h>

typedef unsigned short bf16_t;
using bf16x8 = __attribute__((ext_vector_type(8))) short;
using f32x4 = __attribute__((ext_vector_type(4))) float;
using f32x2 = __attribute__((ext_vector_type(2))) float;

#define NTC 2048
#define NTL 32768
#define NT 34816
#define DM 1024
#define ZS 3024
#define COL_GD 960
#define COL_HY 2000
#define COL_S5 2768
#define NCHUNK 68
#define ALPHA 1.41421356237f
#define NTHREADS 256
#define LDS_BYTES 73728
#define LDS_USER 2048
#define SH_TILE_BASE 2240
#define ACT_ROWS ((SH_TILE_BASE + 272) * 128)

constexpr size_t al256(size_t x) { return (x + 255) & ~(size_t)255; }
constexpr size_t WS_CTL = 0;
constexpr size_t CTL_BYTES = 65536;
constexpr size_t WS_MOD = WS_CTL + CTL_BYTES;
constexpr size_t WS_S5A = al256(WS_MOD + 2 * 9 * 6144 * 4);
constexpr size_t WS_S5B = al256(WS_S5A + 2 * 2 * 16 * 64 * 4 * 4);
constexpr size_t WS_GLUT = al256(WS_S5B + 2 * 2 * 16 * 64 * 32 * 4);
constexpr size_t WS_WINT = al256(WS_GLUT + 2 * 256 * 256 * 2);
constexpr size_t WS_WOUTT = al256(WS_WINT + (size_t)3072 * 1024 * 2);
constexpr size_t WS_FILTL = al256(WS_WOUTT + (size_t)1024 * 1024 * 2);
constexpr size_t WS_FILTC = al256(WS_FILTL + (size_t)4 * 256 * 4096 * 4);
constexpr size_t WS_XC = al256(WS_FILTC + (size_t)4 * 256 * 256 * 4);
constexpr size_t WS_HBY = al256(WS_XC + (size_t)NTC * DM * 4);
constexpr size_t WS_CAT = al256(WS_HBY + (size_t)NT * DM * 2);
constexpr size_t WS_Z = al256(WS_CAT + (size_t)NT * DM * 2);
constexpr size_t WS_R1 = al256(WS_Z + (size_t)NT * ZS * 2);
constexpr size_t R1_RWP = 0;
constexpr size_t R1_GQ = (size_t)NT * 1024 * 2;
constexpr size_t R1_W13T = 0;
constexpr size_t R1_W2T = (size_t)65 * 512 * 1024 * 2;
constexpr size_t R1_BYTES = (size_t)NT * 1024 * 2 + (size_t)NT * 768 * 2;
constexpr size_t WS_KNORM = al256(WS_R1 + R1_BYTES);
constexpr size_t WS_GAB = al256(WS_KNORM + (size_t)NT * 4 * 4);
constexpr size_t WS_S5ST = al256(WS_GAB + (size_t)NT * 16 * 4);
constexpr size_t WS_AEP = al256(WS_S5ST + (size_t)8 * 68 * 2 * 16 * 64 * 2 * 4);
constexpr size_t WS_AW = al256(WS_AEP + (size_t)NT * 8 * 4);
constexpr size_t WS_RTOK = al256(WS_AW + (size_t)NT * 8 * 4);
constexpr size_t WS_HYT = al256(WS_RTOK + (size_t)64 * NT * 4);
constexpr size_t WS_END = al256(WS_HYT + (size_t)8 * 768 * 4096 * 2);
static_assert(R1_W2T + (size_t)65 * 1024 * 256 * 2 <= R1_BYTES, "expert weights must fit R1");
constexpr size_t ACT_BYTES = (size_t)ACT_ROWS * 256 * 2;
constexpr size_t WS_ACT = WS_Z + ((((size_t)NT * ZS * 2 - ACT_BYTES) >> 8) << 8);
constexpr size_t WS_Y2 = WS_HBY;
static_assert(WS_Y2 + ACT_BYTES <= WS_ACT, "y2 must not reach act");

#define CW_QUEUE(l) (4096 + 64 * (l))
#define CW_CNT(l) (4352 + 64 * (l))
#define CW_CUCNT(l) (8192 + 4096 * (l))

#define XB_TMO      128
#define XB_XCNT(j)  (256  + 64 * (j))
#define XB_XSUB(j)  (1280 + 64 * (j))
#define XB_XGEN(j)  (2304 + 64 * (j))
#define XB_TOP      3328
#define XB_TOPGEN   3392
#define XCD_BAR_WORDS 3456
#define XB_SPIN_CAP (1u << 18)
#define LAS __attribute__((address_space(3)))

__device__ __forceinline__ unsigned xb_ld(unsigned* p)              { return __hip_atomic_load(p, __ATOMIC_RELAXED, __HIP_MEMORY_SCOPE_AGENT); }
__device__ __forceinline__ unsigned xb_add(unsigned* p, unsigned v) { return __hip_atomic_fetch_add(p, v, __ATOMIC_RELAXED, __HIP_MEMORY_SCOPE_AGENT); }
__device__ __forceinline__ unsigned xb_xcc_id() { return (unsigned)__builtin_amdgcn_s_getreg((3 << 11) | 20) & 0xFu; }
#define XB_SPIN(cond, bar) do { unsigned _sp = 0; while (cond) { __builtin_amdgcn_s_sleep(1); \
    if ((++_sp & 255u) == 0u) { if (xb_ld(&(bar)[XB_TMO])) break; if (_sp > XB_SPIN_CAP) { atomicAdd(&(bar)[XB_TMO], 1u); break; } } } } while (0)

struct XcdBarrier {
    unsigned* bar; unsigned x;
    volatile LAS unsigned* st;
};
__device__ __forceinline__ XcdBarrier xcd_barrier_post(unsigned* bar, volatile LAS unsigned* st) {
    XcdBarrier b; b.bar = bar; b.x = xb_xcc_id(); b.st = st;
    if (threadIdx.x == 0) (void)xb_add(&bar[XB_XCNT(b.x)], 1u);
    return b;
}
__device__ __forceinline__ void xcd_barrier_complete(unsigned* bar, unsigned x, unsigned& nloc, unsigned& nx) {
    const unsigned G = gridDim.x * gridDim.y * gridDim.z;
    unsigned sum, cnt, mine, sp = 0u;
    for (;;) {
        sum = 0u; cnt = 0u; mine = 0u;
#pragma unroll
        for (unsigned j = 0; j < 16; ++j) { const unsigned c = xb_ld(&bar[XB_XCNT(j)]); sum += c; cnt += (c > 0u) ? 1u : 0u; mine = (j == x) ? c : mine; }
        if (sum == G) break;
        __builtin_amdgcn_s_sleep(1);
        if ((++sp & 255u) == 0u) { if (xb_ld(&bar[XB_TMO])) break; if (sp > XB_SPIN_CAP) { atomicAdd(&bar[XB_TMO], 1u); break; } }
    }
    nloc = mine > 0u ? mine : 1u; nx = cnt > 0u ? cnt : 1u;
}
__device__ __forceinline__ void xcd_barrier(const XcdBarrier& b) {
    asm volatile("s_waitcnt vmcnt(0)" ::: "memory");
    __syncthreads();
    if (threadIdx.x == 0) {
        unsigned* bar = b.bar;
        __builtin_amdgcn_s_waitcnt(0);
        unsigned nloc = b.st[0], nx = b.st[1];
        if (nloc == 0u) { xcd_barrier_complete(bar, b.x, nloc, nx); b.st[0] = nloc; b.st[1] = nx; }
        const unsigned old = xb_add(&bar[XB_XSUB(b.x)], 1u);
        const unsigned gen = old / nloc;
        if (old + 1u == (gen + 1u) * nloc) {
            __builtin_amdgcn_fence(__ATOMIC_RELEASE, "agent");
            asm volatile("s_waitcnt vmcnt(0)" ::: "memory");
            const unsigned og = xb_add(&bar[XB_TOP], 1u);
            const unsigned tg = og / nx;
            if (og + 1u == (tg + 1u) * nx) xb_add(&bar[XB_TOPGEN], 1u);
            else XB_SPIN(xb_ld(&bar[XB_TOPGEN]) == tg, bar);
            __builtin_amdgcn_fence(__ATOMIC_ACQUIRE, "agent");
            xb_add(&bar[XB_XGEN(b.x)], 1u);
            asm volatile("s_waitcnt vmcnt(0)" ::: "memory");
        } else {
            XB_SPIN(xb_ld(&bar[XB_XGEN(b.x)]) == gen, bar);
            __builtin_amdgcn_fence(__ATOMIC_ACQUIRE, "agent");
            asm volatile("s_waitcnt vmcnt(0)" ::: "memory");
        }
    }
    __syncthreads();
}

struct KP {
    const float* in[52];
    float* out;
    char* ws;
    int ph_lo, ph_hi, rep, pad_;
};
struct P {
    const __attribute__((address_space(3))) unsigned* tab;
    float* out;
    char* ws;
    __device__ __forceinline__ const float* in(int i) const {
        const unsigned lo = __builtin_amdgcn_readfirstlane(tab[2 * i]);
        const unsigned hi = __builtin_amdgcn_readfirstlane(tab[2 * i + 1]);
        return (const float*)(((unsigned long long)hi << 32) | (unsigned long long)lo);
    }
};
enum { I_X = 0, I_C, I_CTX, I_CCTX, I_ADAW, I_ADAB, I_WIN, I_WOUT, I_LNG, I_LNB,
       I_RW_W0, I_RW_W2, I_RW_A0, I_RW_A2, I_RW_G2, I_RW_KK, I_RW_KA, I_RW_RK, I_RW_GNG, I_RW_GNB,
       I_GD_CONV, I_GD_ALOG, I_GD_DTB, I_GD_NORM,
       I_HY_CONV, I_HY_CONVB, I_HY_W1, I_HY_B1, I_HY_F1, I_HY_W2, I_HY_B2, I_HY_F2, I_HY_W3, I_HY_SKIP,
       I_S5_LRE, I_S5_LIM, I_S5_LOGSTEP, I_S5_BRE, I_S5_BIM, I_S5_CRE, I_S5_CIM, I_S5_D, I_S5_GLUW, I_S5_GLUB,
       I_ROUTER_W, I_ROUTER_B, I_EX_W1, I_EX_W3, I_EX_W2, I_SH_W1, I_SH_W3, I_SH_W2 };

__device__ __forceinline__ bf16_t f2bf(float f) { unsigned u = __float_as_uint(f); u += 0x7fffu + ((u >> 16) & 1u); return (bf16_t)(u >> 16); }
__device__ __forceinline__ float bf2f(bf16_t h) { return __uint_as_float(((unsigned)h) << 16); }
__device__ __forceinline__ float bflo(unsigned u) { return __uint_as_float(u << 16); }
__device__ __forceinline__ float bfhi(unsigned u) { return __uint_as_float(u & 0xffff0000u); }
__device__ __forceinline__ unsigned pack2(float a, float b) { return (unsigned)f2bf(a) | ((unsigned)f2bf(b) << 16); }
__device__ __forceinline__ float sigm(float x) { return 1.f / (1.f + __expf(-x)); }
__device__ __forceinline__ float siluf(float x) { return x / (1.f + __expf(-x)); }
__device__ __forceinline__ float softplusf(float x) { return fmaxf(x, 0.f) + log1pf(__expf(-fabsf(x))); }
__device__ __forceinline__ float wave_sum(float v) {
#pragma unroll
    for (int o = 32; o >= 1; o >>= 1) v += __shfl_xor(v, o);
    return v;
}
template <int CTRL> __device__ __forceinline__ float dppf(float v) {
    return __int_as_float(__builtin_amdgcn_update_dpp(0, __float_as_int(v), CTRL, 0xF, 0xF, true));
}
__device__ __forceinline__ int otid() { int t = threadIdx.x; asm volatile("" : "+v"(t)); return t; }
__device__ __forceinline__ float* xrow(const P& p, int row) {
    return row < NTC ? (float*)(p.ws + WS_XC) + (size_t)row * DM : p.out + (size_t)(row - NTC) * DM;
}
__device__ __forceinline__ int row_mod(int row) { return row < NTC ? 8 : ((row - NTC) >> 12); }
__device__ __forceinline__ const float* modp(const P& p, int l, int r, int chunk) {
    return (const float*)(p.ws + WS_MOD) + ((size_t)(l * 9 + r) * 6144 + chunk * 1024);
}

struct ARows { int r[4]; };
__device__ __forceinline__ ARows arows_lin(int base, int tid) { ARows a; a.r[0] = base + (tid >> 3); a.r[1] = a.r[0] + 32; a.r[2] = a.r[0] + 64; a.r[3] = a.r[0] + 96; return a; }
__device__ __forceinline__ void gemm_tile(const bf16_t* __restrict__ A, int lda, const ARows& ar,
                                          const bf16_t* __restrict__ Bt, int ldb, int brow0, int K,
                                          char* lds, f32x4 (&acc)[4][4]) {
    const int tid = otid();
    const int wid = tid >> 6, lane = tid & 63, wr = wid >> 1, wc = wid & 1, fr = lane & 15, fq = lane >> 4;
    const int gc = ((tid & 7) ^ ((tid >> 3) & 7)) * 8;
    const bf16_t* ap[4]; const bf16_t* bp[4];
#pragma unroll
    for (int i = 0; i < 4; ++i) {
        ap[i] = A + (size_t)ar.r[i] * lda + gc;
        bp[i] = Bt + (size_t)(brow0 + (tid >> 3) + 32 * i) * ldb + gc;
    }
#pragma unroll
    for (int m = 0; m < 4; ++m)
#pragma unroll
        for (int n = 0; n < 4; ++n) acc[m][n] = f32x4{0.f, 0.f, 0.f, 0.f};
    const int nk = K >> 6;
    auto stage = [&](int t, int buf) {
        char* SA = lds + buf * 32768; char* SB = SA + 16384;
        const int ko = t * 64;
#pragma unroll
        for (int i = 0; i < 4; ++i) {
            __builtin_amdgcn_global_load_lds((const void*)(ap[i] + ko), (LAS void*)(SA + tid * 16 + i * 4096), 16, 0, 0);
            __builtin_amdgcn_global_load_lds((const void*)(bp[i] + ko), (LAS void*)(SB + tid * 16 + i * 4096), 16, 0, 0);
        }
    };
    stage(0, 0);
    asm volatile("s_waitcnt vmcnt(0)" ::: "memory");
    __syncthreads();
    const int sw = fr & 7;
    for (int t = 0; t < nk; ++t) {
        const int buf = t & 1;
        if (t + 1 < nk) stage(t + 1, buf ^ 1);
        const char* SA = lds + buf * 32768; const char* SB = SA + 16384;
#pragma unroll
        for (int ks = 0; ks < 2; ++ks) {
            const int co = ((ks * 4 + fq) ^ sw) * 16;
            bf16x8 af[4], bfr[4];
#pragma unroll
            for (int m = 0; m < 4; ++m) af[m] = *reinterpret_cast<const bf16x8*>(SA + (wr * 64 + m * 16 + fr) * 128 + co);
#pragma unroll
            for (int n = 0; n < 4; ++n) bfr[n] = *reinterpret_cast<const bf16x8*>(SB + (wc * 64 + n * 16 + fr) * 128 + co);
#pragma unroll
            for (int m = 0; m < 4; ++m)
#pragma unroll
                for (int n = 0; n < 4; ++n) acc[m][n] = __builtin_amdgcn_mfma_f32_16x16x32_bf16(af[m], bfr[n], acc[m][n], 0, 0, 0);
        }
        asm volatile("s_waitcnt vmcnt(0)" ::: "memory");
        __syncthreads();
    }
}

__device__ __forceinline__ void ph0_mod_unit(const P& p, int u, char* lds) {
    const int l = u / 96, cg = u % 96, tid = otid();
    float* s = (float*)lds;
    float* red = s + 9 * 1024;
    const float* c = p.in(I_C); const float* cctx = p.in(I_CCTX);
    for (int i = tid; i < 9 * 1024; i += NTHREADS) { int r = i >> 10, k = i & 1023; float v = r < 8 ? c[r * 1024 + k] : cctx[k]; s[i] = v / (1.f + expf(-v)); }
    __syncthreads();
    const int kq = tid >> 6, j = tid & 63, col = cg * 64 + j;
    const float* w = p.in(I_ADAW) + (size_t)l * 1024 * 6144 + col;
    float acc[9];
#pragma unroll
    for (int r = 0; r < 9; ++r) acc[r] = 0.f;
#pragma unroll 4
    for (int k = kq * 256; k < kq * 256 + 256; ++k) {
        const float wv = w[(size_t)k * 6144];
#pragma unroll
        for (int r = 0; r < 9; ++r) acc[r] += s[r * 1024 + k] * wv;
    }
#pragma unroll
    for (int r = 0; r < 9; ++r) red[(kq * 9 + r) * 64 + j] = acc[r];
    __syncthreads();
    if (tid < 64) {
        float* mod = (float*)(p.ws + WS_MOD);
        const float bb = p.in(I_ADAB)[l * 6144 + col];
#pragma unroll
        for (int r = 0; r < 9; ++r) mod[(size_t)(l * 9 + r) * 6144 + col] = red[r * 64 + j] + red[(9 + r) * 64 + j] + red[(18 + r) * 64 + j] + red[(27 + r) * 64 + j] + bb;
    }
    __syncthreads();
}

__device__ __forceinline__ void ph0_s5tab_unit(const P& p, int u) {
    const int tid = otid();
    if (tid >= 64) return;
    const int ldg = u;
    const int idx = ldg * 64 + tid;
    const double lre = (double)p.in(I_S5_LRE)[idx], lim = (double)p.in(I_S5_LIM)[idx];
    const double dt = (double)expf(p.in(I_S5_LOGSTEP)[ldg]);
    const float mag = expf((float)(lre * dt));
    double rev = lim * dt * 0.15915494309189535; rev -= floor(rev);
    float sn, cs; sincospif(2.f * (float)rev, &sn, &cs);
    const double abr = (double)(mag * cs), abi = (double)(mag * sn);
    const double den = lre * lre + lim * lim;
    const double cor = ((abr - 1.0) * lre + abi * lim) / den;
    const double coi = (abi * lre - (abr - 1.0) * lim) / den;
    const float m64f = expf((float)(64.0 * lre * dt));
    double rev64 = 64.0 * lim * dt * 0.15915494309189535; rev64 -= floor(rev64);
    float sn64, cs64; sincospif(2.f * (float)rev64, &sn64, &cs64);
    float* A = (float*)(p.ws + WS_S5A) + (size_t)idx * 4;
    A[0] = (float)abr; A[1] = (float)abi; A[2] = m64f * cs64; A[3] = m64f * sn64;
    float* B = (float*)(p.ws + WS_S5B) + (size_t)idx * 32;
    const float* bre = p.in(I_S5_BRE) + (size_t)idx * 16; const float* bim = p.in(I_S5_BIM) + (size_t)idx * 16;
#pragma unroll
    for (int h = 0; h < 16; ++h) {
        const double br = bre[h], bi = bim[h];
        B[h] = (float)(cor * br - coi * bi);
        B[16 + h] = (float)(cor * bi + coi * br);
    }
}

__device__ __forceinline__ int xmap(int mode, int c) {
    if (mode == 0) return c;
    const int j = c >> 6, cc = c & 63, wc = cc >> 5, pp = (cc & 31) >> 4, i = cc & 15;
    return j * 128 + wc * 64 + pp * 32 + i + (mode == 2 ? 16 : 0);
}
__device__ __forceinline__ void xpose_tile(const float* __restrict__ src, int C, bf16_t* __restrict__ dst, int ldd, int mode, int tr, int tc, char* lds) {
    float* t = (float*)lds;
    const int tid = otid();
    {
        const int c4 = (tid & 15) * 4, c = tc * 64 + c4;
#pragma unroll
        for (int k = 0; k < 4; ++k) {
            const int r = (tid >> 4) + 16 * k;
            float4 v = make_float4(0.f, 0.f, 0.f, 0.f);
            if (c < C) v = *reinterpret_cast<const float4*>(src + (size_t)(tr * 64 + r) * C + c);
            t[(c4 + 0) * 65 + r] = v.x; t[(c4 + 1) * 65 + r] = v.y; t[(c4 + 2) * 65 + r] = v.z; t[(c4 + 3) * 65 + r] = v.w;
        }
    }
    __syncthreads();
#pragma unroll
    for (int k = 0; k < 2; ++k) {
        const int ci = (tid >> 3) + 32 * k, r8 = (tid & 7) * 8;
        const float* tp = t + ci * 65 + r8;
        uint4 o;
        o.x = pack2(tp[0], tp[1]); o.y = pack2(tp[2], tp[3]); o.z = pack2(tp[4], tp[5]); o.w = pack2(tp[6], tp[7]);
        *reinterpret_cast<uint4*>(dst + (size_t)xmap(mode, tc * 64 + ci) * ldd + tr * 64 + r8) = o;
    }
    __syncthreads();
}

enum { M_INIT = 0, M_LN2NEXT = 1, M_LN1 = 2, M_FINAL = 3 };

template <int MODE>
__device__ __forceinline__ void rows_unit(const P& p, int l, int u, char* lds, bool dry = false) {
    const int tid = otid(), w = tid >> 6, lane = tid & 63;
    float* hbuf = (float*)lds;
    bf16_t* hb = (bf16_t*)(p.ws + WS_HBY);
#pragma unroll 1
    for (int rr = 0; rr < 2; ++rr) {
        const int rl = w * 2 + rr, row = u * 8 + rl;
        const int mr = row_mod(row);
        float v[16];
        float* xr = xrow(p, row);
        const float* src = (MODE == M_INIT) ? (row < NTC ? p.in(I_CTX) + (size_t)row * DM : p.in(I_X) + (size_t)(row - NTC) * DM) : xr;
#pragma unroll
        for (int i = 0; i < 4; ++i) {
            const float4 t = *reinterpret_cast<const float4*>(src + i * 256 + lane * 4);
            v[i * 4 + 0] = t.x; v[i * 4 + 1] = t.y; v[i * 4 + 2] = t.z; v[i * 4 + 3] = t.w;
        }
        if (MODE != M_INIT) {
            const int ll = (MODE == M_LN2NEXT) ? l - 1 : l;
            const int which = (MODE == M_LN1) ? 0 : 1;
            float s = 0.f;
#pragma unroll
            for (int i = 0; i < 16; ++i) s += v[i];
            const float mu = wave_sum(s) * (1.f / 1024.f);
            float q = 0.f;
#pragma unroll
            for (int i = 0; i < 16; ++i) { const float d = v[i] - mu; q += d * d; }
            const float rstd = rsqrtf(wave_sum(q) * (1.f / 1024.f) + 1e-5f);
            const float* g = p.in(I_LNG) + (size_t)(ll * 2 + which) * 1024;
            const float* bb = p.in(I_LNB) + (size_t)(ll * 2 + which) * 1024;
#pragma unroll
            for (int i = 0; i < 4; ++i) {
                const float4 gg = *reinterpret_cast<const float4*>(g + i * 256 + lane * 4);
                const float4 b4 = *reinterpret_cast<const float4*>(bb + i * 256 + lane * 4);
                v[i * 4 + 0] = (v[i * 4 + 0] - mu) * rstd * gg.x + b4.x;
                v[i * 4 + 1] = (v[i * 4 + 1] - mu) * rstd * gg.y + b4.y;
                v[i * 4 + 2] = (v[i * 4 + 2] - mu) * rstd * gg.z + b4.z;
                v[i * 4 + 3] = (v[i * 4 + 3] - mu) * rstd * gg.w + b4.w;
            }
        }
        if (MODE == M_FINAL) {
            if (row >= NTC) {
#pragma unroll
                for (int i = 0; i < 4; ++i) *reinterpret_cast<float4*>(xr + i * 256 + lane * 4) = make_float4(v[i * 4], v[i * 4 + 1], v[i * 4 + 2], v[i * 4 + 3]);
            }
            continue;
        }
        const float osc = (MODE == M_LN1) ? ALPHA : 1.f;
#pragma unroll
        for (int i = 0; i < 4; ++i) { float4 o4 = make_float4(osc * v[i * 4], osc * v[i * 4 + 1], osc * v[i * 4 + 2], osc * v[i * 4 + 3]); if (dry) o4 = *reinterpret_cast<const float4*>(src + i * 256 + lane * 4); *reinterpret_cast<float4*>(xr + i * 256 + lane * 4) = o4; }
        const float* sh = modp(p, l, mr, (MODE == M_LN1) ? 3 : 0);
        const float* sc = modp(p, l, mr, (MODE == M_LN1) ? 4 : 1);
#pragma unroll
        for (int i = 0; i < 4; ++i) {
            const float4 s4 = *reinterpret_cast<const float4*>(sc + i * 256 + lane * 4);
            const float4 h4 = *reinterpret_cast<const float4*>(sh + i * 256 + lane * 4);
            const float h0 = v[i * 4 + 0] * (1.f + s4.x) + h4.x, h1 = v[i * 4 + 1] * (1.f + s4.y) + h4.y;
            const float h2 = v[i * 4 + 2] * (1.f + s4.z) + h4.z, h3 = v[i * 4 + 3] * (1.f + s4.w) + h4.w;
            uint2 pk; pk.x = pack2(h0, h1); pk.y = pack2(h2, h3);
            if (!dry) *reinterpret_cast<uint2*>(hb + (size_t)row * DM + i * 256 + lane * 4) = pk;
            if (MODE == M_LN1) *reinterpret_cast<float4*>(hbuf + rl * 1024 + i * 256 + lane * 4) = make_float4(h0, h1, h2, h3);
        }
    }
    if (MODE == M_LN1) {
        float* part = hbuf + 8 * 1024;
        __syncthreads();
        {
            const float* rw = p.in(I_ROUTER_W) + (size_t)l * 1024 * 64 + lane;
            float ac[8];
#pragma unroll
            for (int r = 0; r < 8; ++r) ac[r] = 0.f;
#pragma unroll 2
            for (int k = w * 256; k < w * 256 + 256; k += 4) {
                const float w0 = rw[(size_t)(k + 0) * 64], w1 = rw[(size_t)(k + 1) * 64], w2 = rw[(size_t)(k + 2) * 64], w3 = rw[(size_t)(k + 3) * 64];
#pragma unroll
                for (int r = 0; r < 8; ++r) {
                    const float4 x = *reinterpret_cast<const float4*>(hbuf + r * 1024 + k);
                    ac[r] += x.x * w0 + x.y * w1 + x.z * w2 + x.w * w3;
                }
            }
#pragma unroll
            for (int r = 0; r < 8; ++r) part[(w * 8 + r) * 64 + lane] = ac[r];
        }
        __syncthreads();
        float a0, a1;
        {
            const int r0 = w * 2, r1 = w * 2 + 1;
            a0 = part[(0 * 8 + r0) * 64 + lane] + part[(1 * 8 + r0) * 64 + lane] + part[(2 * 8 + r0) * 64 + lane] + part[(3 * 8 + r0) * 64 + lane];
            a1 = part[(0 * 8 + r1) * 64 + lane] + part[(1 * 8 + r1) * 64 + lane] + part[(2 * 8 + r1) * 64 + lane] + part[(3 * 8 + r1) * 64 + lane];
        }
        const float rbias = p.in(I_ROUTER_B)[l * 64 + lane];
        unsigned* cnt = (unsigned*)(p.ws + WS_CTL) + CW_CNT(l);
        int* aep = (int*)(p.ws + WS_AEP); float* aw = (float*)(p.ws + WS_AW);
#pragma unroll 1
        for (int rr = 0; rr < 2; ++rr) {
            const int row = u * 8 + w * 2 + rr;
            const float logit = rr ? a1 : a0;
            const float s = 1.f / (1.f + expf(-logit));
            const float bsd = s + rbias;
            float m1 = bsd;
            m1 = fmaxf(m1, __shfl_xor(m1, 1)); m1 = fmaxf(m1, __shfl_xor(m1, 2)); m1 = fmaxf(m1, __shfl_xor(m1, 4));
            const unsigned long long eqm = __ballot(bsd == m1);
            const int gbase = lane & ~7;
            const unsigned gbits = (unsigned)((eqm >> gbase) & 0xFFull);
            const int first = gbase + __builtin_ctz(gbits);
            float m2 = (lane == first) ? -INFINITY : bsd;
            m2 = fmaxf(m2, __shfl_xor(m2, 1)); m2 = fmaxf(m2, __shfl_xor(m2, 2)); m2 = fmaxf(m2, __shfl_xor(m2, 4));
            const float gs = m1 + m2;
            const int myg = lane >> 3;
            int grank = 0;
#pragma unroll
            for (int g2 = 0; g2 < 8; ++g2) { const float o = __shfl(gs, g2 * 8); grank += (o > gs || (o == gs && g2 < myg)) ? 1 : 0; }
            const bool gsel = grank < 4;
            const float msk = gsel ? bsd : -INFINITY;
            int erank = 0;
#pragma unroll
            for (int j = 0; j < 64; ++j) { const float o = __shfl(msk, j); erank += (o > msk || (o == msk && j < lane)) ? 1 : 0; }
            const bool sel = gsel && erank < 8;
            const float wsum = wave_sum(sel ? s : 0.f);
            const unsigned long long selm = __ballot(sel);
            if (sel && !dry) {
                const int slot = __popcll(selm & ((1ull << lane) - 1ull));
                const unsigned pos = atomicAdd(&cnt[lane], 1u);
                aep[(size_t)row * 8 + slot] = (int)((unsigned)lane << 24 | pos);
                ((int*)(p.ws + WS_RTOK))[(size_t)lane * NT + pos] = row;
                aw[(size_t)row * 8 + slot] = s / wsum * 2.5f;
            }
        }
    }
}

__device__ __forceinline__ void filt_unit(const P& p, int l, int u, char* lds) {
    const int tid = otid();
    float* feat = (float*)lds;
    float* h1 = feat + 4 * 36;
    float* h2 = h1 + 4 * 64;
    const int pp = tid >> 6, j = tid & 63;
    const int pi = u * 4 + pp;
    const int L = pi < 4096 ? 4096 : 256;
    const int t = pi < 4096 ? pi : pi - 4096;
    const float tt = (float)t / (float)(L - 1);
    if (j < 33) {
        float f;
        if (j == 0) f = tt;
        else {
            const int k = (j - 1) & 15;
            const float band = 1e-4f + (float)k * ((15.0f - 1e-4f) / 15.0f);
            float ph = band * (float)t * (1.f / (float)L);
            ph -= floorf(ph);
            float sn, cs; sincospif(2.f * ph, &sn, &cs);
            f = (j <= 16) ? cs : -sn;
        }
        feat[pp * 36 + j] = f;
    }
    __syncthreads();
    {
        const float* w1 = p.in(I_HY_W1) + (size_t)l * 33 * 64;
        float a = p.in(I_HY_B1)[l * 64 + j];
        for (int i = 0; i < 33; ++i) a += feat[pp * 36 + i] * w1[i * 64 + j];
        h1[pp * 64 + j] = sinf(p.in(I_HY_F1)[l * 64 + j] * a);
    }
    __syncthreads();
    {
        const float* w2 = p.in(I_HY_W2) + (size_t)l * 64 * 64;
        float a = p.in(I_HY_B2)[l * 64 + j];
        for (int i = 0; i < 64; ++i) a += h1[pp * 64 + i] * w2[i * 64 + j];
        h2[pp * 64 + j] = sinf(p.in(I_HY_F2)[l * 64 + j] * a);
    }
    __syncthreads();
    {
        const int c = tid;
        const float* w3 = p.in(I_HY_W3) + (size_t)l * 64 * 1024;
        float acc[4][4];
#pragma unroll
        for (int a = 0; a < 4; ++a)
#pragma unroll
            for (int b = 0; b < 4; ++b) acc[a][b] = 0.f;
        for (int i = 0; i < 64; ++i) {
            float wv[4];
#pragma unroll
            for (int os = 0; os < 4; ++os) wv[os] = w3[i * 1024 + os * 256 + c];
#pragma unroll
            for (int q = 0; q < 4; ++q) {
                const float hv = h2[q * 64 + i];
#pragma unroll
                for (int os = 0; os < 4; ++os) acc[q][os] += hv * wv[os];
            }
        }
        const float d0 = logf(0.01f) / 1.5f, d1 = logf(0.01f) / 0.3f;
        const float delta = fabsf(d0 + (d1 - d0) * ((float)c / 255.f));
#pragma unroll
        for (int q = 0; q < 4; ++q) {
            const int pq = u * 4 + q;
            const int Lq = pq < 4096 ? 4096 : 256;
            const int tq = pq < 4096 ? pq : pq - 4096;
            const float ttq = (float)tq / (float)(Lq - 1);
            const float dec = expf(-ttq * delta);
            float* F = (pq < 4096) ? (float*)(p.ws + WS_FILTL) : (float*)(p.ws + WS_FILTC);
#pragma unroll
            for (int os = 0; os < 4; ++os) {
                if (pq < 4096) F[((size_t)((os >> 1) * 256 + c) * 2 + (os & 1)) * 4096 + tq] = acc[q][os] * dec;
                else F[((size_t)os * 256 + c) * Lq + tq] = acc[q][os] * dec;
            }
        }
    }
    __syncthreads();
}

__device__ __forceinline__ void rwkv_prep_unit(const P& p, int l, int u, char* lds) {
    const int tid = otid(), w = tid >> 6;
    float* tw = (float*)lds;
    float* al = tw + 32 * 64;
    const bf16_t* z = (const bf16_t*)(p.ws + WS_Z);
    bf16_t* rwp = (bf16_t*)(p.ws + WS_R1 + R1_RWP);
    float* knorm = (float*)(p.ws + WS_KNORM);
    const int row0 = u * 32;
#pragma unroll
    for (int i = 0; i < 8; ++i) {
        const int idx = tid + 256 * i, tok = idx >> 6, j = idx & 63;
        const bf16_t* zr = z + (size_t)(row0 + tok) * ZS;
        tw[idx] = tanhf(bf2f(zr[768 + j]));
        al[idx] = bf2f(zr[832 + j]);
    }
    __syncthreads();
    const int c = tid;
#pragma unroll 1
    for (int pass = 0; pass < 4; ++pass) {
        const int d = pass & 1;
        const bool isA = pass >= 2;
        const float* W2 = (isA ? p.in(I_RW_A2) : p.in(I_RW_W2)) + (size_t)((l * 2 + d) * 32) * 256 + c;
        const float base = (isA ? p.in(I_RW_A0) : p.in(I_RW_W0))[(l * 2 + d) * 256 + c];
        float wr[32];
#pragma unroll
        for (int r = 0; r < 32; ++r) wr[r] = W2[r * 256];
        const float* src = isA ? al : tw;
#pragma unroll 2
        for (int tok = 0; tok < 32; ++tok) {
            float a = base;
#pragma unroll
            for (int r = 0; r < 32; r += 4) {
                const float4 x = *reinterpret_cast<const float4*>(src + tok * 64 + d * 32 + r);
                a += x.x * wr[r] + x.y * wr[r + 1] + x.z * wr[r + 2] + x.w * wr[r + 3];
            }
            float o;
            if (isA) o = 1.f / (1.f + expf(-a));
            else o = expf(-softplusf(-a) - 0.5f);
            rwp[((size_t)(row0 + tok) * 4 + pass) * 256 + c] = f2bf(o);
        }
    }
    const float kkc = p.in(I_RW_KK)[l * 256 + c];
#pragma unroll 4
    for (int tok = 0; tok < 32; ++tok) {
        const float kv = bf2f(z[(size_t)(row0 + tok) * ZS + 256 + c]) * kkc;
        const float ss = wave_sum(kv * kv);
        if ((tid & 63) == 0) knorm[(size_t)(row0 + tok) * 4 + w] = rsqrtf(ss + 1e-12f);
    }
    __syncthreads();
}

__device__ __forceinline__ void gdn_prep_unit(const P& p, int l, int u) {
    const int tid = otid();
    const bf16_t* z = (const bf16_t*)(p.ws + WS_Z);
    bf16_t* gq = (bf16_t*)(p.ws + WS_R1 + R1_GQ);
    float* gab = (float*)(p.ws + WS_GAB);
    const int row0 = u * 32;
    int seq0, seqL;
    if (row0 < NTC) { seq0 = row0 & ~255; seqL = 256; } else { seq0 = NTC + ((row0 - NTC) & ~4095); seqL = 4096; }
#pragma unroll 1
    for (int pz = 0; pz < 3; ++pz) {
        const int ch = pz * 256 + tid;
        const float w0 = p.in(I_GD_CONV)[(size_t)(l * 3 + 0) * 768 + ch], w1 = p.in(I_GD_CONV)[(size_t)(l * 3 + 1) * 768 + ch], w2 = p.in(I_GD_CONV)[(size_t)(l * 3 + 2) * 768 + ch];
        const bf16_t* zc = z + COL_GD + ch;
        float xm = (row0 - 1 >= seq0) ? bf2f(zc[(size_t)(row0 - 1) * ZS]) : 0.f;
        float x0 = bf2f(zc[(size_t)row0 * ZS]);
#pragma unroll 4
        for (int tok = 0; tok < 32; ++tok) {
            const int row = row0 + tok;
            const float xp = (row + 1 < seq0 + seqL) ? bf2f(zc[(size_t)(row + 1) * ZS]) : 0.f;
            float v = siluf(w0 * xm + w1 * x0 + w2 * xp);
            if (pz < 2) {
                const float ss = wave_sum(v * v);
                v *= rsqrtf(ss + 1e-12f) * (pz == 0 ? 0.125f : 1.f);
            }
            gq[(size_t)row * 768 + ch] = f2bf(v);
            xm = x0; x0 = xp;
        }
    }
    {
        const int tok = tid >> 3, dh = tid & 7;
        const int row = row0 + tok;
        const float alv = bf2f(z[(size_t)row * ZS + COL_GD + 1024 + dh]);
        const float blv = bf2f(z[(size_t)row * ZS + COL_GD + 1032 + dh]);
        const float g = -expf(p.in(I_GD_ALOG)[l * 8 + dh]) * softplusf(alv + p.in(I_GD_DTB)[l * 8 + dh]);
        gab[(size_t)row * 16 + dh] = expf(g);
        gab[(size_t)row * 16 + 8 + dh] = 1.f / (1.f + expf(-blv));
    }
}

__device__ __forceinline__ int s5_chain_row(int b, int d, int q) {
    if (q < 256) return b * 256 + (d ? 255 - q : q);
    int n = q - 256; if (d) n = 4095 - n;
    return NTC + b * 4096 + (n & 63) * 64 + (n >> 6);
}
__device__ __forceinline__ void s5_load_u(const bf16_t* zr, float* dst) {
    const uint4 a = *reinterpret_cast<const uint4*>(zr);
    const uint4 b = *reinterpret_cast<const uint4*>(zr + 8);
    *reinterpret_cast<float4*>(dst + 0) = make_float4(bflo(a.x), bfhi(a.x), bflo(a.y), bfhi(a.y));
    *reinterpret_cast<float4*>(dst + 4) = make_float4(bflo(a.z), bfhi(a.z), bflo(a.w), bfhi(a.w));
    *reinterpret_cast<float4*>(dst + 8) = make_float4(bflo(b.x), bfhi(b.x), bflo(b.y), bfhi(b.y));
    *reinterpret_cast<float4*>(dst + 12) = make_float4(bflo(b.z), bfhi(b.z), bflo(b.w), bfhi(b.w));
}

__device__ __forceinline__ void s5_pre_unit(const P& p, int l, int u, char* lds) {
    const int tid = otid(), w = tid >> 6, lane = tid & 63;
    float* ust = (float*)lds + w * 1024;
    const int wt = u * 4 + w;
    const int d = wt & 1, g = (wt >> 1) & 15, rest = wt >> 5;
    const int cc = rest % NCHUNK, b = rest / NCHUNK;
    const bf16_t* z = (const bf16_t*)(p.ws + WS_Z);
    {
        const int row = s5_chain_row(b, d, cc * 64 + lane);
        s5_load_u(z + (size_t)row * ZS + COL_S5 + g * 16, ust + lane * 16);
    }
    const int tix = ((l * 2 + d) * 16 + g) * 64 + lane;
    const float4 A = *reinterpret_cast<const float4*>((const float*)(p.ws + WS_S5A) + (size_t)tix * 4);
    const float* Bp = (const float*)(p.ws + WS_S5B) + (size_t)tix * 32;
    float br[16], bi[16];
#pragma unroll
    for (int h = 0; h < 16; ++h) { br[h] = Bp[h]; bi[h] = Bp[16 + h]; }
    float xr = 0.f, xi = 0.f;
#pragma unroll 2
    for (int s = 0; s < 64; ++s) {
        float ur = 0.f, ui = 0.f;
#pragma unroll
        for (int h4 = 0; h4 < 4; ++h4) {
            const float4 uu = *reinterpret_cast<const float4*>(ust + s * 16 + h4 * 4);
            ur += br[h4 * 4] * uu.x + br[h4 * 4 + 1] * uu.y + br[h4 * 4 + 2] * uu.z + br[h4 * 4 + 3] * uu.w;
            ui += bi[h4 * 4] * uu.x + bi[h4 * 4 + 1] * uu.y + bi[h4 * 4 + 2] * uu.z + bi[h4 * 4 + 3] * uu.w;
        }
        const float nr = A.x * xr - A.y * xi + ur;
        const float ni = A.x * xi + A.y * xr + ui;
        xr = nr; xi = ni;
    }
    float* st = (float*)(p.ws + WS_S5ST) + ((((size_t)(b * NCHUNK + cc) * 2 + d) * 16 + g) * 64 + lane) * 2;
    st[0] = xr; st[1] = xi;
}

__device__ __forceinline__ float reduce16(const float (&t)[16], int lane) {
    float a[8];
    const bool hi8 = (lane & 8) != 0;
#pragma unroll
    for (int k = 0; k < 8; ++k) { const float keep = hi8 ? t[k + 8] : t[k]; const float send = hi8 ? t[k] : t[k + 8]; a[k] = keep + dppf<0x140>(send); }
    float b[4];
    const bool hi4 = (lane & 4) != 0;
#pragma unroll
    for (int k = 0; k < 4; ++k) { const float keep = hi4 ? a[k + 4] : a[k]; const float send = hi4 ? a[k] : a[k + 4]; b[k] = keep + dppf<0x141>(send); }
    float c[2];
    const bool hi2 = (lane & 2) != 0;
#pragma unroll
    for (int k = 0; k < 2; ++k) { const float keep = hi2 ? b[k + 2] : b[k]; const float send = hi2 ? b[k] : b[k + 2]; c[k] = keep + dppf<0x4E>(send); }
    const bool hi1 = (lane & 1) != 0;
    float r = (hi1 ? c[1] : c[0]) + dppf<0xB1>(hi1 ? c[0] : c[1]);
    r += __shfl_xor(r, 16);
    r += __shfl_xor(r, 32);
    return r;
}

__device__ __forceinline__ void s5_main_unit(const P& p, int l, int u, char* lds) {
    const int tid = otid(), w = tid >> 6, lane = tid & 63;
    char* wl = lds + w * 12800;
    float* ust = (float*)wl;
    char* xbuf = wl + 4096;
    float* yst = (float*)xbuf;
    const int b = u / NCHUNK, tc = u % NCHUNK;
    bf16_t* z = (bf16_t*)(p.ws + WS_Z);
    const int myrow = (tc < 4) ? (b * 256 + tc * 64 + lane) : (NTC + b * 4096 + lane * 64 + (tc - 4));
    const int fr = lane & 15, fq = lane >> 4;
#pragma unroll 1
    for (int gi = 0; gi < 4; ++gi) {
        const int g = w * 4 + gi;
        s5_load_u(z + (size_t)myrow * ZS + COL_S5 + g * 16, ust + lane * 16);
        f32x4 yacc[4];
#pragma unroll
        for (int mf = 0; mf < 4; ++mf) yacc[mf] = f32x4{0.f, 0.f, 0.f, 0.f};
#pragma unroll 1
        for (int d = 0; d < 2; ++d) {
            const int tix = ((l * 2 + d) * 16 + g) * 64 + lane;
            const float4 A = *reinterpret_cast<const float4*>((const float*)(p.ws + WS_S5A) + (size_t)tix * 4);
            const float* Bp = (const float*)(p.ws + WS_S5B) + (size_t)tix * 32;
            f32x2 bb[16];
#pragma unroll
            for (int h = 0; h < 16; ++h) bb[h] = f32x2{Bp[h], Bp[16 + h]};
            bf16x8 cfrag[4];
            {
                const float* crp = p.in(I_S5_CRE) + (size_t)((l * 2 + d) * 16 + g) * 1024 + fr * 64;
                const float* cip = p.in(I_S5_CIM) + (size_t)((l * 2 + d) * 16 + g) * 1024 + fr * 64;
#pragma unroll
                for (int ks = 0; ks < 4; ++ks) {
                    const int k0 = (ks & 1) * 32 + fq * 8;
                    const float* src = (ks < 2) ? crp + k0 : cip + k0;
                    const float sg = (ks < 2) ? 1.f : -1.f;
                    const float4 c0 = *reinterpret_cast<const float4*>(src), c1 = *reinterpret_cast<const float4*>(src + 4);
                    cfrag[ks][0] = (short)f2bf(sg * c0.x); cfrag[ks][1] = (short)f2bf(sg * c0.y); cfrag[ks][2] = (short)f2bf(sg * c0.z); cfrag[ks][3] = (short)f2bf(sg * c0.w);
                    cfrag[ks][4] = (short)f2bf(sg * c1.x); cfrag[ks][5] = (short)f2bf(sg * c1.y); cfrag[ks][6] = (short)f2bf(sg * c1.z); cfrag[ks][7] = (short)f2bf(sg * c1.w);
                }
            }
            const int cc = d ? ((tc < 4) ? 3 - tc : 71 - tc) : tc;
            float xr = 0.f, xi = 0.f;
            {
                const float* st = (const float*)(p.ws + WS_S5ST) + ((((size_t)(b * NCHUNK) * 2 + d) * 16 + g) * 64 + lane) * 2;
                for (int c0 = 0; c0 < cc; c0 += 8) {
                    float2 sv[8];
#pragma unroll
                    for (int q = 0; q < 8; ++q) {
                        const int c2 = (c0 + q < cc) ? c0 + q : cc - 1;
                        sv[q] = *reinterpret_cast<const float2*>(st + (size_t)c2 * (2 * 16 * 64 * 2));
                    }
#pragma unroll
                    for (int q = 0; q < 8; ++q) {
                        if (c0 + q < cc) {
                            const float nr = A.z * xr - A.w * xi + sv[q].x;
                            const float ni = A.z * xi + A.w * xr + sv[q].y;
                            xr = nr; xi = ni;
                        }
                    }
                }
            }
#pragma unroll 1
            for (int hf = 0; hf < 2; ++hf) {
                const int hbase = (d ? 1 - hf : hf) * 32;
#pragma unroll 4
                for (int s = 0; s < 32; ++s) {
                    const int il = d ? 31 - s : s;
                    const float* up = ust + (hbase + il) * 16;
                    f32x2 bu = f32x2{0.f, 0.f};
#pragma unroll
                    for (int h4 = 0; h4 < 4; ++h4) {
                        const float4 uu = *reinterpret_cast<const float4*>(up + h4 * 4);
                        bu += bb[h4 * 4] * uu.x + bb[h4 * 4 + 1] * uu.y + bb[h4 * 4 + 2] * uu.z + bb[h4 * 4 + 3] * uu.w;
                    }
                    const float nr = A.x * xr - A.y * xi + bu.x;
                    const float ni = A.x * xi + A.y * xr + bu.y;
                    xr = nr; xi = ni;
                    *reinterpret_cast<bf16_t*>(xbuf + il * 272 + lane * 2) = f2bf(xr);
                    *reinterpret_cast<bf16_t*>(xbuf + il * 272 + 128 + lane * 2) = f2bf(xi);
                }
#pragma unroll
                for (int mfl = 0; mfl < 2; ++mfl) {
                    f32x4 acc = yacc[0];
                    const int mf = (hbase >> 4) + mfl;
                    acc = (mf == 0) ? yacc[0] : (mf == 1) ? yacc[1] : (mf == 2) ? yacc[2] : yacc[3];
#pragma unroll
                    for (int ks = 0; ks < 4; ++ks) {
                        const bf16x8 af = *reinterpret_cast<const bf16x8*>(xbuf + (mfl * 16 + fr) * 272 + ks * 64 + fq * 16);
                        acc = __builtin_amdgcn_mfma_f32_16x16x32_bf16(af, cfrag[ks], acc, 0, 0, 0);
                    }
                    if (mf == 0) yacc[0] = acc; else if (mf == 1) yacc[1] = acc; else if (mf == 2) yacc[2] = acc; else yacc[3] = acc;
                }
            }
        }
#pragma unroll
        for (int mf = 0; mf < 4; ++mf)
#pragma unroll
            for (int j = 0; j < 4; ++j) yst[(mf * 16 + fq * 4 + j) * 16 + fr] = yacc[mf][j];
        {
            const float* dsk = p.in(I_S5_D) + l * 256 + g * 16;
            unsigned pk[8];
#pragma unroll
            for (int h = 0; h < 16; h += 2) {
                float y0 = yst[lane * 16 + h] + ust[lane * 16 + h] * dsk[h];
                float y1 = yst[lane * 16 + h + 1] + ust[lane * 16 + h + 1] * dsk[h + 1];
                y0 = 0.5f * y0 * (1.f + erff(y0 * 0.70710678118f));
                y1 = 0.5f * y1 * (1.f + erff(y1 * 0.70710678118f));
                pk[h >> 1] = pack2(y0, y1);
            }
            uint4* dst = reinterpret_cast<uint4*>(z + (size_t)myrow * ZS + COL_S5 + g * 16);
            dst[0] = make_uint4(pk[0], pk[1], pk[2], pk[3]);
            dst[1] = make_uint4(pk[4], pk[5], pk[6], pk[7]);
        }
    }
}

#define SB 16
__device__ __forceinline__ int scan_chain_row(int b, int d, int q) {
    if (q < 256) return b * 256 + (d ? 255 - q : q);
    const int t = q - 256;
    return NTC + b * 4096 + (d ? 4095 - t : t);
}
struct ScanRaw { uint2 r, k, v, e, a; float f0, f1; };

__device__ __forceinline__ void scan_load(const P& p, int m, int b, int h, int d, int q, int cg, ScanRaw& R) {
    const int row = scan_chain_row(b, d, q);
    const int c0 = h * 64 + cg * 4;
    if (m == 0) {
        const bf16_t* z = (const bf16_t*)(p.ws + WS_Z) + (size_t)row * ZS + c0;
        R.r = *reinterpret_cast<const uint2*>(z);
        R.k = *reinterpret_cast<const uint2*>(z + 256);
        R.v = *reinterpret_cast<const uint2*>(z + 512);
        const bf16_t* rw = (const bf16_t*)(p.ws + WS_R1 + R1_RWP) + (size_t)row * 1024 + c0;
        R.e = *reinterpret_cast<const uint2*>(rw + d * 256);
        R.a = *reinterpret_cast<const uint2*>(rw + (2 + d) * 256);
        R.f0 = ((const float*)(p.ws + WS_KNORM))[(size_t)row * 4 + h];
        R.f1 = 0.f;
    } else {
        const bf16_t* gq = (const bf16_t*)(p.ws + WS_R1 + R1_GQ) + (size_t)row * 768 + c0;
        R.r = *reinterpret_cast<const uint2*>(gq);
        R.k = *reinterpret_cast<const uint2*>(gq + 256);
        R.v = *reinterpret_cast<const uint2*>(gq + 512);
        R.e = make_uint2(0u, 0u); R.a = make_uint2(0u, 0u);
        const float* gab = (const float*)(p.ws + WS_GAB) + (size_t)row * 16;
        R.f0 = gab[d * 4 + h];
        R.f1 = gab[8 + d * 4 + h];
    }
}
__device__ __forceinline__ void scan_store(int m, const ScanRaw& R, float* dst  , const float (&kkp)[4], const float (&kap)[4]) {
    float r[4] = {bflo(R.r.x), bfhi(R.r.x), bflo(R.r.y), bfhi(R.r.y)};
    float k[4] = {bflo(R.k.x), bfhi(R.k.x), bflo(R.k.y), bfhi(R.k.y)};
    float v[4] = {bflo(R.v.x), bfhi(R.v.x), bflo(R.v.y), bfhi(R.v.y)};
    float ww[4], aa[4], bb[4], kk[4];
    if (m == 0) {
        float e[4] = {bflo(R.e.x), bfhi(R.e.x), bflo(R.e.y), bfhi(R.e.y)};
        float a[4] = {bflo(R.a.x), bfhi(R.a.x), bflo(R.a.y), bfhi(R.a.y)};
#pragma unroll
        for (int i = 0; i < 4; ++i) {
            ww[i] = __expf(-e[i]);
            kk[i] = k[i] * (1.f + (a[i] - 1.f) * kap[i]);
            const float kn = k[i] * kkp[i] * R.f0;
            aa[i] = -kn;
            bb[i] = kn * a[i];
        }
    } else {
        const float al = R.f0, be = R.f1;
#pragma unroll
        for (int i = 0; i < 4; ++i) { ww[i] = al; aa[i] = k[i]; bb[i] = -al * be * k[i]; kk[i] = be * k[i]; }
    }
    *reinterpret_cast<float4*>(dst + 0 * 64) = make_float4(ww[0], ww[1], ww[2], ww[3]);
    *reinterpret_cast<float4*>(dst + 1 * 64) = make_float4(aa[0], aa[1], aa[2], aa[3]);
    *reinterpret_cast<float4*>(dst + 2 * 64) = make_float4(bb[0], bb[1], bb[2], bb[3]);
    *reinterpret_cast<float4*>(dst + 3 * 64) = make_float4(kk[0], kk[1], kk[2], kk[3]);
    *reinterpret_cast<float4*>(dst + 4 * 64) = make_float4(r[0], r[1], r[2], r[3]);
    *reinterpret_cast<float4*>(dst + 5 * 64) = make_float4(v[0], v[1], v[2], v[3]);
}

__device__ __forceinline__ void scan_unit(const P& p, int l, int u, char* lds) {
    const int tid = otid();
    const int chain = u >> 1, half = u & 1;
    const int m = chain >> 6, rem = chain & 63, b = rem >> 3, h = (rem >> 1) & 3, d = rem & 1;
    float* buf = (float*)lds;
    float* ybuf = buf + 2 * SB * 384;
    const int rp = tid >> 4, sub = tid & 15;
    const int st = tid >> 4, cg = tid & 15;
    float kkp[4], kap[4];
#pragma unroll
    for (int i = 0; i < 4; ++i) { kkp[i] = p.in(I_RW_KK)[l * 256 + h * 64 + cg * 4 + i]; kap[i] = p.in(I_RW_KA)[l * 256 + h * 64 + cg * 4 + i]; }
    bf16_t* ys = (bf16_t*)(p.ws + WS_HBY) + (size_t)(m * 2 + d) * NT * 256;
    f32x2 S2[4];
#pragma unroll
    for (int j = 0; j < 4; ++j) S2[j] = f32x2{0.f, 0.f};
    ScanRaw R, R2;
    scan_load(p, m, b, h, d, st, cg, R);
    scan_store(m, R, buf + (st * 6) * 64 + cg * 4, kkp, kap);
    scan_load(p, m, b, h, d, SB + st, cg, R);
    __syncthreads();
    const int NB = 4352 / SB;
    __builtin_amdgcn_s_setprio(2);
    auto batch = [&](int bt, ScanRaw& Rld, ScanRaw& Rst) {
        const int par = bt & 1;
        if (bt + 2 < NB) scan_load(p, m, b, h, d, (bt + 2) * SB + st, cg, Rld);
        const float* cb = buf + par * (SB * 384);
        float* yb = ybuf + par * (SB * 32);
        {
            const float* sb0 = cb + sub * 4;
            const float* vb0 = cb + 320 + half * 32 + rp;
            float4 nw = *reinterpret_cast<const float4*>(sb0), na = *reinterpret_cast<const float4*>(sb0 + 64), nb = *reinterpret_cast<const float4*>(sb0 + 128);
            float4 nk = *reinterpret_cast<const float4*>(sb0 + 192), nr = *reinterpret_cast<const float4*>(sb0 + 256);
            float nvA = vb0[0], nvB = vb0[16];
#pragma unroll
            for (int s = 0; s < SB; ++s) {
                const float4 w = nw, a = na, bq = nb, k = nk, r = nr;
                const float vA = nvA, vB = nvB;
                if (s + 1 < SB) {
                    const float* sb = sb0 + (s + 1) * 384;
                    nw = *reinterpret_cast<const float4*>(sb); na = *reinterpret_cast<const float4*>(sb + 64); nb = *reinterpret_cast<const float4*>(sb + 128);
                    nk = *reinterpret_cast<const float4*>(sb + 192); nr = *reinterpret_cast<const float4*>(sb + 256);
                    nvA = vb0[(s + 1) * 384]; nvB = vb0[(s + 1) * 384 + 16];
                }
                __builtin_amdgcn_sched_barrier(0);
                const f32x2 v2 = {vA, vB};
                f32x2 sa2 = (S2[0] * a.x + S2[1] * a.y) + (S2[2] * a.z + S2[3] * a.w);
                float sa = sa2.x, sb2 = sa2.y;
                sa += dppf<0xB1>(sa); sb2 += dppf<0xB1>(sb2);
                sa += dppf<0x4E>(sa); sb2 += dppf<0x4E>(sb2);
                sa += dppf<0x141>(sa); sb2 += dppf<0x141>(sb2);
                sa += dppf<0x140>(sa); sb2 += dppf<0x140>(sb2);
                sa2.x = sa; sa2.y = sb2;
                S2[0] = S2[0] * w.x + sa2 * bq.x + v2 * k.x;
                S2[1] = S2[1] * w.y + sa2 * bq.y + v2 * k.y;
                S2[2] = S2[2] * w.z + sa2 * bq.z + v2 * k.z;
                S2[3] = S2[3] * w.w + sa2 * bq.w + v2 * k.w;
                const f32x2 y2 = (S2[0] * r.x + S2[1] * r.y) + (S2[2] * r.z + S2[3] * r.w);
                float yA = y2.x, yB = y2.y;
                yA += dppf<0xB1>(yA); yB += dppf<0xB1>(yB);
                yA += dppf<0x4E>(yA); yB += dppf<0x4E>(yB);
                yA += dppf<0x141>(yA); yB += dppf<0x141>(yB);
                yA += dppf<0x140>(yA); yB += dppf<0x140>(yB);
                yb[s * 32 + rp] = yA; yb[s * 32 + 16 + rp] = yB;
            }
        }
        if (bt + 1 < NB) scan_store(m, Rst, buf + (1 - par) * (SB * 384) + (st * 6) * 64 + cg * 4, kkp, kap);
        __syncthreads();
        {
            const int r2 = cg * 2;
            const int row = scan_chain_row(b, d, bt * SB + st);
            const unsigned pk = pack2(yb[st * 32 + r2], yb[st * 32 + r2 + 1]);
            *reinterpret_cast<unsigned*>(ys + (size_t)row * 256 + h * 64 + half * 32 + r2) = pk;
        }
    };
#pragma unroll 1
    for (int bt = 0; bt < NB; bt += 2) { batch(bt, R2, R); batch(bt + 1, R, R2); }
    __builtin_amdgcn_s_setprio(0);
    __syncthreads();
}

template <int L>
__device__ __forceinline__ void hyena_unit(const P& p, int l, int u, char* lds) {
    constexpr int TPT = L / 256;
    const int tid = otid();
    const int c = u >> 2, bp = u & 3;
    float2* u2 = (float2*)lds;
    float* taps = (float*)(lds + (size_t)L * 8);
    const bf16_t* z = (const bf16_t*)(p.ws + WS_Z);
    bf16_t* cat = (bf16_t*)(p.ws + WS_CAT);
    const float* F = (L == 4096) ? (const float*)(p.ws + WS_FILTL) : (const float*)(p.ws + WS_FILTC);
    int base[2];
#pragma unroll
    for (int bb = 0; bb < 2; ++bb) { const int b = bp * 2 + bb; base[bb] = (L == 4096) ? NTC + b * 4096 : b * 256; }
    const int t0 = tid * TPT;
    const float* cw = p.in(I_HY_CONV) + (size_t)l * 3 * 768; const float* cb = p.in(I_HY_CONVB) + (size_t)l * 768;
    auto sconv = [&](int part, int bb, float (&o)[TPT]) {
        const int ch = part * 256 + c;
        const float w0 = cw[ch], w1 = cw[768 + ch], w2 = cw[1536 + ch], bs = cb[ch];
        const bf16_t* zc = z + (size_t)base[bb] * ZS + COL_HY + ch;
        float xm = (t0 > 0) ? bf2f(zc[(size_t)(t0 - 1) * ZS]) : 0.f;
        float x0 = bf2f(zc[(size_t)t0 * ZS]);
#pragma unroll
        for (int i = 0; i < TPT; ++i) {
            const int t = t0 + i;
            const float xp = (t + 1 < L) ? bf2f(zc[(size_t)(t + 1) * ZS]) : 0.f;
            o[i] = w0 * xm + w1 * x0 + w2 * xp + bs;
            xm = x0; x0 = xp;
        }
    };
    {
        float v0[TPT], v1[TPT];
        sconv(2, 0, v0); sconv(2, 1, v1);
#pragma unroll
        for (int i = 0; i < TPT; ++i) u2[t0 + i] = make_float2(v0[i], v1[i]);
    }
#pragma unroll 1
    for (int o = 0; o < 2; ++o) {
        const float* hf = F + ((size_t)(o * 2 + 0) * 256 + c) * L;
        const float* hbk = F + ((size_t)(o * 2 + 1) * 256 + c) * L;
        for (int k = tid; k < 2 * L; k += NTHREADS) {
            const int dd = k - (L - 1);
            taps[k] = (dd >= L) ? 0.f : (dd >= 0 ? hf[dd] : hbk[-dd]);
        }
        __syncthreads();
        float acc[TPT][2];
#pragma unroll
        for (int i = 0; i < TPT; ++i) { acc[i][0] = 0.f; acc[i][1] = 0.f; }
        if (L == 4096) {
#pragma unroll 1
            for (int s0 = 0; s0 < L; s0 += 16) {
                const int k0 = t0 - s0 + (L - 16);
                float W[32];
#pragma unroll
                for (int q = 0; q < 8; ++q) {
                    const float4 t4 = *reinterpret_cast<const float4*>(taps + k0 + q * 4);
                    W[q * 4] = t4.x; W[q * 4 + 1] = t4.y; W[q * 4 + 2] = t4.z; W[q * 4 + 3] = t4.w;
                }
#pragma unroll
                for (int j = 0; j < 16; ++j) {
                    const float2 uj = u2[s0 + j];
#pragma unroll
                    for (int i = 0; i < TPT; ++i) {
                        const float wv = W[(i - j + 15) & 31];
                        acc[i][0] += wv * uj.x; acc[i][1] += wv * uj.y;
                    }
                }
            }
        } else {
            for (int s = 0; s < L; ++s) {
                const float2 uj = u2[s];
                const float wv = taps[t0 - s + (L - 1)];
                acc[0][0] += wv * uj.x; acc[0][1] += wv * uj.y;
            }
        }
        const float sk = p.in(I_HY_SKIP)[(size_t)(l * 2 + o) * 256 + c];
        float res[TPT][2];
        {
            float g0[TPT], g1[TPT];
            sconv(o, 0, g0); sconv(o, 1, g1);
#pragma unroll
            for (int i = 0; i < TPT; ++i) {
                const float2 ut = u2[t0 + i];
                res[i][0] = g0[i] * (acc[i][0] + sk * ut.x);
                res[i][1] = g1[i] * (acc[i][1] + sk * ut.y);
            }
        }
        __syncthreads();
        if (o == 0) {
#pragma unroll
            for (int i = 0; i < TPT; ++i) u2[t0 + i] = make_float2(res[i][0], res[i][1]);
        } else {
#pragma unroll
            for (int i = 0; i < TPT; ++i) {
                cat[(size_t)(base[0] + t0 + i) * DM + 512 + c] = f2bf(res[i][0]);
                cat[(size_t)(base[1] + t0 + i) * DM + 512 + c] = f2bf(res[i][1]);
            }
        }
        __syncthreads();
    }
}


#define FFT_BS 272
__device__ __forceinline__ int fphys(int d2, int d1, int d0) { return d2 * FFT_BS + d1 * 17 + d0; }
__device__ __forceinline__ float2 cmulf(float2 a, float2 b) { return make_float2(a.x * b.x - a.y * b.y, a.x * b.y + a.y * b.x); }
__device__ static constexpr float C32T[16] = {1.000000000e+00f, 9.807852804e-01f, 9.238795325e-01f, 8.314696123e-01f, 7.071067812e-01f, 5.555702330e-01f, 3.826834324e-01f, 1.950903220e-01f, 6.123233996e-17f, -1.950903220e-01f, -3.826834324e-01f, -5.555702330e-01f, -7.071067812e-01f, -8.314696123e-01f, -9.238795325e-01f, -9.807852804e-01f};
__device__ static constexpr float S32T[16] = {0.000000000e+00f, 1.950903220e-01f, 3.826834324e-01f, 5.555702330e-01f, 7.071067812e-01f, 8.314696123e-01f, 9.238795325e-01f, 9.807852804e-01f, 1.000000000e+00f, 9.807852804e-01f, 9.238795325e-01f, 8.314696123e-01f, 7.071067812e-01f, 5.555702330e-01f, 3.826834324e-01f, 1.950903220e-01f};
template <int LOG> __device__ __forceinline__ constexpr int brev(int i) { int r = 0; for (int b = 0; b < LOG; ++b) r |= ((i >> b) & 1) << (LOG - 1 - b); return r; }
template <int R, bool INV> __device__ __forceinline__ void dftR(float2 (&v)[R]) {
    constexpr int LOG = (R == 32) ? 5 : 4;
    float2 t[R];
#pragma unroll
    for (int i = 0; i < R; ++i) t[brev<LOG>(i)] = v[i];
#pragma unroll
    for (int st = 1; st <= LOG; ++st) {
        const int len = 1 << st, half = len >> 1;
#pragma unroll
        for (int i = 0; i < R; i += len)
#pragma unroll
            for (int j = 0; j < half; ++j) {
                const int tw = j * (32 / len);
                const float2 a = t[i + j], b = t[i + j + half];
                float2 bw;
                if (tw == 0) bw = b;
                else if (tw == 8) bw = INV ? make_float2(-b.y, b.x) : make_float2(b.y, -b.x);
                else { const float wr = C32T[tw], wi = INV ? S32T[tw] : -S32T[tw]; bw = make_float2(b.x * wr - b.y * wi, b.x * wi + b.y * wr); }
                t[i + j] = make_float2(a.x + bw.x, a.y + bw.y);
                t[i + j + half] = make_float2(a.x - bw.x, a.y - bw.y);
            }
    }
#pragma unroll
    for (int i = 0; i < R; ++i) v[i] = t[i];
}
template <int R> __device__ __forceinline__ void twiddle_pow(float2 (&v)[R], float2 first, float2 base) {
    float2 w = first;
#pragma unroll
    for (int k = 0; k < R; ++k) { v[k] = cmulf(v[k], w); w = cmulf(w, base); }
}
__device__ __forceinline__ float2 cispi(float x) { float sn, cs; sincospif(x, &sn, &cs); return make_float2(cs, sn); }

__device__ __forceinline__ void fft_fwd_A_B1(float2 (&v)[32], float2* buf, int tid_in) {
    int tid = tid_in; asm volatile("" : "+v"(tid));
    const int a = tid >> 4, b = tid & 15;
    dftR<32, false>(v);
    twiddle_pow<32>(v, make_float2(1.f, 0.f), cispi(-2.f * (float)tid * (1.f / 8192.f)));
#pragma unroll
    for (int k1 = 0; k1 < 32; ++k1) buf[fphys(k1, a, b)] = v[k1];
    __syncthreads();
#pragma unroll 1
    for (int j = 0; j < 2; ++j) {
        const int g = tid + 256 * j, k1 = g >> 4, bb = g & 15;
        float2 w[16];
#pragma unroll
        for (int aa = 0; aa < 16; ++aa) w[aa] = buf[fphys(k1, aa, bb)];
        dftR<16, false>(w);
        twiddle_pow<16>(w, make_float2(1.f, 0.f), cispi(-2.f * (float)bb * (1.f / 256.f)));
#pragma unroll
        for (int ka = 0; ka < 16; ++ka) buf[fphys(k1, ka, bb)] = w[ka];
    }
    __syncthreads();
}
__device__ __forceinline__ void fft_inv_B1_A(float2 (&v)[32], float2* buf, int tid_in) {
    int tid = tid_in; asm volatile("" : "+v"(tid));
#pragma unroll 1
    for (int j = 0; j < 2; ++j) {
        const int g = tid + 256 * j, k1 = g >> 4, bb = g & 15;
        float2 w[16];
#pragma unroll
        for (int ka = 0; ka < 16; ++ka) w[ka] = buf[fphys(k1, ka, bb)];
        dftR<16, true>(w);
        twiddle_pow<16>(w, cispi(2.f * (float)(k1 * bb) * (1.f / 8192.f)), cispi(2.f * (float)k1 * (1.f / 512.f)));
#pragma unroll
        for (int aa = 0; aa < 16; ++aa) buf[fphys(k1, aa, bb)] = w[aa];
    }
    __syncthreads();
    const int a = tid >> 4, b = tid & 15;
#pragma unroll
    for (int k1 = 0; k1 < 32; ++k1) v[k1] = buf[fphys(k1, a, b)];
    dftR<32, true>(v);
}

__device__ __forceinline__ void hfft_unit(const P& p, int l, int u, char* lds) {
    const int tid = otid();
    float2* buf = (float2*)lds;
    float* F = (float*)(p.ws + WS_FILTL) + (size_t)u * 8192;
    float2 v[32];
#pragma unroll
    for (int n1 = 0; n1 < 32; ++n1) {
        const int n = 256 * n1 + tid;
        float x;
        if (n1 < 16) x = F[n];
        else x = (n == 4096) ? 0.f : F[4096 + (8192 - n)];
        if (n == 0) x += p.in(I_HY_SKIP)[(size_t)l * 512 + u];
        v[n1] = make_float2(x, 0.f);
    }
    fft_fwd_A_B1(v, buf, tid);
    __half2* H = (__half2*)F;
#pragma unroll 1
    for (int j = 0; j < 2; ++j) {
        const int g = tid + 256 * j, k1 = g >> 4, ka = g & 15;
        float2 w[16];
#pragma unroll
        for (int bb = 0; bb < 16; ++bb) w[bb] = buf[fphys(k1, ka, bb)];
        dftR<16, false>(w);
        unsigned pk[16];
#pragma unroll
        for (int kb = 0; kb < 16; ++kb) { const __half2 h = __floats2half2_rn(w[kb].x, w[kb].y); pk[kb] = *reinterpret_cast<const unsigned*>(&h); }
        uint4* dst = reinterpret_cast<uint4*>(H + (size_t)g * 16);
        dst[0] = make_uint4(pk[0], pk[1], pk[2], pk[3]); dst[1] = make_uint4(pk[4], pk[5], pk[6], pk[7]);
        dst[2] = make_uint4(pk[8], pk[9], pk[10], pk[11]); dst[3] = make_uint4(pk[12], pk[13], pk[14], pk[15]);
    }
    __syncthreads();
}

__device__ __forceinline__ void hyena_prep_unit(const P& p, int l, int u, char* lds) {
    const int tid = otid();
    bf16_t* tile = (bf16_t*)lds;
    const int b = u >> 6, t0 = (u & 63) * 64;
    const bf16_t* z = (const bf16_t*)(p.ws + WS_Z) + (size_t)(NTC + b * 4096) * ZS + COL_HY;
    bf16_t* hyT = (bf16_t*)(p.ws + WS_HYT);
    const float* cw = p.in(I_HY_CONV) + (size_t)l * 3 * 768; const float* cb = p.in(I_HY_CONVB) + (size_t)l * 768;
#pragma unroll 1
    for (int part = 0; part < 3; ++part) {
        const int ch = part * 256 + tid;
        const float w0 = cw[ch], w1 = cw[768 + ch], w2 = cw[1536 + ch], bs = cb[ch];
        const bf16_t* zc = z + ch;
        float xm = (t0 > 0) ? bf2f(zc[(size_t)(t0 - 1) * ZS]) : 0.f;
        float x0 = bf2f(zc[(size_t)t0 * ZS]);
#pragma unroll 8
        for (int i = 0; i < 64; ++i) {
            const int t = t0 + i;
            const float xp = (t + 1 < 4096) ? bf2f(zc[(size_t)(t + 1) * ZS]) : 0.f;
            tile[tid * 72 + i] = f2bf(w0 * xm + w1 * x0 + w2 * xp + bs);
            xm = x0; x0 = xp;
        }
        __syncthreads();
#pragma unroll
        for (int k = 0; k < 8; ++k) {
            const int chl = (tid >> 3) + 32 * k, seg = tid & 7;
            const uint4 val = *reinterpret_cast<const uint4*>(tile + chl * 72 + seg * 8);
            *reinterpret_cast<uint4*>(hyT + ((size_t)(b * 3 + part) * 256 + chl) * 4096 + t0 + seg * 8) = val;
        }
        __syncthreads();
    }
}

template <int O>
__device__ __forceinline__ void hyena_conv_pass(const P& p, int c, int bp, int tid, float2 (&v)[32], float2* buf) {
    const bf16_t* hyT = (const bf16_t*)(p.ws + WS_HYT);
#pragma unroll
    for (int j = 16; j < 32; ++j) v[j] = make_float2(0.f, 0.f);
    fft_fwd_A_B1(v, buf, tid);
    const __half2* H = (const __half2*)((const float*)(p.ws + WS_FILTL) + (size_t)(O * 256 + c) * 8192);
    int tm = tid; asm volatile("" : "+v"(tm));
#pragma unroll 1
    for (int j = 0; j < 2; ++j) {
        const int g = tm + 256 * j, k1 = g >> 4, ka = g & 15;
        float2 w[16];
#pragma unroll
        for (int bb = 0; bb < 16; ++bb) w[bb] = buf[fphys(k1, ka, bb)];
        dftR<16, false>(w);
        const uint4* hp = reinterpret_cast<const uint4*>(H + (size_t)g * 16);
        unsigned hk[16];
#pragma unroll
        for (int q = 0; q < 4; ++q) { const uint4 t4 = hp[q]; hk[q * 4] = t4.x; hk[q * 4 + 1] = t4.y; hk[q * 4 + 2] = t4.z; hk[q * 4 + 3] = t4.w; }
#pragma unroll
        for (int kb = 0; kb < 16; ++kb) { const float2 hf = __half22float2(*reinterpret_cast<const __half2*>(&hk[kb])); w[kb] = cmulf(w[kb], hf); }
        dftR<16, true>(w);
        twiddle_pow<16>(w, make_float2(1.f, 0.f), cispi(2.f * (float)ka * (1.f / 256.f)));
#pragma unroll
        for (int bb = 0; bb < 16; ++bb) buf[fphys(k1, ka, bb)] = w[bb];
    }
    __syncthreads();
    fft_inv_B1_A(v, buf, tid);
    asm volatile("" ::: "memory");
    int tq = tid; asm volatile("" : "+v"(tq));
    const bf16_t* g0 = hyT + ((size_t)((bp * 2 + 0) * 3 + O) * 256 + c) * 4096 + tq;
    const bf16_t* g1 = hyT + ((size_t)((bp * 2 + 1) * 3 + O) * 256 + c) * 4096 + tq;
    const float sc = 1.f / 8192.f;
#pragma unroll
    for (int j = 0; j < 16; ++j) {
        const float ga = bf2f(g0[256 * j]) * sc, gb = bf2f(g1[256 * j]) * sc;
        v[j] = make_float2(ga * v[j].x, gb * v[j].y);
    }
    __syncthreads();
}

__device__ __forceinline__ void hyena_fft_unit(const P& p, int l, int u, char* lds) {
    const int tid = otid();
    const int c = u >> 2, bp = u & 3;
    float2* buf = (float2*)lds;
    const bf16_t* hyT = (const bf16_t*)(p.ws + WS_HYT);
    bf16_t* cat = (bf16_t*)(p.ws + WS_CAT);
    float2 v[32];
    {
        const bf16_t* v0p = hyT + ((size_t)((bp * 2 + 0) * 3 + 2) * 256 + c) * 4096 + tid;
        const bf16_t* v1p = hyT + ((size_t)((bp * 2 + 1) * 3 + 2) * 256 + c) * 4096 + tid;
#pragma unroll
        for (int j = 0; j < 16; ++j) v[j] = make_float2(bf2f(v0p[256 * j]), bf2f(v1p[256 * j]));
    }
    hyena_conv_pass<0>(p, c, bp, tid, v, buf);
    hyena_conv_pass<1>(p, c, bp, tid, v, buf);
    int tq = tid; asm volatile("" : "+v"(tq));
#pragma unroll
    for (int j = 0; j < 16; ++j) {
        const int t = tq + 256 * j;
        cat[(size_t)(NTC + (bp * 2 + 0) * 4096 + t) * DM + 512 + c] = f2bf(v[j].x);
        cat[(size_t)(NTC + (bp * 2 + 1) * 4096 + t) * DM + 512 + c] = f2bf(v[j].y);
    }
}

__device__ __forceinline__ void rwkv_post_unit(const P& p, int l, int u, char* lds) {
    const int tid = otid(), c = tid;
    float* sg = (float*)lds;
    const bf16_t* z = (const bf16_t*)(p.ws + WS_Z);
    const bf16_t* rwp = (const bf16_t*)(p.ws + WS_R1 + R1_RWP);
    const bf16_t* ys = (const bf16_t*)(p.ws + WS_HBY);
    bf16_t* cat = (bf16_t*)(p.ws + WS_CAT);
    const int row0 = u * 32;
#pragma unroll
    for (int i = 0; i < 8; ++i) {
        const int idx = tid + 256 * i, tok = idx >> 6, j = idx & 63;
        sg[idx] = sigm(bf2f(z[(size_t)(row0 + tok) * ZS + 896 + j]));
    }
    __syncthreads();
    float g2r[64];
#pragma unroll
    for (int r = 0; r < 64; ++r) g2r[r] = p.in(I_RW_G2)[(size_t)(l * 64 + r) * 256 + c];
    const float ka = p.in(I_RW_KA)[l * 256 + c], rk = p.in(I_RW_RK)[l * 256 + c];
    const float gng = p.in(I_RW_GNG)[l * 256 + c], gnb = p.in(I_RW_GNB)[l * 256 + c];
#pragma unroll 2
    for (int tok = 0; tok < 32; ++tok) {
        const int row = row0 + tok;
        float g = 0.f;
#pragma unroll
        for (int r = 0; r < 64; r += 4) {
            const float4 x = *reinterpret_cast<const float4*>(sg + tok * 64 + r);
            g += x.x * g2r[r] + x.y * g2r[r + 1] + x.z * g2r[r + 2] + x.w * g2r[r + 3];
        }
        const float y = bf2f(ys[(size_t)row * 256 + c]) + bf2f(ys[(size_t)NT * 256 + (size_t)row * 256 + c]);
        const float mu = wave_sum(y) * (1.f / 64.f);
        const float dv = y - mu;
        const float var = wave_sum(dv * dv) * (1.f / 64.f);
        const float yn = dv * rsqrtf(var + 64e-5f) * gng + gnb;
        const bf16_t* zr = z + (size_t)row * ZS;
        const float r = bf2f(zr[c]), k = bf2f(zr[256 + c]), v = bf2f(zr[512 + c]);
        const float a0 = bf2f(rwp[((size_t)row * 4 + 2) * 256 + c]), a1 = bf2f(rwp[((size_t)row * 4 + 3) * 256 + c]);
        const float kd = k * (1.f + (a0 - 1.f) * ka) + k * (1.f + (a1 - 1.f) * ka);
        const float dot = wave_sum(r * kd * rk);
        cat[(size_t)row * DM + c] = f2bf((yn + dot * v) * g);
    }
    __syncthreads();
}

__device__ __forceinline__ void gdn_post_unit(const P& p, int l, int u) {
    const int tid = otid(), c = tid;
    const bf16_t* z = (const bf16_t*)(p.ws + WS_Z);
    const bf16_t* ys = (const bf16_t*)(p.ws + WS_HBY) + (size_t)2 * NT * 256;
    bf16_t* cat = (bf16_t*)(p.ws + WS_CAT);
    const float ng = p.in(I_GD_NORM)[l * 64 + (c & 63)];
    const int row0 = u * 32;
#pragma unroll 4
    for (int tok = 0; tok < 32; ++tok) {
        const int row = row0 + tok;
        const float o = bf2f(ys[(size_t)row * 256 + c]) + bf2f(ys[(size_t)NT * 256 + (size_t)row * 256 + c]);
        const float ms = wave_sum(o * o) * (1.f / 64.f);
        const float zg = bf2f(z[(size_t)row * ZS + COL_GD + 768 + c]);
        cat[(size_t)row * DM + 256 + c] = f2bf(o * rsqrtf(ms + 1e-6f) * ng * siluf(zg));
    }
}


__device__ __forceinline__ void load_tile_bases(unsigned* ctl, int l, int* tb) {
    const int tid = otid();
    __syncthreads();
    if (tid < 64) { const int c = (int)xb_ld(&ctl[CW_CNT(l) + tid]); tb[130 + tid] = c; tb[66 + tid] = (c + 127) >> 7; }
    __syncthreads();
    if (tid == 0) { int a = 0; for (int e = 0; e < 64; ++e) { tb[e] = a; a += tb[66 + e]; } tb[64] = a; }
    __syncthreads();
}

#define NPHASE 36
template <typename F>
__device__ __forceinline__ void strided(int n, F f) { for (int u = blockIdx.x; u < n; u += gridDim.x) f(u); }

__global__ void __launch_bounds__(NTHREADS, 2) fwd_kernel(KP kp) {
    extern __shared__ __attribute__((aligned(16))) char smem[];
    char* lds = smem + LDS_USER;
    {
    const int tid = otid();
    if (tid == 0) *reinterpret_cast<uint4*>(smem) = make_uint4(0u, 0u, 0u, 0u);
    if (tid < 52) { const unsigned long long v = (unsigned long long)kp.in[tid]; ((unsigned*)(smem + 512))[2 * tid] = (unsigned)v; ((unsigned*)(smem + 512))[2 * tid + 1] = (unsigned)(v >> 32); }
    }
    __syncthreads();
    P p; p.tab = (const __attribute__((address_space(3))) unsigned*)(smem + 512); p.out = kp.out; p.ws = kp.ws;
    unsigned* ctl = (unsigned*)(p.ws + WS_CTL);
    XcdBarrier bar = xcd_barrier_post(ctl, (volatile LAS unsigned*)smem);
    const int lo = kp.ph_lo, hi = kp.ph_hi;
#define PHASE_BEGIN(ph) if ((ph) >= lo && (ph) < hi) { if ((ph) > lo) { xcd_barrier(bar); }
#define PHASE_END }
#define LANE_IDS const int tid = otid(); const int wid = tid >> 6, lane = tid & 63, wr = wid >> 1, wc = wid & 1, fr = lane & 15, fq = lane >> 4; (void)wid; (void)lane; (void)wr; (void)wc; (void)fr; (void)fq;

    PHASE_BEGIN(0)
        strided(192 + 64 + 32, [&](int u) {
            if (u < 192) ph0_mod_unit(p, u, lds);
            else if (u < 256) ph0_s5tab_unit(p, u - 192);
            else { const int v = u - 256, ll = v >> 4, t = v & 15;
                   xpose_tile(p.in(I_S5_GLUW) + (size_t)ll * 65536, 256, (bf16_t*)(p.ws + WS_GLUT) + (size_t)ll * 65536, 256, 0, t >> 2, t & 3, lds); }
        });
    PHASE_END

#pragma unroll 1
    for (int l = 0; l < 2; ++l) {
        const int pb = 1 + 17 * l;
        PHASE_BEGIN(pb + 0)
            strided(4352 + 1088 + 768 + 256, [&](int u) {
                if (u < 4352) { if (l == 0) rows_unit<M_INIT>(p, l, u, lds); else rows_unit<M_LN2NEXT>(p, l, u, lds); }
                else if (u < 5440) filt_unit(p, l, u - 4352, lds);
                else if (u < 6208) { const int v = u - 5440; xpose_tile(p.in(I_WIN) + (size_t)l * 1024 * 3024, 3024, (bf16_t*)(p.ws + WS_WINT), 1024, 0, v / 48, v % 48, lds); }
                else { const int v = u - 6208; xpose_tile(p.in(I_WOUT) + (size_t)l * 1024 * 1024, 1024, (bf16_t*)(p.ws + WS_WOUTT), 1024, 0, v >> 4, v & 15, lds); }
            });
        PHASE_END
        PHASE_BEGIN(pb + 1)
            strided(272 * 24, [&](int u) {
                LANE_IDS
                const int mt = u / 24, nt = u % 24;
                f32x4 acc[4][4];
                gemm_tile((const bf16_t*)(p.ws + WS_HBY), DM, arows_lin(mt * 128, tid),
                          (const bf16_t*)(p.ws + WS_WINT), DM, nt * 128, DM, lds, acc);
                bf16_t* z = (bf16_t*)(p.ws + WS_Z);
#pragma unroll
                for (int m = 0; m < 4; ++m)
#pragma unroll
                    for (int n = 0; n < 4; ++n) {
                        const int col = nt * 128 + wc * 64 + n * 16 + fr;
                        if (col < ZS) {
#pragma unroll
                            for (int j = 0; j < 4; ++j) z[(size_t)(mt * 128 + wr * 64 + m * 16 + fq * 4 + j) * ZS + col] = f2bf(acc[m][n][j]);
                        }
                    }
            });
        PHASE_END
        PHASE_BEGIN(pb + 2)
            strided(512 + 512 + 1088 + 1088 + 4352, [&](int u) {
                if (u < 512) { if (kp.rep == 0) hfft_unit(p, l, u, lds); }
                else if (u < 1024) hyena_prep_unit(p, l, u - 512, lds);
                else if (u < 2112) rwkv_prep_unit(p, l, u - 1024, lds);
                else if (u < 3200) gdn_prep_unit(p, l, u - 2112);
                else s5_pre_unit(p, l, u - 3200, lds);
            });
        PHASE_END
        PHASE_BEGIN(pb + 3)
            {
                int* qslot = (int*)(smem + 64);
                const int NO = 1024 + 544 + 1024;
                if (otid() == 0) {
                    const unsigned hw = (unsigned)__builtin_amdgcn_s_getreg((7 << 11) | (8 << 6) | 4);
                    const unsigned cuix = ((xb_xcc_id() & 15u) << 8) | (hw & 255u);
                    qslot[1] = (atomicAdd(&ctl[CW_CUCNT(l) + cuix], 1u) % 2u == 0u) ? 0 : 1;
                }
                __syncthreads();
                for (;;) {
                    if (otid() == 0) {
                        int stage = qslot[1], t = -1;
                        while (t < 0 && stage < 3) {
                            if (stage == 1) { const int q = (int)atomicAdd(&ctl[CW_QUEUE(l) + 16 + kp.rep], 1u); if (q < NO) t = 256 + (q < 544 ? 1024 + q : (q < 1568 ? q - 544 : q)); else stage = 2; }
                            else { const int q = (int)atomicAdd(&ctl[CW_QUEUE(l) + kp.rep], 1u); if (q < 256) t = q; else stage = (stage == 0) ? 1 : 3; }
                        }
                        qslot[1] = stage; qslot[0] = t;
                    }
                    __syncthreads();
                    const int u = qslot[0];
                    __syncthreads();
                    if (u < 0) break;
                    if (u < 256) { if (kp.rep != 2) scan_unit(p, l, u, lds); }
                    else if (kp.rep == 1) {}
                    else if (u < 1280) hyena_fft_unit(p, l, u - 256, lds);
                    else if (u < 1824) { if (kp.rep == 0) s5_main_unit(p, l, u - 1280, lds); }
                    else hyena_unit<256>(p, l, u - 1824, lds);
                    __syncthreads();
                }
            }
        PHASE_END
        PHASE_BEGIN(pb + 4)
            strided(1088 + 1088 + 544, [&](int u) {
                if (u < 1088) rwkv_post_unit(p, l, u, lds);
                else if (u < 2176) gdn_post_unit(p, l, u - 1088);
                else {
                    LANE_IDS
                    const int v = u - 2176, mt = v >> 1, nt = v & 1;
                    f32x4 acc[4][4];
                    const bf16_t* A = (const bf16_t*)(p.ws + WS_Z) + COL_S5;
                    gemm_tile(A, ZS, arows_lin(mt * 128, tid),
                              (const bf16_t*)(p.ws + WS_GLUT) + (size_t)l * 65536, 256, nt * 128, 256, lds, acc);
                    bf16_t* cat = (bf16_t*)(p.ws + WS_CAT);
#pragma unroll
                    for (int m = 0; m < 4; ++m)
#pragma unroll
                        for (int n = 0; n < 4; ++n) {
                            const int col = nt * 128 + wc * 64 + n * 16 + fr;
                            const float gb = p.in(I_S5_GLUB)[l * 256 + col];
#pragma unroll
                            for (int j = 0; j < 4; ++j) {
                                const int row = mt * 128 + wr * 64 + m * 16 + fq * 4 + j;
                                const float yg = bf2f(A[(size_t)row * ZS + col]);
                                cat[(size_t)row * DM + 768 + col] = f2bf(yg * sigm(acc[m][n][j] + gb));
                            }
                        }
                }
            });
        PHASE_END
        PHASE_BEGIN(pb + 5)
            strided(272 * 8 + 65 * 192, [&](int u) {
                if (u < 2176) {
                    LANE_IDS
                    const int mt = u >> 3, nt = u & 7;
                    f32x4 acc[4][4];
                    gemm_tile((const bf16_t*)(p.ws + WS_CAT), DM, arows_lin(mt * 128, tid),
                              (const bf16_t*)(p.ws + WS_WOUTT), DM, nt * 128, DM, lds, acc);
#pragma unroll
                    for (int m = 0; m < 4; ++m)
#pragma unroll
                        for (int j = 0; j < 4; ++j) {
                            const int row = mt * 128 + wr * 64 + m * 16 + fq * 4 + j;
                            float* xr = xrow(p, row);
                            const float* ga = modp(p, l, row_mod(row), 2);
#pragma unroll
                            for (int n = 0; n < 4; ++n) {
                                const int col = nt * 128 + wc * 64 + n * 16 + fr;
                                { const float ca = kp.rep ? 1.f : ALPHA, cb2 = kp.rep ? 0.f : 1.f; xr[col] = ca * xr[col] + cb2 * ga[col] * acc[m][n][j]; }
                            }
                        }
                } else {
                    const int v = u - 2176, e = v / 192, t = v % 192, which = t >> 6, tt = t & 63;
                    bf16_t* W13 = (bf16_t*)(p.ws + WS_R1 + R1_W13T) + (size_t)e * 512 * 1024;
                    bf16_t* W2 = (bf16_t*)(p.ws + WS_R1 + R1_W2T) + (size_t)e * 1024 * 256;
                    if (which == 0) {
                        const float* src = (e < 64) ? p.in(I_EX_W1) + ((size_t)l * 64 + e) * 262144 : p.in(I_SH_W1) + (size_t)l * 262144;
                        xpose_tile(src, 256, W13, 1024, 1, tt >> 2, tt & 3, lds);
                    } else if (which == 1) {
                        const float* src = (e < 64) ? p.in(I_EX_W3) + ((size_t)l * 64 + e) * 262144 : p.in(I_SH_W3) + (size_t)l * 262144;
                        xpose_tile(src, 256, W13, 1024, 2, tt >> 2, tt & 3, lds);
                    } else {
                        const float* src = (e < 64) ? p.in(I_EX_W2) + ((size_t)l * 64 + e) * 262144 : p.in(I_SH_W2) + (size_t)l * 262144;
                        xpose_tile(src, 1024, W2, 256, 0, tt >> 4, tt & 15, lds);
                    }
                }
            });
        PHASE_END
        PHASE_BEGIN(pb + 6)
            strided(4352, [&](int u) { rows_unit<M_LN1>(p, l, u, lds, kp.rep > 0); __syncthreads(); });
        PHASE_END
        PHASE_BEGIN(pb + 8)
            {
                int* tbs = (int*)(smem + 1024);
                load_tile_bases(ctl, l, tbs);
                const int ntr = tbs[64];
                const int* rtok = (const int*)(p.ws + WS_RTOK);
                strided((ntr + 272) * 4, [&](int u) {
                    LANE_IDS
                    const int tile = u >> 2, jn = u & 3;
                    int e, obase; ARows ar;
                    if (tile < ntr) {
                        e = 0;
#pragma unroll 1
                        for (int s2 = 32; s2 >= 1; s2 >>= 1) if (tbs[e + s2] <= tile) e += s2;
                        obase = tile * 128;
                        const int pos0 = (tile - tbs[e]) * 128, ce = tbs[130 + e];
#pragma unroll
                        for (int i = 0; i < 4; ++i) { const int ps = pos0 + (tid >> 3) + 32 * i; ar.r[i] = (ps < ce) ? rtok[(size_t)e * NT + ps] : 0; }
                    } else {
                        const int stt = tile - ntr; e = 64; obase = (SH_TILE_BASE + stt) * 128;
                        ar = arows_lin(stt * 128, tid);
                    }
                    f32x4 acc[4][4];
                    gemm_tile((const bf16_t*)(p.ws + WS_HBY), DM, ar,
                              (const bf16_t*)(p.ws + WS_R1 + R1_W13T) + (size_t)e * 512 * 1024, DM, jn * 128, DM, lds, acc);
                    bf16_t* act = (bf16_t*)(p.ws + WS_ACT);
#pragma unroll
                    for (int m = 0; m < 4; ++m)
#pragma unroll
                        for (int pp = 0; pp < 2; ++pp)
#pragma unroll
                            for (int j = 0; j < 4; ++j) {
                                const float g = acc[m][2 * pp][j], uu = acc[m][2 * pp + 1][j];
                                const int orow = obase + wr * 64 + m * 16 + fq * 4 + j;
                                const int col = jn * 64 + wc * 32 + pp * 16 + fr;
                                act[(size_t)orow * 256 + col] = f2bf(siluf(g) * uu);
                            }
                });
            }
        PHASE_END
#pragma unroll 1
        for (int sl = 0; sl < 4; ++sl) {
            PHASE_BEGIN(pb + 9 + 2 * sl)
            {
                int* tbs = (int*)(smem + 1024);
                load_tile_bases(ctl, l, tbs);
                const int ntr = tbs[64];
                strided((ntr + 272) * 2, [&](int u) {
                    LANE_IDS
                    const int tile = u >> 1, nt2 = u & 1;
                    int e, obase;
                    if (tile < ntr) {
                        e = 0;
#pragma unroll 1
                        for (int s2 = 32; s2 >= 1; s2 >>= 1) if (tbs[e + s2] <= tile) e += s2;
                        obase = tile * 128;
                    }
                    else { e = 64; obase = (SH_TILE_BASE + tile - ntr) * 128; }
                    f32x4 acc[4][4];
                    gemm_tile((const bf16_t*)(p.ws + WS_ACT), 256, arows_lin(obase, tid),
                              (const bf16_t*)(p.ws + WS_R1 + R1_W2T) + (size_t)e * 1024 * 256, 256, sl * 256 + nt2 * 128, 256, lds, acc);
                    bf16_t* y2 = (bf16_t*)(p.ws + WS_Y2);
#pragma unroll
                    for (int m = 0; m < 4; ++m)
#pragma unroll
                        for (int j = 0; j < 4; ++j) {
                            const int orow = obase + wr * 64 + m * 16 + fq * 4 + j;
#pragma unroll
                            for (int n = 0; n < 4; ++n) y2[(size_t)orow * 256 + nt2 * 128 + wc * 64 + n * 16 + fr] = f2bf(acc[m][n][j]);
                        }
                });
            }
            PHASE_END
            PHASE_BEGIN(pb + 10 + 2 * sl)
            {
                int* tb = (int*)lds;
                const int tid = otid();
                const unsigned* cnt = ctl + CW_CNT(l);
                load_tile_bases(ctl, l, tb);
                const int* aep = (const int*)(p.ws + WS_AEP); const float* aw = (const float*)(p.ws + WS_AW);
                const bf16_t* y2 = (const bf16_t*)(p.ws + WS_Y2);
                const int tl = tid >> 5, cg = tid & 31;
                for (int grp = blockIdx.x; grp < NT / 8; grp += gridDim.x) {
                    const int tok = grp * 8 + tl;
                    float a8[8];
                    {
                        const uint4 sv = *reinterpret_cast<const uint4*>(y2 + ((size_t)(SH_TILE_BASE * 128 + tok)) * 256 + cg * 8);
                        a8[0] = bflo(sv.x); a8[1] = bfhi(sv.x); a8[2] = bflo(sv.y); a8[3] = bfhi(sv.y);
                        a8[4] = bflo(sv.z); a8[5] = bfhi(sv.z); a8[6] = bflo(sv.w); a8[7] = bfhi(sv.w);
                    }
#pragma unroll
                    for (int k = 0; k < 8; ++k) {
                        const unsigned v = (unsigned)aep[(size_t)tok * 8 + k];
                        const float wk = aw[(size_t)tok * 8 + k];
                        const int dest = tb[v >> 24] * 128 + (int)(v & 0xFFFFFFu);
                        const uint4 yv = *reinterpret_cast<const uint4*>(y2 + (size_t)dest * 256 + cg * 8);
                        a8[0] += wk * bflo(yv.x); a8[1] += wk * bfhi(yv.x); a8[2] += wk * bflo(yv.y); a8[3] += wk * bfhi(yv.y);
                        a8[4] += wk * bflo(yv.z); a8[5] += wk * bfhi(yv.z); a8[6] += wk * bflo(yv.w); a8[7] += wk * bfhi(yv.w);
                    }
                    float* xr = xrow(p, tok) + sl * 256 + cg * 8;
                    const float* ga = modp(p, l, row_mod(tok), 5) + sl * 256 + cg * 8;
                    float4 x0 = *reinterpret_cast<const float4*>(xr), x1 = *reinterpret_cast<const float4*>(xr + 4);
                    const float4 g0 = *reinterpret_cast<const float4*>(ga), g1 = *reinterpret_cast<const float4*>(ga + 4);
                    const float rs = kp.rep ? 0.f : 1.f;
                    x0.x += rs * g0.x * a8[0]; x0.y += rs * g0.y * a8[1]; x0.z += rs * g0.z * a8[2]; x0.w += rs * g0.w * a8[3];
                    x1.x += rs * g1.x * a8[4]; x1.y += rs * g1.y * a8[5]; x1.z += rs * g1.z * a8[6]; x1.w += rs * g1.w * a8[7];
                    *reinterpret_cast<float4*>(xr) = x0; *reinterpret_cast<float4*>(xr + 4) = x1;
                }
                __syncthreads();
            }
            PHASE_END
        }
    }
#if defined(PROBE_PH)
    if (lo >= 100) {
        float a0 = (float)otid(), a1 = a0 + 1.f, a2 = a0 + 2.f, a3 = a0 + 3.f, a4 = a0 + 4.f, a5 = a0 + 5.f, a6 = a0 + 6.f, a7 = a0 + 7.f;
        const float m = 0.999f, c = 0.5f;
        for (int it = 0; it < 10000; ++it) {
            if (lo == 100) {
#pragma unroll
                for (int q = 0; q < 64; ++q) asm volatile("v_fma_f32 %0, %0, %1, %2" : "+v"(a0) : "v"(m), "v"(c));
            } else {
#pragma unroll
                for (int q = 0; q < 8; ++q) {
                    asm volatile("v_fma_f32 %0, %0, %1, %2" : "+v"(a0) : "v"(m), "v"(c)); asm volatile("v_fma_f32 %0, %0, %1, %2" : "+v"(a1) : "v"(m), "v"(c));
                    asm volatile("v_fma_f32 %0, %0, %1, %2" : "+v"(a2) : "v"(m), "v"(c)); asm volatile("v_fma_f32 %0, %0, %1, %2" : "+v"(a3) : "v"(m), "v"(c));
                    asm volatile("v_fma_f32 %0, %0, %1, %2" : "+v"(a4) : "v"(m), "v"(c)); asm volatile("v_fma_f32 %0, %0, %1, %2" : "+v"(a5) : "v"(m), "v"(c));
                    asm volatile("v_fma_f32 %0, %0, %1, %2" : "+v"(a6) : "v"(m), "v"(c)); asm volatile("v_fma_f32 %0, %0, %1, %2" : "+v"(a7) : "v"(m), "v"(c));
                }
            }
        }
        if (a0 + a1 + a2 + a3 + a4 + a5 + a6 + a7 == 12345.678f) ctl[60] = 1u;
    }
#endif
    PHASE_BEGIN(35)
        strided(4352, [&](int u) { rows_unit<M_FINAL>(p, 1, u, lds); });
    PHASE_END
}

#ifndef N_LAUNCH_MODE
#define N_LAUNCH_MODE 1
#endif
extern "C" void kernel_launch(void* const* d_in, const int* in_sizes, int n_in, void* d_out, int out_size, void* d_ws, size_t ws_size, hipStream_t stream) {
    static int grid = 0;
    if (grid == 0) {
        if (n_in != 52 || out_size != NTL * DM || ws_size < WS_END) { fprintf(stderr, "kernel_launch: unexpected shapes (n_in %d out %d ws %zu need %zu)\n", n_in, out_size, ws_size, (size_t)WS_END); grid = -1; return; }
        int dev = 0, cus = 0, per_cu = 0;
        hipGetDevice(&dev);
        hipDeviceGetAttribute(&cus, hipDeviceAttributeMultiprocessorCount, dev);
        hipFuncSetAttribute((const void*)fwd_kernel, hipFuncAttributeMaxDynamicSharedMemorySize, LDS_BYTES);
        hipOccupancyMaxActiveBlocksPerMultiprocessor(&per_cu, (const void*)fwd_kernel, NTHREADS, LDS_BYTES);
        (void)hipGetLastError();
        if (per_cu < 1) per_cu = 1;
        if (per_cu > 2) per_cu = 2;
        grid = cus * per_cu;
    }
    if (grid < 0) return;
    hipMemsetAsync((char*)d_ws + WS_CTL, 0, CTL_BYTES, stream);
    KP p{};
    for (int i = 0; i < 52; ++i) p.in[i] = (const float*)d_in[i];
    p.out = (float*)d_out; p.ws = (char*)d_ws;
#if defined(PROBE_PH)
    for (int ph = 0; ph < NPHASE; ++ph) {
        const int reps = (ph == PROBE_PH) ? 1 + PROBE_N : 1;
        for (int r = 0; r < reps; ++r) { p.ph_lo = ph; p.ph_hi = ph + 1; p.rep = r; hipLaunchKernelGGL(fwd_kernel, dim3(grid), dim3(NTHREADS), LDS_BYTES, stream, p); }
    }
    if (PROBE_PH >= 100) { p.ph_lo = PROBE_PH; p.ph_hi = PROBE_PH + 1; p.rep = 0; hipLaunchKernelGGL(fwd_kernel, dim3(PROBE_N), dim3(NTHREADS), LDS_BYTES, stream, p); }
#elif N_LAUNCH_MODE == 1
    p.ph_lo = 0; p.ph_hi = NPHASE;
    hipLaunchKernelGGL(fwd_kernel, dim3(grid), dim3(NTHREADS), LDS_BYTES, stream, p);
#else
    for (int ph = 0; ph < NPHASE; ++ph) {
        p.ph_lo = ph; p.ph_hi = ph + 1;
        hipLaunchKernelGGL(fwd_kernel, dim3(grid), dim3(NTHREADS), LDS_BYTES, stream, p);
    }
#endif
}
```

```cpp
#include <hip/hip_runtime.h>
#include <hip/hip_bf16.h>
#include <hip/hip_fp16.h>
#include <stdint.h>
#include <stdio.h>

typedef unsigned short bf16_t;
using bf16x8 = __attribute__((ext_vector_type(8))) short;
using f32x4 = __attribute__((ext_vector_type(4))) float;
using f32x2 = __attribute__((ext_vector_type(2))) float;

#define NTC 2048
#define NTL 32768
#define NT 34816
#define DM 1024
#define ZS 3024
#define COL_GD 960
#define COL_HY 2000
#define COL_S5 2768
#define NCHUNK 68
#define ALPHA 1.41421356237f
#define NTHREADS 256
#define LDS_BYTES 73728
#define LDS_USER 2048
#define SH_TILE_BASE 2240
#define ACT_ROWS ((SH_TILE_BASE + 272) * 128)

constexpr size_t al256(size_t x) { return (x + 255) & ~(size_t)255; }
constexpr size_t WS_CTL = 0;
constexpr size_t CTL_BYTES = 65536;
constexpr size_t WS_MOD = WS_CTL + CTL_BYTES;
constexpr size_t WS_S5A = al256(WS_MOD + 2 * 9 * 6144 * 4);
constexpr size_t WS_S5B = al256(WS_S5A + 2 * 2 * 16 * 64 * 4 * 4);
constexpr size_t WS_GLUT = al256(WS_S5B + 2 * 2 * 16 * 64 * 32 * 4);
constexpr size_t WS_G2T = al256(WS_GLUT + 2 * 256 * 256 * 2);
constexpr size_t WS_WINT = al256(WS_G2T + 2 * 256 * 64 * 2);
constexpr size_t WS_WOUTT = al256(WS_WINT + (size_t)3072 * 1024 * 2);
constexpr size_t WS_FILTL = al256(WS_WOUTT + (size_t)1024 * 1024 * 2);
constexpr size_t WS_FILTC = al256(WS_FILTL + (size_t)4 * 256 * 4096 * 4);
constexpr size_t WS_XC = al256(WS_FILTC + (size_t)4 * 256 * 256 * 4);
constexpr size_t WS_HBY = al256(WS_XC + (size_t)NTC * DM * 4);
constexpr size_t WS_CAT = al256(WS_HBY + (size_t)NT * DM * 2);
constexpr size_t WS_Z = al256(WS_CAT + (size_t)NT * DM * 2);
constexpr size_t WS_R1 = al256(WS_Z + (size_t)NT * ZS * 2);
constexpr size_t R1_RWP = 0;
constexpr size_t R1_GQ = (size_t)NT * 1024 * 2;
constexpr size_t R1_W13T = 0;
constexpr size_t R1_W2T = (size_t)65 * 512 * 1024 * 2;
constexpr size_t R1_BYTES = (size_t)NT * 1024 * 2 + (size_t)NT * 768 * 2;
constexpr size_t WS_KNORM = al256(WS_R1 + R1_BYTES);
constexpr size_t WS_GAB = al256(WS_KNORM + (size_t)NT * 4 * 4);
constexpr size_t WS_S5ST = al256(WS_GAB + (size_t)NT * 16 * 4);
constexpr size_t WS_AEP = al256(WS_S5ST + (size_t)8 * 68 * 2 * 16 * 64 * 2 * 4);
constexpr size_t WS_AW = al256(WS_AEP + (size_t)NT * 8 * 4);
constexpr size_t WS_RTOK = al256(WS_AW + (size_t)NT * 8 * 4);
constexpr size_t WS_HYT = al256(WS_RTOK + (size_t)64 * NT * 4);
constexpr size_t WS_S5G = al256(WS_HYT + (size_t)8 * 768 * 4096 * 2);
constexpr size_t WS_END = al256(WS_S5G + (size_t)NT * 256 * 2);
static_assert(R1_W2T + (size_t)65 * 1024 * 256 * 2 <= R1_BYTES, "expert weights must fit R1");
constexpr size_t ACT_BYTES = (size_t)ACT_ROWS * 256 * 2;
constexpr size_t WS_ACT = WS_Z + ((((size_t)NT * ZS * 2 - ACT_BYTES) >> 8) << 8);
constexpr size_t WS_Y2 = WS_HBY;
static_assert(WS_Y2 + ACT_BYTES <= WS_ACT, "y2 must not reach act");

#define CW_QUEUE(l) (4096 + 64 * (l))
#define CW_CNT(l) (4352 + 64 * (l))
#define CW_CUCNT(l) (8192 + 4096 * (l))

#define XB_TMO      128
#define XB_XCNT(j)  (256  + 64 * (j))
#define XB_XSUB(j)  (1280 + 64 * (j))
#define XB_XGEN(j)  (2304 + 64 * (j))
#define XB_TOP      3328
#define XB_TOPGEN   3392
#define XCD_BAR_WORDS 3456
#define XB_SPIN_CAP (1u << 18)
#define LAS __attribute__((address_space(3)))

__device__ __forceinline__ unsigned xb_ld(unsigned* p)              { return __hip_atomic_load(p, __ATOMIC_RELAXED, __HIP_MEMORY_SCOPE_AGENT); }
__device__ __forceinline__ unsigned xb_add(unsigned* p, unsigned v) { return __hip_atomic_fetch_add(p, v, __ATOMIC_RELAXED, __HIP_MEMORY_SCOPE_AGENT); }
__device__ __forceinline__ unsigned xb_xcc_id() { return (unsigned)__builtin_amdgcn_s_getreg((3 << 11) | 20) & 0xFu; }
#define XB_SPIN(cond, bar) do { unsigned _sp = 0; while (cond) { __builtin_amdgcn_s_sleep(1); \
    if ((++_sp & 255u) == 0u) { if (xb_ld(&(bar)[XB_TMO])) break; if (_sp > XB_SPIN_CAP) { atomicAdd(&(bar)[XB_TMO], 1u); break; } } } } while (0)

struct XcdBarrier {
    unsigned* bar; unsigned x;
    volatile LAS unsigned* st;
};
__device__ __forceinline__ XcdBarrier xcd_barrier_post(unsigned* bar, volatile LAS unsigned* st) {
    XcdBarrier b; b.bar = bar; b.x = xb_xcc_id(); b.st = st;
    if (threadIdx.x == 0) (void)xb_add(&bar[XB_XCNT(b.x)], 1u);
    return b;
}
__device__ __forceinline__ void xcd_barrier_complete(unsigned* bar, unsigned x, unsigned& nloc, unsigned& nx) {
    const unsigned G = gridDim.x * gridDim.y * gridDim.z;
    unsigned sum, cnt, mine, sp = 0u;
    for (;;) {
        sum = 0u; cnt = 0u; mine = 0u;
#pragma unroll
        for (unsigned j = 0; j < 16; ++j) { const unsigned c = xb_ld(&bar[XB_XCNT(j)]); sum += c; cnt += (c > 0u) ? 1u : 0u; mine = (j == x) ? c : mine; }
        if (sum == G) break;
        __builtin_amdgcn_s_sleep(1);
        if ((++sp & 255u) == 0u) { if (xb_ld(&bar[XB_TMO])) break; if (sp > XB_SPIN_CAP) { atomicAdd(&bar[XB_TMO], 1u); break; } }
    }
    nloc = mine > 0u ? mine : 1u; nx = cnt > 0u ? cnt : 1u;
}
__device__ __forceinline__ void xcd_barrier(const XcdBarrier& b) {
    asm volatile("s_waitcnt vmcnt(0)" ::: "memory");
    __syncthreads();
    if (threadIdx.x == 0) {
        unsigned* bar = b.bar;
        __builtin_amdgcn_s_waitcnt(0);
        unsigned nloc = b.st[0], nx = b.st[1];
        if (nloc == 0u) { xcd_barrier_complete(bar, b.x, nloc, nx); b.st[0] = nloc; b.st[1] = nx; }
        const unsigned old = xb_add(&bar[XB_XSUB(b.x)], 1u);
        const unsigned gen = old / nloc;
        if (old + 1u == (gen + 1u) * nloc) {
            __builtin_amdgcn_fence(__ATOMIC_RELEASE, "agent");
            asm volatile("s_waitcnt vmcnt(0)" ::: "memory");
            const unsigned og = xb_add(&bar[XB_TOP], 1u);
            const unsigned tg = og / nx;
            if (og + 1u == (tg + 1u) * nx) xb_add(&bar[XB_TOPGEN], 1u);
            else XB_SPIN(xb_ld(&bar[XB_TOPGEN]) == tg, bar);
            __builtin_amdgcn_fence(__ATOMIC_ACQUIRE, "agent");
            xb_add(&bar[XB_XGEN(b.x)], 1u);
            asm volatile("s_waitcnt vmcnt(0)" ::: "memory");
        } else {
            XB_SPIN(xb_ld(&bar[XB_XGEN(b.x)]) == gen, bar);
            __builtin_amdgcn_fence(__ATOMIC_ACQUIRE, "agent");
            asm volatile("s_waitcnt vmcnt(0)" ::: "memory");
        }
    }
    __syncthreads();
}

struct KP {
    const float* in[52];
    float* out;
    char* ws;
    int ph_lo, ph_hi, rep, pad_;
};
struct P {
    const __attribute__((address_space(3))) unsigned* tab;
    float* out;
    char* ws;
    __device__ __forceinline__ const float* in(int i) const {
        const unsigned lo = __builtin_amdgcn_readfirstlane(tab[2 * i]);
        const unsigned hi = __builtin_amdgcn_readfirstlane(tab[2 * i + 1]);
        return (const float*)(((unsigned long long)hi << 32) | (unsigned long long)lo);
    }
};
enum { I_X = 0, I_C, I_CTX, I_CCTX, I_ADAW, I_ADAB, I_WIN, I_WOUT, I_LNG, I_LNB,
       I_RW_W0, I_RW_W2, I_RW_A0, I_RW_A2, I_RW_G2, I_RW_KK, I_RW_KA, I_RW_RK, I_RW_GNG, I_RW_GNB,
       I_GD_CONV, I_GD_ALOG, I_GD_DTB, I_GD_NORM,
       I_HY_CONV, I_HY_CONVB, I_HY_W1, I_HY_B1, I_HY_F1, I_HY_W2, I_HY_B2, I_HY_F2, I_HY_W3, I_HY_SKIP,
       I_S5_LRE, I_S5_LIM, I_S5_LOGSTEP, I_S5_BRE, I_S5_BIM, I_S5_CRE, I_S5_CIM, I_S5_D, I_S5_GLUW, I_S5_GLUB,
       I_ROUTER_W, I_ROUTER_B, I_EX_W1, I_EX_W3, I_EX_W2, I_SH_W1, I_SH_W3, I_SH_W2 };

__device__ __forceinline__ bf16_t f2bf(float f) { unsigned u = __float_as_uint(f); u += 0x7fffu + ((u >> 16) & 1u); return (bf16_t)(u >> 16); }
__device__ __forceinline__ float bf2f(bf16_t h) { return __uint_as_float(((unsigned)h) << 16); }
__device__ __forceinline__ float bflo(unsigned u) { return __uint_as_float(u << 16); }
__device__ __forceinline__ float bfhi(unsigned u) { return __uint_as_float(u & 0xffff0000u); }
__device__ __forceinline__ unsigned pack2(float a, float b) { return (unsigned)f2bf(a) | ((unsigned)f2bf(b) << 16); }
__device__ __forceinline__ float sigm(float x) { return 1.f / (1.f + __expf(-x)); }
__device__ __forceinline__ float siluf(float x) { return x / (1.f + __expf(-x)); }
__device__ __forceinline__ float softplusf(float x) { return fmaxf(x, 0.f) + log1pf(__expf(-fabsf(x))); }
template <int CTRL> __device__ __forceinline__ float dppf(float v) {
    return __int_as_float(__builtin_amdgcn_update_dpp(0, __float_as_int(v), CTRL, 0xF, 0xF, true));
}
__device__ __forceinline__ float wave_sum(float v) {
    v += dppf<0xB1>(v); v += dppf<0x4E>(v); v += dppf<0x141>(v); v += dppf<0x140>(v);
    const int iv = __float_as_int(v);
    const float r0 = __int_as_float(__builtin_amdgcn_readlane(iv, 0)), r1 = __int_as_float(__builtin_amdgcn_readlane(iv, 16));
    const float r2 = __int_as_float(__builtin_amdgcn_readlane(iv, 32)), r3 = __int_as_float(__builtin_amdgcn_readlane(iv, 48));
    return (r0 + r1) + (r2 + r3);
}

__device__ __forceinline__ void unpack8(const uint4& v, float (&o)[8]) {
    o[0] = bflo(v.x); o[1] = bfhi(v.x); o[2] = bflo(v.y); o[3] = bfhi(v.y); o[4] = bflo(v.z); o[5] = bfhi(v.z); o[6] = bflo(v.w); o[7] = bfhi(v.w);
}
__device__ __forceinline__ uint4 pack8(const float (&o)[8]) { return make_uint4(pack2(o[0], o[1]), pack2(o[2], o[3]), pack2(o[4], o[5]), pack2(o[6], o[7])); }
__device__ __forceinline__ float sum8lanes(float v) { v += dppf<0xB1>(v); v += dppf<0x4E>(v); v += dppf<0x141>(v); return v; }
__device__ __forceinline__ int otid() { int t = threadIdx.x; asm volatile("" : "+v"(t)); return t; }
__device__ __forceinline__ float* xrow(const P& p, int row) {
    return row < NTC ? (float*)(p.ws + WS_XC) + (size_t)row * DM : p.out + (size_t)(row - NTC) * DM;
}
__device__ __forceinline__ int row_mod(int row) { return row < NTC ? 8 : ((row - NTC) >> 12); }
__device__ __forceinline__ const float* modp(const P& p, int l, int r, int chunk) {
    return (const float*)(p.ws + WS_MOD) + ((size_t)(l * 9 + r) * 6144 + chunk * 1024);
}

struct ARows { int r[4]; };
__device__ __forceinline__ ARows arows_lin(int base, int tid) { ARows a; a.r[0] = base + (tid >> 3); a.r[1] = a.r[0] + 32; a.r[2] = a.r[0] + 64; a.r[3] = a.r[0] + 96; return a; }
__device__ __forceinline__ void gemm_tile(const bf16_t* __restrict__ A, int lda, const ARows& ar,
                                          const bf16_t* __restrict__ Bt, int ldb, int brow0, int K,
                                          char* lds, f32x4 (&acc)[4][4]) {
    const int tid = otid();
    const int wid = tid >> 6, lane = tid & 63, wr = wid >> 1, wc = wid & 1, fr = lane & 15, fq = lane >> 4;
    const int gc = ((tid & 7) ^ ((tid >> 3) & 7)) * 8;
    const bf16_t* ap[4]; const bf16_t* bp[4];
#pragma unroll
    for (int i = 0; i < 4; ++i) {
        ap[i] = A + (size_t)ar.r[i] * lda + gc;
        bp[i] = Bt + (size_t)(brow0 + (tid >> 3) + 32 * i) * ldb + gc;
    }
#pragma unroll
    for (int m = 0; m < 4; ++m)
#pragma unroll
        for (int n = 0; n < 4; ++n) acc[m][n] = f32x4{0.f, 0.f, 0.f, 0.f};
    const int nk = K >> 6;
    auto stage = [&](int t, int buf) {
        char* SA = lds + buf * 32768; char* SB = SA + 16384;
        const int ko = t * 64;
#pragma unroll
        for (int i = 0; i < 4; ++i) {
            __builtin_amdgcn_global_load_lds((const void*)(ap[i] + ko), (LAS void*)(SA + tid * 16 + i * 4096), 16, 0, 0);
            __builtin_amdgcn_global_load_lds((const void*)(bp[i] + ko), (LAS void*)(SB + tid * 16 + i * 4096), 16, 0, 0);
        }
    };
    stage(0, 0);
    asm volatile("s_waitcnt vmcnt(0)" ::: "memory");
    __syncthreads();
    const int sw = fr & 7;
    for (int t = 0; t < nk; ++t) {
        const int buf = t & 1;
        if (t + 1 < nk) stage(t + 1, buf ^ 1);
        const char* SA = lds + buf * 32768; const char* SB = SA + 16384;
#pragma unroll
        for (int ks = 0; ks < 2; ++ks) {
            const int co = ((ks * 4 + fq) ^ sw) * 16;
            bf16x8 af[4], bfr[4];
#pragma unroll
            for (int m = 0; m < 4; ++m) af[m] = *reinterpret_cast<const bf16x8*>(SA + (wr * 64 + m * 16 + fr) * 128 + co);
#pragma unroll
            for (int n = 0; n < 4; ++n) bfr[n] = *reinterpret_cast<const bf16x8*>(SB + (wc * 64 + n * 16 + fr) * 128 + co);
#pragma unroll
            for (int m = 0; m < 4; ++m)
#pragma unroll
                for (int n = 0; n < 4; ++n) acc[m][n] = __builtin_amdgcn_mfma_f32_16x16x32_bf16(af[m], bfr[n], acc[m][n], 0, 0, 0);
        }
        asm volatile("s_waitcnt vmcnt(0)" ::: "memory");
        __syncthreads();
    }
}

__device__ __forceinline__ void ph0_mod_unit(const P& p, int u, char* lds) {
    const int l = u / 96, cg = u % 96, tid = otid();
    float* s = (float*)lds;
    float* red = s + 9 * 1024;
    const float* c = p.in(I_C); const float* cctx = p.in(I_CCTX);
    for (int i = tid; i < 9 * 1024; i += NTHREADS) { int r = i >> 10, k = i & 1023; float v = r < 8 ? c[r * 1024 + k] : cctx[k]; s[i] = v / (1.f + expf(-v)); }
    __syncthreads();
    const int kq = tid >> 6, j = tid & 63, col = cg * 64 + j;
    const float* w = p.in(I_ADAW) + (size_t)l * 1024 * 6144 + col;
    float acc[9];
#pragma unroll
    for (int r = 0; r < 9; ++r) acc[r] = 0.f;
#pragma unroll 4
    for (int k = kq * 256; k < kq * 256 + 256; ++k) {
        const float wv = w[(size_t)k * 6144];
#pragma unroll
        for (int r = 0; r < 9; ++r) acc[r] += s[r * 1024 + k] * wv;
    }
#pragma unroll
    for (int r = 0; r < 9; ++r) red[(kq * 9 + r) * 64 + j] = acc[r];
    __syncthreads();
    if (tid < 64) {
        float* mod = (float*)(p.ws + WS_MOD);
        const float bb = p.in(I_ADAB)[l * 6144 + col];
#pragma unroll
        for (int r = 0; r < 9; ++r) mod[(size_t)(l * 9 + r) * 6144 + col] = red[r * 64 + j] + red[(9 + r) * 64 + j] + red[(18 + r) * 64 + j] + red[(27 + r) * 64 + j] + bb;
    }
    __syncthreads();
}

__device__ __forceinline__ void ph0_s5tab_unit(const P& p, int u) {
    const int tid = otid();
    if (tid >= 64) return;
    const int ldg = u;
    const int idx = ldg * 64 + tid;
    const double lre = (double)p.in(I_S5_LRE)[idx], lim = (double)p.in(I_S5_LIM)[idx];
    const double dt = (double)expf(p.in(I_S5_LOGSTEP)[ldg]);
    const float mag = expf((float)(lre * dt));
    double rev = lim * dt * 0.15915494309189535; rev -= floor(rev);
    float sn, cs; sincospif(2.f * (float)rev, &sn, &cs);
    const double abr = (double)(mag * cs), abi = (double)(mag * sn);
    const double den = lre * lre + lim * lim;
    const double cor = ((abr - 1.0) * lre + abi * lim) / den;
    const double coi = (abi * lre - (abr - 1.0) * lim) / den;
    const float m64f = expf((float)(64.0 * lre * dt));
    double rev64 = 64.0 * lim * dt * 0.15915494309189535; rev64 -= floor(rev64);
    float sn64, cs64; sincospif(2.f * (float)rev64, &sn64, &cs64);
    float* A = (float*)(p.ws + WS_S5A) + (size_t)idx * 4;
    A[0] = (float)abr; A[1] = (float)abi; A[2] = m64f * cs64; A[3] = m64f * sn64;
    float* B = (float*)(p.ws + WS_S5B) + (size_t)idx * 32;
    const float* bre = p.in(I_S5_BRE) + (size_t)idx * 16; const float* bim = p.in(I_S5_BIM) + (size_t)idx * 16;
#pragma unroll
    for (int h = 0; h < 16; ++h) {
        const double br = bre[h], bi = bim[h];
        B[h] = (float)(cor * br - coi * bi);
        B[16 + h] = (float)(cor * bi + coi * br);
    }
}

__device__ __forceinline__ int xmap(int mode, int c) {
    if (mode == 0) return c;
    const int j = c >> 6, cc = c & 63, wc = cc >> 5, pp = (cc & 31) >> 4, i = cc & 15;
    return j * 128 + wc * 64 + pp * 32 + i + (mode == 2 ? 16 : 0);
}
__device__ __forceinline__ void xpose_tile(const float* __restrict__ src, int C, bf16_t* __restrict__ dst, int ldd, int mode, int tr, int tc, char* lds) {
    float* t = (float*)lds;
    const int tid = otid();
    {
        const int c4 = (tid & 15) * 4, c = tc * 64 + c4;
#pragma unroll
        for (int k = 0; k < 4; ++k) {
            const int r = (tid >> 4) + 16 * k;
            float4 v = make_float4(0.f, 0.f, 0.f, 0.f);
            if (c < C) v = *reinterpret_cast<const float4*>(src + (size_t)(tr * 64 + r) * C + c);
            t[(c4 + 0) * 65 + r] = v.x; t[(c4 + 1) * 65 + r] = v.y; t[(c4 + 2) * 65 + r] = v.z; t[(c4 + 3) * 65 + r] = v.w;
        }
    }
    __syncthreads();
#pragma unroll
    for (int k = 0; k < 2; ++k) {
        const int ci = (tid >> 3) + 32 * k, r8 = (tid & 7) * 8;
        const float* tp = t + ci * 65 + r8;
        uint4 o;
        o.x = pack2(tp[0], tp[1]); o.y = pack2(tp[2], tp[3]); o.z = pack2(tp[4], tp[5]); o.w = pack2(tp[6], tp[7]);
        *reinterpret_cast<uint4*>(dst + (size_t)xmap(mode, tc * 64 + ci) * ldd + tr * 64 + r8) = o;
    }
    __syncthreads();
}

enum { M_INIT = 0, M_LN2NEXT = 1, M_LN1 = 2, M_FINAL = 3 };

template <int MODE>
__device__ __forceinline__ void rows_unit(const P& p, int l, int u, char* lds, bool dry = false) {
    const int tid = otid(), w = tid >> 6, lane = tid & 63;
    float* hbuf = (float*)lds;
    bf16_t* hb = (bf16_t*)(p.ws + WS_HBY);
#pragma unroll 1
    for (int rr = 0; rr < 2; ++rr) {
        const int rl = w * 2 + rr, row = u * 8 + rl;
        const int mr = row_mod(row);
        float v[16];
        float* xr = xrow(p, row);
        const float* src = (MODE == M_INIT) ? (row < NTC ? p.in(I_CTX) + (size_t)row * DM : p.in(I_X) + (size_t)(row - NTC) * DM) : xr;
#pragma unroll
        for (int i = 0; i < 4; ++i) {
            const float4 t = *reinterpret_cast<const float4*>(src + i * 256 + lane * 4);
            v[i * 4 + 0] = t.x; v[i * 4 + 1] = t.y; v[i * 4 + 2] = t.z; v[i * 4 + 3] = t.w;
        }
        if (MODE != M_INIT) {
            const int ll = (MODE == M_LN2NEXT) ? l - 1 : l;
            const int which = (MODE == M_LN1) ? 0 : 1;
            float s = 0.f;
#pragma unroll
            for (int i = 0; i < 16; ++i) s += v[i];
            const float mu = wave_sum(s) * (1.f / 1024.f);
            float q = 0.f;
#pragma unroll
            for (int i = 0; i < 16; ++i) { const float d = v[i] - mu; q += d * d; }
            const float rstd = rsqrtf(wave_sum(q) * (1.f / 1024.f) + 1e-5f);
            const float* g = p.in(I_LNG) + (size_t)(ll * 2 + which) * 1024;
            const float* bb = p.in(I_LNB) + (size_t)(ll * 2 + which) * 1024;
#pragma unroll
            for (int i = 0; i < 4; ++i) {
                const float4 gg = *reinterpret_cast<const float4*>(g + i * 256 + lane * 4);
                const float4 b4 = *reinterpret_cast<const float4*>(bb + i * 256 + lane * 4);
                v[i * 4 + 0] = (v[i * 4 + 0] - mu) * rstd * gg.x + b4.x;
                v[i * 4 + 1] = (v[i * 4 + 1] - mu) * rstd * gg.y + b4.y;
                v[i * 4 + 2] = (v[i * 4 + 2] - mu) * rstd * gg.z + b4.z;
                v[i * 4 + 3] = (v[i * 4 + 3] - mu) * rstd * gg.w + b4.w;
            }
        }
        if (MODE == M_FINAL) {
            if (row >= NTC) {
#pragma unroll
                for (int i = 0; i < 4; ++i) *reinterpret_cast<float4*>(xr + i * 256 + lane * 4) = make_float4(v[i * 4], v[i * 4 + 1], v[i * 4 + 2], v[i * 4 + 3]);
            }
            continue;
        }
        const float osc = (MODE == M_LN1) ? ALPHA : 1.f;
#pragma unroll
        for (int i = 0; i < 4; ++i) { float4 o4 = make_float4(osc * v[i * 4], osc * v[i * 4 + 1], osc * v[i * 4 + 2], osc * v[i * 4 + 3]); if (dry) o4 = *reinterpret_cast<const float4*>(src + i * 256 + lane * 4); *reinterpret_cast<float4*>(xr + i * 256 + lane * 4) = o4; }
        const float* sh = modp(p, l, mr, (MODE == M_LN1) ? 3 : 0);
        const float* sc = modp(p, l, mr, (MODE == M_LN1) ? 4 : 1);
#pragma unroll
        for (int i = 0; i < 4; ++i) {
            const float4 s4 = *reinterpret_cast<const float4*>(sc + i * 256 + lane * 4);
            const float4 h4 = *reinterpret_cast<const float4*>(sh + i * 256 + lane * 4);
            const float h0 = v[i * 4 + 0] * (1.f + s4.x) + h4.x, h1 = v[i * 4 + 1] * (1.f + s4.y) + h4.y;
            const float h2 = v[i * 4 + 2] * (1.f + s4.z) + h4.z, h3 = v[i * 4 + 3] * (1.f + s4.w) + h4.w;
            uint2 pk; pk.x = pack2(h0, h1); pk.y = pack2(h2, h3);
            if (!dry) *reinterpret_cast<uint2*>(hb + (size_t)row * DM + i * 256 + lane * 4) = pk;
            if (MODE == M_LN1) *reinterpret_cast<float4*>(hbuf + rl * 1024 + i * 256 + lane * 4) = make_float4(h0, h1, h2, h3);
        }
    }
    if (MODE == M_LN1) {
        float* part = hbuf + 8 * 1024;
        __syncthreads();
        {
            const float* rw = p.in(I_ROUTER_W) + (size_t)l * 1024 * 64 + lane;
            float ac[8];
#pragma unroll
            for (int r = 0; r < 8; ++r) ac[r] = 0.f;
#pragma unroll 2
            for (int k = w * 256; k < w * 256 + 256; k += 4) {
                const float w0 = rw[(size_t)(k + 0) * 64], w1 = rw[(size_t)(k + 1) * 64], w2 = rw[(size_t)(k + 2) * 64], w3 = rw[(size_t)(k + 3) * 64];
#pragma unroll
                for (int r = 0; r < 8; ++r) {
                    const float4 x = *reinterpret_cast<const float4*>(hbuf + r * 1024 + k);
                    ac[r] += x.x * w0 + x.y * w1 + x.z * w2 + x.w * w3;
                }
            }
#pragma unroll
            for (int r = 0; r < 8; ++r) part[(w * 8 + r) * 64 + lane] = ac[r];
        }
        __syncthreads();
        float a0, a1;
        {
            const int r0 = w * 2, r1 = w * 2 + 1;
            a0 = part[(0 * 8 + r0) * 64 + lane] + part[(1 * 8 + r0) * 64 + lane] + part[(2 * 8 + r0) * 64 + lane] + part[(3 * 8 + r0) * 64 + lane];
            a1 = part[(0 * 8 + r1) * 64 + lane] + part[(1 * 8 + r1) * 64 + lane] + part[(2 * 8 + r1) * 64 + lane] + part[(3 * 8 + r1) * 64 + lane];
        }
        const float rbias = p.in(I_ROUTER_B)[l * 64 + lane];
        unsigned* cnt = (unsigned*)(p.ws + WS_CTL) + CW_CNT(l);
        int* aep = (int*)(p.ws + WS_AEP); float* aw = (float*)(p.ws + WS_AW);
#pragma unroll 1
        for (int rr = 0; rr < 2; ++rr) {
            const int row = u * 8 + w * 2 + rr;
            const float logit = rr ? a1 : a0;
            const float s = 1.f / (1.f + expf(-logit));
            const float bsd = s + rbias;
            float m1 = bsd;
            m1 = fmaxf(m1, __shfl_xor(m1, 1)); m1 = fmaxf(m1, __shfl_xor(m1, 2)); m1 = fmaxf(m1, __shfl_xor(m1, 4));
            const unsigned long long eqm = __ballot(bsd == m1);
            const int gbase = lane & ~7;
            const unsigned gbits = (unsigned)((eqm >> gbase) & 0xFFull);
            const int first = gbase + __builtin_ctz(gbits);
            float m2 = (lane == first) ? -INFINITY : bsd;
            m2 = fmaxf(m2, __shfl_xor(m2, 1)); m2 = fmaxf(m2, __shfl_xor(m2, 2)); m2 = fmaxf(m2, __shfl_xor(m2, 4));
            const float gs = m1 + m2;
            const int myg = lane >> 3;
            int grank = 0;
#pragma unroll
            for (int g2 = 0; g2 < 8; ++g2) { const float o = __shfl(gs, g2 * 8); grank += (o > gs || (o == gs && g2 < myg)) ? 1 : 0; }
            const bool gsel = grank < 4;
            const float msk = gsel ? bsd : -INFINITY;
            int erank = 0;
#pragma unroll
            for (int j = 0; j < 64; ++j) { const float o = __shfl(msk, j); erank += (o > msk || (o == msk && j < lane)) ? 1 : 0; }
            const bool sel = gsel && erank < 8;
            const float wsum = wave_sum(sel ? s : 0.f);
            const unsigned long long selm = __ballot(sel);
            if (sel && !dry) {
                const int slot = __popcll(selm & ((1ull << lane) - 1ull));
                const unsigned pos = atomicAdd(&cnt[lane], 1u);
                aep[(size_t)row * 8 + slot] = (int)((unsigned)lane << 24 | pos);
                ((int*)(p.ws + WS_RTOK))[(size_t)lane * NT + pos] = row;
                aw[(size_t)row * 8 + slot] = s / wsum * 2.5f;
            }
        }
    }
}

__device__ __forceinline__ void filt_unit(const P& p, int l, int u, char* lds) {
    const int tid = otid();
    float* feat = (float*)lds;
    float* h1 = feat + 4 * 36;
    float* h2 = h1 + 4 * 64;
    const int pp = tid >> 6, j = tid & 63;
    const int pi = u * 4 + pp;
    const int L = pi < 4096 ? 4096 : 256;
    const int t = pi < 4096 ? pi : pi - 4096;
    const float tt = (float)t / (float)(L - 1);
    if (j < 33) {
        float f;
        if (j == 0) f = tt;
        else {
            const int k = (j - 1) & 15;
            const float band = 1e-4f + (float)k * ((15.0f - 1e-4f) / 15.0f);
            float ph = band * (float)t * (1.f / (float)L);
            ph -= floorf(ph);
            float sn, cs; sincospif(2.f * ph, &sn, &cs);
            f = (j <= 16) ? cs : -sn;
        }
        feat[pp * 36 + j] = f;
    }
    __syncthreads();
    {
        const float* w1 = p.in(I_HY_W1) + (size_t)l * 33 * 64;
        float a = p.in(I_HY_B1)[l * 64 + j];
        for (int i = 0; i < 33; ++i) a += feat[pp * 36 + i] * w1[i * 64 + j];
        h1[pp * 64 + j] = sinf(p.in(I_HY_F1)[l * 64 + j] * a);
    }
    __syncthreads();
    {
        const float* w2 = p.in(I_HY_W2) + (size_t)l * 64 * 64;
        float a = p.in(I_HY_B2)[l * 64 + j];
        for (int i = 0; i < 64; ++i) a += h1[pp * 64 + i] * w2[i * 64 + j];
        h2[pp * 64 + j] = sinf(p.in(I_HY_F2)[l * 64 + j] * a);
    }
    __syncthreads();
    {
        const int c = tid;
        const float* w3 = p.in(I_HY_W3) + (size_t)l * 64 * 1024;
        float acc[4][4];
#pragma unroll
        for (int a = 0; a < 4; ++a)
#pragma unroll
            for (int b = 0; b < 4; ++b) acc[a][b] = 0.f;
        for (int i = 0; i < 64; ++i) {
            float wv[4];
#pragma unroll
            for (int os = 0; os < 4; ++os) wv[os] = w3[i * 1024 + os * 256 + c];
#pragma unroll
            for (int q = 0; q < 4; ++q) {
                const float hv = h2[q * 64 + i];
#pragma unroll
                for (int os = 0; os < 4; ++os) acc[q][os] += hv * wv[os];
            }
        }
        const float d0 = logf(0.01f) / 1.5f, d1 = logf(0.01f) / 0.3f;
        const float delta = fabsf(d0 + (d1 - d0) * ((float)c / 255.f));
#pragma unroll
        for (int q = 0; q < 4; ++q) {
            const int pq = u * 4 + q;
            const int Lq = pq < 4096 ? 4096 : 256;
            const int tq = pq < 4096 ? pq : pq - 4096;
            const float ttq = (float)tq / (float)(Lq - 1);
            const float dec = expf(-ttq * delta);
            float* F = (pq < 4096) ? (float*)(p.ws + WS_FILTL) : (float*)(p.ws + WS_FILTC);
#pragma unroll
            for (int os = 0; os < 4; ++os) {
                if (pq < 4096) F[((size_t)((os >> 1) * 256 + c) * 2 + (os & 1)) * 4096 + tq] = acc[q][os] * dec;
                else F[((size_t)os * 256 + c) * Lq + tq] = acc[q][os] * dec;
            }
        }
    }
    __syncthreads();
}

__device__ __forceinline__ void rwkv_prep_unit(const P& p, int l, int u, char* lds) {
    const int tid = otid(), w = tid >> 6;
    float* tw = (float*)lds;
    float* al = tw + 32 * 64;
    const bf16_t* z = (const bf16_t*)(p.ws + WS_Z);
    bf16_t* rwp = (bf16_t*)(p.ws + WS_R1 + R1_RWP);
    float* knorm = (float*)(p.ws + WS_KNORM);
    const int row0 = u * 32;
#pragma unroll
    for (int i = 0; i < 8; ++i) {
        const int idx = tid + 256 * i, tok = idx >> 6, j = idx & 63;
        const bf16_t* zr = z + (size_t)(row0 + tok) * ZS;
        { const float xv = bf2f(zr[768 + j]); tw[idx] = 1.f - 2.f * __frcp_rn(1.f + __expf(2.f * xv)); }
        al[idx] = bf2f(zr[832 + j]);
    }
    __syncthreads();
    const int c = tid;
#pragma unroll 1
    for (int pass = 0; pass < 4; ++pass) {
        const int d = pass & 1;
        const bool isA = pass >= 2;
        const float* W2 = (isA ? p.in(I_RW_A2) : p.in(I_RW_W2)) + (size_t)((l * 2 + d) * 32) * 256 + c;
        const float base = (isA ? p.in(I_RW_A0) : p.in(I_RW_W0))[(l * 2 + d) * 256 + c];
        float wr[32];
#pragma unroll
        for (int r = 0; r < 32; ++r) wr[r] = W2[r * 256];
        const float* src = isA ? al : tw;
#pragma unroll 2
        for (int tok = 0; tok < 32; ++tok) {
            float a = base;
#pragma unroll
            for (int r = 0; r < 32; r += 4) {
                const float4 x = *reinterpret_cast<const float4*>(src + tok * 64 + d * 32 + r);
                a += x.x * wr[r] + x.y * wr[r + 1] + x.z * wr[r + 2] + x.w * wr[r + 3];
            }
            float o;
            if (isA) o = __frcp_rn(1.f + __expf(-a));
            else { const float na = -a; const float sp = fmaxf(na, 0.f) + __logf(1.f + __expf(-fabsf(na))); o = __expf(-sp - 0.5f); }
            rwp[((size_t)(row0 + tok) * 4 + pass) * 256 + c] = f2bf(o);
        }
    }
    const float kkc = p.in(I_RW_KK)[l * 256 + c];
#pragma unroll 4
    for (int tok = 0; tok < 32; ++tok) {
        const float kv = bf2f(z[(size_t)(row0 + tok) * ZS + 256 + c]) * kkc;
        const float ss = wave_sum(kv * kv);
        if ((tid & 63) == 0) knorm[(size_t)(row0 + tok) * 4 + w] = rsqrtf(ss + 1e-12f);
    }
    __syncthreads();
}

__device__ __forceinline__ void gdn_prep_unit(const P& p, int l, int u) {
    const int tid = otid();
    const bf16_t* z = (const bf16_t*)(p.ws + WS_Z);
    bf16_t* gq = (bf16_t*)(p.ws + WS_R1 + R1_GQ);
    float* gab = (float*)(p.ws + WS_GAB);
    const int row0 = u * 32;
    int seq0, seqL;
    if (row0 < NTC) { seq0 = row0 & ~255; seqL = 256; } else { seq0 = NTC + ((row0 - NTC) & ~4095); seqL = 4096; }
    const int tl = tid >> 5, cg = tid & 31;
#pragma unroll 1
    for (int pz = 0; pz < 3; ++pz) {
        const int ch0 = pz * 256 + cg * 8;
        float w0[8], w1[8], w2[8];
        {
            const float* cw = p.in(I_GD_CONV) + (size_t)l * 3 * 768 + ch0;
#pragma unroll
            for (int i = 0; i < 8; i += 4) {
                const float4 a = *reinterpret_cast<const float4*>(cw + i), b = *reinterpret_cast<const float4*>(cw + 768 + i), c = *reinterpret_cast<const float4*>(cw + 1536 + i);
                w0[i] = a.x; w0[i + 1] = a.y; w0[i + 2] = a.z; w0[i + 3] = a.w;
                w1[i] = b.x; w1[i + 1] = b.y; w1[i + 2] = b.z; w1[i + 3] = b.w;
                w2[i] = c.x; w2[i + 1] = c.y; w2[i + 2] = c.z; w2[i + 3] = c.w;
            }
        }
#pragma unroll 2
        for (int it = 0; it < 4; ++it) {
            const int row = row0 + it * 8 + tl;
            const bf16_t* zc = z + (size_t)row * ZS + COL_GD + ch0;
            const uint4 zero4 = make_uint4(0u, 0u, 0u, 0u);
            const uint4 vm = (row - 1 >= seq0) ? *reinterpret_cast<const uint4*>(zc - ZS) : zero4;
            const uint4 v0 = *reinterpret_cast<const uint4*>(zc);
            const uint4 vp = (row + 1 < seq0 + seqL) ? *reinterpret_cast<const uint4*>(zc + ZS) : zero4;
            float xm[8], x0[8], xp[8], o[8];
            unpack8(vm, xm); unpack8(v0, x0); unpack8(vp, xp);
            float ss = 0.f;
#pragma unroll
            for (int i = 0; i < 8; ++i) { o[i] = siluf(w0[i] * xm[i] + w1[i] * x0[i] + w2[i] * xp[i]); ss += o[i] * o[i]; }
            if (pz < 2) {
                ss = sum8lanes(ss);
                const float sc = rsqrtf(ss + 1e-12f) * (pz == 0 ? 0.125f : 1.f);
#pragma unroll
                for (int i = 0; i < 8; ++i) o[i] *= sc;
            }
            *reinterpret_cast<uint4*>(gq + (size_t)row * 768 + ch0) = pack8(o);
        }
    }
    {
        const int tok = tid >> 3, dh = tid & 7;
        const int row = row0 + tok;
        const float alv = bf2f(z[(size_t)row * ZS + COL_GD + 1024 + dh]);
        const float blv = bf2f(z[(size_t)row * ZS + COL_GD + 1032 + dh]);
        const float g = -expf(p.in(I_GD_ALOG)[l * 8 + dh]) * softplusf(alv + p.in(I_GD_DTB)[l * 8 + dh]);
        gab[(size_t)row * 16 + dh] = expf(g);
        gab[(size_t)row * 16 + 8 + dh] = 1.f / (1.f + expf(-blv));
    }
}

__device__ __forceinline__ int s5_chain_row(int b, int d, int q) {
    if (q < 256) return b * 256 + (d ? 255 - q : q);
    int n = q - 256; if (d) n = 4095 - n;
    return NTC + b * 4096 + (n & 63) * 64 + (n >> 6);
}
__device__ __forceinline__ void s5_load_u(const bf16_t* zr, float* dst) {
    const uint4 a = *reinterpret_cast<const uint4*>(zr);
    const uint4 b = *reinterpret_cast<const uint4*>(zr + 8);
    *reinterpret_cast<float4*>(dst + 0) = make_float4(bflo(a.x), bfhi(a.x), bflo(a.y), bfhi(a.y));
    *reinterpret_cast<float4*>(dst + 4) = make_float4(bflo(a.z), bfhi(a.z), bflo(a.w), bfhi(a.w));
    *reinterpret_cast<float4*>(dst + 8) = make_float4(bflo(b.x), bfhi(b.x), bflo(b.y), bfhi(b.y));
    *reinterpret_cast<float4*>(dst + 12) = make_float4(bflo(b.z), bfhi(b.z), bflo(b.w), bfhi(b.w));
}

__device__ __forceinline__ void s5_pre_unit(const P& p, int l, int u, char* lds) {
    const int tid = otid(), w = tid >> 6, lane = tid & 63;
    float* ust = (float*)lds + w * 1024;
    const int wt = u * 4 + w;
    const int d = wt & 1, g = (wt >> 1) & 15, rest = wt >> 5;
    const int cc = rest % NCHUNK, b = rest / NCHUNK;
    const bf16_t* z = (const bf16_t*)(p.ws + WS_Z);
    {
        const int row = s5_chain_row(b, d, cc * 64 + lane);
        s5_load_u(z + (size_t)row * ZS + COL_S5 + g * 16, ust + lane * 16);
    }
    const int tix = ((l * 2 + d) * 16 + g) * 64 + lane;
    const float4 A = *reinterpret_cast<const float4*>((const float*)(p.ws + WS_S5A) + (size_t)tix * 4);
    const float* Bp = (const float*)(p.ws + WS_S5B) + (size_t)tix * 32;
    float br[16], bi[16];
#pragma unroll
    for (int h = 0; h < 16; ++h) { br[h] = Bp[h]; bi[h] = Bp[16 + h]; }
    float xr = 0.f, xi = 0.f;
#pragma unroll 2
    for (int s = 0; s < 64; ++s) {
        float ur = 0.f, ui = 0.f;
#pragma unroll
        for (int h4 = 0; h4 < 4; ++h4) {
            const float4 uu = *reinterpret_cast<const float4*>(ust + s * 16 + h4 * 4);
            ur += br[h4 * 4] * uu.x + br[h4 * 4 + 1] * uu.y + br[h4 * 4 + 2] * uu.z + br[h4 * 4 + 3] * uu.w;
            ui += bi[h4 * 4] * uu.x + bi[h4 * 4 + 1] * uu.y + bi[h4 * 4 + 2] * uu.z + bi[h4 * 4 + 3] * uu.w;
        }
        const float nr = A.x * xr - A.y * xi + ur;
        const float ni = A.x * xi + A.y * xr + ui;
        xr = nr; xi = ni;
    }
    float* st = (float*)(p.ws + WS_S5ST) + ((((size_t)(b * NCHUNK + cc) * 2 + d) * 16 + g) * 64 + lane) * 2;
    st[0] = xr; st[1] = xi;
}

__device__ __forceinline__ float reduce16(const float (&t)[16], int lane) {
    float a[8];
    const bool hi8 = (lane & 8) != 0;
#pragma unroll
    for (int k = 0; k < 8; ++k) { const float keep = hi8 ? t[k + 8] : t[k]; const float send = hi8 ? t[k] : t[k + 8]; a[k] = keep + dppf<0x140>(send); }
    float b[4];
    const bool hi4 = (lane & 4) != 0;
#pragma unroll
    for (int k = 0; k < 4; ++k) { const float keep = hi4 ? a[k + 4] : a[k]; const float send = hi4 ? a[k] : a[k + 4]; b[k] = keep + dppf<0x141>(send); }
    float c[2];
    const bool hi2 = (lane & 2) != 0;
#pragma unroll
    for (int k = 0; k < 2; ++k) { const float keep = hi2 ? b[k + 2] : b[k]; const float send = hi2 ? b[k] : b[k + 2]; c[k] = keep + dppf<0x4E>(send); }
    const bool hi1 = (lane & 1) != 0;
    float r = (hi1 ? c[1] : c[0]) + dppf<0xB1>(hi1 ? c[0] : c[1]);
    r += __shfl_xor(r, 16);
    r += __shfl_xor(r, 32);
    return r;
}

__device__ __forceinline__ void s5_main_unit(const P& p, int l, int u, char* lds) {
    const int tid = otid(), w = tid >> 6, lane = tid & 63;
    char* wl = lds + w * 12800;
    float* ust = (float*)wl;
    char* xbuf = wl + 4096;
    float* yst = (float*)xbuf;
    const int b = u / NCHUNK, tc = u % NCHUNK;
    bf16_t* z = (bf16_t*)(p.ws + WS_Z);
    const int myrow = (tc < 4) ? (b * 256 + tc * 64 + lane) : (NTC + b * 4096 + lane * 64 + (tc - 4));
    const int fr = lane & 15, fq = lane >> 4;
#pragma unroll 1
    for (int gi = 0; gi < 4; ++gi) {
        const int g = w * 4 + gi;
        s5_load_u(z + (size_t)myrow * ZS + COL_S5 + g * 16, ust + lane * 16);
        f32x4 yacc[4];
#pragma unroll
        for (int mf = 0; mf < 4; ++mf) yacc[mf] = f32x4{0.f, 0.f, 0.f, 0.f};
#pragma unroll 1
        for (int d = 0; d < 2; ++d) {
            const int tix = ((l * 2 + d) * 16 + g) * 64 + lane;
            const float4 A = *reinterpret_cast<const float4*>((const float*)(p.ws + WS_S5A) + (size_t)tix * 4);
            const float* Bp = (const float*)(p.ws + WS_S5B) + (size_t)tix * 32;
            f32x2 bb[16];
#pragma unroll
            for (int h = 0; h < 16; ++h) bb[h] = f32x2{Bp[h], Bp[16 + h]};
            bf16x8 cfrag[4];
            {
                const float* crp = p.in(I_S5_CRE) + (size_t)((l * 2 + d) * 16 + g) * 1024 + fr * 64;
                const float* cip = p.in(I_S5_CIM) + (size_t)((l * 2 + d) * 16 + g) * 1024 + fr * 64;
#pragma unroll
                for (int ks = 0; ks < 4; ++ks) {
                    const int k0 = (ks & 1) * 32 + fq * 8;
                    const float* src = (ks < 2) ? crp + k0 : cip + k0;
                    const float sg = (ks < 2) ? 1.f : -1.f;
                    const float4 c0 = *reinterpret_cast<const float4*>(src), c1 = *reinterpret_cast<const float4*>(src + 4);
                    cfrag[ks][0] = (short)f2bf(sg * c0.x); cfrag[ks][1] = (short)f2bf(sg * c0.y); cfrag[ks][2] = (short)f2bf(sg * c0.z); cfrag[ks][3] = (short)f2bf(sg * c0.w);
                    cfrag[ks][4] = (short)f2bf(sg * c1.x); cfrag[ks][5] = (short)f2bf(sg * c1.y); cfrag[ks][6] = (short)f2bf(sg * c1.z); cfrag[ks][7] = (short)f2bf(sg * c1.w);
                }
            }
            const int cc = d ? ((tc < 4) ? 3 - tc : 71 - tc) : tc;
            float xr = 0.f, xi = 0.f;
            {
                const float* st = (const float*)(p.ws + WS_S5ST) + ((((size_t)(b * NCHUNK) * 2 + d) * 16 + g) * 64 + lane) * 2;
                for (int c0 = 0; c0 < cc; c0 += 8) {
                    float2 sv[8];
#pragma unroll
                    for (int q = 0; q < 8; ++q) {
                        const int c2 = (c0 + q < cc) ? c0 + q : cc - 1;
                        sv[q] = *reinterpret_cast<const float2*>(st + (size_t)c2 * (2 * 16 * 64 * 2));
                    }
#pragma unroll
                    for (int q = 0; q < 8; ++q) {
                        if (c0 + q < cc) {
                            const float nr = A.z * xr - A.w * xi + sv[q].x;
                            const float ni = A.z * xi + A.w * xr + sv[q].y;
                            xr = nr; xi = ni;
                        }
                    }
                }
            }
#pragma unroll 1
            for (int hf = 0; hf < 2; ++hf) {
                const int hbase = (d ? 1 - hf : hf) * 32;
#pragma unroll 4
                for (int s = 0; s < 32; ++s) {
                    const int il = d ? 31 - s : s;
                    const float* up = ust + (hbase + il) * 16;
                    f32x2 bu = f32x2{0.f, 0.f};
#pragma unroll
                    for (int h4 = 0; h4 < 4; ++h4) {
                        const float4 uu = *reinterpret_cast<const float4*>(up + h4 * 4);
                        bu += bb[h4 * 4] * uu.x + bb[h4 * 4 + 1] * uu.y + bb[h4 * 4 + 2] * uu.z + bb[h4 * 4 + 3] * uu.w;
                    }
                    const float nr = A.x * xr - A.y * xi + bu.x;
                    const float ni = A.x * xi + A.y * xr + bu.y;
                    xr = nr; xi = ni;
                    *reinterpret_cast<bf16_t*>(xbuf + il * 272 + lane * 2) = f2bf(xr);
                    *reinterpret_cast<bf16_t*>(xbuf + il * 272 + 128 + lane * 2) = f2bf(xi);
                }
#pragma unroll
                for (int mfl = 0; mfl < 2; ++mfl) {
                    f32x4 acc = yacc[0];
                    const int mf = (hbase >> 4) + mfl;
                    acc = (mf == 0) ? yacc[0] : (mf == 1) ? yacc[1] : (mf == 2) ? yacc[2] : yacc[3];
#pragma unroll
                    for (int ks = 0; ks < 4; ++ks) {
                        const bf16x8 af = *reinterpret_cast<const bf16x8*>(xbuf + (mfl * 16 + fr) * 272 + ks * 64 + fq * 16);
                        acc = __builtin_amdgcn_mfma_f32_16x16x32_bf16(af, cfrag[ks], acc, 0, 0, 0);
                    }
                    if (mf == 0) yacc[0] = acc; else if (mf == 1) yacc[1] = acc; else if (mf == 2) yacc[2] = acc; else yacc[3] = acc;
                }
            }
        }
#pragma unroll
        for (int mf = 0; mf < 4; ++mf)
#pragma unroll
            for (int j = 0; j < 4; ++j) yst[(mf * 16 + fq * 4 + j) * 16 + fr] = yacc[mf][j];
        {
            const float* dsk = p.in(I_S5_D) + l * 256 + g * 16;
            unsigned pk[8];
#pragma unroll
            for (int h = 0; h < 16; h += 2) {
                float y0 = yst[lane * 16 + h] + ust[lane * 16 + h] * dsk[h];
                float y1 = yst[lane * 16 + h + 1] + ust[lane * 16 + h + 1] * dsk[h + 1];
                y0 = 0.5f * y0 * (1.f + erff(y0 * 0.70710678118f));
                y1 = 0.5f * y1 * (1.f + erff(y1 * 0.70710678118f));
                pk[h >> 1] = pack2(y0, y1);
            }
            uint4* dst = reinterpret_cast<uint4*>((bf16_t*)(p.ws + WS_S5G) + (size_t)myrow * 256 + g * 16);
            dst[0] = make_uint4(pk[0], pk[1], pk[2], pk[3]);
            dst[1] = make_uint4(pk[4], pk[5], pk[6], pk[7]);
        }
    }
}

#define SB 16
__device__ __forceinline__ int scan_chain_row(int b, int d, int q) {
    if (q < 256) return b * 256 + (d ? 255 - q : q);
    const int t = q - 256;
    return NTC + b * 4096 + (d ? 4095 - t : t);
}
struct ScanRaw { uint2 r, k, v, e, a; float f0, f1; };

__device__ __forceinline__ void scan_load(const P& p, int m, int b, int h, int d, int q, int cg, ScanRaw& R) {
    const int row = scan_chain_row(b, d, q);
    const int c0 = h * 64 + cg * 4;
    if (m == 0) {
        const bf16_t* z = (const bf16_t*)(p.ws + WS_Z) + (size_t)row * ZS + c0;
        R.r = *reinterpret_cast<const uint2*>(z);
        R.k = *reinterpret_cast<const uint2*>(z + 256);
        R.v = *reinterpret_cast<const uint2*>(z + 512);
        const bf16_t* rw = (const bf16_t*)(p.ws + WS_R1 + R1_RWP) + (size_t)row * 1024 + c0;
        R.e = *reinterpret_cast<const uint2*>(rw + d * 256);
        R.a = *reinterpret_cast<const uint2*>(rw + (2 + d) * 256);
        R.f0 = ((const float*)(p.ws + WS_KNORM))[(size_t)row * 4 + h];
        R.f1 = 0.f;
    } else {
        const bf16_t* gq = (const bf16_t*)(p.ws + WS_R1 + R1_GQ) + (size_t)row * 768 + c0;
        R.r = *reinterpret_cast<const uint2*>(gq);
        R.k = *reinterpret_cast<const uint2*>(gq + 256);
        R.v = *reinterpret_cast<const uint2*>(gq + 512);
        R.e = make_uint2(0u, 0u); R.a = make_uint2(0u, 0u);
        const float* gab = (const float*)(p.ws + WS_GAB) + (size_t)row * 16;
        R.f0 = gab[d * 4 + h];
        R.f1 = gab[8 + d * 4 + h];
    }
}
__device__ __forceinline__ void scan_store(int m, const ScanRaw& R, float* dst  , const float (&kkp)[4], const float (&kap)[4]) {
    float r[4] = {bflo(R.r.x), bfhi(R.r.x), bflo(R.r.y), bfhi(R.r.y)};
    float k[4] = {bflo(R.k.x), bfhi(R.k.x), bflo(R.k.y), bfhi(R.k.y)};
    float v[4] = {bflo(R.v.x), bfhi(R.v.x), bflo(R.v.y), bfhi(R.v.y)};
    float ww[4], aa[4], bb[4], kk[4];
    if (m == 0) {
        float e[4] = {bflo(R.e.x), bfhi(R.e.x), bflo(R.e.y), bfhi(R.e.y)};
        float a[4] = {bflo(R.a.x), bfhi(R.a.x), bflo(R.a.y), bfhi(R.a.y)};
#pragma unroll
        for (int i = 0; i < 4; ++i) {
            ww[i] = __expf(-e[i]);
            kk[i] = k[i] * (1.f + (a[i] - 1.f) * kap[i]);
            const float kn = k[i] * kkp[i] * R.f0;
            aa[i] = -kn;
            bb[i] = kn * a[i];
        }
    } else {
        const float al = R.f0, be = R.f1;
#pragma unroll
        for (int i = 0; i < 4; ++i) { ww[i] = al; aa[i] = k[i]; bb[i] = -al * be * k[i]; kk[i] = be * k[i]; }
    }
    *reinterpret_cast<float4*>(dst + 0 * 64) = make_float4(ww[0], ww[1], ww[2], ww[3]);
    *reinterpret_cast<float4*>(dst + 1 * 64) = make_float4(aa[0], aa[1], aa[2], aa[3]);
    *reinterpret_cast<float4*>(dst + 2 * 64) = make_float4(bb[0], bb[1], bb[2], bb[3]);
    *reinterpret_cast<float4*>(dst + 3 * 64) = make_float4(kk[0], kk[1], kk[2], kk[3]);
    *reinterpret_cast<float4*>(dst + 4 * 64) = make_float4(r[0], r[1], r[2], r[3]);
    *reinterpret_cast<float4*>(dst + 5 * 64) = make_float4(v[0], v[1], v[2], v[3]);
}

__device__ __forceinline__ void scan_unit(const P& p, int l, int u, char* lds) {
    const int tid = otid();
    const int chain = u >> 1, half = u & 1;
    const int m = chain >> 6, rem = chain & 63, b = rem >> 3, h = (rem >> 1) & 3, d = rem & 1;
    float* buf = (float*)lds;
    float* ybuf = buf + 2 * SB * 384;
    const int rp = tid >> 4, sub = tid & 15;
    const int st = tid >> 4, cg = tid & 15;
    float kkp[4], kap[4];
#pragma unroll
    for (int i = 0; i < 4; ++i) { kkp[i] = p.in(I_RW_KK)[l * 256 + h * 64 + cg * 4 + i]; kap[i] = p.in(I_RW_KA)[l * 256 + h * 64 + cg * 4 + i]; }
    bf16_t* ys = (bf16_t*)(p.ws + WS_HBY) + (size_t)(m * 2 + d) * NT * 256;
    f32x2 S2[4];
#pragma unroll
    for (int j = 0; j < 4; ++j) S2[j] = f32x2{0.f, 0.f};
    ScanRaw R, R2;
    scan_load(p, m, b, h, d, st, cg, R);
    scan_store(m, R, buf + (st * 6) * 64 + cg * 4, kkp, kap);
    scan_load(p, m, b, h, d, SB + st, cg, R);
    __syncthreads();
    const int NB = 4352 / SB;
    __builtin_amdgcn_s_setprio(2);
    auto batch = [&](int bt, ScanRaw& Rld, ScanRaw& Rst) {
        const int par = bt & 1;
        if (bt + 2 < NB) scan_load(p, m, b, h, d, (bt + 2) * SB + st, cg, Rld);
        const float* cb = buf + par * (SB * 384);
        float* yb = ybuf + par * (SB * 32);
        {
            const float* sb0 = cb + sub * 4;
            const float* vb0 = cb + 320 + half * 32 + rp;
            float4 nw = *reinterpret_cast<const float4*>(sb0), na = *reinterpret_cast<const float4*>(sb0 + 64), nb = *reinterpret_cast<const float4*>(sb0 + 128);
            float4 nk = *reinterpret_cast<const float4*>(sb0 + 192), nr = *reinterpret_cast<const float4*>(sb0 + 256);
            float nvA = vb0[0], nvB = vb0[16];
#pragma unroll
            for (int s = 0; s < SB; ++s) {
                const float4 w = nw, a = na, bq = nb, k = nk, r = nr;
                const float vA = nvA, vB = nvB;
                if (s + 1 < SB) {
                    const float* sb = sb0 + (s + 1) * 384;
                    nw = *reinterpret_cast<const float4*>(sb); na = *reinterpret_cast<const float4*>(sb + 64); nb = *reinterpret_cast<const float4*>(sb + 128);
                    nk = *reinterpret_cast<const float4*>(sb + 192); nr = *reinterpret_cast<const float4*>(sb + 256);
                    nvA = vb0[(s + 1) * 384]; nvB = vb0[(s + 1) * 384 + 16];
                }
                __builtin_amdgcn_sched_barrier(0);
                const f32x2 v2 = {vA, vB};
                f32x2 sa2 = (S2[0] * a.x + S2[1] * a.y) + (S2[2] * a.z + S2[3] * a.w);
                float sa = sa2.x, sb2 = sa2.y;
                sa += dppf<0xB1>(sa); sb2 += dppf<0xB1>(sb2);
                sa += dppf<0x4E>(sa); sb2 += dppf<0x4E>(sb2);
                sa += dppf<0x141>(sa); sb2 += dppf<0x141>(sb2);
                sa += dppf<0x140>(sa); sb2 += dppf<0x140>(sb2);
                sa2.x = sa; sa2.y = sb2;
                S2[0] = S2[0] * w.x + sa2 * bq.x + v2 * k.x;
                S2[1] = S2[1] * w.y + sa2 * bq.y + v2 * k.y;
                S2[2] = S2[2] * w.z + sa2 * bq.z + v2 * k.z;
                S2[3] = S2[3] * w.w + sa2 * bq.w + v2 * k.w;
                const f32x2 y2 = (S2[0] * r.x + S2[1] * r.y) + (S2[2] * r.z + S2[3] * r.w);
                float yA = y2.x, yB = y2.y;
                yA += dppf<0xB1>(yA); yB += dppf<0xB1>(yB);
                yA += dppf<0x4E>(yA); yB += dppf<0x4E>(yB);
                yA += dppf<0x141>(yA); yB += dppf<0x141>(yB);
                yA += dppf<0x140>(yA); yB += dppf<0x140>(yB);
                yb[s * 32 + rp] = yA; yb[s * 32 + 16 + rp] = yB;
            }
        }
        if (bt + 1 < NB) scan_store(m, Rst, buf + (1 - par) * (SB * 384) + (st * 6) * 64 + cg * 4, kkp, kap);
        __syncthreads();
        {
            const int r2 = cg * 2;
            const int row = scan_chain_row(b, d, bt * SB + st);
            const unsigned pk = pack2(yb[st * 32 + r2], yb[st * 32 + r2 + 1]);
            *reinterpret_cast<unsigned*>(ys + (size_t)row * 256 + h * 64 + half * 32 + r2) = pk;
        }
    };
#pragma unroll 1
    for (int bt = 0; bt < NB; bt += 2) { batch(bt, R2, R); batch(bt + 1, R, R2); }
    __builtin_amdgcn_s_setprio(0);
    __syncthreads();
}

template <int L>
__device__ __forceinline__ void hyena_unit(const P& p, int l, int u, char* lds) {
    constexpr int TPT = L / 256;
    const int tid = otid();
    const int c = u >> 2, bp = u & 3;
    float2* u2 = (float2*)lds;
    float* taps = (float*)(lds + (size_t)L * 8);
    const bf16_t* z = (const bf16_t*)(p.ws + WS_Z);
    bf16_t* cat = (bf16_t*)(p.ws + WS_CAT);
    const float* F = (L == 4096) ? (const float*)(p.ws + WS_FILTL) : (const float*)(p.ws + WS_FILTC);
    int base[2];
#pragma unroll
    for (int bb = 0; bb < 2; ++bb) { const int b = bp * 2 + bb; base[bb] = (L == 4096) ? NTC + b * 4096 : b * 256; }
    const int t0 = tid * TPT;
    const float* cw = p.in(I_HY_CONV) + (size_t)l * 3 * 768; const float* cb = p.in(I_HY_CONVB) + (size_t)l * 768;
    auto sconv = [&](int part, int bb, float (&o)[TPT]) {
        const int ch = part * 256 + c;
        const float w0 = cw[ch], w1 = cw[768 + ch], w2 = cw[1536 + ch], bs = cb[ch];
        const bf16_t* zc = z + (size_t)base[bb] * ZS + COL_HY + ch;
        float xm = (t0 > 0) ? bf2f(zc[(size_t)(t0 - 1) * ZS]) : 0.f;
        float x0 = bf2f(zc[(size_t)t0 * ZS]);
#pragma unroll
        for (int i = 0; i < TPT; ++i) {
            const int t = t0 + i;
            const float xp = (t + 1 < L) ? bf2f(zc[(size_t)(t + 1) * ZS]) : 0.f;
            o[i] = w0 * xm + w1 * x0 + w2 * xp + bs;
            xm = x0; x0 = xp;
        }
    };
    {
        float v0[TPT], v1[TPT];
        sconv(2, 0, v0); sconv(2, 1, v1);
#pragma unroll
        for (int i = 0; i < TPT; ++i) u2[t0 + i] = make_float2(v0[i], v1[i]);
    }
#pragma unroll 1
    for (int o = 0; o < 2; ++o) {
        const float* hf = F + ((size_t)(o * 2 + 0) * 256 + c) * L;
        const float* hbk = F + ((size_t)(o * 2 + 1) * 256 + c) * L;
        for (int k = tid; k < 2 * L; k += NTHREADS) {
            const int dd = k - (L - 1);
            taps[k] = (dd >= L) ? 0.f : (dd >= 0 ? hf[dd] : hbk[-dd]);
        }
        __syncthreads();
        float acc[TPT][2];
#pragma unroll
        for (int i = 0; i < TPT; ++i) { acc[i][0] = 0.f; acc[i][1] = 0.f; }
        if (L == 4096) {
#pragma unroll 1
            for (int s0 = 0; s0 < L; s0 += 16) {
                const int k0 = t0 - s0 + (L - 16);
                float W[32];
#pragma unroll
                for (int q = 0; q < 8; ++q) {
                    const float4 t4 = *reinterpret_cast<const float4*>(taps + k0 + q * 4);
                    W[q * 4] = t4.x; W[q * 4 + 1] = t4.y; W[q * 4 + 2] = t4.z; W[q * 4 + 3] = t4.w;
                }
#pragma unroll
                for (int j = 0; j < 16; ++j) {
                    const float2 uj = u2[s0 + j];
#pragma unroll
                    for (int i = 0; i < TPT; ++i) {
                        const float wv = W[(i - j + 15) & 31];
                        acc[i][0] += wv * uj.x; acc[i][1] += wv * uj.y;
                    }
                }
            }
        } else {
            for (int s = 0; s < L; ++s) {
                const float2 uj = u2[s];
                const float wv = taps[t0 - s + (L - 1)];
                acc[0][0] += wv * uj.x; acc[0][1] += wv * uj.y;
            }
        }
        const float sk = p.in(I_HY_SKIP)[(size_t)(l * 2 + o) * 256 + c];
        float res[TPT][2];
        {
            float g0[TPT], g1[TPT];
            sconv(o, 0, g0); sconv(o, 1, g1);
#pragma unroll
            for (int i = 0; i < TPT; ++i) {
                const float2 ut = u2[t0 + i];
                res[i][0] = g0[i] * (acc[i][0] + sk * ut.x);
                res[i][1] = g1[i] * (acc[i][1] + sk * ut.y);
            }
        }
        __syncthreads();
        if (o == 0) {
#pragma unroll
            for (int i = 0; i < TPT; ++i) u2[t0 + i] = make_float2(res[i][0], res[i][1]);
        } else {
#pragma unroll
            for (int i = 0; i < TPT; ++i) {
                cat[(size_t)(base[0] + t0 + i) * DM + 512 + c] = f2bf(res[i][0]);
                cat[(size_t)(base[1] + t0 + i) * DM + 512 + c] = f2bf(res[i][1]);
            }
        }
        __syncthreads();
    }
}


#define FFT_BS 272
__device__ __forceinline__ int fphys(int d2, int d1, int d0) { return d2 * FFT_BS + d1 * 17 + d0; }
__device__ __forceinline__ float2 cmulf(float2 a, float2 b) { return make_float2(a.x * b.x - a.y * b.y, a.x * b.y + a.y * b.x); }
__device__ static constexpr float C32T[16] = {1.000000000e+00f, 9.807852804e-01f, 9.238795325e-01f, 8.314696123e-01f, 7.071067812e-01f, 5.555702330e-01f, 3.826834324e-01f, 1.950903220e-01f, 6.123233996e-17f, -1.950903220e-01f, -3.826834324e-01f, -5.555702330e-01f, -7.071067812e-01f, -8.314696123e-01f, -9.238795325e-01f, -9.807852804e-01f};
__device__ static constexpr float S32T[16] = {0.000000000e+00f, 1.950903220e-01f, 3.826834324e-01f, 5.555702330e-01f, 7.071067812e-01f, 8.314696123e-01f, 9.238795325e-01f, 9.807852804e-01f, 1.000000000e+00f, 9.807852804e-01f, 9.238795325e-01f, 8.314696123e-01f, 7.071067812e-01f, 5.555702330e-01f, 3.826834324e-01f, 1.950903220e-01f};
template <int LOG> __device__ __forceinline__ constexpr int brev(int i) { int r = 0; for (int b = 0; b < LOG; ++b) r |= ((i >> b) & 1) << (LOG - 1 - b); return r; }
template <int R, bool INV> __device__ __forceinline__ void dftR(float2 (&v)[R]) {
    constexpr int LOG = (R == 32) ? 5 : 4;
    float2 t[R];
#pragma unroll
    for (int i = 0; i < R; ++i) t[brev<LOG>(i)] = v[i];
#pragma unroll
    for (int st = 1; st <= LOG; ++st) {
        const int len = 1 << st, half = len >> 1;
#pragma unroll
        for (int i = 0; i < R; i += len)
#pragma unroll
            for (int j = 0; j < half; ++j) {
                const int tw = j * (32 / len);
                const float2 a = t[i + j], b = t[i + j + half];
                float2 bw;
                if (tw == 0) bw = b;
                else if (tw == 8) bw = INV ? make_float2(-b.y, b.x) : make_float2(b.y, -b.x);
                else { const float wr = C32T[tw], wi = INV ? S32T[tw] : -S32T[tw]; bw = make_float2(b.x * wr - b.y * wi, b.x * wi + b.y * wr); }
                t[i + j] = make_float2(a.x + bw.x, a.y + bw.y);
                t[i + j + half] = make_float2(a.x - bw.x, a.y - bw.y);
            }
    }
#pragma unroll
    for (int i = 0; i < R; ++i) v[i] = t[i];
}
template <int R> __device__ __forceinline__ void twiddle_pow(float2 (&v)[R], float2 first, float2 base) {
    float2 w = first;
#pragma unroll
    for (int k = 0; k < R; ++k) { v[k] = cmulf(v[k], w); w = cmulf(w, base); }
}
__device__ __forceinline__ float2 cispi(float x) { float sn, cs; sincospif(x, &sn, &cs); return make_float2(cs, sn); }

__device__ __forceinline__ void fft_fwd_A_B1(float2 (&v)[32], float2* buf, int tid_in) {
    int tid = tid_in; asm volatile("" : "+v"(tid));
    const int a = tid >> 4, b = tid & 15;
    dftR<32, false>(v);
    twiddle_pow<32>(v, make_float2(1.f, 0.f), cispi(-2.f * (float)tid * (1.f / 8192.f)));
#pragma unroll
    for (int k1 = 0; k1 < 32; ++k1) buf[fphys(k1, a, b)] = v[k1];
    __syncthreads();
#pragma unroll 1
    for (int j = 0; j < 2; ++j) {
        const int g = tid + 256 * j, k1 = g >> 4, bb = g & 15;
        float2 w[16];
#pragma unroll
        for (int aa = 0; aa < 16; ++aa) w[aa] = buf[fphys(k1, aa, bb)];
        dftR<16, false>(w);
        twiddle_pow<16>(w, make_float2(1.f, 0.f), cispi(-2.f * (float)bb * (1.f / 256.f)));
#pragma unroll
        for (int ka = 0; ka < 16; ++ka) buf[fphys(k1, ka, bb)] = w[ka];
    }
    __syncthreads();
}
__device__ __forceinline__ void fft_inv_B1_A(float2 (&v)[32], float2* buf, int tid_in) {
    int tid = tid_in; asm volatile("" : "+v"(tid));
#pragma unroll 1
    for (int j = 0; j < 2; ++j) {
        const int g = tid + 256 * j, k1 = g >> 4, bb = g & 15;
        float2 w[16];
#pragma unroll
        for (int ka = 0; ka < 16; ++ka) w[ka] = buf[fphys(k1, ka, bb)];
        dftR<16, true>(w);
        twiddle_pow<16>(w, cispi(2.f * (float)(k1 * bb) * (1.f / 8192.f)), cispi(2.f * (float)k1 * (1.f / 512.f)));
#pragma unroll
        for (int aa = 0; aa < 16; ++aa) buf[fphys(k1, aa, bb)] = w[aa];
    }
    __syncthreads();
    const int a = tid >> 4, b = tid & 15;
#pragma unroll
    for (int k1 = 0; k1 < 32; ++k1) v[k1] = buf[fphys(k1, a, b)];
    dftR<32, true>(v);
}

__device__ __forceinline__ void hfft_unit(const P& p, int l, int u, char* lds) {
    const int tid = otid();
    float2* buf = (float2*)lds;
    float* F = (float*)(p.ws + WS_FILTL) + (size_t)u * 8192;
    float2 v[32];
#pragma unroll
    for (int n1 = 0; n1 < 32; ++n1) {
        const int n = 256 * n1 + tid;
        float x;
        if (n1 < 16) x = F[n];
        else x = (n == 4096) ? 0.f : F[4096 + (8192 - n)];
        if (n == 0) x += p.in(I_HY_SKIP)[(size_t)l * 512 + u];
        v[n1] = make_float2(x, 0.f);
    }
    fft_fwd_A_B1(v, buf, tid);
    __half2* H = (__half2*)F;
#pragma unroll 1
    for (int j = 0; j < 2; ++j) {
        const int g = tid + 256 * j, k1 = g >> 4, ka = g & 15;
        float2 w[16];
#pragma unroll
        for (int bb = 0; bb < 16; ++bb) w[bb] = buf[fphys(k1, ka, bb)];
        dftR<16, false>(w);
        unsigned pk[16];
#pragma unroll
        for (int kb = 0; kb < 16; ++kb) { const __half2 h = __floats2half2_rn(w[kb].x, w[kb].y); pk[kb] = *reinterpret_cast<const unsigned*>(&h); }
        uint4* dst = reinterpret_cast<uint4*>(H + (size_t)g * 16);
        dst[0] = make_uint4(pk[0], pk[1], pk[2], pk[3]); dst[1] = make_uint4(pk[4], pk[5], pk[6], pk[7]);
        dst[2] = make_uint4(pk[8], pk[9], pk[10], pk[11]); dst[3] = make_uint4(pk[12], pk[13], pk[14], pk[15]);
    }
    __syncthreads();
}

__device__ __forceinline__ void hyena_prep_unit(const P& p, int l, int u, char* lds) {
    const int tid = otid();
    bf16_t* tile = (bf16_t*)lds;
    const int b = u >> 6, t0 = (u & 63) * 64;
    const bf16_t* z = (const bf16_t*)(p.ws + WS_Z) + (size_t)(NTC + b * 4096) * ZS + COL_HY;
    bf16_t* hyT = (bf16_t*)(p.ws + WS_HYT);
    const float* cw = p.in(I_HY_CONV) + (size_t)l * 3 * 768; const float* cb = p.in(I_HY_CONVB) + (size_t)l * 768;
#pragma unroll 1
    for (int part = 0; part < 3; ++part) {
        const int ch = part * 256 + tid;
        const float w0 = cw[ch], w1 = cw[768 + ch], w2 = cw[1536 + ch], bs = cb[ch];
        const bf16_t* zc = z + ch;
        float xm = (t0 > 0) ? bf2f(zc[(size_t)(t0 - 1) * ZS]) : 0.f;
        float x0 = bf2f(zc[(size_t)t0 * ZS]);
#pragma unroll 8
        for (int i = 0; i < 64; ++i) {
            const int t = t0 + i;
            const float xp = (t + 1 < 4096) ? bf2f(zc[(size_t)(t + 1) * ZS]) : 0.f;
            tile[tid * 72 + i] = f2bf(w0 * xm + w1 * x0 + w2 * xp + bs);
            xm = x0; x0 = xp;
        }
        __syncthreads();
#pragma unroll
        for (int k = 0; k < 8; ++k) {
            const int chl = (tid >> 3) + 32 * k, seg = tid & 7;
            const uint4 val = *reinterpret_cast<const uint4*>(tile + chl * 72 + seg * 8);
            *reinterpret_cast<uint4*>(hyT + ((size_t)(b * 3 + part) * 256 + chl) * 4096 + t0 + seg * 8) = val;
        }
        __syncthreads();
    }
}

template <int O>
__device__ __forceinline__ void hyena_conv_pass(const P& p, int c, int bp, int tid, float2 (&v)[32], float2* buf) {
    const bf16_t* hyT = (const bf16_t*)(p.ws + WS_HYT);
#pragma unroll
    for (int j = 16; j < 32; ++j) v[j] = make_float2(0.f, 0.f);
    fft_fwd_A_B1(v, buf, tid);
    const __half2* H = (const __half2*)((const float*)(p.ws + WS_FILTL) + (size_t)(O * 256 + c) * 8192);
    int tm = tid; asm volatile("" : "+v"(tm));
#pragma unroll 1
    for (int j = 0; j < 2; ++j) {
        const int g = tm + 256 * j, k1 = g >> 4, ka = g & 15;
        float2 w[16];
#pragma unroll
        for (int bb = 0; bb < 16; ++bb) w[bb] = buf[fphys(k1, ka, bb)];
        dftR<16, false>(w);
        const uint4* hp = reinterpret_cast<const uint4*>(H + (size_t)g * 16);
        unsigned hk[16];
#pragma unroll
        for (int q = 0; q < 4; ++q) { const uint4 t4 = hp[q]; hk[q * 4] = t4.x; hk[q * 4 + 1] = t4.y; hk[q * 4 + 2] = t4.z; hk[q * 4 + 3] = t4.w; }
#pragma unroll
        for (int kb = 0; kb < 16; ++kb) { const float2 hf = __half22float2(*reinterpret_cast<const __half2*>(&hk[kb])); w[kb] = cmulf(w[kb], hf); }
        dftR<16, true>(w);
        twiddle_pow<16>(w, make_float2(1.f, 0.f), cispi(2.f * (float)ka * (1.f / 256.f)));
#pragma unroll
        for (int bb = 0; bb < 16; ++bb) buf[fphys(k1, ka, bb)] = w[bb];
    }
    __syncthreads();
    fft_inv_B1_A(v, buf, tid);
    asm volatile("" ::: "memory");
    int tq = tid; asm volatile("" : "+v"(tq));
    const bf16_t* g0 = hyT + ((size_t)((bp * 2 + 0) * 3 + O) * 256 + c) * 4096 + tq;
    const bf16_t* g1 = hyT + ((size_t)((bp * 2 + 1) * 3 + O) * 256 + c) * 4096 + tq;
    const float sc = 1.f / 8192.f;
#pragma unroll
    for (int j = 0; j < 16; ++j) {
        const float ga = bf2f(g0[256 * j]) * sc, gb = bf2f(g1[256 * j]) * sc;
        v[j] = make_float2(ga * v[j].x, gb * v[j].y);
    }
    __syncthreads();
}

__device__ __forceinline__ void hyena_fft_unit(const P& p, int l, int u, char* lds) {
    const int tid = otid();
    const int c = u >> 2, bp = u & 3;
    float2* buf = (float2*)lds;
    const bf16_t* hyT = (const bf16_t*)(p.ws + WS_HYT);
    bf16_t* cat = (bf16_t*)(p.ws + WS_CAT);
    float2 v[32];
    {
        const bf16_t* v0p = hyT + ((size_t)((bp * 2 + 0) * 3 + 2) * 256 + c) * 4096 + tid;
        const bf16_t* v1p = hyT + ((size_t)((bp * 2 + 1) * 3 + 2) * 256 + c) * 4096 + tid;
#pragma unroll
        for (int j = 0; j < 16; ++j) v[j] = make_float2(bf2f(v0p[256 * j]), bf2f(v1p[256 * j]));
    }
    hyena_conv_pass<0>(p, c, bp, tid, v, buf);
    hyena_conv_pass<1>(p, c, bp, tid, v, buf);
    int tq = tid; asm volatile("" : "+v"(tq));
#pragma unroll
    for (int j = 0; j < 16; ++j) {
        const int t = tq + 256 * j;
        cat[(size_t)(NTC + (bp * 2 + 0) * 4096 + t) * DM + 512 + c] = f2bf(v[j].x);
        cat[(size_t)(NTC + (bp * 2 + 1) * 4096 + t) * DM + 512 + c] = f2bf(v[j].y);
    }
}

__device__ __forceinline__ void rwkv_post_unit(const P& p, int l, int u, char* lds) {
    const int tid = otid();
    bf16_t* sgb = (bf16_t*)lds;
    float* gt = (float*)(lds + 4608);
    const bf16_t* z = (const bf16_t*)(p.ws + WS_Z);
    const bf16_t* rwp = (const bf16_t*)(p.ws + WS_R1 + R1_RWP);
    const bf16_t* ys = (const bf16_t*)(p.ws + WS_HBY);
    bf16_t* cat = (bf16_t*)(p.ws + WS_CAT);
    const int row0 = u * 32;
    {
        const int tok = tid >> 3, j0 = (tid & 7) * 8;
        float gl[8];
        unpack8(*reinterpret_cast<const uint4*>(z + (size_t)(row0 + tok) * ZS + 896 + j0), gl);
#pragma unroll
        for (int i = 0; i < 8; ++i) gl[i] = sigm(gl[i]);
        *reinterpret_cast<uint4*>(sgb + tok * 72 + j0) = pack8(gl);
    }
    __syncthreads();
    {
        const int w = tid >> 6, lane = tid & 63, fr = lane & 15, fq = lane >> 4;
        const bf16_t* g2t = (const bf16_t*)(p.ws + WS_G2T) + (size_t)l * 256 * 64;
        f32x4 acc[2][4];
#pragma unroll
        for (int mf = 0; mf < 2; ++mf)
#pragma unroll
            for (int nf = 0; nf < 4; ++nf) acc[mf][nf] = f32x4{0.f, 0.f, 0.f, 0.f};
#pragma unroll
        for (int ks = 0; ks < 2; ++ks) {
            bf16x8 af[2], bfr[4];
#pragma unroll
            for (int mf = 0; mf < 2; ++mf) af[mf] = *reinterpret_cast<const bf16x8*>(sgb + (mf * 16 + fr) * 72 + ks * 32 + fq * 8);
#pragma unroll
            for (int nf = 0; nf < 4; ++nf) bfr[nf] = *reinterpret_cast<const bf16x8*>(g2t + (size_t)(w * 64 + nf * 16 + fr) * 64 + ks * 32 + fq * 8);
#pragma unroll
            for (int mf = 0; mf < 2; ++mf)
#pragma unroll
                for (int nf = 0; nf < 4; ++nf) acc[mf][nf] = __builtin_amdgcn_mfma_f32_16x16x32_bf16(af[mf], bfr[nf], acc[mf][nf], 0, 0, 0);
        }
#pragma unroll
        for (int mf = 0; mf < 2; ++mf)
#pragma unroll
            for (int nf = 0; nf < 4; ++nf)
#pragma unroll
                for (int j = 0; j < 4; ++j) gt[(mf * 16 + fq * 4 + j) * 264 + w * 64 + nf * 16 + fr] = acc[mf][nf][j];
    }
    __syncthreads();
    {
        const int tl = tid >> 5, cg = tid & 31, c0 = cg * 8;
        float ka[8], rk[8], gng[8], gnb[8];
#pragma unroll
        for (int i = 0; i < 8; ++i) {
            ka[i] = p.in(I_RW_KA)[l * 256 + c0 + i]; rk[i] = p.in(I_RW_RK)[l * 256 + c0 + i];
            gng[i] = p.in(I_RW_GNG)[l * 256 + c0 + i]; gnb[i] = p.in(I_RW_GNB)[l * 256 + c0 + i];
        }
#pragma unroll 2
        for (int it = 0; it < 4; ++it) {
            const int tok = it * 8 + tl, row = row0 + tok;
            float ya[8], yb[8], r[8], k[8], v[8], a0[8], a1[8], o[8];
            unpack8(*reinterpret_cast<const uint4*>(ys + (size_t)row * 256 + c0), ya);
            unpack8(*reinterpret_cast<const uint4*>(ys + (size_t)NT * 256 + (size_t)row * 256 + c0), yb);
            const bf16_t* zr = z + (size_t)row * ZS + c0;
            unpack8(*reinterpret_cast<const uint4*>(zr), r);
            unpack8(*reinterpret_cast<const uint4*>(zr + 256), k);
            unpack8(*reinterpret_cast<const uint4*>(zr + 512), v);
            unpack8(*reinterpret_cast<const uint4*>(rwp + ((size_t)row * 4 + 2) * 256 + c0), a0);
            unpack8(*reinterpret_cast<const uint4*>(rwp + ((size_t)row * 4 + 3) * 256 + c0), a1);
            float sy = 0.f, sd = 0.f;
#pragma unroll
            for (int i = 0; i < 8; ++i) {
                ya[i] += yb[i]; sy += ya[i];
                const float kd = k[i] * (1.f + (a0[i] - 1.f) * ka[i]) + k[i] * (1.f + (a1[i] - 1.f) * ka[i]);
                sd += r[i] * kd * rk[i];
            }
            const float mu = sum8lanes(sy) * (1.f / 64.f);
            const float dot = sum8lanes(sd);
            float sq = 0.f;
#pragma unroll
            for (int i = 0; i < 8; ++i) { ya[i] -= mu; sq += ya[i] * ya[i]; }
            const float rs = rsqrtf(sum8lanes(sq) * (1.f / 64.f) + 64e-5f);
            const float4 g0 = *reinterpret_cast<const float4*>(gt + tok * 264 + c0), g1 = *reinterpret_cast<const float4*>(gt + tok * 264 + c0 + 4);
            const float gg[8] = {g0.x, g0.y, g0.z, g0.w, g1.x, g1.y, g1.z, g1.w};
#pragma unroll
            for (int i = 0; i < 8; ++i) o[i] = (ya[i] * rs * gng[i] + gnb[i] + dot * v[i]) * gg[i];
            *reinterpret_cast<uint4*>(cat + (size_t)row * DM + c0) = pack8(o);
        }
    }
    __syncthreads();
}

__device__ __forceinline__ void gdn_post_unit(const P& p, int l, int u) {
    const int tid = otid();
    const bf16_t* z = (const bf16_t*)(p.ws + WS_Z);
    const bf16_t* ys = (const bf16_t*)(p.ws + WS_HBY) + (size_t)2 * NT * 256;
    bf16_t* cat = (bf16_t*)(p.ws + WS_CAT);
    const int tl = tid >> 5, cg = tid & 31, c0 = cg * 8;
    float ng[8];
#pragma unroll
    for (int i = 0; i < 8; ++i) ng[i] = p.in(I_GD_NORM)[l * 64 + ((c0 + i) & 63)];
    const int row0 = u * 32;
#pragma unroll 2
    for (int it = 0; it < 4; ++it) {
        const int row = row0 + it * 8 + tl;
        const uint4 a4 = *reinterpret_cast<const uint4*>(ys + (size_t)row * 256 + c0);
        const uint4 b4 = *reinterpret_cast<const uint4*>(ys + (size_t)NT * 256 + (size_t)row * 256 + c0);
        const uint4 z4 = *reinterpret_cast<const uint4*>(z + (size_t)row * ZS + COL_GD + 768 + c0);
        float a[8], b[8], zg[8], o[8];
        unpack8(a4, a); unpack8(b4, b); unpack8(z4, zg);
        float ss = 0.f;
#pragma unroll
        for (int i = 0; i < 8; ++i) { o[i] = a[i] + b[i]; ss += o[i] * o[i]; }
        ss = sum8lanes(ss);
        const float sc = rsqrtf(ss * (1.f / 64.f) + 1e-6f);
#pragma unroll
        for (int i = 0; i < 8; ++i) o[i] = o[i] * sc * ng[i] * siluf(zg[i]);
        *reinterpret_cast<uint4*>(cat + (size_t)row * DM + 256 + c0) = pack8(o);
    }
}

__device__ __forceinline__ void load_tile_bases(unsigned* ctl, int l, int* tb) {
    const int tid = otid();
    __syncthreads();
    if (tid < 64) { const int c = (int)xb_ld(&ctl[CW_CNT(l) + tid]); tb[130 + tid] = c; tb[66 + tid] = (c + 127) >> 7; }
    __syncthreads();
    if (tid == 0) { int a = 0; for (int e = 0; e < 64; ++e) { tb[e] = a; a += tb[66 + e]; } tb[64] = a; }
    __syncthreads();
}

#define NPHASE 36
template <typename F>
__device__ __forceinline__ void strided(int n, F f) { for (int u = blockIdx.x; u < n; u += gridDim.x) f(u); }

__global__ void __launch_bounds__(NTHREADS, 2) fwd_kernel(KP kp) {
    extern __shared__ __attribute__((aligned(16))) char smem[];
    char* lds = smem + LDS_USER;
    {
    const int tid = otid();
    if (tid == 0) *reinterpret_cast<uint4*>(smem) = make_uint4(0u, 0u, 0u, 0u);
    if (tid < 52) { const unsigned long long v = (unsigned long long)kp.in[tid]; ((unsigned*)(smem + 512))[2 * tid] = (unsigned)v; ((unsigned*)(smem + 512))[2 * tid + 1] = (unsigned)(v >> 32); }
    }
    __syncthreads();
    P p; p.tab = (const __attribute__((address_space(3))) unsigned*)(smem + 512); p.out = kp.out; p.ws = kp.ws;
    unsigned* ctl = (unsigned*)(p.ws + WS_CTL);
    XcdBarrier bar = xcd_barrier_post(ctl, (volatile LAS unsigned*)smem);
    const int lo = kp.ph_lo, hi = kp.ph_hi;
#define PHASE_BEGIN(ph) if ((ph) >= lo && (ph) < hi) { if ((ph) > lo) { xcd_barrier(bar); }
#define PHASE_END }
#define LANE_IDS const int tid = otid(); const int wid = tid >> 6, lane = tid & 63, wr = wid >> 1, wc = wid & 1, fr = lane & 15, fq = lane >> 4; (void)wid; (void)lane; (void)wr; (void)wc; (void)fr; (void)fq;

    PHASE_BEGIN(0)
        strided(192 + 64 + 32 + 8, [&](int u) {
            if (u < 192) ph0_mod_unit(p, u, lds);
            else if (u < 256) ph0_s5tab_unit(p, u - 192);
            else if (u >= 288) { const int v = u - 288, ll = v >> 2, t = v & 3;
                   xpose_tile(p.in(I_RW_G2) + (size_t)ll * 64 * 256, 256, (bf16_t*)(p.ws + WS_G2T) + (size_t)ll * 256 * 64, 64, 0, 0, t, lds); }
            else { const int v = u - 256, ll = v >> 4, t = v & 15;
                   xpose_tile(p.in(I_S5_GLUW) + (size_t)ll * 65536, 256, (bf16_t*)(p.ws + WS_GLUT) + (size_t)ll * 65536, 256, 0, t >> 2, t & 3, lds); }
        });
    PHASE_END

#pragma unroll 1
    for (int l = 0; l < 2; ++l) {
        const int pb = 1 + 17 * l;
        PHASE_BEGIN(pb + 0)
            strided(4352 + 1088 + 768 + 256, [&](int u) {
                if (u < 4352) { if (l == 0) rows_unit<M_INIT>(p, l, u, lds); else rows_unit<M_LN2NEXT>(p, l, u, lds); }
                else if (u < 5440) filt_unit(p, l, u - 4352, lds);
                else if (u < 6208) { const int v = u - 5440; xpose_tile(p.in(I_WIN) + (size_t)l * 1024 * 3024, 3024, (bf16_t*)(p.ws + WS_WINT), 1024, 0, v / 48, v % 48, lds); }
                else { const int v = u - 6208; xpose_tile(p.in(I_WOUT) + (size_t)l * 1024 * 1024, 1024, (bf16_t*)(p.ws + WS_WOUTT), 1024, 0, v >> 4, v & 15, lds); }
            });
        PHASE_END
        PHASE_BEGIN(pb + 1)
            strided(272 * 24, [&](int u) {
                LANE_IDS
                const int mt = u / 24, nt = u % 24;
                f32x4 acc[4][4];
                gemm_tile((const bf16_t*)(p.ws + WS_HBY), DM, arows_lin(mt * 128, tid),
                          (const bf16_t*)(p.ws + WS_WINT), DM, nt * 128, DM, lds, acc);
                bf16_t* z = (bf16_t*)(p.ws + WS_Z);
#pragma unroll
                for (int m = 0; m < 4; ++m)
#pragma unroll
                    for (int n = 0; n < 4; ++n) {
                        const int col = nt * 128 + wc * 64 + n * 16 + fr;
                        if (col < ZS) {
#pragma unroll
                            for (int j = 0; j < 4; ++j) z[(size_t)(mt * 128 + wr * 64 + m * 16 + fq * 4 + j) * ZS + col] = f2bf(acc[m][n][j]);
                        }
                    }
            });
        PHASE_END
        PHASE_BEGIN(pb + 2)
            strided(512 + 512 + 1088 + 1088 + 4352, [&](int u) {
                if (u < 512) { if (kp.rep == 0) hfft_unit(p, l, u, lds); }
                else if (u < 1024) hyena_prep_unit(p, l, u - 512, lds);
                else if (u < 2112) rwkv_prep_unit(p, l, u - 1024, lds);
                else if (u < 3200) gdn_prep_unit(p, l, u - 2112);
                else s5_pre_unit(p, l, u - 3200, lds);
            });
        PHASE_END
        PHASE_BEGIN(pb + 3)
            {
                int* qslot = (int*)(smem + 64);
                const int NO = 1024 + 544 + 1024;
                if (otid() == 0) {
                    const unsigned hw = (unsigned)__builtin_amdgcn_s_getreg((7 << 11) | (8 << 6) | 4);
                    const unsigned cuix = ((xb_xcc_id() & 15u) << 8) | (hw & 255u);
                    qslot[1] = (atomicAdd(&ctl[CW_CUCNT(l) + cuix], 1u) % 2u == 0u) ? 0 : 1;
                }
                __syncthreads();
                for (;;) {
                    if (otid() == 0) {
                        int stage = qslot[1], t = -1;
                        while (t < 0 && stage < 3) {
                            if (stage == 1) { const int q = (int)atomicAdd(&ctl[CW_QUEUE(l) + 16 + kp.rep], 1u); if (q < NO) t = 256 + (q < 544 ? 1024 + q : (q < 1568 ? q - 544 : q)); else stage = 2; }
                            else { const int q = (int)atomicAdd(&ctl[CW_QUEUE(l) + kp.rep], 1u); if (q < 256) t = q; else stage = (stage == 0) ? 1 : 3; }
                        }
                        qslot[1] = stage; qslot[0] = t;
                    }
                    __syncthreads();
                    const int u = qslot[0];
                    __syncthreads();
                    if (u < 0) break;
                    if (u < 256) { if (kp.rep != 2) scan_unit(p, l, u, lds); }
                    else if (kp.rep == 1) {}
                    else if (u < 1280) hyena_fft_unit(p, l, u - 256, lds);
                    else if (u < 1824) s5_main_unit(p, l, u - 1280, lds);
                    else hyena_unit<256>(p, l, u - 1824, lds);
                    __syncthreads();
                }
            }
        PHASE_END
        PHASE_BEGIN(pb + 4)
            strided(1088 + 1088 + 544, [&](int u) {
                if (u < 1088) rwkv_post_unit(p, l, u, lds);
                else if (u < 2176) gdn_post_unit(p, l, u - 1088);
                else {
                    LANE_IDS
                    const int v = u - 2176, mt = v >> 1, nt = v & 1;
                    f32x4 acc[4][4];
                    const bf16_t* A = (const bf16_t*)(p.ws + WS_S5G);
                    gemm_tile(A, 256, arows_lin(mt * 128, tid),
                              (const bf16_t*)(p.ws + WS_GLUT) + (size_t)l * 65536, 256, nt * 128, 256, lds, acc);
                    bf16_t* cat = (bf16_t*)(p.ws + WS_CAT);
#pragma unroll
                    for (int m = 0; m < 4; ++m)
#pragma unroll
                        for (int n = 0; n < 4; ++n) {
                            const int col = nt * 128 + wc * 64 + n * 16 + fr;
                            const float gb = p.in(I_S5_GLUB)[l * 256 + col];
#pragma unroll
                            for (int j = 0; j < 4; ++j) {
                                const int row = mt * 128 + wr * 64 + m * 16 + fq * 4 + j;
                                const float yg = bf2f(A[(size_t)row * 256 + col]);
                                cat[(size_t)row * DM + 768 + col] = f2bf(yg * sigm(acc[m][n][j] + gb));
                            }
                        }
                }
            });
        PHASE_END
        PHASE_BEGIN(pb + 5)
            strided(272 * 8 + 65 * 192, [&](int u) {
                if (u < 2176) {
                    LANE_IDS
                    const int mt = u >> 3, nt = u & 7;
                    f32x4 acc[4][4];
                    gemm_tile((const bf16_t*)(p.ws + WS_CAT), DM, arows_lin(mt * 128, tid),
                              (const bf16_t*)(p.ws + WS_WOUTT), DM, nt * 128, DM, lds, acc);
#pragma unroll
                    for (int m = 0; m < 4; ++m)
#pragma unroll
                        for (int j = 0; j < 4; ++j) {
                            const int row = mt * 128 + wr * 64 + m * 16 + fq * 4 + j;
                            float* xr = xrow(p, row);
                            const float* ga = modp(p, l, row_mod(row), 2);
#pragma unroll
                            for (int n = 0; n < 4; ++n) {
                                const int col = nt * 128 + wc * 64 + n * 16 + fr;
                                { const float ca = kp.rep ? 1.f : ALPHA, cb2 = kp.rep ? 0.f : 1.f; xr[col] = ca * xr[col] + cb2 * ga[col] * acc[m][n][j]; }
                            }
                        }
                } else {
                    const int v = u - 2176, e = v / 192, t = v % 192, which = t >> 6, tt = t & 63;
                    bf16_t* W13 = (bf16_t*)(p.ws + WS_R1 + R1_W13T) + (size_t)e * 512 * 1024;
                    bf16_t* W2 = (bf16_t*)(p.ws + WS_R1 + R1_W2T) + (size_t)e * 1024 * 256;
                    if (which == 0) {
                        const float* src = (e < 64) ? p.in(I_EX_W1) + ((size_t)l * 64 + e) * 262144 : p.in(I_SH_W1) + (size_t)l * 262144;
                        xpose_tile(src, 256, W13, 1024, 1, tt >> 2, tt & 3, lds);
                    } else if (which == 1) {
                        const float* src = (e < 64) ? p.in(I_EX_W3) + ((size_t)l * 64 + e) * 262144 : p.in(I_SH_W3) + (size_t)l * 262144;
                        xpose_tile(src, 256, W13, 1024, 2, tt >> 2, tt & 3, lds);
                    } else {
                        const float* src = (e < 64) ? p.in(I_EX_W2) + ((size_t)l * 64 + e) * 262144 : p.in(I_SH_W2) + (size_t)l * 262144;
                        xpose_tile(src, 1024, W2, 256, 0, tt >> 4, tt & 15, lds);
                    }
                }
            });
        PHASE_END
        PHASE_BEGIN(pb + 6)
            strided(4352, [&](int u) { rows_unit<M_LN1>(p, l, u, lds, kp.rep > 0); __syncthreads(); });
        PHASE_END
        PHASE_BEGIN(pb + 8)
            {
                int* tbs = (int*)(smem + 1024);
                load_tile_bases(ctl, l, tbs);
                const int ntr = tbs[64];
                const int* rtok = (const int*)(p.ws + WS_RTOK);
                strided((ntr + 272) * 4, [&](int u) {
                    LANE_IDS
                    const int tile = u >> 2, jn = u & 3;
                    int e, obase; ARows ar;
                    if (tile < ntr) {
                        e = 0;
#pragma unroll 1
                        for (int s2 = 32; s2 >= 1; s2 >>= 1) if (tbs[e + s2] <= tile) e += s2;
                        obase = tile * 128;
                        const int pos0 = (tile - tbs[e]) * 128, ce = tbs[130 + e];
#pragma unroll
                        for (int i = 0; i < 4; ++i) { const int ps = pos0 + (tid >> 3) + 32 * i; ar.r[i] = (ps < ce) ? rtok[(size_t)e * NT + ps] : 0; }
                    } else {
                        const int stt = tile - ntr; e = 64; obase = (SH_TILE_BASE + stt) * 128;
                        ar = arows_lin(stt * 128, tid);
                    }
                    f32x4 acc[4][4];
                    gemm_tile((const bf16_t*)(p.ws + WS_HBY), DM, ar,
                              (const bf16_t*)(p.ws + WS_R1 + R1_W13T) + (size_t)e * 512 * 1024, DM, jn * 128, DM, lds, acc);
                    bf16_t* act = (bf16_t*)(p.ws + WS_ACT);
#pragma unroll
                    for (int m = 0; m < 4; ++m)
#pragma unroll
                        for (int pp = 0; pp < 2; ++pp)
#pragma unroll
                            for (int j = 0; j < 4; ++j) {
                                const float g = acc[m][2 * pp][j], uu = acc[m][2 * pp + 1][j];
                                const int orow = obase + wr * 64 + m * 16 + fq * 4 + j;
                                const int col = jn * 64 + wc * 32 + pp * 16 + fr;
                                act[(size_t)orow * 256 + col] = f2bf(siluf(g) * uu);
                            }
                });
            }
        PHASE_END
#pragma unroll 1
        for (int sl = 0; sl < 4; ++sl) {
            PHASE_BEGIN(pb + 9 + 2 * sl)
            {
                int* tbs = (int*)(smem + 1024);
                load_tile_bases(ctl, l, tbs);
                const int ntr = tbs[64];
                strided((ntr + 272) * 2, [&](int u) {
                    LANE_IDS
                    const int tile = u >> 1, nt2 = u & 1;
                    int e, obase;
                    if (tile < ntr) {
                        e = 0;
#pragma unroll 1
                        for (int s2 = 32; s2 >= 1; s2 >>= 1) if (tbs[e + s2] <= tile) e += s2;
                        obase = tile * 128;
                    }
                    else { e = 64; obase = (SH_TILE_BASE + tile - ntr) * 128; }
                    f32x4 acc[4][4];
                    gemm_tile((const bf16_t*)(p.ws + WS_ACT), 256, arows_lin(obase, tid),
                              (const bf16_t*)(p.ws + WS_R1 + R1_W2T) + (size_t)e * 1024 * 256, 256, sl * 256 + nt2 * 128, 256, lds, acc);
                    bf16_t* y2 = (bf16_t*)(p.ws + WS_Y2);
#pragma unroll
                    for (int m = 0; m < 4; ++m)
#pragma unroll
                        for (int j = 0; j < 4; ++j) {
                            const int orow = obase + wr * 64 + m * 16 + fq * 4 + j;
#pragma unroll
                            for (int n = 0; n < 4; ++n) y2[(size_t)orow * 256 + nt2 * 128 + wc * 64 + n * 16 + fr] = f2bf(acc[m][n][j]);
                        }
                });
            }
            PHASE_END
            PHASE_BEGIN(pb + 10 + 2 * sl)
            {
                int* tb = (int*)lds;
                const int tid = otid();
                const unsigned* cnt = ctl + CW_CNT(l);
                load_tile_bases(ctl, l, tb);
                const int* aep = (const int*)(p.ws + WS_AEP); const float* aw = (const float*)(p.ws + WS_AW);
                const bf16_t* y2 = (const bf16_t*)(p.ws + WS_Y2);
                const int tl = tid >> 5, cg = tid & 31;
                for (int grp = blockIdx.x; grp < NT / 8; grp += gridDim.x) {
                    const int tok = grp * 8 + tl;
                    float a8[8];
                    {
                        const uint4 sv = *reinterpret_cast<const uint4*>(y2 + ((size_t)(SH_TILE_BASE * 128 + tok)) * 256 + cg * 8);
                        a8[0] = bflo(sv.x); a8[1] = bfhi(sv.x); a8[2] = bflo(sv.y); a8[3] = bfhi(sv.y);
                        a8[4] = bflo(sv.z); a8[5] = bfhi(sv.z); a8[6] = bflo(sv.w); a8[7] = bfhi(sv.w);
                    }
#pragma unroll
                    for (int k = 0; k < 8; ++k) {
                        const unsigned v = (unsigned)aep[(size_t)tok * 8 + k];
                        const float wk = aw[(size_t)tok * 8 + k];
                        const int dest = tb[v >> 24] * 128 + (int)(v & 0xFFFFFFu);
                        const uint4 yv = *reinterpret_cast<const uint4*>(y2 + (size_t)dest * 256 + cg * 8);
                        a8[0] += wk * bflo(yv.x); a8[1] += wk * bfhi(yv.x); a8[2] += wk * bflo(yv.y); a8[3] += wk * bfhi(yv.y);
                        a8[4] += wk * bflo(yv.z); a8[5] += wk * bfhi(yv.z); a8[6] += wk * bflo(yv.w); a8[7] += wk * bfhi(yv.w);
                    }
                    float* xr = xrow(p, tok) + sl * 256 + cg * 8;
                    const float* ga = modp(p, l, row_mod(tok), 5) + sl * 256 + cg * 8;
                    float4 x0 = *reinterpret_cast<const float4*>(xr), x1 = *reinterpret_cast<const float4*>(xr + 4);
                    const float4 g0 = *reinterpret_cast<const float4*>(ga), g1 = *reinterpret_cast<const float4*>(ga + 4);
                    const float rs = kp.rep ? 0.f : 1.f;
                    x0.x += rs * g0.x * a8[0]; x0.y += rs * g0.y * a8[1]; x0.z += rs * g0.z * a8[2]; x0.w += rs * g0.w * a8[3];
                    x1.x += rs * g1.x * a8[4]; x1.y += rs * g1.y * a8[5]; x1.z += rs * g1.z * a8[6]; x1.w += rs * g1.w * a8[7];
                    *reinterpret_cast<float4*>(xr) = x0; *reinterpret_cast<float4*>(xr + 4) = x1;
                }
                __syncthreads();
            }
            PHASE_END
        }
    }
#if defined(PROBE_PH)
    if (lo >= 100) {
        float a0 = (float)otid(), a1 = a0 + 1.f, a2 = a0 + 2.f, a3 = a0 + 3.f, a4 = a0 + 4.f, a5 = a0 + 5.f, a6 = a0 + 6.f, a7 = a0 + 7.f;
        const float m = 0.999f, c = 0.5f;
        for (int it = 0; it < 10000; ++it) {
            if (lo == 100) {
#pragma unroll
                for (int q = 0; q < 64; ++q) asm volatile("v_fma_f32 %0, %0, %1, %2" : "+v"(a0) : "v"(m), "v"(c));
            } else {
#pragma unroll
                for (int q = 0; q < 8; ++q) {
                    asm volatile("v_fma_f32 %0, %0, %1, %2" : "+v"(a0) : "v"(m), "v"(c)); asm volatile("v_fma_f32 %0, %0, %1, %2" : "+v"(a1) : "v"(m), "v"(c));
                    asm volatile("v_fma_f32 %0, %0, %1, %2" : "+v"(a2) : "v"(m), "v"(c)); asm volatile("v_fma_f32 %0, %0, %1, %2" : "+v"(a3) : "v"(m), "v"(c));
                    asm volatile("v_fma_f32 %0, %0, %1, %2" : "+v"(a4) : "v"(m), "v"(c)); asm volatile("v_fma_f32 %0, %0, %1, %2" : "+v"(a5) : "v"(m), "v"(c));
                    asm volatile("v_fma_f32 %0, %0, %1, %2" : "+v"(a6) : "v"(m), "v"(c)); asm volatile("v_fma_f32 %0, %0, %1, %2" : "+v"(a7) : "v"(m), "v"(c));
                }
            }
        }
        if (a0 + a1 + a2 + a3 + a4 + a5 + a6 + a7 == 12345.678f) ctl[60] = 1u;
    }
#endif
    PHASE_BEGIN(35)
        strided(4352, [&](int u) { rows_unit<M_FINAL>(p, 1, u, lds); });
    PHASE_END
}

#ifndef N_LAUNCH_MODE
#define N_LAUNCH_MODE 1
#endif
extern "C" void kernel_launch(void* const* d_in, const int* in_sizes, int n_in, void* d_out, int out_size, void* d_ws, size_t ws_size, hipStream_t stream) {
    static int grid = 0;
    if (grid == 0) {
        if (n_in != 52 || out_size != NTL * DM || ws_size < WS_END) { fprintf(stderr, "kernel_launch: unexpected shapes (n_in %d out %d ws %zu need %zu)\n", n_in, out_size, ws_size, (size_t)WS_END); grid = -1; return; }
        int dev = 0, cus = 0, per_cu = 0;
        hipGetDevice(&dev);
        hipDeviceGetAttribute(&cus, hipDeviceAttributeMultiprocessorCount, dev);
        hipFuncSetAttribute((const void*)fwd_kernel, hipFuncAttributeMaxDynamicSharedMemorySize, LDS_BYTES);
        hipOccupancyMaxActiveBlocksPerMultiprocessor(&per_cu, (const void*)fwd_kernel, NTHREADS, LDS_BYTES);
        (void)hipGetLastError();
        if (per_cu < 1) per_cu = 1;
        if (per_cu > 2) per_cu = 2;
        grid = cus * per_cu;
    }
    if (grid < 0) return;
    hipMemsetAsync((char*)d_ws + WS_CTL, 0, CTL_BYTES, stream);
    KP p{};
    for (int i = 0; i < 52; ++i) p.in[i] = (const float*)d_in[i];
    p.out = (float*)d_out; p.ws = (char*)d_ws;
#if defined(PROBE_PH)
    for (int ph = 0; ph < NPHASE; ++ph) {
        const int reps = (ph == PROBE_PH) ? 1 + PROBE_N : 1;
        for (int r = 0; r < reps; ++r) { p.ph_lo = ph; p.ph_hi = ph + 1; p.rep = r; hipLaunchKernelGGL(fwd_kernel, dim3(grid), dim3(NTHREADS), LDS_BYTES, stream, p); }
    }
    if (PROBE_PH >= 100) { p.ph_lo = PROBE_PH; p.ph_hi = PROBE_PH + 1; p.rep = 0; hipLaunchKernelGGL(fwd_kernel, dim3(PROBE_N), dim3(NTHREADS), LDS_BYTES, stream, p); }
#elif N_LAUNCH_MODE == 1
    p.ph_lo = 0; p.ph_hi = NPHASE;
    hipLaunchKernelGGL(fwd_kernel, dim3(grid), dim3(NTHREADS), LDS_BYTES, stream, p);
#else
    for (int ph = 0; ph < NPHASE; ++ph) {
        p.ph_lo = ph; p.ph_hi = ph + 1;
        hipLaunchKernelGGL(fwd_kernel, dim3(grid), dim3(NTHREADS), LDS_BYTES, stream, p);
    }
#endif
}
```

```cpp
#include <hip/hip_runtime.h>
#include <hip/hip_bf16.h>
#include <hip/hip_fp16.h>
#include <stdint.h>
#include <stdio.h>

typedef unsigned short bf16_t;
using bf16x8 = __attribute__((ext_vector_type(8))) short;
using f32x4 = __attribute__((ext_vector_type(4))) float;
using f32x2 = __attribute__((ext_vector_type(2))) float;

#define NTC 2048
#define NTL 32768
#define NT 34816
#define DM 1024
#define ZS 3024
#define COL_GD 960
#define COL_HY 2000
#define COL_S5 2768
#define NCHUNK 68
#define ALPHA 1.41421356237f
#define NTHREADS 256
#define LDS_BYTES 73728
#define LDS_USER 2048
#define SH_TILE_BASE 2240
#define ACT_ROWS ((SH_TILE_BASE + 272) * 128)

constexpr size_t al256(size_t x) { return (x + 255) & ~(size_t)255; }
constexpr size_t WS_CTL = 0;
constexpr size_t CTL_BYTES = 65536;
constexpr size_t WS_MOD = WS_CTL + CTL_BYTES;
constexpr size_t WS_S5A = al256(WS_MOD + 2 * 9 * 6144 * 4);
constexpr size_t WS_S5B = al256(WS_S5A + 2 * 2 * 16 * 64 * 4 * 4);
constexpr size_t WS_GLUT = al256(WS_S5B + 2 * 2 * 16 * 64 * 32 * 4);
constexpr size_t WS_G2T = al256(WS_GLUT + 2 * 256 * 256 * 2);
constexpr size_t WS_LW2T = al256(WS_G2T + 2 * 256 * 64 * 2);
constexpr size_t WS_LA2T = al256(WS_LW2T + 2 * 256 * 64 * 2);
constexpr size_t WS_WINT = al256(WS_LA2T + 2 * 256 * 64 * 2);
constexpr size_t WS_WOUTT = al256(WS_WINT + (size_t)3072 * 1024 * 2);
constexpr size_t WS_FILTL = al256(WS_WOUTT + (size_t)1024 * 1024 * 2);
constexpr size_t WS_FILTC = al256(WS_FILTL + (size_t)4 * 256 * 4096 * 4);
constexpr size_t WS_XC = al256(WS_FILTC + (size_t)4 * 256 * 256 * 4);
constexpr size_t WS_HBY = al256(WS_XC + (size_t)NTC * DM * 4);
constexpr size_t WS_CAT = al256(WS_HBY + (size_t)NT * DM * 2);
constexpr size_t WS_Z = al256(WS_CAT + (size_t)NT * DM * 2);
constexpr size_t WS_R1 = al256(WS_Z + (size_t)NT * ZS * 2);
constexpr size_t R1_RWP = 0;
constexpr size_t R1_GQ = (size_t)NT * 1024 * 2;
constexpr size_t R1_W13T = 0;
constexpr size_t R1_W2T = (size_t)65 * 512 * 1024 * 2;
constexpr size_t R1_BYTES = (size_t)NT * 1024 * 2 + (size_t)NT * 768 * 2;
constexpr size_t WS_KNORM = al256(WS_R1 + R1_BYTES);
constexpr size_t WS_GAB = al256(WS_KNORM + (size_t)NT * 4 * 4);
constexpr size_t WS_S5ST = al256(WS_GAB + (size_t)NT * 16 * 4);
constexpr size_t WS_AEP = al256(WS_S5ST + (size_t)8 * 68 * 2 * 16 * 64 * 2 * 4);
constexpr size_t WS_AW = al256(WS_AEP + (size_t)NT * 8 * 4);
constexpr size_t WS_RTOK = al256(WS_AW + (size_t)NT * 8 * 4);
constexpr size_t WS_HYT = al256(WS_RTOK + (size_t)64 * NT * 4);
constexpr size_t WS_S5G = al256(WS_HYT + (size_t)8 * 768 * 4096 * 2);
constexpr size_t WS_END = al256(WS_S5G + (size_t)NT * 256 * 2);
static_assert(R1_W2T + (size_t)65 * 1024 * 256 * 2 <= R1_BYTES, "expert weights must fit R1");
constexpr size_t ACT_BYTES = (size_t)ACT_ROWS * 256 * 2;
constexpr size_t WS_ACT = WS_Z + ((((size_t)NT * ZS * 2 - ACT_BYTES) >> 8) << 8);
constexpr size_t WS_Y2 = WS_HBY;
static_assert(WS_Y2 + ACT_BYTES <= WS_ACT, "y2 must not reach act");

#define CW_QUEUE(l) (4096 + 64 * (l))
#define CW_CNT(l) (4352 + 64 * (l))
#define CW_CUCNT(l) (8192 + 4096 * (l))

#define XB_TMO      128
#define XB_XCNT(j)  (256  + 64 * (j))
#define XB_XSUB(j)  (1280 + 64 * (j))
#define XB_XGEN(j)  (2304 + 64 * (j))
#define XB_TOP      3328
#define XB_TOPGEN   3392
#define XCD_BAR_WORDS 3456
#define XB_SPIN_CAP (1u << 18)
#define LAS __attribute__((address_space(3)))

__device__ __forceinline__ unsigned xb_ld(unsigned* p)              { return __hip_atomic_load(p, __ATOMIC_RELAXED, __HIP_MEMORY_SCOPE_AGENT); }
__device__ __forceinline__ unsigned xb_add(unsigned* p, unsigned v) { return __hip_atomic_fetch_add(p, v, __ATOMIC_RELAXED, __HIP_MEMORY_SCOPE_AGENT); }
__device__ __forceinline__ unsigned xb_xcc_id() { return (unsigned)__builtin_amdgcn_s_getreg((3 << 11) | 20) & 0xFu; }
#define XB_SPIN(cond, bar) do { unsigned _sp = 0; while (cond) { __builtin_amdgcn_s_sleep(1); \
    if ((++_sp & 255u) == 0u) { if (xb_ld(&(bar)[XB_TMO])) break; if (_sp > XB_SPIN_CAP) { atomicAdd(&(bar)[XB_TMO], 1u); break; } } } } while (0)

struct XcdBarrier {
    unsigned* bar; unsigned x;
    volatile LAS unsigned* st;
};
__device__ __forceinline__ XcdBarrier xcd_barrier_post(unsigned* bar, volatile LAS unsigned* st) {
    XcdBarrier b; b.bar = bar; b.x = xb_xcc_id(); b.st = st;
    if (threadIdx.x == 0) (void)xb_add(&bar[XB_XCNT(b.x)], 1u);
    return b;
}
__device__ __forceinline__ void xcd_barrier_complete(unsigned* bar, unsigned x, unsigned& nloc, unsigned& nx) {
    const unsigned G = gridDim.x * gridDim.y * gridDim.z;
    unsigned sum, cnt, mine, sp = 0u;
    for (;;) {
        sum = 0u; cnt = 0u; mine = 0u;
#pragma unroll
        for (unsigned j = 0; j < 16; ++j) { const unsigned c = xb_ld(&bar[XB_XCNT(j)]); sum += c; cnt += (c > 0u) ? 1u : 0u; mine = (j == x) ? c : mine; }
        if (sum == G) break;
        __builtin_amdgcn_s_sleep(1);
        if ((++sp & 255u) == 0u) { if (xb_ld(&bar[XB_TMO])) break; if (sp > XB_SPIN_CAP) { atomicAdd(&bar[XB_TMO], 1u); break; } }
    }
    nloc = mine > 0u ? mine : 1u; nx = cnt > 0u ? cnt : 1u;
}
__device__ __forceinline__ void xcd_barrier(const XcdBarrier& b) {
    asm volatile("s_waitcnt vmcnt(0)" ::: "memory");
    __syncthreads();
    if (threadIdx.x == 0) {
        unsigned* bar = b.bar;
        __builtin_amdgcn_s_waitcnt(0);
        unsigned nloc = b.st[0], nx = b.st[1];
        if (nloc == 0u) { xcd_barrier_complete(bar, b.x, nloc, nx); b.st[0] = nloc; b.st[1] = nx; }
        const unsigned old = xb_add(&bar[XB_XSUB(b.x)], 1u);
        const unsigned gen = old / nloc;
        if (old + 1u == (gen + 1u) * nloc) {
            __builtin_amdgcn_fence(__ATOMIC_RELEASE, "agent");
            asm volatile("s_waitcnt vmcnt(0)" ::: "memory");
            const unsigned og = xb_add(&bar[XB_TOP], 1u);
            const unsigned tg = og / nx;
            if (og + 1u == (tg + 1u) * nx) xb_add(&bar[XB_TOPGEN], 1u);
            else XB_SPIN(xb_ld(&bar[XB_TOPGEN]) == tg, bar);
            __builtin_amdgcn_fence(__ATOMIC_ACQUIRE, "agent");
            xb_add(&bar[XB_XGEN(b.x)], 1u);
            asm volatile("s_waitcnt vmcnt(0)" ::: "memory");
        } else {
            XB_SPIN(xb_ld(&bar[XB_XGEN(b.x)]) == gen, bar);
            __builtin_amdgcn_fence(__ATOMIC_ACQUIRE, "agent");
            asm volatile("s_waitcnt vmcnt(0)" ::: "memory");
        }
    }
    __syncthreads();
}

struct KP {
    const float* in[52];
    float* out;
    char* ws;
    int ph_lo, ph_hi, rep, pad_;
};
struct P {
    const __attribute__((address_space(3))) unsigned* tab;
    float* out;
    char* ws;
    __device__ __forceinline__ const float* in(int i) const {
        const unsigned lo = __builtin_amdgcn_readfirstlane(tab[2 * i]);
        const unsigned hi = __builtin_amdgcn_readfirstlane(tab[2 * i + 1]);
        return (const float*)(((unsigned long long)hi << 32) | (unsigned long long)lo);
    }
};
enum { I_X = 0, I_C, I_CTX, I_CCTX, I_ADAW, I_ADAB, I_WIN, I_WOUT, I_LNG, I_LNB,
       I_RW_W0, I_RW_W2, I_RW_A0, I_RW_A2, I_RW_G2, I_RW_KK, I_RW_KA, I_RW_RK, I_RW_GNG, I_RW_GNB,
       I_GD_CONV, I_GD_ALOG, I_GD_DTB, I_GD_NORM,
       I_HY_CONV, I_HY_CONVB, I_HY_W1, I_HY_B1, I_HY_F1, I_HY_W2, I_HY_B2, I_HY_F2, I_HY_W3, I_HY_SKIP,
       I_S5_LRE, I_S5_LIM, I_S5_LOGSTEP, I_S5_BRE, I_S5_BIM, I_S5_CRE, I_S5_CIM, I_S5_D, I_S5_GLUW, I_S5_GLUB,
       I_ROUTER_W, I_ROUTER_B, I_EX_W1, I_EX_W3, I_EX_W2, I_SH_W1, I_SH_W3, I_SH_W2 };

__device__ __forceinline__ bf16_t f2bf(float f) { unsigned u = __float_as_uint(f); u += 0x7fffu + ((u >> 16) & 1u); return (bf16_t)(u >> 16); }
__device__ __forceinline__ float bf2f(bf16_t h) { return __uint_as_float(((unsigned)h) << 16); }
__device__ __forceinline__ float bflo(unsigned u) { return __uint_as_float(u << 16); }
__device__ __forceinline__ float bfhi(unsigned u) { return __uint_as_float(u & 0xffff0000u); }
__device__ __forceinline__ unsigned pack2(float a, float b) { return (unsigned)f2bf(a) | ((unsigned)f2bf(b) << 16); }
__device__ __forceinline__ float sigm(float x) { return 1.f / (1.f + __expf(-x)); }
__device__ __forceinline__ float siluf(float x) { return x / (1.f + __expf(-x)); }
__device__ __forceinline__ float softplusf(float x) { return fmaxf(x, 0.f) + log1pf(__expf(-fabsf(x))); }
template <int CTRL> __device__ __forceinline__ float dppf(float v) {
    return __int_as_float(__builtin_amdgcn_update_dpp(0, __float_as_int(v), CTRL, 0xF, 0xF, true));
}
__device__ __forceinline__ float wave_sum(float v) {
    v += dppf<0xB1>(v); v += dppf<0x4E>(v); v += dppf<0x141>(v); v += dppf<0x140>(v);
    const int iv = __float_as_int(v);
    const float r0 = __int_as_float(__builtin_amdgcn_readlane(iv, 0)), r1 = __int_as_float(__builtin_amdgcn_readlane(iv, 16));
    const float r2 = __int_as_float(__builtin_amdgcn_readlane(iv, 32)), r3 = __int_as_float(__builtin_amdgcn_readlane(iv, 48));
    return (r0 + r1) + (r2 + r3);
}

__device__ __forceinline__ void unpack8(const uint4& v, float (&o)[8]) {
    o[0] = bflo(v.x); o[1] = bfhi(v.x); o[2] = bflo(v.y); o[3] = bfhi(v.y); o[4] = bflo(v.z); o[5] = bfhi(v.z); o[6] = bflo(v.w); o[7] = bfhi(v.w);
}
__device__ __forceinline__ uint4 pack8(const float (&o)[8]) { return make_uint4(pack2(o[0], o[1]), pack2(o[2], o[3]), pack2(o[4], o[5]), pack2(o[6], o[7])); }
__device__ __forceinline__ float sum8lanes(float v) { v += dppf<0xB1>(v); v += dppf<0x4E>(v); v += dppf<0x141>(v); return v; }
__device__ __forceinline__ int otid() { int t = threadIdx.x; asm volatile("" : "+v"(t)); return t; }
__device__ __forceinline__ float* xrow(const P& p, int row) {
    return row < NTC ? (float*)(p.ws + WS_XC) + (size_t)row * DM : p.out + (size_t)(row - NTC) * DM;
}
__device__ __forceinline__ int row_mod(int row) { return row < NTC ? 8 : ((row - NTC) >> 12); }
__device__ __forceinline__ const float* modp(const P& p, int l, int r, int chunk) {
    return (const float*)(p.ws + WS_MOD) + ((size_t)(l * 9 + r) * 6144 + chunk * 1024);
}

struct ARows { int r[4]; };
__device__ __forceinline__ ARows arows_lin(int base, int tid) { ARows a; a.r[0] = base + (tid >> 3); a.r[1] = a.r[0] + 32; a.r[2] = a.r[0] + 64; a.r[3] = a.r[0] + 96; return a; }
__device__ __forceinline__ void gemm_tile(const bf16_t* __restrict__ A, int lda, const ARows& ar,
                                          const bf16_t* __restrict__ Bt, int ldb, int brow0, int K,
                                          char* lds, f32x4 (&acc)[4][4]) {
    const int tid = otid();
    const int wid = tid >> 6, lane = tid & 63, wr = wid >> 1, wc = wid & 1, fr = lane & 15, fq = lane >> 4;
    const int gc = ((tid & 7) ^ ((tid >> 3) & 7)) * 8;
    const bf16_t* ap[4]; const bf16_t* bp[4];
#pragma unroll
    for (int i = 0; i < 4; ++i) {
        ap[i] = A + (size_t)ar.r[i] * lda + gc;
        bp[i] = Bt + (size_t)(brow0 + (tid >> 3) + 32 * i) * ldb + gc;
    }
#pragma unroll
    for (int m = 0; m < 4; ++m)
#pragma unroll
        for (int n = 0; n < 4; ++n) acc[m][n] = f32x4{0.f, 0.f, 0.f, 0.f};
    const int nk = K >> 6;
    auto stage = [&](int t, int buf) {
        char* SA = lds + buf * 32768; char* SB = SA + 16384;
        const int ko = t * 64;
#pragma unroll
        for (int i = 0; i < 4; ++i) {
            __builtin_amdgcn_global_load_lds((const void*)(ap[i] + ko), (LAS void*)(SA + tid * 16 + i * 4096), 16, 0, 0);
            __builtin_amdgcn_global_load_lds((const void*)(bp[i] + ko), (LAS void*)(SB + tid * 16 + i * 4096), 16, 0, 0);
        }
    };
    stage(0, 0);
    asm volatile("s_waitcnt vmcnt(0)" ::: "memory");
    __syncthreads();
    const int sw = fr & 7;
    for (int t = 0; t < nk; ++t) {
        const int buf = t & 1;
        if (t + 1 < nk) stage(t + 1, buf ^ 1);
        const char* SA = lds + buf * 32768; const char* SB = SA + 16384;
#pragma unroll
        for (int ks = 0; ks < 2; ++ks) {
            const int co = ((ks * 4 + fq) ^ sw) * 16;
            bf16x8 af[4], bfr[4];
#pragma unroll
            for (int m = 0; m < 4; ++m) af[m] = *reinterpret_cast<const bf16x8*>(SA + (wr * 64 + m * 16 + fr) * 128 + co);
#pragma unroll
            for (int n = 0; n < 4; ++n) bfr[n] = *reinterpret_cast<const bf16x8*>(SB + (wc * 64 + n * 16 + fr) * 128 + co);
#pragma unroll
            for (int m = 0; m < 4; ++m)
#pragma unroll
                for (int n = 0; n < 4; ++n) acc[m][n] = __builtin_amdgcn_mfma_f32_16x16x32_bf16(af[m], bfr[n], acc[m][n], 0, 0, 0);
        }
        asm volatile("s_waitcnt vmcnt(0)" ::: "memory");
        __syncthreads();
    }
}

__device__ __forceinline__ void ph0_mod_unit(const P& p, int u, char* lds) {
    const int l = u / 96, cg = u % 96, tid = otid();
    float* s = (float*)lds;
    float* red = s + 9 * 1024;
    const float* c = p.in(I_C); const float* cctx = p.in(I_CCTX);
    for (int i = tid; i < 9 * 1024; i += NTHREADS) { int r = i >> 10, k = i & 1023; float v = r < 8 ? c[r * 1024 + k] : cctx[k]; s[i] = v / (1.f + expf(-v)); }
    __syncthreads();
    const int kq = tid >> 6, j = tid & 63, col = cg * 64 + j;
    const float* w = p.in(I_ADAW) + (size_t)l * 1024 * 6144 + col;
    float acc[9];
#pragma unroll
    for (int r = 0; r < 9; ++r) acc[r] = 0.f;
#pragma unroll 4
    for (int k = kq * 256; k < kq * 256 + 256; ++k) {
        const float wv = w[(size_t)k * 6144];
#pragma unroll
        for (int r = 0; r < 9; ++r) acc[r] += s[r * 1024 + k] * wv;
    }
#pragma unroll
    for (int r = 0; r < 9; ++r) red[(kq * 9 + r) * 64 + j] = acc[r];
    __syncthreads();
    if (tid < 64) {
        float* mod = (float*)(p.ws + WS_MOD);
        const float bb = p.in(I_ADAB)[l * 6144 + col];
#pragma unroll
        for (int r = 0; r < 9; ++r) mod[(size_t)(l * 9 + r) * 6144 + col] = red[r * 64 + j] + red[(9 + r) * 64 + j] + red[(18 + r) * 64 + j] + red[(27 + r) * 64 + j] + bb;
    }
    __syncthreads();
}

__device__ __forceinline__ void ph0_s5tab_unit(const P& p, int u) {
    const int tid = otid();
    if (tid >= 64) return;
    const int ldg = u;
    const int idx = ldg * 64 + tid;
    const double lre = (double)p.in(I_S5_LRE)[idx], lim = (double)p.in(I_S5_LIM)[idx];
    const double dt = (double)expf(p.in(I_S5_LOGSTEP)[ldg]);
    const float mag = expf((float)(lre * dt));
    double rev = lim * dt * 0.15915494309189535; rev -= floor(rev);
    float sn, cs; sincospif(2.f * (float)rev, &sn, &cs);
    const double abr = (double)(mag * cs), abi = (double)(mag * sn);
    const double den = lre * lre + lim * lim;
    const double cor = ((abr - 1.0) * lre + abi * lim) / den;
    const double coi = (abi * lre - (abr - 1.0) * lim) / den;
    const float m64f = expf((float)(64.0 * lre * dt));
    double rev64 = 64.0 * lim * dt * 0.15915494309189535; rev64 -= floor(rev64);
    float sn64, cs64; sincospif(2.f * (float)rev64, &sn64, &cs64);
    float* A = (float*)(p.ws + WS_S5A) + (size_t)idx * 4;
    A[0] = (float)abr; A[1] = (float)abi; A[2] = m64f * cs64; A[3] = m64f * sn64;
    float* B = (float*)(p.ws + WS_S5B) + (size_t)idx * 32;
    const float* bre = p.in(I_S5_BRE) + (size_t)idx * 16; const float* bim = p.in(I_S5_BIM) + (size_t)idx * 16;
#pragma unroll
    for (int h = 0; h < 16; ++h) {
        const double br = bre[h], bi = bim[h];
        B[h] = (float)(cor * br - coi * bi);
        B[16 + h] = (float)(cor * bi + coi * br);
    }
}

__device__ __forceinline__ int xmap(int mode, int c) {
    if (mode == 0) return c;
    const int j = c >> 6, cc = c & 63, wc = cc >> 5, pp = (cc & 31) >> 4, i = cc & 15;
    return j * 128 + wc * 64 + pp * 32 + i + (mode == 2 ? 16 : 0);
}
__device__ __forceinline__ void xpose_tile(const float* __restrict__ src, int C, bf16_t* __restrict__ dst, int ldd, int mode, int tr, int tc, char* lds) {
    float* t = (float*)lds;
    const int tid = otid();
    {
        const int c4 = (tid & 15) * 4, c = tc * 64 + c4;
#pragma unroll
        for (int k = 0; k < 4; ++k) {
            const int r = (tid >> 4) + 16 * k;
            float4 v = make_float4(0.f, 0.f, 0.f, 0.f);
            if (c < C) v = *reinterpret_cast<const float4*>(src + (size_t)(tr * 64 + r) * C + c);
            t[(c4 + 0) * 65 + r] = v.x; t[(c4 + 1) * 65 + r] = v.y; t[(c4 + 2) * 65 + r] = v.z; t[(c4 + 3) * 65 + r] = v.w;
        }
    }
    __syncthreads();
#pragma unroll
    for (int k = 0; k < 2; ++k) {
        const int ci = (tid >> 3) + 32 * k, r8 = (tid & 7) * 8;
        const float* tp = t + ci * 65 + r8;
        uint4 o;
        o.x = pack2(tp[0], tp[1]); o.y = pack2(tp[2], tp[3]); o.z = pack2(tp[4], tp[5]); o.w = pack2(tp[6], tp[7]);
        *reinterpret_cast<uint4*>(dst + (size_t)xmap(mode, tc * 64 + ci) * ldd + tr * 64 + r8) = o;
    }
    __syncthreads();
}

enum { M_INIT = 0, M_LN2NEXT = 1, M_LN1 = 2, M_FINAL = 3 };

template <int MODE>
__device__ __forceinline__ void rows_unit(const P& p, int l, int u, char* lds, bool dry = false) {
    const int tid = otid(), w = tid >> 6, lane = tid & 63;
    float* hbuf = (float*)lds;
    bf16_t* hb = (bf16_t*)(p.ws + WS_HBY);
#pragma unroll 1
    for (int rr = 0; rr < 2; ++rr) {
        const int rl = w * 2 + rr, row = u * 8 + rl;
        const int mr = row_mod(row);
        float v[16];
        float* xr = xrow(p, row);
        const float* src = (MODE == M_INIT) ? (row < NTC ? p.in(I_CTX) + (size_t)row * DM : p.in(I_X) + (size_t)(row - NTC) * DM) : xr;
#pragma unroll
        for (int i = 0; i < 4; ++i) {
            const float4 t = *reinterpret_cast<const float4*>(src + i * 256 + lane * 4);
            v[i * 4 + 0] = t.x; v[i * 4 + 1] = t.y; v[i * 4 + 2] = t.z; v[i * 4 + 3] = t.w;
        }
        if (MODE != M_INIT) {
            const int ll = (MODE == M_LN2NEXT) ? l - 1 : l;
            const int which = (MODE == M_LN1) ? 0 : 1;
            float s = 0.f;
#pragma unroll
            for (int i = 0; i < 16; ++i) s += v[i];
            const float mu = wave_sum(s) * (1.f / 1024.f);
            float q = 0.f;
#pragma unroll
            for (int i = 0; i < 16; ++i) { const float d = v[i] - mu; q += d * d; }
            const float rstd = rsqrtf(wave_sum(q) * (1.f / 1024.f) + 1e-5f);
            const float* g = p.in(I_LNG) + (size_t)(ll * 2 + which) * 1024;
            const float* bb = p.in(I_LNB) + (size_t)(ll * 2 + which) * 1024;
#pragma unroll
            for (int i = 0; i < 4; ++i) {
                const float4 gg = *reinterpret_cast<const float4*>(g + i * 256 + lane * 4);
                const float4 b4 = *reinterpret_cast<const float4*>(bb + i * 256 + lane * 4);
                v[i * 4 + 0] = (v[i * 4 + 0] - mu) * rstd * gg.x + b4.x;
                v[i * 4 + 1] = (v[i * 4 + 1] - mu) * rstd * gg.y + b4.y;
                v[i * 4 + 2] = (v[i * 4 + 2] - mu) * rstd * gg.z + b4.z;
                v[i * 4 + 3] = (v[i * 4 + 3] - mu) * rstd * gg.w + b4.w;
            }
        }
        if (MODE == M_FINAL) {
            if (row >= NTC) {
#pragma unroll
                for (int i = 0; i < 4; ++i) *reinterpret_cast<float4*>(xr + i * 256 + lane * 4) = make_float4(v[i * 4], v[i * 4 + 1], v[i * 4 + 2], v[i * 4 + 3]);
            }
            continue;
        }
        const float osc = (MODE == M_LN1) ? ALPHA : 1.f;
#pragma unroll
        for (int i = 0; i < 4; ++i) { float4 o4 = make_float4(osc * v[i * 4], osc * v[i * 4 + 1], osc * v[i * 4 + 2], osc * v[i * 4 + 3]); if (dry) o4 = *reinterpret_cast<const float4*>(src + i * 256 + lane * 4); *reinterpret_cast<float4*>(xr + i * 256 + lane * 4) = o4; }
        const float* sh = modp(p, l, mr, (MODE == M_LN1) ? 3 : 0);
        const float* sc = modp(p, l, mr, (MODE == M_LN1) ? 4 : 1);
#pragma unroll
        for (int i = 0; i < 4; ++i) {
            const float4 s4 = *reinterpret_cast<const float4*>(sc + i * 256 + lane * 4);
            const float4 h4 = *reinterpret_cast<const float4*>(sh + i * 256 + lane * 4);
            const float h0 = v[i * 4 + 0] * (1.f + s4.x) + h4.x, h1 = v[i * 4 + 1] * (1.f + s4.y) + h4.y;
            const float h2 = v[i * 4 + 2] * (1.f + s4.z) + h4.z, h3 = v[i * 4 + 3] * (1.f + s4.w) + h4.w;
            uint2 pk; pk.x = pack2(h0, h1); pk.y = pack2(h2, h3);
            if (!dry) *reinterpret_cast<uint2*>(hb + (size_t)row * DM + i * 256 + lane * 4) = pk;
            if (MODE == M_LN1) *reinterpret_cast<float4*>(hbuf + rl * 1024 + i * 256 + lane * 4) = make_float4(h0, h1, h2, h3);
        }
    }
    if (MODE == M_LN1) {
        float* part = hbuf + 8 * 1024;
        __syncthreads();
        {
            const float* rw = p.in(I_ROUTER_W) + (size_t)l * 1024 * 64 + lane;
            float ac[8];
#pragma unroll
            for (int r = 0; r < 8; ++r) ac[r] = 0.f;
#pragma unroll 2
            for (int k = w * 256; k < w * 256 + 256; k += 4) {
                const float w0 = rw[(size_t)(k + 0) * 64], w1 = rw[(size_t)(k + 1) * 64], w2 = rw[(size_t)(k + 2) * 64], w3 = rw[(size_t)(k + 3) * 64];
#pragma unroll
                for (int r = 0; r < 8; ++r) {
                    const float4 x = *reinterpret_cast<const float4*>(hbuf + r * 1024 + k);
                    ac[r] += x.x * w0 + x.y * w1 + x.z * w2 + x.w * w3;
                }
            }
#pragma unroll
            for (int r = 0; r < 8; ++r) part[(w * 8 + r) * 64 + lane] = ac[r];
        }
        __syncthreads();
        float a0, a1;
        {
            const int r0 = w * 2, r1 = w * 2 + 1;
            a0 = part[(0 * 8 + r0) * 64 + lane] + part[(1 * 8 + r0) * 64 + lane] + part[(2 * 8 + r0) * 64 + lane] + part[(3 * 8 + r0) * 64 + lane];
            a1 = part[(0 * 8 + r1) * 64 + lane] + part[(1 * 8 + r1) * 64 + lane] + part[(2 * 8 + r1) * 64 + lane] + part[(3 * 8 + r1) * 64 + lane];
        }
        const float rbias = p.in(I_ROUTER_B)[l * 64 + lane];
        unsigned* cnt = (unsigned*)(p.ws + WS_CTL) + CW_CNT(l);
        int* aep = (int*)(p.ws + WS_AEP); float* aw = (float*)(p.ws + WS_AW);
#pragma unroll 1
        for (int rr = 0; rr < 2; ++rr) {
            const int row = u * 8 + w * 2 + rr;
            const float logit = rr ? a1 : a0;
            const float s = 1.f / (1.f + expf(-logit));
            const float bsd = s + rbias;
            float m1 = bsd;
            m1 = fmaxf(m1, __shfl_xor(m1, 1)); m1 = fmaxf(m1, __shfl_xor(m1, 2)); m1 = fmaxf(m1, __shfl_xor(m1, 4));
            const unsigned long long eqm = __ballot(bsd == m1);
            const int gbase = lane & ~7;
            const unsigned gbits = (unsigned)((eqm >> gbase) & 0xFFull);
            const int first = gbase + __builtin_ctz(gbits);
            float m2 = (lane == first) ? -INFINITY : bsd;
            m2 = fmaxf(m2, __shfl_xor(m2, 1)); m2 = fmaxf(m2, __shfl_xor(m2, 2)); m2 = fmaxf(m2, __shfl_xor(m2, 4));
            const float gs = m1 + m2;
            const int myg = lane >> 3;
            int grank = 0;
#pragma unroll
            for (int g2 = 0; g2 < 8; ++g2) { const float o = __shfl(gs, g2 * 8); grank += (o > gs || (o == gs && g2 < myg)) ? 1 : 0; }
            const bool gsel = grank < 4;
            const float msk = gsel ? bsd : -INFINITY;
            int erank = 0;
#pragma unroll
            for (int j = 0; j < 64; ++j) { const float o = __shfl(msk, j); erank += (o > msk || (o == msk && j < lane)) ? 1 : 0; }
            const bool sel = gsel && erank < 8;
            const float wsum = wave_sum(sel ? s : 0.f);
            const unsigned long long selm = __ballot(sel);
            if (sel && !dry) {
                const int slot = __popcll(selm & ((1ull << lane) - 1ull));
                const unsigned pos = atomicAdd(&cnt[lane], 1u);
                aep[(size_t)row * 8 + slot] = (int)((unsigned)lane << 24 | pos);
                ((int*)(p.ws + WS_RTOK))[(size_t)lane * NT + pos] = row;
                aw[(size_t)row * 8 + slot] = s / wsum * 2.5f;
            }
        }
    }
}

__device__ __forceinline__ void filt_unit(const P& p, int l, int u, char* lds) {
    const int tid = otid();
    float* feat = (float*)lds;
    float* h1 = feat + 4 * 36;
    float* h2 = h1 + 4 * 64;
    const int pp = tid >> 6, j = tid & 63;
    const int pi = u * 4 + pp;
    const int L = pi < 4096 ? 4096 : 256;
    const int t = pi < 4096 ? pi : pi - 4096;
    const float tt = (float)t / (float)(L - 1);
    if (j < 33) {
        float f;
        if (j == 0) f = tt;
        else {
            const int k = (j - 1) & 15;
            const float band = 1e-4f + (float)k * ((15.0f - 1e-4f) / 15.0f);
            float ph = band * (float)t * (1.f / (float)L);
            ph -= floorf(ph);
            float sn, cs; sincospif(2.f * ph, &sn, &cs);
            f = (j <= 16) ? cs : -sn;
        }
        feat[pp * 36 + j] = f;
    }
    __syncthreads();
    {
        const float* w1 = p.in(I_HY_W1) + (size_t)l * 33 * 64;
        float a = p.in(I_HY_B1)[l * 64 + j];
        for (int i = 0; i < 33; ++i) a += feat[pp * 36 + i] * w1[i * 64 + j];
        h1[pp * 64 + j] = sinf(p.in(I_HY_F1)[l * 64 + j] * a);
    }
    __syncthreads();
    {
        const float* w2 = p.in(I_HY_W2) + (size_t)l * 64 * 64;
        float a = p.in(I_HY_B2)[l * 64 + j];
        for (int i = 0; i < 64; ++i) a += h1[pp * 64 + i] * w2[i * 64 + j];
        h2[pp * 64 + j] = sinf(p.in(I_HY_F2)[l * 64 + j] * a);
    }
    __syncthreads();
    {
        const int c = tid;
        const float* w3 = p.in(I_HY_W3) + (size_t)l * 64 * 1024;
        float acc[4][4];
#pragma unroll
        for (int a = 0; a < 4; ++a)
#pragma unroll
            for (int b = 0; b < 4; ++b) acc[a][b] = 0.f;
        for (int i = 0; i < 64; ++i) {
            float wv[4];
#pragma unroll
            for (int os = 0; os < 4; ++os) wv[os] = w3[i * 1024 + os * 256 + c];
#pragma unroll
            for (int q = 0; q < 4; ++q) {
                const float hv = h2[q * 64 + i];
#pragma unroll
                for (int os = 0; os < 4; ++os) acc[q][os] += hv * wv[os];
            }
        }
        const float d0 = logf(0.01f) / 1.5f, d1 = logf(0.01f) / 0.3f;
        const float delta = fabsf(d0 + (d1 - d0) * ((float)c / 255.f));
#pragma unroll
        for (int q = 0; q < 4; ++q) {
            const int pq = u * 4 + q;
            const int Lq = pq < 4096 ? 4096 : 256;
            const int tq = pq < 4096 ? pq : pq - 4096;
            const float ttq = (float)tq / (float)(Lq - 1);
            const float dec = expf(-ttq * delta);
            float* F = (pq < 4096) ? (float*)(p.ws + WS_FILTL) : (float*)(p.ws + WS_FILTC);
#pragma unroll
            for (int os = 0; os < 4; ++os) {
                if (pq < 4096) F[((size_t)((os >> 1) * 256 + c) * 2 + (os & 1)) * 4096 + tq] = acc[q][os] * dec;
                else F[((size_t)os * 256 + c) * Lq + tq] = acc[q][os] * dec;
            }
        }
    }
    __syncthreads();
}

__device__ __forceinline__ void rwkv_prep_unit(const P& p, int l, int u, char* lds) {
    const int tid = otid();
    bf16_t* twb = (bf16_t*)lds;
    bf16_t* alb = twb + 32 * 72;
    bf16_t* ot = alb + 32 * 72;
    const bf16_t* z = (const bf16_t*)(p.ws + WS_Z);
    bf16_t* rwp = (bf16_t*)(p.ws + WS_R1 + R1_RWP);
    float* knorm = (float*)(p.ws + WS_KNORM);
    const int row0 = u * 32;
    {
        const int tok = tid >> 3, j0 = (tid & 7) * 8;
        const bf16_t* zr = z + (size_t)(row0 + tok) * ZS;
        float wl[8];
        unpack8(*reinterpret_cast<const uint4*>(zr + 768 + j0), wl);
#pragma unroll
        for (int i = 0; i < 8; ++i) wl[i] = 1.f - 2.f * __frcp_rn(1.f + __expf(2.f * wl[i]));
        *reinterpret_cast<uint4*>(twb + tok * 72 + j0) = pack8(wl);
        *reinterpret_cast<uint4*>(alb + tok * 72 + j0) = *reinterpret_cast<const uint4*>(zr + 832 + j0);
    }
    {
        const int tl = tid >> 5, cg = tid & 31, c0 = cg * 8;
        float kk[8];
#pragma unroll
        for (int i = 0; i < 8; ++i) kk[i] = p.in(I_RW_KK)[l * 256 + c0 + i];
#pragma unroll
        for (int it = 0; it < 4; ++it) {
            const int row = row0 + it * 8 + tl;
            float k[8];
            unpack8(*reinterpret_cast<const uint4*>(z + (size_t)row * ZS + 256 + c0), k);
            float ss = 0.f;
#pragma unroll
            for (int i = 0; i < 8; ++i) { const float kv = k[i] * kk[i]; ss += kv * kv; }
            ss = sum8lanes(ss);
            if ((cg & 7) == 0) knorm[(size_t)row * 4 + (cg >> 3)] = rsqrtf(ss + 1e-12f);
        }
    }
    __syncthreads();
    const int w = tid >> 6, lane = tid & 63, fr = lane & 15, fq = lane >> 4;
#pragma unroll 1
    for (int combo = 0; combo < 4; ++combo) {
        const int kind = combo >> 1, d = combo & 1;
        const bf16_t* At = kind ? alb : twb;
        const bf16_t* Bt = (const bf16_t*)(p.ws + (kind ? WS_LA2T : WS_LW2T)) + (size_t)l * 256 * 64;
        const float* basep = (kind ? p.in(I_RW_A0) : p.in(I_RW_W0)) + (l * 2 + d) * 256;
        bf16x8 af[2], bfr[4];
#pragma unroll
        for (int mf = 0; mf < 2; ++mf) af[mf] = *reinterpret_cast<const bf16x8*>(At + (mf * 16 + fr) * 72 + d * 32 + fq * 8);
#pragma unroll
        for (int nf = 0; nf < 4; ++nf) bfr[nf] = *reinterpret_cast<const bf16x8*>(Bt + (size_t)(w * 64 + nf * 16 + fr) * 64 + d * 32 + fq * 8);
#pragma unroll
        for (int nf = 0; nf < 4; ++nf) {
            const float base = basep[w * 64 + nf * 16 + fr];
#pragma unroll
            for (int mf = 0; mf < 2; ++mf) {
                const f32x4 acc = __builtin_amdgcn_mfma_f32_16x16x32_bf16(af[mf], bfr[nf], f32x4{0.f, 0.f, 0.f, 0.f}, 0, 0, 0);
#pragma unroll
                for (int j = 0; j < 4; ++j) {
                    const float a = base + acc[j];
                    float o;
                    if (kind) o = __frcp_rn(1.f + __expf(-a));
                    else { const float na = -a; const float sp = fmaxf(na, 0.f) + __logf(1.f + __expf(-fabsf(na))); o = __expf(-sp - 0.5f); }
                    ot[(mf * 16 + fq * 4 + j) * 264 + w * 64 + nf * 16 + fr] = f2bf(o);
                }
            }
        }
        __syncthreads();
#pragma unroll
        for (int i = 0; i < 4; ++i) {
            const int id = tid + 256 * i, tok = id >> 5, c8 = (id & 31) * 8;
            *reinterpret_cast<uint4*>(rwp + ((size_t)(row0 + tok) * 4 + combo) * 256 + c8) = *reinterpret_cast<const uint4*>(ot + tok * 264 + c8);
        }
        __syncthreads();
    }
}

__device__ __forceinline__ void gdn_prep_unit(const P& p, int l, int u) {
    const int tid = otid();
    const bf16_t* z = (const bf16_t*)(p.ws + WS_Z);
    bf16_t* gq = (bf16_t*)(p.ws + WS_R1 + R1_GQ);
    float* gab = (float*)(p.ws + WS_GAB);
    const int row0 = u * 32;
    int seq0, seqL;
    if (row0 < NTC) { seq0 = row0 & ~255; seqL = 256; } else { seq0 = NTC + ((row0 - NTC) & ~4095); seqL = 4096; }
    const int tl = tid >> 5, cg = tid & 31;
#pragma unroll 1
    for (int pz = 0; pz < 3; ++pz) {
        const int ch0 = pz * 256 + cg * 8;
        float w0[8], w1[8], w2[8];
        {
            const float* cw = p.in(I_GD_CONV) + (size_t)l * 3 * 768 + ch0;
#pragma unroll
            for (int i = 0; i < 8; i += 4) {
                const float4 a = *reinterpret_cast<const float4*>(cw + i), b = *reinterpret_cast<const float4*>(cw + 768 + i), c = *reinterpret_cast<const float4*>(cw + 1536 + i);
                w0[i] = a.x; w0[i + 1] = a.y; w0[i + 2] = a.z; w0[i + 3] = a.w;
                w1[i] = b.x; w1[i + 1] = b.y; w1[i + 2] = b.z; w1[i + 3] = b.w;
                w2[i] = c.x; w2[i + 1] = c.y; w2[i + 2] = c.z; w2[i + 3] = c.w;
            }
        }
#pragma unroll 2
        for (int it = 0; it < 4; ++it) {
            const int row = row0 + it * 8 + tl;
            const bf16_t* zc = z + (size_t)row * ZS + COL_GD + ch0;
            const uint4 zero4 = make_uint4(0u, 0u, 0u, 0u);
            const uint4 vm = (row - 1 >= seq0) ? *reinterpret_cast<const uint4*>(zc - ZS) : zero4;
            const uint4 v0 = *reinterpret_cast<const uint4*>(zc);
            const uint4 vp = (row + 1 < seq0 + seqL) ? *reinterpret_cast<const uint4*>(zc + ZS) : zero4;
            float xm[8], x0[8], xp[8], o[8];
            unpack8(vm, xm); unpack8(v0, x0); unpack8(vp, xp);
            float ss = 0.f;
#pragma unroll
            for (int i = 0; i < 8; ++i) { o[i] = siluf(w0[i] * xm[i] + w1[i] * x0[i] + w2[i] * xp[i]); ss += o[i] * o[i]; }
            if (pz < 2) {
                ss = sum8lanes(ss);
                const float sc = rsqrtf(ss + 1e-12f) * (pz == 0 ? 0.125f : 1.f);
#pragma unroll
                for (int i = 0; i < 8; ++i) o[i] *= sc;
            }
            *reinterpret_cast<uint4*>(gq + (size_t)row * 768 + ch0) = pack8(o);
        }
    }
    {
        const int tok = tid >> 3, dh = tid & 7;
        const int row = row0 + tok;
        const float alv = bf2f(z[(size_t)row * ZS + COL_GD + 1024 + dh]);
        const float blv = bf2f(z[(size_t)row * ZS + COL_GD + 1032 + dh]);
        const float g = -expf(p.in(I_GD_ALOG)[l * 8 + dh]) * softplusf(alv + p.in(I_GD_DTB)[l * 8 + dh]);
        gab[(size_t)row * 16 + dh] = expf(g);
        gab[(size_t)row * 16 + 8 + dh] = 1.f / (1.f + expf(-blv));
    }
}

__device__ __forceinline__ int s5_chain_row(int b, int d, int q) {
    if (q < 256) return b * 256 + (d ? 255 - q : q);
    int n = q - 256; if (d) n = 4095 - n;
    return NTC + b * 4096 + (n & 63) * 64 + (n >> 6);
}
__device__ __forceinline__ void s5_load_u(const bf16_t* zr, float* dst) {
    const uint4 a = *reinterpret_cast<const uint4*>(zr);
    const uint4 b = *reinterpret_cast<const uint4*>(zr + 8);
    *reinterpret_cast<float4*>(dst + 0) = make_float4(bflo(a.x), bfhi(a.x), bflo(a.y), bfhi(a.y));
    *reinterpret_cast<float4*>(dst + 4) = make_float4(bflo(a.z), bfhi(a.z), bflo(a.w), bfhi(a.w));
    *reinterpret_cast<float4*>(dst + 8) = make_float4(bflo(b.x), bfhi(b.x), bflo(b.y), bfhi(b.y));
    *reinterpret_cast<float4*>(dst + 12) = make_float4(bflo(b.z), bfhi(b.z), bflo(b.w), bfhi(b.w));
}

__device__ __forceinline__ void s5_pre_unit(const P& p, int l, int u, char* lds) {
    const int tid = otid(), w = tid >> 6, lane = tid & 63;
    float* ust = (float*)lds + w * 1024;
    const int wt = u * 4 + w;
    const int d = wt & 1, g = (wt >> 1) & 15, rest = wt >> 5;
    const int cc = rest % NCHUNK, b = rest / NCHUNK;
    const bf16_t* z = (const bf16_t*)(p.ws + WS_Z);
    {
        const int row = s5_chain_row(b, d, cc * 64 + lane);
        s5_load_u(z + (size_t)row * ZS + COL_S5 + g * 16, ust + lane * 16);
    }
    const int tix = ((l * 2 + d) * 16 + g) * 64 + lane;
    const float4 A = *reinterpret_cast<const float4*>((const float*)(p.ws + WS_S5A) + (size_t)tix * 4);
    const float* Bp = (const float*)(p.ws + WS_S5B) + (size_t)tix * 32;
    f32x2 bb[16];
#pragma unroll
    for (int h = 0; h < 16; ++h) bb[h] = f32x2{Bp[h], Bp[16 + h]};
    float xr = 0.f, xi = 0.f;
#pragma unroll 4
    for (int s = 0; s < 64; ++s) {
        f32x2 bu = f32x2{0.f, 0.f};
#pragma unroll
        for (int h4 = 0; h4 < 4; ++h4) {
            const float4 uu = *reinterpret_cast<const float4*>(ust + s * 16 + h4 * 4);
            bu += bb[h4 * 4] * uu.x + bb[h4 * 4 + 1] * uu.y + bb[h4 * 4 + 2] * uu.z + bb[h4 * 4 + 3] * uu.w;
        }
        const float nr = A.x * xr - A.y * xi + bu.x;
        const float ni = A.x * xi + A.y * xr + bu.y;
        xr = nr; xi = ni;
    }
    float* st = (float*)(p.ws + WS_S5ST) + ((((size_t)(b * NCHUNK + cc) * 2 + d) * 16 + g) * 64 + lane) * 2;
    st[0] = xr; st[1] = xi;
}

__device__ __forceinline__ float reduce16(const float (&t)[16], int lane) {
    float a[8];
    const bool hi8 = (lane & 8) != 0;
#pragma unroll
    for (int k = 0; k < 8; ++k) { const float keep = hi8 ? t[k + 8] : t[k]; const float send = hi8 ? t[k] : t[k + 8]; a[k] = keep + dppf<0x140>(send); }
    float b[4];
    const bool hi4 = (lane & 4) != 0;
#pragma unroll
    for (int k = 0; k < 4; ++k) { const float keep = hi4 ? a[k + 4] : a[k]; const float send = hi4 ? a[k] : a[k + 4]; b[k] = keep + dppf<0x141>(send); }
    float c[2];
    const bool hi2 = (lane & 2) != 0;
#pragma unroll
    for (int k = 0; k < 2; ++k) { const float keep = hi2 ? b[k + 2] : b[k]; const float send = hi2 ? b[k] : b[k + 2]; c[k] = keep + dppf<0x4E>(send); }
    const bool hi1 = (lane & 1) != 0;
    float r = (hi1 ? c[1] : c[0]) + dppf<0xB1>(hi1 ? c[0] : c[1]);
    r += __shfl_xor(r, 16);
    r += __shfl_xor(r, 32);
    return r;
}

__device__ __forceinline__ void s5_main_unit(const P& p, int l, int u, char* lds) {
    const int tid = otid(), w = tid >> 6, lane = tid & 63;
    char* wl = lds + w * 12800;
    float* ust = (float*)wl;
    char* xbuf = wl + 4096;
    float* yst = (float*)xbuf;
    const int b = u / NCHUNK, tc = u % NCHUNK;
    bf16_t* z = (bf16_t*)(p.ws + WS_Z);
    const int myrow = (tc < 4) ? (b * 256 + tc * 64 + lane) : (NTC + b * 4096 + lane * 64 + (tc - 4));
    const int fr = lane & 15, fq = lane >> 4;
#pragma unroll 1
    for (int gi = 0; gi < 4; ++gi) {
        const int g = w * 4 + gi;
        s5_load_u(z + (size_t)myrow * ZS + COL_S5 + g * 16, ust + lane * 16);
        f32x4 yacc[4];
#pragma unroll
        for (int mf = 0; mf < 4; ++mf) yacc[mf] = f32x4{0.f, 0.f, 0.f, 0.f};
#pragma unroll 1
        for (int d = 0; d < 2; ++d) {
            const int tix = ((l * 2 + d) * 16 + g) * 64 + lane;
            const float4 A = *reinterpret_cast<const float4*>((const float*)(p.ws + WS_S5A) + (size_t)tix * 4);
            const float* Bp = (const float*)(p.ws + WS_S5B) + (size_t)tix * 32;
            f32x2 bb[16];
#pragma unroll
            for (int h = 0; h < 16; ++h) bb[h] = f32x2{Bp[h], Bp[16 + h]};
            bf16x8 cfrag[4];
            {
                const float* crp = p.in(I_S5_CRE) + (size_t)((l * 2 + d) * 16 + g) * 1024 + fr * 64;
                const float* cip = p.in(I_S5_CIM) + (size_t)((l * 2 + d) * 16 + g) * 1024 + fr * 64;
#pragma unroll
                for (int ks = 0; ks < 4; ++ks) {
                    const int k0 = (ks & 1) * 32 + fq * 8;
                    const float* src = (ks < 2) ? crp + k0 : cip + k0;
                    const float sg = (ks < 2) ? 1.f : -1.f;
                    const float4 c0 = *reinterpret_cast<const float4*>(src), c1 = *reinterpret_cast<const float4*>(src + 4);
                    cfrag[ks][0] = (short)f2bf(sg * c0.x); cfrag[ks][1] = (short)f2bf(sg * c0.y); cfrag[ks][2] = (short)f2bf(sg * c0.z); cfrag[ks][3] = (short)f2bf(sg * c0.w);
                    cfrag[ks][4] = (short)f2bf(sg * c1.x); cfrag[ks][5] = (short)f2bf(sg * c1.y); cfrag[ks][6] = (short)f2bf(sg * c1.z); cfrag[ks][7] = (short)f2bf(sg * c1.w);
                }
            }
            const int cc = d ? ((tc < 4) ? 3 - tc : 71 - tc) : tc;
            float xr = 0.f, xi = 0.f;
            {
                const float* st = (const float*)(p.ws + WS_S5ST) + ((((size_t)(b * NCHUNK) * 2 + d) * 16 + g) * 64 + lane) * 2;
                for (int c0 = 0; c0 < cc; c0 += 8) {
                    float2 sv[8];
#pragma unroll
                    for (int q = 0; q < 8; ++q) {
                        const int c2 = (c0 + q < cc) ? c0 + q : cc - 1;
                        sv[q] = *reinterpret_cast<const float2*>(st + (size_t)c2 * (2 * 16 * 64 * 2));
                    }
#pragma unroll
                    for (int q = 0; q < 8; ++q) {
                        if (c0 + q < cc) {
                            const float nr = A.z * xr - A.w * xi + sv[q].x;
                            const float ni = A.z * xi + A.w * xr + sv[q].y;
                            xr = nr; xi = ni;
                        }
                    }
                }
            }
#pragma unroll 1
            for (int hf = 0; hf < 2; ++hf) {
                const int hbase = (d ? 1 - hf : hf) * 32;
#pragma unroll 4
                for (int s = 0; s < 32; ++s) {
                    const int il = d ? 31 - s : s;
                    const float* up = ust + (hbase + il) * 16;
                    f32x2 bu = f32x2{0.f, 0.f};
#pragma unroll
                    for (int h4 = 0; h4 < 4; ++h4) {
                        const float4 uu = *reinterpret_cast<const float4*>(up + h4 * 4);
                        bu += bb[h4 * 4] * uu.x + bb[h4 * 4 + 1] * uu.y + bb[h4 * 4 + 2] * uu.z + bb[h4 * 4 + 3] * uu.w;
                    }
                    const float nr = A.x * xr - A.y * xi + bu.x;
                    const float ni = A.x * xi + A.y * xr + bu.y;
                    xr = nr; xi = ni;
                    *reinterpret_cast<bf16_t*>(xbuf + il * 272 + lane * 2) = f2bf(xr);
                    *reinterpret_cast<bf16_t*>(xbuf + il * 272 + 128 + lane * 2) = f2bf(xi);
                }
#pragma unroll
                for (int mfl = 0; mfl < 2; ++mfl) {
                    f32x4 acc = yacc[0];
                    const int mf = (hbase >> 4) + mfl;
                    acc = (mf == 0) ? yacc[0] : (mf == 1) ? yacc[1] : (mf == 2) ? yacc[2] : yacc[3];
#pragma unroll
                    for (int ks = 0; ks < 4; ++ks) {
                        const bf16x8 af = *reinterpret_cast<const bf16x8*>(xbuf + (mfl * 16 + fr) * 272 + ks * 64 + fq * 16);
                        acc = __builtin_amdgcn_mfma_f32_16x16x32_bf16(af, cfrag[ks], acc, 0, 0, 0);
                    }
                    if (mf == 0) yacc[0] = acc; else if (mf == 1) yacc[1] = acc; else if (mf == 2) yacc[2] = acc; else yacc[3] = acc;
                }
            }
        }
#pragma unroll
        for (int mf = 0; mf < 4; ++mf)
#pragma unroll
            for (int j = 0; j < 4; ++j) yst[(mf * 16 + fq * 4 + j) * 16 + fr] = yacc[mf][j];
        {
            const float* dsk = p.in(I_S5_D) + l * 256 + g * 16;
            unsigned pk[8];
#pragma unroll
            for (int h = 0; h < 16; h += 2) {
                float y0 = yst[lane * 16 + h] + ust[lane * 16 + h] * dsk[h];
                float y1 = yst[lane * 16 + h + 1] + ust[lane * 16 + h + 1] * dsk[h + 1];
                y0 = 0.5f * y0 * (1.f + erff(y0 * 0.70710678118f));
                y1 = 0.5f * y1 * (1.f + erff(y1 * 0.70710678118f));
                pk[h >> 1] = pack2(y0, y1);
            }
            uint4* dst = reinterpret_cast<uint4*>((bf16_t*)(p.ws + WS_S5G) + (size_t)myrow * 256 + g * 16);
            dst[0] = make_uint4(pk[0], pk[1], pk[2], pk[3]);
            dst[1] = make_uint4(pk[4], pk[5], pk[6], pk[7]);
        }
    }
}

#define SB 16
__device__ __forceinline__ int scan_chain_row(int b, int d, int q) {
    if (q < 256) return b * 256 + (d ? 255 - q : q);
    const int t = q - 256;
    return NTC + b * 4096 + (d ? 4095 - t : t);
}
struct ScanRaw { uint2 r, k, v, e, a; float f0, f1; };

__device__ __forceinline__ void scan_load(const P& p, int m, int b, int h, int d, int q, int cg, ScanRaw& R) {
    const int row = scan_chain_row(b, d, q);
    const int c0 = h * 64 + cg * 4;
    if (m == 0) {
        const bf16_t* z = (const bf16_t*)(p.ws + WS_Z) + (size_t)row * ZS + c0;
        R.r = *reinterpret_cast<const uint2*>(z);
        R.k = *reinterpret_cast<const uint2*>(z + 256);
        R.v = *reinterpret_cast<const uint2*>(z + 512);
        const bf16_t* rw = (const bf16_t*)(p.ws + WS_R1 + R1_RWP) + (size_t)row * 1024 + c0;
        R.e = *reinterpret_cast<const uint2*>(rw + d * 256);
        R.a = *reinterpret_cast<const uint2*>(rw + (2 + d) * 256);
        R.f0 = ((const float*)(p.ws + WS_KNORM))[(size_t)row * 4 + h];
        R.f1 = 0.f;
    } else {
        const bf16_t* gq = (const bf16_t*)(p.ws + WS_R1 + R1_GQ) + (size_t)row * 768 + c0;
        R.r = *reinterpret_cast<const uint2*>(gq);
        R.k = *reinterpret_cast<const uint2*>(gq + 256);
        R.v = *reinterpret_cast<const uint2*>(gq + 512);
        R.e = make_uint2(0u, 0u); R.a = make_uint2(0u, 0u);
        const float* gab = (const float*)(p.ws + WS_GAB) + (size_t)row * 16;
        R.f0 = gab[d * 4 + h];
        R.f1 = gab[8 + d * 4 + h];
    }
}
__device__ __forceinline__ void scan_store(int m, const ScanRaw& R, float* dst  , const float (&kkp)[4], const float (&kap)[4]) {
    float r[4] = {bflo(R.r.x), bfhi(R.r.x), bflo(R.r.y), bfhi(R.r.y)};
    float k[4] = {bflo(R.k.x), bfhi(R.k.x), bflo(R.k.y), bfhi(R.k.y)};
    float v[4] = {bflo(R.v.x), bfhi(R.v.x), bflo(R.v.y), bfhi(R.v.y)};
    float ww[4], aa[4], bb[4], kk[4];
    if (m == 0) {
        float e[4] = {bflo(R.e.x), bfhi(R.e.x), bflo(R.e.y), bfhi(R.e.y)};
        float a[4] = {bflo(R.a.x), bfhi(R.a.x), bflo(R.a.y), bfhi(R.a.y)};
#pragma unroll
        for (int i = 0; i < 4; ++i) {
            ww[i] = __expf(-e[i]);
            kk[i] = k[i] * (1.f + (a[i] - 1.f) * kap[i]);
            const float kn = k[i] * kkp[i] * R.f0;
            aa[i] = -kn;
            bb[i] = kn * a[i];
        }
    } else {
        const float al = R.f0, be = R.f1;
#pragma unroll
        for (int i = 0; i < 4; ++i) { ww[i] = al; aa[i] = k[i]; bb[i] = -al * be * k[i]; kk[i] = be * k[i]; }
    }
    *reinterpret_cast<float4*>(dst + 0 * 64) = make_float4(ww[0], ww[1], ww[2], ww[3]);
    *reinterpret_cast<float4*>(dst + 1 * 64) = make_float4(aa[0], aa[1], aa[2], aa[3]);
    *reinterpret_cast<float4*>(dst + 2 * 64) = make_float4(bb[0], bb[1], bb[2], bb[3]);
    *reinterpret_cast<float4*>(dst + 3 * 64) = make_float4(kk[0], kk[1], kk[2], kk[3]);
    *reinterpret_cast<float4*>(dst + 4 * 64) = make_float4(r[0], r[1], r[2], r[3]);
    *reinterpret_cast<float4*>(dst + 5 * 64) = make_float4(v[0], v[1], v[2], v[3]);
}

__device__ __forceinline__ void scan_unit(const P& p, int l, int u, char* lds) {
    const int tid = otid();
    const int chain = u >> 1, half = u & 1;
    const int m = chain >> 6, rem = chain & 63, b = rem >> 3, h = (rem >> 1) & 3, d = rem & 1;
    float* buf = (float*)lds;
    float* ybuf = buf + 2 * SB * 384;
    const int rp = tid >> 4, sub = tid & 15;
    const int st = tid >> 4, cg = tid & 15;
    float kkp[4], kap[4];
#pragma unroll
    for (int i = 0; i < 4; ++i) { kkp[i] = p.in(I_RW_KK)[l * 256 + h * 64 + cg * 4 + i]; kap[i] = p.in(I_RW_KA)[l * 256 + h * 64 + cg * 4 + i]; }
    bf16_t* ys = (bf16_t*)(p.ws + WS_HBY) + (size_t)(m * 2 + d) * NT * 256;
    f32x2 S2[4];
#pragma unroll
    for (int j = 0; j < 4; ++j) S2[j] = f32x2{0.f, 0.f};
    ScanRaw R, R2;
    scan_load(p, m, b, h, d, st, cg, R);
    scan_store(m, R, buf + (st * 6) * 64 + cg * 4, kkp, kap);
    scan_load(p, m, b, h, d, SB + st, cg, R);
    __syncthreads();
    const int NB = 4352 / SB;
    __builtin_amdgcn_s_setprio(2);
    auto batch = [&](int bt, ScanRaw& Rld, ScanRaw& Rst) {
        const int par = bt & 1;
        if (bt + 2 < NB) scan_load(p, m, b, h, d, (bt + 2) * SB + st, cg, Rld);
        const float* cb = buf + par * (SB * 384);
        float* yb = ybuf + par * (SB * 32);
        {
            const float* sb0 = cb + sub * 4;
            const float* vb0 = cb + 320 + half * 32 + rp;
            float4 nw = *reinterpret_cast<const float4*>(sb0), na = *reinterpret_cast<const float4*>(sb0 + 64), nb = *reinterpret_cast<const float4*>(sb0 + 128);
            float4 nk = *reinterpret_cast<const float4*>(sb0 + 192), nr = *reinterpret_cast<const float4*>(sb0 + 256);
            float nvA = vb0[0], nvB = vb0[16];
#pragma unroll
            for (int s = 0; s < SB; ++s) {
                const float4 w = nw, a = na, bq = nb, k = nk, r = nr;
                const float vA = nvA, vB = nvB;
                if (s + 1 < SB) {
                    const float* sb = sb0 + (s + 1) * 384;
                    nw = *reinterpret_cast<const float4*>(sb); na = *reinterpret_cast<const float4*>(sb + 64); nb = *reinterpret_cast<const float4*>(sb + 128);
                    nk = *reinterpret_cast<const float4*>(sb + 192); nr = *reinterpret_cast<const float4*>(sb + 256);
                    nvA = vb0[(s + 1) * 384]; nvB = vb0[(s + 1) * 384 + 16];
                }
                __builtin_amdgcn_sched_barrier(0);
                const f32x2 v2 = {vA, vB};
                f32x2 sa2 = (S2[0] * a.x + S2[1] * a.y) + (S2[2] * a.z + S2[3] * a.w);
                float sa = sa2.x, sb2 = sa2.y;
                sa += dppf<0xB1>(sa); sb2 += dppf<0xB1>(sb2);
                sa += dppf<0x4E>(sa); sb2 += dppf<0x4E>(sb2);
                sa += dppf<0x141>(sa); sb2 += dppf<0x141>(sb2);
                sa += dppf<0x140>(sa); sb2 += dppf<0x140>(sb2);
                sa2.x = sa; sa2.y = sb2;
                S2[0] = S2[0] * w.x + sa2 * bq.x + v2 * k.x;
                S2[1] = S2[1] * w.y + sa2 * bq.y + v2 * k.y;
                S2[2] = S2[2] * w.z + sa2 * bq.z + v2 * k.z;
                S2[3] = S2[3] * w.w + sa2 * bq.w + v2 * k.w;
                const f32x2 y2 = (S2[0] * r.x + S2[1] * r.y) + (S2[2] * r.z + S2[3] * r.w);
                float yA = y2.x, yB = y2.y;
                yA += dppf<0xB1>(yA); yB += dppf<0xB1>(yB);
                yA += dppf<0x4E>(yA); yB += dppf<0x4E>(yB);
                yA += dppf<0x141>(yA); yB += dppf<0x141>(yB);
                yA += dppf<0x140>(yA); yB += dppf<0x140>(yB);
                yb[s * 32 + rp] = yA; yb[s * 32 + 16 + rp] = yB;
            }
        }
        if (bt + 1 < NB) scan_store(m, Rst, buf + (1 - par) * (SB * 384) + (st * 6) * 64 + cg * 4, kkp, kap);
        __syncthreads();
        {
            const int r2 = cg * 2;
            const int row = scan_chain_row(b, d, bt * SB + st);
            const unsigned pk = pack2(yb[st * 32 + r2], yb[st * 32 + r2 + 1]);
            *reinterpret_cast<unsigned*>(ys + (size_t)row * 256 + h * 64 + half * 32 + r2) = pk;
        }
    };
#pragma unroll 1
    for (int bt = 0; bt < NB; bt += 2) { batch(bt, R2, R); batch(bt + 1, R, R2); }
    __builtin_amdgcn_s_setprio(0);
    __syncthreads();
}

template <int L>
__device__ __forceinline__ void hyena_unit(const P& p, int l, int u, char* lds) {
    constexpr int TPT = L / 256;
    const int tid = otid();
    const int c = u >> 2, bp = u & 3;
    float2* u2 = (float2*)lds;
    float* taps = (float*)(lds + (size_t)L * 8);
    const bf16_t* z = (const bf16_t*)(p.ws + WS_Z);
    bf16_t* cat = (bf16_t*)(p.ws + WS_CAT);
    const float* F = (L == 4096) ? (const float*)(p.ws + WS_FILTL) : (const float*)(p.ws + WS_FILTC);
    int base[2];
#pragma unroll
    for (int bb = 0; bb < 2; ++bb) { const int b = bp * 2 + bb; base[bb] = (L == 4096) ? NTC + b * 4096 : b * 256; }
    const int t0 = tid * TPT;
    const float* cw = p.in(I_HY_CONV) + (size_t)l * 3 * 768; const float* cb = p.in(I_HY_CONVB) + (size_t)l * 768;
    auto sconv = [&](int part, int bb, float (&o)[TPT]) {
        const int ch = part * 256 + c;
        const float w0 = cw[ch], w1 = cw[768 + ch], w2 = cw[1536 + ch], bs = cb[ch];
        const bf16_t* zc = z + (size_t)base[bb] * ZS + COL_HY + ch;
        float xm = (t0 > 0) ? bf2f(zc[(size_t)(t0 - 1) * ZS]) : 0.f;
        float x0 = bf2f(zc[(size_t)t0 * ZS]);
#pragma unroll
        for (int i = 0; i < TPT; ++i) {
            const int t = t0 + i;
            const float xp = (t + 1 < L) ? bf2f(zc[(size_t)(t + 1) * ZS]) : 0.f;
            o[i] = w0 * xm + w1 * x0 + w2 * xp + bs;
            xm = x0; x0 = xp;
        }
    };
    {
        float v0[TPT], v1[TPT];
        sconv(2, 0, v0); sconv(2, 1, v1);
#pragma unroll
        for (int i = 0; i < TPT; ++i) u2[t0 + i] = make_float2(v0[i], v1[i]);
    }
#pragma unroll 1
    for (int o = 0; o < 2; ++o) {
        const float* hf = F + ((size_t)(o * 2 + 0) * 256 + c) * L;
        const float* hbk = F + ((size_t)(o * 2 + 1) * 256 + c) * L;
        for (int k = tid; k < 2 * L; k += NTHREADS) {
            const int dd = k - (L - 1);
            taps[k] = (dd >= L) ? 0.f : (dd >= 0 ? hf[dd] : hbk[-dd]);
        }
        __syncthreads();
        float acc[TPT][2];
#pragma unroll
        for (int i = 0; i < TPT; ++i) { acc[i][0] = 0.f; acc[i][1] = 0.f; }
        if (L == 4096) {
#pragma unroll 1
            for (int s0 = 0; s0 < L; s0 += 16) {
                const int k0 = t0 - s0 + (L - 16);
                float W[32];
#pragma unroll
                for (int q = 0; q < 8; ++q) {
                    const float4 t4 = *reinterpret_cast<const float4*>(taps + k0 + q * 4);
                    W[q * 4] = t4.x; W[q * 4 + 1] = t4.y; W[q * 4 + 2] = t4.z; W[q * 4 + 3] = t4.w;
                }
#pragma unroll
                for (int j = 0; j < 16; ++j) {
                    const float2 uj = u2[s0 + j];
#pragma unroll
                    for (int i = 0; i < TPT; ++i) {
                        const float wv = W[(i - j + 15) & 31];
                        acc[i][0] += wv * uj.x; acc[i][1] += wv * uj.y;
                    }
                }
            }
        } else {
            for (int s = 0; s < L; ++s) {
                const float2 uj = u2[s];
                const float wv = taps[t0 - s + (L - 1)];
                acc[0][0] += wv * uj.x; acc[0][1] += wv * uj.y;
            }
        }
        const float sk = p.in(I_HY_SKIP)[(size_t)(l * 2 + o) * 256 + c];
        float res[TPT][2];
        {
            float g0[TPT], g1[TPT];
            sconv(o, 0, g0); sconv(o, 1, g1);
#pragma unroll
            for (int i = 0; i < TPT; ++i) {
                const float2 ut = u2[t0 + i];
                res[i][0] = g0[i] * (acc[i][0] + sk * ut.x);
                res[i][1] = g1[i] * (acc[i][1] + sk * ut.y);
            }
        }
        __syncthreads();
        if (o == 0) {
#pragma unroll
            for (int i = 0; i < TPT; ++i) u2[t0 + i] = make_float2(res[i][0], res[i][1]);
        } else {
#pragma unroll
            for (int i = 0; i < TPT; ++i) {
                cat[(size_t)(base[0] + t0 + i) * DM + 512 + c] = f2bf(res[i][0]);
                cat[(size_t)(base[1] + t0 + i) * DM + 512 + c] = f2bf(res[i][1]);
            }
        }
        __syncthreads();
    }
}


#define FFT_BS 272
__device__ __forceinline__ int fphys(int d2, int d1, int d0) { return d2 * FFT_BS + d1 * 17 + d0; }
__device__ __forceinline__ float2 cmulf(float2 a, float2 b) { return make_float2(a.x * b.x - a.y * b.y, a.x * b.y + a.y * b.x); }
__device__ static constexpr float C32T[16] = {1.000000000e+00f, 9.807852804e-01f, 9.238795325e-01f, 8.314696123e-01f, 7.071067812e-01f, 5.555702330e-01f, 3.826834324e-01f, 1.950903220e-01f, 6.123233996e-17f, -1.950903220e-01f, -3.826834324e-01f, -5.555702330e-01f, -7.071067812e-01f, -8.314696123e-01f, -9.238795325e-01f, -9.807852804e-01f};
__device__ static constexpr float S32T[16] = {0.000000000e+00f, 1.950903220e-01f, 3.826834324e-01f, 5.555702330e-01f, 7.071067812e-01f, 8.314696123e-01f, 9.238795325e-01f, 9.807852804e-01f, 1.000000000e+00f, 9.807852804e-01f, 9.238795325e-01f, 8.314696123e-01f, 7.071067812e-01f, 5.555702330e-01f, 3.826834324e-01f, 1.950903220e-01f};
template <int LOG> __device__ __forceinline__ constexpr int brev(int i) { int r = 0; for (int b = 0; b < LOG; ++b) r |= ((i >> b) & 1) << (LOG - 1 - b); return r; }
template <int R, bool INV> __device__ __forceinline__ void dftR(float2 (&v)[R]) {
    constexpr int LOG = (R == 32) ? 5 : 4;
    float2 t[R];
#pragma unroll
    for (int i = 0; i < R; ++i) t[brev<LOG>(i)] = v[i];
#pragma unroll
    for (int st = 1; st <= LOG; ++st) {
        const int len = 1 << st, half = len >> 1;
#pragma unroll
        for (int i = 0; i < R; i += len)
#pragma unroll
            for (int j = 0; j < half; ++j) {
                const int tw = j * (32 / len);
                const float2 a = t[i + j], b = t[i + j + half];
                float2 bw;
                if (tw == 0) bw = b;
                else if (tw == 8) bw = INV ? make_float2(-b.y, b.x) : make_float2(b.y, -b.x);
                else { const float wr = C32T[tw], wi = INV ? S32T[tw] : -S32T[tw]; bw = make_float2(b.x * wr - b.y * wi, b.x * wi + b.y * wr); }
                t[i + j] = make_float2(a.x + bw.x, a.y + bw.y);
                t[i + j + half] = make_float2(a.x - bw.x, a.y - bw.y);
            }
    }
#pragma unroll
    for (int i = 0; i < R; ++i) v[i] = t[i];
}
template <int R> __device__ __forceinline__ void twiddle_pow(float2 (&v)[R], float2 first, float2 base) {
    float2 w = first;
#pragma unroll
    for (int k = 0; k < R; ++k) { v[k] = cmulf(v[k], w); w = cmulf(w, base); }
}
__device__ __forceinline__ float2 cispi(float x) { float sn, cs; sincospif(x, &sn, &cs); return make_float2(cs, sn); }

__device__ __forceinline__ void fft_fwd_A_B1(float2 (&v)[32], float2* buf, int tid_in) {
    int tid = tid_in; asm volatile("" : "+v"(tid));
    const int a = tid >> 4, b = tid & 15;
    dftR<32, false>(v);
    twiddle_pow<32>(v, make_float2(1.f, 0.f), cispi(-2.f * (float)tid * (1.f / 8192.f)));
#pragma unroll
    for (int k1 = 0; k1 < 32; ++k1) buf[fphys(k1, a, b)] = v[k1];
    __syncthreads();
#pragma unroll 1
    for (int j = 0; j < 2; ++j) {
        const int g = tid + 256 * j, k1 = g >> 4, bb = g & 15;
        float2 w[16];
#pragma unroll
        for (int aa = 0; aa < 16; ++aa) w[aa] = buf[fphys(k1, aa, bb)];
        dftR<16, false>(w);
        twiddle_pow<16>(w, make_float2(1.f, 0.f), cispi(-2.f * (float)bb * (1.f / 256.f)));
#pragma unroll
        for (int ka = 0; ka < 16; ++ka) buf[fphys(k1, ka, bb)] = w[ka];
    }
    __syncthreads();
}
__device__ __forceinline__ void fft_inv_B1_A(float2 (&v)[32], float2* buf, int tid_in) {
    int tid = tid_in; asm volatile("" : "+v"(tid));
#pragma unroll 1
    for (int j = 0; j < 2; ++j) {
        const int g = tid + 256 * j, k1 = g >> 4, bb = g & 15;
        float2 w[16];
#pragma unroll
        for (int ka = 0; ka < 16; ++ka) w[ka] = buf[fphys(k1, ka, bb)];
        dftR<16, true>(w);
        twiddle_pow<16>(w, cispi(2.f * (float)(k1 * bb) * (1.f / 8192.f)), cispi(2.f * (float)k1 * (1.f / 512.f)));
#pragma unroll
        for (int aa = 0; aa < 16; ++aa) buf[fphys(k1, aa, bb)] = w[aa];
    }
    __syncthreads();
    const int a = tid >> 4, b = tid & 15;
#pragma unroll
    for (int k1 = 0; k1 < 32; ++k1) v[k1] = buf[fphys(k1, a, b)];
    dftR<32, true>(v);
}

__device__ __forceinline__ void hfft_unit(const P& p, int l, int u, char* lds) {
    const int tid = otid();
    float2* buf = (float2*)lds;
    float* F = (float*)(p.ws + WS_FILTL) + (size_t)u * 8192;
    float2 v[32];
#pragma unroll
    for (int n1 = 0; n1 < 32; ++n1) {
        const int n = 256 * n1 + tid;
        float x;
        if (n1 < 16) x = F[n];
        else x = (n == 4096) ? 0.f : F[4096 + (8192 - n)];
        if (n == 0) x += p.in(I_HY_SKIP)[(size_t)l * 512 + u];
        v[n1] = make_float2(x, 0.f);
    }
    fft_fwd_A_B1(v, buf, tid);
    __half2* H = (__half2*)F;
#pragma unroll 1
    for (int j = 0; j < 2; ++j) {
        const int g = tid + 256 * j, k1 = g >> 4, ka = g & 15;
        float2 w[16];
#pragma unroll
        for (int bb = 0; bb < 16; ++bb) w[bb] = buf[fphys(k1, ka, bb)];
        dftR<16, false>(w);
        unsigned pk[16];
#pragma unroll
        for (int kb = 0; kb < 16; ++kb) { const __half2 h = __floats2half2_rn(w[kb].x, w[kb].y); pk[kb] = *reinterpret_cast<const unsigned*>(&h); }
        uint4* dst = reinterpret_cast<uint4*>(H + (size_t)g * 16);
        dst[0] = make_uint4(pk[0], pk[1], pk[2], pk[3]); dst[1] = make_uint4(pk[4], pk[5], pk[6], pk[7]);
        dst[2] = make_uint4(pk[8], pk[9], pk[10], pk[11]); dst[3] = make_uint4(pk[12], pk[13], pk[14], pk[15]);
    }
    __syncthreads();
}

__device__ __forceinline__ void hyena_prep_unit(const P& p, int l, int u, char* lds) {
    const int tid = otid();
    bf16_t* tile = (bf16_t*)lds;
    const int b = u >> 6, t0 = (u & 63) * 64;
    const bf16_t* z = (const bf16_t*)(p.ws + WS_Z) + (size_t)(NTC + b * 4096) * ZS + COL_HY;
    bf16_t* hyT = (bf16_t*)(p.ws + WS_HYT);
    const float* cw = p.in(I_HY_CONV) + (size_t)l * 3 * 768; const float* cb = p.in(I_HY_CONVB) + (size_t)l * 768;
    const int tl = tid >> 5, cg = tid & 31;
#pragma unroll 1
    for (int part = 0; part < 3; ++part) {
        const int ch0 = part * 256 + cg * 8;
        float w0[8], w1[8], w2[8], bs[8];
#pragma unroll
        for (int i = 0; i < 8; ++i) { w0[i] = cw[ch0 + i]; w1[i] = cw[768 + ch0 + i]; w2[i] = cw[1536 + ch0 + i]; bs[i] = cb[ch0 + i]; }
#pragma unroll 2
        for (int it = 0; it < 8; ++it) {
            const int tk = it * 8 + tl, t = t0 + tk;
            const bf16_t* zc = z + (size_t)t * ZS + ch0;
            const uint4 zero4 = make_uint4(0u, 0u, 0u, 0u);
            const uint4 vm = (t > 0) ? *reinterpret_cast<const uint4*>(zc - ZS) : zero4;
            const uint4 v0 = *reinterpret_cast<const uint4*>(zc);
            const uint4 vp = (t + 1 < 4096) ? *reinterpret_cast<const uint4*>(zc + ZS) : zero4;
            float xm[8], x0[8], xp[8];
            unpack8(vm, xm); unpack8(v0, x0); unpack8(vp, xp);
#pragma unroll
            for (int i = 0; i < 8; ++i) tile[(cg * 8 + i) * 72 + tk] = f2bf(w0[i] * xm[i] + w1[i] * x0[i] + w2[i] * xp[i] + bs[i]);
        }
        __syncthreads();
#pragma unroll
        for (int k = 0; k < 8; ++k) {
            const int chl = (tid >> 3) + 32 * k, seg = tid & 7;
            const uint4 val = *reinterpret_cast<const uint4*>(tile + chl * 72 + seg * 8);
            *reinterpret_cast<uint4*>(hyT + ((size_t)(b * 3 + part) * 256 + chl) * 4096 + t0 + seg * 8) = val;
        }
        __syncthreads();
    }
}

template <int O>
__device__ __forceinline__ void hyena_conv_pass(const P& p, int c, int bp, int tid, float2 (&v)[32], float2* buf) {
    const bf16_t* hyT = (const bf16_t*)(p.ws + WS_HYT);
#pragma unroll
    for (int j = 16; j < 32; ++j) v[j] = make_float2(0.f, 0.f);
    fft_fwd_A_B1(v, buf, tid);
    const __half2* H = (const __half2*)((const float*)(p.ws + WS_FILTL) + (size_t)(O * 256 + c) * 8192);
    int tm = tid; asm volatile("" : "+v"(tm));
#pragma unroll 1
    for (int j = 0; j < 2; ++j) {
        const int g = tm + 256 * j, k1 = g >> 4, ka = g & 15;
        float2 w[16];
#pragma unroll
        for (int bb = 0; bb < 16; ++bb) w[bb] = buf[fphys(k1, ka, bb)];
        dftR<16, false>(w);
        const uint4* hp = reinterpret_cast<const uint4*>(H + (size_t)g * 16);
        unsigned hk[16];
#pragma unroll
        for (int q = 0; q < 4; ++q) { const uint4 t4 = hp[q]; hk[q * 4] = t4.x; hk[q * 4 + 1] = t4.y; hk[q * 4 + 2] = t4.z; hk[q * 4 + 3] = t4.w; }
#pragma unroll
        for (int kb = 0; kb < 16; ++kb) { const float2 hf = __half22float2(*reinterpret_cast<const __half2*>(&hk[kb])); w[kb] = cmulf(w[kb], hf); }
        dftR<16, true>(w);
        twiddle_pow<16>(w, make_float2(1.f, 0.f), cispi(2.f * (float)ka * (1.f / 256.f)));
#pragma unroll
        for (int bb = 0; bb < 16; ++bb) buf[fphys(k1, ka, bb)] = w[bb];
    }
    __syncthreads();
    fft_inv_B1_A(v, buf, tid);
    asm volatile("" ::: "memory");
    int tq = tid; asm volatile("" : "+v"(tq));
    const bf16_t* g0 = hyT + ((size_t)((bp * 2 + 0) * 3 + O) * 256 + c) * 4096 + tq;
    const bf16_t* g1 = hyT + ((size_t)((bp * 2 + 1) * 3 + O) * 256 + c) * 4096 + tq;
    const float sc = 1.f / 8192.f;
#pragma unroll
    for (int j = 0; j < 16; ++j) {
        const float ga = bf2f(g0[256 * j]) * sc, gb = bf2f(g1[256 * j]) * sc;
        v[j] = make_float2(ga * v[j].x, gb * v[j].y);
    }
    __syncthreads();
}

__device__ __forceinline__ void hyena_fft_unit(const P& p, int l, int u, char* lds) {
    const int tid = otid();
    const int c = u >> 2, bp = u & 3;
    float2* buf = (float2*)lds;
    const bf16_t* hyT = (const bf16_t*)(p.ws + WS_HYT);
    bf16_t* cat = (bf16_t*)(p.ws + WS_CAT);
    float2 v[32];
    {
        const bf16_t* v0p = hyT + ((size_t)((bp * 2 + 0) * 3 + 2) * 256 + c) * 4096 + tid;
        const bf16_t* v1p = hyT + ((size_t)((bp * 2 + 1) * 3 + 2) * 256 + c) * 4096 + tid;
#pragma unroll
        for (int j = 0; j < 16; ++j) v[j] = make_float2(bf2f(v0p[256 * j]), bf2f(v1p[256 * j]));
    }
    hyena_conv_pass<0>(p, c, bp, tid, v, buf);
    hyena_conv_pass<1>(p, c, bp, tid, v, buf);
    int tq = tid; asm volatile("" : "+v"(tq));
#pragma unroll
    for (int j = 0; j < 16; ++j) {
        const int t = tq + 256 * j;
        cat[(size_t)(NTC + (bp * 2 + 0) * 4096 + t) * DM + 512 + c] = f2bf(v[j].x);
        cat[(size_t)(NTC + (bp * 2 + 1) * 4096 + t) * DM + 512 + c] = f2bf(v[j].y);
    }
}

__device__ __forceinline__ void rwkv_post_unit(const P& p, int l, int u, char* lds) {
    const int tid = otid();
    bf16_t* sgb = (bf16_t*)lds;
    float* gt = (float*)(lds + 4608);
    const bf16_t* z = (const bf16_t*)(p.ws + WS_Z);
    const bf16_t* rwp = (const bf16_t*)(p.ws + WS_R1 + R1_RWP);
    const bf16_t* ys = (const bf16_t*)(p.ws + WS_HBY);
    bf16_t* cat = (bf16_t*)(p.ws + WS_CAT);
    const int row0 = u * 32;
    {
        const int tok = tid >> 3, j0 = (tid & 7) * 8;
        float gl[8];
        unpack8(*reinterpret_cast<const uint4*>(z + (size_t)(row0 + tok) * ZS + 896 + j0), gl);
#pragma unroll
        for (int i = 0; i < 8; ++i) gl[i] = sigm(gl[i]);
        *reinterpret_cast<uint4*>(sgb + tok * 72 + j0) = pack8(gl);
    }
    __syncthreads();
    {
        const int w = tid >> 6, lane = tid & 63, fr = lane & 15, fq = lane >> 4;
        const bf16_t* g2t = (const bf16_t*)(p.ws + WS_G2T) + (size_t)l * 256 * 64;
        f32x4 acc[2][4];
#pragma unroll
        for (int mf = 0; mf < 2; ++mf)
#pragma unroll
            for (int nf = 0; nf < 4; ++nf) acc[mf][nf] = f32x4{0.f, 0.f, 0.f, 0.f};
#pragma unroll
        for (int ks = 0; ks < 2; ++ks) {
            bf16x8 af[2], bfr[4];
#pragma unroll
            for (int mf = 0; mf < 2; ++mf) af[mf] = *reinterpret_cast<const bf16x8*>(sgb + (mf * 16 + fr) * 72 + ks * 32 + fq * 8);
#pragma unroll
            for (int nf = 0; nf < 4; ++nf) bfr[nf] = *reinterpret_cast<const bf16x8*>(g2t + (size_t)(w * 64 + nf * 16 + fr) * 64 + ks * 32 + fq * 8);
#pragma unroll
            for (int mf = 0; mf < 2; ++mf)
#pragma unroll
                for (int nf = 0; nf < 4; ++nf) acc[mf][nf] = __builtin_amdgcn_mfma_f32_16x16x32_bf16(af[mf], bfr[nf], acc[mf][nf], 0, 0, 0);
        }
#pragma unroll
        for (int mf = 0; mf < 2; ++mf)
#pragma unroll
            for (int nf = 0; nf < 4; ++nf)
#pragma unroll
                for (int j = 0; j < 4; ++j) gt[(mf * 16 + fq * 4 + j) * 264 + w * 64 + nf * 16 + fr] = acc[mf][nf][j];
    }
    __syncthreads();
    {
        const int tl = tid >> 5, cg = tid & 31, c0 = cg * 8;
        float ka[8], rk[8], gng[8], gnb[8];
#pragma unroll
        for (int i = 0; i < 8; ++i) {
            ka[i] = p.in(I_RW_KA)[l * 256 + c0 + i]; rk[i] = p.in(I_RW_RK)[l * 256 + c0 + i];
            gng[i] = p.in(I_RW_GNG)[l * 256 + c0 + i]; gnb[i] = p.in(I_RW_GNB)[l * 256 + c0 + i];
        }
#pragma unroll 2
        for (int it = 0; it < 4; ++it) {
            const int tok = it * 8 + tl, row = row0 + tok;
            float ya[8], yb[8], r[8], k[8], v[8], a0[8], a1[8], o[8];
            unpack8(*reinterpret_cast<const uint4*>(ys + (size_t)row * 256 + c0), ya);
            unpack8(*reinterpret_cast<const uint4*>(ys + (size_t)NT * 256 + (size_t)row * 256 + c0), yb);
            const bf16_t* zr = z + (size_t)row * ZS + c0;
            unpack8(*reinterpret_cast<const uint4*>(zr), r);
            unpack8(*reinterpret_cast<const uint4*>(zr + 256), k);
            unpack8(*reinterpret_cast<const uint4*>(zr + 512), v);
            unpack8(*reinterpret_cast<const uint4*>(rwp + ((size_t)row * 4 + 2) * 256 + c0), a0);
            unpack8(*reinterpret_cast<const uint4*>(rwp + ((size_t)row * 4 + 3) * 256 + c0), a1);
            float sy = 0.f, sd = 0.f;
#pragma unroll
            for (int i = 0; i < 8; ++i) {
                ya[i] += yb[i]; sy += ya[i];
                const float kd = k[i] * (1.f + (a0[i] - 1.f) * ka[i]) + k[i] * (1.f + (a1[i] - 1.f) * ka[i]);
                sd += r[i] * kd * rk[i];
            }
            const float mu = sum8lanes(sy) * (1.f / 64.f);
            const float dot = sum8lanes(sd);
            float sq = 0.f;
#pragma unroll
            for (int i = 0; i < 8; ++i) { ya[i] -= mu; sq += ya[i] * ya[i]; }
            const float rs = rsqrtf(sum8lanes(sq) * (1.f / 64.f) + 64e-5f);
            const float4 g0 = *reinterpret_cast<const float4*>(gt + tok * 264 + c0), g1 = *reinterpret_cast<const float4*>(gt + tok * 264 + c0 + 4);
            const float gg[8] = {g0.x, g0.y, g0.z, g0.w, g1.x, g1.y, g1.z, g1.w};
#pragma unroll
            for (int i = 0; i < 8; ++i) o[i] = (ya[i] * rs * gng[i] + gnb[i] + dot * v[i]) * gg[i];
            *reinterpret_cast<uint4*>(cat + (size_t)row * DM + c0) = pack8(o);
        }
    }
    __syncthreads();
}

__device__ __forceinline__ void gdn_post_unit(const P& p, int l, int u) {
    const int tid = otid();
    const bf16_t* z = (const bf16_t*)(p.ws + WS_Z);
    const bf16_t* ys = (const bf16_t*)(p.ws + WS_HBY) + (size_t)2 * NT * 256;
    bf16_t* cat = (bf16_t*)(p.ws + WS_CAT);
    const int tl = tid >> 5, cg = tid & 31, c0 = cg * 8;
    float ng[8];
#pragma unroll
    for (int i = 0; i < 8; ++i) ng[i] = p.in(I_GD_NORM)[l * 64 + ((c0 + i) & 63)];
    const int row0 = u * 32;
#pragma unroll 2
    for (int it = 0; it < 4; ++it) {
        const int row = row0 + it * 8 + tl;
        const uint4 a4 = *reinterpret_cast<const uint4*>(ys + (size_t)row * 256 + c0);
        const uint4 b4 = *reinterpret_cast<const uint4*>(ys + (size_t)NT * 256 + (size_t)row * 256 + c0);
        const uint4 z4 = *reinterpret_cast<const uint4*>(z + (size_t)row * ZS + COL_GD + 768 + c0);
        float a[8], b[8], zg[8], o[8];
        unpack8(a4, a); unpack8(b4, b); unpack8(z4, zg);
        float ss = 0.f;
#pragma unroll
        for (int i = 0; i < 8; ++i) { o[i] = a[i] + b[i]; ss += o[i] * o[i]; }
        ss = sum8lanes(ss);
        const float sc = rsqrtf(ss * (1.f / 64.f) + 1e-6f);
#pragma unroll
        for (int i = 0; i < 8; ++i) o[i] = o[i] * sc * ng[i] * siluf(zg[i]);
        *reinterpret_cast<uint4*>(cat + (size_t)row * DM + 256 + c0) = pack8(o);
    }
}

__device__ __forceinline__ void load_tile_bases(unsigned* ctl, int l, int* tb) {
    const int tid = otid();
    __syncthreads();
    if (tid < 64) { const int c = (int)xb_ld(&ctl[CW_CNT(l) + tid]); tb[130 + tid] = c; tb[66 + tid] = (c + 127) >> 7; }
    __syncthreads();
    if (tid == 0) { int a = 0; for (int e = 0; e < 64; ++e) { tb[e] = a; a += tb[66 + e]; } tb[64] = a; }
    __syncthreads();
}

#define NPHASE 36
template <typename F>
__device__ __forceinline__ void strided(int n, F f) { for (int u = blockIdx.x; u < n; u += gridDim.x) f(u); }

__global__ void __launch_bounds__(NTHREADS, 2) fwd_kernel(KP kp) {
    extern __shared__ __attribute__((aligned(16))) char smem[];
    char* lds = smem + LDS_USER;
    {
    const int tid = otid();
    if (tid == 0) *reinterpret_cast<uint4*>(smem) = make_uint4(0u, 0u, 0u, 0u);
    if (tid < 52) { const unsigned long long v = (unsigned long long)kp.in[tid]; ((unsigned*)(smem + 512))[2 * tid] = (unsigned)v; ((unsigned*)(smem + 512))[2 * tid + 1] = (unsigned)(v >> 32); }
    }
    __syncthreads();
    P p; p.tab = (const __attribute__((address_space(3))) unsigned*)(smem + 512); p.out = kp.out; p.ws = kp.ws;
    unsigned* ctl = (unsigned*)(p.ws + WS_CTL);
    XcdBarrier bar = xcd_barrier_post(ctl, (volatile LAS unsigned*)smem);
    const int lo = kp.ph_lo, hi = kp.ph_hi;
#define PHASE_BEGIN(ph) if ((ph) >= lo && (ph) < hi) { if ((ph) > lo) { xcd_barrier(bar); }
#define PHASE_END }
#define LANE_IDS const int tid = otid(); const int wid = tid >> 6, lane = tid & 63, wr = wid >> 1, wc = wid & 1, fr = lane & 15, fq = lane >> 4; (void)wid; (void)lane; (void)wr; (void)wc; (void)fr; (void)fq;

    PHASE_BEGIN(0)
        strided(192 + 64 + 32 + 24, [&](int u) {
            if (u < 192) ph0_mod_unit(p, u, lds);
            else if (u < 256) ph0_s5tab_unit(p, u - 192);
            else if (u >= 288) { const int v = u - 288, which = v >> 3, ll = (v >> 2) & 1, t = v & 3;
                   const float* src = (which == 0 ? p.in(I_RW_G2) : which == 1 ? p.in(I_RW_W2) : p.in(I_RW_A2)) + (size_t)ll * 64 * 256;
                   bf16_t* dst = (bf16_t*)(p.ws + (which == 0 ? WS_G2T : which == 1 ? WS_LW2T : WS_LA2T)) + (size_t)ll * 256 * 64;
                   xpose_tile(src, 256, dst, 64, 0, 0, t, lds); }
            else { const int v = u - 256, ll = v >> 4, t = v & 15;
                   xpose_tile(p.in(I_S5_GLUW) + (size_t)ll * 65536, 256, (bf16_t*)(p.ws + WS_GLUT) + (size_t)ll * 65536, 256, 0, t >> 2, t & 3, lds); }
        });
    PHASE_END

#pragma unroll 1
    for (int l = 0; l < 2; ++l) {
        const int pb = 1 + 17 * l;
        PHASE_BEGIN(pb + 0)
            strided(4352 + 1088 + 768 + 256, [&](int u) {
                if (u < 4352) { if (l == 0) rows_unit<M_INIT>(p, l, u, lds); else rows_unit<M_LN2NEXT>(p, l, u, lds); }
                else if (u < 5440) filt_unit(p, l, u - 4352, lds);
                else if (u < 6208) { const int v = u - 5440; xpose_tile(p.in(I_WIN) + (size_t)l * 1024 * 3024, 3024, (bf16_t*)(p.ws + WS_WINT), 1024, 0, v / 48, v % 48, lds); }
                else { const int v = u - 6208; xpose_tile(p.in(I_WOUT) + (size_t)l * 1024 * 1024, 1024, (bf16_t*)(p.ws + WS_WOUTT), 1024, 0, v >> 4, v & 15, lds); }
            });
        PHASE_END
        PHASE_BEGIN(pb + 1)
            strided(272 * 24, [&](int u) {
                LANE_IDS
                const int q_ = u >> 3, g_ = q_ / 12;
                const int mt = (g_ % 34) * 8 + (u & 7), nt = (g_ / 34) * 12 + (q_ % 12);
                f32x4 acc[4][4];
                gemm_tile((const bf16_t*)(p.ws + WS_HBY), DM, arows_lin(mt * 128, tid),
                          (const bf16_t*)(p.ws + WS_WINT), DM, nt * 128, DM, lds, acc);
                bf16_t* z = (bf16_t*)(p.ws + WS_Z);
#pragma unroll
                for (int m = 0; m < 4; ++m)
#pragma unroll
                    for (int n = 0; n < 4; ++n) {
                        const int col = nt * 128 + wc * 64 + n * 16 + fr;
                        if (col < ZS) {
#pragma unroll
                            for (int j = 0; j < 4; ++j) z[(size_t)(mt * 128 + wr * 64 + m * 16 + fq * 4 + j) * ZS + col] = f2bf(acc[m][n][j]);
                        }
                    }
            });
        PHASE_END
        PHASE_BEGIN(pb + 2)
            strided(512 + 512 + 1088 + 1088 + 4352, [&](int u) {
                if (u < 512) { if (kp.rep == 0) hfft_unit(p, l, u, lds); }
                else if (u < 1024) hyena_prep_unit(p, l, u - 512, lds);
                else if (u < 2112) rwkv_prep_unit(p, l, u - 1024, lds);
                else if (u < 3200) gdn_prep_unit(p, l, u - 2112);
                else s5_pre_unit(p, l, u - 3200, lds);
            });
        PHASE_END
        PHASE_BEGIN(pb + 3)
            {
                int* qslot = (int*)(smem + 64);
                const int NO = 1024 + 544 + 1024;
                if (otid() == 0) {
                    const unsigned hw = (unsigned)__builtin_amdgcn_s_getreg((7 << 11) | (8 << 6) | 4);
                    const unsigned cuix = ((xb_xcc_id() & 15u) << 8) | (hw & 255u);
                    qslot[1] = (atomicAdd(&ctl[CW_CUCNT(l) + cuix], 1u) % 2u == 0u) ? 0 : 1;
                }
                __syncthreads();
                for (;;) {
                    if (otid() == 0) {
                        int stage = qslot[1], t = -1;
                        while (t < 0 && stage < 3) {
                            if (stage == 1) { const int q = (int)atomicAdd(&ctl[CW_QUEUE(l) + 16 + kp.rep], 1u); if (q < NO) t = 256 + (q < 544 ? 1024 + q : (q < 1568 ? q - 544 : q)); else stage = 2; }
                            else { const int q = (int)atomicAdd(&ctl[CW_QUEUE(l) + kp.rep], 1u); if (q < 256) t = q; else stage = (stage == 0) ? 1 : 3; }
                        }
                        qslot[1] = stage; qslot[0] = t;
                    }
                    __syncthreads();
                    const int u = qslot[0];
                    __syncthreads();
                    if (u < 0) break;
                    if (u < 256) { if (kp.rep != 2) scan_unit(p, l, u, lds); }
                    else if (kp.rep == 1) {}
                    else if (u < 1280) hyena_fft_unit(p, l, u - 256, lds);
                    else if (u < 1824) s5_main_unit(p, l, u - 1280, lds);
                    else hyena_unit<256>(p, l, u - 1824, lds);
                    __syncthreads();
                }
            }
        PHASE_END
        PHASE_BEGIN(pb + 4)
            strided(1088 + 1088 + 544, [&](int u) {
                if (u < 1088) rwkv_post_unit(p, l, u, lds);
                else if (u < 2176) gdn_post_unit(p, l, u - 1088);
                else {
                    LANE_IDS
                    const int v = u - 2176, mt = v >> 1, nt = v & 1;
                    f32x4 acc[4][4];
                    const bf16_t* A = (const bf16_t*)(p.ws + WS_S5G);
                    gemm_tile(A, 256, arows_lin(mt * 128, tid),
                              (const bf16_t*)(p.ws + WS_GLUT) + (size_t)l * 65536, 256, nt * 128, 256, lds, acc);
                    bf16_t* cat = (bf16_t*)(p.ws + WS_CAT);
#pragma unroll
                    for (int m = 0; m < 4; ++m)
#pragma unroll
                        for (int n = 0; n < 4; ++n) {
                            const int col = nt * 128 + wc * 64 + n * 16 + fr;
                            const float gb = p.in(I_S5_GLUB)[l * 256 + col];
#pragma unroll
                            for (int j = 0; j < 4; ++j) {
                                const int row = mt * 128 + wr * 64 + m * 16 + fq * 4 + j;
                                const float yg = bf2f(A[(size_t)row * 256 + col]);
                                cat[(size_t)row * DM + 768 + col] = f2bf(yg * sigm(acc[m][n][j] + gb));
                            }
                        }
                }
            });
        PHASE_END
        PHASE_BEGIN(pb + 5)
            strided(272 * 8 + 65 * 192, [&](int u) {
                if (u < 2176) {
                    LANE_IDS
                    const int mt = ((u >> 3) >> 3) * 8 + (u & 7), nt = (u >> 3) & 7;
                    f32x4 acc[4][4];
                    gemm_tile((const bf16_t*)(p.ws + WS_CAT), DM, arows_lin(mt * 128, tid),
                              (const bf16_t*)(p.ws + WS_WOUTT), DM, nt * 128, DM, lds, acc);
#pragma unroll
                    for (int m = 0; m < 4; ++m)
#pragma unroll
                        for (int j = 0; j < 4; ++j) {
                            const int row = mt * 128 + wr * 64 + m * 16 + fq * 4 + j;
                            float* xr = xrow(p, row);
                            const float* ga = modp(p, l, row_mod(row), 2);
#pragma unroll
                            for (int n = 0; n < 4; ++n) {
                                const int col = nt * 128 + wc * 64 + n * 16 + fr;
                                { const float ca = kp.rep ? 1.f : ALPHA, cb2 = kp.rep ? 0.f : 1.f; xr[col] = ca * xr[col] + cb2 * ga[col] * acc[m][n][j]; }
                            }
                        }
                } else {
                    const int v = u - 2176, e = v / 192, t = v % 192, which = t >> 6, tt = t & 63;
                    bf16_t* W13 = (bf16_t*)(p.ws + WS_R1 + R1_W13T) + (size_t)e * 512 * 1024;
                    bf16_t* W2 = (bf16_t*)(p.ws + WS_R1 + R1_W2T) + (size_t)e * 1024 * 256;
                    if (which == 0) {
                        const float* src = (e < 64) ? p.in(I_EX_W1) + ((size_t)l * 64 + e) * 262144 : p.in(I_SH_W1) + (size_t)l * 262144;
                        xpose_tile(src, 256, W13, 1024, 1, tt >> 2, tt & 3, lds);
                    } else if (which == 1) {
                        const float* src = (e < 64) ? p.in(I_EX_W3) + ((size_t)l * 64 + e) * 262144 : p.in(I_SH_W3) + (size_t)l * 262144;
                        xpose_tile(src, 256, W13, 1024, 2, tt >> 2, tt & 3, lds);
                    } else {
                        const float* src = (e < 64) ? p.in(I_EX_W2) + ((size_t)l * 64 + e) * 262144 : p.in(I_SH_W2) + (size_t)l * 262144;
                        xpose_tile(src, 1024, W2, 256, 0, tt >> 4, tt & 15, lds);
                    }
                }
            });
        PHASE_END
        PHASE_BEGIN(pb + 6)
            strided(4352, [&](int u) { rows_unit<M_LN1>(p, l, u, lds, kp.rep > 0); __syncthreads(); });
        PHASE_END
        PHASE_BEGIN(pb + 8)
            {
                int* tbs = (int*)(smem + 1024);
                load_tile_bases(ctl, l, tbs);
                const int ntr = tbs[64];
                const int* rtok = (const int*)(p.ws + WS_RTOK);
                const int ntl1 = ntr + 272;
                strided(((ntl1 + 7) >> 3) * 32, [&](int u) {
                    const int tile = ((u >> 3) >> 2) * 8 + (u & 7), jn = (u >> 3) & 3;
                    if (tile >= ntl1) return;
                    LANE_IDS
                    int e, obase; ARows ar;
                    if (tile < ntr) {
                        e = 0;
#pragma unroll 1
                        for (int s2 = 32; s2 >= 1; s2 >>= 1) if (tbs[e + s2] <= tile) e += s2;
                        obase = tile * 128;
                        const int pos0 = (tile - tbs[e]) * 128, ce = tbs[130 + e];
#pragma unroll
                        for (int i = 0; i < 4; ++i) { const int ps = pos0 + (tid >> 3) + 32 * i; ar.r[i] = (ps < ce) ? rtok[(size_t)e * NT + ps] : 0; }
                    } else {
                        const int stt = tile - ntr; e = 64; obase = (SH_TILE_BASE + stt) * 128;
                        ar = arows_lin(stt * 128, tid);
                    }
                    f32x4 acc[4][4];
                    gemm_tile((const bf16_t*)(p.ws + WS_HBY), DM, ar,
                              (const bf16_t*)(p.ws + WS_R1 + R1_W13T) + (size_t)e * 512 * 1024, DM, jn * 128, DM, lds, acc);
                    bf16_t* act = (bf16_t*)(p.ws + WS_ACT);
#pragma unroll
                    for (int m = 0; m < 4; ++m)
#pragma unroll
                        for (int pp = 0; pp < 2; ++pp)
#pragma unroll
                            for (int j = 0; j < 4; ++j) {
                                const float g = acc[m][2 * pp][j], uu = acc[m][2 * pp + 1][j];
                                const int orow = obase + wr * 64 + m * 16 + fq * 4 + j;
                                const int col = jn * 64 + wc * 32 + pp * 16 + fr;
                                act[(size_t)orow * 256 + col] = f2bf(siluf(g) * uu);
                            }
                });
            }
        PHASE_END
#pragma unroll 1
        for (int sl = 0; sl < 4; ++sl) {
            PHASE_BEGIN(pb + 9 + 2 * sl)
            {
                int* tbs = (int*)(smem + 1024);
                load_tile_bases(ctl, l, tbs);
                const int ntr = tbs[64];
                const int ntl2 = ntr + 272;
                strided(((ntl2 + 7) >> 3) * 16, [&](int u) {
                    const int tile = ((u >> 3) >> 1) * 8 + (u & 7), nt2 = (u >> 3) & 1;
                    if (tile >= ntl2) return;
                    LANE_IDS
                    int e, obase;
                    if (tile < ntr) {
                        e = 0;
#pragma unroll 1
                        for (int s2 = 32; s2 >= 1; s2 >>= 1) if (tbs[e + s2] <= tile) e += s2;
                        obase = tile * 128;
                    }
                    else { e = 64; obase = (SH_TILE_BASE + tile - ntr) * 128; }
                    f32x4 acc[4][4];
                    gemm_tile((const bf16_t*)(p.ws + WS_ACT), 256, arows_lin(obase, tid),
                              (const bf16_t*)(p.ws + WS_R1 + R1_W2T) + (size_t)e * 1024 * 256, 256, sl * 256 + nt2 * 128, 256, lds, acc);
                    bf16_t* y2 = (bf16_t*)(p.ws + WS_Y2);
#pragma unroll
                    for (int m = 0; m < 4; ++m)
#pragma unroll
                        for (int j = 0; j < 4; ++j) {
                            const int orow = obase + wr * 64 + m * 16 + fq * 4 + j;
#pragma unroll
                            for (int n = 0; n < 4; ++n) y2[(size_t)orow * 256 + nt2 * 128 + wc * 64 + n * 16 + fr] = f2bf(acc[m][n][j]);
                        }
                });
            }
            PHASE_END
            PHASE_BEGIN(pb + 10 + 2 * sl)
            {
                int* tb = (int*)lds;
                const int tid = otid();
                const unsigned* cnt = ctl + CW_CNT(l);
                load_tile_bases(ctl, l, tb);
                const int* aep = (const int*)(p.ws + WS_AEP); const float* aw = (const float*)(p.ws + WS_AW);
                const bf16_t* y2 = (const bf16_t*)(p.ws + WS_Y2);
                const int tl = tid >> 5, cg = tid & 31;
                for (int grp = blockIdx.x; grp < NT / 8; grp += gridDim.x) {
                    const int tok = grp * 8 + tl;
                    float a8[8];
                    {
                        const uint4 sv = *reinterpret_cast<const uint4*>(y2 + ((size_t)(SH_TILE_BASE * 128 + tok)) * 256 + cg * 8);
                        a8[0] = bflo(sv.x); a8[1] = bfhi(sv.x); a8[2] = bflo(sv.y); a8[3] = bfhi(sv.y);
                        a8[4] = bflo(sv.z); a8[5] = bfhi(sv.z); a8[6] = bflo(sv.w); a8[7] = bfhi(sv.w);
                    }
#pragma unroll
                    for (int k = 0; k < 8; ++k) {
                        const unsigned v = (unsigned)aep[(size_t)tok * 8 + k];
                        const float wk = aw[(size_t)tok * 8 + k];
                        const int dest = tb[v >> 24] * 128 + (int)(v & 0xFFFFFFu);
                        const uint4 yv = *reinterpret_cast<const uint4*>(y2 + (size_t)dest * 256 + cg * 8);
                        a8[0] += wk * bflo(yv.x); a8[1] += wk * bfhi(yv.x); a8[2] += wk * bflo(yv.y); a8[3] += wk * bfhi(yv.y);
                        a8[4] += wk * bflo(yv.z); a8[5] += wk * bfhi(yv.z); a8[6] += wk * bflo(yv.w); a8[7] += wk * bfhi(yv.w);
                    }
                    float* xr = xrow(p, tok) + sl * 256 + cg * 8;
                    const float* ga = modp(p, l, row_mod(tok), 5) + sl * 256 + cg * 8;
                    float4 x0 = *reinterpret_cast<const float4*>(xr), x1 = *reinterpret_cast<const float4*>(xr + 4);
                    const float4 g0 = *reinterpret_cast<const float4*>(ga), g1 = *reinterpret_cast<const float4*>(ga + 4);
                    const float rs = kp.rep ? 0.f : 1.f;
                    x0.x += rs * g0.x * a8[0]; x0.y += rs * g0.y * a8[1]; x0.z += rs * g0.z * a8[2]; x0.w += rs * g0.w * a8[3];
                    x1.x += rs * g1.x * a8[4]; x1.y += rs * g1.y * a8[5]; x1.z += rs * g1.z * a8[6]; x1.w += rs * g1.w * a8[7];
                    *reinterpret_cast<float4*>(xr) = x0; *reinterpret_cast<float4*>(xr + 4) = x1;
                }
                __syncthreads();
            }
            PHASE_END
        }
    }
#if defined(PROBE_PH)
    if (lo >= 100) {
        float a0 = (float)otid(), a1 = a0 + 1.f, a2 = a0 + 2.f, a3 = a0 + 3.f, a4 = a0 + 4.f, a5 = a0 + 5.f, a6 = a0 + 6.f, a7 = a0 + 7.f;
        const float m = 0.999f, c = 0.5f;
        for (int it = 0; it < 10000; ++it) {
            if (lo == 100) {
#pragma unroll
                for (int q = 0; q < 64; ++q) asm volatile("v_fma_f32 %0, %0, %1, %2" : "+v"(a0) : "v"(m), "v"(c));
            } else {
#pragma unroll
                for (int q = 0; q < 8; ++q) {
                    asm volatile("v_fma_f32 %0, %0, %1, %2" : "+v"(a0) : "v"(m), "v"(c)); asm volatile("v_fma_f32 %0, %0, %1, %2" : "+v"(a1) : "v"(m), "v"(c));
                    asm volatile("v_fma_f32 %0, %0, %1, %2" : "+v"(a2) : "v"(m), "v"(c)); asm volatile("v_fma_f32 %0, %0, %1, %2" : "+v"(a3) : "v"(m), "v"(c));
                    asm volatile("v_fma_f32 %0, %0, %1, %2" : "+v"(a4) : "v"(m), "v"(c)); asm volatile("v_fma_f32 %0, %0, %1, %2" : "+v"(a5) : "v"(m), "v"(c));
                    asm volatile("v_fma_f32 %0, %0, %1, %2" : "+v"(a6) : "v"(m), "v"(c)); asm volatile("v_fma_f32 %0, %0, %1, %2" : "+v"(a7) : "v"(m), "v"(c));
                }
            }
        }
        if (a0 + a1 + a2 + a3 + a4 + a5 + a6 + a7 == 12345.678f) ctl[60] = 1u;
    }
#endif
    PHASE_BEGIN(35)
        strided(4352, [&](int u) { rows_unit<M_FINAL>(p, 1, u, lds); });
    PHASE_END
}

#ifndef N_LAUNCH_MODE
#define N_LAUNCH_MODE 1
#endif
extern "C" void kernel_launch(void* const* d_in, const int* in_sizes, int n_in, void* d_out, int out_size, void* d_ws, size_t ws_size, hipStream_t stream) {
    static int grid = 0;
    if (grid == 0) {
        if (n_in != 52 || out_size != NTL * DM || ws_size < WS_END) { fprintf(stderr, "kernel_launch: unexpected shapes (n_in %d out %d ws %zu need %zu)\n", n_in, out_size, ws_size, (size_t)WS_END); grid = -1; return; }
        int dev = 0, cus = 0, per_cu = 0;
        hipGetDevice(&dev);
        hipDeviceGetAttribute(&cus, hipDeviceAttributeMultiprocessorCount, dev);
        hipFuncSetAttribute((const void*)fwd_kernel, hipFuncAttributeMaxDynamicSharedMemorySize, LDS_BYTES);
        hipOccupancyMaxActiveBlocksPerMultiprocessor(&per_cu, (const void*)fwd_kernel, NTHREADS, LDS_BYTES);
        (void)hipGetLastError();
        if (per_cu < 1) per_cu = 1;
        if (per_cu > 2) per_cu = 2;
        grid = cus * per_cu;
    }
    if (grid < 0) return;
    hipMemsetAsync((char*)d_ws + WS_CTL, 0, CTL_BYTES, stream);
    KP p{};
    for (int i = 0; i < 52; ++i) p.in[i] = (const float*)d_in[i];
    p.out = (float*)d_out; p.ws = (char*)d_ws;
#if defined(PROBE_PH)
    for (int ph = 0; ph < NPHASE; ++ph) {
        const int reps = (ph == PROBE_PH) ? 1 + PROBE_N : 1;
        for (int r = 0; r < reps; ++r) { p.ph_lo = ph; p.ph_hi = ph + 1; p.rep = r; hipLaunchKernelGGL(fwd_kernel, dim3(grid), dim3(NTHREADS), LDS_BYTES, stream, p); }
    }
    if (PROBE_PH >= 100) { p.ph_lo = PROBE_PH; p.ph_hi = PROBE_PH + 1; p.rep = 0; hipLaunchKernelGGL(fwd_kernel, dim3(PROBE_N), dim3(NTHREADS), LDS_BYTES, stream, p); }
#elif N_LAUNCH_MODE == 1
    p.ph_lo = 0; p.ph_hi = NPHASE;
    hipLaunchKernelGGL(fwd_kernel, dim3(grid), dim3(NTHREADS), LDS_BYTES, stream, p);
#else
    for (int ph = 0; ph < NPHASE; ++ph) {
        p.ph_lo = ph; p.ph_hi = ph + 1;
        hipLaunchKernelGGL(fwd_kernel, dim3(grid), dim3(NTHREADS), LDS_BYTES, stream, p);
    }
#endif
}
```

```cpp
#include <hip/hip_runtime.h>
#include <hip/hip_bf16.h>
#include <hip/hip_fp16.h>
#include <stdint.h>
#include <stdio.h>

typedef unsigned short bf16_t;
using bf16x8 = __attribute__((ext_vector_type(8))) short;
using f32x4 = __attribute__((ext_vector_type(4))) float;
using f32x2 = __attribute__((ext_vector_type(2))) float;

#define NTC 2048
#define NTL 32768
#define NT 34816
#define DM 1024
#define ZS 3024
#define COL_GD 960
#define COL_HY 2000
#define COL_S5 2768
#define NCHUNK 68
#define ALPHA 1.41421356237f
#define NTHREADS 256
#define LDS_BYTES 73728
#define LDS_USER 2048
#define SH_TILE_BASE 2240
#define ACT_ROWS ((SH_TILE_BASE + 272) * 128)

constexpr size_t al256(size_t x) { return (x + 255) & ~(size_t)255; }
constexpr size_t WS_CTL = 0;
constexpr size_t CTL_BYTES = 131072;
constexpr size_t WS_MOD = WS_CTL + CTL_BYTES;
constexpr size_t WS_S5A = al256(WS_MOD + 2 * 9 * 6144 * 4);
constexpr size_t WS_S5B = al256(WS_S5A + 2 * 2 * 16 * 64 * 4 * 4);
constexpr size_t WS_GLUT = al256(WS_S5B + 2 * 2 * 16 * 64 * 32 * 4);
constexpr size_t WS_G2T = al256(WS_GLUT + 2 * 256 * 256 * 2);
constexpr size_t WS_LW2T = al256(WS_G2T + 2 * 256 * 64 * 2);
constexpr size_t WS_LA2T = al256(WS_LW2T + 2 * 256 * 64 * 2);
constexpr size_t SZ_WINT = (size_t)3072 * 1024 * 2, SZ_WOUTT = (size_t)1024 * 1024 * 2, SZ_FILTL = (size_t)4 * 256 * 4096 * 4, SZ_FILTC = (size_t)4 * 256 * 256 * 4;
constexpr size_t WS_WINT = al256(WS_LA2T + 2 * 256 * 64 * 2);
constexpr size_t WS_WOUTT = al256(WS_WINT + 2 * SZ_WINT);
constexpr size_t WS_FILTL = al256(WS_WOUTT + 2 * SZ_WOUTT);
constexpr size_t WS_FILTC = al256(WS_FILTL + 2 * SZ_FILTL);
constexpr size_t WS_XC = al256(WS_FILTC + 2 * SZ_FILTC);
constexpr size_t WS_HBY = al256(WS_XC + (size_t)NTC * DM * 4);
constexpr size_t WS_CAT = al256(WS_HBY + (size_t)NT * DM * 2);
constexpr size_t WS_Z = al256(WS_CAT + (size_t)NT * DM * 2);
constexpr size_t WS_R1 = al256(WS_Z + (size_t)NT * ZS * 2);
constexpr size_t R1_RWP = 0;
constexpr size_t R1_GQ = (size_t)NT * 1024 * 2;
constexpr size_t R1_W13T = 0;
constexpr size_t R1_W2T = (size_t)65 * 512 * 1024 * 2;
constexpr size_t R1_BYTES = (size_t)NT * 1024 * 2 + (size_t)NT * 768 * 2;
constexpr size_t WS_KNORM = al256(WS_R1 + R1_BYTES);
constexpr size_t WS_GAB = al256(WS_KNORM + (size_t)NT * 4 * 4);
constexpr size_t WS_S5ST = al256(WS_GAB + (size_t)NT * 16 * 4);
constexpr size_t WS_AEP = al256(WS_S5ST + (size_t)8 * 68 * 2 * 16 * 64 * 2 * 4);
constexpr size_t WS_AW = al256(WS_AEP + (size_t)NT * 8 * 4);
constexpr size_t WS_RTOK = al256(WS_AW + (size_t)NT * 8 * 4);
constexpr size_t WS_HYT = al256(WS_RTOK + (size_t)64 * NT * 4);
constexpr size_t WS_S5G = al256(WS_HYT + (size_t)8 * 768 * 4096 * 2);
constexpr size_t WS_END = al256(WS_S5G + (size_t)NT * 256 * 2);
static_assert(R1_W2T + (size_t)65 * 1024 * 256 * 2 <= R1_BYTES, "expert weights must fit R1");
constexpr size_t ACT_BYTES = (size_t)ACT_ROWS * 256 * 2;
constexpr size_t WS_ACT = WS_Z + ((((size_t)NT * ZS * 2 - ACT_BYTES) >> 8) << 8);
constexpr size_t WS_Y2 = WS_HBY;
static_assert(WS_Y2 + ACT_BYTES <= WS_ACT, "y2 must not reach act");

#define CW_QUEUE(l) (4096 + 64 * (l))
#define CW_CNT(l) (16384 + 2048 * (l))
#define CW_CUCNT(l) (8192 + 4096 * (l))

#define XB_TMO      128
#define XB_XCNT(j)  (256  + 64 * (j))
#define XB_XSUB(j)  (1280 + 64 * (j))
#define XB_XGEN(j)  (2304 + 64 * (j))
#define XB_TOP      3328
#define XB_TOPGEN   3392
#define XCD_BAR_WORDS 3456
#define XB_SPIN_CAP (1u << 18)
#define LAS __attribute__((address_space(3)))

__device__ __forceinline__ unsigned xb_ld(unsigned* p)              { return __hip_atomic_load(p, __ATOMIC_RELAXED, __HIP_MEMORY_SCOPE_AGENT); }
__device__ __forceinline__ unsigned xb_add(unsigned* p, unsigned v) { return __hip_atomic_fetch_add(p, v, __ATOMIC_RELAXED, __HIP_MEMORY_SCOPE_AGENT); }
__device__ __forceinline__ unsigned xb_xcc_id() { return (unsigned)__builtin_amdgcn_s_getreg((3 << 11) | 20) & 0xFu; }
#define XB_SPIN(cond, bar) do { unsigned _sp = 0; while (cond) { __builtin_amdgcn_s_sleep(1); \
    if ((++_sp & 255u) == 0u) { if (xb_ld(&(bar)[XB_TMO])) break; if (_sp > XB_SPIN_CAP) { atomicAdd(&(bar)[XB_TMO], 1u); break; } } } } while (0)

struct XcdBarrier {
    unsigned* bar; unsigned x;
    volatile LAS unsigned* st;
};
__device__ __forceinline__ XcdBarrier xcd_barrier_post(unsigned* bar, volatile LAS unsigned* st) {
    XcdBarrier b; b.bar = bar; b.x = xb_xcc_id(); b.st = st;
    if (threadIdx.x == 0) (void)xb_add(&bar[XB_XCNT(b.x)], 1u);
    return b;
}
__device__ __forceinline__ void xcd_barrier_complete(unsigned* bar, unsigned x, unsigned& nloc, unsigned& nx) {
    const unsigned G = gridDim.x * gridDim.y * gridDim.z;
    unsigned sum, cnt, mine, sp = 0u;
    for (;;) {
        sum = 0u; cnt = 0u; mine = 0u;
#pragma unroll
        for (unsigned j = 0; j < 16; ++j) { const unsigned c = xb_ld(&bar[XB_XCNT(j)]); sum += c; cnt += (c > 0u) ? 1u : 0u; mine = (j == x) ? c : mine; }
        if (sum == G) break;
        __builtin_amdgcn_s_sleep(1);
        if ((++sp & 255u) == 0u) { if (xb_ld(&bar[XB_TMO])) break; if (sp > XB_SPIN_CAP) { atomicAdd(&bar[XB_TMO], 1u); break; } }
    }
    nloc = mine > 0u ? mine : 1u; nx = cnt > 0u ? cnt : 1u;
}
__device__ __forceinline__ void xcd_barrier(const XcdBarrier& b) {
    asm volatile("s_waitcnt vmcnt(0)" ::: "memory");
    __syncthreads();
    if (threadIdx.x == 0) {
        unsigned* bar = b.bar;
        __builtin_amdgcn_s_waitcnt(0);
        unsigned nloc = b.st[0], nx = b.st[1];
        if (nloc == 0u) { xcd_barrier_complete(bar, b.x, nloc, nx); b.st[0] = nloc; b.st[1] = nx; }
        const unsigned old = xb_add(&bar[XB_XSUB(b.x)], 1u);
        const unsigned gen = old / nloc;
        if (old + 1u == (gen + 1u) * nloc) {
            __builtin_amdgcn_fence(__ATOMIC_RELEASE, "agent");
            asm volatile("s_waitcnt vmcnt(0)" ::: "memory");
            const unsigned og = xb_add(&bar[XB_TOP], 1u);
            const unsigned tg = og / nx;
            if (og + 1u == (tg + 1u) * nx) xb_add(&bar[XB_TOPGEN], 1u);
            else XB_SPIN(xb_ld(&bar[XB_TOPGEN]) == tg, bar);
            __builtin_amdgcn_fence(__ATOMIC_ACQUIRE, "agent");
            xb_add(&bar[XB_XGEN(b.x)], 1u);
            asm volatile("s_waitcnt vmcnt(0)" ::: "memory");
        } else {
            XB_SPIN(xb_ld(&bar[XB_XGEN(b.x)]) == gen, bar);
            __builtin_amdgcn_fence(__ATOMIC_ACQUIRE, "agent");
            asm volatile("s_waitcnt vmcnt(0)" ::: "memory");
        }
    }
    __syncthreads();
}

struct KP {
    const float* in[52];
    float* out;
    char* ws;
    int ph_lo, ph_hi, rep, pad_;
};
struct P {
    const __attribute__((address_space(3))) unsigned* tab;
    float* out;
    char* ws;
    __device__ __forceinline__ const float* in(int i) const {
        const unsigned lo = __builtin_amdgcn_readfirstlane(tab[2 * i]);
        const unsigned hi = __builtin_amdgcn_readfirstlane(tab[2 * i + 1]);
        return (const float*)(((unsigned long long)hi << 32) | (unsigned long long)lo);
    }
};
enum { I_X = 0, I_C, I_CTX, I_CCTX, I_ADAW, I_ADAB, I_WIN, I_WOUT, I_LNG, I_LNB,
       I_RW_W0, I_RW_W2, I_RW_A0, I_RW_A2, I_RW_G2, I_RW_KK, I_RW_KA, I_RW_RK, I_RW_GNG, I_RW_GNB,
       I_GD_CONV, I_GD_ALOG, I_GD_DTB, I_GD_NORM,
       I_HY_CONV, I_HY_CONVB, I_HY_W1, I_HY_B1, I_HY_F1, I_HY_W2, I_HY_B2, I_HY_F2, I_HY_W3, I_HY_SKIP,
       I_S5_LRE, I_S5_LIM, I_S5_LOGSTEP, I_S5_BRE, I_S5_BIM, I_S5_CRE, I_S5_CIM, I_S5_D, I_S5_GLUW, I_S5_GLUB,
       I_ROUTER_W, I_ROUTER_B, I_EX_W1, I_EX_W3, I_EX_W2, I_SH_W1, I_SH_W3, I_SH_W2 };

__device__ __forceinline__ bf16_t f2bf(float f) { unsigned u = __float_as_uint(f); u += 0x7fffu + ((u >> 16) & 1u); return (bf16_t)(u >> 16); }
__device__ __forceinline__ float bf2f(bf16_t h) { return __uint_as_float(((unsigned)h) << 16); }
__device__ __forceinline__ float bflo(unsigned u) { return __uint_as_float(u << 16); }
__device__ __forceinline__ float bfhi(unsigned u) { return __uint_as_float(u & 0xffff0000u); }
__device__ __forceinline__ unsigned pack2(float a, float b) { return (unsigned)f2bf(a) | ((unsigned)f2bf(b) << 16); }
__device__ __forceinline__ float sigm(float x) { return 1.f / (1.f + __expf(-x)); }
__device__ __forceinline__ float siluf(float x) { return x / (1.f + __expf(-x)); }
__device__ __forceinline__ float softplusf(float x) { return fmaxf(x, 0.f) + log1pf(__expf(-fabsf(x))); }
template <int CTRL> __device__ __forceinline__ float dppf(float v) {
    return __int_as_float(__builtin_amdgcn_update_dpp(0, __float_as_int(v), CTRL, 0xF, 0xF, true));
}
__device__ __forceinline__ float wave_sum(float v) {
    v += dppf<0xB1>(v); v += dppf<0x4E>(v); v += dppf<0x141>(v); v += dppf<0x140>(v);
    const int iv = __float_as_int(v);
    const float r0 = __int_as_float(__builtin_amdgcn_readlane(iv, 0)), r1 = __int_as_float(__builtin_amdgcn_readlane(iv, 16));
    const float r2 = __int_as_float(__builtin_amdgcn_readlane(iv, 32)), r3 = __int_as_float(__builtin_amdgcn_readlane(iv, 48));
    return (r0 + r1) + (r2 + r3);
}

__device__ __forceinline__ void unpack8(const uint4& v, float (&o)[8]) {
    o[0] = bflo(v.x); o[1] = bfhi(v.x); o[2] = bflo(v.y); o[3] = bfhi(v.y); o[4] = bflo(v.z); o[5] = bfhi(v.z); o[6] = bflo(v.w); o[7] = bfhi(v.w);
}
__device__ __forceinline__ uint4 pack8(const float (&o)[8]) { return make_uint4(pack2(o[0], o[1]), pack2(o[2], o[3]), pack2(o[4], o[5]), pack2(o[6], o[7])); }
__device__ __forceinline__ float sum8lanes(float v) { v += dppf<0xB1>(v); v += dppf<0x4E>(v); v += dppf<0x141>(v); return v; }

#define DPP_ADD_ASM(name, ctrl) __device__ __forceinline__ float name(float x) { float r; asm volatile("s_nop 1\n\tv_add_f32_dpp %0, %1, %1 " ctrl " row_mask:0xf bank_mask:0xf bound_ctrl:1" : "=v"(r) : "v"(x)); return r; }
DPP_ADD_ASM(dadd_x1, "quad_perm:[1,0,3,2]")
DPP_ADD_ASM(dadd_x2, "quad_perm:[2,3,0,1]")
DPP_ADD_ASM(dadd_hm, "row_half_mirror")
DPP_ADD_ASM(dadd_rm, "row_mirror")

__device__ __forceinline__ void dpp_allreduce16_x2(float& a, float& b) {
    asm volatile(
        "s_nop 1\n\t"
        "v_add_f32_dpp %0, %0, %0 quad_perm:[1,0,3,2] row_mask:0xf bank_mask:0xf bound_ctrl:1\n\t"
        "v_add_f32_dpp %1, %1, %1 quad_perm:[1,0,3,2] row_mask:0xf bank_mask:0xf bound_ctrl:1\n\t"
        "s_nop 0\n\t"
        "v_add_f32_dpp %0, %0, %0 quad_perm:[2,3,0,1] row_mask:0xf bank_mask:0xf bound_ctrl:1\n\t"
        "v_add_f32_dpp %1, %1, %1 quad_perm:[2,3,0,1] row_mask:0xf bank_mask:0xf bound_ctrl:1\n\t"
        "s_nop 0\n\t"
        "v_add_f32_dpp %0, %0, %0 row_half_mirror row_mask:0xf bank_mask:0xf bound_ctrl:1\n\t"
        "v_add_f32_dpp %1, %1, %1 row_half_mirror row_mask:0xf bank_mask:0xf bound_ctrl:1\n\t"
        "s_nop 0\n\t"
        "v_add_f32_dpp %0, %0, %0 row_mirror row_mask:0xf bank_mask:0xf bound_ctrl:1\n\t"
        "v_add_f32_dpp %1, %1, %1 row_mirror row_mask:0xf bank_mask:0xf bound_ctrl:1"
        : "+v"(a), "+v"(b));
}
__device__ __forceinline__ int otid() { int t = threadIdx.x; asm volatile("" : "+v"(t)); return t; }
__device__ __forceinline__ float* xrow(const P& p, int row) {
    return row < NTC ? (float*)(p.ws + WS_XC) + (size_t)row * DM : p.out + (size_t)(row - NTC) * DM;
}
__device__ __forceinline__ int row_mod(int row) { return row < NTC ? 8 : ((row - NTC) >> 12); }
__device__ __forceinline__ const float* modp(const P& p, int l, int r, int chunk) {
    return (const float*)(p.ws + WS_MOD) + ((size_t)(l * 9 + r) * 6144 + chunk * 1024);
}

struct ARows { int r[4]; };
__device__ __forceinline__ ARows arows_lin(int base, int tid) { ARows a; a.r[0] = base + (tid >> 3); a.r[1] = a.r[0] + 32; a.r[2] = a.r[0] + 64; a.r[3] = a.r[0] + 96; return a; }
__device__ __forceinline__ void gemm_tile(const bf16_t* __restrict__ A, int lda, const ARows& ar,
                                          const bf16_t* __restrict__ Bt, int ldb, int brow0, int K,
                                          char* lds, f32x4 (&acc)[4][4]) {
    const int tid = otid();
    const int wid = tid >> 6, lane = tid & 63, wr = wid >> 1, wc = wid & 1, fr = lane & 15, fq = lane >> 4;
    const int gc = ((tid & 7) ^ ((tid >> 3) & 7)) * 8;
    const bf16_t* ap[4]; const bf16_t* bp[4];
#pragma unroll
    for (int i = 0; i < 4; ++i) {
        ap[i] = A + (size_t)ar.r[i] * lda + gc;
        bp[i] = Bt + (size_t)(brow0 + (tid >> 3) + 32 * i) * ldb + gc;
    }
#pragma unroll
    for (int m = 0; m < 4; ++m)
#pragma unroll
        for (int n = 0; n < 4; ++n) acc[m][n] = f32x4{0.f, 0.f, 0.f, 0.f};
    const int nk = K >> 6;
    auto stage = [&](int t, int buf) {
        char* SA = lds + buf * 32768; char* SB = SA + 16384;
        const int ko = t * 64;
#pragma unroll
        for (int i = 0; i < 4; ++i) {
            __builtin_amdgcn_global_load_lds((const void*)(ap[i] + ko), (LAS void*)(SA + tid * 16 + i * 4096), 16, 0, 0);
            __builtin_amdgcn_global_load_lds((const void*)(bp[i] + ko), (LAS void*)(SB + tid * 16 + i * 4096), 16, 0, 0);
        }
    };
    stage(0, 0);
    asm volatile("s_waitcnt vmcnt(0)" ::: "memory");
    __syncthreads();
    const int sw = fr & 7;
    for (int t = 0; t < nk; ++t) {
        const int buf = t & 1;
        if (t + 1 < nk) stage(t + 1, buf ^ 1);
        const char* SA = lds + buf * 32768; const char* SB = SA + 16384;
        bf16x8 af[2][4], bfr[2][4];
#pragma unroll
        for (int ks = 0; ks < 2; ++ks) {
            const int co = ((ks * 4 + fq) ^ sw) * 16;
#pragma unroll
            for (int m = 0; m < 4; ++m) af[ks][m] = *reinterpret_cast<const bf16x8*>(SA + (wr * 64 + m * 16 + fr) * 128 + co);
#pragma unroll
            for (int n = 0; n < 4; ++n) bfr[ks][n] = *reinterpret_cast<const bf16x8*>(SB + (wc * 64 + n * 16 + fr) * 128 + co);
        }
        __builtin_amdgcn_s_setprio(1);
#pragma unroll
        for (int ks = 0; ks < 2; ++ks)
#pragma unroll
            for (int m = 0; m < 4; ++m)
#pragma unroll
                for (int n = 0; n < 4; ++n) acc[m][n] = __builtin_amdgcn_mfma_f32_16x16x32_bf16(af[ks][m], bfr[ks][n], acc[m][n], 0, 0, 0);
        __builtin_amdgcn_s_setprio(0);
        asm volatile("s_waitcnt vmcnt(0)" ::: "memory");
        __syncthreads();
    }
}

__device__ __forceinline__ void ph0_mod_unit(const P& p, int u, char* lds) {
    const int l = u / 96, cg = u % 96, tid = otid();
    float* s = (float*)lds;
    float* red = s + 9 * 1024;
    const float* c = p.in(I_C); const float* cctx = p.in(I_CCTX);
    for (int i = tid; i < 9 * 1024; i += NTHREADS) { int r = i >> 10, k = i & 1023; float v = r < 8 ? c[r * 1024 + k] : cctx[k]; s[i] = v / (1.f + expf(-v)); }
    __syncthreads();
    const int kq = tid >> 6, j = tid & 63, col = cg * 64 + j;
    const float* w = p.in(I_ADAW) + (size_t)l * 1024 * 6144 + col;
    float acc[9];
#pragma unroll
    for (int r = 0; r < 9; ++r) acc[r] = 0.f;
#pragma unroll 4
    for (int k = kq * 256; k < kq * 256 + 256; ++k) {
        const float wv = w[(size_t)k * 6144];
#pragma unroll
        for (int r = 0; r < 9; ++r) acc[r] += s[r * 1024 + k] * wv;
    }
#pragma unroll
    for (int r = 0; r < 9; ++r) red[(kq * 9 + r) * 64 + j] = acc[r];
    __syncthreads();
    if (tid < 64) {
        float* mod = (float*)(p.ws + WS_MOD);
        const float bb = p.in(I_ADAB)[l * 6144 + col];
#pragma unroll
        for (int r = 0; r < 9; ++r) mod[(size_t)(l * 9 + r) * 6144 + col] = red[r * 64 + j] + red[(9 + r) * 64 + j] + red[(18 + r) * 64 + j] + red[(27 + r) * 64 + j] + bb;
    }
    __syncthreads();
}

__device__ __forceinline__ void ph0_s5tab_unit(const P& p, int u) {
    const int tid = otid();
    if (tid >= 64) return;
    const int ldg = u;
    const int idx = ldg * 64 + tid;
    const double lre = (double)p.in(I_S5_LRE)[idx], lim = (double)p.in(I_S5_LIM)[idx];
    const double dt = (double)expf(p.in(I_S5_LOGSTEP)[ldg]);
    const float mag = expf((float)(lre * dt));
    double rev = lim * dt * 0.15915494309189535; rev -= floor(rev);
    float sn, cs; sincospif(2.f * (float)rev, &sn, &cs);
    const double abr = (double)(mag * cs), abi = (double)(mag * sn);
    const double den = lre * lre + lim * lim;
    const double cor = ((abr - 1.0) * lre + abi * lim) / den;
    const double coi = (abi * lre - (abr - 1.0) * lim) / den;
    const float m64f = expf((float)(64.0 * lre * dt));
    double rev64 = 64.0 * lim * dt * 0.15915494309189535; rev64 -= floor(rev64);
    float sn64, cs64; sincospif(2.f * (float)rev64, &sn64, &cs64);
    float* A = (float*)(p.ws + WS_S5A) + (size_t)idx * 4;
    A[0] = (float)abr; A[1] = (float)abi; A[2] = m64f * cs64; A[3] = m64f * sn64;
    float* B = (float*)(p.ws + WS_S5B) + (size_t)idx * 32;
    const float* bre = p.in(I_S5_BRE) + (size_t)idx * 16; const float* bim = p.in(I_S5_BIM) + (size_t)idx * 16;
#pragma unroll
    for (int h = 0; h < 16; ++h) {
        const double br = bre[h], bi = bim[h];
        B[h] = (float)(cor * br - coi * bi);
        B[16 + h] = (float)(cor * bi + coi * br);
    }
}

__device__ __forceinline__ int xmap(int mode, int c) {
    if (mode == 0) return c;
    const int j = c >> 6, cc = c & 63, wc = cc >> 5, pp = (cc & 31) >> 4, i = cc & 15;
    return j * 128 + wc * 64 + pp * 32 + i + (mode == 2 ? 16 : 0);
}
__device__ __forceinline__ void xpose_tile(const float* __restrict__ src, int C, bf16_t* __restrict__ dst, int ldd, int mode, int tr, int tc, char* lds) {
    float* t = (float*)lds;
    const int tid = otid();
    {
        const int c4 = (tid & 15) * 4, c = tc * 64 + c4;
#pragma unroll
        for (int k = 0; k < 4; ++k) {
            const int r = (tid >> 4) + 16 * k;
            float4 v = make_float4(0.f, 0.f, 0.f, 0.f);
            if (c < C) v = *reinterpret_cast<const float4*>(src + (size_t)(tr * 64 + r) * C + c);
            t[(c4 + 0) * 65 + r] = v.x; t[(c4 + 1) * 65 + r] = v.y; t[(c4 + 2) * 65 + r] = v.z; t[(c4 + 3) * 65 + r] = v.w;
        }
    }
    __syncthreads();
#pragma unroll
    for (int k = 0; k < 2; ++k) {
        const int ci = (tid >> 3) + 32 * k, r8 = (tid & 7) * 8;
        const float* tp = t + ci * 65 + r8;
        uint4 o;
        o.x = pack2(tp[0], tp[1]); o.y = pack2(tp[2], tp[3]); o.z = pack2(tp[4], tp[5]); o.w = pack2(tp[6], tp[7]);
        *reinterpret_cast<uint4*>(dst + (size_t)xmap(mode, tc * 64 + ci) * ldd + tr * 64 + r8) = o;
    }
    __syncthreads();
}

__device__ __forceinline__ void xpose_strip4(const float* __restrict__ src, int C, bf16_t* __restrict__ dst, int ldd, int mode, int tr, int tc0, char* lds) {
    float* t = (float*)lds;
    const int tid = otid();
    {
        const int c4 = (tid & 15) * 4;
        float4 v[4][4];
#pragma unroll
        for (int q = 0; q < 4; ++q)
#pragma unroll
            for (int k = 0; k < 4; ++k) v[q][k] = *reinterpret_cast<const float4*>(src + (size_t)(tr * 64 + (tid >> 4) + 16 * k) * C + (tc0 + q) * 64 + c4);
#pragma unroll
        for (int q = 0; q < 4; ++q)
#pragma unroll
            for (int k = 0; k < 4; ++k) {
                const int r = (tid >> 4) + 16 * k;
                float* tq = t + q * (64 * 65);
                tq[(c4 + 0) * 65 + r] = v[q][k].x; tq[(c4 + 1) * 65 + r] = v[q][k].y; tq[(c4 + 2) * 65 + r] = v[q][k].z; tq[(c4 + 3) * 65 + r] = v[q][k].w;
            }
    }
    __syncthreads();
#pragma unroll
    for (int q = 0; q < 4; ++q)
#pragma unroll
        for (int k = 0; k < 2; ++k) {
            const int ci = (tid >> 3) + 32 * k, r8 = (tid & 7) * 8;
            const float* tp = t + q * (64 * 65) + ci * 65 + r8;
            uint4 o;
            o.x = pack2(tp[0], tp[1]); o.y = pack2(tp[2], tp[3]); o.z = pack2(tp[4], tp[5]); o.w = pack2(tp[6], tp[7]);
            *reinterpret_cast<uint4*>(dst + (size_t)xmap(mode, (tc0 + q) * 64 + ci) * ldd + tr * 64 + r8) = o;
        }
    __syncthreads();
}

enum { M_INIT = 0, M_LN2NEXT = 1, M_LN1 = 2, M_FINAL = 3 };

template <int MODE>
__device__ __forceinline__ void rows_unit(const P& p, int l, int u, char* lds, int dry = 0) {
    const int tid = otid(), w = tid >> 6, lane = tid & 63;
    constexpr int RW = (MODE == M_LN1) ? 4 : 2;
    float* hbuf = (float*)lds;
    bf16_t* hb = (bf16_t*)(p.ws + WS_HBY);
#pragma unroll 1
    for (int rr = 0; rr < RW; ++rr) {
        const int rl = w * RW + rr, row = u * (4 * RW) + rl;
        const int mr = row_mod(row);
        float v[16];
        float* xr = xrow(p, row);
        const float* src = (MODE == M_INIT) ? (row < NTC ? p.in(I_CTX) + (size_t)row * DM : p.in(I_X) + (size_t)(row - NTC) * DM) : xr;
#pragma unroll
        for (int i = 0; i < 4; ++i) {
            const float4 t = *reinterpret_cast<const float4*>(src + i * 256 + lane * 4);
            v[i * 4 + 0] = t.x; v[i * 4 + 1] = t.y; v[i * 4 + 2] = t.z; v[i * 4 + 3] = t.w;
        }
        if (MODE == M_FINAL && row >= NTC) {
            const int* tbs = (const int*)(lds - LDS_USER + 1024);
            const bf16_t* y2 = (const bf16_t*)(p.ws + WS_Y2);
            const int* aep = (const int*)(p.ws + WS_AEP); const float* aw = (const float*)(p.ws + WS_AW);
            const uint2 sv = *reinterpret_cast<const uint2*>(y2 + ((size_t)(SH_TILE_BASE * 128 + row)) * 256 + lane * 4);
            float r4[4] = {bflo(sv.x), bfhi(sv.x), bflo(sv.y), bfhi(sv.y)};
#pragma unroll
            for (int k = 0; k < 8; ++k) {
                const unsigned av = (unsigned)aep[(size_t)row * 8 + k];
                const float wk = aw[(size_t)row * 8 + k];
                const int dest = tbs[av >> 24] * 128 + (int)(av & 0xFFFFFFu);
                const uint2 yv = *reinterpret_cast<const uint2*>(y2 + (size_t)dest * 256 + lane * 4);
                r4[0] += wk * bflo(yv.x); r4[1] += wk * bfhi(yv.x); r4[2] += wk * bflo(yv.y); r4[3] += wk * bfhi(yv.y);
            }
            const float4 g4 = *reinterpret_cast<const float4*>(modp(p, l, mr, 5) + 768 + lane * 4);
            v[12] += g4.x * r4[0]; v[13] += g4.y * r4[1]; v[14] += g4.z * r4[2]; v[15] += g4.w * r4[3];
        }
        if (MODE != M_INIT) {
            const int ll = (MODE == M_LN2NEXT) ? l - 1 : l;
            const int which = (MODE == M_LN1) ? 0 : 1;
            float s = 0.f;
#pragma unroll
            for (int i = 0; i < 16; ++i) s += v[i];
            const float mu = wave_sum(s) * (1.f / 1024.f);
            float q = 0.f;
#pragma unroll
            for (int i = 0; i < 16; ++i) { const float d = v[i] - mu; q += d * d; }
            const float rstd = rsqrtf(wave_sum(q) * (1.f / 1024.f) + 1e-5f);
            const float* g = p.in(I_LNG) + (size_t)(ll * 2 + which) * 1024;
            const float* bb = p.in(I_LNB) + (size_t)(ll * 2 + which) * 1024;
#pragma unroll
            for (int i = 0; i < 4; ++i) {
                const float4 gg = *reinterpret_cast<const float4*>(g + i * 256 + lane * 4);
                const float4 b4 = *reinterpret_cast<const float4*>(bb + i * 256 + lane * 4);
                v[i * 4 + 0] = (v[i * 4 + 0] - mu) * rstd * gg.x + b4.x;
                v[i * 4 + 1] = (v[i * 4 + 1] - mu) * rstd * gg.y + b4.y;
                v[i * 4 + 2] = (v[i * 4 + 2] - mu) * rstd * gg.z + b4.z;
                v[i * 4 + 3] = (v[i * 4 + 3] - mu) * rstd * gg.w + b4.w;
            }
        }
        if (MODE == M_FINAL) {
            if (row >= NTC) {
#pragma unroll
                for (int i = 0; i < 4; ++i) *reinterpret_cast<float4*>(xr + i * 256 + lane * 4) = make_float4(v[i * 4], v[i * 4 + 1], v[i * 4 + 2], v[i * 4 + 3]);
            }
            continue;
        }
        const float osc = (MODE == M_LN1) ? ALPHA : 1.f;
#pragma unroll
        for (int i = 0; i < 4; ++i) if (MODE != M_INIT) { float4 o4 = make_float4(osc * v[i * 4], osc * v[i * 4 + 1], osc * v[i * 4 + 2], osc * v[i * 4 + 3]); if (dry) o4 = *reinterpret_cast<const float4*>(src + i * 256 + lane * 4); *reinterpret_cast<float4*>(xr + i * 256 + lane * 4) = o4; }
        const float* sh = modp(p, l, mr, (MODE == M_LN1) ? 3 : 0);
        const float* sc = modp(p, l, mr, (MODE == M_LN1) ? 4 : 1);
#pragma unroll
        for (int i = 0; i < 4; ++i) {
            const float4 s4 = *reinterpret_cast<const float4*>(sc + i * 256 + lane * 4);
            const float4 h4 = *reinterpret_cast<const float4*>(sh + i * 256 + lane * 4);
            const float h0 = v[i * 4 + 0] * (1.f + s4.x) + h4.x, h1 = v[i * 4 + 1] * (1.f + s4.y) + h4.y;
            const float h2 = v[i * 4 + 2] * (1.f + s4.z) + h4.z, h3 = v[i * 4 + 3] * (1.f + s4.w) + h4.w;
            uint2 pk; pk.x = pack2(h0, h1); pk.y = pack2(h2, h3);
            if (!dry) *reinterpret_cast<uint2*>(hb + (size_t)row * DM + i * 256 + lane * 4) = pk;
            if (MODE == M_LN1) *reinterpret_cast<float4*>(hbuf + rl * 1028 + i * 256 + lane * 4) = make_float4(h0, h1, h2, h3);
        }
    }
    if (MODE == M_LN1 && dry != 2) {
        float* part = hbuf;
        __syncthreads();
        {
            const int fr = lane & 15, fq = lane >> 4;
            const float* rwb = p.in(I_ROUTER_W) + (size_t)l * 1024 * 64 + fr;
            const float* hrow = hbuf + fr * 1028 + fq;
            f32x4 ac[4];
#pragma unroll
            for (int nf = 0; nf < 4; ++nf) ac[nf] = f32x4{0.f, 0.f, 0.f, 0.f};
#pragma unroll 8
            for (int k = w * 256; k < w * 256 + 256; k += 4) {
                const float av = hrow[k];
                const float* bp = rwb + (size_t)(k + fq) * 64;
#pragma unroll
                for (int nf = 0; nf < 4; ++nf) ac[nf] = __builtin_amdgcn_mfma_f32_16x16x4f32(av, bp[nf * 16], ac[nf], 0, 0, 0);
            }
            __syncthreads();
#pragma unroll
            for (int nf = 0; nf < 4; ++nf)
#pragma unroll
                for (int r = 0; r < 4; ++r) part[(w * 16 + fq * 4 + r) * 64 + nf * 16 + fr] = ac[nf][r];
        }
        __syncthreads();
        float lg[4];
#pragma unroll
        for (int rr = 0; rr < 4; ++rr) {
            const int r0 = w * 4 + rr;
            lg[rr] = part[(0 * 16 + r0) * 64 + lane] + part[(1 * 16 + r0) * 64 + lane] + part[(2 * 16 + r0) * 64 + lane] + part[(3 * 16 + r0) * 64 + lane];
        }
        const float rbias = p.in(I_ROUTER_B)[l * 64 + lane];
        unsigned* cnt = (unsigned*)(p.ws + WS_CTL) + CW_CNT(l);
        int* aep = (int*)(p.ws + WS_AEP); float* aw = (float*)(p.ws + WS_AW);
#pragma unroll 1
        for (int rr = 0; rr < 4; ++rr) {
            const int row = u * 16 + w * 4 + rr;
            const float logit = (rr == 0) ? lg[0] : (rr == 1) ? lg[1] : (rr == 2) ? lg[2] : lg[3];
            const float s = 1.f / (1.f + expf(-logit));
            const float bsd = s + rbias;
            float m1 = bsd;
            m1 = fmaxf(m1, __shfl_xor(m1, 1)); m1 = fmaxf(m1, __shfl_xor(m1, 2)); m1 = fmaxf(m1, __shfl_xor(m1, 4));
            const unsigned long long eqm = __ballot(bsd == m1);
            const int gbase = lane & ~7;
            const unsigned gbits = (unsigned)((eqm >> gbase) & 0xFFull);
            const int first = gbase + __builtin_ctz(gbits);
            float m2 = (lane == first) ? -INFINITY : bsd;
            m2 = fmaxf(m2, __shfl_xor(m2, 1)); m2 = fmaxf(m2, __shfl_xor(m2, 2)); m2 = fmaxf(m2, __shfl_xor(m2, 4));
            const float gs = m1 + m2;
            const int myg = lane >> 3;
            int grank = 0;
#pragma unroll
            for (int g2 = 0; g2 < 8; ++g2) { const float o = __int_as_float(__builtin_amdgcn_readlane(__float_as_int(gs), g2 * 8)); grank += (o > gs || (o == gs && g2 < myg)) ? 1 : 0; }
            const bool gsel = grank < 4;
            const float msk = gsel ? bsd : -INFINITY;
            int erank = 0;
#pragma unroll
            for (int j = 0; j < 64; ++j) { const float o = __int_as_float(__builtin_amdgcn_readlane(__float_as_int(msk), j)); erank += (o > msk || (o == msk && j < lane)) ? 1 : 0; }
            const bool sel = gsel && erank < 8;
            const float wsum = wave_sum(sel ? s : 0.f);
            const unsigned long long selm = __ballot(sel);
            if (sel && !dry) {
                const int slot = __popcll(selm & ((1ull << lane) - 1ull));
                const unsigned pos = atomicAdd(&cnt[lane * 32], 1u);
                aep[(size_t)row * 8 + slot] = (int)((unsigned)lane << 24 | pos);
                ((int*)(p.ws + WS_RTOK))[(size_t)lane * NT + pos] = row;
                aw[(size_t)row * 8 + slot] = s / wsum * 2.5f;
            }
        }
    }
}

__device__ __forceinline__ void filt_unit(const P& p, int l, int u, char* lds) {
    const int tid = otid();
    float* feat = (float*)lds;
    float* h1 = feat + 4 * 36;
    float* h2 = h1 + 4 * 64;
    const int pp = tid >> 6, j = tid & 63;
    const int pi = u * 4 + pp;
    const int L = pi < 4096 ? 4096 : 256;
    const int t = pi < 4096 ? pi : pi - 4096;
    const float tt = (float)t / (float)(L - 1);
    if (j < 33) {
        float f;
        if (j == 0) f = tt;
        else {
            const int k = (j - 1) & 15;
            const float band = 1e-4f + (float)k * ((15.0f - 1e-4f) / 15.0f);
            float ph = band * (float)t * (1.f / (float)L);
            ph -= floorf(ph);
            float sn, cs; sincospif(2.f * ph, &sn, &cs);
            f = (j <= 16) ? cs : -sn;
        }
        feat[pp * 36 + j] = f;
    }
    __syncthreads();
    {
        const float* w1 = p.in(I_HY_W1) + (size_t)l * 33 * 64;
        float a = p.in(I_HY_B1)[l * 64 + j];
        for (int i = 0; i < 33; ++i) a += feat[pp * 36 + i] * w1[i * 64 + j];
        h1[pp * 64 + j] = sinf(p.in(I_HY_F1)[l * 64 + j] * a);
    }
    __syncthreads();
    {
        const float* w2 = p.in(I_HY_W2) + (size_t)l * 64 * 64;
        float a = p.in(I_HY_B2)[l * 64 + j];
        for (int i = 0; i < 64; ++i) a += h1[pp * 64 + i] * w2[i * 64 + j];
        h2[pp * 64 + j] = sinf(p.in(I_HY_F2)[l * 64 + j] * a);
    }
    __syncthreads();
    {
        const int c = tid;
        const float* w3 = p.in(I_HY_W3) + (size_t)l * 64 * 1024;
        float acc[4][4];
#pragma unroll
        for (int a = 0; a < 4; ++a)
#pragma unroll
            for (int b = 0; b < 4; ++b) acc[a][b] = 0.f;
        for (int i = 0; i < 64; ++i) {
            float wv[4];
#pragma unroll
            for (int os = 0; os < 4; ++os) wv[os] = w3[i * 1024 + os * 256 + c];
#pragma unroll
            for (int q = 0; q < 4; ++q) {
                const float hv = h2[q * 64 + i];
#pragma unroll
                for (int os = 0; os < 4; ++os) acc[q][os] += hv * wv[os];
            }
        }
        const float d0 = logf(0.01f) / 1.5f, d1 = logf(0.01f) / 0.3f;
        const float delta = fabsf(d0 + (d1 - d0) * ((float)c / 255.f));
#pragma unroll
        for (int q = 0; q < 4; ++q) {
            const int pq = u * 4 + q;
            const int Lq = pq < 4096 ? 4096 : 256;
            const int tq = pq < 4096 ? pq : pq - 4096;
            const float ttq = (float)tq / (float)(Lq - 1);
            const float dec = expf(-ttq * delta);
            float* F = (pq < 4096) ? (float*)(p.ws + WS_FILTL + l * SZ_FILTL) : (float*)(p.ws + WS_FILTC + l * SZ_FILTC);
#pragma unroll
            for (int os = 0; os < 4; ++os) {
                if (pq < 4096) F[((size_t)((os >> 1) * 256 + c) * 2 + (os & 1)) * 4096 + tq] = acc[q][os] * dec;
                else F[((size_t)os * 256 + c) * Lq + tq] = acc[q][os] * dec;
            }
        }
    }
    __syncthreads();
}

__device__ __forceinline__ void rwkv_prep_unit(const P& p, int l, int u, char* lds) {
    const int tid = otid();
    bf16_t* twb = (bf16_t*)lds;
    bf16_t* alb = twb + 32 * 72;
    bf16_t* ot = alb + 32 * 72;
    const bf16_t* z = (const bf16_t*)(p.ws + WS_Z);
    bf16_t* rwp = (bf16_t*)(p.ws + WS_R1 + R1_RWP);
    float* knorm = (float*)(p.ws + WS_KNORM);
    const int row0 = u * 32;
    {
        const int tok = tid >> 3, j0 = (tid & 7) * 8;
        const bf16_t* zr = z + (size_t)(row0 + tok) * ZS;
        float wl[8];
        unpack8(*reinterpret_cast<const uint4*>(zr + 768 + j0), wl);
#pragma unroll
        for (int i = 0; i < 8; ++i) wl[i] = 1.f - 2.f * __frcp_rn(1.f + __expf(2.f * wl[i]));
        *reinterpret_cast<uint4*>(twb + tok * 72 + j0) = pack8(wl);
        *reinterpret_cast<uint4*>(alb + tok * 72 + j0) = *reinterpret_cast<const uint4*>(zr + 832 + j0);
    }
    {
        const int tl = tid >> 5, cg = tid & 31, c0 = cg * 8;
        float kk[8];
#pragma unroll
        for (int i = 0; i < 8; ++i) kk[i] = p.in(I_RW_KK)[l * 256 + c0 + i];
#pragma unroll
        for (int it = 0; it < 4; ++it) {
            const int row = row0 + it * 8 + tl;
            float k[8];
            unpack8(*reinterpret_cast<const uint4*>(z + (size_t)row * ZS + 256 + c0), k);
            float ss = 0.f;
#pragma unroll
            for (int i = 0; i < 8; ++i) { const float kv = k[i] * kk[i]; ss += kv * kv; }
            ss = sum8lanes(ss);
            if ((cg & 7) == 0) knorm[(size_t)row * 4 + (cg >> 3)] = rsqrtf(ss + 1e-12f);
        }
    }
    __syncthreads();
    const int w = tid >> 6, lane = tid & 63, fr = lane & 15, fq = lane >> 4;
#pragma unroll 1
    for (int combo = 0; combo < 4; ++combo) {
        const int kind = combo >> 1, d = combo & 1;
        const bf16_t* At = kind ? alb : twb;
        const bf16_t* Bt = (const bf16_t*)(p.ws + (kind ? WS_LA2T : WS_LW2T)) + (size_t)l * 256 * 64;
        const float* basep = (kind ? p.in(I_RW_A0) : p.in(I_RW_W0)) + (l * 2 + d) * 256;
        bf16x8 af[2], bfr[4];
#pragma unroll
        for (int mf = 0; mf < 2; ++mf) af[mf] = *reinterpret_cast<const bf16x8*>(At + (mf * 16 + fr) * 72 + d * 32 + fq * 8);
#pragma unroll
        for (int nf = 0; nf < 4; ++nf) bfr[nf] = *reinterpret_cast<const bf16x8*>(Bt + (size_t)(w * 64 + nf * 16 + fr) * 64 + d * 32 + fq * 8);
#pragma unroll
        for (int nf = 0; nf < 4; ++nf) {
            const float base = basep[w * 64 + nf * 16 + fr];
#pragma unroll
            for (int mf = 0; mf < 2; ++mf) {
                const f32x4 acc = __builtin_amdgcn_mfma_f32_16x16x32_bf16(af[mf], bfr[nf], f32x4{0.f, 0.f, 0.f, 0.f}, 0, 0, 0);
#pragma unroll
                for (int j = 0; j < 4; ++j) {
                    const float a = base + acc[j];
                    float o;
                    if (kind) o = __frcp_rn(1.f + __expf(-a));
                    else { const float na = -a; const float sp = fmaxf(na, 0.f) + __logf(1.f + __expf(-fabsf(na))); o = __expf(-sp - 0.5f); }
                    ot[(mf * 16 + fq * 4 + j) * 264 + w * 64 + nf * 16 + fr] = f2bf(o);
                }
            }
        }
        __syncthreads();
#pragma unroll
        for (int i = 0; i < 4; ++i) {
            const int id = tid + 256 * i, tok = id >> 5, c8 = (id & 31) * 8;
            *reinterpret_cast<uint4*>(rwp + ((size_t)(row0 + tok) * 4 + combo) * 256 + c8) = *reinterpret_cast<const uint4*>(ot + tok * 264 + c8);
        }
        __syncthreads();
    }
}

__device__ __forceinline__ void gdn_prep_unit(const P& p, int l, int u) {
    const int tid = otid();
    const bf16_t* z = (const bf16_t*)(p.ws + WS_Z);
    bf16_t* gq = (bf16_t*)(p.ws + WS_R1 + R1_GQ);
    float* gab = (float*)(p.ws + WS_GAB);
    const int row0 = u * 32;
    int seq0, seqL;
    if (row0 < NTC) { seq0 = row0 & ~255; seqL = 256; } else { seq0 = NTC + ((row0 - NTC) & ~4095); seqL = 4096; }
    const int tl = tid >> 5, cg = tid & 31;
#pragma unroll 1
    for (int pz = 0; pz < 3; ++pz) {
        const int ch0 = pz * 256 + cg * 8;
        float w0[8], w1[8], w2[8];
        {
            const float* cw = p.in(I_GD_CONV) + (size_t)l * 3 * 768 + ch0;
#pragma unroll
            for (int i = 0; i < 8; i += 4) {
                const float4 a = *reinterpret_cast<const float4*>(cw + i), b = *reinterpret_cast<const float4*>(cw + 768 + i), c = *reinterpret_cast<const float4*>(cw + 1536 + i);
                w0[i] = a.x; w0[i + 1] = a.y; w0[i + 2] = a.z; w0[i + 3] = a.w;
                w1[i] = b.x; w1[i + 1] = b.y; w1[i + 2] = b.z; w1[i + 3] = b.w;
                w2[i] = c.x; w2[i + 1] = c.y; w2[i + 2] = c.z; w2[i + 3] = c.w;
            }
        }
#pragma unroll 2
        for (int it = 0; it < 4; ++it) {
            const int row = row0 + it * 8 + tl;
            const bf16_t* zc = z + (size_t)row * ZS + COL_GD + ch0;
            const uint4 zero4 = make_uint4(0u, 0u, 0u, 0u);
            const uint4 vm = (row - 1 >= seq0) ? *reinterpret_cast<const uint4*>(zc - ZS) : zero4;
            const uint4 v0 = *reinterpret_cast<const uint4*>(zc);
            const uint4 vp = (row + 1 < seq0 + seqL) ? *reinterpret_cast<const uint4*>(zc + ZS) : zero4;
            float xm[8], x0[8], xp[8], o[8];
            unpack8(vm, xm); unpack8(v0, x0); unpack8(vp, xp);
            float ss = 0.f;
#pragma unroll
            for (int i = 0; i < 8; ++i) { o[i] = siluf(w0[i] * xm[i] + w1[i] * x0[i] + w2[i] * xp[i]); ss += o[i] * o[i]; }
            if (pz < 2) {
                ss = sum8lanes(ss);
                const float sc = rsqrtf(ss + 1e-12f) * (pz == 0 ? 0.125f : 1.f);
#pragma unroll
                for (int i = 0; i < 8; ++i) o[i] *= sc;
            }
            *reinterpret_cast<uint4*>(gq + (size_t)row * 768 + ch0) = pack8(o);
        }
    }
    {
        const int tok = tid >> 3, dh = tid & 7;
        const int row = row0 + tok;
        const float alv = bf2f(z[(size_t)row * ZS + COL_GD + 1024 + dh]);
        const float blv = bf2f(z[(size_t)row * ZS + COL_GD + 1032 + dh]);
        const float g = -expf(p.in(I_GD_ALOG)[l * 8 + dh]) * softplusf(alv + p.in(I_GD_DTB)[l * 8 + dh]);
        gab[(size_t)row * 16 + dh] = expf(g);
        gab[(size_t)row * 16 + 8 + dh] = 1.f / (1.f + expf(-blv));
    }
}

__device__ __forceinline__ int s5_chain_row(int b, int d, int q) {
    if (q < 256) return b * 256 + (d ? 255 - q : q);
    int n = q - 256; if (d) n = 4095 - n;
    return NTC + b * 4096 + (n & 63) * 64 + (n >> 6);
}
__device__ __forceinline__ void s5_load_u(const bf16_t* zr, float* dst) {
    const uint4 a = *reinterpret_cast<const uint4*>(zr);
    const uint4 b = *reinterpret_cast<const uint4*>(zr + 8);
    *reinterpret_cast<float4*>(dst + 0) = make_float4(bflo(a.x), bfhi(a.x), bflo(a.y), bfhi(a.y));
    *reinterpret_cast<float4*>(dst + 4) = make_float4(bflo(a.z), bfhi(a.z), bflo(a.w), bfhi(a.w));
    *reinterpret_cast<float4*>(dst + 8) = make_float4(bflo(b.x), bfhi(b.x), bflo(b.y), bfhi(b.y));
    *reinterpret_cast<float4*>(dst + 12) = make_float4(bflo(b.z), bfhi(b.z), bflo(b.w), bfhi(b.w));
}

__device__ __forceinline__ void s5_pre_unit(const P& p, int l, int u, char* lds) {
    const int tid = otid(), w = tid >> 6, lane = tid & 63;
    float* ust = (float*)lds + w * 1024;
    const int wt = u * 4 + w;
    const int d = wt & 1, g = (wt >> 1) & 15, rest = wt >> 5;
    const int cc = rest % NCHUNK, b = rest / NCHUNK;
    const bf16_t* z = (const bf16_t*)(p.ws + WS_Z);
    {
        const int row = s5_chain_row(b, d, cc * 64 + lane);
        s5_load_u(z + (size_t)row * ZS + COL_S5 + g * 16, ust + lane * 16);
    }
    const int tix = ((l * 2 + d) * 16 + g) * 64 + lane;
    const float4 A = *reinterpret_cast<const float4*>((const float*)(p.ws + WS_S5A) + (size_t)tix * 4);
    const float* Bp = (const float*)(p.ws + WS_S5B) + (size_t)tix * 32;
    f32x2 bb[16];
#pragma unroll
    for (int h = 0; h < 16; ++h) bb[h] = f32x2{Bp[h], Bp[16 + h]};
    float xr = 0.f, xi = 0.f;
#pragma unroll 4
    for (int s = 0; s < 64; ++s) {
        f32x2 bu = f32x2{0.f, 0.f};
#pragma unroll
        for (int h4 = 0; h4 < 4; ++h4) {
            const float4 uu = *reinterpret_cast<const float4*>(ust + s * 16 + h4 * 4);
            bu += bb[h4 * 4] * uu.x + bb[h4 * 4 + 1] * uu.y + bb[h4 * 4 + 2] * uu.z + bb[h4 * 4 + 3] * uu.w;
        }
        const float nr = A.x * xr - A.y * xi + bu.x;
        const float ni = A.x * xi + A.y * xr + bu.y;
        xr = nr; xi = ni;
    }
    float* st = (float*)(p.ws + WS_S5ST) + ((((size_t)(b * NCHUNK + cc) * 2 + d) * 16 + g) * 64 + lane) * 2;
    st[0] = xr; st[1] = xi;
}

__device__ __forceinline__ float reduce16(const float (&t)[16], int lane) {
    float a[8];
    const bool hi8 = (lane & 8) != 0;
#pragma unroll
    for (int k = 0; k < 8; ++k) { const float keep = hi8 ? t[k + 8] : t[k]; const float send = hi8 ? t[k] : t[k + 8]; a[k] = keep + dppf<0x140>(send); }
    float b[4];
    const bool hi4 = (lane & 4) != 0;
#pragma unroll
    for (int k = 0; k < 4; ++k) { const float keep = hi4 ? a[k + 4] : a[k]; const float send = hi4 ? a[k] : a[k + 4]; b[k] = keep + dppf<0x141>(send); }
    float c[2];
    const bool hi2 = (lane & 2) != 0;
#pragma unroll
    for (int k = 0; k < 2; ++k) { const float keep = hi2 ? b[k + 2] : b[k]; const float send = hi2 ? b[k] : b[k + 2]; c[k] = keep + dppf<0x4E>(send); }
    const bool hi1 = (lane & 1) != 0;
    float r = (hi1 ? c[1] : c[0]) + dppf<0xB1>(hi1 ? c[0] : c[1]);
    r += __shfl_xor(r, 16);
    r += __shfl_xor(r, 32);
    return r;
}

__device__ __forceinline__ void s5_main_unit(const P& p, int l, int u, char* lds) {
    const int tid = otid(), w = tid >> 6, lane = tid & 63;
    char* wl = lds + w * 12800;
    float* ust = (float*)wl;
    char* xbuf = wl + 4096;
    float* yst = (float*)xbuf;
    const int b = u / NCHUNK, tc = u % NCHUNK;
    bf16_t* z = (bf16_t*)(p.ws + WS_Z);
    const int myrow = (tc < 4) ? (b * 256 + tc * 64 + lane) : (NTC + b * 4096 + lane * 64 + (tc - 4));
    const int fr = lane & 15, fq = lane >> 4;
#pragma unroll 1
    for (int gi = 0; gi < 4; ++gi) {
        const int g = w * 4 + gi;
        s5_load_u(z + (size_t)myrow * ZS + COL_S5 + g * 16, ust + lane * 16);
        f32x4 yacc[4];
#pragma unroll
        for (int mf = 0; mf < 4; ++mf) yacc[mf] = f32x4{0.f, 0.f, 0.f, 0.f};
#pragma unroll 1
        for (int d = 0; d < 2; ++d) {
            const int tix = ((l * 2 + d) * 16 + g) * 64 + lane;
            const float4 A = *reinterpret_cast<const float4*>((const float*)(p.ws + WS_S5A) + (size_t)tix * 4);
            const float* Bp = (const float*)(p.ws + WS_S5B) + (size_t)tix * 32;
            f32x2 bb[16];
#pragma unroll
            for (int h = 0; h < 16; ++h) bb[h] = f32x2{Bp[h], Bp[16 + h]};
            bf16x8 cfrag[4];
            {
                const float* crp = p.in(I_S5_CRE) + (size_t)((l * 2 + d) * 16 + g) * 1024 + fr * 64;
                const float* cip = p.in(I_S5_CIM) + (size_t)((l * 2 + d) * 16 + g) * 1024 + fr * 64;
#pragma unroll
                for (int ks = 0; ks < 4; ++ks) {
                    const int k0 = (ks & 1) * 32 + fq * 8;
                    const float* src = (ks < 2) ? crp + k0 : cip + k0;
                    const float sg = (ks < 2) ? 1.f : -1.f;
                    const float4 c0 = *reinterpret_cast<const float4*>(src), c1 = *reinterpret_cast<const float4*>(src + 4);
                    cfrag[ks][0] = (short)f2bf(sg * c0.x); cfrag[ks][1] = (short)f2bf(sg * c0.y); cfrag[ks][2] = (short)f2bf(sg * c0.z); cfrag[ks][3] = (short)f2bf(sg * c0.w);
                    cfrag[ks][4] = (short)f2bf(sg * c1.x); cfrag[ks][5] = (short)f2bf(sg * c1.y); cfrag[ks][6] = (short)f2bf(sg * c1.z); cfrag[ks][7] = (short)f2bf(sg * c1.w);
                }
            }
            const int cc = d ? ((tc < 4) ? 3 - tc : 71 - tc) : tc;
            float xr = 0.f, xi = 0.f;
            {
                const float* st = (const float*)(p.ws + WS_S5ST) + ((((size_t)(b * NCHUNK) * 2 + d) * 16 + g) * 64 + lane) * 2;
                for (int c0 = 0; c0 < cc; c0 += 8) {
                    float2 sv[8];
#pragma unroll
                    for (int q = 0; q < 8; ++q) {
                        const int c2 = (c0 + q < cc) ? c0 + q : cc - 1;
                        sv[q] = *reinterpret_cast<const float2*>(st + (size_t)c2 * (2 * 16 * 64 * 2));
                    }
#pragma unroll
                    for (int q = 0; q < 8; ++q) {
                        if (c0 + q < cc) {
                            const float nr = A.z * xr - A.w * xi + sv[q].x;
                            const float ni = A.z * xi + A.w * xr + sv[q].y;
                            xr = nr; xi = ni;
                        }
                    }
                }
            }
#pragma unroll 1
            for (int hf = 0; hf < 2; ++hf) {
                const int hbase = (d ? 1 - hf : hf) * 32;
#pragma unroll 4
                for (int s = 0; s < 32; ++s) {
                    const int il = d ? 31 - s : s;
                    const float* up = ust + (hbase + il) * 16;
                    f32x2 bu = f32x2{0.f, 0.f};
#pragma unroll
                    for (int h4 = 0; h4 < 4; ++h4) {
                        const float4 uu = *reinterpret_cast<const float4*>(up + h4 * 4);
                        bu += bb[h4 * 4] * uu.x + bb[h4 * 4 + 1] * uu.y + bb[h4 * 4 + 2] * uu.z + bb[h4 * 4 + 3] * uu.w;
                    }
                    const float nr = A.x * xr - A.y * xi + bu.x;
                    const float ni = A.x * xi + A.y * xr + bu.y;
                    xr = nr; xi = ni;
                    *reinterpret_cast<bf16_t*>(xbuf + il * 272 + lane * 2) = f2bf(xr);
                    *reinterpret_cast<bf16_t*>(xbuf + il * 272 + 128 + lane * 2) = f2bf(xi);
                }
#pragma unroll
                for (int mfl = 0; mfl < 2; ++mfl) {
                    f32x4 acc = yacc[0];
                    const int mf = (hbase >> 4) + mfl;
                    acc = (mf == 0) ? yacc[0] : (mf == 1) ? yacc[1] : (mf == 2) ? yacc[2] : yacc[3];
#pragma unroll
                    for (int ks = 0; ks < 4; ++ks) {
                        const bf16x8 af = *reinterpret_cast<const bf16x8*>(xbuf + (mfl * 16 + fr) * 272 + ks * 64 + fq * 16);
                        acc = __builtin_amdgcn_mfma_f32_16x16x32_bf16(af, cfrag[ks], acc, 0, 0, 0);
                    }
                    if (mf == 0) yacc[0] = acc; else if (mf == 1) yacc[1] = acc; else if (mf == 2) yacc[2] = acc; else yacc[3] = acc;
                }
            }
        }
#pragma unroll
        for (int mf = 0; mf < 4; ++mf)
#pragma unroll
            for (int j = 0; j < 4; ++j) yst[(mf * 16 + fq * 4 + j) * 16 + fr] = yacc[mf][j];
        {
            const float* dsk = p.in(I_S5_D) + l * 256 + g * 16;
            unsigned pk[8];
#pragma unroll
            for (int h = 0; h < 16; h += 2) {
                float y0 = yst[lane * 16 + h] + ust[lane * 16 + h] * dsk[h];
                float y1 = yst[lane * 16 + h + 1] + ust[lane * 16 + h + 1] * dsk[h + 1];
                y0 = 0.5f * y0 * (1.f + erff(y0 * 0.70710678118f));
                y1 = 0.5f * y1 * (1.f + erff(y1 * 0.70710678118f));
                pk[h >> 1] = pack2(y0, y1);
            }
            uint4* dst = reinterpret_cast<uint4*>((bf16_t*)(p.ws + WS_S5G) + (size_t)myrow * 256 + g * 16);
            dst[0] = make_uint4(pk[0], pk[1], pk[2], pk[3]);
            dst[1] = make_uint4(pk[4], pk[5], pk[6], pk[7]);
        }
    }
}

#define SB 16
__device__ __forceinline__ int scan_chain_row(int b, int d, int q) {
    if (q < 256) return b * 256 + (d ? 255 - q : q);
    const int t = q - 256;
    return NTC + b * 4096 + (d ? 4095 - t : t);
}
struct ScanRaw { uint2 r, k, v, e, a; float f0, f1; };

__device__ __forceinline__ void scan_load(const P& p, int m, int b, int h, int d, int q, int cg, ScanRaw& R) {
    const int row = scan_chain_row(b, d, q);
    const int c0 = h * 64 + cg * 4;
    if (m == 0) {
        const bf16_t* z = (const bf16_t*)(p.ws + WS_Z) + (size_t)row * ZS + c0;
        R.r = *reinterpret_cast<const uint2*>(z);
        R.k = *reinterpret_cast<const uint2*>(z + 256);
        R.v = *reinterpret_cast<const uint2*>(z + 512);
        const bf16_t* rw = (const bf16_t*)(p.ws + WS_R1 + R1_RWP) + (size_t)row * 1024 + c0;
        R.e = *reinterpret_cast<const uint2*>(rw + d * 256);
        R.a = *reinterpret_cast<const uint2*>(rw + (2 + d) * 256);
        R.f0 = ((const float*)(p.ws + WS_KNORM))[(size_t)row * 4 + h];
        R.f1 = 0.f;
    } else {
        const bf16_t* gq = (const bf16_t*)(p.ws + WS_R1 + R1_GQ) + (size_t)row * 768 + c0;
        R.r = *reinterpret_cast<const uint2*>(gq);
        R.k = *reinterpret_cast<const uint2*>(gq + 256);
        R.v = *reinterpret_cast<const uint2*>(gq + 512);
        R.e = make_uint2(0u, 0u); R.a = make_uint2(0u, 0u);
        const float* gab = (const float*)(p.ws + WS_GAB) + (size_t)row * 16;
        R.f0 = gab[d * 4 + h];
        R.f1 = gab[8 + d * 4 + h];
    }
}
__device__ __forceinline__ void scan_store(int m, const ScanRaw& R, float* dst  , const float (&kkp)[4], const float (&kap)[4]) {
    float r[4] = {bflo(R.r.x), bfhi(R.r.x), bflo(R.r.y), bfhi(R.r.y)};
    float k[4] = {bflo(R.k.x), bfhi(R.k.x), bflo(R.k.y), bfhi(R.k.y)};
    float v[4] = {bflo(R.v.x), bfhi(R.v.x), bflo(R.v.y), bfhi(R.v.y)};
    float ww[4], aa[4], bb[4], kk[4];
    if (m == 0) {
        float e[4] = {bflo(R.e.x), bfhi(R.e.x), bflo(R.e.y), bfhi(R.e.y)};
        float a[4] = {bflo(R.a.x), bfhi(R.a.x), bflo(R.a.y), bfhi(R.a.y)};
#pragma unroll
        for (int i = 0; i < 4; ++i) {
            ww[i] = __expf(-e[i]);
            kk[i] = k[i] * (1.f + (a[i] - 1.f) * kap[i]);
            const float kn = k[i] * kkp[i] * R.f0;
            aa[i] = -kn;
            bb[i] = kn * a[i];
        }
    } else {
        const float al = R.f0, be = R.f1;
#pragma unroll
        for (int i = 0; i < 4; ++i) { ww[i] = al; aa[i] = k[i]; bb[i] = -al * be * k[i]; kk[i] = be * k[i]; }
    }
    *reinterpret_cast<float4*>(dst + 0 * 64) = make_float4(ww[0], ww[1], ww[2], ww[3]);
    *reinterpret_cast<float4*>(dst + 1 * 64) = make_float4(aa[0], aa[1], aa[2], aa[3]);
    *reinterpret_cast<float4*>(dst + 2 * 64) = make_float4(bb[0], bb[1], bb[2], bb[3]);
    *reinterpret_cast<float4*>(dst + 3 * 64) = make_float4(kk[0], kk[1], kk[2], kk[3]);
    *reinterpret_cast<float4*>(dst + 4 * 64) = make_float4(r[0], r[1], r[2], r[3]);
    *reinterpret_cast<float4*>(dst + 5 * 64) = make_float4(v[0], v[1], v[2], v[3]);
}

__device__ __forceinline__ void scan_unit(const P& p, int l, int u, char* lds) {
    const int tid = otid();
    const int chain = u >> 1, half = u & 1;
    const int m = chain >> 6, rem = chain & 63, b = rem >> 3, h = (rem >> 1) & 3, d = rem & 1;
    float* buf = (float*)lds;
    float* ybuf = buf + 2 * SB * 384;
    const int rp = tid >> 4, sub = tid & 15;
    const int st = tid >> 4, cg = tid & 15;
    float kkp[4], kap[4];
#pragma unroll
    for (int i = 0; i < 4; ++i) { kkp[i] = p.in(I_RW_KK)[l * 256 + h * 64 + cg * 4 + i]; kap[i] = p.in(I_RW_KA)[l * 256 + h * 64 + cg * 4 + i]; }
    bf16_t* ys = (bf16_t*)(p.ws + WS_HBY) + (size_t)(m * 2 + d) * NT * 256;
    f32x2 S2[4];
#pragma unroll
    for (int j = 0; j < 4; ++j) S2[j] = f32x2{0.f, 0.f};
    ScanRaw R, R2;
    scan_load(p, m, b, h, d, st, cg, R);
    scan_store(m, R, buf + (st * 6) * 64 + cg * 4, kkp, kap);
    scan_load(p, m, b, h, d, SB + st, cg, R);
    __syncthreads();
    const int NB = 4352 / SB;
    __builtin_amdgcn_s_setprio(2);
    auto batch = [&](int bt, ScanRaw& Rld, ScanRaw& Rst) {
        const int par = bt & 1;
        if (bt + 2 < NB) scan_load(p, m, b, h, d, (bt + 2) * SB + st, cg, Rld);
        const float* cb = buf + par * (SB * 384);
        float* yb = ybuf + par * (SB * 32);
        {
            const float* sb0 = cb + sub * 4;
            const float* vb0 = cb + 320 + half * 32 + rp;
            float4 nw = *reinterpret_cast<const float4*>(sb0), na = *reinterpret_cast<const float4*>(sb0 + 64), nb = *reinterpret_cast<const float4*>(sb0 + 128);
            float4 nk = *reinterpret_cast<const float4*>(sb0 + 192), nr = *reinterpret_cast<const float4*>(sb0 + 256);
            float nvA = vb0[0], nvB = vb0[16];
            float4 mw = *reinterpret_cast<const float4*>(sb0 + 384), ma = *reinterpret_cast<const float4*>(sb0 + 384 + 64), mb = *reinterpret_cast<const float4*>(sb0 + 384 + 128);
            float4 mk = *reinterpret_cast<const float4*>(sb0 + 384 + 192), mr = *reinterpret_cast<const float4*>(sb0 + 384 + 256);
            float mvA = vb0[384], mvB = vb0[384 + 16];
#pragma unroll
            for (int s = 0; s < SB; ++s) {
                const float4 w = nw, a = na, bq = nb, k = nk, r = nr;
                const float vA = nvA, vB = nvB;
                nw = mw; na = ma; nb = mb; nk = mk; nr = mr; nvA = mvA; nvB = mvB;
                if (s + 2 < SB) {
                    const float* sb = sb0 + (s + 2) * 384;
                    mw = *reinterpret_cast<const float4*>(sb); ma = *reinterpret_cast<const float4*>(sb + 64); mb = *reinterpret_cast<const float4*>(sb + 128);
                    mk = *reinterpret_cast<const float4*>(sb + 192); mr = *reinterpret_cast<const float4*>(sb + 256);
                    mvA = vb0[(s + 2) * 384]; mvB = vb0[(s + 2) * 384 + 16];
                }
                __builtin_amdgcn_sched_barrier(0);
                const f32x2 v2 = {vA, vB};
                f32x2 sa2 = S2[0] * a.x + S2[1] * a.y + S2[2] * a.z + S2[3] * a.w;
                float sa = sa2.x, sb2 = sa2.y;
                dpp_allreduce16_x2(sa, sb2);
                sa2.x = sa; sa2.y = sb2;
                S2[0] = S2[0] * w.x + sa2 * bq.x + v2 * k.x;
                S2[1] = S2[1] * w.y + sa2 * bq.y + v2 * k.y;
                S2[2] = S2[2] * w.z + sa2 * bq.z + v2 * k.z;
                S2[3] = S2[3] * w.w + sa2 * bq.w + v2 * k.w;
                const f32x2 y2 = S2[0] * r.x + S2[1] * r.y + S2[2] * r.z + S2[3] * r.w;
                float yA = y2.x, yB = y2.y;
                dpp_allreduce16_x2(yA, yB);
                yb[s * 32 + rp] = yA; yb[s * 32 + 16 + rp] = yB;
            }
        }
        if (bt + 1 < NB) scan_store(m, Rst, buf + (1 - par) * (SB * 384) + (st * 6) * 64 + cg * 4, kkp, kap);
        __syncthreads();
        {
            const int r2 = cg * 2;
            const int row = scan_chain_row(b, d, bt * SB + st);
            const unsigned pk = pack2(yb[st * 32 + r2], yb[st * 32 + r2 + 1]);
            *reinterpret_cast<unsigned*>(ys + (size_t)row * 256 + h * 64 + half * 32 + r2) = pk;
        }
    };
#pragma unroll 1
    for (int bt = 0; bt < NB; bt += 2) { batch(bt, R2, R); batch(bt + 1, R, R2); }
    __builtin_amdgcn_s_setprio(0);
    __syncthreads();
}

__device__ __forceinline__ void scan_unit_gd2(const P& p, int l, int u, char* lds) {
    const int tid = otid();
    const int chain = 64 + (u >> 1), half = u & 1;
    const int m = chain >> 6, rem = chain & 63, b = rem >> 3, h = (rem >> 1) & 3, d = rem & 1;
    float* buf = (float*)lds;
    float* ybuf = buf + 2 * SB * 384;
    const int rp = tid >> 4, sub = tid & 15;
    const int st = tid >> 4, cg = tid & 15;
    float kkp[4], kap[4];
#pragma unroll
    for (int i = 0; i < 4; ++i) { kkp[i] = p.in(I_RW_KK)[l * 256 + h * 64 + cg * 4 + i]; kap[i] = p.in(I_RW_KA)[l * 256 + h * 64 + cg * 4 + i]; }
    bf16_t* ys = (bf16_t*)(p.ws + WS_HBY) + (size_t)(m * 2 + d) * NT * 256;
    f32x2 S2[4];
#pragma unroll
    for (int j = 0; j < 4; ++j) S2[j] = f32x2{0.f, 0.f};
    ScanRaw R, R2;
    scan_load(p, m, b, h, d, st, cg, R);
    scan_store(m, R, buf + (st * 6) * 64 + cg * 4, kkp, kap);
    scan_load(p, m, b, h, d, SB + st, cg, R);
    __syncthreads();
    const int NB = 4352 / SB;
    __builtin_amdgcn_s_setprio(2);
    auto batch = [&](int bt, ScanRaw& Rld, ScanRaw& Rst) {
        const int par = bt & 1;
        if (bt + 2 < NB) scan_load(p, m, b, h, d, (bt + 2) * SB + st, cg, Rld);
        const float* cb = buf + par * (SB * 384);
        float* yb = ybuf + par * (SB * 32);
        {
            const float* sb0 = cb + sub * 4;
            const float* vb0 = cb + 320 + half * 32 + rp;
            float4 na = *reinterpret_cast<const float4*>(sb0 + 64), nk = *reinterpret_cast<const float4*>(sb0 + 192), nr = *reinterpret_cast<const float4*>(sb0 + 256);
            float nal = cb[0], nvA = vb0[0], nvB = vb0[16];
            float4 ma = *reinterpret_cast<const float4*>(sb0 + 384 + 64), mk = *reinterpret_cast<const float4*>(sb0 + 384 + 192), mr = *reinterpret_cast<const float4*>(sb0 + 384 + 256);
            float mal = cb[384], mvA = vb0[384], mvB = vb0[384 + 16];
#pragma unroll
            for (int s = 0; s < SB; ++s) {
                const float4 a = na, k = nk, r = nr;
                const float al = nal, vA = nvA, vB = nvB;
                na = ma; nk = mk; nr = mr; nal = mal; nvA = mvA; nvB = mvB;
                if (s + 2 < SB) {
                    const float* sb = sb0 + (s + 2) * 384;
                    ma = *reinterpret_cast<const float4*>(sb + 64); mk = *reinterpret_cast<const float4*>(sb + 192); mr = *reinterpret_cast<const float4*>(sb + 256);
                    mal = cb[(s + 2) * 384]; mvA = vb0[(s + 2) * 384]; mvB = vb0[(s + 2) * 384 + 16];
                }
                __builtin_amdgcn_sched_barrier(0);
                const f32x2 v2 = {vA, vB};
                f32x2 d2 = S2[0] * a.x + S2[1] * a.y + S2[2] * a.z + S2[3] * a.w;
                float sa = d2.x, sb2 = d2.y;
                dpp_allreduce16_x2(sa, sb2);
                d2.x = sa; d2.y = sb2;
                const f32x2 e2 = v2 - d2 * al;
                S2[0] = S2[0] * al + e2 * k.x;
                S2[1] = S2[1] * al + e2 * k.y;
                S2[2] = S2[2] * al + e2 * k.z;
                S2[3] = S2[3] * al + e2 * k.w;
                const f32x2 y2 = S2[0] * r.x + S2[1] * r.y + S2[2] * r.z + S2[3] * r.w;
                float yA = y2.x, yB = y2.y;
                dpp_allreduce16_x2(yA, yB);
                yb[s * 32 + rp] = yA; yb[s * 32 + 16 + rp] = yB;
            }
        }
        if (bt + 1 < NB) scan_store(m, Rst, buf + (1 - par) * (SB * 384) + (st * 6) * 64 + cg * 4, kkp, kap);
        __syncthreads();
        {
            const int r2 = cg * 2;
            const int row = scan_chain_row(b, d, bt * SB + st);
            const unsigned pk = pack2(yb[st * 32 + r2], yb[st * 32 + r2 + 1]);
            *reinterpret_cast<unsigned*>(ys + (size_t)row * 256 + h * 64 + half * 32 + r2) = pk;
        }
    };
#pragma unroll 1
    for (int bt = 0; bt < NB; bt += 2) { batch(bt, R2, R); batch(bt + 1, R, R2); }
    __builtin_amdgcn_s_setprio(0);
    __syncthreads();
}

template <int L>
__device__ __forceinline__ void hyena_unit(const P& p, int l, int u, char* lds) {
    constexpr int TPT = L / 256;
    const int tid = otid();
    const int c = u >> 2, bp = u & 3;
    float2* u2 = (float2*)lds;
    float* taps = (float*)(lds + (size_t)L * 8);
    const bf16_t* z = (const bf16_t*)(p.ws + WS_Z);
    bf16_t* cat = (bf16_t*)(p.ws + WS_CAT);
    const float* F = (L == 4096) ? (const float*)(p.ws + WS_FILTL + l * SZ_FILTL) : (const float*)(p.ws + WS_FILTC + l * SZ_FILTC);
    int base[2];
#pragma unroll
    for (int bb = 0; bb < 2; ++bb) { const int b = bp * 2 + bb; base[bb] = (L == 4096) ? NTC + b * 4096 : b * 256; }
    const int t0 = tid * TPT;
    const float* cw = p.in(I_HY_CONV) + (size_t)l * 3 * 768; const float* cb = p.in(I_HY_CONVB) + (size_t)l * 768;
    auto sconv = [&](int part, int bb, float (&o)[TPT]) {
        const int ch = part * 256 + c;
        const float w0 = cw[ch], w1 = cw[768 + ch], w2 = cw[1536 + ch], bs = cb[ch];
        const bf16_t* zc = z + (size_t)base[bb] * ZS + COL_HY + ch;
        float xm = (t0 > 0) ? bf2f(zc[(size_t)(t0 - 1) * ZS]) : 0.f;
        float x0 = bf2f(zc[(size_t)t0 * ZS]);
#pragma unroll
        for (int i = 0; i < TPT; ++i) {
            const int t = t0 + i;
            const float xp = (t + 1 < L) ? bf2f(zc[(size_t)(t + 1) * ZS]) : 0.f;
            o[i] = w0 * xm + w1 * x0 + w2 * xp + bs;
            xm = x0; x0 = xp;
        }
    };
    {
        float v0[TPT], v1[TPT];
        sconv(2, 0, v0); sconv(2, 1, v1);
#pragma unroll
        for (int i = 0; i < TPT; ++i) u2[t0 + i] = make_float2(v0[i], v1[i]);
    }
#pragma unroll 1
    for (int o = 0; o < 2; ++o) {
        const float* hf = F + ((size_t)(o * 2 + 0) * 256 + c) * L;
        const float* hbk = F + ((size_t)(o * 2 + 1) * 256 + c) * L;
        for (int k = tid; k < 2 * L; k += NTHREADS) {
            const int dd = k - (L - 1);
            taps[k] = (dd >= L) ? 0.f : (dd >= 0 ? hf[dd] : hbk[-dd]);
        }
        __syncthreads();
        float acc[TPT][2];
#pragma unroll
        for (int i = 0; i < TPT; ++i) { acc[i][0] = 0.f; acc[i][1] = 0.f; }
        if (L == 4096) {
#pragma unroll 1
            for (int s0 = 0; s0 < L; s0 += 16) {
                const int k0 = t0 - s0 + (L - 16);
                float W[32];
#pragma unroll
                for (int q = 0; q < 8; ++q) {
                    const float4 t4 = *reinterpret_cast<const float4*>(taps + k0 + q * 4);
                    W[q * 4] = t4.x; W[q * 4 + 1] = t4.y; W[q * 4 + 2] = t4.z; W[q * 4 + 3] = t4.w;
                }
#pragma unroll
                for (int j = 0; j < 16; ++j) {
                    const float2 uj = u2[s0 + j];
#pragma unroll
                    for (int i = 0; i < TPT; ++i) {
                        const float wv = W[(i - j + 15) & 31];
                        acc[i][0] += wv * uj.x; acc[i][1] += wv * uj.y;
                    }
                }
            }
        } else {
            for (int s = 0; s < L; ++s) {
                const float2 uj = u2[s];
                const float wv = taps[t0 - s + (L - 1)];
                acc[0][0] += wv * uj.x; acc[0][1] += wv * uj.y;
            }
        }
        const float sk = p.in(I_HY_SKIP)[(size_t)(l * 2 + o) * 256 + c];
        float res[TPT][2];
        {
            float g0[TPT], g1[TPT];
            sconv(o, 0, g0); sconv(o, 1, g1);
#pragma unroll
            for (int i = 0; i < TPT; ++i) {
                const float2 ut = u2[t0 + i];
                res[i][0] = g0[i] * (acc[i][0] + sk * ut.x);
                res[i][1] = g1[i] * (acc[i][1] + sk * ut.y);
            }
        }
        __syncthreads();
        if (o == 0) {
#pragma unroll
            for (int i = 0; i < TPT; ++i) u2[t0 + i] = make_float2(res[i][0], res[i][1]);
        } else {
#pragma unroll
            for (int i = 0; i < TPT; ++i) {
                cat[(size_t)(base[0] + t0 + i) * DM + 512 + c] = f2bf(res[i][0]);
                cat[(size_t)(base[1] + t0 + i) * DM + 512 + c] = f2bf(res[i][1]);
            }
        }
        __syncthreads();
    }
}


#define FFT_BS 272
__device__ __forceinline__ int fphys(int d2, int d1, int d0) { return d2 * FFT_BS + d1 * 17 + d0; }
__device__ __forceinline__ float2 cmulf(float2 a, float2 b) { return make_float2(a.x * b.x - a.y * b.y, a.x * b.y + a.y * b.x); }
__device__ static constexpr float C32T[16] = {1.000000000e+00f, 9.807852804e-01f, 9.238795325e-01f, 8.314696123e-01f, 7.071067812e-01f, 5.555702330e-01f, 3.826834324e-01f, 1.950903220e-01f, 6.123233996e-17f, -1.950903220e-01f, -3.826834324e-01f, -5.555702330e-01f, -7.071067812e-01f, -8.314696123e-01f, -9.238795325e-01f, -9.807852804e-01f};
__device__ static constexpr float S32T[16] = {0.000000000e+00f, 1.950903220e-01f, 3.826834324e-01f, 5.555702330e-01f, 7.071067812e-01f, 8.314696123e-01f, 9.238795325e-01f, 9.807852804e-01f, 1.000000000e+00f, 9.807852804e-01f, 9.238795325e-01f, 8.314696123e-01f, 7.071067812e-01f, 5.555702330e-01f, 3.826834324e-01f, 1.950903220e-01f};
template <int LOG> __device__ __forceinline__ constexpr int brev(int i) { int r = 0; for (int b = 0; b < LOG; ++b) r |= ((i >> b) & 1) << (LOG - 1 - b); return r; }
template <int R, bool INV> __device__ __forceinline__ void dftR(float2 (&v)[R]) {
    constexpr int LOG = (R == 32) ? 5 : 4;
    float2 t[R];
#pragma unroll
    for (int i = 0; i < R; ++i) t[brev<LOG>(i)] = v[i];
#pragma unroll
    for (int st = 1; st <= LOG; ++st) {
        const int len = 1 << st, half = len >> 1;
#pragma unroll
        for (int i = 0; i < R; i += len)
#pragma unroll
            for (int j = 0; j < half; ++j) {
                const int tw = j * (32 / len);
                const float2 a = t[i + j], b = t[i + j + half];
                float2 bw;
                if (tw == 0) bw = b;
                else if (tw == 8) bw = INV ? make_float2(-b.y, b.x) : make_float2(b.y, -b.x);
                else { const float wr = C32T[tw], wi = INV ? S32T[tw] : -S32T[tw]; bw = make_float2(b.x * wr - b.y * wi, b.x * wi + b.y * wr); }
                t[i + j] = make_float2(a.x + bw.x, a.y + bw.y);
                t[i + j + half] = make_float2(a.x - bw.x, a.y - bw.y);
            }
    }
#pragma unroll
    for (int i = 0; i < R; ++i) v[i] = t[i];
}
template <int R> __device__ __forceinline__ void twiddle_pow(float2 (&v)[R], float2 first, float2 base) {
    float2 w = first;
#pragma unroll
    for (int k = 0; k < R; ++k) { v[k] = cmulf(v[k], w); w = cmulf(w, base); }
}
__device__ __forceinline__ float2 cispi(float x) { float sn, cs; sincospif(x, &sn, &cs); return make_float2(cs, sn); }

__device__ __forceinline__ void fft_fwd_A_B1(float2 (&v)[32], float2* buf, int tid_in) {
    int tid = tid_in; asm volatile("" : "+v"(tid));
    const int a = tid >> 4, b = tid & 15;
    dftR<32, false>(v);
    twiddle_pow<32>(v, make_float2(1.f, 0.f), cispi(-2.f * (float)tid * (1.f / 8192.f)));
#pragma unroll
    for (int k1 = 0; k1 < 32; ++k1) buf[fphys(k1, a, b)] = v[k1];
    __syncthreads();
#pragma unroll 1
    for (int j = 0; j < 2; ++j) {
        const int g = tid + 256 * j, k1 = g >> 4, bb = g & 15;
        float2 w[16];
#pragma unroll
        for (int aa = 0; aa < 16; ++aa) w[aa] = buf[fphys(k1, aa, bb)];
        dftR<16, false>(w);
        twiddle_pow<16>(w, make_float2(1.f, 0.f), cispi(-2.f * (float)bb * (1.f / 256.f)));
#pragma unroll
        for (int ka = 0; ka < 16; ++ka) buf[fphys(k1, ka, bb)] = w[ka];
    }
    __syncthreads();
}
__device__ __forceinline__ void fft_inv_B1_A(float2 (&v)[32], float2* buf, int tid_in) {
    int tid = tid_in; asm volatile("" : "+v"(tid));
#pragma unroll 1
    for (int j = 0; j < 2; ++j) {
        const int g = tid + 256 * j, k1 = g >> 4, bb = g & 15;
        float2 w[16];
#pragma unroll
        for (int ka = 0; ka < 16; ++ka) w[ka] = buf[fphys(k1, ka, bb)];
        dftR<16, true>(w);
        twiddle_pow<16>(w, cispi(2.f * (float)(k1 * bb) * (1.f / 8192.f)), cispi(2.f * (float)k1 * (1.f / 512.f)));
#pragma unroll
        for (int aa = 0; aa < 16; ++aa) buf[fphys(k1, aa, bb)] = w[aa];
    }
    __syncthreads();
    const int a = tid >> 4, b = tid & 15;
#pragma unroll
    for (int k1 = 0; k1 < 32; ++k1) v[k1] = buf[fphys(k1, a, b)];
    dftR<32, true>(v);
}

__device__ __forceinline__ void hfft_unit(const P& p, int l, int u, char* lds) {
    const int tid = otid();
    float2* buf = (float2*)lds;
    float* F = (float*)(p.ws + WS_FILTL + l * SZ_FILTL) + (size_t)u * 8192;
    float2 v[32];
#pragma unroll
    for (int n1 = 0; n1 < 32; ++n1) {
        const int n = 256 * n1 + tid;
        float x;
        if (n1 < 16) x = F[n];
        else x = (n == 4096) ? 0.f : F[4096 + (8192 - n)];
        if (n == 0) x += p.in(I_HY_SKIP)[(size_t)l * 512 + u];
        v[n1] = make_float2(x, 0.f);
    }
    fft_fwd_A_B1(v, buf, tid);
    __half2* H = (__half2*)F;
#pragma unroll 1
    for (int j = 0; j < 2; ++j) {
        const int g = tid + 256 * j, k1 = g >> 4, ka = g & 15;
        float2 w[16];
#pragma unroll
        for (int bb = 0; bb < 16; ++bb) w[bb] = buf[fphys(k1, ka, bb)];
        dftR<16, false>(w);
        unsigned pk[16];
#pragma unroll
        for (int kb = 0; kb < 16; ++kb) { const __half2 h = __floats2half2_rn(w[kb].x, w[kb].y); pk[kb] = *reinterpret_cast<const unsigned*>(&h); }
        uint4* dst = reinterpret_cast<uint4*>(H + (size_t)g * 16);
        dst[0] = make_uint4(pk[0], pk[1], pk[2], pk[3]); dst[1] = make_uint4(pk[4], pk[5], pk[6], pk[7]);
        dst[2] = make_uint4(pk[8], pk[9], pk[10], pk[11]); dst[3] = make_uint4(pk[12], pk[13], pk[14], pk[15]);
    }
    __syncthreads();
}

__device__ __forceinline__ void hyena_prep_unit(const P& p, int l, int u, char* lds) {
    const int tid = otid();
    bf16_t* tile = (bf16_t*)lds;
    const int b = u >> 6, t0 = (u & 63) * 64;
    const bf16_t* z = (const bf16_t*)(p.ws + WS_Z) + (size_t)(NTC + b * 4096) * ZS + COL_HY;
    bf16_t* hyT = (bf16_t*)(p.ws + WS_HYT);
    const float* cw = p.in(I_HY_CONV) + (size_t)l * 3 * 768; const float* cb = p.in(I_HY_CONVB) + (size_t)l * 768;
    const int tl = tid >> 5, cg = tid & 31;
#pragma unroll 1
    for (int part = 0; part < 3; ++part) {
        const int ch0 = part * 256 + cg * 8;
        float w0[8], w1[8], w2[8], bs[8];
#pragma unroll
        for (int i = 0; i < 8; ++i) { w0[i] = cw[ch0 + i]; w1[i] = cw[768 + ch0 + i]; w2[i] = cw[1536 + ch0 + i]; bs[i] = cb[ch0 + i]; }
#pragma unroll 2
        for (int it = 0; it < 8; ++it) {
            const int tk = it * 8 + tl, t = t0 + tk;
            const bf16_t* zc = z + (size_t)t * ZS + ch0;
            const uint4 zero4 = make_uint4(0u, 0u, 0u, 0u);
            const uint4 vm = (t > 0) ? *reinterpret_cast<const uint4*>(zc - ZS) : zero4;
            const uint4 v0 = *reinterpret_cast<const uint4*>(zc);
            const uint4 vp = (t + 1 < 4096) ? *reinterpret_cast<const uint4*>(zc + ZS) : zero4;
            float xm[8], x0[8], xp[8];
            unpack8(vm, xm); unpack8(v0, x0); unpack8(vp, xp);
#pragma unroll
            for (int i = 0; i < 8; ++i) tile[(cg * 8 + i) * 72 + tk] = f2bf(w0[i] * xm[i] + w1[i] * x0[i] + w2[i] * xp[i] + bs[i]);
        }
        __syncthreads();
#pragma unroll
        for (int k = 0; k < 8; ++k) {
            const int chl = (tid >> 3) + 32 * k, seg = tid & 7;
            const uint4 val = *reinterpret_cast<const uint4*>(tile + chl * 72 + seg * 8);
            *reinterpret_cast<uint4*>(hyT + ((size_t)(b * 3 + part) * 256 + chl) * 4096 + t0 + seg * 8) = val;
        }
        __syncthreads();
    }
}

template <int O>
__device__ __forceinline__ void hyena_conv_pass(const P& p, int l, int c, int bp, int tid, float2 (&v)[32], float2* buf) {
    const bf16_t* hyT = (const bf16_t*)(p.ws + WS_HYT);
#pragma unroll
    for (int j = 16; j < 32; ++j) v[j] = make_float2(0.f, 0.f);
    fft_fwd_A_B1(v, buf, tid);
    const __half2* H = (const __half2*)((const float*)(p.ws + WS_FILTL + l * SZ_FILTL) + (size_t)(O * 256 + c) * 8192);
    int tm = tid; asm volatile("" : "+v"(tm));
#pragma unroll 1
    for (int j = 0; j < 2; ++j) {
        const int g = tm + 256 * j, k1 = g >> 4, ka = g & 15;
        float2 w[16];
#pragma unroll
        for (int bb = 0; bb < 16; ++bb) w[bb] = buf[fphys(k1, ka, bb)];
        dftR<16, false>(w);
        const uint4* hp = reinterpret_cast<const uint4*>(H + (size_t)g * 16);
        unsigned hk[16];
#pragma unroll
        for (int q = 0; q < 4; ++q) { const uint4 t4 = hp[q]; hk[q * 4] = t4.x; hk[q * 4 + 1] = t4.y; hk[q * 4 + 2] = t4.z; hk[q * 4 + 3] = t4.w; }
#pragma unroll
        for (int kb = 0; kb < 16; ++kb) { const float2 hf = __half22float2(*reinterpret_cast<const __half2*>(&hk[kb])); w[kb] = cmulf(w[kb], hf); }
        dftR<16, true>(w);
        twiddle_pow<16>(w, make_float2(1.f, 0.f), cispi(2.f * (float)ka * (1.f / 256.f)));
#pragma unroll
        for (int bb = 0; bb < 16; ++bb) buf[fphys(k1, ka, bb)] = w[bb];
    }
    __syncthreads();
    fft_inv_B1_A(v, buf, tid);
    asm volatile("" ::: "memory");
    int tq = tid; asm volatile("" : "+v"(tq));
    const bf16_t* g0 = hyT + ((size_t)((bp * 2 + 0) * 3 + O) * 256 + c) * 4096 + tq;
    const bf16_t* g1 = hyT + ((size_t)((bp * 2 + 1) * 3 + O) * 256 + c) * 4096 + tq;
    const float sc = 1.f / 8192.f;
#pragma unroll
    for (int j = 0; j < 16; ++j) {
        const float ga = bf2f(g0[256 * j]) * sc, gb = bf2f(g1[256 * j]) * sc;
        v[j] = make_float2(ga * v[j].x, gb * v[j].y);
    }
    __syncthreads();
}

__device__ __forceinline__ void hyena_fft_unit(const P& p, int l, int u, char* lds) {
    const int tid = otid();
    const int c = u >> 2, bp = u & 3;
    float2* buf = (float2*)lds;
    const bf16_t* hyT = (const bf16_t*)(p.ws + WS_HYT);
    bf16_t* cat = (bf16_t*)(p.ws + WS_CAT);
    float2 v[32];
    {
        const bf16_t* v0p = hyT + ((size_t)((bp * 2 + 0) * 3 + 2) * 256 + c) * 4096 + tid;
        const bf16_t* v1p = hyT + ((size_t)((bp * 2 + 1) * 3 + 2) * 256 + c) * 4096 + tid;
#pragma unroll
        for (int j = 0; j < 16; ++j) v[j] = make_float2(bf2f(v0p[256 * j]), bf2f(v1p[256 * j]));
    }
    hyena_conv_pass<0>(p, l, c, bp, tid, v, buf);
    hyena_conv_pass<1>(p, l, c, bp, tid, v, buf);
    int tq = tid; asm volatile("" : "+v"(tq));
#pragma unroll
    for (int j = 0; j < 16; ++j) {
        const int t = tq + 256 * j;
        cat[(size_t)(NTC + (bp * 2 + 0) * 4096 + t) * DM + 512 + c] = f2bf(v[j].x);
        cat[(size_t)(NTC + (bp * 2 + 1) * 4096 + t) * DM + 512 + c] = f2bf(v[j].y);
    }
}

__device__ __forceinline__ void rwkv_post_unit(const P& p, int l, int u, char* lds) {
    const int tid = otid();
    bf16_t* sgb = (bf16_t*)lds;
    float* gt = (float*)(lds + 4608);
    const bf16_t* z = (const bf16_t*)(p.ws + WS_Z);
    const bf16_t* rwp = (const bf16_t*)(p.ws + WS_R1 + R1_RWP);
    const bf16_t* ys = (const bf16_t*)(p.ws + WS_HBY);
    bf16_t* cat = (bf16_t*)(p.ws + WS_CAT);
    const int row0 = u * 32;
    {
        const int tok = tid >> 3, j0 = (tid & 7) * 8;
        float gl[8];
        unpack8(*reinterpret_cast<const uint4*>(z + (size_t)(row0 + tok) * ZS + 896 + j0), gl);
#pragma unroll
        for (int i = 0; i < 8; ++i) gl[i] = sigm(gl[i]);
        *reinterpret_cast<uint4*>(sgb + tok * 72 + j0) = pack8(gl);
    }
    __syncthreads();
    {
        const int w = tid >> 6, lane = tid & 63, fr = lane & 15, fq = lane >> 4;
        const bf16_t* g2t = (const bf16_t*)(p.ws + WS_G2T) + (size_t)l * 256 * 64;
        f32x4 acc[2][4];
#pragma unroll
        for (int mf = 0; mf < 2; ++mf)
#pragma unroll
            for (int nf = 0; nf < 4; ++nf) acc[mf][nf] = f32x4{0.f, 0.f, 0.f, 0.f};
#pragma unroll
        for (int ks = 0; ks < 2; ++ks) {
            bf16x8 af[2], bfr[4];
#pragma unroll
            for (int mf = 0; mf < 2; ++mf) af[mf] = *reinterpret_cast<const bf16x8*>(sgb + (mf * 16 + fr) * 72 + ks * 32 + fq * 8);
#pragma unroll
            for (int nf = 0; nf < 4; ++nf) bfr[nf] = *reinterpret_cast<const bf16x8*>(g2t + (size_t)(w * 64 + nf * 16 + fr) * 64 + ks * 32 + fq * 8);
#pragma unroll
            for (int mf = 0; mf < 2; ++mf)
#pragma unroll
                for (int nf = 0; nf < 4; ++nf) acc[mf][nf] = __builtin_amdgcn_mfma_f32_16x16x32_bf16(af[mf], bfr[nf], acc[mf][nf], 0, 0, 0);
        }
#pragma unroll
        for (int mf = 0; mf < 2; ++mf)
#pragma unroll
            for (int nf = 0; nf < 4; ++nf)
#pragma unroll
                for (int j = 0; j < 4; ++j) gt[(mf * 16 + fq * 4 + j) * 264 + w * 64 + nf * 16 + fr] = acc[mf][nf][j];
    }
    __syncthreads();
    {
        const int tl = tid >> 5, cg = tid & 31, c0 = cg * 8;
        float ka[8], rk[8], gng[8], gnb[8];
#pragma unroll
        for (int i = 0; i < 8; ++i) {
            ka[i] = p.in(I_RW_KA)[l * 256 + c0 + i]; rk[i] = p.in(I_RW_RK)[l * 256 + c0 + i];
            gng[i] = p.in(I_RW_GNG)[l * 256 + c0 + i]; gnb[i] = p.in(I_RW_GNB)[l * 256 + c0 + i];
        }
#pragma unroll 2
        for (int it = 0; it < 4; ++it) {
            const int tok = it * 8 + tl, row = row0 + tok;
            float ya[8], yb[8], r[8], k[8], v[8], a0[8], a1[8], o[8];
            unpack8(*reinterpret_cast<const uint4*>(ys + (size_t)row * 256 + c0), ya);
            unpack8(*reinterpret_cast<const uint4*>(ys + (size_t)NT * 256 + (size_t)row * 256 + c0), yb);
            const bf16_t* zr = z + (size_t)row * ZS + c0;
            unpack8(*reinterpret_cast<const uint4*>(zr), r);
            unpack8(*reinterpret_cast<const uint4*>(zr + 256), k);
            unpack8(*reinterpret_cast<const uint4*>(zr + 512), v);
            unpack8(*reinterpret_cast<const uint4*>(rwp + ((size_t)row * 4 + 2) * 256 + c0), a0);
            unpack8(*reinterpret_cast<const uint4*>(rwp + ((size_t)row * 4 + 3) * 256 + c0), a1);
            float sy = 0.f, sd = 0.f;
#pragma unroll
            for (int i = 0; i < 8; ++i) {
                ya[i] += yb[i]; sy += ya[i];
                const float kd = k[i] * (1.f + (a0[i] - 1.f) * ka[i]) + k[i] * (1.f + (a1[i] - 1.f) * ka[i]);
                sd += r[i] * kd * rk[i];
            }
            const float mu = sum8lanes(sy) * (1.f / 64.f);
            const float dot = sum8lanes(sd);
            float sq = 0.f;
#pragma unroll
            for (int i = 0; i < 8; ++i) { ya[i] -= mu; sq += ya[i] * ya[i]; }
            const float rs = rsqrtf(sum8lanes(sq) * (1.f / 64.f) + 64e-5f);
            const float4 g0 = *reinterpret_cast<const float4*>(gt + tok * 264 + c0), g1 = *reinterpret_cast<const float4*>(gt + tok * 264 + c0 + 4);
            const float gg[8] = {g0.x, g0.y, g0.z, g0.w, g1.x, g1.y, g1.z, g1.w};
#pragma unroll
            for (int i = 0; i < 8; ++i) o[i] = (ya[i] * rs * gng[i] + gnb[i] + dot * v[i]) * gg[i];
            *reinterpret_cast<uint4*>(cat + (size_t)row * DM + c0) = pack8(o);
        }
    }
    __syncthreads();
}

__device__ __forceinline__ void gdn_post_unit(const P& p, int l, int u) {
    const int tid = otid();
    const bf16_t* z = (const bf16_t*)(p.ws + WS_Z);
    const bf16_t* ys = (const bf16_t*)(p.ws + WS_HBY) + (size_t)2 * NT * 256;
    bf16_t* cat = (bf16_t*)(p.ws + WS_CAT);
    const int tl = tid >> 5, cg = tid & 31, c0 = cg * 8;
    float ng[8];
#pragma unroll
    for (int i = 0; i < 8; ++i) ng[i] = p.in(I_GD_NORM)[l * 64 + ((c0 + i) & 63)];
    const int row0 = u * 32;
#pragma unroll 2
    for (int it = 0; it < 4; ++it) {
        const int row = row0 + it * 8 + tl;
        const uint4 a4 = *reinterpret_cast<const uint4*>(ys + (size_t)row * 256 + c0);
        const uint4 b4 = *reinterpret_cast<const uint4*>(ys + (size_t)NT * 256 + (size_t)row * 256 + c0);
        const uint4 z4 = *reinterpret_cast<const uint4*>(z + (size_t)row * ZS + COL_GD + 768 + c0);
        float a[8], b[8], zg[8], o[8];
        unpack8(a4, a); unpack8(b4, b); unpack8(z4, zg);
        float ss = 0.f;
#pragma unroll
        for (int i = 0; i < 8; ++i) { o[i] = a[i] + b[i]; ss += o[i] * o[i]; }
        ss = sum8lanes(ss);
        const float sc = rsqrtf(ss * (1.f / 64.f) + 1e-6f);
#pragma unroll
        for (int i = 0; i < 8; ++i) o[i] = o[i] * sc * ng[i] * siluf(zg[i]);
        *reinterpret_cast<uint4*>(cat + (size_t)row * DM + 256 + c0) = pack8(o);
    }
}

__device__ __forceinline__ void load_tile_bases(unsigned* ctl, int l, int* tb) {
    const int tid = otid();
    __syncthreads();
    if (tid < 64) { const int c = (int)xb_ld(&ctl[CW_CNT(l) + tid * 32]); tb[130 + tid] = c; tb[66 + tid] = (c + 127) >> 7; }
    __syncthreads();
    if (tid == 0) { int a = 0; for (int e = 0; e < 64; ++e) { tb[e] = a; a += tb[66 + e]; } tb[64] = a; }
    __syncthreads();
}

#define NPHASE 36
template <typename F>
__device__ __forceinline__ void strided(int n, F f) { for (int u = blockIdx.x; u < n; u += gridDim.x) f(u); }

__global__ void __launch_bounds__(NTHREADS, 2) fwd_kernel(KP kp) {
    extern __shared__ __attribute__((aligned(16))) char smem[];
    char* lds = smem + LDS_USER;
    {
    const int tid = otid();
    if (tid == 0) *reinterpret_cast<uint4*>(smem) = make_uint4(0u, 0u, 0u, 0u);
    if (tid < 52) { const unsigned long long v = (unsigned long long)kp.in[tid]; ((unsigned*)(smem + 512))[2 * tid] = (unsigned)v; ((unsigned*)(smem + 512))[2 * tid + 1] = (unsigned)(v >> 32); }
    }
    __syncthreads();
    P p; p.tab = (const __attribute__((address_space(3))) unsigned*)(smem + 512); p.out = kp.out; p.ws = kp.ws;
    unsigned* ctl = (unsigned*)(p.ws + WS_CTL);
    XcdBarrier bar = xcd_barrier_post(ctl, (volatile LAS unsigned*)smem);
    const int lo = kp.ph_lo, hi = kp.ph_hi;
#define PHASE_BEGIN(ph) if ((ph) >= lo && (ph) < hi) { if ((ph) > lo) { xcd_barrier(bar); }
#define PHASE_END }
#define LANE_IDS const int tid = otid(); const int wid = tid >> 6, lane = tid & 63, wr = wid >> 1, wc = wid & 1, fr = lane & 15, fq = lane >> 4; (void)wid; (void)lane; (void)wr; (void)wc; (void)fr; (void)fq;

    PHASE_BEGIN(0)
        strided(192 + 64 + 32 + 24 + 2 * 2112, [&](int u) {
            if (u >= 312) {
                const int v0 = u - 312, ll = v0 / 2112, v = v0 % 2112;
                if (v < 1088) filt_unit(p, ll, v, lds);
                else if (v < 1856) { const int t = v - 1088; xpose_tile(p.in(I_WIN) + (size_t)ll * 1024 * 3024, 3024, (bf16_t*)(p.ws + WS_WINT + ll * SZ_WINT), 1024, 0, t / 48, t % 48, lds); }
                else { const int t = v - 1856; xpose_tile(p.in(I_WOUT) + (size_t)ll * 1024 * 1024, 1024, (bf16_t*)(p.ws + WS_WOUTT + ll * SZ_WOUTT), 1024, 0, t >> 4, t & 15, lds); }
            }
            else if (u < 192) ph0_mod_unit(p, u, lds);
            else if (u < 256) ph0_s5tab_unit(p, u - 192);
            else if (u >= 288) { const int v = u - 288, which = v >> 3, ll = (v >> 2) & 1, t = v & 3;
                   const float* src = (which == 0 ? p.in(I_RW_G2) : which == 1 ? p.in(I_RW_W2) : p.in(I_RW_A2)) + (size_t)ll * 64 * 256;
                   bf16_t* dst = (bf16_t*)(p.ws + (which == 0 ? WS_G2T : which == 1 ? WS_LW2T : WS_LA2T)) + (size_t)ll * 256 * 64;
                   xpose_tile(src, 256, dst, 64, 0, 0, t, lds); }
            else { const int v = u - 256, ll = v >> 4, t = v & 15;
                   xpose_tile(p.in(I_S5_GLUW) + (size_t)ll * 65536, 256, (bf16_t*)(p.ws + WS_GLUT) + (size_t)ll * 65536, 256, 0, t >> 2, t & 3, lds); }
        });
    PHASE_END

#pragma unroll 1
    for (int l = 0; l < 2; ++l) {
        const int pb = 1 + 17 * l;
        PHASE_BEGIN(pb + 0)
            strided(4352, [&](int u) { if (l == 0) rows_unit<M_INIT>(p, l, u, lds); else rows_unit<M_LN2NEXT>(p, l, u, lds); });
        PHASE_END
        PHASE_BEGIN(pb + 1)
            strided(272 * 24, [&](int u) {
                LANE_IDS
                const int q_ = u >> 3, g_ = q_ / 12;
                const int mt = (g_ % 34) * 8 + (u & 7), nt = (g_ / 34) * 12 + (q_ % 12);
                f32x4 acc[4][4];
                gemm_tile((const bf16_t*)(p.ws + WS_HBY), DM, arows_lin(mt * 128, tid),
                          (const bf16_t*)(p.ws + WS_WINT + l * SZ_WINT), DM, nt * 128, DM, lds, acc);
                bf16_t* z = (bf16_t*)(p.ws + WS_Z);
#pragma unroll
                for (int m = 0; m < 4; ++m)
#pragma unroll
                    for (int n = 0; n < 4; ++n) {
                        const int col = nt * 128 + wc * 64 + n * 16 + fr;
                        if (col < ZS) {
#pragma unroll
                            for (int j = 0; j < 4; ++j) z[(size_t)(mt * 128 + wr * 64 + m * 16 + fq * 4 + j) * ZS + col] = f2bf(acc[m][n][j]);
                        }
                    }
            });
        PHASE_END
        PHASE_BEGIN(pb + 2)
            strided(512 + 512 + 1088 + 1088 + 4352, [&](int u) {
                if (u < 512) { if (kp.rep == 0) hfft_unit(p, l, u, lds); }
                else if (u < 1024) hyena_prep_unit(p, l, u - 512, lds);
                else if (u < 2112) rwkv_prep_unit(p, l, u - 1024, lds);
                else if (u < 3200) gdn_prep_unit(p, l, u - 2112);
                else s5_pre_unit(p, l, u - 3200, lds);
            });
        PHASE_END
        PHASE_BEGIN(pb + 3)
            {
                int* qslot = (int*)(smem + 64);
                const int NO = 1024 + 544 + 1024;
                if (otid() == 0) {
                    const unsigned hw = (unsigned)__builtin_amdgcn_s_getreg((7 << 11) | (8 << 6) | 4);
                    const unsigned cuix = ((xb_xcc_id() & 15u) << 8) | (hw & 255u);
                    qslot[1] = (atomicAdd(&ctl[CW_CUCNT(l) + cuix], 1u) % 2u == 0u) ? 0 : 1;
                }
                __syncthreads();
                for (;;) {
                    if (otid() == 0) {
                        int stage = qslot[1], t = -1;
                        while (t < 0 && stage < 3) {
                            if (stage == 1) { const int q = (int)atomicAdd(&ctl[CW_QUEUE(l) + 16 + kp.rep], 1u); if (q < NO) t = 256 + (q < 544 ? 1024 + q : (q < 1568 ? q - 544 : q)); else stage = 2; }
                            else { const int q = (int)atomicAdd(&ctl[CW_QUEUE(l) + kp.rep], 1u); if (q < 256) t = q; else stage = (stage == 0) ? 1 : 3; }
                        }
                        qslot[1] = stage; qslot[0] = t;
                    }
                    __syncthreads();
                    const int u = qslot[0];
                    __syncthreads();
                    if (u < 0) break;
                    if (u < 128) { if (kp.rep != 2) scan_unit_gd2(p, l, u, lds); }
                    else if (u < 256) { if (kp.rep != 2) scan_unit(p, l, u - 128, lds); }
                    else if (kp.rep == 1) {}
                    else if (u < 1280) hyena_fft_unit(p, l, u - 256, lds);
                    else if (u < 1824) s5_main_unit(p, l, u - 1280, lds);
                    else hyena_unit<256>(p, l, u - 1824, lds);
                    __syncthreads();
                }
            }
        PHASE_END
        PHASE_BEGIN(pb + 4)
            strided(1088 + 1088 + 544, [&](int u) {
                if (u < 1088) rwkv_post_unit(p, l, u, lds);
                else if (u < 2176) gdn_post_unit(p, l, u - 1088);
                else {
                    LANE_IDS
                    const int v = u - 2176, mt = v >> 1, nt = v & 1;
                    f32x4 acc[4][4];
                    const bf16_t* A = (const bf16_t*)(p.ws + WS_S5G);
                    gemm_tile(A, 256, arows_lin(mt * 128, tid),
                              (const bf16_t*)(p.ws + WS_GLUT) + (size_t)l * 65536, 256, nt * 128, 256, lds, acc);
                    bf16_t* cat = (bf16_t*)(p.ws + WS_CAT);
#pragma unroll
                    for (int m = 0; m < 4; ++m)
#pragma unroll
                        for (int n = 0; n < 4; ++n) {
                            const int col = nt * 128 + wc * 64 + n * 16 + fr;
                            const float gb = p.in(I_S5_GLUB)[l * 256 + col];
#pragma unroll
                            for (int j = 0; j < 4; ++j) {
                                const int row = mt * 128 + wr * 64 + m * 16 + fq * 4 + j;
                                const float yg = bf2f(A[(size_t)row * 256 + col]);
                                cat[(size_t)row * DM + 768 + col] = f2bf(yg * sigm(acc[m][n][j] + gb));
                            }
                        }
                }
            });
        PHASE_END
        PHASE_BEGIN(pb + 5)
            strided(136 * 40, [&](int u0) {
                const int grp = u0 / 40, rr_ = u0 % 40;
                const int u = (rr_ < 16) ? grp * 16 + rr_ : 2176 + grp * 24 + (rr_ - 16);
                if (u >= 2176 + 65 * 48) return;
                if (u < 2176) {
                    LANE_IDS
                    const int mt = ((u >> 3) >> 3) * 8 + (u & 7), nt = (u >> 3) & 7;
                    f32x4 acc[4][4];
                    gemm_tile((const bf16_t*)(p.ws + WS_CAT), DM, arows_lin(mt * 128, tid),
                              (const bf16_t*)(p.ws + WS_WOUTT + l * SZ_WOUTT), DM, nt * 128, DM, lds, acc);
#pragma unroll
                    for (int m = 0; m < 4; ++m)
#pragma unroll
                        for (int j = 0; j < 4; ++j) {
                            const int row = mt * 128 + wr * 64 + m * 16 + fq * 4 + j;
                            float* xr = xrow(p, row);
                            const float* xs = (l == 0 && kp.rep == 0) ? (row < NTC ? p.in(I_CTX) + (size_t)row * DM : p.in(I_X) + (size_t)(row - NTC) * DM) : xr;
                            const float* ga = modp(p, l, row_mod(row), 2);
#pragma unroll
                            for (int n = 0; n < 4; ++n) {
                                const int col = nt * 128 + wc * 64 + n * 16 + fr;
                                { const float ca = kp.rep ? 1.f : ALPHA, cb2 = kp.rep ? 0.f : 1.f; xr[col] = ca * xs[col] + cb2 * ga[col] * acc[m][n][j]; }
                            }
                        }
                } else {
                    const int v = u - 2176, e = v / 48, t = v % 48, which = t >> 4, tt = t & 15;
                    bf16_t* W13 = (bf16_t*)(p.ws + WS_R1 + R1_W13T) + (size_t)e * 512 * 1024;
                    bf16_t* W2 = (bf16_t*)(p.ws + WS_R1 + R1_W2T) + (size_t)e * 1024 * 256;
                    if (which == 0) {
                        const float* src = (e < 64) ? p.in(I_EX_W1) + ((size_t)l * 64 + e) * 262144 : p.in(I_SH_W1) + (size_t)l * 262144;
                        xpose_strip4(src, 256, W13, 1024, 1, tt, 0, lds);
                    } else if (which == 1) {
                        const float* src = (e < 64) ? p.in(I_EX_W3) + ((size_t)l * 64 + e) * 262144 : p.in(I_SH_W3) + (size_t)l * 262144;
                        xpose_strip4(src, 256, W13, 1024, 2, tt, 0, lds);
                    } else {
                        const float* src = (e < 64) ? p.in(I_EX_W2) + ((size_t)l * 64 + e) * 262144 : p.in(I_SH_W2) + (size_t)l * 262144;
                        xpose_strip4(src, 1024, W2, 256, 0, tt >> 2, (tt & 3) * 4, lds);
                    }
                }
            });
        PHASE_END
        PHASE_BEGIN(pb + 6)
            strided(2176, [&](int u) { rows_unit<M_LN1>(p, l, u, lds, kp.rep); __syncthreads(); });
        PHASE_END
        PHASE_BEGIN(pb + 8)
            {
                int* tbs = (int*)(smem + 1024);
                load_tile_bases(ctl, l, tbs);
                const int ntr = tbs[64];
                const int* rtok = (const int*)(p.ws + WS_RTOK);
                const int ntl1 = ntr + 272;
                strided(((ntl1 + 7) >> 3) * 32, [&](int u) {
                    const int tile = ((u >> 3) >> 2) * 8 + (u & 7), jn = (u >> 3) & 3;
                    if (tile >= ntl1) return;
                    LANE_IDS
                    int e, obase; ARows ar;
                    if (tile < ntr) {
                        e = 0;
#pragma unroll 1
                        for (int s2 = 32; s2 >= 1; s2 >>= 1) if (tbs[e + s2] <= tile) e += s2;
                        obase = tile * 128;
                        const int pos0 = (tile - tbs[e]) * 128, ce = tbs[130 + e];
#pragma unroll
                        for (int i = 0; i < 4; ++i) { const int ps = pos0 + (tid >> 3) + 32 * i; ar.r[i] = (ps < ce) ? rtok[(size_t)e * NT + ps] : 0; }
                    } else {
                        const int stt = tile - ntr; e = 64; obase = (SH_TILE_BASE + stt) * 128;
                        ar = arows_lin(stt * 128, tid);
                    }
                    f32x4 acc[4][4];
                    gemm_tile((const bf16_t*)(p.ws + WS_HBY), DM, ar,
                              (const bf16_t*)(p.ws + WS_R1 + R1_W13T) + (size_t)e * 512 * 1024, DM, jn * 128, DM, lds, acc);
                    bf16_t* act = (bf16_t*)(p.ws + WS_ACT);
#pragma unroll
                    for (int m = 0; m < 4; ++m)
#pragma unroll
                        for (int pp = 0; pp < 2; ++pp)
#pragma unroll
                            for (int j = 0; j < 4; ++j) {
                                const float g = acc[m][2 * pp][j], uu = acc[m][2 * pp + 1][j];
                                const int orow = obase + wr * 64 + m * 16 + fq * 4 + j;
                                const int col = jn * 64 + wc * 32 + pp * 16 + fr;
                                act[(size_t)orow * 256 + col] = f2bf(siluf(g) * uu);
                            }
                });
            }
        PHASE_END
#pragma unroll 1
        for (int sl = 0; sl < 4; ++sl) {
            PHASE_BEGIN(pb + 9 + 2 * sl)
            {
                int* tbs = (int*)(smem + 1024);
                load_tile_bases(ctl, l, tbs);
                const int ntr = tbs[64];
                const int ntl2 = ntr + 272;
                strided(((ntl2 + 7) >> 3) * 16, [&](int u) {
                    const int tile = ((u >> 3) >> 1) * 8 + (u & 7), nt2 = (u >> 3) & 1;
                    if (tile >= ntl2) return;
                    LANE_IDS
                    int e, obase;
                    if (tile < ntr) {
                        e = 0;
#pragma unroll 1
                        for (int s2 = 32; s2 >= 1; s2 >>= 1) if (tbs[e + s2] <= tile) e += s2;
                        obase = tile * 128;
                    }
                    else { e = 64; obase = (SH_TILE_BASE + tile - ntr) * 128; }
                    f32x4 acc[4][4];
                    gemm_tile((const bf16_t*)(p.ws + WS_ACT), 256, arows_lin(obase, tid),
                              (const bf16_t*)(p.ws + WS_R1 + R1_W2T) + (size_t)e * 1024 * 256, 256, sl * 256 + nt2 * 128, 256, lds, acc);
                    bf16_t* y2 = (bf16_t*)(p.ws + WS_Y2);
#pragma unroll
                    for (int m = 0; m < 4; ++m)
#pragma unroll
                        for (int j = 0; j < 4; ++j) {
                            const int orow = obase + wr * 64 + m * 16 + fq * 4 + j;
#pragma unroll
                            for (int n = 0; n < 4; ++n) y2[(size_t)orow * 256 + nt2 * 128 + wc * 64 + n * 16 + fr] = f2bf(acc[m][n][j]);
                        }
                });
            }
            PHASE_END
            if (!(l == 1 && sl == 3)) {
            PHASE_BEGIN(pb + 10 + 2 * sl)
            {
                int* tb = (int*)lds;
                const int tid = otid();
                const unsigned* cnt = ctl + CW_CNT(l);
                load_tile_bases(ctl, l, tb);
                const int* aep = (const int*)(p.ws + WS_AEP); const float* aw = (const float*)(p.ws + WS_AW);
                const bf16_t* y2 = (const bf16_t*)(p.ws + WS_Y2);
                const int tl = tid >> 5, cg = tid & 31;
                for (int grp = blockIdx.x; grp < NT / 8; grp += gridDim.x) {
                    const int tok = grp * 8 + tl;
                    float a8[8];
                    {
                        const uint4 sv = *reinterpret_cast<const uint4*>(y2 + ((size_t)(SH_TILE_BASE * 128 + tok)) * 256 + cg * 8);
                        a8[0] = bflo(sv.x); a8[1] = bfhi(sv.x); a8[2] = bflo(sv.y); a8[3] = bfhi(sv.y);
                        a8[4] = bflo(sv.z); a8[5] = bfhi(sv.z); a8[6] = bflo(sv.w); a8[7] = bfhi(sv.w);
                    }
#pragma unroll
                    for (int k = 0; k < 8; ++k) {
                        const unsigned v = (unsigned)aep[(size_t)tok * 8 + k];
                        const float wk = aw[(size_t)tok * 8 + k];
                        const int dest = tb[v >> 24] * 128 + (int)(v & 0xFFFFFFu);
                        const uint4 yv = *reinterpret_cast<const uint4*>(y2 + (size_t)dest * 256 + cg * 8);
                        a8[0] += wk * bflo(yv.x); a8[1] += wk * bfhi(yv.x); a8[2] += wk * bflo(yv.y); a8[3] += wk * bfhi(yv.y);
                        a8[4] += wk * bflo(yv.z); a8[5] += wk * bfhi(yv.z); a8[6] += wk * bflo(yv.w); a8[7] += wk * bfhi(yv.w);
                    }
                    float* xr = xrow(p, tok) + sl * 256 + cg * 8;
                    const float* ga = modp(p, l, row_mod(tok), 5) + sl * 256 + cg * 8;
                    float4 x0 = *reinterpret_cast<const float4*>(xr), x1 = *reinterpret_cast<const float4*>(xr + 4);
                    const float4 g0 = *reinterpret_cast<const float4*>(ga), g1 = *reinterpret_cast<const float4*>(ga + 4);
                    const float rs = kp.rep ? 0.f : 1.f;
                    x0.x += rs * g0.x * a8[0]; x0.y += rs * g0.y * a8[1]; x0.z += rs * g0.z * a8[2]; x0.w += rs * g0.w * a8[3];
                    x1.x += rs * g1.x * a8[4]; x1.y += rs * g1.y * a8[5]; x1.z += rs * g1.z * a8[6]; x1.w += rs * g1.w * a8[7];
                    *reinterpret_cast<float4*>(xr) = x0; *reinterpret_cast<float4*>(xr + 4) = x1;
                }
                __syncthreads();
            }
            PHASE_END
            }
        }
    }
#if defined(PROBE_PH)
    if (lo >= 100) {
        float a0 = (float)otid(), a1 = a0 + 1.f, a2 = a0 + 2.f, a3 = a0 + 3.f, a4 = a0 + 4.f, a5 = a0 + 5.f, a6 = a0 + 6.f, a7 = a0 + 7.f;
        const float m = 0.999f, c = 0.5f;
        for (int it = 0; it < 10000; ++it) {
            if (lo == 100) {
#pragma unroll
                for (int q = 0; q < 64; ++q) asm volatile("v_fma_f32 %0, %0, %1, %2" : "+v"(a0) : "v"(m), "v"(c));
            } else {
#pragma unroll
                for (int q = 0; q < 8; ++q) {
                    asm volatile("v_fma_f32 %0, %0, %1, %2" : "+v"(a0) : "v"(m), "v"(c)); asm volatile("v_fma_f32 %0, %0, %1, %2" : "+v"(a1) : "v"(m), "v"(c));
                    asm volatile("v_fma_f32 %0, %0, %1, %2" : "+v"(a2) : "v"(m), "v"(c)); asm volatile("v_fma_f32 %0, %0, %1, %2" : "+v"(a3) : "v"(m), "v"(c));
                    asm volatile("v_fma_f32 %0, %0, %1, %2" : "+v"(a4) : "v"(m), "v"(c)); asm volatile("v_fma_f32 %0, %0, %1, %2" : "+v"(a5) : "v"(m), "v"(c));
                    asm volatile("v_fma_f32 %0, %0, %1, %2" : "+v"(a6) : "v"(m), "v"(c)); asm volatile("v_fma_f32 %0, %0, %1, %2" : "+v"(a7) : "v"(m), "v"(c));
                }
            }
        }
        if (a0 + a1 + a2 + a3 + a4 + a5 + a6 + a7 == 12345.678f) ctl[60] = 1u;
    }
#endif
    PHASE_BEGIN(35)
        load_tile_bases(ctl, 1, (int*)(smem + 1024));
        strided(4352, [&](int u) { rows_unit<M_FINAL>(p, 1, u, lds); });
    PHASE_END
}

#ifndef N_LAUNCH_MODE
#define N_LAUNCH_MODE 1
#endif
extern "C" void kernel_launch(void* const* d_in, const int* in_sizes, int n_in, void* d_out, int out_size, void* d_ws, size_t ws_size, hipStream_t stream) {
    static int grid = 0;
    if (grid == 0) {
        if (n_in != 52 || out_size != NTL * DM || ws_size < WS_END) { fprintf(stderr, "kernel_launch: unexpected shapes (n_in %d out %d ws %zu need %zu)\n", n_in, out_size, ws_size, (size_t)WS_END); grid = -1; return; }
        int dev = 0, cus = 0, per_cu = 0;
        hipGetDevice(&dev);
        hipDeviceGetAttribute(&cus, hipDeviceAttributeMultiprocessorCount, dev);
        hipFuncSetAttribute((const void*)fwd_kernel, hipFuncAttributeMaxDynamicSharedMemorySize, LDS_BYTES);
        hipOccupancyMaxActiveBlocksPerMultiprocessor(&per_cu, (const void*)fwd_kernel, NTHREADS, LDS_BYTES);
        (void)hipGetLastError();
        if (per_cu < 1) per_cu = 1;
        if (per_cu > 2) per_cu = 2;
        grid = cus * per_cu;
    }
    if (grid < 0) return;
    hipMemsetAsync((char*)d_ws + WS_CTL, 0, CTL_BYTES, stream);
    KP p{};
    for (int i = 0; i < 52; ++i) p.in[i] = (const float*)d_in[i];
    p.out = (float*)d_out; p.ws = (char*)d_ws;
#if defined(PROBE_PH)
    for (int ph = 0; ph < NPHASE; ++ph) {
        const int reps = (ph == PROBE_PH) ? 1 + PROBE_N : 1;
        for (int r = 0; r < reps; ++r) { p.ph_lo = ph; p.ph_hi = ph + 1; p.rep = r; hipLaunchKernelGGL(fwd_kernel, dim3(grid), dim3(NTHREADS), LDS_BYTES, stream, p); }
    }
    if (PROBE_PH >= 100) { p.ph_lo = PROBE_PH; p.ph_hi = PROBE_PH + 1; p.rep = 0; hipLaunchKernelGGL(fwd_kernel, dim3(PROBE_N), dim3(NTHREADS), LDS_BYTES, stream, p); }
#elif N_LAUNCH_MODE == 1
    p.ph_lo = 0; p.ph_hi = NPHASE;
    hipLaunchKernelGGL(fwd_kernel, dim3(grid), dim3(NTHREADS), LDS_BYTES, stream, p);
#else
    for (int ph = 0; ph < NPHASE; ++ph) {
        p.ph_lo = ph; p.ph_hi = ph + 1;
        hipLaunchKernelGGL(fwd_kernel, dim3(grid), dim3(NTHREADS), LDS_BYTES, stream, p);
    }
#endif
}
```

```cpp
#include <hip/hip_runtime.h>
#include <hip/hip_bf16.h>
#include <hip/hip_fp16.h>
#include <stdint.h>
#include <stdio.h>

typedef unsigned short bf16_t;
using bf16x8 = __attribute__((ext_vector_type(8))) short;
using f32x4 = __attribute__((ext_vector_type(4))) float;
using f32x2 = __attribute__((ext_vector_type(2))) float;

#define NTC 2048
#define NTL 32768
#define NT 34816
#define DM 1024
#define ZS 3024
#define COL_GD 960
#define COL_HY 2000
#define COL_S5 2768
#define NCHUNK 68
#define ALPHA 1.41421356237f
#define NTHREADS 256
#define LDS_BYTES 73728
#define LDS_USER 2048
#define SH_TILE_BASE 2240
#define ACT_ROWS ((SH_TILE_BASE + 272) * 128)

constexpr size_t al256(size_t x) { return (x + 255) & ~(size_t)255; }
constexpr size_t WS_CTL = 0;
constexpr size_t CTL_BYTES = 131072;
constexpr size_t WS_MOD = WS_CTL + CTL_BYTES;
constexpr size_t WS_S5A = al256(WS_MOD + 2 * 9 * 6144 * 4);
constexpr size_t WS_S5B = al256(WS_S5A + 2 * 2 * 16 * 64 * 4 * 4);
constexpr size_t WS_GLUT = al256(WS_S5B + 2 * 2 * 16 * 64 * 32 * 4);
constexpr size_t WS_G2T = al256(WS_GLUT + 2 * 256 * 256 * 2);
constexpr size_t WS_LW2T = al256(WS_G2T + 2 * 256 * 64 * 2);
constexpr size_t WS_LA2T = al256(WS_LW2T + 2 * 256 * 64 * 2);
constexpr size_t SZ_WINT = (size_t)3072 * 1024 * 2, SZ_WOUTT = (size_t)1024 * 1024 * 2, SZ_FILTL = (size_t)4 * 256 * 4096 * 4, SZ_FILTC = (size_t)4 * 256 * 256 * 4;
constexpr size_t WS_WINT = al256(WS_LA2T + 2 * 256 * 64 * 2);
constexpr size_t WS_WOUTT = al256(WS_WINT + 2 * SZ_WINT);
constexpr size_t WS_FILTL = al256(WS_WOUTT + 2 * SZ_WOUTT);
constexpr size_t WS_FILTC = al256(WS_FILTL + 2 * SZ_FILTL);
constexpr size_t WS_XC = al256(WS_FILTC + 2 * SZ_FILTC);
constexpr size_t WS_HBY = al256(WS_XC + (size_t)NTC * DM * 4);
constexpr size_t WS_CAT = al256(WS_HBY + (size_t)NT * DM * 2);
constexpr size_t WS_Z = al256(WS_CAT + (size_t)NT * DM * 2);
constexpr size_t WS_R1 = al256(WS_Z + (size_t)NT * ZS * 2);
constexpr size_t R1_RWP = 0;
constexpr size_t R1_GQ = (size_t)NT * 1024 * 2;
constexpr size_t R1_W13T = 0;
constexpr size_t R1_W2T = (size_t)65 * 512 * 1024 * 2;
constexpr size_t R1_BYTES = (size_t)NT * 1024 * 2 + (size_t)NT * 768 * 2;
constexpr size_t WS_KNORM = al256(WS_R1 + R1_BYTES);
constexpr size_t WS_GAB = al256(WS_KNORM + (size_t)NT * 4 * 4);
constexpr size_t WS_S5ST = al256(WS_GAB + (size_t)NT * 16 * 4);
constexpr size_t WS_AEP = al256(WS_S5ST + (size_t)8 * 68 * 2 * 16 * 64 * 2 * 4);
constexpr size_t WS_AW = al256(WS_AEP + (size_t)NT * 8 * 4);
constexpr size_t WS_RTOK = al256(WS_AW + (size_t)NT * 8 * 4);
constexpr size_t WS_HYT = al256(WS_RTOK + (size_t)64 * NT * 4);
constexpr size_t WS_S5G = al256(WS_HYT + (size_t)8 * 768 * 4096 * 2);
constexpr size_t WS_END = al256(WS_S5G + (size_t)NT * 256 * 2);
static_assert(R1_W2T + (size_t)65 * 1024 * 256 * 2 <= R1_BYTES, "expert weights must fit R1");
constexpr size_t ACT_BYTES = (size_t)ACT_ROWS * 256 * 2;
constexpr size_t WS_ACT = WS_Z + ((((size_t)NT * ZS * 2 - ACT_BYTES) >> 8) << 8);
constexpr size_t WS_Y2 = WS_HBY;
static_assert(WS_Y2 + ACT_BYTES <= WS_ACT, "y2 must not reach act");

#define CW_QUEUE(l) (4096 + 64 * (l))
#define CW_CNT(l) (16384 + 2048 * (l))
#define CW_CUCNT(l) (8192 + 4096 * (l))

#define XB_TMO      128
#define XB_XCNT(j)  (256  + 64 * (j))
#define XB_XSUB(j)  (1280 + 64 * (j))
#define XB_XGEN(j)  (2304 + 64 * (j))
#define XB_TOP      3328
#define XB_TOPGEN   3392
#define XCD_BAR_WORDS 3456
#define XB_SPIN_CAP (1u << 18)
#define LAS __attribute__((address_space(3)))

__device__ __forceinline__ unsigned xb_ld(unsigned* p)              { return __hip_atomic_load(p, __ATOMIC_RELAXED, __HIP_MEMORY_SCOPE_AGENT); }
__device__ __forceinline__ unsigned xb_add(unsigned* p, unsigned v) { return __hip_atomic_fetch_add(p, v, __ATOMIC_RELAXED, __HIP_MEMORY_SCOPE_AGENT); }
__device__ __forceinline__ unsigned xb_xcc_id() { return (unsigned)__builtin_amdgcn_s_getreg((3 << 11) | 20) & 0xFu; }
#define XB_SPIN(cond, bar) do { unsigned _sp = 0; while (cond) { __builtin_amdgcn_s_sleep(1); \
    if ((++_sp & 255u) == 0u) { if (xb_ld(&(bar)[XB_TMO])) break; if (_sp > XB_SPIN_CAP) { atomicAdd(&(bar)[XB_TMO], 1u); break; } } } } while (0)

struct XcdBarrier {
    unsigned* bar; unsigned x;
    volatile LAS unsigned* st;
};
__device__ __forceinline__ XcdBarrier xcd_barrier_post(unsigned* bar, volatile LAS unsigned* st) {
    XcdBarrier b; b.bar = bar; b.x = xb_xcc_id(); b.st = st;
    if (threadIdx.x == 0) (void)xb_add(&bar[XB_XCNT(b.x)], 1u);
    return b;
}
__device__ __forceinline__ void xcd_barrier_complete(unsigned* bar, unsigned x, unsigned& nloc, unsigned& nx) {
    const unsigned G = gridDim.x * gridDim.y * gridDim.z;
    unsigned sum, cnt, mine, sp = 0u;
    for (;;) {
        sum = 0u; cnt = 0u; mine = 0u;
#pragma unroll
        for (unsigned j = 0; j < 16; ++j) { const unsigned c = xb_ld(&bar[XB_XCNT(j)]); sum += c; cnt += (c > 0u) ? 1u : 0u; mine = (j == x) ? c : mine; }
        if (sum == G) break;
        __builtin_amdgcn_s_sleep(1);
        if ((++sp & 255u) == 0u) { if (xb_ld(&bar[XB_TMO])) break; if (sp > XB_SPIN_CAP) { atomicAdd(&bar[XB_TMO], 1u); break; } }
    }
    nloc = mine > 0u ? mine : 1u; nx = cnt > 0u ? cnt : 1u;
}
__device__ __forceinline__ void xcd_barrier(const XcdBarrier& b) {
    asm volatile("s_waitcnt vmcnt(0)" ::: "memory");
    __syncthreads();
    if (threadIdx.x == 0) {
        unsigned* bar = b.bar;
        __builtin_amdgcn_s_waitcnt(0);
        unsigned nloc = b.st[0], nx = b.st[1];
        if (nloc == 0u) { xcd_barrier_complete(bar, b.x, nloc, nx); b.st[0] = nloc; b.st[1] = nx; }
        const unsigned old = xb_add(&bar[XB_XSUB(b.x)], 1u);
        const unsigned gen = old / nloc;
        if (old + 1u == (gen + 1u) * nloc) {
            __builtin_amdgcn_fence(__ATOMIC_RELEASE, "agent");
            asm volatile("s_waitcnt vmcnt(0)" ::: "memory");
            const unsigned og = xb_add(&bar[XB_TOP], 1u);
            const unsigned tg = og / nx;
            if (og + 1u == (tg + 1u) * nx) xb_add(&bar[XB_TOPGEN], 1u);
            else XB_SPIN(xb_ld(&bar[XB_TOPGEN]) == tg, bar);
            __builtin_amdgcn_fence(__ATOMIC_ACQUIRE, "agent");
            xb_add(&bar[XB_XGEN(b.x)], 1u);
            asm volatile("s_waitcnt vmcnt(0)" ::: "memory");
        } else {
            XB_SPIN(xb_ld(&bar[XB_XGEN(b.x)]) == gen, bar);
            __builtin_amdgcn_fence(__ATOMIC_ACQUIRE, "agent");
            asm volatile("s_waitcnt vmcnt(0)" ::: "memory");
        }
    }
    __syncthreads();
}

struct KP {
    const float* in[52];
    float* out;
    char* ws;
    int ph_lo, ph_hi, rep, pad_;
};
struct P {
    const __attribute__((address_space(3))) unsigned* tab;
    float* out;
    char* ws;
    __device__ __forceinline__ const float* in(int i) const {
        const unsigned lo = __builtin_amdgcn_readfirstlane(tab[2 * i]);
        const unsigned hi = __builtin_amdgcn_readfirstlane(tab[2 * i + 1]);
        return (const float*)(((unsigned long long)hi << 32) | (unsigned long long)lo);
    }
};
enum { I_X = 0, I_C, I_CTX, I_CCTX, I_ADAW, I_ADAB, I_WIN, I_WOUT, I_LNG, I_LNB,
       I_RW_W0, I_RW_W2, I_RW_A0, I_RW_A2, I_RW_G2, I_RW_KK, I_RW_KA, I_RW_RK, I_RW_GNG, I_RW_GNB,
       I_GD_CONV, I_GD_ALOG, I_GD_DTB, I_GD_NORM,
       I_HY_CONV, I_HY_CONVB, I_HY_W1, I_HY_B1, I_HY_F1, I_HY_W2, I_HY_B2, I_HY_F2, I_HY_W3, I_HY_SKIP,
       I_S5_LRE, I_S5_LIM, I_S5_LOGSTEP, I_S5_BRE, I_S5_BIM, I_S5_CRE, I_S5_CIM, I_S5_D, I_S5_GLUW, I_S5_GLUB,
       I_ROUTER_W, I_ROUTER_B, I_EX_W1, I_EX_W3, I_EX_W2, I_SH_W1, I_SH_W3, I_SH_W2 };

__device__ __forceinline__ bf16_t f2bf(float f) { unsigned u = __float_as_uint(f); u += 0x7fffu + ((u >> 16) & 1u); return (bf16_t)(u >> 16); }
__device__ __forceinline__ float bf2f(bf16_t h) { return __uint_as_float(((unsigned)h) << 16); }
__device__ __forceinline__ float bflo(unsigned u) { return __uint_as_float(u << 16); }
__device__ __forceinline__ float bfhi(unsigned u) { return __uint_as_float(u & 0xffff0000u); }
__device__ __forceinline__ unsigned pack2(float a, float b) { return (unsigned)f2bf(a) | ((unsigned)f2bf(b) << 16); }
__device__ __forceinline__ float sigm(float x) { return 1.f / (1.f + __expf(-x)); }
__device__ __forceinline__ float siluf(float x) { return x / (1.f + __expf(-x)); }
__device__ __forceinline__ float softplusf(float x) { return fmaxf(x, 0.f) + log1pf(__expf(-fabsf(x))); }
template <int CTRL> __device__ __forceinline__ float dppf(float v) {
    return __int_as_float(__builtin_amdgcn_update_dpp(0, __float_as_int(v), CTRL, 0xF, 0xF, true));
}
__device__ __forceinline__ float wave_sum(float v) {
    v += dppf<0xB1>(v); v += dppf<0x4E>(v); v += dppf<0x141>(v); v += dppf<0x140>(v);
    const int iv = __float_as_int(v);
    const float r0 = __int_as_float(__builtin_amdgcn_readlane(iv, 0)), r1 = __int_as_float(__builtin_amdgcn_readlane(iv, 16));
    const float r2 = __int_as_float(__builtin_amdgcn_readlane(iv, 32)), r3 = __int_as_float(__builtin_amdgcn_readlane(iv, 48));
    return (r0 + r1) + (r2 + r3);
}

__device__ __forceinline__ void unpack8(const uint4& v, float (&o)[8]) {
    o[0] = bflo(v.x); o[1] = bfhi(v.x); o[2] = bflo(v.y); o[3] = bfhi(v.y); o[4] = bflo(v.z); o[5] = bfhi(v.z); o[6] = bflo(v.w); o[7] = bfhi(v.w);
}
__device__ __forceinline__ uint4 pack8(const float (&o)[8]) { return make_uint4(pack2(o[0], o[1]), pack2(o[2], o[3]), pack2(o[4], o[5]), pack2(o[6], o[7])); }
__device__ __forceinline__ float sum8lanes(float v) { v += dppf<0xB1>(v); v += dppf<0x4E>(v); v += dppf<0x141>(v); return v; }

#define DPP_ADD_ASM(name, ctrl) __device__ __forceinline__ float name(float x) { float r; asm volatile("s_nop 1\n\tv_add_f32_dpp %0, %1, %1 " ctrl " row_mask:0xf bank_mask:0xf bound_ctrl:1" : "=v"(r) : "v"(x)); return r; }
DPP_ADD_ASM(dadd_x1, "quad_perm:[1,0,3,2]")
DPP_ADD_ASM(dadd_x2, "quad_perm:[2,3,0,1]")
DPP_ADD_ASM(dadd_hm, "row_half_mirror")
DPP_ADD_ASM(dadd_rm, "row_mirror")

__device__ __forceinline__ void dpp_allreduce16_x2(float& a, float& b) {
    asm volatile(
        "s_nop 1\n\t"
        "v_add_f32_dpp %0, %0, %0 quad_perm:[1,0,3,2] row_mask:0xf bank_mask:0xf bound_ctrl:1\n\t"
        "v_add_f32_dpp %1, %1, %1 quad_perm:[1,0,3,2] row_mask:0xf bank_mask:0xf bound_ctrl:1\n\t"
        "s_nop 0\n\t"
        "v_add_f32_dpp %0, %0, %0 quad_perm:[2,3,0,1] row_mask:0xf bank_mask:0xf bound_ctrl:1\n\t"
        "v_add_f32_dpp %1, %1, %1 quad_perm:[2,3,0,1] row_mask:0xf bank_mask:0xf bound_ctrl:1\n\t"
        "s_nop 0\n\t"
        "v_add_f32_dpp %0, %0, %0 row_half_mirror row_mask:0xf bank_mask:0xf bound_ctrl:1\n\t"
        "v_add_f32_dpp %1, %1, %1 row_half_mirror row_mask:0xf bank_mask:0xf bound_ctrl:1\n\t"
        "s_nop 0\n\t"
        "v_add_f32_dpp %0, %0, %0 row_mirror row_mask:0xf bank_mask:0xf bound_ctrl:1\n\t"
        "v_add_f32_dpp %1, %1, %1 row_mirror row_mask:0xf bank_mask:0xf bound_ctrl:1"
        : "+v"(a), "+v"(b));
}
__device__ __forceinline__ int otid() { int t = threadIdx.x; asm volatile("" : "+v"(t)); return t; }
__device__ __forceinline__ float* xrow(const P& p, int row) {
    return row < NTC ? (float*)(p.ws + WS_XC) + (size_t)row * DM : p.out + (size_t)(row - NTC) * DM;
}
__device__ __forceinline__ int row_mod(int row) { return row < NTC ? 8 : ((row - NTC) >> 12); }
__device__ __forceinline__ const float* modp(const P& p, int l, int r, int chunk) {
    return (const float*)(p.ws + WS_MOD) + ((size_t)(l * 9 + r) * 6144 + chunk * 1024);
}

struct ARows { int r[4]; };
__device__ __forceinline__ ARows arows_lin(int base, int tid) { ARows a; a.r[0] = base + (tid >> 3); a.r[1] = a.r[0] + 32; a.r[2] = a.r[0] + 64; a.r[3] = a.r[0] + 96; return a; }
__device__ __forceinline__ void gemm_tile(const bf16_t* __restrict__ A, int lda, const ARows& ar,
                                          const bf16_t* __restrict__ Bt, int ldb, int brow0, int K,
                                          char* lds, f32x4 (&acc)[4][4]) {
    const int tid = otid();
    const int wid = tid >> 6, lane = tid & 63, wr = wid >> 1, wc = wid & 1, fr = lane & 15, fq = lane >> 4;
    const int gc = ((tid & 7) ^ ((tid >> 3) & 7)) * 8;
    const bf16_t* ap[4]; const bf16_t* bp[4];
#pragma unroll
    for (int i = 0; i < 4; ++i) {
        ap[i] = A + (size_t)ar.r[i] * lda + gc;
        bp[i] = Bt + (size_t)(brow0 + (tid >> 3) + 32 * i) * ldb + gc;
    }
#pragma unroll
    for (int m = 0; m < 4; ++m)
#pragma unroll
        for (int n = 0; n < 4; ++n) acc[m][n] = f32x4{0.f, 0.f, 0.f, 0.f};
    const int nk = K >> 6;
    auto stage = [&](int t, int buf) {
        char* SA = lds + buf * 32768; char* SB = SA + 16384;
        const int ko = t * 64;
#pragma unroll
        for (int i = 0; i < 4; ++i) {
            __builtin_amdgcn_global_load_lds((const void*)(ap[i] + ko), (LAS void*)(SA + tid * 16 + i * 4096), 16, 0, 0);
            __builtin_amdgcn_global_load_lds((const void*)(bp[i] + ko), (LAS void*)(SB + tid * 16 + i * 4096), 16, 0, 0);
        }
    };
    stage(0, 0);
    asm volatile("s_waitcnt vmcnt(0)" ::: "memory");
    __syncthreads();
    const int sw = fr & 7;
    for (int t = 0; t < nk; ++t) {
        const int buf = t & 1;
        if (t + 1 < nk) stage(t + 1, buf ^ 1);
        const char* SA = lds + buf * 32768; const char* SB = SA + 16384;
        bf16x8 af[2][4], bfr[2][4];
#pragma unroll
        for (int ks = 0; ks < 2; ++ks) {
            const int co = ((ks * 4 + fq) ^ sw) * 16;
#pragma unroll
            for (int m = 0; m < 4; ++m) af[ks][m] = *reinterpret_cast<const bf16x8*>(SA + (wr * 64 + m * 16 + fr) * 128 + co);
#pragma unroll
            for (int n = 0; n < 4; ++n) bfr[ks][n] = *reinterpret_cast<const bf16x8*>(SB + (wc * 64 + n * 16 + fr) * 128 + co);
        }
        __builtin_amdgcn_s_setprio(1);
#pragma unroll
        for (int ks = 0; ks < 2; ++ks)
#pragma unroll
            for (int m = 0; m < 4; ++m)
#pragma unroll
                for (int n = 0; n < 4; ++n) acc[m][n] = __builtin_amdgcn_mfma_f32_16x16x32_bf16(af[ks][m], bfr[ks][n], acc[m][n], 0, 0, 0);
        __builtin_amdgcn_s_setprio(0);
        asm volatile("s_waitcnt vmcnt(0)" ::: "memory");
        __syncthreads();
    }
}

__device__ __forceinline__ void ph0_mod_unit(const P& p, int u, char* lds) {
    const int l = u / 96, cg = u % 96, tid = otid();
    float* s = (float*)lds;
    float* red = s + 9 * 1024;
    const float* c = p.in(I_C); const float* cctx = p.in(I_CCTX);
    for (int i = tid; i < 9 * 1024; i += NTHREADS) { int r = i >> 10, k = i & 1023; float v = r < 8 ? c[r * 1024 + k] : cctx[k]; s[i] = v / (1.f + expf(-v)); }
    __syncthreads();
    const int kq = tid >> 6, j = tid & 63, col = cg * 64 + j;
    const float* w = p.in(I_ADAW) + (size_t)l * 1024 * 6144 + col;
    float acc[9];
#pragma unroll
    for (int r = 0; r < 9; ++r) acc[r] = 0.f;
#pragma unroll 4
    for (int k = kq * 256; k < kq * 256 + 256; ++k) {
        const float wv = w[(size_t)k * 6144];
#pragma unroll
        for (int r = 0; r < 9; ++r) acc[r] += s[r * 1024 + k] * wv;
    }
#pragma unroll
    for (int r = 0; r < 9; ++r) red[(kq * 9 + r) * 64 + j] = acc[r];
    __syncthreads();
    if (tid < 64) {
        float* mod = (float*)(p.ws + WS_MOD);
        const float bb = p.in(I_ADAB)[l * 6144 + col];
#pragma unroll
        for (int r = 0; r < 9; ++r) mod[(size_t)(l * 9 + r) * 6144 + col] = red[r * 64 + j] + red[(9 + r) * 64 + j] + red[(18 + r) * 64 + j] + red[(27 + r) * 64 + j] + bb;
    }
    __syncthreads();
}

__device__ __forceinline__ void ph0_s5tab_unit(const P& p, int u) {
    const int tid = otid();
    if (tid >= 64) return;
    const int ldg = u;
    const int idx = ldg * 64 + tid;
    const double lre = (double)p.in(I_S5_LRE)[idx], lim = (double)p.in(I_S5_LIM)[idx];
    const double dt = (double)expf(p.in(I_S5_LOGSTEP)[ldg]);
    const float mag = expf((float)(lre * dt));
    double rev = lim * dt * 0.15915494309189535; rev -= floor(rev);
    float sn, cs; sincospif(2.f * (float)rev, &sn, &cs);
    const double abr = (double)(mag * cs), abi = (double)(mag * sn);
    const double den = lre * lre + lim * lim;
    const double cor = ((abr - 1.0) * lre + abi * lim) / den;
    const double coi = (abi * lre - (abr - 1.0) * lim) / den;
    const float m64f = expf((float)(64.0 * lre * dt));
    double rev64 = 64.0 * lim * dt * 0.15915494309189535; rev64 -= floor(rev64);
    float sn64, cs64; sincospif(2.f * (float)rev64, &sn64, &cs64);
    float* A = (float*)(p.ws + WS_S5A) + (size_t)idx * 4;
    A[0] = (float)abr; A[1] = (float)abi; A[2] = m64f * cs64; A[3] = m64f * sn64;
    float* B = (float*)(p.ws + WS_S5B) + (size_t)idx * 32;
    const float* bre = p.in(I_S5_BRE) + (size_t)idx * 16; const float* bim = p.in(I_S5_BIM) + (size_t)idx * 16;
#pragma unroll
    for (int h = 0; h < 16; ++h) {
        const double br = bre[h], bi = bim[h];
        B[h] = (float)(cor * br - coi * bi);
        B[16 + h] = (float)(cor * bi + coi * br);
    }
}

__device__ __forceinline__ int xmap(int mode, int c) {
    if (mode == 0) return c;
    const int j = c >> 6, cc = c & 63, wc = cc >> 5, pp = (cc & 31) >> 4, i = cc & 15;
    return j * 128 + wc * 64 + pp * 32 + i + (mode == 2 ? 16 : 0);
}
__device__ __forceinline__ void xpose_tile(const float* __restrict__ src, int C, bf16_t* __restrict__ dst, int ldd, int mode, int tr, int tc, char* lds) {
    float* t = (float*)lds;
    const int tid = otid();
    {
        const int c4 = (tid & 15) * 4, c = tc * 64 + c4;
#pragma unroll
        for (int k = 0; k < 4; ++k) {
            const int r = (tid >> 4) + 16 * k;
            float4 v = make_float4(0.f, 0.f, 0.f, 0.f);
            if (c < C) v = *reinterpret_cast<const float4*>(src + (size_t)(tr * 64 + r) * C + c);
            t[(c4 + 0) * 65 + r] = v.x; t[(c4 + 1) * 65 + r] = v.y; t[(c4 + 2) * 65 + r] = v.z; t[(c4 + 3) * 65 + r] = v.w;
        }
    }
    __syncthreads();
#pragma unroll
    for (int k = 0; k < 2; ++k) {
        const int ci = (tid >> 3) + 32 * k, r8 = (tid & 7) * 8;
        const float* tp = t + ci * 65 + r8;
        uint4 o;
        o.x = pack2(tp[0], tp[1]); o.y = pack2(tp[2], tp[3]); o.z = pack2(tp[4], tp[5]); o.w = pack2(tp[6], tp[7]);
        *reinterpret_cast<uint4*>(dst + (size_t)xmap(mode, tc * 64 + ci) * ldd + tr * 64 + r8) = o;
    }
    __syncthreads();
}

__device__ __forceinline__ void xpose_strip4(const float* __restrict__ src, int C, bf16_t* __restrict__ dst, int ldd, int mode, int tr, int tc0, char* lds) {
    float* t = (float*)lds;
    const int tid = otid();
    {
        const int c4 = (tid & 15) * 4;
        float4 v[4][4];
#pragma unroll
        for (int q = 0; q < 4; ++q)
#pragma unroll
            for (int k = 0; k < 4; ++k) v[q][k] = *reinterpret_cast<const float4*>(src + (size_t)(tr * 64 + (tid >> 4) + 16 * k) * C + (tc0 + q) * 64 + c4);
#pragma unroll
        for (int q = 0; q < 4; ++q)
#pragma unroll
            for (int k = 0; k < 4; ++k) {
                const int r = (tid >> 4) + 16 * k;
                float* tq = t + q * (64 * 65);
                tq[(c4 + 0) * 65 + r] = v[q][k].x; tq[(c4 + 1) * 65 + r] = v[q][k].y; tq[(c4 + 2) * 65 + r] = v[q][k].z; tq[(c4 + 3) * 65 + r] = v[q][k].w;
            }
    }
    __syncthreads();
#pragma unroll
    for (int q = 0; q < 4; ++q)
#pragma unroll
        for (int k = 0; k < 2; ++k) {
            const int ci = (tid >> 3) + 32 * k, r8 = (tid & 7) * 8;
            const float* tp = t + q * (64 * 65) + ci * 65 + r8;
            uint4 o;
            o.x = pack2(tp[0], tp[1]); o.y = pack2(tp[2], tp[3]); o.z = pack2(tp[4], tp[5]); o.w = pack2(tp[6], tp[7]);
            *reinterpret_cast<uint4*>(dst + (size_t)xmap(mode, (tc0 + q) * 64 + ci) * ldd + tr * 64 + r8) = o;
        }
    __syncthreads();
}

enum { M_INIT = 0, M_LN2NEXT = 1, M_LN1 = 2, M_FINAL = 3 };

template <int MODE>
__device__ __forceinline__ void rows_unit(const P& p, int l, int u, char* lds, int dry = 0) {
    const int tid = otid(), w = tid >> 6, lane = tid & 63;
    constexpr int RW = (MODE == M_LN1) ? 4 : 2;
    float* hbuf = (float*)lds;
    bf16_t* hb = (bf16_t*)(p.ws + WS_HBY);
#pragma unroll 1
    for (int rr = 0; rr < RW; ++rr) {
        const int rl = w * RW + rr, row = u * (4 * RW) + rl;
        const int mr = row_mod(row);
        float v[16];
        float* xr = xrow(p, row);
        const float* src = (MODE == M_INIT) ? (row < NTC ? p.in(I_CTX) + (size_t)row * DM : p.in(I_X) + (size_t)(row - NTC) * DM) : xr;
#pragma unroll
        for (int i = 0; i < 4; ++i) {
            const float4 t = *reinterpret_cast<const float4*>(src + i * 256 + lane * 4);
            v[i * 4 + 0] = t.x; v[i * 4 + 1] = t.y; v[i * 4 + 2] = t.z; v[i * 4 + 3] = t.w;
        }
        if (MODE == M_FINAL && row >= NTC) {
            const int* tbs = (const int*)(lds - LDS_USER + 1024);
            const unsigned char* y2 = (const unsigned char*)(p.ws + WS_Y2);
            const int* aep = (const int*)(p.ws + WS_AEP); const float* aw = (const float*)(p.ws + WS_AW);
            float r8[8];
            {
                const unsigned char* yr = y2 + ((size_t)(SH_TILE_BASE * 128 + row)) * 512 + lane * 4;
                const int w0 = *reinterpret_cast<const int*>(yr), w1 = *reinterpret_cast<const int*>(yr + 256);
                r8[0] = __builtin_amdgcn_cvt_f32_fp8(w0, 0); r8[1] = __builtin_amdgcn_cvt_f32_fp8(w0, 1); r8[2] = __builtin_amdgcn_cvt_f32_fp8(w0, 2); r8[3] = __builtin_amdgcn_cvt_f32_fp8(w0, 3);
                r8[4] = __builtin_amdgcn_cvt_f32_fp8(w1, 0); r8[5] = __builtin_amdgcn_cvt_f32_fp8(w1, 1); r8[6] = __builtin_amdgcn_cvt_f32_fp8(w1, 2); r8[7] = __builtin_amdgcn_cvt_f32_fp8(w1, 3);
            }
#pragma unroll
            for (int k = 0; k < 8; ++k) {
                const unsigned av = (unsigned)aep[(size_t)row * 8 + k];
                const float wk = aw[(size_t)row * 8 + k];
                const int dest = tbs[av >> 24] * 128 + (int)(av & 0xFFFFFFu);
                const unsigned char* yr = y2 + (size_t)dest * 512 + lane * 4;
                const int w0 = *reinterpret_cast<const int*>(yr), w1 = *reinterpret_cast<const int*>(yr + 256);
                r8[0] += wk * __builtin_amdgcn_cvt_f32_fp8(w0, 0); r8[1] += wk * __builtin_amdgcn_cvt_f32_fp8(w0, 1); r8[2] += wk * __builtin_amdgcn_cvt_f32_fp8(w0, 2); r8[3] += wk * __builtin_amdgcn_cvt_f32_fp8(w0, 3);
                r8[4] += wk * __builtin_amdgcn_cvt_f32_fp8(w1, 0); r8[5] += wk * __builtin_amdgcn_cvt_f32_fp8(w1, 1); r8[6] += wk * __builtin_amdgcn_cvt_f32_fp8(w1, 2); r8[7] += wk * __builtin_amdgcn_cvt_f32_fp8(w1, 3);
            }
            const float4 g2 = *reinterpret_cast<const float4*>(modp(p, l, mr, 5) + 512 + lane * 4);
            const float4 g3 = *reinterpret_cast<const float4*>(modp(p, l, mr, 5) + 768 + lane * 4);
            const float sc16 = 1.f / 16.f;
            v[8] += sc16 * g2.x * r8[0]; v[9] += sc16 * g2.y * r8[1]; v[10] += sc16 * g2.z * r8[2]; v[11] += sc16 * g2.w * r8[3];
            v[12] += sc16 * g3.x * r8[4]; v[13] += sc16 * g3.y * r8[5]; v[14] += sc16 * g3.z * r8[6]; v[15] += sc16 * g3.w * r8[7];
        }
        if (MODE != M_INIT) {
            const int ll = (MODE == M_LN2NEXT) ? l - 1 : l;
            const int which = (MODE == M_LN1) ? 0 : 1;
            float s = 0.f;
#pragma unroll
            for (int i = 0; i < 16; ++i) s += v[i];
            const float mu = wave_sum(s) * (1.f / 1024.f);
            float q = 0.f;
#pragma unroll
            for (int i = 0; i < 16; ++i) { const float d = v[i] - mu; q += d * d; }
            const float rstd = rsqrtf(wave_sum(q) * (1.f / 1024.f) + 1e-5f);
            const float* g = p.in(I_LNG) + (size_t)(ll * 2 + which) * 1024;
            const float* bb = p.in(I_LNB) + (size_t)(ll * 2 + which) * 1024;
#pragma unroll
            for (int i = 0; i < 4; ++i) {
                const float4 gg = *reinterpret_cast<const float4*>(g + i * 256 + lane * 4);
                const float4 b4 = *reinterpret_cast<const float4*>(bb + i * 256 + lane * 4);
                v[i * 4 + 0] = (v[i * 4 + 0] - mu) * rstd * gg.x + b4.x;
                v[i * 4 + 1] = (v[i * 4 + 1] - mu) * rstd * gg.y + b4.y;
                v[i * 4 + 2] = (v[i * 4 + 2] - mu) * rstd * gg.z + b4.z;
                v[i * 4 + 3] = (v[i * 4 + 3] - mu) * rstd * gg.w + b4.w;
            }
        }
        if (MODE == M_FINAL) {
            if (row >= NTC) {
#pragma unroll
                for (int i = 0; i < 4; ++i) *reinterpret_cast<float4*>(xr + i * 256 + lane * 4) = make_float4(v[i * 4], v[i * 4 + 1], v[i * 4 + 2], v[i * 4 + 3]);
            }
            continue;
        }
        const float osc = (MODE == M_LN1) ? ALPHA : 1.f;
#pragma unroll
        for (int i = 0; i < 4; ++i) if (MODE != M_INIT) { float4 o4 = make_float4(osc * v[i * 4], osc * v[i * 4 + 1], osc * v[i * 4 + 2], osc * v[i * 4 + 3]); if (dry) o4 = *reinterpret_cast<const float4*>(src + i * 256 + lane * 4); *reinterpret_cast<float4*>(xr + i * 256 + lane * 4) = o4; }
        const float* sh = modp(p, l, mr, (MODE == M_LN1) ? 3 : 0);
        const float* sc = modp(p, l, mr, (MODE == M_LN1) ? 4 : 1);
#pragma unroll
        for (int i = 0; i < 4; ++i) {
            const float4 s4 = *reinterpret_cast<const float4*>(sc + i * 256 + lane * 4);
            const float4 h4 = *reinterpret_cast<const float4*>(sh + i * 256 + lane * 4);
            const float h0 = v[i * 4 + 0] * (1.f + s4.x) + h4.x, h1 = v[i * 4 + 1] * (1.f + s4.y) + h4.y;
            const float h2 = v[i * 4 + 2] * (1.f + s4.z) + h4.z, h3 = v[i * 4 + 3] * (1.f + s4.w) + h4.w;
            uint2 pk; pk.x = pack2(h0, h1); pk.y = pack2(h2, h3);
            if (!dry) *reinterpret_cast<uint2*>(hb + (size_t)row * DM + i * 256 + lane * 4) = pk;
            if (MODE == M_LN1) *reinterpret_cast<float4*>(hbuf + rl * 1028 + i * 256 + lane * 4) = make_float4(h0, h1, h2, h3);
        }
    }
    if (MODE == M_LN1 && dry != 2) {
        float* part = hbuf;
        __syncthreads();
        {
            const int fr = lane & 15, fq = lane >> 4;
            const float* rwb = p.in(I_ROUTER_W) + (size_t)l * 1024 * 64 + fr;
            const float* hrow = hbuf + fr * 1028 + fq;
            f32x4 ac[4];
#pragma unroll
            for (int nf = 0; nf < 4; ++nf) ac[nf] = f32x4{0.f, 0.f, 0.f, 0.f};
#pragma unroll 8
            for (int k = w * 256; k < w * 256 + 256; k += 4) {
                const float av = hrow[k];
                const float* bp = rwb + (size_t)(k + fq) * 64;
#pragma unroll
                for (int nf = 0; nf < 4; ++nf) ac[nf] = __builtin_amdgcn_mfma_f32_16x16x4f32(av, bp[nf * 16], ac[nf], 0, 0, 0);
            }
            __syncthreads();
#pragma unroll
            for (int nf = 0; nf < 4; ++nf)
#pragma unroll
                for (int r = 0; r < 4; ++r) part[(w * 16 + fq * 4 + r) * 64 + nf * 16 + fr] = ac[nf][r];
        }
        __syncthreads();
        float lg[4];
#pragma unroll
        for (int rr = 0; rr < 4; ++rr) {
            const int r0 = w * 4 + rr;
            lg[rr] = part[(0 * 16 + r0) * 64 + lane] + part[(1 * 16 + r0) * 64 + lane] + part[(2 * 16 + r0) * 64 + lane] + part[(3 * 16 + r0) * 64 + lane];
        }
        const float rbias = p.in(I_ROUTER_B)[l * 64 + lane];
        unsigned* cnt = (unsigned*)(p.ws + WS_CTL) + CW_CNT(l);
        int* aep = (int*)(p.ws + WS_AEP); float* aw = (float*)(p.ws + WS_AW);
#pragma unroll 1
        for (int rr = 0; rr < 4; ++rr) {
            const int row = u * 16 + w * 4 + rr;
            const float logit = (rr == 0) ? lg[0] : (rr == 1) ? lg[1] : (rr == 2) ? lg[2] : lg[3];
            const float s = 1.f / (1.f + expf(-logit));
            const float bsd = s + rbias;
            float m1 = bsd;
            m1 = fmaxf(m1, __shfl_xor(m1, 1)); m1 = fmaxf(m1, __shfl_xor(m1, 2)); m1 = fmaxf(m1, __shfl_xor(m1, 4));
            const unsigned long long eqm = __ballot(bsd == m1);
            const int gbase = lane & ~7;
            const unsigned gbits = (unsigned)((eqm >> gbase) & 0xFFull);
            const int first = gbase + __builtin_ctz(gbits);
            float m2 = (lane == first) ? -INFINITY : bsd;
            m2 = fmaxf(m2, __shfl_xor(m2, 1)); m2 = fmaxf(m2, __shfl_xor(m2, 2)); m2 = fmaxf(m2, __shfl_xor(m2, 4));
            const float gs = m1 + m2;
            const int myg = lane >> 3;
            int grank = 0;
#pragma unroll
            for (int g2 = 0; g2 < 8; ++g2) { const float o = __int_as_float(__builtin_amdgcn_readlane(__float_as_int(gs), g2 * 8)); grank += (o > gs || (o == gs && g2 < myg)) ? 1 : 0; }
            const bool gsel = grank < 4;
            const float msk = gsel ? bsd : -INFINITY;
            int erank = 0;
#pragma unroll
            for (int j = 0; j < 64; ++j) { const float o = __int_as_float(__builtin_amdgcn_readlane(__float_as_int(msk), j)); erank += (o > msk || (o == msk && j < lane)) ? 1 : 0; }
            const bool sel = gsel && erank < 8;
            const float wsum = wave_sum(sel ? s : 0.f);
            const unsigned long long selm = __ballot(sel);
            if (sel && !dry) {
                const int slot = __popcll(selm & ((1ull << lane) - 1ull));
                const unsigned pos = atomicAdd(&cnt[lane * 32], 1u);
                aep[(size_t)row * 8 + slot] = (int)((unsigned)lane << 24 | pos);
                ((int*)(p.ws + WS_RTOK))[(size_t)lane * NT + pos] = row;
                aw[(size_t)row * 8 + slot] = s / wsum * 2.5f;
            }
        }
    }
}

__device__ __forceinline__ void filt_unit(const P& p, int l, int u, char* lds) {
    const int tid = otid();
    float* feat = (float*)lds;
    float* h1 = feat + 4 * 36;
    float* h2 = h1 + 4 * 64;
    const int pp = tid >> 6, j = tid & 63;
    const int pi = u * 4 + pp;
    const int L = pi < 4096 ? 4096 : 256;
    const int t = pi < 4096 ? pi : pi - 4096;
    const float tt = (float)t / (float)(L - 1);
    if (j < 33) {
        float f;
        if (j == 0) f = tt;
        else {
            const int k = (j - 1) & 15;
            const float band = 1e-4f + (float)k * ((15.0f - 1e-4f) / 15.0f);
            float ph = band * (float)t * (1.f / (float)L);
            ph -= floorf(ph);
            float sn, cs; sincospif(2.f * ph, &sn, &cs);
            f = (j <= 16) ? cs : -sn;
        }
        feat[pp * 36 + j] = f;
    }
    __syncthreads();
    {
        const float* w1 = p.in(I_HY_W1) + (size_t)l * 33 * 64;
        float a = p.in(I_HY_B1)[l * 64 + j];
        for (int i = 0; i < 33; ++i) a += feat[pp * 36 + i] * w1[i * 64 + j];
        h1[pp * 64 + j] = sinf(p.in(I_HY_F1)[l * 64 + j] * a);
    }
    __syncthreads();
    {
        const float* w2 = p.in(I_HY_W2) + (size_t)l * 64 * 64;
        float a = p.in(I_HY_B2)[l * 64 + j];
        for (int i = 0; i < 64; ++i) a += h1[pp * 64 + i] * w2[i * 64 + j];
        h2[pp * 64 + j] = sinf(p.in(I_HY_F2)[l * 64 + j] * a);
    }
    __syncthreads();
    {
        const int c = tid;
        const float* w3 = p.in(I_HY_W3) + (size_t)l * 64 * 1024;
        float acc[4][4];
#pragma unroll
        for (int a = 0; a < 4; ++a)
#pragma unroll
            for (int b = 0; b < 4; ++b) acc[a][b] = 0.f;
        for (int i = 0; i < 64; ++i) {
            float wv[4];
#pragma unroll
            for (int os = 0; os < 4; ++os) wv[os] = w3[i * 1024 + os * 256 + c];
#pragma unroll
            for (int q = 0; q < 4; ++q) {
                const float hv = h2[q * 64 + i];
#pragma unroll
                for (int os = 0; os < 4; ++os) acc[q][os] += hv * wv[os];
            }
        }
        const float d0 = logf(0.01f) / 1.5f, d1 = logf(0.01f) / 0.3f;
        const float delta = fabsf(d0 + (d1 - d0) * ((float)c / 255.f));
#pragma unroll
        for (int q = 0; q < 4; ++q) {
            const int pq = u * 4 + q;
            const int Lq = pq < 4096 ? 4096 : 256;
            const int tq = pq < 4096 ? pq : pq - 4096;
            const float ttq = (float)tq / (float)(Lq - 1);
            const float dec = expf(-ttq * delta);
            float* F = (pq < 4096) ? (float*)(p.ws + WS_FILTL + l * SZ_FILTL) : (float*)(p.ws + WS_FILTC + l * SZ_FILTC);
#pragma unroll
            for (int os = 0; os < 4; ++os) {
                if (pq < 4096) F[((size_t)((os >> 1) * 256 + c) * 2 + (os & 1)) * 4096 + tq] = acc[q][os] * dec;
                else F[((size_t)os * 256 + c) * Lq + tq] = acc[q][os] * dec;
            }
        }
    }
    __syncthreads();
}

__device__ __forceinline__ void rwkv_prep_unit(const P& p, int l, int u, char* lds) {
    const int tid = otid();
    bf16_t* twb = (bf16_t*)lds;
    bf16_t* alb = twb + 32 * 72;
    bf16_t* ot = alb + 32 * 72;
    const bf16_t* z = (const bf16_t*)(p.ws + WS_Z);
    bf16_t* rwp = (bf16_t*)(p.ws + WS_R1 + R1_RWP);
    float* knorm = (float*)(p.ws + WS_KNORM);
    const int row0 = u * 32;
    {
        const int tok = tid >> 3, j0 = (tid & 7) * 8;
        const bf16_t* zr = z + (size_t)(row0 + tok) * ZS;
        float wl[8];
        unpack8(*reinterpret_cast<const uint4*>(zr + 768 + j0), wl);
#pragma unroll
        for (int i = 0; i < 8; ++i) wl[i] = 1.f - 2.f * __frcp_rn(1.f + __expf(2.f * wl[i]));
        *reinterpret_cast<uint4*>(twb + tok * 72 + j0) = pack8(wl);
        *reinterpret_cast<uint4*>(alb + tok * 72 + j0) = *reinterpret_cast<const uint4*>(zr + 832 + j0);
    }
    {
        const int tl = tid >> 5, cg = tid & 31, c0 = cg * 8;
        float kk[8];
#pragma unroll
        for (int i = 0; i < 8; ++i) kk[i] = p.in(I_RW_KK)[l * 256 + c0 + i];
#pragma unroll
        for (int it = 0; it < 4; ++it) {
            const int row = row0 + it * 8 + tl;
            float k[8];
            unpack8(*reinterpret_cast<const uint4*>(z + (size_t)row * ZS + 256 + c0), k);
            float ss = 0.f;
#pragma unroll
            for (int i = 0; i < 8; ++i) { const float kv = k[i] * kk[i]; ss += kv * kv; }
            ss = sum8lanes(ss);
            if ((cg & 7) == 0) knorm[(size_t)row * 4 + (cg >> 3)] = rsqrtf(ss + 1e-12f);
        }
    }
    __syncthreads();
    const int w = tid >> 6, lane = tid & 63, fr = lane & 15, fq = lane >> 4;
#pragma unroll 1
    for (int combo = 0; combo < 4; ++combo) {
        const int kind = combo >> 1, d = combo & 1;
        const bf16_t* At = kind ? alb : twb;
        const bf16_t* Bt = (const bf16_t*)(p.ws + (kind ? WS_LA2T : WS_LW2T)) + (size_t)l * 256 * 64;
        const float* basep = (kind ? p.in(I_RW_A0) : p.in(I_RW_W0)) + (l * 2 + d) * 256;
        bf16x8 af[2], bfr[4];
#pragma unroll
        for (int mf = 0; mf < 2; ++mf) af[mf] = *reinterpret_cast<const bf16x8*>(At + (mf * 16 + fr) * 72 + d * 32 + fq * 8);
#pragma unroll
        for (int nf = 0; nf < 4; ++nf) bfr[nf] = *reinterpret_cast<const bf16x8*>(Bt + (size_t)(w * 64 + nf * 16 + fr) * 64 + d * 32 + fq * 8);
#pragma unroll
        for (int nf = 0; nf < 4; ++nf) {
            const float base = basep[w * 64 + nf * 16 + fr];
#pragma unroll
            for (int mf = 0; mf < 2; ++mf) {
                const f32x4 acc = __builtin_amdgcn_mfma_f32_16x16x32_bf16(af[mf], bfr[nf], f32x4{0.f, 0.f, 0.f, 0.f}, 0, 0, 0);
#pragma unroll
                for (int j = 0; j < 4; ++j) {
                    const float a = base + acc[j];
                    float o;
                    if (kind) o = __frcp_rn(1.f + __expf(-a));
                    else { const float na = -a; const float sp = fmaxf(na, 0.f) + __logf(1.f + __expf(-fabsf(na))); o = __expf(-sp - 0.5f); }
                    ot[(mf * 16 + fq * 4 + j) * 264 + w * 64 + nf * 16 + fr] = f2bf(o);
                }
            }
        }
        __syncthreads();
#pragma unroll
        for (int i = 0; i < 4; ++i) {
            const int id = tid + 256 * i, tok = id >> 5, c8 = (id & 31) * 8;
            *reinterpret_cast<uint4*>(rwp + ((size_t)(row0 + tok) * 4 + combo) * 256 + c8) = *reinterpret_cast<const uint4*>(ot + tok * 264 + c8);
        }
        __syncthreads();
    }
}

__device__ __forceinline__ void gdn_prep_unit(const P& p, int l, int u) {
    const int tid = otid();
    const bf16_t* z = (const bf16_t*)(p.ws + WS_Z);
    bf16_t* gq = (bf16_t*)(p.ws + WS_R1 + R1_GQ);
    float* gab = (float*)(p.ws + WS_GAB);
    const int row0 = u * 32;
    int seq0, seqL;
    if (row0 < NTC) { seq0 = row0 & ~255; seqL = 256; } else { seq0 = NTC + ((row0 - NTC) & ~4095); seqL = 4096; }
    const int tl = tid >> 5, cg = tid & 31;
#pragma unroll 1
    for (int pz = 0; pz < 3; ++pz) {
        const int ch0 = pz * 256 + cg * 8;
        float w0[8], w1[8], w2[8];
        {
            const float* cw = p.in(I_GD_CONV) + (size_t)l * 3 * 768 + ch0;
#pragma unroll
            for (int i = 0; i < 8; i += 4) {
                const float4 a = *reinterpret_cast<const float4*>(cw + i), b = *reinterpret_cast<const float4*>(cw + 768 + i), c = *reinterpret_cast<const float4*>(cw + 1536 + i);
                w0[i] = a.x; w0[i + 1] = a.y; w0[i + 2] = a.z; w0[i + 3] = a.w;
                w1[i] = b.x; w1[i + 1] = b.y; w1[i + 2] = b.z; w1[i + 3] = b.w;
                w2[i] = c.x; w2[i + 1] = c.y; w2[i + 2] = c.z; w2[i + 3] = c.w;
            }
        }
#pragma unroll 2
        for (int it = 0; it < 4; ++it) {
            const int row = row0 + it * 8 + tl;
            const bf16_t* zc = z + (size_t)row * ZS + COL_GD + ch0;
            const uint4 zero4 = make_uint4(0u, 0u, 0u, 0u);
            const uint4 vm = (row - 1 >= seq0) ? *reinterpret_cast<const uint4*>(zc - ZS) : zero4;
            const uint4 v0 = *reinterpret_cast<const uint4*>(zc);
            const uint4 vp = (row + 1 < seq0 + seqL) ? *reinterpret_cast<const uint4*>(zc + ZS) : zero4;
            float xm[8], x0[8], xp[8], o[8];
            unpack8(vm, xm); unpack8(v0, x0); unpack8(vp, xp);
            float ss = 0.f;
#pragma unroll
            for (int i = 0; i < 8; ++i) { o[i] = siluf(w0[i] * xm[i] + w1[i] * x0[i] + w2[i] * xp[i]); ss += o[i] * o[i]; }
            if (pz < 2) {
                ss = sum8lanes(ss);
                const float sc = rsqrtf(ss + 1e-12f) * (pz == 0 ? 0.125f : 1.f);
#pragma unroll
                for (int i = 0; i < 8; ++i) o[i] *= sc;
            }
            *reinterpret_cast<uint4*>(gq + (size_t)row * 768 + ch0) = pack8(o);
        }
    }
    {
        const int tok = tid >> 3, dh = tid & 7;
        const int row = row0 + tok;
        const float alv = bf2f(z[(size_t)row * ZS + COL_GD + 1024 + dh]);
        const float blv = bf2f(z[(size_t)row * ZS + COL_GD + 1032 + dh]);
        const float g = -expf(p.in(I_GD_ALOG)[l * 8 + dh]) * softplusf(alv + p.in(I_GD_DTB)[l * 8 + dh]);
        gab[(size_t)row * 16 + dh] = expf(g);
        gab[(size_t)row * 16 + 8 + dh] = 1.f / (1.f + expf(-blv));
    }
}

__device__ __forceinline__ int s5_chain_row(int b, int d, int q) {
    if (q < 256) return b * 256 + (d ? 255 - q : q);
    int n = q - 256; if (d) n = 4095 - n;
    return NTC + b * 4096 + (n & 63) * 64 + (n >> 6);
}
__device__ __forceinline__ void s5_load_u(const bf16_t* zr, float* dst) {
    const uint4 a = *reinterpret_cast<const uint4*>(zr);
    const uint4 b = *reinterpret_cast<const uint4*>(zr + 8);
    *reinterpret_cast<float4*>(dst + 0) = make_float4(bflo(a.x), bfhi(a.x), bflo(a.y), bfhi(a.y));
    *reinterpret_cast<float4*>(dst + 4) = make_float4(bflo(a.z), bfhi(a.z), bflo(a.w), bfhi(a.w));
    *reinterpret_cast<float4*>(dst + 8) = make_float4(bflo(b.x), bfhi(b.x), bflo(b.y), bfhi(b.y));
    *reinterpret_cast<float4*>(dst + 12) = make_float4(bflo(b.z), bfhi(b.z), bflo(b.w), bfhi(b.w));
}

__device__ __forceinline__ void s5_pre_unit(const P& p, int l, int u, char* lds) {
    const int tid = otid(), w = tid >> 6, lane = tid & 63;
    float* ust = (float*)lds + w * 1024;
    const int wt = u * 4 + w;
    const int d = wt & 1, g = (wt >> 1) & 15, rest = wt >> 5;
    const int cc = rest % NCHUNK, b = rest / NCHUNK;
    const bf16_t* z = (const bf16_t*)(p.ws + WS_Z);
    {
        const int row = s5_chain_row(b, d, cc * 64 + lane);
        s5_load_u(z + (size_t)row * ZS + COL_S5 + g * 16, ust + lane * 16);
    }
    const int tix = ((l * 2 + d) * 16 + g) * 64 + lane;
    const float4 A = *reinterpret_cast<const float4*>((const float*)(p.ws + WS_S5A) + (size_t)tix * 4);
    const float* Bp = (const float*)(p.ws + WS_S5B) + (size_t)tix * 32;
    f32x2 bb[16];
#pragma unroll
    for (int h = 0; h < 16; ++h) bb[h] = f32x2{Bp[h], Bp[16 + h]};
    float xr = 0.f, xi = 0.f;
#pragma unroll 4
    for (int s = 0; s < 64; ++s) {
        f32x2 bu = f32x2{0.f, 0.f};
#pragma unroll
        for (int h4 = 0; h4 < 4; ++h4) {
            const float4 uu = *reinterpret_cast<const float4*>(ust + s * 16 + h4 * 4);
            bu += bb[h4 * 4] * uu.x + bb[h4 * 4 + 1] * uu.y + bb[h4 * 4 + 2] * uu.z + bb[h4 * 4 + 3] * uu.w;
        }
        const float nr = A.x * xr - A.y * xi + bu.x;
        const float ni = A.x * xi + A.y * xr + bu.y;
        xr = nr; xi = ni;
    }
    float* st = (float*)(p.ws + WS_S5ST) + ((((size_t)(b * NCHUNK + cc) * 2 + d) * 16 + g) * 64 + lane) * 2;
    st[0] = xr; st[1] = xi;
}

__device__ __forceinline__ float reduce16(const float (&t)[16], int lane) {
    float a[8];
    const bool hi8 = (lane & 8) != 0;
#pragma unroll
    for (int k = 0; k < 8; ++k) { const float keep = hi8 ? t[k + 8] : t[k]; const float send = hi8 ? t[k] : t[k + 8]; a[k] = keep + dppf<0x140>(send); }
    float b[4];
    const bool hi4 = (lane & 4) != 0;
#pragma unroll
    for (int k = 0; k < 4; ++k) { const float keep = hi4 ? a[k + 4] : a[k]; const float send = hi4 ? a[k] : a[k + 4]; b[k] = keep + dppf<0x141>(send); }
    float c[2];
    const bool hi2 = (lane & 2) != 0;
#pragma unroll
    for (int k = 0; k < 2; ++k) { const float keep = hi2 ? b[k + 2] : b[k]; const float send = hi2 ? b[k] : b[k + 2]; c[k] = keep + dppf<0x4E>(send); }
    const bool hi1 = (lane & 1) != 0;
    float r = (hi1 ? c[1] : c[0]) + dppf<0xB1>(hi1 ? c[0] : c[1]);
    r += __shfl_xor(r, 16);
    r += __shfl_xor(r, 32);
    return r;
}

__device__ __forceinline__ void s5_main_unit(const P& p, int l, int u, char* lds) {
    const int tid = otid(), w = tid >> 6, lane = tid & 63;
    char* wl = lds + w * 12800;
    float* ust = (float*)wl;
    char* xbuf = wl + 4096;
    float* yst = (float*)xbuf;
    const int b = u / NCHUNK, tc = u % NCHUNK;
    bf16_t* z = (bf16_t*)(p.ws + WS_Z);
    const int myrow = (tc < 4) ? (b * 256 + tc * 64 + lane) : (NTC + b * 4096 + lane * 64 + (tc - 4));
    const int fr = lane & 15, fq = lane >> 4;
#pragma unroll 1
    for (int gi = 0; gi < 4; ++gi) {
        const int g = w * 4 + gi;
        s5_load_u(z + (size_t)myrow * ZS + COL_S5 + g * 16, ust + lane * 16);
        f32x4 yacc[4];
#pragma unroll
        for (int mf = 0; mf < 4; ++mf) yacc[mf] = f32x4{0.f, 0.f, 0.f, 0.f};
#pragma unroll 1
        for (int d = 0; d < 2; ++d) {
            const int tix = ((l * 2 + d) * 16 + g) * 64 + lane;
            const float4 A = *reinterpret_cast<const float4*>((const float*)(p.ws + WS_S5A) + (size_t)tix * 4);
            const float* Bp = (const float*)(p.ws + WS_S5B) + (size_t)tix * 32;
            f32x2 bb[16];
#pragma unroll
            for (int h = 0; h < 16; ++h) bb[h] = f32x2{Bp[h], Bp[16 + h]};
            bf16x8 cfrag[4];
            {
                const float* crp = p.in(I_S5_CRE) + (size_t)((l * 2 + d) * 16 + g) * 1024 + fr * 64;
                const float* cip = p.in(I_S5_CIM) + (size_t)((l * 2 + d) * 16 + g) * 1024 + fr * 64;
#pragma unroll
                for (int ks = 0; ks < 4; ++ks) {
                    const int k0 = (ks & 1) * 32 + fq * 8;
                    const float* src = (ks < 2) ? crp + k0 : cip + k0;
                    const float sg = (ks < 2) ? 1.f : -1.f;
                    const float4 c0 = *reinterpret_cast<const float4*>(src), c1 = *reinterpret_cast<const float4*>(src + 4);
                    cfrag[ks][0] = (short)f2bf(sg * c0.x); cfrag[ks][1] = (short)f2bf(sg * c0.y); cfrag[ks][2] = (short)f2bf(sg * c0.z); cfrag[ks][3] = (short)f2bf(sg * c0.w);
                    cfrag[ks][4] = (short)f2bf(sg * c1.x); cfrag[ks][5] = (short)f2bf(sg * c1.y); cfrag[ks][6] = (short)f2bf(sg * c1.z); cfrag[ks][7] = (short)f2bf(sg * c1.w);
                }
            }
            const int cc = d ? ((tc < 4) ? 3 - tc : 71 - tc) : tc;
            float xr = 0.f, xi = 0.f;
            {
                const float* st = (const float*)(p.ws + WS_S5ST) + ((((size_t)(b * NCHUNK) * 2 + d) * 16 + g) * 64 + lane) * 2;
                for (int c0 = 0; c0 < cc; c0 += 8) {
                    float2 sv[8];
#pragma unroll
                    for (int q = 0; q < 8; ++q) {
                        const int c2 = (c0 + q < cc) ? c0 + q : cc - 1;
                        sv[q] = *reinterpret_cast<const float2*>(st + (size_t)c2 * (2 * 16 * 64 * 2));
                    }
#pragma unroll
                    for (int q = 0; q < 8; ++q) {
                        if (c0 + q < cc) {
                            const float nr = A.z * xr - A.w * xi + sv[q].x;
                            const float ni = A.z * xi + A.w * xr + sv[q].y;
                            xr = nr; xi = ni;
                        }
                    }
                }
            }
#pragma unroll 1
            for (int hf = 0; hf < 2; ++hf) {
                const int hbase = (d ? 1 - hf : hf) * 32;
#pragma unroll 4
                for (int s = 0; s < 32; ++s) {
                    const int il = d ? 31 - s : s;
                    const float* up = ust + (hbase + il) * 16;
                    f32x2 bu = f32x2{0.f, 0.f};
#pragma unroll
                    for (int h4 = 0; h4 < 4; ++h4) {
                        const float4 uu = *reinterpret_cast<const float4*>(up + h4 * 4);
                        bu += bb[h4 * 4] * uu.x + bb[h4 * 4 + 1] * uu.y + bb[h4 * 4 + 2] * uu.z + bb[h4 * 4 + 3] * uu.w;
                    }
                    const float nr = A.x * xr - A.y * xi + bu.x;
                    const float ni = A.x * xi + A.y * xr + bu.y;
                    xr = nr; xi = ni;
                    *reinterpret_cast<bf16_t*>(xbuf + il * 272 + lane * 2) = f2bf(xr);
                    *reinterpret_cast<bf16_t*>(xbuf + il * 272 + 128 + lane * 2) = f2bf(xi);
                }
#pragma unroll
                for (int mfl = 0; mfl < 2; ++mfl) {
                    f32x4 acc = yacc[0];
                    const int mf = (hbase >> 4) + mfl;
                    acc = (mf == 0) ? yacc[0] : (mf == 1) ? yacc[1] : (mf == 2) ? yacc[2] : yacc[3];
#pragma unroll
                    for (int ks = 0; ks < 4; ++ks) {
                        const bf16x8 af = *reinterpret_cast<const bf16x8*>(xbuf + (mfl * 16 + fr) * 272 + ks * 64 + fq * 16);
                        acc = __builtin_amdgcn_mfma_f32_16x16x32_bf16(af, cfrag[ks], acc, 0, 0, 0);
                    }
                    if (mf == 0) yacc[0] = acc; else if (mf == 1) yacc[1] = acc; else if (mf == 2) yacc[2] = acc; else yacc[3] = acc;
                }
            }
        }
#pragma unroll
        for (int mf = 0; mf < 4; ++mf)
#pragma unroll
            for (int j = 0; j < 4; ++j) yst[(mf * 16 + fq * 4 + j) * 16 + fr] = yacc[mf][j];
        {
            const float* dsk = p.in(I_S5_D) + l * 256 + g * 16;
            unsigned pk[8];
#pragma unroll
            for (int h = 0; h < 16; h += 2) {
                float y0 = yst[lane * 16 + h] + ust[lane * 16 + h] * dsk[h];
                float y1 = yst[lane * 16 + h + 1] + ust[lane * 16 + h + 1] * dsk[h + 1];
                y0 = 0.5f * y0 * (1.f + erff(y0 * 0.70710678118f));
                y1 = 0.5f * y1 * (1.f + erff(y1 * 0.70710678118f));
                pk[h >> 1] = pack2(y0, y1);
            }
            uint4* dst = reinterpret_cast<uint4*>((bf16_t*)(p.ws + WS_S5G) + (size_t)myrow * 256 + g * 16);
            dst[0] = make_uint4(pk[0], pk[1], pk[2], pk[3]);
            dst[1] = make_uint4(pk[4], pk[5], pk[6], pk[7]);
        }
    }
}

#define SB 16
__device__ __forceinline__ int scan_chain_row(int b, int d, int q) {
    if (q < 256) return b * 256 + (d ? 255 - q : q);
    const int t = q - 256;
    return NTC + b * 4096 + (d ? 4095 - t : t);
}
struct ScanRaw { uint2 r, k, v, e, a; float f0, f1; };

__device__ __forceinline__ void scan_load(const P& p, int m, int b, int h, int d, int q, int cg, ScanRaw& R) {
    const int row = scan_chain_row(b, d, q);
    const int c0 = h * 64 + cg * 4;
    if (m == 0) {
        const bf16_t* z = (const bf16_t*)(p.ws + WS_Z) + (size_t)row * ZS + c0;
        R.r = *reinterpret_cast<const uint2*>(z);
        R.k = *reinterpret_cast<const uint2*>(z + 256);
        R.v = *reinterpret_cast<const uint2*>(z + 512);
        const bf16_t* rw = (const bf16_t*)(p.ws + WS_R1 + R1_RWP) + (size_t)row * 1024 + c0;
        R.e = *reinterpret_cast<const uint2*>(rw + d * 256);
        R.a = *reinterpret_cast<const uint2*>(rw + (2 + d) * 256);
        R.f0 = ((const float*)(p.ws + WS_KNORM))[(size_t)row * 4 + h];
        R.f1 = 0.f;
    } else {
        const bf16_t* gq = (const bf16_t*)(p.ws + WS_R1 + R1_GQ) + (size_t)row * 768 + c0;
        R.r = *reinterpret_cast<const uint2*>(gq);
        R.k = *reinterpret_cast<const uint2*>(gq + 256);
        R.v = *reinterpret_cast<const uint2*>(gq + 512);
        R.e = make_uint2(0u, 0u); R.a = make_uint2(0u, 0u);
        const float* gab = (const float*)(p.ws + WS_GAB) + (size_t)row * 16;
        R.f0 = gab[d * 4 + h];
        R.f1 = gab[8 + d * 4 + h];
    }
}
__device__ __forceinline__ void scan_store(int m, const ScanRaw& R, float* dst  , const float (&kkp)[4], const float (&kap)[4]) {
    float r[4] = {bflo(R.r.x), bfhi(R.r.x), bflo(R.r.y), bfhi(R.r.y)};
    float k[4] = {bflo(R.k.x), bfhi(R.k.x), bflo(R.k.y), bfhi(R.k.y)};
    float v[4] = {bflo(R.v.x), bfhi(R.v.x), bflo(R.v.y), bfhi(R.v.y)};
    float ww[4], aa[4], bb[4], kk[4];
    if (m == 0) {
        float e[4] = {bflo(R.e.x), bfhi(R.e.x), bflo(R.e.y), bfhi(R.e.y)};
        float a[4] = {bflo(R.a.x), bfhi(R.a.x), bflo(R.a.y), bfhi(R.a.y)};
#pragma unroll
        for (int i = 0; i < 4; ++i) {
            ww[i] = __expf(-e[i]);
            kk[i] = k[i] * (1.f + (a[i] - 1.f) * kap[i]);
            const float kn = k[i] * kkp[i] * R.f0;
            aa[i] = -kn;
            bb[i] = kn * a[i];
        }
    } else {
        const float al = R.f0, be = R.f1;
#pragma unroll
        for (int i = 0; i < 4; ++i) { ww[i] = al; aa[i] = k[i]; bb[i] = -al * be * k[i]; kk[i] = be * k[i]; }
    }
    *reinterpret_cast<float4*>(dst + 0 * 64) = make_float4(ww[0], ww[1], ww[2], ww[3]);
    *reinterpret_cast<float4*>(dst + 1 * 64) = make_float4(aa[0], aa[1], aa[2], aa[3]);
    *reinterpret_cast<float4*>(dst + 2 * 64) = make_float4(bb[0], bb[1], bb[2], bb[3]);
    *reinterpret_cast<float4*>(dst + 3 * 64) = make_float4(kk[0], kk[1], kk[2], kk[3]);
    *reinterpret_cast<float4*>(dst + 4 * 64) = make_float4(r[0], r[1], r[2], r[3]);
    *reinterpret_cast<float4*>(dst + 5 * 64) = make_float4(v[0], v[1], v[2], v[3]);
}

__device__ __forceinline__ void scan_unit(const P& p, int l, int u, char* lds) {
    const int tid = otid();
    const int chain = u >> 1, half = u & 1;
    const int m = chain >> 6, rem = chain & 63, b = rem >> 3, h = (rem >> 1) & 3, d = rem & 1;
    float* buf = (float*)lds;
    float* ybuf = buf + 2 * SB * 384;
    const int rp = tid >> 4, sub = tid & 15;
    const int st = tid >> 4, cg = tid & 15;
    float kkp[4], kap[4];
#pragma unroll
    for (int i = 0; i < 4; ++i) { kkp[i] = p.in(I_RW_KK)[l * 256 + h * 64 + cg * 4 + i]; kap[i] = p.in(I_RW_KA)[l * 256 + h * 64 + cg * 4 + i]; }
    bf16_t* ys = (bf16_t*)(p.ws + WS_HBY) + (size_t)(m * 2 + d) * NT * 256;
    f32x2 S2[4];
#pragma unroll
    for (int j = 0; j < 4; ++j) S2[j] = f32x2{0.f, 0.f};
    ScanRaw R, R2;
    scan_load(p, m, b, h, d, st, cg, R);
    scan_store(m, R, buf + (st * 6) * 64 + cg * 4, kkp, kap);
    scan_load(p, m, b, h, d, SB + st, cg, R);
    __syncthreads();
    const int NB = 4352 / SB;
    __builtin_amdgcn_s_setprio(2);
    auto batch = [&](int bt, ScanRaw& Rld, ScanRaw& Rst) {
        const int par = bt & 1;
        if (bt + 2 < NB) scan_load(p, m, b, h, d, (bt + 2) * SB + st, cg, Rld);
        const float* cb = buf + par * (SB * 384);
        float* yb = ybuf + par * (SB * 32);
        {
            const float* sb0 = cb + sub * 4;
            const float* vb0 = cb + 320 + half * 32 + rp;
            float4 nw = *reinterpret_cast<const float4*>(sb0), na = *reinterpret_cast<const float4*>(sb0 + 64), nb = *reinterpret_cast<const float4*>(sb0 + 128);
            float4 nk = *reinterpret_cast<const float4*>(sb0 + 192), nr = *reinterpret_cast<const float4*>(sb0 + 256);
            float nvA = vb0[0], nvB = vb0[16];
            float4 mw = *reinterpret_cast<const float4*>(sb0 + 384), ma = *reinterpret_cast<const float4*>(sb0 + 384 + 64), mb = *reinterpret_cast<const float4*>(sb0 + 384 + 128);
            float4 mk = *reinterpret_cast<const float4*>(sb0 + 384 + 192), mr = *reinterpret_cast<const float4*>(sb0 + 384 + 256);
            float mvA = vb0[384], mvB = vb0[384 + 16];
#pragma unroll
            for (int s = 0; s < SB; ++s) {
                const float4 w = nw, a = na, bq = nb, k = nk, r = nr;
                const float vA = nvA, vB = nvB;
                nw = mw; na = ma; nb = mb; nk = mk; nr = mr; nvA = mvA; nvB = mvB;
                if (s + 2 < SB) {
                    const float* sb = sb0 + (s + 2) * 384;
                    mw = *reinterpret_cast<const float4*>(sb); ma = *reinterpret_cast<const float4*>(sb + 64); mb = *reinterpret_cast<const float4*>(sb + 128);
                    mk = *reinterpret_cast<const float4*>(sb + 192); mr = *reinterpret_cast<const float4*>(sb + 256);
                    mvA = vb0[(s + 2) * 384]; mvB = vb0[(s + 2) * 384 + 16];
                }
                __builtin_amdgcn_sched_barrier(0);
                const f32x2 v2 = {vA, vB};
                f32x2 sa2 = S2[0] * a.x + S2[1] * a.y + S2[2] * a.z + S2[3] * a.w;
                float sa = sa2.x, sb2 = sa2.y;
                dpp_allreduce16_x2(sa, sb2);
                sa2.x = sa; sa2.y = sb2;
                S2[0] = S2[0] * w.x + sa2 * bq.x + v2 * k.x;
                S2[1] = S2[1] * w.y + sa2 * bq.y + v2 * k.y;
                S2[2] = S2[2] * w.z + sa2 * bq.z + v2 * k.z;
                S2[3] = S2[3] * w.w + sa2 * bq.w + v2 * k.w;
                const f32x2 y2 = S2[0] * r.x + S2[1] * r.y + S2[2] * r.z + S2[3] * r.w;
                float yA = y2.x, yB = y2.y;
                dpp_allreduce16_x2(yA, yB);
                yb[s * 32 + rp] = yA; yb[s * 32 + 16 + rp] = yB;
            }
        }
        if (bt + 1 < NB) scan_store(m, Rst, buf + (1 - par) * (SB * 384) + (st * 6) * 64 + cg * 4, kkp, kap);
        __syncthreads();
        {
            const int r2 = cg * 2;
            const int row = scan_chain_row(b, d, bt * SB + st);
            const unsigned pk = pack2(yb[st * 32 + r2], yb[st * 32 + r2 + 1]);
            *reinterpret_cast<unsigned*>(ys + (size_t)row * 256 + h * 64 + half * 32 + r2) = pk;
        }
    };
#pragma unroll 1
    for (int bt = 0; bt < NB; bt += 2) { batch(bt, R2, R); batch(bt + 1, R, R2); }
    __builtin_amdgcn_s_setprio(0);
    __syncthreads();
}

__device__ __forceinline__ void scan_unit_gd2(const P& p, int l, int u, char* lds) {
    const int tid = otid();
    const int chain = 64 + (u >> 1), half = u & 1;
    const int m = chain >> 6, rem = chain & 63, b = rem >> 3, h = (rem >> 1) & 3, d = rem & 1;
    float* buf = (float*)lds;
    float* ybuf = buf + 2 * SB * 384;
    const int rp = tid >> 4, sub = tid & 15;
    const int st = tid >> 4, cg = tid & 15;
    float kkp[4], kap[4];
#pragma unroll
    for (int i = 0; i < 4; ++i) { kkp[i] = p.in(I_RW_KK)[l * 256 + h * 64 + cg * 4 + i]; kap[i] = p.in(I_RW_KA)[l * 256 + h * 64 + cg * 4 + i]; }
    bf16_t* ys = (bf16_t*)(p.ws + WS_HBY) + (size_t)(m * 2 + d) * NT * 256;
    f32x2 S2[4];
#pragma unroll
    for (int j = 0; j < 4; ++j) S2[j] = f32x2{0.f, 0.f};
    ScanRaw R, R2;
    scan_load(p, m, b, h, d, st, cg, R);
    scan_store(m, R, buf + (st * 6) * 64 + cg * 4, kkp, kap);
    scan_load(p, m, b, h, d, SB + st, cg, R);
    __syncthreads();
    const int NB = 4352 / SB;
    __builtin_amdgcn_s_setprio(2);
    auto batch = [&](int bt, ScanRaw& Rld, ScanRaw& Rst) {
        const int par = bt & 1;
        if (bt + 2 < NB) scan_load(p, m, b, h, d, (bt + 2) * SB + st, cg, Rld);
        const float* cb = buf + par * (SB * 384);
        float* yb = ybuf + par * (SB * 32);
        {
            const float* sb0 = cb + sub * 4;
            const float* vb0 = cb + 320 + half * 32 + rp;
            float4 na = *reinterpret_cast<const float4*>(sb0 + 64), nk = *reinterpret_cast<const float4*>(sb0 + 192), nr = *reinterpret_cast<const float4*>(sb0 + 256);
            float nal = cb[0], nvA = vb0[0], nvB = vb0[16];
            float4 ma = *reinterpret_cast<const float4*>(sb0 + 384 + 64), mk = *reinterpret_cast<const float4*>(sb0 + 384 + 192), mr = *reinterpret_cast<const float4*>(sb0 + 384 + 256);
            float mal = cb[384], mvA = vb0[384], mvB = vb0[384 + 16];
#pragma unroll
            for (int s = 0; s < SB; ++s) {
                const float4 a = na, k = nk, r = nr;
                const float al = nal, vA = nvA, vB = nvB;
                na = ma; nk = mk; nr = mr; nal = mal; nvA = mvA; nvB = mvB;
                if (s + 2 < SB) {
                    const float* sb = sb0 + (s + 2) * 384;
                    ma = *reinterpret_cast<const float4*>(sb + 64); mk = *reinterpret_cast<const float4*>(sb + 192); mr = *reinterpret_cast<const float4*>(sb + 256);
                    mal = cb[(s + 2) * 384]; mvA = vb0[(s + 2) * 384]; mvB = vb0[(s + 2) * 384 + 16];
                }
                __builtin_amdgcn_sched_barrier(0);
                const f32x2 v2 = {vA, vB};
                f32x2 d2 = S2[0] * a.x + S2[1] * a.y + S2[2] * a.z + S2[3] * a.w;
                float sa = d2.x, sb2 = d2.y;
                dpp_allreduce16_x2(sa, sb2);
                d2.x = sa; d2.y = sb2;
                const f32x2 e2 = v2 - d2 * al;
                S2[0] = S2[0] * al + e2 * k.x;
                S2[1] = S2[1] * al + e2 * k.y;
                S2[2] = S2[2] * al + e2 * k.z;
                S2[3] = S2[3] * al + e2 * k.w;
                const f32x2 y2 = S2[0] * r.x + S2[1] * r.y + S2[2] * r.z + S2[3] * r.w;
                float yA = y2.x, yB = y2.y;
                dpp_allreduce16_x2(yA, yB);
                yb[s * 32 + rp] = yA; yb[s * 32 + 16 + rp] = yB;
            }
        }
        if (bt + 1 < NB) scan_store(m, Rst, buf + (1 - par) * (SB * 384) + (st * 6) * 64 + cg * 4, kkp, kap);
        __syncthreads();
        {
            const int r2 = cg * 2;
            const int row = scan_chain_row(b, d, bt * SB + st);
            const unsigned pk = pack2(yb[st * 32 + r2], yb[st * 32 + r2 + 1]);
            *reinterpret_cast<unsigned*>(ys + (size_t)row * 256 + h * 64 + half * 32 + r2) = pk;
        }
    };
#pragma unroll 1
    for (int bt = 0; bt < NB; bt += 2) { batch(bt, R2, R); batch(bt + 1, R, R2); }
    __builtin_amdgcn_s_setprio(0);
    __syncthreads();
}

template <int L>
__device__ __forceinline__ void hyena_unit(const P& p, int l, int u, char* lds) {
    constexpr int TPT = L / 256;
    const int tid = otid();
    const int c = u >> 2, bp = u & 3;
    float2* u2 = (float2*)lds;
    float* taps = (float*)(lds + (size_t)L * 8);
    const bf16_t* z = (const bf16_t*)(p.ws + WS_Z);
    bf16_t* cat = (bf16_t*)(p.ws + WS_CAT);
    const float* F = (L == 4096) ? (const float*)(p.ws + WS_FILTL + l * SZ_FILTL) : (const float*)(p.ws + WS_FILTC + l * SZ_FILTC);
    int base[2];
#pragma unroll
    for (int bb = 0; bb < 2; ++bb) { const int b = bp * 2 + bb; base[bb] = (L == 4096) ? NTC + b * 4096 : b * 256; }
    const int t0 = tid * TPT;
    const float* cw = p.in(I_HY_CONV) + (size_t)l * 3 * 768; const float* cb = p.in(I_HY_CONVB) + (size_t)l * 768;
    auto sconv = [&](int part, int bb, float (&o)[TPT]) {
        const int ch = part * 256 + c;
        const float w0 = cw[ch], w1 = cw[768 + ch], w2 = cw[1536 + ch], bs = cb[ch];
        const bf16_t* zc = z + (size_t)base[bb] * ZS + COL_HY + ch;
        float xm = (t0 > 0) ? bf2f(zc[(size_t)(t0 - 1) * ZS]) : 0.f;
        float x0 = bf2f(zc[(size_t)t0 * ZS]);
#pragma unroll
        for (int i = 0; i < TPT; ++i) {
            const int t = t0 + i;
            const float xp = (t + 1 < L) ? bf2f(zc[(size_t)(t + 1) * ZS]) : 0.f;
            o[i] = w0 * xm + w1 * x0 + w2 * xp + bs;
            xm = x0; x0 = xp;
        }
    };
    {
        float v0[TPT], v1[TPT];
        sconv(2, 0, v0); sconv(2, 1, v1);
#pragma unroll
        for (int i = 0; i < TPT; ++i) u2[t0 + i] = make_float2(v0[i], v1[i]);
    }
#pragma unroll 1
    for (int o = 0; o < 2; ++o) {
        const float* hf = F + ((size_t)(o * 2 + 0) * 256 + c) * L;
        const float* hbk = F + ((size_t)(o * 2 + 1) * 256 + c) * L;
        for (int k = tid; k < 2 * L; k += NTHREADS) {
            const int dd = k - (L - 1);
            taps[k] = (dd >= L) ? 0.f : (dd >= 0 ? hf[dd] : hbk[-dd]);
        }
        __syncthreads();
        float acc[TPT][2];
#pragma unroll
        for (int i = 0; i < TPT; ++i) { acc[i][0] = 0.f; acc[i][1] = 0.f; }
        if (L == 4096) {
#pragma unroll 1
            for (int s0 = 0; s0 < L; s0 += 16) {
                const int k0 = t0 - s0 + (L - 16);
                float W[32];
#pragma unroll
                for (int q = 0; q < 8; ++q) {
                    const float4 t4 = *reinterpret_cast<const float4*>(taps + k0 + q * 4);
                    W[q * 4] = t4.x; W[q * 4 + 1] = t4.y; W[q * 4 + 2] = t4.z; W[q * 4 + 3] = t4.w;
                }
#pragma unroll
                for (int j = 0; j < 16; ++j) {
                    const float2 uj = u2[s0 + j];
#pragma unroll
                    for (int i = 0; i < TPT; ++i) {
                        const float wv = W[(i - j + 15) & 31];
                        acc[i][0] += wv * uj.x; acc[i][1] += wv * uj.y;
                    }
                }
            }
        } else {
            for (int s = 0; s < L; ++s) {
                const float2 uj = u2[s];
                const float wv = taps[t0 - s + (L - 1)];
                acc[0][0] += wv * uj.x; acc[0][1] += wv * uj.y;
            }
        }
        const float sk = p.in(I_HY_SKIP)[(size_t)(l * 2 + o) * 256 + c];
        float res[TPT][2];
        {
            float g0[TPT], g1[TPT];
            sconv(o, 0, g0); sconv(o, 1, g1);
#pragma unroll
            for (int i = 0; i < TPT; ++i) {
                const float2 ut = u2[t0 + i];
                res[i][0] = g0[i] * (acc[i][0] + sk * ut.x);
                res[i][1] = g1[i] * (acc[i][1] + sk * ut.y);
            }
        }
        __syncthreads();
        if (o == 0) {
#pragma unroll
            for (int i = 0; i < TPT; ++i) u2[t0 + i] = make_float2(res[i][0], res[i][1]);
        } else {
#pragma unroll
            for (int i = 0; i < TPT; ++i) {
                cat[(size_t)(base[0] + t0 + i) * DM + 512 + c] = f2bf(res[i][0]);
                cat[(size_t)(base[1] + t0 + i) * DM + 512 + c] = f2bf(res[i][1]);
            }
        }
        __syncthreads();
    }
}


#define FFT_BS 272
__device__ __forceinline__ int fphys(int d2, int d1, int d0) { return d2 * FFT_BS + d1 * 17 + d0; }
__device__ __forceinline__ float2 cmulf(float2 a, float2 b) { return make_float2(a.x * b.x - a.y * b.y, a.x * b.y + a.y * b.x); }
__device__ static constexpr float C32T[16] = {1.000000000e+00f, 9.807852804e-01f, 9.238795325e-01f, 8.314696123e-01f, 7.071067812e-01f, 5.555702330e-01f, 3.826834324e-01f, 1.950903220e-01f, 6.123233996e-17f, -1.950903220e-01f, -3.826834324e-01f, -5.555702330e-01f, -7.071067812e-01f, -8.314696123e-01f, -9.238795325e-01f, -9.807852804e-01f};
__device__ static constexpr float S32T[16] = {0.000000000e+00f, 1.950903220e-01f, 3.826834324e-01f, 5.555702330e-01f, 7.071067812e-01f, 8.314696123e-01f, 9.238795325e-01f, 9.807852804e-01f, 1.000000000e+00f, 9.807852804e-01f, 9.238795325e-01f, 8.314696123e-01f, 7.071067812e-01f, 5.555702330e-01f, 3.826834324e-01f, 1.950903220e-01f};
template <int LOG> __device__ __forceinline__ constexpr int brev(int i) { int r = 0; for (int b = 0; b < LOG; ++b) r |= ((i >> b) & 1) << (LOG - 1 - b); return r; }
template <int R, bool INV> __device__ __forceinline__ void dftR(float2 (&v)[R]) {
    constexpr int LOG = (R == 32) ? 5 : 4;
    float2 t[R];
#pragma unroll
    for (int i = 0; i < R; ++i) t[brev<LOG>(i)] = v[i];
#pragma unroll
    for (int st = 1; st <= LOG; ++st) {
        const int len = 1 << st, half = len >> 1;
#pragma unroll
        for (int i = 0; i < R; i += len)
#pragma unroll
            for (int j = 0; j < half; ++j) {
                const int tw = j * (32 / len);
                const float2 a = t[i + j], b = t[i + j + half];
                float2 bw;
                if (tw == 0) bw = b;
                else if (tw == 8) bw = INV ? make_float2(-b.y, b.x) : make_float2(b.y, -b.x);
                else { const float wr = C32T[tw], wi = INV ? S32T[tw] : -S32T[tw]; bw = make_float2(b.x * wr - b.y * wi, b.x * wi + b.y * wr); }
                t[i + j] = make_float2(a.x + bw.x, a.y + bw.y);
                t[i + j + half] = make_float2(a.x - bw.x, a.y - bw.y);
            }
    }
#pragma unroll
    for (int i = 0; i < R; ++i) v[i] = t[i];
}
template <int R> __device__ __forceinline__ void twiddle_pow(float2 (&v)[R], float2 first, float2 base) {
    float2 w = first;
#pragma unroll
    for (int k = 0; k < R; ++k) { v[k] = cmulf(v[k], w); w = cmulf(w, base); }
}
__device__ __forceinline__ float2 cispi(float x) { float sn, cs; sincospif(x, &sn, &cs); return make_float2(cs, sn); }

__device__ __forceinline__ void fft_fwd_A_B1(float2 (&v)[32], float2* buf, int tid_in) {
    int tid = tid_in; asm volatile("" : "+v"(tid));
    const int a = tid >> 4, b = tid & 15;
    dftR<32, false>(v);
    twiddle_pow<32>(v, make_float2(1.f, 0.f), cispi(-2.f * (float)tid * (1.f / 8192.f)));
#pragma unroll
    for (int k1 = 0; k1 < 32; ++k1) buf[fphys(k1, a, b)] = v[k1];
    __syncthreads();
#pragma unroll 1
    for (int j = 0; j < 2; ++j) {
        const int g = tid + 256 * j, k1 = g >> 4, bb = g & 15;
        float2 w[16];
#pragma unroll
        for (int aa = 0; aa < 16; ++aa) w[aa] = buf[fphys(k1, aa, bb)];
        dftR<16, false>(w);
        twiddle_pow<16>(w, make_float2(1.f, 0.f), cispi(-2.f * (float)bb * (1.f / 256.f)));
#pragma unroll
        for (int ka = 0; ka < 16; ++ka) buf[fphys(k1, ka, bb)] = w[ka];
    }
    __syncthreads();
}
__device__ __forceinline__ void fft_inv_B1_A(float2 (&v)[32], float2* buf, int tid_in) {
    int tid = tid_in; asm volatile("" : "+v"(tid));
#pragma unroll 1
    for (int j = 0; j < 2; ++j) {
        const int g = tid + 256 * j, k1 = g >> 4, bb = g & 15;
        float2 w[16];
#pragma unroll
        for (int ka = 0; ka < 16; ++ka) w[ka] = buf[fphys(k1, ka, bb)];
        dftR<16, true>(w);
        twiddle_pow<16>(w, cispi(2.f * (float)(k1 * bb) * (1.f / 8192.f)), cispi(2.f * (float)k1 * (1.f / 512.f)));
#pragma unroll
        for (int aa = 0; aa < 16; ++aa) buf[fphys(k1, aa, bb)] = w[aa];
    }
    __syncthreads();
    const int a = tid >> 4, b = tid & 15;
#pragma unroll
    for (int k1 = 0; k1 < 32; ++k1) v[k1] = buf[fphys(k1, a, b)];
    dftR<32, true>(v);
}

__device__ __forceinline__ void hfft_unit(const P& p, int l, int u, char* lds) {
    const int tid = otid();
    float2* buf = (float2*)lds;
    float* F = (float*)(p.ws + WS_FILTL + l * SZ_FILTL) + (size_t)u * 8192;
    float2 v[32];
#pragma unroll
    for (int n1 = 0; n1 < 32; ++n1) {
        const int n = 256 * n1 + tid;
        float x;
        if (n1 < 16) x = F[n];
        else x = (n == 4096) ? 0.f : F[4096 + (8192 - n)];
        if (n == 0) x += p.in(I_HY_SKIP)[(size_t)l * 512 + u];
        v[n1] = make_float2(x, 0.f);
    }
    fft_fwd_A_B1(v, buf, tid);
    __half2* H = (__half2*)F;
#pragma unroll 1
    for (int j = 0; j < 2; ++j) {
        const int g = tid + 256 * j, k1 = g >> 4, ka = g & 15;
        float2 w[16];
#pragma unroll
        for (int bb = 0; bb < 16; ++bb) w[bb] = buf[fphys(k1, ka, bb)];
        dftR<16, false>(w);
        unsigned pk[16];
#pragma unroll
        for (int kb = 0; kb < 16; ++kb) { const __half2 h = __floats2half2_rn(w[kb].x, w[kb].y); pk[kb] = *reinterpret_cast<const unsigned*>(&h); }
        uint4* dst = reinterpret_cast<uint4*>(H + (size_t)g * 16);
        dst[0] = make_uint4(pk[0], pk[1], pk[2], pk[3]); dst[1] = make_uint4(pk[4], pk[5], pk[6], pk[7]);
        dst[2] = make_uint4(pk[8], pk[9], pk[10], pk[11]); dst[3] = make_uint4(pk[12], pk[13], pk[14], pk[15]);
    }
    __syncthreads();
}

__device__ __forceinline__ void hyena_prep_unit(const P& p, int l, int u, char* lds) {
    const int tid = otid();
    bf16_t* tile = (bf16_t*)lds;
    const int b = u >> 6, t0 = (u & 63) * 64;
    const bf16_t* z = (const bf16_t*)(p.ws + WS_Z) + (size_t)(NTC + b * 4096) * ZS + COL_HY;
    bf16_t* hyT = (bf16_t*)(p.ws + WS_HYT);
    const float* cw = p.in(I_HY_CONV) + (size_t)l * 3 * 768; const float* cb = p.in(I_HY_CONVB) + (size_t)l * 768;
    const int tl = tid >> 5, cg = tid & 31;
#pragma unroll 1
    for (int part = 0; part < 3; ++part) {
        const int ch0 = part * 256 + cg * 8;
        float w0[8], w1[8], w2[8], bs[8];
#pragma unroll
        for (int i = 0; i < 8; ++i) { w0[i] = cw[ch0 + i]; w1[i] = cw[768 + ch0 + i]; w2[i] = cw[1536 + ch0 + i]; bs[i] = cb[ch0 + i]; }
#pragma unroll 2
        for (int it = 0; it < 8; ++it) {
            const int tk = it * 8 + tl, t = t0 + tk;
            const bf16_t* zc = z + (size_t)t * ZS + ch0;
            const uint4 zero4 = make_uint4(0u, 0u, 0u, 0u);
            const uint4 vm = (t > 0) ? *reinterpret_cast<const uint4*>(zc - ZS) : zero4;
            const uint4 v0 = *reinterpret_cast<const uint4*>(zc);
            const uint4 vp = (t + 1 < 4096) ? *reinterpret_cast<const uint4*>(zc + ZS) : zero4;
            float xm[8], x0[8], xp[8];
            unpack8(vm, xm); unpack8(v0, x0); unpack8(vp, xp);
#pragma unroll
            for (int i = 0; i < 8; ++i) tile[(cg * 8 + i) * 72 + tk] = f2bf(w0[i] * xm[i] + w1[i] * x0[i] + w2[i] * xp[i] + bs[i]);
        }
        __syncthreads();
#pragma unroll
        for (int k = 0; k < 8; ++k) {
            const int chl = (tid >> 3) + 32 * k, seg = tid & 7;
            const uint4 val = *reinterpret_cast<const uint4*>(tile + chl * 72 + seg * 8);
            *reinterpret_cast<uint4*>(hyT + ((size_t)(b * 3 + part) * 256 + chl) * 4096 + t0 + seg * 8) = val;
        }
        __syncthreads();
    }
}

template <int O>
__device__ __forceinline__ void hyena_conv_pass(const P& p, int l, int c, int bp, int tid, float2 (&v)[32], float2* buf) {
    const bf16_t* hyT = (const bf16_t*)(p.ws + WS_HYT);
#pragma unroll
    for (int j = 16; j < 32; ++j) v[j] = make_float2(0.f, 0.f);
    fft_fwd_A_B1(v, buf, tid);
    const __half2* H = (const __half2*)((const float*)(p.ws + WS_FILTL + l * SZ_FILTL) + (size_t)(O * 256 + c) * 8192);
    int tm = tid; asm volatile("" : "+v"(tm));
#pragma unroll 1
    for (int j = 0; j < 2; ++j) {
        const int g = tm + 256 * j, k1 = g >> 4, ka = g & 15;
        float2 w[16];
#pragma unroll
        for (int bb = 0; bb < 16; ++bb) w[bb] = buf[fphys(k1, ka, bb)];
        dftR<16, false>(w);
        const uint4* hp = reinterpret_cast<const uint4*>(H + (size_t)g * 16);
        unsigned hk[16];
#pragma unroll
        for (int q = 0; q < 4; ++q) { const uint4 t4 = hp[q]; hk[q * 4] = t4.x; hk[q * 4 + 1] = t4.y; hk[q * 4 + 2] = t4.z; hk[q * 4 + 3] = t4.w; }
#pragma unroll
        for (int kb = 0; kb < 16; ++kb) { const float2 hf = __half22float2(*reinterpret_cast<const __half2*>(&hk[kb])); w[kb] = cmulf(w[kb], hf); }
        dftR<16, true>(w);
        twiddle_pow<16>(w, make_float2(1.f, 0.f), cispi(2.f * (float)ka * (1.f / 256.f)));
#pragma unroll
        for (int bb = 0; bb < 16; ++bb) buf[fphys(k1, ka, bb)] = w[bb];
    }
    __syncthreads();
    fft_inv_B1_A(v, buf, tid);
    asm volatile("" ::: "memory");
    int tq = tid; asm volatile("" : "+v"(tq));
    const bf16_t* g0 = hyT + ((size_t)((bp * 2 + 0) * 3 + O) * 256 + c) * 4096 + tq;
    const bf16_t* g1 = hyT + ((size_t)((bp * 2 + 1) * 3 + O) * 256 + c) * 4096 + tq;
    const float sc = 1.f / 8192.f;
#pragma unroll
    for (int j = 0; j < 16; ++j) {
        const float ga = bf2f(g0[256 * j]) * sc, gb = bf2f(g1[256 * j]) * sc;
        v[j] = make_float2(ga * v[j].x, gb * v[j].y);
    }
    __syncthreads();
}

__device__ __forceinline__ void hyena_fft_unit(const P& p, int l, int u, char* lds) {
    const int tid = otid();
    const int c = u >> 2, bp = u & 3;
    float2* buf = (float2*)lds;
    const bf16_t* hyT = (const bf16_t*)(p.ws + WS_HYT);
    bf16_t* cat = (bf16_t*)(p.ws + WS_CAT);
    float2 v[32];
    {
        const bf16_t* v0p = hyT + ((size_t)((bp * 2 + 0) * 3 + 2) * 256 + c) * 4096 + tid;
        const bf16_t* v1p = hyT + ((size_t)((bp * 2 + 1) * 3 + 2) * 256 + c) * 4096 + tid;
#pragma unroll
        for (int j = 0; j < 16; ++j) v[j] = make_float2(bf2f(v0p[256 * j]), bf2f(v1p[256 * j]));
    }
    hyena_conv_pass<0>(p, l, c, bp, tid, v, buf);
    hyena_conv_pass<1>(p, l, c, bp, tid, v, buf);
    int tq = tid; asm volatile("" : "+v"(tq));
#pragma unroll
    for (int j = 0; j < 16; ++j) {
        const int t = tq + 256 * j;
        cat[(size_t)(NTC + (bp * 2 + 0) * 4096 + t) * DM + 512 + c] = f2bf(v[j].x);
        cat[(size_t)(NTC + (bp * 2 + 1) * 4096 + t) * DM + 512 + c] = f2bf(v[j].y);
    }
}

__device__ __forceinline__ void rwkv_post_unit(const P& p, int l, int u, char* lds) {
    const int tid = otid();
    bf16_t* sgb = (bf16_t*)lds;
    float* gt = (float*)(lds + 4608);
    const bf16_t* z = (const bf16_t*)(p.ws + WS_Z);
    const bf16_t* rwp = (const bf16_t*)(p.ws + WS_R1 + R1_RWP);
    const bf16_t* ys = (const bf16_t*)(p.ws + WS_HBY);
    bf16_t* cat = (bf16_t*)(p.ws + WS_CAT);
    const int row0 = u * 32;
    {
        const int tok = tid >> 3, j0 = (tid & 7) * 8;
        float gl[8];
        unpack8(*reinterpret_cast<const uint4*>(z + (size_t)(row0 + tok) * ZS + 896 + j0), gl);
#pragma unroll
        for (int i = 0; i < 8; ++i) gl[i] = sigm(gl[i]);
        *reinterpret_cast<uint4*>(sgb + tok * 72 + j0) = pack8(gl);
    }
    __syncthreads();
    {
        const int w = tid >> 6, lane = tid & 63, fr = lane & 15, fq = lane >> 4;
        const bf16_t* g2t = (const bf16_t*)(p.ws + WS_G2T) + (size_t)l * 256 * 64;
        f32x4 acc[2][4];
#pragma unroll
        for (int mf = 0; mf < 2; ++mf)
#pragma unroll
            for (int nf = 0; nf < 4; ++nf) acc[mf][nf] = f32x4{0.f, 0.f, 0.f, 0.f};
#pragma unroll
        for (int ks = 0; ks < 2; ++ks) {
            bf16x8 af[2], bfr[4];
#pragma unroll
            for (int mf = 0; mf < 2; ++mf) af[mf] = *reinterpret_cast<const bf16x8*>(sgb + (mf * 16 + fr) * 72 + ks * 32 + fq * 8);
#pragma unroll
            for (int nf = 0; nf < 4; ++nf) bfr[nf] = *reinterpret_cast<const bf16x8*>(g2t + (size_t)(w * 64 + nf * 16 + fr) * 64 + ks * 32 + fq * 8);
#pragma unroll
            for (int mf = 0; mf < 2; ++mf)
#pragma unroll
                for (int nf = 0; nf < 4; ++nf) acc[mf][nf] = __builtin_amdgcn_mfma_f32_16x16x32_bf16(af[mf], bfr[nf], acc[mf][nf], 0, 0, 0);
        }
#pragma unroll
        for (int mf = 0; mf < 2; ++mf)
#pragma unroll
            for (int nf = 0; nf < 4; ++nf)
#pragma unroll
                for (int j = 0; j < 4; ++j) gt[(mf * 16 + fq * 4 + j) * 264 + w * 64 + nf * 16 + fr] = acc[mf][nf][j];
    }
    __syncthreads();
    {
        const int tl = tid >> 5, cg = tid & 31, c0 = cg * 8;
        float ka[8], rk[8], gng[8], gnb[8];
#pragma unroll
        for (int i = 0; i < 8; ++i) {
            ka[i] = p.in(I_RW_KA)[l * 256 + c0 + i]; rk[i] = p.in(I_RW_RK)[l * 256 + c0 + i];
            gng[i] = p.in(I_RW_GNG)[l * 256 + c0 + i]; gnb[i] = p.in(I_RW_GNB)[l * 256 + c0 + i];
        }
#pragma unroll 2
        for (int it = 0; it < 4; ++it) {
            const int tok = it * 8 + tl, row = row0 + tok;
            float ya[8], yb[8], r[8], k[8], v[8], a0[8], a1[8], o[8];
            unpack8(*reinterpret_cast<const uint4*>(ys + (size_t)row * 256 + c0), ya);
            unpack8(*reinterpret_cast<const uint4*>(ys + (size_t)NT * 256 + (size_t)row * 256 + c0), yb);
            const bf16_t* zr = z + (size_t)row * ZS + c0;
            unpack8(*reinterpret_cast<const uint4*>(zr), r);
            unpack8(*reinterpret_cast<const uint4*>(zr + 256), k);
            unpack8(*reinterpret_cast<const uint4*>(zr + 512), v);
            unpack8(*reinterpret_cast<const uint4*>(rwp + ((size_t)row * 4 + 2) * 256 + c0), a0);
            unpack8(*reinterpret_cast<const uint4*>(rwp + ((size_t)row * 4 + 3) * 256 + c0), a1);
            float sy = 0.f, sd = 0.f;
#pragma unroll
            for (int i = 0; i < 8; ++i) {
                ya[i] += yb[i]; sy += ya[i];
                const float kd = k[i] * (1.f + (a0[i] - 1.f) * ka[i]) + k[i] * (1.f + (a1[i] - 1.f) * ka[i]);
                sd += r[i] * kd * rk[i];
            }
            const float mu = sum8lanes(sy) * (1.f / 64.f);
            const float dot = sum8lanes(sd);
            float sq = 0.f;
#pragma unroll
            for (int i = 0; i < 8; ++i) { ya[i] -= mu; sq += ya[i] * ya[i]; }
            const float rs = rsqrtf(sum8lanes(sq) * (1.f / 64.f) + 64e-5f);
            const float4 g0 = *reinterpret_cast<const float4*>(gt + tok * 264 + c0), g1 = *reinterpret_cast<const float4*>(gt + tok * 264 + c0 + 4);
            const float gg[8] = {g0.x, g0.y, g0.z, g0.w, g1.x, g1.y, g1.z, g1.w};
#pragma unroll
            for (int i = 0; i < 8; ++i) o[i] = (ya[i] * rs * gng[i] + gnb[i] + dot * v[i]) * gg[i];
            *reinterpret_cast<uint4*>(cat + (size_t)row * DM + c0) = pack8(o);
        }
    }
    __syncthreads();
}

__device__ __forceinline__ void gdn_post_unit(const P& p, int l, int u) {
    const int tid = otid();
    const bf16_t* z = (const bf16_t*)(p.ws + WS_Z);
    const bf16_t* ys = (const bf16_t*)(p.ws + WS_HBY) + (size_t)2 * NT * 256;
    bf16_t* cat = (bf16_t*)(p.ws + WS_CAT);
    const int tl = tid >> 5, cg = tid & 31, c0 = cg * 8;
    float ng[8];
#pragma unroll
    for (int i = 0; i < 8; ++i) ng[i] = p.in(I_GD_NORM)[l * 64 + ((c0 + i) & 63)];
    const int row0 = u * 32;
#pragma unroll 2
    for (int it = 0; it < 4; ++it) {
        const int row = row0 + it * 8 + tl;
        const uint4 a4 = *reinterpret_cast<const uint4*>(ys + (size_t)row * 256 + c0);
        const uint4 b4 = *reinterpret_cast<const uint4*>(ys + (size_t)NT * 256 + (size_t)row * 256 + c0);
        const uint4 z4 = *reinterpret_cast<const uint4*>(z + (size_t)row * ZS + COL_GD + 768 + c0);
        float a[8], b[8], zg[8], o[8];
        unpack8(a4, a); unpack8(b4, b); unpack8(z4, zg);
        float ss = 0.f;
#pragma unroll
        for (int i = 0; i < 8; ++i) { o[i] = a[i] + b[i]; ss += o[i] * o[i]; }
        ss = sum8lanes(ss);
        const float sc = rsqrtf(ss * (1.f / 64.f) + 1e-6f);
#pragma unroll
        for (int i = 0; i < 8; ++i) o[i] = o[i] * sc * ng[i] * siluf(zg[i]);
        *reinterpret_cast<uint4*>(cat + (size_t)row * DM + 256 + c0) = pack8(o);
    }
}

__device__ __forceinline__ void load_tile_bases(unsigned* ctl, int l, int* tb) {
    const int tid = otid();
    __syncthreads();
    if (tid < 64) { const int c = (int)xb_ld(&ctl[CW_CNT(l) + tid * 32]); tb[130 + tid] = c; tb[66 + tid] = (c + 127) >> 7; }
    __syncthreads();
    if (tid == 0) { int a = 0; for (int e = 0; e < 64; ++e) { tb[e] = a; a += tb[66 + e]; } tb[64] = a; }
    __syncthreads();
}

#define NPHASE 28
template <typename F>
__device__ __forceinline__ void strided(int n, F f) { for (int u = blockIdx.x; u < n; u += gridDim.x) f(u); }

__global__ void __launch_bounds__(NTHREADS, 2) fwd_kernel(KP kp) {
    extern __shared__ __attribute__((aligned(16))) char smem[];
    char* lds = smem + LDS_USER;
    {
    const int tid = otid();
    if (tid == 0) *reinterpret_cast<uint4*>(smem) = make_uint4(0u, 0u, 0u, 0u);
    if (tid < 52) { const unsigned long long v = (unsigned long long)kp.in[tid]; ((unsigned*)(smem + 512))[2 * tid] = (unsigned)v; ((unsigned*)(smem + 512))[2 * tid + 1] = (unsigned)(v >> 32); }
    }
    __syncthreads();
    P p; p.tab = (const __attribute__((address_space(3))) unsigned*)(smem + 512); p.out = kp.out; p.ws = kp.ws;
    unsigned* ctl = (unsigned*)(p.ws + WS_CTL);
    XcdBarrier bar = xcd_barrier_post(ctl, (volatile LAS unsigned*)smem);
    const int lo = kp.ph_lo, hi = kp.ph_hi;
#define PHASE_BEGIN(ph) if ((ph) >= lo && (ph) < hi) { if ((ph) > lo) { xcd_barrier(bar); }
#define PHASE_END }
#define LANE_IDS const int tid = otid(); const int wid = tid >> 6, lane = tid & 63, wr = wid >> 1, wc = wid & 1, fr = lane & 15, fq = lane >> 4; (void)wid; (void)lane; (void)wr; (void)wc; (void)fr; (void)fq;

    PHASE_BEGIN(0)
        strided(192 + 64 + 32 + 24 + 2 * 2112, [&](int u) {
            if (u >= 312) {
                const int v0 = u - 312, ll = v0 / 2112, v = v0 % 2112;
                if (v < 1088) filt_unit(p, ll, v, lds);
                else if (v < 1856) { const int t = v - 1088; xpose_tile(p.in(I_WIN) + (size_t)ll * 1024 * 3024, 3024, (bf16_t*)(p.ws + WS_WINT + ll * SZ_WINT), 1024, 0, t / 48, t % 48, lds); }
                else { const int t = v - 1856; xpose_tile(p.in(I_WOUT) + (size_t)ll * 1024 * 1024, 1024, (bf16_t*)(p.ws + WS_WOUTT + ll * SZ_WOUTT), 1024, 0, t >> 4, t & 15, lds); }
            }
            else if (u < 192) ph0_mod_unit(p, u, lds);
            else if (u < 256) ph0_s5tab_unit(p, u - 192);
            else if (u >= 288) { const int v = u - 288, which = v >> 3, ll = (v >> 2) & 1, t = v & 3;
                   const float* src = (which == 0 ? p.in(I_RW_G2) : which == 1 ? p.in(I_RW_W2) : p.in(I_RW_A2)) + (size_t)ll * 64 * 256;
                   bf16_t* dst = (bf16_t*)(p.ws + (which == 0 ? WS_G2T : which == 1 ? WS_LW2T : WS_LA2T)) + (size_t)ll * 256 * 64;
                   xpose_tile(src, 256, dst, 64, 0, 0, t, lds); }
            else { const int v = u - 256, ll = v >> 4, t = v & 15;
                   xpose_tile(p.in(I_S5_GLUW) + (size_t)ll * 65536, 256, (bf16_t*)(p.ws + WS_GLUT) + (size_t)ll * 65536, 256, 0, t >> 2, t & 3, lds); }
        });
    PHASE_END

#pragma unroll 1
    for (int l = 0; l < 2; ++l) {
        const int pb = 1 + 13 * l;
        PHASE_BEGIN(pb + 0)
            strided(4352, [&](int u) { if (l == 0) rows_unit<M_INIT>(p, l, u, lds); else rows_unit<M_LN2NEXT>(p, l, u, lds); });
        PHASE_END
        PHASE_BEGIN(pb + 1)
            strided(272 * 24, [&](int u) {
                LANE_IDS
                const int q_ = u >> 3, g_ = q_ / 12;
                const int mt = (g_ % 34) * 8 + (u & 7), nt = (g_ / 34) * 12 + (q_ % 12);
                f32x4 acc[4][4];
                gemm_tile((const bf16_t*)(p.ws + WS_HBY), DM, arows_lin(mt * 128, tid),
                          (const bf16_t*)(p.ws + WS_WINT + l * SZ_WINT), DM, nt * 128, DM, lds, acc);
                bf16_t* z = (bf16_t*)(p.ws + WS_Z);
#pragma unroll
                for (int m = 0; m < 4; ++m)
#pragma unroll
                    for (int n = 0; n < 4; ++n) {
                        const int col = nt * 128 + wc * 64 + n * 16 + fr;
                        if (col < ZS) {
#pragma unroll
                            for (int j = 0; j < 4; ++j) z[(size_t)(mt * 128 + wr * 64 + m * 16 + fq * 4 + j) * ZS + col] = f2bf(acc[m][n][j]);
                        }
                    }
            });
        PHASE_END
        PHASE_BEGIN(pb + 2)
            strided(512 + 512 + 1088 + 1088 + 4352, [&](int u) {
                if (u < 512) { if (kp.rep == 0) hfft_unit(p, l, u, lds); }
                else if (u < 1024) hyena_prep_unit(p, l, u - 512, lds);
                else if (u < 2112) rwkv_prep_unit(p, l, u - 1024, lds);
                else if (u < 3200) gdn_prep_unit(p, l, u - 2112);
                else s5_pre_unit(p, l, u - 3200, lds);
            });
        PHASE_END
        PHASE_BEGIN(pb + 3)
            {
                int* qslot = (int*)(smem + 64);
                const int NO = 1024 + 544 + 1024;
                if (otid() == 0) {
                    const unsigned hw = (unsigned)__builtin_amdgcn_s_getreg((7 << 11) | (8 << 6) | 4);
                    const unsigned cuix = ((xb_xcc_id() & 15u) << 8) | (hw & 255u);
                    qslot[1] = (atomicAdd(&ctl[CW_CUCNT(l) + cuix], 1u) % 2u == 0u) ? 0 : 1;
                }
                __syncthreads();
                for (;;) {
                    if (otid() == 0) {
                        int stage = qslot[1], t = -1;
                        while (t < 0 && stage < 3) {
                            if (stage == 1) { const int q = (int)atomicAdd(&ctl[CW_QUEUE(l) + 16 + kp.rep], 1u); if (q < NO) t = 256 + (q < 544 ? 1024 + q : (q < 1568 ? q - 544 : q)); else stage = 2; }
                            else { const int q = (int)atomicAdd(&ctl[CW_QUEUE(l) + kp.rep], 1u); if (q < 256) t = q; else stage = (stage == 0) ? 1 : 3; }
                        }
                        qslot[1] = stage; qslot[0] = t;
                    }
                    __syncthreads();
                    const int u = qslot[0];
                    __syncthreads();
                    if (u < 0) break;
                    if (u < 128) { if (kp.rep != 2) scan_unit_gd2(p, l, u, lds); }
                    else if (u < 256) { if (kp.rep != 2) scan_unit(p, l, u - 128, lds); }
                    else if (kp.rep == 1) {}
                    else if (u < 1280) hyena_fft_unit(p, l, u - 256, lds);
                    else if (u < 1824) s5_main_unit(p, l, u - 1280, lds);
                    else hyena_unit<256>(p, l, u - 1824, lds);
                    __syncthreads();
                }
            }
        PHASE_END
        PHASE_BEGIN(pb + 4)
            strided(1088 + 1088 + 544, [&](int u) {
                if (u < 1088) rwkv_post_unit(p, l, u, lds);
                else if (u < 2176) gdn_post_unit(p, l, u - 1088);
                else {
                    LANE_IDS
                    const int v = u - 2176, mt = v >> 1, nt = v & 1;
                    f32x4 acc[4][4];
                    const bf16_t* A = (const bf16_t*)(p.ws + WS_S5G);
                    gemm_tile(A, 256, arows_lin(mt * 128, tid),
                              (const bf16_t*)(p.ws + WS_GLUT) + (size_t)l * 65536, 256, nt * 128, 256, lds, acc);
                    bf16_t* cat = (bf16_t*)(p.ws + WS_CAT);
#pragma unroll
                    for (int m = 0; m < 4; ++m)
#pragma unroll
                        for (int n = 0; n < 4; ++n) {
                            const int col = nt * 128 + wc * 64 + n * 16 + fr;
                            const float gb = p.in(I_S5_GLUB)[l * 256 + col];
#pragma unroll
                            for (int j = 0; j < 4; ++j) {
                                const int row = mt * 128 + wr * 64 + m * 16 + fq * 4 + j;
                                const float yg = bf2f(A[(size_t)row * 256 + col]);
                                cat[(size_t)row * DM + 768 + col] = f2bf(yg * sigm(acc[m][n][j] + gb));
                            }
                        }
                }
            });
        PHASE_END
        PHASE_BEGIN(pb + 5)
            strided(136 * 40, [&](int u0) {
                const int grp = u0 / 40, rr_ = u0 % 40;
                const int u = (rr_ < 16) ? grp * 16 + rr_ : 2176 + grp * 24 + (rr_ - 16);
                if (u >= 2176 + 65 * 48) return;
                if (u < 2176) {
                    LANE_IDS
                    const int mt = ((u >> 3) >> 3) * 8 + (u & 7), nt = (u >> 3) & 7;
                    f32x4 acc[4][4];
                    gemm_tile((const bf16_t*)(p.ws + WS_CAT), DM, arows_lin(mt * 128, tid),
                              (const bf16_t*)(p.ws + WS_WOUTT + l * SZ_WOUTT), DM, nt * 128, DM, lds, acc);
#pragma unroll
                    for (int m = 0; m < 4; ++m)
#pragma unroll
                        for (int j = 0; j < 4; ++j) {
                            const int row = mt * 128 + wr * 64 + m * 16 + fq * 4 + j;
                            float* xr = xrow(p, row);
                            const float* xs = (l == 0 && kp.rep == 0) ? (row < NTC ? p.in(I_CTX) + (size_t)row * DM : p.in(I_X) + (size_t)(row - NTC) * DM) : xr;
                            const float* ga = modp(p, l, row_mod(row), 2);
#pragma unroll
                            for (int n = 0; n < 4; ++n) {
                                const int col = nt * 128 + wc * 64 + n * 16 + fr;
                                { const float ca = kp.rep ? 1.f : ALPHA, cb2 = kp.rep ? 0.f : 1.f; xr[col] = ca * xs[col] + cb2 * ga[col] * acc[m][n][j]; }
                            }
                        }
                } else {
                    const int v = u - 2176, e = v / 48, t = v % 48, which = t >> 4, tt = t & 15;
                    bf16_t* W13 = (bf16_t*)(p.ws + WS_R1 + R1_W13T) + (size_t)e * 512 * 1024;
                    bf16_t* W2 = (bf16_t*)(p.ws + WS_R1 + R1_W2T) + (size_t)e * 1024 * 256;
                    if (which == 0) {
                        const float* src = (e < 64) ? p.in(I_EX_W1) + ((size_t)l * 64 + e) * 262144 : p.in(I_SH_W1) + (size_t)l * 262144;
                        xpose_strip4(src, 256, W13, 1024, 1, tt, 0, lds);
                    } else if (which == 1) {
                        const float* src = (e < 64) ? p.in(I_EX_W3) + ((size_t)l * 64 + e) * 262144 : p.in(I_SH_W3) + (size_t)l * 262144;
                        xpose_strip4(src, 256, W13, 1024, 2, tt, 0, lds);
                    } else {
                        const float* src = (e < 64) ? p.in(I_EX_W2) + ((size_t)l * 64 + e) * 262144 : p.in(I_SH_W2) + (size_t)l * 262144;
                        xpose_strip4(src, 1024, W2, 256, 0, tt >> 2, (tt & 3) * 4, lds);
                    }
                }
            });
        PHASE_END
        PHASE_BEGIN(pb + 6)
            strided(2176, [&](int u) { rows_unit<M_LN1>(p, l, u, lds, kp.rep); __syncthreads(); });
        PHASE_END
        PHASE_BEGIN(pb + 8)
            {
                int* tbs = (int*)(smem + 1024);
                load_tile_bases(ctl, l, tbs);
                const int ntr = tbs[64];
                const int* rtok = (const int*)(p.ws + WS_RTOK);
                const int ntl1 = ntr + 272;
                strided(((ntl1 + 7) >> 3) * 32, [&](int u) {
                    const int tile = ((u >> 3) >> 2) * 8 + (u & 7), jn = (u >> 3) & 3;
                    if (tile >= ntl1) return;
                    LANE_IDS
                    int e, obase; ARows ar;
                    if (tile < ntr) {
                        e = 0;
#pragma unroll 1
                        for (int s2 = 32; s2 >= 1; s2 >>= 1) if (tbs[e + s2] <= tile) e += s2;
                        obase = tile * 128;
                        const int pos0 = (tile - tbs[e]) * 128, ce = tbs[130 + e];
#pragma unroll
                        for (int i = 0; i < 4; ++i) { const int ps = pos0 + (tid >> 3) + 32 * i; ar.r[i] = (ps < ce) ? rtok[(size_t)e * NT + ps] : 0; }
                    } else {
                        const int stt = tile - ntr; e = 64; obase = (SH_TILE_BASE + stt) * 128;
                        ar = arows_lin(stt * 128, tid);
                    }
                    f32x4 acc[4][4];
                    gemm_tile((const bf16_t*)(p.ws + WS_HBY), DM, ar,
                              (const bf16_t*)(p.ws + WS_R1 + R1_W13T) + (size_t)e * 512 * 1024, DM, jn * 128, DM, lds, acc);
                    bf16_t* act = (bf16_t*)(p.ws + WS_ACT);
#pragma unroll
                    for (int m = 0; m < 4; ++m)
#pragma unroll
                        for (int pp = 0; pp < 2; ++pp)
#pragma unroll
                            for (int j = 0; j < 4; ++j) {
                                const float g = acc[m][2 * pp][j], uu = acc[m][2 * pp + 1][j];
                                const int orow = obase + wr * 64 + m * 16 + fq * 4 + j;
                                const int col = jn * 64 + wc * 32 + pp * 16 + fr;
                                act[(size_t)orow * 256 + col] = f2bf(siluf(g) * uu);
                            }
                });
            }
        PHASE_END
#pragma unroll 1
        for (int sl = 0; sl < 2; ++sl) {
            PHASE_BEGIN(pb + 9 + 2 * sl)
            {
                int* tbs = (int*)(smem + 1024);
                load_tile_bases(ctl, l, tbs);
                const int ntr = tbs[64];
                const int ntl2 = ntr + 272;
                strided(((ntl2 + 7) >> 3) * 32, [&](int u) {
                    const int tile = ((u >> 3) >> 2) * 8 + (u & 7), nt4 = (u >> 3) & 3;
                    if (tile >= ntl2) return;
                    LANE_IDS
                    int e, obase;
                    if (tile < ntr) {
                        e = 0;
#pragma unroll 1
                        for (int s2 = 32; s2 >= 1; s2 >>= 1) if (tbs[e + s2] <= tile) e += s2;
                        obase = tile * 128;
                    }
                    else { e = 64; obase = (SH_TILE_BASE + tile - ntr) * 128; }
                    f32x4 acc[4][4];
                    gemm_tile((const bf16_t*)(p.ws + WS_ACT), 256, arows_lin(obase, tid),
                              (const bf16_t*)(p.ws + WS_R1 + R1_W2T) + (size_t)e * 1024 * 256, 256, sl * 512 + nt4 * 128, 256, lds, acc);
                    unsigned char* ot = (unsigned char*)lds;
#pragma unroll
                    for (int m = 0; m < 4; ++m)
#pragma unroll
                        for (int n = 0; n < 4; ++n)
#pragma unroll
                            for (int j = 0; j < 4; ++j) {
                                const float v16 = acc[m][n][j] * 16.f;
                                ot[(wr * 64 + m * 16 + fq * 4 + j) * 144 + wc * 64 + n * 16 + fr] = (unsigned char)(__builtin_amdgcn_cvt_pk_fp8_f32(v16, v16, 0, false) & 0xFF);
                            }
                    __syncthreads();
                    unsigned char* y2 = (unsigned char*)(p.ws + WS_Y2);
#pragma unroll
                    for (int i = 0; i < 4; ++i) {
                        const int id = tid + 256 * i, r = id >> 3, c16 = (id & 7) * 16;
                        *reinterpret_cast<uint4*>(y2 + (size_t)(obase + r) * 512 + nt4 * 128 + c16) = *reinterpret_cast<const uint4*>(ot + r * 144 + c16);
                    }
                    __syncthreads();
                });
            }
            PHASE_END
            if (!(l == 1 && sl == 1)) {
            PHASE_BEGIN(pb + 10 + 2 * sl)
            {
                int* tb = (int*)lds;
                const int tid = otid();
                load_tile_bases(ctl, l, tb);
                const int* aep = (const int*)(p.ws + WS_AEP); const float* aw = (const float*)(p.ws + WS_AW);
                const unsigned char* y2 = (const unsigned char*)(p.ws + WS_Y2);
                const int tl = tid >> 5, cg = tid & 31;
                for (int grp = blockIdx.x; grp < NT / 8; grp += gridDim.x) {
                    const int tok = grp * 8 + tl;
                    float a16[16];
                    {
                        const uint4 sv = *reinterpret_cast<const uint4*>(y2 + ((size_t)(SH_TILE_BASE * 128 + tok)) * 512 + cg * 16);
                        const unsigned wv[4] = {sv.x, sv.y, sv.z, sv.w};
#pragma unroll
                        for (int q = 0; q < 4; ++q) {
                            a16[q * 4 + 0] = __builtin_amdgcn_cvt_f32_fp8((int)wv[q], 0); a16[q * 4 + 1] = __builtin_amdgcn_cvt_f32_fp8((int)wv[q], 1);
                            a16[q * 4 + 2] = __builtin_amdgcn_cvt_f32_fp8((int)wv[q], 2); a16[q * 4 + 3] = __builtin_amdgcn_cvt_f32_fp8((int)wv[q], 3);
                        }
                    }
#pragma unroll
                    for (int k = 0; k < 8; ++k) {
                        const unsigned v = (unsigned)aep[(size_t)tok * 8 + k];
                        const float wk = aw[(size_t)tok * 8 + k];
                        const int dest = tb[v >> 24] * 128 + (int)(v & 0xFFFFFFu);
                        const uint4 yv = *reinterpret_cast<const uint4*>(y2 + (size_t)dest * 512 + cg * 16);
                        const unsigned wv[4] = {yv.x, yv.y, yv.z, yv.w};
#pragma unroll
                        for (int q = 0; q < 4; ++q) {
                            a16[q * 4 + 0] += wk * __builtin_amdgcn_cvt_f32_fp8((int)wv[q], 0); a16[q * 4 + 1] += wk * __builtin_amdgcn_cvt_f32_fp8((int)wv[q], 1);
                            a16[q * 4 + 2] += wk * __builtin_amdgcn_cvt_f32_fp8((int)wv[q], 2); a16[q * 4 + 3] += wk * __builtin_amdgcn_cvt_f32_fp8((int)wv[q], 3);
                        }
                    }
                    float* xr = xrow(p, tok) + sl * 512 + cg * 16;
                    const float* ga = modp(p, l, row_mod(tok), 5) + sl * 512 + cg * 16;
                    const float rs = kp.rep ? 0.f : (1.f / 16.f);
#pragma unroll
                    for (int q = 0; q < 4; ++q) {
                        float4 x4 = *reinterpret_cast<const float4*>(xr + q * 4);
                        const float4 g4 = *reinterpret_cast<const float4*>(ga + q * 4);
                        x4.x += rs * g4.x * a16[q * 4 + 0]; x4.y += rs * g4.y * a16[q * 4 + 1]; x4.z += rs * g4.z * a16[q * 4 + 2]; x4.w += rs * g4.w * a16[q * 4 + 3];
                        *reinterpret_cast<float4*>(xr + q * 4) = x4;
                    }
                }
                __syncthreads();
            }
            PHASE_END
            }
        }
    }
#if defined(PROBE_PH)
    if (lo >= 100) {
        float a0 = (float)otid(), a1 = a0 + 1.f, a2 = a0 + 2.f, a3 = a0 + 3.f, a4 = a0 + 4.f, a5 = a0 + 5.f, a6 = a0 + 6.f, a7 = a0 + 7.f;
        const float m = 0.999f, c = 0.5f;
        for (int it = 0; it < 10000; ++it) {
            if (lo == 100) {
#pragma unroll
                for (int q = 0; q < 64; ++q) asm volatile("v_fma_f32 %0, %0, %1, %2" : "+v"(a0) : "v"(m), "v"(c));
            } else {
#pragma unroll
                for (int q = 0; q < 8; ++q) {
                    asm volatile("v_fma_f32 %0, %0, %1, %2" : "+v"(a0) : "v"(m), "v"(c)); asm volatile("v_fma_f32 %0, %0, %1, %2" : "+v"(a1) : "v"(m), "v"(c));
                    asm volatile("v_fma_f32 %0, %0, %1, %2" : "+v"(a2) : "v"(m), "v"(c)); asm volatile("v_fma_f32 %0, %0, %1, %2" : "+v"(a3) : "v"(m), "v"(c));
                    asm volatile("v_fma_f32 %0, %0, %1, %2" : "+v"(a4) : "v"(m), "v"(c)); asm volatile("v_fma_f32 %0, %0, %1, %2" : "+v"(a5) : "v"(m), "v"(c));
                    asm volatile("v_fma_f32 %0, %0, %1, %2" : "+v"(a6) : "v"(m), "v"(c)); asm volatile("v_fma_f32 %0, %0, %1, %2" : "+v"(a7) : "v"(m), "v"(c));
                }
            }
        }
        if (a0 + a1 + a2 + a3 + a4 + a5 + a6 + a7 == 12345.678f) ctl[60] = 1u;
    }
#endif
    PHASE_BEGIN(27)
        load_tile_bases(ctl, 1, (int*)(smem + 1024));
        strided(4352, [&](int u) { rows_unit<M_FINAL>(p, 1, u, lds); });
    PHASE_END
}

#ifndef N_LAUNCH_MODE
#define N_LAUNCH_MODE 1
#endif
extern "C" void kernel_launch(void* const* d_in, const int* in_sizes, int n_in, void* d_out, int out_size, void* d_ws, size_t ws_size, hipStream_t stream) {
    static int grid = 0;
    if (grid == 0) {
        if (n_in != 52 || out_size != NTL * DM || ws_size < WS_END) { fprintf(stderr, "kernel_launch: unexpected shapes (n_in %d out %d ws %zu need %zu)\n", n_in, out_size, ws_size, (size_t)WS_END); grid = -1; return; }
        int dev = 0, cus = 0, per_cu = 0;
        hipGetDevice(&dev);
        hipDeviceGetAttribute(&cus, hipDeviceAttributeMultiprocessorCount, dev);
        hipFuncSetAttribute((const void*)fwd_kernel, hipFuncAttributeMaxDynamicSharedMemorySize, LDS_BYTES);
        hipOccupancyMaxActiveBlocksPerMultiprocessor(&per_cu, (const void*)fwd_kernel, NTHREADS, LDS_BYTES);
        (void)hipGetLastError();
        if (per_cu < 1) per_cu = 1;
        if (per_cu > 2) per_cu = 2;
        grid = cus * per_cu;
    }
    if (grid < 0) return;
    hipMemsetAsync((char*)d_ws + WS_CTL, 0, CTL_BYTES, stream);
    KP p{};
    for (int i = 0; i < 52; ++i) p.in[i] = (const float*)d_in[i];
    p.out = (float*)d_out; p.ws = (char*)d_ws;
#if defined(PROBE_PH)
    for (int ph = 0; ph < NPHASE; ++ph) {
        const int reps = (ph == PROBE_PH) ? 1 + PROBE_N : 1;
        for (int r = 0; r < reps; ++r) { p.ph_lo = ph; p.ph_hi = ph + 1; p.rep = r; hipLaunchKernelGGL(fwd_kernel, dim3(grid), dim3(NTHREADS), LDS_BYTES, stream, p); }
    }
    if (PROBE_PH >= 100) { p.ph_lo = PROBE_PH; p.ph_hi = PROBE_PH + 1; p.rep = 0; hipLaunchKernelGGL(fwd_kernel, dim3(PROBE_N), dim3(NTHREADS), LDS_BYTES, stream, p); }
#elif N_LAUNCH_MODE == 1
    p.ph_lo = 0; p.ph_hi = NPHASE;
    hipLaunchKernelGGL(fwd_kernel, dim3(grid), dim3(NTHREADS), LDS_BYTES, stream, p);
#else
    for (int ph = 0; ph < NPHASE; ++ph) {
        p.ph_lo = ph; p.ph_hi = ph + 1;
        hipLaunchKernelGGL(fwd_kernel, dim3(grid), dim3(NTHREADS), LDS_BYTES, stream, p);
    }
#endif
}
```

```cpp
#include <hip/hip_runtime.h>
#include <hip/hip_bf16.h>
#include <hip/hip_fp16.h>
#include <stdint.h>
#include <stdio.h>

typedef unsigned short bf16_t;
using bf16x8 = __attribute__((ext_vector_type(8))) short;
using f32x4 = __attribute__((ext_vector_type(4))) float;
using f32x2 = __attribute__((ext_vector_type(2))) float;

#define NTC 2048
#define NTL 32768
#define NT 34816
#define DM 1024
#define ZS 3024
#define COL_GD 960
#define COL_HY 2000
#define COL_S5 2768
#define NCHUNK 68
#define ALPHA 1.41421356237f
#define NTHREADS 256
#define LDS_BYTES 73728
#define LDS_USER 2048
#define SH_TILE_BASE 2240
#define ACT_ROWS ((SH_TILE_BASE + 272) * 128)

constexpr size_t al256(size_t x) { return (x + 255) & ~(size_t)255; }
constexpr size_t WS_CTL = 0;
constexpr size_t CTL_BYTES = 131072;
constexpr size_t WS_MOD = WS_CTL + CTL_BYTES;
constexpr size_t WS_S5A = al256(WS_MOD + 2 * 9 * 6144 * 4);
constexpr size_t WS_S5B = al256(WS_S5A + 2 * 2 * 16 * 64 * 4 * 4);
constexpr size_t WS_GLUT = al256(WS_S5B + 2 * 2 * 16 * 64 * 32 * 4);
constexpr size_t WS_G2T = al256(WS_GLUT + 2 * 256 * 256 * 2);
constexpr size_t WS_LW2T = al256(WS_G2T + 2 * 256 * 64 * 2);
constexpr size_t WS_LA2T = al256(WS_LW2T + 2 * 256 * 64 * 2);
constexpr size_t SZ_WINT = (size_t)3072 * 1024 * 2, SZ_WOUTT = (size_t)1024 * 1024 * 2, SZ_FILTL = (size_t)4 * 256 * 4096 * 4, SZ_FILTC = (size_t)4 * 256 * 256 * 4;
constexpr size_t WS_WINT = al256(WS_LA2T + 2 * 256 * 64 * 2);
constexpr size_t WS_WOUTT = al256(WS_WINT + 2 * SZ_WINT);
constexpr size_t WS_FILTL = al256(WS_WOUTT + 2 * SZ_WOUTT);
constexpr size_t WS_FILTC = al256(WS_FILTL + 2 * SZ_FILTL);
constexpr size_t WS_XC = al256(WS_FILTC + 2 * SZ_FILTC);
constexpr size_t WS_HBY = al256(WS_XC + (size_t)NTC * DM * 4);
constexpr size_t WS_CAT = al256(WS_HBY + (size_t)NT * DM * 2);
constexpr size_t WS_Z = al256(WS_CAT + (size_t)NT * DM * 2);
constexpr size_t WS_R1 = al256(WS_Z + (size_t)NT * ZS * 2);
constexpr size_t R1_RWP = 0;
constexpr size_t R1_GQ = (size_t)NT * 1024 * 2;
constexpr size_t R1_W13T = 0;
constexpr size_t R1_W2T = (size_t)65 * 512 * 1024 * 2;
constexpr size_t R1_BYTES = (size_t)NT * 1024 * 2 + (size_t)NT * 768 * 2;
constexpr size_t WS_KNORM = al256(WS_R1 + R1_BYTES);
constexpr size_t WS_GAB = al256(WS_KNORM + (size_t)NT * 4 * 4);
constexpr size_t WS_S5ST = al256(WS_GAB + (size_t)NT * 16 * 4);
constexpr size_t WS_AEP = al256(WS_S5ST + (size_t)8 * 68 * 2 * 16 * 64 * 2 * 4);
constexpr size_t WS_AW = al256(WS_AEP + (size_t)NT * 8 * 4);
constexpr size_t WS_RTOK = al256(WS_AW + (size_t)NT * 8 * 4);
constexpr size_t WS_HYT = al256(WS_RTOK + (size_t)64 * NT * 4);
constexpr size_t WS_S5G = al256(WS_HYT + (size_t)8 * 768 * 4096 * 2);
constexpr size_t WS_END = al256(WS_S5G + (size_t)NT * 256 * 2);
static_assert(R1_W2T + (size_t)65 * 1024 * 256 * 2 <= R1_BYTES, "expert weights must fit R1");
constexpr size_t ACT_BYTES = (size_t)ACT_ROWS * 256 * 2;
constexpr size_t WS_ACT = WS_Z + ((((size_t)NT * ZS * 2 - ACT_BYTES) >> 8) << 8);
constexpr size_t WS_Y2 = WS_HBY;
static_assert(WS_Y2 + ACT_BYTES <= WS_ACT, "y2 must not reach act");

#define CW_QUEUE(l) (4096 + 64 * (l))
#define CW_CNT(l) (16384 + 2048 * (l))
#define CW_CUCNT(l) (8192 + 4096 * (l))

#define XB_TMO      128
#define XB_XCNT(j)  (256  + 64 * (j))
#define XB_XSUB(j)  (1280 + 64 * (j))
#define XB_XGEN(j)  (2304 + 64 * (j))
#define XB_TOP      3328
#define XB_TOPGEN   3392
#define XCD_BAR_WORDS 3456
#define XB_SPIN_CAP (1u << 18)
#define LAS __attribute__((address_space(3)))

__device__ __forceinline__ unsigned xb_ld(unsigned* p)              { return __hip_atomic_load(p, __ATOMIC_RELAXED, __HIP_MEMORY_SCOPE_AGENT); }
__device__ __forceinline__ unsigned xb_add(unsigned* p, unsigned v) { return __hip_atomic_fetch_add(p, v, __ATOMIC_RELAXED, __HIP_MEMORY_SCOPE_AGENT); }
__device__ __forceinline__ unsigned xb_xcc_id() { return (unsigned)__builtin_amdgcn_s_getreg((3 << 11) | 20) & 0xFu; }
#define XB_SPIN(cond, bar) do { unsigned _sp = 0; while (cond) { __builtin_amdgcn_s_sleep(1); \
    if ((++_sp & 255u) == 0u) { if (xb_ld(&(bar)[XB_TMO])) break; if (_sp > XB_SPIN_CAP) { atomicAdd(&(bar)[XB_TMO], 1u); break; } } } } while (0)

struct XcdBarrier {
    unsigned* bar; unsigned x;
    volatile LAS unsigned* st;
};
__device__ __forceinline__ XcdBarrier xcd_barrier_post(unsigned* bar, volatile LAS unsigned* st) {
    XcdBarrier b; b.bar = bar; b.x = xb_xcc_id(); b.st = st;
    if (threadIdx.x == 0) (void)xb_add(&bar[XB_XCNT(b.x)], 1u);
    return b;
}
__device__ __forceinline__ void xcd_barrier_complete(unsigned* bar, unsigned x, unsigned& nloc, unsigned& nx) {
    const unsigned G = gridDim.x * gridDim.y * gridDim.z;
    unsigned sum, cnt, mine, sp = 0u;
    for (;;) {
        sum = 0u; cnt = 0u; mine = 0u;
#pragma unroll
        for (unsigned j = 0; j < 16; ++j) { const unsigned c = xb_ld(&bar[XB_XCNT(j)]); sum += c; cnt += (c > 0u) ? 1u : 0u; mine = (j == x) ? c : mine; }
        if (sum == G) break;
        __builtin_amdgcn_s_sleep(1);
        if ((++sp & 255u) == 0u) { if (xb_ld(&bar[XB_TMO])) break; if (sp > XB_SPIN_CAP) { atomicAdd(&bar[XB_TMO], 1u); break; } }
    }
    nloc = mine > 0u ? mine : 1u; nx = cnt > 0u ? cnt : 1u;
}
__device__ __forceinline__ void xcd_barrier(const XcdBarrier& b) {
    asm volatile("s_waitcnt vmcnt(0)" ::: "memory");
    __syncthreads();
    if (threadIdx.x == 0) {
        unsigned* bar = b.bar;
        __builtin_amdgcn_s_waitcnt(0);
        unsigned nloc = b.st[0], nx = b.st[1];
        if (nloc == 0u) { xcd_barrier_complete(bar, b.x, nloc, nx); b.st[0] = nloc; b.st[1] = nx; }
        const unsigned old = xb_add(&bar[XB_XSUB(b.x)], 1u);
        const unsigned gen = old / nloc;
        if (old + 1u == (gen + 1u) * nloc) {
            __builtin_amdgcn_fence(__ATOMIC_RELEASE, "agent");
            asm volatile("s_waitcnt vmcnt(0)" ::: "memory");
            const unsigned og = xb_add(&bar[XB_TOP], 1u);
            const unsigned tg = og / nx;
            if (og + 1u == (tg + 1u) * nx) xb_add(&bar[XB_TOPGEN], 1u);
            else XB_SPIN(xb_ld(&bar[XB_TOPGEN]) == tg, bar);
            __builtin_amdgcn_fence(__ATOMIC_ACQUIRE, "agent");
            xb_add(&bar[XB_XGEN(b.x)], 1u);
            asm volatile("s_waitcnt vmcnt(0)" ::: "memory");
        } else {
            XB_SPIN(xb_ld(&bar[XB_XGEN(b.x)]) == gen, bar);
            __builtin_amdgcn_fence(__ATOMIC_ACQUIRE, "agent");
            asm volatile("s_waitcnt vmcnt(0)" ::: "memory");
        }
    }
    __syncthreads();
}

struct KP {
    const float* in[52];
    float* out;
    char* ws;
    int ph_lo, ph_hi, rep, pad_;
};
struct P {
    const __attribute__((address_space(3))) unsigned* tab;
    float* out;
    char* ws;
    __device__ __forceinline__ const float* in(int i) const {
        const unsigned lo = __builtin_amdgcn_readfirstlane(tab[2 * i]);
        const unsigned hi = __builtin_amdgcn_readfirstlane(tab[2 * i + 1]);
        return (const float*)(((unsigned long long)hi << 32) | (unsigned long long)lo);
    }
};
enum { I_X = 0, I_C, I_CTX, I_CCTX, I_ADAW, I_ADAB, I_WIN, I_WOUT, I_LNG, I_LNB,
       I_RW_W0, I_RW_W2, I_RW_A0, I_RW_A2, I_RW_G2, I_RW_KK, I_RW_KA, I_RW_RK, I_RW_GNG, I_RW_GNB,
       I_GD_CONV, I_GD_ALOG, I_GD_DTB, I_GD_NORM,
       I_HY_CONV, I_HY_CONVB, I_HY_W1, I_HY_B1, I_HY_F1, I_HY_W2, I_HY_B2, I_HY_F2, I_HY_W3, I_HY_SKIP,
       I_S5_LRE, I_S5_LIM, I_S5_LOGSTEP, I_S5_BRE, I_S5_BIM, I_S5_CRE, I_S5_CIM, I_S5_D, I_S5_GLUW, I_S5_GLUB,
       I_ROUTER_W, I_ROUTER_B, I_EX_W1, I_EX_W3, I_EX_W2, I_SH_W1, I_SH_W3, I_SH_W2 };

__device__ __forceinline__ bf16_t f2bf(float f) { unsigned u = __float_as_uint(f); u += 0x7fffu + ((u >> 16) & 1u); return (bf16_t)(u >> 16); }
__device__ __forceinline__ float bf2f(bf16_t h) { return __uint_as_float(((unsigned)h) << 16); }
__device__ __forceinline__ float bflo(unsigned u) { return __uint_as_float(u << 16); }
__device__ __forceinline__ float bfhi(unsigned u) { return __uint_as_float(u & 0xffff0000u); }
__device__ __forceinline__ unsigned pack2(float a, float b) { return (unsigned)f2bf(a) | ((unsigned)f2bf(b) << 16); }
__device__ __forceinline__ float sigm(float x) { return 1.f / (1.f + __expf(-x)); }
__device__ __forceinline__ float siluf(float x) { return x / (1.f + __expf(-x)); }
__device__ __forceinline__ float softplusf(float x) { return fmaxf(x, 0.f) + log1pf(__expf(-fabsf(x))); }
template <int CTRL> __device__ __forceinline__ float dppf(float v) {
    return __int_as_float(__builtin_amdgcn_update_dpp(0, __float_as_int(v), CTRL, 0xF, 0xF, true));
}
__device__ __forceinline__ float wave_sum(float v) {
    v += dppf<0xB1>(v); v += dppf<0x4E>(v); v += dppf<0x141>(v); v += dppf<0x140>(v);
    const int iv = __float_as_int(v);
    const float r0 = __int_as_float(__builtin_amdgcn_readlane(iv, 0)), r1 = __int_as_float(__builtin_amdgcn_readlane(iv, 16));
    const float r2 = __int_as_float(__builtin_amdgcn_readlane(iv, 32)), r3 = __int_as_float(__builtin_amdgcn_readlane(iv, 48));
    return (r0 + r1) + (r2 + r3);
}

__device__ __forceinline__ void unpack8(const uint4& v, float (&o)[8]) {
    o[0] = bflo(v.x); o[1] = bfhi(v.x); o[2] = bflo(v.y); o[3] = bfhi(v.y); o[4] = bflo(v.z); o[5] = bfhi(v.z); o[6] = bflo(v.w); o[7] = bfhi(v.w);
}
__device__ __forceinline__ uint4 pack8(const float (&o)[8]) { return make_uint4(pack2(o[0], o[1]), pack2(o[2], o[3]), pack2(o[4], o[5]), pack2(o[6], o[7])); }
__device__ __forceinline__ float sum8lanes(float v) { v += dppf<0xB1>(v); v += dppf<0x4E>(v); v += dppf<0x141>(v); return v; }

#define DPP_ADD_ASM(name, ctrl) __device__ __forceinline__ float name(float x) { float r; asm volatile("s_nop 1\n\tv_add_f32_dpp %0, %1, %1 " ctrl " row_mask:0xf bank_mask:0xf bound_ctrl:1" : "=v"(r) : "v"(x)); return r; }
DPP_ADD_ASM(dadd_x1, "quad_perm:[1,0,3,2]")
DPP_ADD_ASM(dadd_x2, "quad_perm:[2,3,0,1]")
DPP_ADD_ASM(dadd_hm, "row_half_mirror")
DPP_ADD_ASM(dadd_rm, "row_mirror")

__device__ __forceinline__ void dpp_allreduce16_x2(float& a, float& b) {
    asm volatile(
        "s_nop 1\n\t"
        "v_add_f32_dpp %0, %0, %0 quad_perm:[1,0,3,2] row_mask:0xf bank_mask:0xf bound_ctrl:1\n\t"
        "v_add_f32_dpp %1, %1, %1 quad_perm:[1,0,3,2] row_mask:0xf bank_mask:0xf bound_ctrl:1\n\t"
        "s_nop 0\n\t"
        "v_add_f32_dpp %0, %0, %0 quad_perm:[2,3,0,1] row_mask:0xf bank_mask:0xf bound_ctrl:1\n\t"
        "v_add_f32_dpp %1, %1, %1 quad_perm:[2,3,0,1] row_mask:0xf bank_mask:0xf bound_ctrl:1\n\t"
        "s_nop 0\n\t"
        "v_add_f32_dpp %0, %0, %0 row_half_mirror row_mask:0xf bank_mask:0xf bound_ctrl:1\n\t"
        "v_add_f32_dpp %1, %1, %1 row_half_mirror row_mask:0xf bank_mask:0xf bound_ctrl:1\n\t"
        "s_nop 0\n\t"
        "v_add_f32_dpp %0, %0, %0 row_mirror row_mask:0xf bank_mask:0xf bound_ctrl:1\n\t"
        "v_add_f32_dpp %1, %1, %1 row_mirror row_mask:0xf bank_mask:0xf bound_ctrl:1"
        : "+v"(a), "+v"(b));
}
__device__ __forceinline__ int otid() { int t = threadIdx.x; asm volatile("" : "+v"(t)); return t; }
__device__ __forceinline__ float* xrow(const P& p, int row) {
    return row < NTC ? (float*)(p.ws + WS_XC) + (size_t)row * DM : p.out + (size_t)(row - NTC) * DM;
}
__device__ __forceinline__ int row_mod(int row) { return row < NTC ? 8 : ((row - NTC) >> 12); }
__device__ __forceinline__ const float* modp(const P& p, int l, int r, int chunk) {
    return (const float*)(p.ws + WS_MOD) + ((size_t)(l * 9 + r) * 6144 + chunk * 1024);
}

struct ARows { int r[4]; };
__device__ __forceinline__ ARows arows_lin(int base, int tid) { ARows a; a.r[0] = base + (tid >> 3); a.r[1] = a.r[0] + 32; a.r[2] = a.r[0] + 64; a.r[3] = a.r[0] + 96; return a; }
__device__ __forceinline__ void gemm_tile(const bf16_t* __restrict__ A, int lda, const ARows& ar,
                                          const bf16_t* __restrict__ Bt, int ldb, int brow0, int K,
                                          char* lds, f32x4 (&acc)[4][4]) {
    const int tid = otid();
    const int wid = tid >> 6, lane = tid & 63, wr = wid >> 1, wc = wid & 1, fr = lane & 15, fq = lane >> 4;
    const int gc = ((tid & 7) ^ ((tid >> 3) & 7)) * 8;
    const bf16_t* ap[4]; const bf16_t* bp[4];
#pragma unroll
    for (int i = 0; i < 4; ++i) {
        ap[i] = A + (size_t)ar.r[i] * lda + gc;
        bp[i] = Bt + (size_t)(brow0 + (tid >> 3) + 32 * i) * ldb + gc;
    }
#pragma unroll
    for (int m = 0; m < 4; ++m)
#pragma unroll
        for (int n = 0; n < 4; ++n) acc[m][n] = f32x4{0.f, 0.f, 0.f, 0.f};
    const int nk = K >> 6;
    auto stage = [&](int t, int buf) {
        char* SA = lds + buf * 32768; char* SB = SA + 16384;
        const int ko = t * 64;
#pragma unroll
        for (int i = 0; i < 4; ++i) {
            __builtin_amdgcn_global_load_lds((const void*)(ap[i] + ko), (LAS void*)(SA + tid * 16 + i * 4096), 16, 0, 0);
            __builtin_amdgcn_global_load_lds((const void*)(bp[i] + ko), (LAS void*)(SB + tid * 16 + i * 4096), 16, 0, 0);
        }
    };
    stage(0, 0);
    asm volatile("s_waitcnt vmcnt(0)" ::: "memory");
    __syncthreads();
    const int sw = fr & 7;
    for (int t = 0; t < nk; ++t) {
        const int buf = t & 1;
        if (t + 1 < nk) stage(t + 1, buf ^ 1);
        const char* SA = lds + buf * 32768; const char* SB = SA + 16384;
        bf16x8 af[2][4], bfr[2][4];
#pragma unroll
        for (int ks = 0; ks < 2; ++ks) {
            const int co = ((ks * 4 + fq) ^ sw) * 16;
#pragma unroll
            for (int m = 0; m < 4; ++m) af[ks][m] = *reinterpret_cast<const bf16x8*>(SA + (wr * 64 + m * 16 + fr) * 128 + co);
#pragma unroll
            for (int n = 0; n < 4; ++n) bfr[ks][n] = *reinterpret_cast<const bf16x8*>(SB + (wc * 64 + n * 16 + fr) * 128 + co);
        }
        __builtin_amdgcn_s_setprio(1);
#pragma unroll
        for (int ks = 0; ks < 2; ++ks)
#pragma unroll
            for (int m = 0; m < 4; ++m)
#pragma unroll
                for (int n = 0; n < 4; ++n) acc[m][n] = __builtin_amdgcn_mfma_f32_16x16x32_bf16(af[ks][m], bfr[ks][n], acc[m][n], 0, 0, 0);
        __builtin_amdgcn_s_setprio(0);
        asm volatile("s_waitcnt vmcnt(0)" ::: "memory");
        __syncthreads();
    }
}

__device__ __forceinline__ void ph0_mod_unit(const P& p, int u, char* lds) {
    const int l = u / 96, cg = u % 96, tid = otid();
    float* s = (float*)lds;
    float* red = s + 9 * 1024;
    const float* c = p.in(I_C); const float* cctx = p.in(I_CCTX);
    for (int i = tid; i < 9 * 1024; i += NTHREADS) { int r = i >> 10, k = i & 1023; float v = r < 8 ? c[r * 1024 + k] : cctx[k]; s[i] = v / (1.f + expf(-v)); }
    __syncthreads();
    const int kq = tid >> 6, j = tid & 63, col = cg * 64 + j;
    const float* w = p.in(I_ADAW) + (size_t)l * 1024 * 6144 + col;
    float acc[9];
#pragma unroll
    for (int r = 0; r < 9; ++r) acc[r] = 0.f;
#pragma unroll 4
    for (int k = kq * 256; k < kq * 256 + 256; ++k) {
        const float wv = w[(size_t)k * 6144];
#pragma unroll
        for (int r = 0; r < 9; ++r) acc[r] += s[r * 1024 + k] * wv;
    }
#pragma unroll
    for (int r = 0; r < 9; ++r) red[(kq * 9 + r) * 64 + j] = acc[r];
    __syncthreads();
    if (tid < 64) {
        float* mod = (float*)(p.ws + WS_MOD);
        const float bb = p.in(I_ADAB)[l * 6144 + col];
#pragma unroll
        for (int r = 0; r < 9; ++r) mod[(size_t)(l * 9 + r) * 6144 + col] = red[r * 64 + j] + red[(9 + r) * 64 + j] + red[(18 + r) * 64 + j] + red[(27 + r) * 64 + j] + bb;
    }
    __syncthreads();
}

__device__ __forceinline__ void ph0_s5tab_unit(const P& p, int u) {
    const int tid = otid();
    if (tid >= 64) return;
    const int ldg = u;
    const int idx = ldg * 64 + tid;
    const double lre = (double)p.in(I_S5_LRE)[idx], lim = (double)p.in(I_S5_LIM)[idx];
    const double dt = (double)expf(p.in(I_S5_LOGSTEP)[ldg]);
    const float mag = expf((float)(lre * dt));
    double rev = lim * dt * 0.15915494309189535; rev -= floor(rev);
    float sn, cs; sincospif(2.f * (float)rev, &sn, &cs);
    const double abr = (double)(mag * cs), abi = (double)(mag * sn);
    const double den = lre * lre + lim * lim;
    const double cor = ((abr - 1.0) * lre + abi * lim) / den;
    const double coi = (abi * lre - (abr - 1.0) * lim) / den;
    const float m64f = expf((float)(64.0 * lre * dt));
    double rev64 = 64.0 * lim * dt * 0.15915494309189535; rev64 -= floor(rev64);
    float sn64, cs64; sincospif(2.f * (float)rev64, &sn64, &cs64);
    float* A = (float*)(p.ws + WS_S5A) + (size_t)idx * 4;
    A[0] = (float)abr; A[1] = (float)abi; A[2] = m64f * cs64; A[3] = m64f * sn64;
    float* B = (float*)(p.ws + WS_S5B) + (size_t)idx * 32;
    const float* bre = p.in(I_S5_BRE) + (size_t)idx * 16; const float* bim = p.in(I_S5_BIM) + (size_t)idx * 16;
#pragma unroll
    for (int h = 0; h < 16; ++h) {
        const double br = bre[h], bi = bim[h];
        B[h] = (float)(cor * br - coi * bi);
        B[16 + h] = (float)(cor * bi + coi * br);
    }
}

__device__ __forceinline__ int xmap(int mode, int c) {
    if (mode == 0) return c;
    const int j = c >> 6, cc = c & 63, wc = cc >> 5, pp = (cc & 31) >> 4, i = cc & 15;
    return j * 128 + wc * 64 + pp * 32 + i + (mode == 2 ? 16 : 0);
}
__device__ __forceinline__ void xpose_tile(const float* __restrict__ src, int C, bf16_t* __restrict__ dst, int ldd, int mode, int tr, int tc, char* lds) {
    float* t = (float*)lds;
    const int tid = otid();
    {
        const int c4 = (tid & 15) * 4, c = tc * 64 + c4;
#pragma unroll
        for (int k = 0; k < 4; ++k) {
            const int r = (tid >> 4) + 16 * k;
            float4 v = make_float4(0.f, 0.f, 0.f, 0.f);
            if (c < C) v = *reinterpret_cast<const float4*>(src + (size_t)(tr * 64 + r) * C + c);
            t[(c4 + 0) * 65 + r] = v.x; t[(c4 + 1) * 65 + r] = v.y; t[(c4 + 2) * 65 + r] = v.z; t[(c4 + 3) * 65 + r] = v.w;
        }
    }
    __syncthreads();
#pragma unroll
    for (int k = 0; k < 2; ++k) {
        const int ci = (tid >> 3) + 32 * k, r8 = (tid & 7) * 8;
        const float* tp = t + ci * 65 + r8;
        uint4 o;
        o.x = pack2(tp[0], tp[1]); o.y = pack2(tp[2], tp[3]); o.z = pack2(tp[4], tp[5]); o.w = pack2(tp[6], tp[7]);
        *reinterpret_cast<uint4*>(dst + (size_t)xmap(mode, tc * 64 + ci) * ldd + tr * 64 + r8) = o;
    }
    __syncthreads();
}

__device__ __forceinline__ void xpose_strip4(const float* __restrict__ src, int C, bf16_t* __restrict__ dst, int ldd, int mode, int tr, int tc0, char* lds) {
    float* t = (float*)lds;
    const int tid = otid();
    {
        const int c4 = (tid & 15) * 4;
        float4 v[4][4];
#pragma unroll
        for (int q = 0; q < 4; ++q)
#pragma unroll
            for (int k = 0; k < 4; ++k) v[q][k] = *reinterpret_cast<const float4*>(src + (size_t)(tr * 64 + (tid >> 4) + 16 * k) * C + (tc0 + q) * 64 + c4);
#pragma unroll
        for (int q = 0; q < 4; ++q)
#pragma unroll
            for (int k = 0; k < 4; ++k) {
                const int r = (tid >> 4) + 16 * k;
                float* tq = t + q * (64 * 65);
                tq[(c4 + 0) * 65 + r] = v[q][k].x; tq[(c4 + 1) * 65 + r] = v[q][k].y; tq[(c4 + 2) * 65 + r] = v[q][k].z; tq[(c4 + 3) * 65 + r] = v[q][k].w;
            }
    }
    __syncthreads();
#pragma unroll
    for (int q = 0; q < 4; ++q)
#pragma unroll
        for (int k = 0; k < 2; ++k) {
            const int ci = (tid >> 3) + 32 * k, r8 = (tid & 7) * 8;
            const float* tp = t + q * (64 * 65) + ci * 65 + r8;
            uint4 o;
            o.x = pack2(tp[0], tp[1]); o.y = pack2(tp[2], tp[3]); o.z = pack2(tp[4], tp[5]); o.w = pack2(tp[6], tp[7]);
            *reinterpret_cast<uint4*>(dst + (size_t)xmap(mode, (tc0 + q) * 64 + ci) * ldd + tr * 64 + r8) = o;
        }
    __syncthreads();
}

enum { M_INIT = 0, M_LN2NEXT = 1, M_LN1 = 2, M_FINAL = 3 };

template <int MODE>
__device__ __forceinline__ void rows_unit(const P& p, int l, int u, char* lds, int dry = 0) {
    const int tid = otid(), w = tid >> 6, lane = tid & 63;
    constexpr int RW = (MODE == M_LN1) ? 4 : 2;
    float* hbuf = (float*)lds;
    bf16_t* hb = (bf16_t*)(p.ws + WS_HBY);
#pragma unroll 1
    for (int rr = 0; rr < RW; ++rr) {
        const int rl = w * RW + rr, row = u * (4 * RW) + rl;
        const int mr = row_mod(row);
        float v[16];
        float* xr = xrow(p, row);
        const float* src = (MODE == M_INIT) ? (row < NTC ? p.in(I_CTX) + (size_t)row * DM : p.in(I_X) + (size_t)(row - NTC) * DM) : xr;
#pragma unroll
        for (int i = 0; i < 4; ++i) {
            const float4 t = *reinterpret_cast<const float4*>(src + i * 256 + lane * 4);
            v[i * 4 + 0] = t.x; v[i * 4 + 1] = t.y; v[i * 4 + 2] = t.z; v[i * 4 + 3] = t.w;
        }
        if (MODE == M_FINAL && row >= NTC) {
            const int* tbs = (const int*)(lds - LDS_USER + 1024);
            const unsigned char* y2 = (const unsigned char*)(p.ws + WS_Y2);
            const int* aep = (const int*)(p.ws + WS_AEP); const float* aw = (const float*)(p.ws + WS_AW);
            float r8[8];
            {
                const unsigned char* yr = y2 + ((size_t)(SH_TILE_BASE * 128 + row)) * 512 + lane * 4;
                const int w0 = *reinterpret_cast<const int*>(yr), w1 = *reinterpret_cast<const int*>(yr + 256);
                r8[0] = __builtin_amdgcn_cvt_f32_fp8(w0, 0); r8[1] = __builtin_amdgcn_cvt_f32_fp8(w0, 1); r8[2] = __builtin_amdgcn_cvt_f32_fp8(w0, 2); r8[3] = __builtin_amdgcn_cvt_f32_fp8(w0, 3);
                r8[4] = __builtin_amdgcn_cvt_f32_fp8(w1, 0); r8[5] = __builtin_amdgcn_cvt_f32_fp8(w1, 1); r8[6] = __builtin_amdgcn_cvt_f32_fp8(w1, 2); r8[7] = __builtin_amdgcn_cvt_f32_fp8(w1, 3);
            }
#pragma unroll
            for (int k = 0; k < 8; ++k) {
                const unsigned av = (unsigned)aep[(size_t)row * 8 + k];
                const float wk = aw[(size_t)row * 8 + k];
                const int dest = tbs[av >> 24] * 128 + (int)(av & 0xFFFFFFu);
                const unsigned char* yr = y2 + (size_t)dest * 512 + lane * 4;
                const int w0 = *reinterpret_cast<const int*>(yr), w1 = *reinterpret_cast<const int*>(yr + 256);
                r8[0] += wk * __builtin_amdgcn_cvt_f32_fp8(w0, 0); r8[1] += wk * __builtin_amdgcn_cvt_f32_fp8(w0, 1); r8[2] += wk * __builtin_amdgcn_cvt_f32_fp8(w0, 2); r8[3] += wk * __builtin_amdgcn_cvt_f32_fp8(w0, 3);
                r8[4] += wk * __builtin_amdgcn_cvt_f32_fp8(w1, 0); r8[5] += wk * __builtin_amdgcn_cvt_f32_fp8(w1, 1); r8[6] += wk * __builtin_amdgcn_cvt_f32_fp8(w1, 2); r8[7] += wk * __builtin_amdgcn_cvt_f32_fp8(w1, 3);
            }
            const float4 g2 = *reinterpret_cast<const float4*>(modp(p, l, mr, 5) + 512 + lane * 4);
            const float4 g3 = *reinterpret_cast<const float4*>(modp(p, l, mr, 5) + 768 + lane * 4);
            const float sc16 = 1.f / 16.f;
            v[8] += sc16 * g2.x * r8[0]; v[9] += sc16 * g2.y * r8[1]; v[10] += sc16 * g2.z * r8[2]; v[11] += sc16 * g2.w * r8[3];
            v[12] += sc16 * g3.x * r8[4]; v[13] += sc16 * g3.y * r8[5]; v[14] += sc16 * g3.z * r8[6]; v[15] += sc16 * g3.w * r8[7];
        }
        if (MODE != M_INIT) {
            const int ll = (MODE == M_LN2NEXT) ? l - 1 : l;
            const int which = (MODE == M_LN1) ? 0 : 1;
            float s = 0.f;
#pragma unroll
            for (int i = 0; i < 16; ++i) s += v[i];
            const float mu = wave_sum(s) * (1.f / 1024.f);
            float q = 0.f;
#pragma unroll
            for (int i = 0; i < 16; ++i) { const float d = v[i] - mu; q += d * d; }
            const float rstd = rsqrtf(wave_sum(q) * (1.f / 1024.f) + 1e-5f);
            const float* g = p.in(I_LNG) + (size_t)(ll * 2 + which) * 1024;
            const float* bb = p.in(I_LNB) + (size_t)(ll * 2 + which) * 1024;
#pragma unroll
            for (int i = 0; i < 4; ++i) {
                const float4 gg = *reinterpret_cast<const float4*>(g + i * 256 + lane * 4);
                const float4 b4 = *reinterpret_cast<const float4*>(bb + i * 256 + lane * 4);
                v[i * 4 + 0] = (v[i * 4 + 0] - mu) * rstd * gg.x + b4.x;
                v[i * 4 + 1] = (v[i * 4 + 1] - mu) * rstd * gg.y + b4.y;
                v[i * 4 + 2] = (v[i * 4 + 2] - mu) * rstd * gg.z + b4.z;
                v[i * 4 + 3] = (v[i * 4 + 3] - mu) * rstd * gg.w + b4.w;
            }
        }
        if (MODE == M_FINAL) {
            if (row >= NTC) {
#pragma unroll
                for (int i = 0; i < 4; ++i) *reinterpret_cast<float4*>(xr + i * 256 + lane * 4) = make_float4(v[i * 4], v[i * 4 + 1], v[i * 4 + 2], v[i * 4 + 3]);
            }
            continue;
        }
        const float osc = (MODE == M_LN1) ? ALPHA : 1.f;
#pragma unroll
        for (int i = 0; i < 4; ++i) if (MODE != M_INIT) { float4 o4 = make_float4(osc * v[i * 4], osc * v[i * 4 + 1], osc * v[i * 4 + 2], osc * v[i * 4 + 3]); if (dry) o4 = *reinterpret_cast<const float4*>(src + i * 256 + lane * 4); *reinterpret_cast<float4*>(xr + i * 256 + lane * 4) = o4; }
        const float* sh = modp(p, l, mr, (MODE == M_LN1) ? 3 : 0);
        const float* sc = modp(p, l, mr, (MODE == M_LN1) ? 4 : 1);
#pragma unroll
        for (int i = 0; i < 4; ++i) {
            const float4 s4 = *reinterpret_cast<const float4*>(sc + i * 256 + lane * 4);
            const float4 h4 = *reinterpret_cast<const float4*>(sh + i * 256 + lane * 4);
            const float h0 = v[i * 4 + 0] * (1.f + s4.x) + h4.x, h1 = v[i * 4 + 1] * (1.f + s4.y) + h4.y;
            const float h2 = v[i * 4 + 2] * (1.f + s4.z) + h4.z, h3 = v[i * 4 + 3] * (1.f + s4.w) + h4.w;
            uint2 pk; pk.x = pack2(h0, h1); pk.y = pack2(h2, h3);
            if (!dry) *reinterpret_cast<uint2*>(hb + (size_t)row * DM + i * 256 + lane * 4) = pk;
            if (MODE == M_LN1) *reinterpret_cast<float4*>(hbuf + rl * 1028 + i * 256 + lane * 4) = make_float4(h0, h1, h2, h3);
        }
    }
    if (MODE == M_LN1 && dry != 2) {
        float* part = hbuf;
        __syncthreads();
        {
            const int fr = lane & 15, fq = lane >> 4;
            const float* rwb = p.in(I_ROUTER_W) + (size_t)l * 1024 * 64 + fr;
            const float* hrow = hbuf + fr * 1028 + fq;
            f32x4 ac[4];
#pragma unroll
            for (int nf = 0; nf < 4; ++nf) ac[nf] = f32x4{0.f, 0.f, 0.f, 0.f};
#pragma unroll 8
            for (int k = w * 256; k < w * 256 + 256; k += 4) {
                const float av = hrow[k];
                const float* bp = rwb + (size_t)(k + fq) * 64;
#pragma unroll
                for (int nf = 0; nf < 4; ++nf) ac[nf] = __builtin_amdgcn_mfma_f32_16x16x4f32(av, bp[nf * 16], ac[nf], 0, 0, 0);
            }
            __syncthreads();
#pragma unroll
            for (int nf = 0; nf < 4; ++nf)
#pragma unroll
                for (int r = 0; r < 4; ++r) part[(w * 16 + fq * 4 + r) * 64 + nf * 16 + fr] = ac[nf][r];
        }
        __syncthreads();
        float lg[4];
#pragma unroll
        for (int rr = 0; rr < 4; ++rr) {
            const int r0 = w * 4 + rr;
            lg[rr] = part[(0 * 16 + r0) * 64 + lane] + part[(1 * 16 + r0) * 64 + lane] + part[(2 * 16 + r0) * 64 + lane] + part[(3 * 16 + r0) * 64 + lane];
        }
        const float rbias = p.in(I_ROUTER_B)[l * 64 + lane];
        unsigned* cnt = (unsigned*)(p.ws + WS_CTL) + CW_CNT(l);
        int* aep = (int*)(p.ws + WS_AEP); float* aw = (float*)(p.ws + WS_AW);
#pragma unroll 1
        for (int rr = 0; rr < 4; ++rr) {
            const int row = u * 16 + w * 4 + rr;
            const float logit = (rr == 0) ? lg[0] : (rr == 1) ? lg[1] : (rr == 2) ? lg[2] : lg[3];
            const float s = 1.f / (1.f + expf(-logit));
            const float bsd = s + rbias;
            float m1 = bsd;
            m1 = fmaxf(m1, __shfl_xor(m1, 1)); m1 = fmaxf(m1, __shfl_xor(m1, 2)); m1 = fmaxf(m1, __shfl_xor(m1, 4));
            const unsigned long long eqm = __ballot(bsd == m1);
            const int gbase = lane & ~7;
            const unsigned gbits = (unsigned)((eqm >> gbase) & 0xFFull);
            const int first = gbase + __builtin_ctz(gbits);
            float m2 = (lane == first) ? -INFINITY : bsd;
            m2 = fmaxf(m2, __shfl_xor(m2, 1)); m2 = fmaxf(m2, __shfl_xor(m2, 2)); m2 = fmaxf(m2, __shfl_xor(m2, 4));
            const float gs = m1 + m2;
            const int myg = lane >> 3;
            int grank = 0;
#pragma unroll
            for (int g2 = 0; g2 < 8; ++g2) { const float o = __int_as_float(__builtin_amdgcn_readlane(__float_as_int(gs), g2 * 8)); grank += (o > gs || (o == gs && g2 < myg)) ? 1 : 0; }
            const bool gsel = grank < 4;
            const float msk = gsel ? bsd : -INFINITY;
            int erank = 0;
#pragma unroll
            for (int j = 0; j < 64; ++j) { const float o = __int_as_float(__builtin_amdgcn_readlane(__float_as_int(msk), j)); erank += (o > msk || (o == msk && j < lane)) ? 1 : 0; }
            const bool sel = gsel && erank < 8;
            const float wsum = wave_sum(sel ? s : 0.f);
            const unsigned long long selm = __ballot(sel);
            if (sel && !dry) {
                const int slot = __popcll(selm & ((1ull << lane) - 1ull));
                const unsigned pos = atomicAdd(&cnt[lane * 32], 1u);
                aep[(size_t)row * 8 + slot] = (int)((unsigned)lane << 24 | pos);
                ((int*)(p.ws + WS_RTOK))[(size_t)lane * NT + pos] = row;
                aw[(size_t)row * 8 + slot] = s / wsum * 2.5f;
            }
        }
    }
}

__device__ __forceinline__ void filt_unit(const P& p, int l, int u, char* lds) {
    const int tid = otid();
    float* feat = (float*)lds;
    float* h1 = feat + 4 * 36;
    float* h2 = h1 + 4 * 64;
    const int pp = tid >> 6, j = tid & 63;
    const int pi = u * 4 + pp;
    const int L = pi < 4096 ? 4096 : 256;
    const int t = pi < 4096 ? pi : pi - 4096;
    const float tt = (float)t / (float)(L - 1);
    if (j < 33) {
        float f;
        if (j == 0) f = tt;
        else {
            const int k = (j - 1) & 15;
            const float band = 1e-4f + (float)k * ((15.0f - 1e-4f) / 15.0f);
            float ph = band * (float)t * (1.f / (float)L);
            ph -= floorf(ph);
            float sn, cs; sincospif(2.f * ph, &sn, &cs);
            f = (j <= 16) ? cs : -sn;
        }
        feat[pp * 36 + j] = f;
    }
    __syncthreads();
    {
        const float* w1 = p.in(I_HY_W1) + (size_t)l * 33 * 64;
        float a = p.in(I_HY_B1)[l * 64 + j];
        for (int i = 0; i < 33; ++i) a += feat[pp * 36 + i] * w1[i * 64 + j];
        h1[pp * 64 + j] = sinf(p.in(I_HY_F1)[l * 64 + j] * a);
    }
    __syncthreads();
    {
        const float* w2 = p.in(I_HY_W2) + (size_t)l * 64 * 64;
        float a = p.in(I_HY_B2)[l * 64 + j];
        for (int i = 0; i < 64; ++i) a += h1[pp * 64 + i] * w2[i * 64 + j];
        h2[pp * 64 + j] = sinf(p.in(I_HY_F2)[l * 64 + j] * a);
    }
    __syncthreads();
    {
        const int c = tid;
        const float* w3 = p.in(I_HY_W3) + (size_t)l * 64 * 1024;
        float acc[4][4];
#pragma unroll
        for (int a = 0; a < 4; ++a)
#pragma unroll
            for (int b = 0; b < 4; ++b) acc[a][b] = 0.f;
        for (int i = 0; i < 64; ++i) {
            float wv[4];
#pragma unroll
            for (int os = 0; os < 4; ++os) wv[os] = w3[i * 1024 + os * 256 + c];
#pragma unroll
            for (int q = 0; q < 4; ++q) {
                const float hv = h2[q * 64 + i];
#pragma unroll
                for (int os = 0; os < 4; ++os) acc[q][os] += hv * wv[os];
            }
        }
        const float d0 = logf(0.01f) / 1.5f, d1 = logf(0.01f) / 0.3f;
        const float delta = fabsf(d0 + (d1 - d0) * ((float)c / 255.f));
#pragma unroll
        for (int q = 0; q < 4; ++q) {
            const int pq = u * 4 + q;
            const int Lq = pq < 4096 ? 4096 : 256;
            const int tq = pq < 4096 ? pq : pq - 4096;
            const float ttq = (float)tq / (float)(Lq - 1);
            const float dec = expf(-ttq * delta);
            float* F = (pq < 4096) ? (float*)(p.ws + WS_FILTL + l * SZ_FILTL) : (float*)(p.ws + WS_FILTC + l * SZ_FILTC);
#pragma unroll
            for (int os = 0; os < 4; ++os) {
                if (pq < 4096) F[((size_t)((os >> 1) * 256 + c) * 2 + (os & 1)) * 4096 + tq] = acc[q][os] * dec;
                else F[((size_t)os * 256 + c) * Lq + tq] = acc[q][os] * dec;
            }
        }
    }
    __syncthreads();
}

__device__ __forceinline__ void rwkv_prep_unit(const P& p, int l, int u, char* lds) {
    const int tid = otid();
    bf16_t* twb = (bf16_t*)lds;
    bf16_t* alb = twb + 32 * 72;
    bf16_t* ot = alb + 32 * 72;
    const bf16_t* z = (const bf16_t*)(p.ws + WS_Z);
    bf16_t* rwp = (bf16_t*)(p.ws + WS_R1 + R1_RWP);
    float* knorm = (float*)(p.ws + WS_KNORM);
    const int row0 = u * 32;
    {
        const int tok = tid >> 3, j0 = (tid & 7) * 8;
        const bf16_t* zr = z + (size_t)(row0 + tok) * ZS;
        float wl[8];
        unpack8(*reinterpret_cast<const uint4*>(zr + 768 + j0), wl);
#pragma unroll
        for (int i = 0; i < 8; ++i) wl[i] = 1.f - 2.f * __frcp_rn(1.f + __expf(2.f * wl[i]));
        *reinterpret_cast<uint4*>(twb + tok * 72 + j0) = pack8(wl);
        *reinterpret_cast<uint4*>(alb + tok * 72 + j0) = *reinterpret_cast<const uint4*>(zr + 832 + j0);
    }
    {
        const int tl = tid >> 5, cg = tid & 31, c0 = cg * 8;
        float kk[8];
#pragma unroll
        for (int i = 0; i < 8; ++i) kk[i] = p.in(I_RW_KK)[l * 256 + c0 + i];
#pragma unroll
        for (int it = 0; it < 4; ++it) {
            const int row = row0 + it * 8 + tl;
            float k[8];
            unpack8(*reinterpret_cast<const uint4*>(z + (size_t)row * ZS + 256 + c0), k);
            float ss = 0.f;
#pragma unroll
            for (int i = 0; i < 8; ++i) { const float kv = k[i] * kk[i]; ss += kv * kv; }
            ss = sum8lanes(ss);
            if ((cg & 7) == 0) knorm[(size_t)row * 4 + (cg >> 3)] = rsqrtf(ss + 1e-12f);
        }
    }
    __syncthreads();
    const int w = tid >> 6, lane = tid & 63, fr = lane & 15, fq = lane >> 4;
#pragma unroll 1
    for (int combo = 0; combo < 4; ++combo) {
        const int kind = combo >> 1, d = combo & 1;
        const bf16_t* At = kind ? alb : twb;
        const bf16_t* Bt = (const bf16_t*)(p.ws + (kind ? WS_LA2T : WS_LW2T)) + (size_t)l * 256 * 64;
        const float* basep = (kind ? p.in(I_RW_A0) : p.in(I_RW_W0)) + (l * 2 + d) * 256;
        bf16x8 af[2], bfr[4];
#pragma unroll
        for (int mf = 0; mf < 2; ++mf) af[mf] = *reinterpret_cast<const bf16x8*>(At + (mf * 16 + fr) * 72 + d * 32 + fq * 8);
#pragma unroll
        for (int nf = 0; nf < 4; ++nf) bfr[nf] = *reinterpret_cast<const bf16x8*>(Bt + (size_t)(w * 64 + nf * 16 + fr) * 64 + d * 32 + fq * 8);
#pragma unroll
        for (int nf = 0; nf < 4; ++nf) {
            const float base = basep[w * 64 + nf * 16 + fr];
#pragma unroll
            for (int mf = 0; mf < 2; ++mf) {
                const f32x4 acc = __builtin_amdgcn_mfma_f32_16x16x32_bf16(af[mf], bfr[nf], f32x4{0.f, 0.f, 0.f, 0.f}, 0, 0, 0);
#pragma unroll
                for (int j = 0; j < 4; ++j) {
                    const float a = base + acc[j];
                    float o;
                    if (kind) o = __frcp_rn(1.f + __expf(-a));
                    else { const float na = -a; const float sp = fmaxf(na, 0.f) + __logf(1.f + __expf(-fabsf(na))); o = __expf(-sp - 0.5f); }
                    ot[(mf * 16 + fq * 4 + j) * 264 + w * 64 + nf * 16 + fr] = f2bf(o);
                }
            }
        }
        __syncthreads();
#pragma unroll
        for (int i = 0; i < 4; ++i) {
            const int id = tid + 256 * i, tok = id >> 5, c8 = (id & 31) * 8;
            *reinterpret_cast<uint4*>(rwp + ((size_t)(row0 + tok) * 4 + combo) * 256 + c8) = *reinterpret_cast<const uint4*>(ot + tok * 264 + c8);
        }
        __syncthreads();
    }
}

__device__ __forceinline__ void gdn_prep_unit(const P& p, int l, int u) {
    const int tid = otid();
    const bf16_t* z = (const bf16_t*)(p.ws + WS_Z);
    bf16_t* gq = (bf16_t*)(p.ws + WS_R1 + R1_GQ);
    float* gab = (float*)(p.ws + WS_GAB);
    const int row0 = u * 32;
    int seq0, seqL;
    if (row0 < NTC) { seq0 = row0 & ~255; seqL = 256; } else { seq0 = NTC + ((row0 - NTC) & ~4095); seqL = 4096; }
    const int tl = tid >> 5, cg = tid & 31;
#pragma unroll 1
    for (int pz = 0; pz < 3; ++pz) {
        const int ch0 = pz * 256 + cg * 8;
        float w0[8], w1[8], w2[8];
        {
            const float* cw = p.in(I_GD_CONV) + (size_t)l * 3 * 768 + ch0;
#pragma unroll
            for (int i = 0; i < 8; i += 4) {
                const float4 a = *reinterpret_cast<const float4*>(cw + i), b = *reinterpret_cast<const float4*>(cw + 768 + i), c = *reinterpret_cast<const float4*>(cw + 1536 + i);
                w0[i] = a.x; w0[i + 1] = a.y; w0[i + 2] = a.z; w0[i + 3] = a.w;
                w1[i] = b.x; w1[i + 1] = b.y; w1[i + 2] = b.z; w1[i + 3] = b.w;
                w2[i] = c.x; w2[i + 1] = c.y; w2[i + 2] = c.z; w2[i + 3] = c.w;
            }
        }
#pragma unroll 2
        for (int it = 0; it < 4; ++it) {
            const int row = row0 + it * 8 + tl;
            const bf16_t* zc = z + (size_t)row * ZS + COL_GD + ch0;
            const uint4 zero4 = make_uint4(0u, 0u, 0u, 0u);
            const uint4 vm = (row - 1 >= seq0) ? *reinterpret_cast<const uint4*>(zc - ZS) : zero4;
            const uint4 v0 = *reinterpret_cast<const uint4*>(zc);
            const uint4 vp = (row + 1 < seq0 + seqL) ? *reinterpret_cast<const uint4*>(zc + ZS) : zero4;
            float xm[8], x0[8], xp[8], o[8];
            unpack8(vm, xm); unpack8(v0, x0); unpack8(vp, xp);
            float ss = 0.f;
#pragma unroll
            for (int i = 0; i < 8; ++i) { o[i] = siluf(w0[i] * xm[i] + w1[i] * x0[i] + w2[i] * xp[i]); ss += o[i] * o[i]; }
            if (pz < 2) {
                ss = sum8lanes(ss);
                const float sc = rsqrtf(ss + 1e-12f) * (pz == 0 ? 0.125f : 1.f);
#pragma unroll
                for (int i = 0; i < 8; ++i) o[i] *= sc;
            }
            *reinterpret_cast<uint4*>(gq + (size_t)row * 768 + ch0) = pack8(o);
        }
    }
    {
        const int tok = tid >> 3, dh = tid & 7;
        const int row = row0 + tok;
        const float alv = bf2f(z[(size_t)row * ZS + COL_GD + 1024 + dh]);
        const float blv = bf2f(z[(size_t)row * ZS + COL_GD + 1032 + dh]);
        const float g = -expf(p.in(I_GD_ALOG)[l * 8 + dh]) * softplusf(alv + p.in(I_GD_DTB)[l * 8 + dh]);
        gab[(size_t)row * 16 + dh] = expf(g);
        gab[(size_t)row * 16 + 8 + dh] = 1.f / (1.f + expf(-blv));
    }
}

__device__ __forceinline__ int s5_chain_row(int b, int d, int q) {
    if (q < 256) return b * 256 + (d ? 255 - q : q);
    int n = q - 256; if (d) n = 4095 - n;
    return NTC + b * 4096 + (n & 63) * 64 + (n >> 6);
}
__device__ __forceinline__ void s5_load_u(const bf16_t* zr, float* dst) {
    const uint4 a = *reinterpret_cast<const uint4*>(zr);
    const uint4 b = *reinterpret_cast<const uint4*>(zr + 8);
    *reinterpret_cast<float4*>(dst + 0) = make_float4(bflo(a.x), bfhi(a.x), bflo(a.y), bfhi(a.y));
    *reinterpret_cast<float4*>(dst + 4) = make_float4(bflo(a.z), bfhi(a.z), bflo(a.w), bfhi(a.w));
    *reinterpret_cast<float4*>(dst + 8) = make_float4(bflo(b.x), bfhi(b.x), bflo(b.y), bfhi(b.y));
    *reinterpret_cast<float4*>(dst + 12) = make_float4(bflo(b.z), bfhi(b.z), bflo(b.w), bfhi(b.w));
}

__device__ __forceinline__ void s5_pre_unit(const P& p, int l, int u, char* lds) {
    const int tid = otid(), w = tid >> 6, lane = tid & 63;
    float* ust = (float*)lds + w * 1024;
    const int wt = u * 4 + w;
    const int d = wt & 1, g = (wt >> 1) & 15, rest = wt >> 5;
    const int cc = rest % NCHUNK, b = rest / NCHUNK;
    const bf16_t* z = (const bf16_t*)(p.ws + WS_Z);
    {
        const int row = s5_chain_row(b, d, cc * 64 + lane);
        s5_load_u(z + (size_t)row * ZS + COL_S5 + g * 16, ust + lane * 16);
    }
    const int tix = ((l * 2 + d) * 16 + g) * 64 + lane;
    const float4 A = *reinterpret_cast<const float4*>((const float*)(p.ws + WS_S5A) + (size_t)tix * 4);
    const float* Bp = (const float*)(p.ws + WS_S5B) + (size_t)tix * 32;
    f32x2 bb[16];
#pragma unroll
    for (int h = 0; h < 16; ++h) bb[h] = f32x2{Bp[h], Bp[16 + h]};
    float xr = 0.f, xi = 0.f;
#pragma unroll 4
    for (int s = 0; s < 64; ++s) {
        f32x2 bu = f32x2{0.f, 0.f};
#pragma unroll
        for (int h4 = 0; h4 < 4; ++h4) {
            const float4 uu = *reinterpret_cast<const float4*>(ust + s * 16 + h4 * 4);
            bu += bb[h4 * 4] * uu.x + bb[h4 * 4 + 1] * uu.y + bb[h4 * 4 + 2] * uu.z + bb[h4 * 4 + 3] * uu.w;
        }
        const float nr = A.x * xr - A.y * xi + bu.x;
        const float ni = A.x * xi + A.y * xr + bu.y;
        xr = nr; xi = ni;
    }
    float* st = (float*)(p.ws + WS_S5ST) + ((((size_t)(b * NCHUNK + cc) * 2 + d) * 16 + g) * 64 + lane) * 2;
    st[0] = xr; st[1] = xi;
}

__device__ __forceinline__ float reduce16(const float (&t)[16], int lane) {
    float a[8];
    const bool hi8 = (lane & 8) != 0;
#pragma unroll
    for (int k = 0; k < 8; ++k) { const float keep = hi8 ? t[k + 8] : t[k]; const float send = hi8 ? t[k] : t[k + 8]; a[k] = keep + dppf<0x140>(send); }
    float b[4];
    const bool hi4 = (lane & 4) != 0;
#pragma unroll
    for (int k = 0; k < 4; ++k) { const float keep = hi4 ? a[k + 4] : a[k]; const float send = hi4 ? a[k] : a[k + 4]; b[k] = keep + dppf<0x141>(send); }
    float c[2];
    const bool hi2 = (lane & 2) != 0;
#pragma unroll
    for (int k = 0; k < 2; ++k) { const float keep = hi2 ? b[k + 2] : b[k]; const float send = hi2 ? b[k] : b[k + 2]; c[k] = keep + dppf<0x4E>(send); }
    const bool hi1 = (lane & 1) != 0;
    float r = (hi1 ? c[1] : c[0]) + dppf<0xB1>(hi1 ? c[0] : c[1]);
    r += __shfl_xor(r, 16);
    r += __shfl_xor(r, 32);
    return r;
}

__device__ __forceinline__ void s5_main_unit(const P& p, int l, int u, char* lds) {
    const int tid = otid(), w = tid >> 6, lane = tid & 63;
    char* wl = lds + w * 12800;
    float* ust = (float*)wl;
    char* xbuf = wl + 4096;
    float* yst = (float*)xbuf;
    const int b = u / NCHUNK, tc = u % NCHUNK;
    bf16_t* z = (bf16_t*)(p.ws + WS_Z);
    const int myrow = (tc < 4) ? (b * 256 + tc * 64 + lane) : (NTC + b * 4096 + lane * 64 + (tc - 4));
    const int fr = lane & 15, fq = lane >> 4;
#pragma unroll 1
    for (int gi = 0; gi < 4; ++gi) {
        const int g = w * 4 + gi;
        s5_load_u(z + (size_t)myrow * ZS + COL_S5 + g * 16, ust + lane * 16);
        f32x4 yacc[4];
#pragma unroll
        for (int mf = 0; mf < 4; ++mf) yacc[mf] = f32x4{0.f, 0.f, 0.f, 0.f};
#pragma unroll 1
        for (int d = 0; d < 2; ++d) {
            const int tix = ((l * 2 + d) * 16 + g) * 64 + lane;
            const float4 A = *reinterpret_cast<const float4*>((const float*)(p.ws + WS_S5A) + (size_t)tix * 4);
            const float* Bp = (const float*)(p.ws + WS_S5B) + (size_t)tix * 32;
            f32x2 bb[16];
#pragma unroll
            for (int h = 0; h < 16; ++h) bb[h] = f32x2{Bp[h], Bp[16 + h]};
            bf16x8 cfrag[4];
            {
                const float* crp = p.in(I_S5_CRE) + (size_t)((l * 2 + d) * 16 + g) * 1024 + fr * 64;
                const float* cip = p.in(I_S5_CIM) + (size_t)((l * 2 + d) * 16 + g) * 1024 + fr * 64;
#pragma unroll
                for (int ks = 0; ks < 4; ++ks) {
                    const int k0 = (ks & 1) * 32 + fq * 8;
                    const float* src = (ks < 2) ? crp + k0 : cip + k0;
                    const float sg = (ks < 2) ? 1.f : -1.f;
                    const float4 c0 = *reinterpret_cast<const float4*>(src), c1 = *reinterpret_cast<const float4*>(src + 4);
                    cfrag[ks][0] = (short)f2bf(sg * c0.x); cfrag[ks][1] = (short)f2bf(sg * c0.y); cfrag[ks][2] = (short)f2bf(sg * c0.z); cfrag[ks][3] = (short)f2bf(sg * c0.w);
                    cfrag[ks][4] = (short)f2bf(sg * c1.x); cfrag[ks][5] = (short)f2bf(sg * c1.y); cfrag[ks][6] = (short)f2bf(sg * c1.z); cfrag[ks][7] = (short)f2bf(sg * c1.w);
                }
            }
            const int cc = d ? ((tc < 4) ? 3 - tc : 71 - tc) : tc;
            float xr = 0.f, xi = 0.f;
            {
                const float* st = (const float*)(p.ws + WS_S5ST) + ((((size_t)(b * NCHUNK) * 2 + d) * 16 + g) * 64 + lane) * 2;
                for (int c0 = 0; c0 < cc; c0 += 8) {
                    float2 sv[8];
#pragma unroll
                    for (int q = 0; q < 8; ++q) {
                        const int c2 = (c0 + q < cc) ? c0 + q : cc - 1;
                        sv[q] = *reinterpret_cast<const float2*>(st + (size_t)c2 * (2 * 16 * 64 * 2));
                    }
#pragma unroll
                    for (int q = 0; q < 8; ++q) {
                        if (c0 + q < cc) {
                            const float nr = A.z * xr - A.w * xi + sv[q].x;
                            const float ni = A.z * xi + A.w * xr + sv[q].y;
                            xr = nr; xi = ni;
                        }
                    }
                }
            }
#pragma unroll 1
            for (int hf = 0; hf < 2; ++hf) {
                const int hbase = (d ? 1 - hf : hf) * 32;
#pragma unroll 4
                for (int s = 0; s < 32; ++s) {
                    const int il = d ? 31 - s : s;
                    const float* up = ust + (hbase + il) * 16;
                    f32x2 bu = f32x2{0.f, 0.f};
#pragma unroll
                    for (int h4 = 0; h4 < 4; ++h4) {
                        const float4 uu = *reinterpret_cast<const float4*>(up + h4 * 4);
                        bu += bb[h4 * 4] * uu.x + bb[h4 * 4 + 1] * uu.y + bb[h4 * 4 + 2] * uu.z + bb[h4 * 4 + 3] * uu.w;
                    }
                    const float nr = A.x * xr - A.y * xi + bu.x;
                    const float ni = A.x * xi + A.y * xr + bu.y;
                    xr = nr; xi = ni;
                    *reinterpret_cast<bf16_t*>(xbuf + il * 272 + lane * 2) = f2bf(xr);
                    *reinterpret_cast<bf16_t*>(xbuf + il * 272 + 128 + lane * 2) = f2bf(xi);
                }
#pragma unroll
                for (int mfl = 0; mfl < 2; ++mfl) {
                    f32x4 acc = yacc[0];
                    const int mf = (hbase >> 4) + mfl;
                    acc = (mf == 0) ? yacc[0] : (mf == 1) ? yacc[1] : (mf == 2) ? yacc[2] : yacc[3];
#pragma unroll
                    for (int ks = 0; ks < 4; ++ks) {
                        const bf16x8 af = *reinterpret_cast<const bf16x8*>(xbuf + (mfl * 16 + fr) * 272 + ks * 64 + fq * 16);
                        acc = __builtin_amdgcn_mfma_f32_16x16x32_bf16(af, cfrag[ks], acc, 0, 0, 0);
                    }
                    if (mf == 0) yacc[0] = acc; else if (mf == 1) yacc[1] = acc; else if (mf == 2) yacc[2] = acc; else yacc[3] = acc;
                }
            }
        }
#pragma unroll
        for (int mf = 0; mf < 4; ++mf)
#pragma unroll
            for (int j = 0; j < 4; ++j) yst[(mf * 16 + fq * 4 + j) * 16 + fr] = yacc[mf][j];
        {
            const float* dsk = p.in(I_S5_D) + l * 256 + g * 16;
            unsigned pk[8];
#pragma unroll
            for (int h = 0; h < 16; h += 2) {
                float y0 = yst[lane * 16 + h] + ust[lane * 16 + h] * dsk[h];
                float y1 = yst[lane * 16 + h + 1] + ust[lane * 16 + h + 1] * dsk[h + 1];
                y0 = 0.5f * y0 * (1.f + erff(y0 * 0.70710678118f));
                y1 = 0.5f * y1 * (1.f + erff(y1 * 0.70710678118f));
                pk[h >> 1] = pack2(y0, y1);
            }
            uint4* dst = reinterpret_cast<uint4*>((bf16_t*)(p.ws + WS_S5G) + (size_t)myrow * 256 + g * 16);
            dst[0] = make_uint4(pk[0], pk[1], pk[2], pk[3]);
            dst[1] = make_uint4(pk[4], pk[5], pk[6], pk[7]);
        }
    }
}

#define SB 16
__device__ __forceinline__ int scan_chain_row(int b, int d, int q) {
    if (q < 256) return b * 256 + (d ? 255 - q : q);
    const int t = q - 256;
    return NTC + b * 4096 + (d ? 4095 - t : t);
}
struct ScanRaw { uint2 r, k, v, e, a; float f0, f1; };

__device__ __forceinline__ void scan_load(const P& p, int m, int b, int h, int d, int q, int cg, ScanRaw& R) {
    const int row = scan_chain_row(b, d, q);
    const int c0 = h * 64 + cg * 4;
    if (m == 0) {
        const bf16_t* z = (const bf16_t*)(p.ws + WS_Z) + (size_t)row * ZS + c0;
        R.r = *reinterpret_cast<const uint2*>(z);
        R.k = *reinterpret_cast<const uint2*>(z + 256);
        R.v = *reinterpret_cast<const uint2*>(z + 512);
        const bf16_t* rw = (const bf16_t*)(p.ws + WS_R1 + R1_RWP) + (size_t)row * 1024 + c0;
        R.e = *reinterpret_cast<const uint2*>(rw + d * 256);
        R.a = *reinterpret_cast<const uint2*>(rw + (2 + d) * 256);
        R.f0 = ((const float*)(p.ws + WS_KNORM))[(size_t)row * 4 + h];
        R.f1 = 0.f;
    } else {
        const bf16_t* gq = (const bf16_t*)(p.ws + WS_R1 + R1_GQ) + (size_t)row * 768 + c0;
        R.r = *reinterpret_cast<const uint2*>(gq);
        R.k = *reinterpret_cast<const uint2*>(gq + 256);
        R.v = *reinterpret_cast<const uint2*>(gq + 512);
        R.e = make_uint2(0u, 0u); R.a = make_uint2(0u, 0u);
        const float* gab = (const float*)(p.ws + WS_GAB) + (size_t)row * 16;
        R.f0 = gab[d * 4 + h];
        R.f1 = gab[8 + d * 4 + h];
    }
}
__device__ __forceinline__ void scan_store(int m, const ScanRaw& R, float* dst  , const float (&kkp)[4], const float (&kap)[4]) {
    float r[4] = {bflo(R.r.x), bfhi(R.r.x), bflo(R.r.y), bfhi(R.r.y)};
    float k[4] = {bflo(R.k.x), bfhi(R.k.x), bflo(R.k.y), bfhi(R.k.y)};
    float v[4] = {bflo(R.v.x), bfhi(R.v.x), bflo(R.v.y), bfhi(R.v.y)};
    float ww[4], aa[4], bb[4], kk[4];
    if (m == 0) {
        float e[4] = {bflo(R.e.x), bfhi(R.e.x), bflo(R.e.y), bfhi(R.e.y)};
        float a[4] = {bflo(R.a.x), bfhi(R.a.x), bflo(R.a.y), bfhi(R.a.y)};
#pragma unroll
        for (int i = 0; i < 4; ++i) {
            ww[i] = __expf(-e[i]);
            kk[i] = k[i] * (1.f + (a[i] - 1.f) * kap[i]);
            const float kn = k[i] * kkp[i] * R.f0;
            aa[i] = -kn;
            bb[i] = kn * a[i];
        }
    } else {
        const float al = R.f0, be = R.f1;
#pragma unroll
        for (int i = 0; i < 4; ++i) { ww[i] = al; aa[i] = k[i]; bb[i] = -al * be * k[i]; kk[i] = be * k[i]; }
    }
    *reinterpret_cast<float4*>(dst + 0 * 64) = make_float4(ww[0], ww[1], ww[2], ww[3]);
    *reinterpret_cast<float4*>(dst + 1 * 64) = make_float4(aa[0], aa[1], aa[2], aa[3]);
    *reinterpret_cast<float4*>(dst + 2 * 64) = make_float4(bb[0], bb[1], bb[2], bb[3]);
    *reinterpret_cast<float4*>(dst + 3 * 64) = make_float4(kk[0], kk[1], kk[2], kk[3]);
    *reinterpret_cast<float4*>(dst + 4 * 64) = make_float4(r[0], r[1], r[2], r[3]);
    *reinterpret_cast<float4*>(dst + 5 * 64) = make_float4(v[0], v[1], v[2], v[3]);
}

__device__ __forceinline__ void scan_unit(const P& p, int l, int u, char* lds) {
    const int tid = otid();
    const int chain = u >> 1, half = u & 1;
    const int m = chain >> 6, rem = chain & 63, b = rem >> 3, h = (rem >> 1) & 3, d = rem & 1;
    float* buf = (float*)lds;
    float* ybuf = buf + 2 * SB * 384;
    const int rp = tid >> 4, sub = tid & 15;
    const int st = tid >> 4, cg = tid & 15;
    float kkp[4], kap[4];
#pragma unroll
    for (int i = 0; i < 4; ++i) { kkp[i] = p.in(I_RW_KK)[l * 256 + h * 64 + cg * 4 + i]; kap[i] = p.in(I_RW_KA)[l * 256 + h * 64 + cg * 4 + i]; }
    bf16_t* ys = (bf16_t*)(p.ws + WS_HBY) + (size_t)(m * 2 + d) * NT * 256;
    f32x2 S2[4];
#pragma unroll
    for (int j = 0; j < 4; ++j) S2[j] = f32x2{0.f, 0.f};
    ScanRaw R, R2;
    scan_load(p, m, b, h, d, st, cg, R);
    scan_store(m, R, buf + (st * 6) * 64 + cg * 4, kkp, kap);
    scan_load(p, m, b, h, d, SB + st, cg, R);
    __syncthreads();
    const int NB = 4352 / SB;
    __builtin_amdgcn_s_setprio(2);
    auto batch = [&](int bt, ScanRaw& Rld, ScanRaw& Rst) {
        const int par = bt & 1;
        if (bt + 2 < NB) scan_load(p, m, b, h, d, (bt + 2) * SB + st, cg, Rld);
        const float* cb = buf + par * (SB * 384);
        float* yb = ybuf + par * (SB * 32);
        {
            const float* sb0 = cb + sub * 4;
            const float* vb0 = cb + 320 + half * 32 + rp;
            float4 nw = *reinterpret_cast<const float4*>(sb0), na = *reinterpret_cast<const float4*>(sb0 + 64), nb = *reinterpret_cast<const float4*>(sb0 + 128);
            float4 nk = *reinterpret_cast<const float4*>(sb0 + 192), nr = *reinterpret_cast<const float4*>(sb0 + 256);
            float nvA = vb0[0], nvB = vb0[16];
            float4 mw = *reinterpret_cast<const float4*>(sb0 + 384), ma = *reinterpret_cast<const float4*>(sb0 + 384 + 64), mb = *reinterpret_cast<const float4*>(sb0 + 384 + 128);
            float4 mk = *reinterpret_cast<const float4*>(sb0 + 384 + 192), mr = *reinterpret_cast<const float4*>(sb0 + 384 + 256);
            float mvA = vb0[384], mvB = vb0[384 + 16];
#pragma unroll
            for (int s = 0; s < SB; ++s) {
                const float4 w = nw, a = na, bq = nb, k = nk, r = nr;
                const float vA = nvA, vB = nvB;
                nw = mw; na = ma; nb = mb; nk = mk; nr = mr; nvA = mvA; nvB = mvB;
                if (s + 2 < SB) {
                    const float* sb = sb0 + (s + 2) * 384;
                    mw = *reinterpret_cast<const float4*>(sb); ma = *reinterpret_cast<const float4*>(sb + 64); mb = *reinterpret_cast<const float4*>(sb + 128);
                    mk = *reinterpret_cast<const float4*>(sb + 192); mr = *reinterpret_cast<const float4*>(sb + 256);
                    mvA = vb0[(s + 2) * 384]; mvB = vb0[(s + 2) * 384 + 16];
                }
                __builtin_amdgcn_sched_barrier(0);
                const f32x2 v2 = {vA, vB};
                f32x2 sa2 = S2[0] * a.x + S2[1] * a.y + S2[2] * a.z + S2[3] * a.w;
                float sa = sa2.x, sb2 = sa2.y;
                dpp_allreduce16_x2(sa, sb2);
                sa2.x = sa; sa2.y = sb2;
                S2[0] = S2[0] * w.x + sa2 * bq.x + v2 * k.x;
                S2[1] = S2[1] * w.y + sa2 * bq.y + v2 * k.y;
                S2[2] = S2[2] * w.z + sa2 * bq.z + v2 * k.z;
                S2[3] = S2[3] * w.w + sa2 * bq.w + v2 * k.w;
                const f32x2 y2 = S2[0] * r.x + S2[1] * r.y + S2[2] * r.z + S2[3] * r.w;
                float yA = y2.x, yB = y2.y;
                dpp_allreduce16_x2(yA, yB);
                yb[s * 32 + rp] = yA; yb[s * 32 + 16 + rp] = yB;
            }
        }
        if (bt + 1 < NB) scan_store(m, Rst, buf + (1 - par) * (SB * 384) + (st * 6) * 64 + cg * 4, kkp, kap);
        __syncthreads();
        {
            const int r2 = cg * 2;
            const int row = scan_chain_row(b, d, bt * SB + st);
            const unsigned pk = pack2(yb[st * 32 + r2], yb[st * 32 + r2 + 1]);
            *reinterpret_cast<unsigned*>(ys + (size_t)row * 256 + h * 64 + half * 32 + r2) = pk;
        }
    };
#pragma unroll 1
    for (int bt = 0; bt < NB; bt += 2) { batch(bt, R2, R); batch(bt + 1, R, R2); }
    __builtin_amdgcn_s_setprio(0);
    __syncthreads();
}

__device__ __forceinline__ void scan_unit_gd2(const P& p, int l, int u, char* lds) {
    const int tid = otid();
    const int chain = 64 + (u >> 1), half = u & 1;
    const int m = chain >> 6, rem = chain & 63, b = rem >> 3, h = (rem >> 1) & 3, d = rem & 1;
    float* buf = (float*)lds;
    float* ybuf = buf + 2 * SB * 384;
    const int rp = tid >> 4, sub = tid & 15;
    const int st = tid >> 4, cg = tid & 15;
    float kkp[4], kap[4];
#pragma unroll
    for (int i = 0; i < 4; ++i) { kkp[i] = p.in(I_RW_KK)[l * 256 + h * 64 + cg * 4 + i]; kap[i] = p.in(I_RW_KA)[l * 256 + h * 64 + cg * 4 + i]; }
    bf16_t* ys = (bf16_t*)(p.ws + WS_HBY) + (size_t)(m * 2 + d) * NT * 256;
    f32x2 S2[4];
#pragma unroll
    for (int j = 0; j < 4; ++j) S2[j] = f32x2{0.f, 0.f};
    ScanRaw R, R2;
    scan_load(p, m, b, h, d, st, cg, R);
    scan_store(m, R, buf + (st * 6) * 64 + cg * 4, kkp, kap);
    scan_load(p, m, b, h, d, SB + st, cg, R);
    __syncthreads();
    const int NB = 4352 / SB;
    __builtin_amdgcn_s_setprio(2);
    auto batch = [&](int bt, ScanRaw& Rld, ScanRaw& Rst) {
        const int par = bt & 1;
        if (bt + 2 < NB) scan_load(p, m, b, h, d, (bt + 2) * SB + st, cg, Rld);
        const float* cb = buf + par * (SB * 384);
        float* yb = ybuf + par * (SB * 32);
        {
            const float* sb0 = cb + sub * 4;
            const float* vb0 = cb + 320 + half * 32 + rp;
            float4 na = *reinterpret_cast<const float4*>(sb0 + 64), nk = *reinterpret_cast<const float4*>(sb0 + 192), nr = *reinterpret_cast<const float4*>(sb0 + 256);
            float nal = cb[0], nvA = vb0[0], nvB = vb0[16];
            float4 ma = *reinterpret_cast<const float4*>(sb0 + 384 + 64), mk = *reinterpret_cast<const float4*>(sb0 + 384 + 192), mr = *reinterpret_cast<const float4*>(sb0 + 384 + 256);
            float mal = cb[384], mvA = vb0[384], mvB = vb0[384 + 16];
#pragma unroll
            for (int s = 0; s < SB; ++s) {
                const float4 a = na, k = nk, r = nr;
                const float al = nal, vA = nvA, vB = nvB;
                na = ma; nk = mk; nr = mr; nal = mal; nvA = mvA; nvB = mvB;
                if (s + 2 < SB) {
                    const float* sb = sb0 + (s + 2) * 384;
                    ma = *reinterpret_cast<const float4*>(sb + 64); mk = *reinterpret_cast<const float4*>(sb + 192); mr = *reinterpret_cast<const float4*>(sb + 256);
                    mal = cb[(s + 2) * 384]; mvA = vb0[(s + 2) * 384]; mvB = vb0[(s + 2) * 384 + 16];
                }
                __builtin_amdgcn_sched_barrier(0);
                const f32x2 v2 = {vA, vB};
                f32x2 d2 = S2[0] * a.x + S2[1] * a.y + S2[2] * a.z + S2[3] * a.w;
                float sa = d2.x, sb2 = d2.y;
                dpp_allreduce16_x2(sa, sb2);
                d2.x = sa; d2.y = sb2;
                const f32x2 e2 = v2 - d2 * al;
                S2[0] = S2[0] * al + e2 * k.x;
                S2[1] = S2[1] * al + e2 * k.y;
                S2[2] = S2[2] * al + e2 * k.z;
                S2[3] = S2[3] * al + e2 * k.w;
                const f32x2 y2 = S2[0] * r.x + S2[1] * r.y + S2[2] * r.z + S2[3] * r.w;
                float yA = y2.x, yB = y2.y;
                dpp_allreduce16_x2(yA, yB);
                yb[s * 32 + rp] = yA; yb[s * 32 + 16 + rp] = yB;
            }
        }
        if (bt + 1 < NB) scan_store(m, Rst, buf + (1 - par) * (SB * 384) + (st * 6) * 64 + cg * 4, kkp, kap);
        __syncthreads();
        {
            const int r2 = cg * 2;
            const int row = scan_chain_row(b, d, bt * SB + st);
            const unsigned pk = pack2(yb[st * 32 + r2], yb[st * 32 + r2 + 1]);
            *reinterpret_cast<unsigned*>(ys + (size_t)row * 256 + h * 64 + half * 32 + r2) = pk;
        }
    };
#pragma unroll 1
    for (int bt = 0; bt < NB; bt += 2) { batch(bt, R2, R); batch(bt + 1, R, R2); }
    __builtin_amdgcn_s_setprio(0);
    __syncthreads();
}

template <int L>
__device__ __forceinline__ void hyena_unit(const P& p, int l, int u, char* lds) {
    constexpr int TPT = L / 256;
    const int tid = otid();
    const int c = u >> 2, bp = u & 3;
    float2* u2 = (float2*)lds;
    float* taps = (float*)(lds + (size_t)L * 8);
    const bf16_t* z = (const bf16_t*)(p.ws + WS_Z);
    bf16_t* cat = (bf16_t*)(p.ws + WS_CAT);
    const float* F = (L == 4096) ? (const float*)(p.ws + WS_FILTL + l * SZ_FILTL) : (const float*)(p.ws + WS_FILTC + l * SZ_FILTC);
    int base[2];
#pragma unroll
    for (int bb = 0; bb < 2; ++bb) { const int b = bp * 2 + bb; base[bb] = (L == 4096) ? NTC + b * 4096 : b * 256; }
    const int t0 = tid * TPT;
    const float* cw = p.in(I_HY_CONV) + (size_t)l * 3 * 768; const float* cb = p.in(I_HY_CONVB) + (size_t)l * 768;
    auto sconv = [&](int part, int bb, float (&o)[TPT]) {
        const int ch = part * 256 + c;
        const float w0 = cw[ch], w1 = cw[768 + ch], w2 = cw[1536 + ch], bs = cb[ch];
        const bf16_t* zc = z + (size_t)base[bb] * ZS + COL_HY + ch;
        float xm = (t0 > 0) ? bf2f(zc[(size_t)(t0 - 1) * ZS]) : 0.f;
        float x0 = bf2f(zc[(size_t)t0 * ZS]);
#pragma unroll
        for (int i = 0; i < TPT; ++i) {
            const int t = t0 + i;
            const float xp = (t + 1 < L) ? bf2f(zc[(size_t)(t + 1) * ZS]) : 0.f;
            o[i] = w0 * xm + w1 * x0 + w2 * xp + bs;
            xm = x0; x0 = xp;
        }
    };
    {
        float v0[TPT], v1[TPT];
        sconv(2, 0, v0); sconv(2, 1, v1);
#pragma unroll
        for (int i = 0; i < TPT; ++i) u2[t0 + i] = make_float2(v0[i], v1[i]);
    }
#pragma unroll 1
    for (int o = 0; o < 2; ++o) {
        const float* hf = F + ((size_t)(o * 2 + 0) * 256 + c) * L;
        const float* hbk = F + ((size_t)(o * 2 + 1) * 256 + c) * L;
        for (int k = tid; k < 2 * L; k += NTHREADS) {
            const int dd = k - (L - 1);
            taps[k] = (dd >= L) ? 0.f : (dd >= 0 ? hf[dd] : hbk[-dd]);
        }
        __syncthreads();
        float acc[TPT][2];
#pragma unroll
        for (int i = 0; i < TPT; ++i) { acc[i][0] = 0.f; acc[i][1] = 0.f; }
        if (L == 4096) {
#pragma unroll 1
            for (int s0 = 0; s0 < L; s0 += 16) {
                const int k0 = t0 - s0 + (L - 16);
                float W[32];
#pragma unroll
                for (int q = 0; q < 8; ++q) {
                    const float4 t4 = *reinterpret_cast<const float4*>(taps + k0 + q * 4);
                    W[q * 4] = t4.x; W[q * 4 + 1] = t4.y; W[q * 4 + 2] = t4.z; W[q * 4 + 3] = t4.w;
                }
#pragma unroll
                for (int j = 0; j < 16; ++j) {
                    const float2 uj = u2[s0 + j];
#pragma unroll
                    for (int i = 0; i < TPT; ++i) {
                        const float wv = W[(i - j + 15) & 31];
                        acc[i][0] += wv * uj.x; acc[i][1] += wv * uj.y;
                    }
                }
            }
        } else {
            for (int s = 0; s < L; ++s) {
                const float2 uj = u2[s];
                const float wv = taps[t0 - s + (L - 1)];
                acc[0][0] += wv * uj.x; acc[0][1] += wv * uj.y;
            }
        }
        const float sk = p.in(I_HY_SKIP)[(size_t)(l * 2 + o) * 256 + c];
        float res[TPT][2];
        {
            float g0[TPT], g1[TPT];
            sconv(o, 0, g0); sconv(o, 1, g1);
#pragma unroll
            for (int i = 0; i < TPT; ++i) {
                const float2 ut = u2[t0 + i];
                res[i][0] = g0[i] * (acc[i][0] + sk * ut.x);
                res[i][1] = g1[i] * (acc[i][1] + sk * ut.y);
            }
        }
        __syncthreads();
        if (o == 0) {
#pragma unroll
            for (int i = 0; i < TPT; ++i) u2[t0 + i] = make_float2(res[i][0], res[i][1]);
        } else {
#pragma unroll
            for (int i = 0; i < TPT; ++i) {
                cat[(size_t)(base[0] + t0 + i) * DM + 512 + c] = f2bf(res[i][0]);
                cat[(size_t)(base[1] + t0 + i) * DM + 512 + c] = f2bf(res[i][1]);
            }
        }
        __syncthreads();
    }
}


#define FFT_BS 272
__device__ __forceinline__ int fphys(int d2, int d1, int d0) { return d2 * FFT_BS + d1 * 17 + d0; }
__device__ __forceinline__ float2 cmulf(float2 a, float2 b) { return make_float2(a.x * b.x - a.y * b.y, a.x * b.y + a.y * b.x); }
__device__ static constexpr float C32T[16] = {1.000000000e+00f, 9.807852804e-01f, 9.238795325e-01f, 8.314696123e-01f, 7.071067812e-01f, 5.555702330e-01f, 3.826834324e-01f, 1.950903220e-01f, 6.123233996e-17f, -1.950903220e-01f, -3.826834324e-01f, -5.555702330e-01f, -7.071067812e-01f, -8.314696123e-01f, -9.238795325e-01f, -9.807852804e-01f};
__device__ static constexpr float S32T[16] = {0.000000000e+00f, 1.950903220e-01f, 3.826834324e-01f, 5.555702330e-01f, 7.071067812e-01f, 8.314696123e-01f, 9.238795325e-01f, 9.807852804e-01f, 1.000000000e+00f, 9.807852804e-01f, 9.238795325e-01f, 8.314696123e-01f, 7.071067812e-01f, 5.555702330e-01f, 3.826834324e-01f, 1.950903220e-01f};
template <int LOG> __device__ __forceinline__ constexpr int brev(int i) { int r = 0; for (int b = 0; b < LOG; ++b) r |= ((i >> b) & 1) << (LOG - 1 - b); return r; }
template <int R, bool INV> __device__ __forceinline__ void dftR(float2 (&v)[R]) {
    constexpr int LOG = (R == 32) ? 5 : 4;
    float2 t[R];
#pragma unroll
    for (int i = 0; i < R; ++i) t[brev<LOG>(i)] = v[i];
#pragma unroll
    for (int st = 1; st <= LOG; ++st) {
        const int len = 1 << st, half = len >> 1;
#pragma unroll
        for (int i = 0; i < R; i += len)
#pragma unroll
            for (int j = 0; j < half; ++j) {
                const int tw = j * (32 / len);
                const float2 a = t[i + j], b = t[i + j + half];
                float2 bw;
                if (tw == 0) bw = b;
                else if (tw == 8) bw = INV ? make_float2(-b.y, b.x) : make_float2(b.y, -b.x);
                else { const float wr = C32T[tw], wi = INV ? S32T[tw] : -S32T[tw]; bw = make_float2(b.x * wr - b.y * wi, b.x * wi + b.y * wr); }
                t[i + j] = make_float2(a.x + bw.x, a.y + bw.y);
                t[i + j + half] = make_float2(a.x - bw.x, a.y - bw.y);
            }
    }
#pragma unroll
    for (int i = 0; i < R; ++i) v[i] = t[i];
}
template <int R> __device__ __forceinline__ void twiddle_pow(float2 (&v)[R], float2 first, float2 base) {
    float2 w = first;
#pragma unroll
    for (int k = 0; k < R; ++k) { v[k] = cmulf(v[k], w); w = cmulf(w, base); }
}
__device__ __forceinline__ float2 cispi(float x) { float sn, cs; sincospif(x, &sn, &cs); return make_float2(cs, sn); }

__device__ __forceinline__ void fft_fwd_A_B1(float2 (&v)[32], float2* buf, int tid_in) {
    int tid = tid_in; asm volatile("" : "+v"(tid));
    const int a = tid >> 4, b = tid & 15;
    dftR<32, false>(v);
    twiddle_pow<32>(v, make_float2(1.f, 0.f), cispi(-2.f * (float)tid * (1.f / 8192.f)));
#pragma unroll
    for (int k1 = 0; k1 < 32; ++k1) buf[fphys(k1, a, b)] = v[k1];
    __syncthreads();
#pragma unroll 1
    for (int j = 0; j < 2; ++j) {
        const int g = tid + 256 * j, k1 = g >> 4, bb = g & 15;
        float2 w[16];
#pragma unroll
        for (int aa = 0; aa < 16; ++aa) w[aa] = buf[fphys(k1, aa, bb)];
        dftR<16, false>(w);
        twiddle_pow<16>(w, make_float2(1.f, 0.f), cispi(-2.f * (float)bb * (1.f / 256.f)));
#pragma unroll
        for (int ka = 0; ka < 16; ++ka) buf[fphys(k1, ka, bb)] = w[ka];
    }
    __syncthreads();
}
__device__ __forceinline__ void fft_inv_B1_A(float2 (&v)[32], float2* buf, int tid_in) {
    int tid = tid_in; asm volatile("" : "+v"(tid));
#pragma unroll 1
    for (int j = 0; j < 2; ++j) {
        const int g = tid + 256 * j, k1 = g >> 4, bb = g & 15;
        float2 w[16];
#pragma unroll
        for (int ka = 0; ka < 16; ++ka) w[ka] = buf[fphys(k1, ka, bb)];
        dftR<16, true>(w);
        twiddle_pow<16>(w, cispi(2.f * (float)(k1 * bb) * (1.f / 8192.f)), cispi(2.f * (float)k1 * (1.f / 512.f)));
#pragma unroll
        for (int aa = 0; aa < 16; ++aa) buf[fphys(k1, aa, bb)] = w[aa];
    }
    __syncthreads();
    const int a = tid >> 4, b = tid & 15;
#pragma unroll
    for (int k1 = 0; k1 < 32; ++k1) v[k1] = buf[fphys(k1, a, b)];
    dftR<32, true>(v);
}

__device__ __forceinline__ void hfft_unit(const P& p, int l, int u, char* lds) {
    const int tid = otid();
    float2* buf = (float2*)lds;
    float* F = (float*)(p.ws + WS_FILTL + l * SZ_FILTL) + (size_t)u * 8192;
    float2 v[32];
#pragma unroll
    for (int n1 = 0; n1 < 32; ++n1) {
        const int n = 256 * n1 + tid;
        float x;
        if (n1 < 16) x = F[n];
        else x = (n == 4096) ? 0.f : F[4096 + (8192 - n)];
        if (n == 0) x += p.in(I_HY_SKIP)[(size_t)l * 512 + u];
        v[n1] = make_float2(x, 0.f);
    }
    fft_fwd_A_B1(v, buf, tid);
    __half2* H = (__half2*)F;
#pragma unroll 1
    for (int j = 0; j < 2; ++j) {
        const int g = tid + 256 * j, k1 = g >> 4, ka = g & 15;
        float2 w[16];
#pragma unroll
        for (int bb = 0; bb < 16; ++bb) w[bb] = buf[fphys(k1, ka, bb)];
        dftR<16, false>(w);
        unsigned pk[16];
#pragma unroll
        for (int kb = 0; kb < 16; ++kb) { const __half2 h = __floats2half2_rn(w[kb].x, w[kb].y); pk[kb] = *reinterpret_cast<const unsigned*>(&h); }
        uint4* dst = reinterpret_cast<uint4*>(H + (size_t)g * 16);
        dst[0] = make_uint4(pk[0], pk[1], pk[2], pk[3]); dst[1] = make_uint4(pk[4], pk[5], pk[6], pk[7]);
        dst[2] = make_uint4(pk[8], pk[9], pk[10], pk[11]); dst[3] = make_uint4(pk[12], pk[13], pk[14], pk[15]);
    }
    __syncthreads();
}

__device__ __forceinline__ void hyena_prep_unit(const P& p, int l, int u, char* lds) {
    const int tid = otid();
    bf16_t* tile = (bf16_t*)lds;
    const int b = u >> 6, t0 = (u & 63) * 64;
    const bf16_t* z = (const bf16_t*)(p.ws + WS_Z) + (size_t)(NTC + b * 4096) * ZS + COL_HY;
    bf16_t* hyT = (bf16_t*)(p.ws + WS_HYT);
    const float* cw = p.in(I_HY_CONV) + (size_t)l * 3 * 768; const float* cb = p.in(I_HY_CONVB) + (size_t)l * 768;
    const int tl = tid >> 5, cg = tid & 31;
#pragma unroll 1
    for (int part = 0; part < 3; ++part) {
        const int ch0 = part * 256 + cg * 8;
        float w0[8], w1[8], w2[8], bs[8];
#pragma unroll
        for (int i = 0; i < 8; ++i) { w0[i] = cw[ch0 + i]; w1[i] = cw[768 + ch0 + i]; w2[i] = cw[1536 + ch0 + i]; bs[i] = cb[ch0 + i]; }
#pragma unroll 2
        for (int it = 0; it < 8; ++it) {
            const int tk = it * 8 + tl, t = t0 + tk;
            const bf16_t* zc = z + (size_t)t * ZS + ch0;
            const uint4 zero4 = make_uint4(0u, 0u, 0u, 0u);
            const uint4 vm = (t > 0) ? *reinterpret_cast<const uint4*>(zc - ZS) : zero4;
            const uint4 v0 = *reinterpret_cast<const uint4*>(zc);
            const uint4 vp = (t + 1 < 4096) ? *reinterpret_cast<const uint4*>(zc + ZS) : zero4;
            float xm[8], x0[8], xp[8];
            unpack8(vm, xm); unpack8(v0, x0); unpack8(vp, xp);
#pragma unroll
            for (int i = 0; i < 8; ++i) tile[(cg * 8 + i) * 72 + tk] = f2bf(w0[i] * xm[i] + w1[i] * x0[i] + w2[i] * xp[i] + bs[i]);
        }
        __syncthreads();
#pragma unroll
        for (int k = 0; k < 8; ++k) {
            const int chl = (tid >> 3) + 32 * k, seg = tid & 7;
            const uint4 val = *reinterpret_cast<const uint4*>(tile + chl * 72 + seg * 8);
            *reinterpret_cast<uint4*>(hyT + ((size_t)(b * 3 + part) * 256 + chl) * 4096 + t0 + seg * 8) = val;
        }
        __syncthreads();
    }
}

template <int O>
__device__ __forceinline__ void hyena_conv_pass(const P& p, int l, int c, int bp, int tid, float2 (&v)[32], float2* buf) {
    const bf16_t* hyT = (const bf16_t*)(p.ws + WS_HYT);
#pragma unroll
    for (int j = 16; j < 32; ++j) v[j] = make_float2(0.f, 0.f);
    fft_fwd_A_B1(v, buf, tid);
    const __half2* H = (const __half2*)((const float*)(p.ws + WS_FILTL + l * SZ_FILTL) + (size_t)(O * 256 + c) * 8192);
    int tm = tid; asm volatile("" : "+v"(tm));
#pragma unroll 1
    for (int j = 0; j < 2; ++j) {
        const int g = tm + 256 * j, k1 = g >> 4, ka = g & 15;
        float2 w[16];
#pragma unroll
        for (int bb = 0; bb < 16; ++bb) w[bb] = buf[fphys(k1, ka, bb)];
        dftR<16, false>(w);
        const uint4* hp = reinterpret_cast<const uint4*>(H + (size_t)g * 16);
        unsigned hk[16];
#pragma unroll
        for (int q = 0; q < 4; ++q) { const uint4 t4 = hp[q]; hk[q * 4] = t4.x; hk[q * 4 + 1] = t4.y; hk[q * 4 + 2] = t4.z; hk[q * 4 + 3] = t4.w; }
#pragma unroll
        for (int kb = 0; kb < 16; ++kb) { const float2 hf = __half22float2(*reinterpret_cast<const __half2*>(&hk[kb])); w[kb] = cmulf(w[kb], hf); }
        dftR<16, true>(w);
        twiddle_pow<16>(w, make_float2(1.f, 0.f), cispi(2.f * (float)ka * (1.f / 256.f)));
#pragma unroll
        for (int bb = 0; bb < 16; ++bb) buf[fphys(k1, ka, bb)] = w[bb];
    }
    __syncthreads();
    fft_inv_B1_A(v, buf, tid);
    asm volatile("" ::: "memory");
    int tq = tid; asm volatile("" : "+v"(tq));
    const bf16_t* g0 = hyT + ((size_t)((bp * 2 + 0) * 3 + O) * 256 + c) * 4096 + tq;
    const bf16_t* g1 = hyT + ((size_t)((bp * 2 + 1) * 3 + O) * 256 + c) * 4096 + tq;
    const float sc = 1.f / 8192.f;
#pragma unroll
    for (int j = 0; j < 16; ++j) {
        const float ga = bf2f(g0[256 * j]) * sc, gb = bf2f(g1[256 * j]) * sc;
        v[j] = make_float2(ga * v[j].x, gb * v[j].y);
    }
    __syncthreads();
}

__device__ __forceinline__ void hyena_fft_unit(const P& p, int l, int u, char* lds) {
    const int tid = otid();
    const int c = u >> 2, bp = u & 3;
    float2* buf = (float2*)lds;
    const bf16_t* hyT = (const bf16_t*)(p.ws + WS_HYT);
    bf16_t* cat = (bf16_t*)(p.ws + WS_CAT);
    float2 v[32];
    {
        const bf16_t* v0p = hyT + ((size_t)((bp * 2 + 0) * 3 + 2) * 256 + c) * 4096 + tid;
        const bf16_t* v1p = hyT + ((size_t)((bp * 2 + 1) * 3 + 2) * 256 + c) * 4096 + tid;
#pragma unroll
        for (int j = 0; j < 16; ++j) v[j] = make_float2(bf2f(v0p[256 * j]), bf2f(v1p[256 * j]));
    }
    hyena_conv_pass<0>(p, l, c, bp, tid, v, buf);
    hyena_conv_pass<1>(p, l, c, bp, tid, v, buf);
    int tq = tid; asm volatile("" : "+v"(tq));
#pragma unroll
    for (int j = 0; j < 16; ++j) {
        const int t = tq + 256 * j;
        cat[(size_t)(NTC + (bp * 2 + 0) * 4096 + t) * DM + 512 + c] = f2bf(v[j].x);
        cat[(size_t)(NTC + (bp * 2 + 1) * 4096 + t) * DM + 512 + c] = f2bf(v[j].y);
    }
}

__device__ __forceinline__ void rwkv_post_unit(const P& p, int l, int u, char* lds) {
    const int tid = otid();
    bf16_t* sgb = (bf16_t*)lds;
    float* gt = (float*)(lds + 4608);
    const bf16_t* z = (const bf16_t*)(p.ws + WS_Z);
    const bf16_t* rwp = (const bf16_t*)(p.ws + WS_R1 + R1_RWP);
    const bf16_t* ys = (const bf16_t*)(p.ws + WS_HBY);
    bf16_t* cat = (bf16_t*)(p.ws + WS_CAT);
    const int row0 = u * 32;
    {
        const int tok = tid >> 3, j0 = (tid & 7) * 8;
        float gl[8];
        unpack8(*reinterpret_cast<const uint4*>(z + (size_t)(row0 + tok) * ZS + 896 + j0), gl);
#pragma unroll
        for (int i = 0; i < 8; ++i) gl[i] = sigm(gl[i]);
        *reinterpret_cast<uint4*>(sgb + tok * 72 + j0) = pack8(gl);
    }
    __syncthreads();
    {
        const int w = tid >> 6, lane = tid & 63, fr = lane & 15, fq = lane >> 4;
        const bf16_t* g2t = (const bf16_t*)(p.ws + WS_G2T) + (size_t)l * 256 * 64;
        f32x4 acc[2][4];
#pragma unroll
        for (int mf = 0; mf < 2; ++mf)
#pragma unroll
            for (int nf = 0; nf < 4; ++nf) acc[mf][nf] = f32x4{0.f, 0.f, 0.f, 0.f};
#pragma unroll
        for (int ks = 0; ks < 2; ++ks) {
            bf16x8 af[2], bfr[4];
#pragma unroll
            for (int mf = 0; mf < 2; ++mf) af[mf] = *reinterpret_cast<const bf16x8*>(sgb + (mf * 16 + fr) * 72 + ks * 32 + fq * 8);
#pragma unroll
            for (int nf = 0; nf < 4; ++nf) bfr[nf] = *reinterpret_cast<const bf16x8*>(g2t + (size_t)(w * 64 + nf * 16 + fr) * 64 + ks * 32 + fq * 8);
#pragma unroll
            for (int mf = 0; mf < 2; ++mf)
#pragma unroll
                for (int nf = 0; nf < 4; ++nf) acc[mf][nf] = __builtin_amdgcn_mfma_f32_16x16x32_bf16(af[mf], bfr[nf], acc[mf][nf], 0, 0, 0);
        }
#pragma unroll
        for (int mf = 0; mf < 2; ++mf)
#pragma unroll
            for (int nf = 0; nf < 4; ++nf)
#pragma unroll
                for (int j = 0; j < 4; ++j) gt[(mf * 16 + fq * 4 + j) * 264 + w * 64 + nf * 16 + fr] = acc[mf][nf][j];
    }
    __syncthreads();
    {
        const int tl = tid >> 5, cg = tid & 31, c0 = cg * 8;
        float ka[8], rk[8], gng[8], gnb[8];
#pragma unroll
        for (int i = 0; i < 8; ++i) {
            ka[i] = p.in(I_RW_KA)[l * 256 + c0 + i]; rk[i] = p.in(I_RW_RK)[l * 256 + c0 + i];
            gng[i] = p.in(I_RW_GNG)[l * 256 + c0 + i]; gnb[i] = p.in(I_RW_GNB)[l * 256 + c0 + i];
        }
#pragma unroll 2
        for (int it = 0; it < 4; ++it) {
            const int tok = it * 8 + tl, row = row0 + tok;
            float ya[8], yb[8], r[8], k[8], v[8], a0[8], a1[8], o[8];
            unpack8(*reinterpret_cast<const uint4*>(ys + (size_t)row * 256 + c0), ya);
            unpack8(*reinterpret_cast<const uint4*>(ys + (size_t)NT * 256 + (size_t)row * 256 + c0), yb);
            const bf16_t* zr = z + (size_t)row * ZS + c0;
            unpack8(*reinterpret_cast<const uint4*>(zr), r);
            unpack8(*reinterpret_cast<const uint4*>(zr + 256), k);
            unpack8(*reinterpret_cast<const uint4*>(zr + 512), v);
            unpack8(*reinterpret_cast<const uint4*>(rwp + ((size_t)row * 4 + 2) * 256 + c0), a0);
            unpack8(*reinterpret_cast<const uint4*>(rwp + ((size_t)row * 4 + 3) * 256 + c0), a1);
            float sy = 0.f, sd = 0.f;
#pragma unroll
            for (int i = 0; i < 8; ++i) {
                ya[i] += yb[i]; sy += ya[i];
                const float kd = k[i] * (1.f + (a0[i] - 1.f) * ka[i]) + k[i] * (1.f + (a1[i] - 1.f) * ka[i]);
                sd += r[i] * kd * rk[i];
            }
            const float mu = sum8lanes(sy) * (1.f / 64.f);
            const float dot = sum8lanes(sd);
            float sq = 0.f;
#pragma unroll
            for (int i = 0; i < 8; ++i) { ya[i] -= mu; sq += ya[i] * ya[i]; }
            const float rs = rsqrtf(sum8lanes(sq) * (1.f / 64.f) + 64e-5f);
            const float4 g0 = *reinterpret_cast<const float4*>(gt + tok * 264 + c0), g1 = *reinterpret_cast<const float4*>(gt + tok * 264 + c0 + 4);
            const float gg[8] = {g0.x, g0.y, g0.z, g0.w, g1.x, g1.y, g1.z, g1.w};
#pragma unroll
            for (int i = 0; i < 8; ++i) o[i] = (ya[i] * rs * gng[i] + gnb[i] + dot * v[i]) * gg[i];
            *reinterpret_cast<uint4*>(cat + (size_t)row * DM + c0) = pack8(o);
        }
    }
    __syncthreads();
}

__device__ __forceinline__ void gdn_post_unit(const P& p, int l, int u) {
    const int tid = otid();
    const bf16_t* z = (const bf16_t*)(p.ws + WS_Z);
    const bf16_t* ys = (const bf16_t*)(p.ws + WS_HBY) + (size_t)2 * NT * 256;
    bf16_t* cat = (bf16_t*)(p.ws + WS_CAT);
    const int tl = tid >> 5, cg = tid & 31, c0 = cg * 8;
    float ng[8];
#pragma unroll
    for (int i = 0; i < 8; ++i) ng[i] = p.in(I_GD_NORM)[l * 64 + ((c0 + i) & 63)];
    const int row0 = u * 32;
#pragma unroll 2
    for (int it = 0; it < 4; ++it) {
        const int row = row0 + it * 8 + tl;
        const uint4 a4 = *reinterpret_cast<const uint4*>(ys + (size_t)row * 256 + c0);
        const uint4 b4 = *reinterpret_cast<const uint4*>(ys + (size_t)NT * 256 + (size_t)row * 256 + c0);
        const uint4 z4 = *reinterpret_cast<const uint4*>(z + (size_t)row * ZS + COL_GD + 768 + c0);
        float a[8], b[8], zg[8], o[8];
        unpack8(a4, a); unpack8(b4, b); unpack8(z4, zg);
        float ss = 0.f;
#pragma unroll
        for (int i = 0; i < 8; ++i) { o[i] = a[i] + b[i]; ss += o[i] * o[i]; }
        ss = sum8lanes(ss);
        const float sc = rsqrtf(ss * (1.f / 64.f) + 1e-6f);
#pragma unroll
        for (int i = 0; i < 8; ++i) o[i] = o[i] * sc * ng[i] * siluf(zg[i]);
        *reinterpret_cast<uint4*>(cat + (size_t)row * DM + 256 + c0) = pack8(o);
    }
}

__device__ __forceinline__ void load_tile_bases(unsigned* ctl, int l, int* tb) {
    const int tid = otid();
    __syncthreads();
    if (tid < 64) { const int c = (int)xb_ld(&ctl[CW_CNT(l) + tid * 32]); tb[130 + tid] = c; tb[66 + tid] = (c + 127) >> 7; }
    __syncthreads();
    if (tid == 0) { int a = 0; for (int e = 0; e < 64; ++e) { tb[e] = a; a += tb[66 + e]; } tb[64] = a; }
    __syncthreads();
}

#define NPHASE 28
template <typename F>
__device__ __forceinline__ void strided(int n, F f) { for (int u = blockIdx.x; u < n; u += gridDim.x) f(u); }

__global__ void __launch_bounds__(NTHREADS, 2) fwd_kernel(KP kp) {
    extern __shared__ __attribute__((aligned(16))) char smem[];
    char* lds = smem + LDS_USER;
    {
    const int tid = otid();
    if (tid == 0) *reinterpret_cast<uint4*>(smem) = make_uint4(0u, 0u, 0u, 0u);
    if (tid < 52) { const unsigned long long v = (unsigned long long)kp.in[tid]; ((unsigned*)(smem + 512))[2 * tid] = (unsigned)v; ((unsigned*)(smem + 512))[2 * tid + 1] = (unsigned)(v >> 32); }
    }
    __syncthreads();
    P p; p.tab = (const __attribute__((address_space(3))) unsigned*)(smem + 512); p.out = kp.out; p.ws = kp.ws;
    unsigned* ctl = (unsigned*)(p.ws + WS_CTL);
    XcdBarrier bar = xcd_barrier_post(ctl, (volatile LAS unsigned*)smem);
    const int lo = kp.ph_lo, hi = kp.ph_hi;
#define PHASE_BEGIN(ph) if ((ph) >= lo && (ph) < hi) { if ((ph) > lo) { xcd_barrier(bar); }
#define PHASE_END }
#define LANE_IDS const int tid = otid(); const int wid = tid >> 6, lane = tid & 63, wr = wid >> 1, wc = wid & 1, fr = lane & 15, fq = lane >> 4; (void)wid; (void)lane; (void)wr; (void)wc; (void)fr; (void)fq;

    PHASE_BEGIN(0)
        strided(192 + 64 + 32 + 24 + 2 * 2112, [&](int u) {
            if (u >= 312) {
                const int v0 = u - 312, ll = v0 / 2112, v = v0 % 2112;
                if (v < 1088) filt_unit(p, ll, v, lds);
                else if (v < 1856) { const int t = v - 1088; xpose_tile(p.in(I_WIN) + (size_t)ll * 1024 * 3024, 3024, (bf16_t*)(p.ws + WS_WINT + ll * SZ_WINT), 1024, 0, t / 48, t % 48, lds); }
                else { const int t = v - 1856; xpose_tile(p.in(I_WOUT) + (size_t)ll * 1024 * 1024, 1024, (bf16_t*)(p.ws + WS_WOUTT + ll * SZ_WOUTT), 1024, 0, t >> 4, t & 15, lds); }
            }
            else if (u < 192) ph0_mod_unit(p, u, lds);
            else if (u < 256) ph0_s5tab_unit(p, u - 192);
            else if (u >= 288) { const int v = u - 288, which = v >> 3, ll = (v >> 2) & 1, t = v & 3;
                   const float* src = (which == 0 ? p.in(I_RW_G2) : which == 1 ? p.in(I_RW_W2) : p.in(I_RW_A2)) + (size_t)ll * 64 * 256;
                   bf16_t* dst = (bf16_t*)(p.ws + (which == 0 ? WS_G2T : which == 1 ? WS_LW2T : WS_LA2T)) + (size_t)ll * 256 * 64;
                   xpose_tile(src, 256, dst, 64, 0, 0, t, lds); }
            else { const int v = u - 256, ll = v >> 4, t = v & 15;
                   xpose_tile(p.in(I_S5_GLUW) + (size_t)ll * 65536, 256, (bf16_t*)(p.ws + WS_GLUT) + (size_t)ll * 65536, 256, 0, t >> 2, t & 3, lds); }
        });
    PHASE_END

#pragma unroll 1
    for (int l = 0; l < 2; ++l) {
        const int pb = 1 + 13 * l;
        PHASE_BEGIN(pb + 0)
            strided(4352, [&](int u) { if (l == 0) rows_unit<M_INIT>(p, l, u, lds); else rows_unit<M_LN2NEXT>(p, l, u, lds); });
        PHASE_END
        PHASE_BEGIN(pb + 1)
            strided(272 * 24, [&](int u) {
                LANE_IDS
                const int q_ = u >> 3, g_ = q_ / 12;
                const int mt = (g_ % 34) * 8 + (u & 7), nt = (g_ / 34) * 12 + (q_ % 12);
                f32x4 acc[4][4];
                gemm_tile((const bf16_t*)(p.ws + WS_HBY), DM, arows_lin(mt * 128, tid),
                          (const bf16_t*)(p.ws + WS_WINT + l * SZ_WINT), DM, nt * 128, DM, lds, acc);
                bf16_t* z = (bf16_t*)(p.ws + WS_Z);
#pragma unroll
                for (int m = 0; m < 4; ++m)
#pragma unroll
                    for (int n = 0; n < 4; ++n) {
                        const int col = nt * 128 + wc * 64 + n * 16 + fr;
                        if (col < ZS) {
#pragma unroll
                            for (int j = 0; j < 4; ++j) z[(size_t)(mt * 128 + wr * 64 + m * 16 + fq * 4 + j) * ZS + col] = f2bf(acc[m][n][j]);
                        }
                    }
            });
        PHASE_END
        PHASE_BEGIN(pb + 2)
            strided(512 + 512 + 1088 + 1088 + 4352, [&](int u) {
                if (u < 512) { if (kp.rep == 0) hfft_unit(p, l, u, lds); }
                else if (u < 1024) hyena_prep_unit(p, l, u - 512, lds);
                else if (u < 2112) rwkv_prep_unit(p, l, u - 1024, lds);
                else if (u < 3200) gdn_prep_unit(p, l, u - 2112);
                else s5_pre_unit(p, l, u - 3200, lds);
            });
        PHASE_END
        PHASE_BEGIN(pb + 3)
            {
                int* qslot = (int*)(smem + 64);
                const int NO = 1024 + 544 + 1024;
                if (otid() == 0) {
                    const unsigned hw = (unsigned)__builtin_amdgcn_s_getreg((7 << 11) | (8 << 6) | 4);
                    const unsigned cuix = ((xb_xcc_id() & 15u) << 8) | (hw & 255u);
                    qslot[1] = (atomicAdd(&ctl[CW_CUCNT(l) + cuix], 1u) % 2u == 0u) ? 0 : 1;
                }
                __syncthreads();
                for (;;) {
                    if (otid() == 0) {
                        int stage = qslot[1], t = -1;
                        while (t < 0 && stage < 3) {
                            if (stage == 1) { const int q = (int)atomicAdd(&ctl[CW_QUEUE(l) + 16 + kp.rep], 1u); if (q < NO) t = 256 + (q < 544 ? 1024 + q : (q < 1568 ? q - 544 : q)); else stage = 2; }
                            else { const int q = (int)atomicAdd(&ctl[CW_QUEUE(l) + kp.rep], 1u); if (q < 256) t = q; else stage = (stage == 0) ? 1 : 3; }
                        }
                        qslot[1] = stage; qslot[0] = t;
                    }
                    __syncthreads();
                    const int u = qslot[0];
                    __syncthreads();
                    if (u < 0) break;
                    if (u < 128) { if (kp.rep != 2) scan_unit_gd2(p, l, u, lds); }
                    else if (u < 256) { if (kp.rep != 2) scan_unit(p, l, u - 128, lds); }
                    else if (kp.rep == 1) {}
                    else if (u < 1280) hyena_fft_unit(p, l, u - 256, lds);
                    else if (u < 1824) s5_main_unit(p, l, u - 1280, lds);
                    else hyena_unit<256>(p, l, u - 1824, lds);
                    __syncthreads();
                }
            }
        PHASE_END
        PHASE_BEGIN(pb + 4)
            strided(1088 + 1088 + 544, [&](int u) {
                if (u < 1088) rwkv_post_unit(p, l, u, lds);
                else if (u < 2176) gdn_post_unit(p, l, u - 1088);
                else {
                    LANE_IDS
                    const int v = u - 2176, mt = v >> 1, nt = v & 1;
                    f32x4 acc[4][4];
                    const bf16_t* A = (const bf16_t*)(p.ws + WS_S5G);
                    gemm_tile(A, 256, arows_lin(mt * 128, tid),
                              (const bf16_t*)(p.ws + WS_GLUT) + (size_t)l * 65536, 256, nt * 128, 256, lds, acc);
                    bf16_t* cat = (bf16_t*)(p.ws + WS_CAT);
#pragma unroll
                    for (int m = 0; m < 4; ++m)
#pragma unroll
                        for (int n = 0; n < 4; ++n) {
                            const int col = nt * 128 + wc * 64 + n * 16 + fr;
                            const float gb = p.in(I_S5_GLUB)[l * 256 + col];
#pragma unroll
                            for (int j = 0; j < 4; ++j) {
                                const int row = mt * 128 + wr * 64 + m * 16 + fq * 4 + j;
                                const float yg = bf2f(A[(size_t)row * 256 + col]);
                                cat[(size_t)row * DM + 768 + col] = f2bf(yg * sigm(acc[m][n][j] + gb));
                            }
                        }
                }
            });
        PHASE_END
        PHASE_BEGIN(pb + 5)
            strided(136 * 40, [&](int u0) {
                const int grp = u0 / 40, rr_ = u0 % 40;
                const int u = (rr_ < 16) ? grp * 16 + rr_ : 2176 + grp * 24 + (rr_ - 16);
                if (u >= 2176 + 65 * 48) return;
                if (u < 2176) {
                    LANE_IDS
                    const int mt = ((u >> 3) >> 3) * 8 + (u & 7), nt = (u >> 3) & 7;
                    f32x4 acc[4][4];
                    gemm_tile((const bf16_t*)(p.ws + WS_CAT), DM, arows_lin(mt * 128, tid),
                              (const bf16_t*)(p.ws + WS_WOUTT + l * SZ_WOUTT), DM, nt * 128, DM, lds, acc);
#pragma unroll
                    for (int m = 0; m < 4; ++m)
#pragma unroll
                        for (int j = 0; j < 4; ++j) {
                            const int row = mt * 128 + wr * 64 + m * 16 + fq * 4 + j;
                            float* xr = xrow(p, row);
                            const float* xs = (l == 0 && kp.rep == 0) ? (row < NTC ? p.in(I_CTX) + (size_t)row * DM : p.in(I_X) + (size_t)(row - NTC) * DM) : xr;
                            const float* ga = modp(p, l, row_mod(row), 2);
#pragma unroll
                            for (int n = 0; n < 4; ++n) {
                                const int col = nt * 128 + wc * 64 + n * 16 + fr;
                                { const float ca = kp.rep ? 1.f : ALPHA, cb2 = kp.rep ? 0.f : 1.f; xr[col] = ca * xs[col] + cb2 * ga[col] * acc[m][n][j]; }
                            }
                        }
                } else {
                    const int v = u - 2176, e = v / 48, t = v % 48, which = t >> 4, tt = t & 15;
                    bf16_t* W13 = (bf16_t*)(p.ws + WS_R1 + R1_W13T) + (size_t)e * 512 * 1024;
                    bf16_t* W2 = (bf16_t*)(p.ws + WS_R1 + R1_W2T) + (size_t)e * 1024 * 256;
                    if (which == 0) {
                        const float* src = (e < 64) ? p.in(I_EX_W1) + ((size_t)l * 64 + e) * 262144 : p.in(I_SH_W1) + (size_t)l * 262144;
                        xpose_strip4(src, 256, W13, 1024, 1, tt, 0, lds);
                    } else if (which == 1) {
                        const float* src = (e < 64) ? p.in(I_EX_W3) + ((size_t)l * 64 + e) * 262144 : p.in(I_SH_W3) + (size_t)l * 262144;
                        xpose_strip4(src, 256, W13, 1024, 2, tt, 0, lds);
                    } else {
                        const float* src = (e < 64) ? p.in(I_EX_W2) + ((size_t)l * 64 + e) * 262144 : p.in(I_SH_W2) + (size_t)l * 262144;
                        xpose_strip4(src, 1024, W2, 256, 0, tt >> 2, (tt & 3) * 4, lds);
                    }
                }
            });
        PHASE_END
        PHASE_BEGIN(pb + 6)
            strided(2176, [&](int u) { rows_unit<M_LN1>(p, l, u, lds, kp.rep); __syncthreads(); });
        PHASE_END
        PHASE_BEGIN(pb + 8)
            {
                int* tbs = (int*)(smem + 1024);
                load_tile_bases(ctl, l, tbs);
                const int ntr = tbs[64];
                const int* rtok = (const int*)(p.ws + WS_RTOK);
                const int ntl1 = ntr + 272;
                strided(((ntl1 + 7) >> 3) * 32, [&](int u) {
                    const int tile = ((u >> 3) >> 2) * 8 + (u & 7), jn = (u >> 3) & 3;
                    if (tile >= ntl1) return;
                    LANE_IDS
                    int e, obase; ARows ar;
                    if (tile < ntr) {
                        e = 0;
#pragma unroll 1
                        for (int s2 = 32; s2 >= 1; s2 >>= 1) if (tbs[e + s2] <= tile) e += s2;
                        obase = tile * 128;
                        const int pos0 = (tile - tbs[e]) * 128, ce = tbs[130 + e];
#pragma unroll
                        for (int i = 0; i < 4; ++i) { const int ps = pos0 + (tid >> 3) + 32 * i; ar.r[i] = (ps < ce) ? rtok[(size_t)e * NT + ps] : 0; }
                    } else {
                        const int stt = tile - ntr; e = 64; obase = (SH_TILE_BASE + stt) * 128;
                        ar = arows_lin(stt * 128, tid);
                    }
                    f32x4 acc[4][4];
                    gemm_tile((const bf16_t*)(p.ws + WS_HBY), DM, ar,
                              (const bf16_t*)(p.ws + WS_R1 + R1_W13T) + (size_t)e * 512 * 1024, DM, jn * 128, DM, lds, acc);
                    bf16_t* act = (bf16_t*)(p.ws + WS_ACT);
#pragma unroll
                    for (int m = 0; m < 4; ++m)
#pragma unroll
                        for (int pp = 0; pp < 2; ++pp)
#pragma unroll
                            for (int j = 0; j < 4; ++j) {
                                const float g = acc[m][2 * pp][j], uu = acc[m][2 * pp + 1][j];
                                const int orow = obase + wr * 64 + m * 16 + fq * 4 + j;
                                const int col = jn * 64 + wc * 32 + pp * 16 + fr;
                                act[(size_t)orow * 256 + col] = f2bf(siluf(g) * uu);
                            }
                });
            }
        PHASE_END
#pragma unroll 1
        for (int sl = 0; sl < 2; ++sl) {
            PHASE_BEGIN(pb + 9 + 2 * sl)
            {
                int* tbs = (int*)(smem + 1024);
                load_tile_bases(ctl, l, tbs);
                const int ntr = tbs[64];
                const int ntl2 = ntr + 272;
                strided(((ntl2 + 7) >> 3) * 32, [&](int u) {
                    const int tile = ((u >> 3) >> 2) * 8 + (u & 7), nt4 = (u >> 3) & 3;
                    if (tile >= ntl2) return;
                    LANE_IDS
                    int e, obase;
                    if (tile < ntr) {
                        e = 0;
#pragma unroll 1
                        for (int s2 = 32; s2 >= 1; s2 >>= 1) if (tbs[e + s2] <= tile) e += s2;
                        obase = tile * 128;
                    }
                    else { e = 64; obase = (SH_TILE_BASE + tile - ntr) * 128; }
                    f32x4 acc[4][4];
                    gemm_tile((const bf16_t*)(p.ws + WS_ACT), 256, arows_lin(obase, tid),
                              (const bf16_t*)(p.ws + WS_R1 + R1_W2T) + (size_t)e * 1024 * 256, 256, sl * 512 + nt4 * 128, 256, lds, acc);
                    unsigned char* ot = (unsigned char*)lds;
#pragma unroll
                    for (int m = 0; m < 4; ++m)
#pragma unroll
                        for (int n = 0; n < 4; ++n)
#pragma unroll
                            for (int j = 0; j < 4; ++j) {
                                const float v16 = fminf(fmaxf(acc[m][n][j] * 16.f, -440.f), 440.f);
                                ot[(wr * 64 + m * 16 + fq * 4 + j) * 144 + wc * 64 + n * 16 + fr] = (unsigned char)(__builtin_amdgcn_cvt_pk_fp8_f32(v16, v16, 0, false) & 0xFF);
                            }
                    __syncthreads();
                    unsigned char* y2 = (unsigned char*)(p.ws + WS_Y2);
#pragma unroll
                    for (int i = 0; i < 4; ++i) {
                        const int id = tid + 256 * i, r = id >> 3, c16 = (id & 7) * 16;
                        *reinterpret_cast<uint4*>(y2 + (size_t)(obase + r) * 512 + nt4 * 128 + c16) = *reinterpret_cast<const uint4*>(ot + r * 144 + c16);
                    }
                    __syncthreads();
                });
            }
            PHASE_END
            if (!(l == 1 && sl == 1)) {
            PHASE_BEGIN(pb + 10 + 2 * sl)
            {
                int* tb = (int*)lds;
                const int tid = otid();
                load_tile_bases(ctl, l, tb);
                const int* aep = (const int*)(p.ws + WS_AEP); const float* aw = (const float*)(p.ws + WS_AW);
                const unsigned char* y2 = (const unsigned char*)(p.ws + WS_Y2);
                const int tl = tid >> 5, cg = tid & 31;
                for (int grp = blockIdx.x; grp < NT / 8; grp += gridDim.x) {
                    const int tok = grp * 8 + tl;
                    float a16[16];
                    {
                        const uint4 sv = *reinterpret_cast<const uint4*>(y2 + ((size_t)(SH_TILE_BASE * 128 + tok)) * 512 + cg * 16);
                        const unsigned wv[4] = {sv.x, sv.y, sv.z, sv.w};
#pragma unroll
                        for (int q = 0; q < 4; ++q) {
                            a16[q * 4 + 0] = __builtin_amdgcn_cvt_f32_fp8((int)wv[q], 0); a16[q * 4 + 1] = __builtin_amdgcn_cvt_f32_fp8((int)wv[q], 1);
                            a16[q * 4 + 2] = __builtin_amdgcn_cvt_f32_fp8((int)wv[q], 2); a16[q * 4 + 3] = __builtin_amdgcn_cvt_f32_fp8((int)wv[q], 3);
                        }
                    }
#pragma unroll
                    for (int k = 0; k < 8; ++k) {
                        const unsigned v = (unsigned)aep[(size_t)tok * 8 + k];
                        const float wk = aw[(size_t)tok * 8 + k];
                        const int dest = tb[v >> 24] * 128 + (int)(v & 0xFFFFFFu);
                        const uint4 yv = *reinterpret_cast<const uint4*>(y2 + (size_t)dest * 512 + cg * 16);
                        const unsigned wv[4] = {yv.x, yv.y, yv.z, yv.w};
#pragma unroll
                        for (int q = 0; q < 4; ++q) {
                            a16[q * 4 + 0] += wk * __builtin_amdgcn_cvt_f32_fp8((int)wv[q], 0); a16[q * 4 + 1] += wk * __builtin_amdgcn_cvt_f32_fp8((int)wv[q], 1);
                            a16[q * 4 + 2] += wk * __builtin_amdgcn_cvt_f32_fp8((int)wv[q], 2); a16[q * 4 + 3] += wk * __builtin_amdgcn_cvt_f32_fp8((int)wv[q], 3);
                        }
                    }
                    float* xr = xrow(p, tok) + sl * 512 + cg * 16;
                    const float* ga = modp(p, l, row_mod(tok), 5) + sl * 512 + cg * 16;
                    const float rs = kp.rep ? 0.f : (1.f / 16.f);
#pragma unroll
                    for (int q = 0; q < 4; ++q) {
                        float4 x4 = *reinterpret_cast<const float4*>(xr + q * 4);
                        const float4 g4 = *reinterpret_cast<const float4*>(ga + q * 4);
                        x4.x += rs * g4.x * a16[q * 4 + 0]; x4.y += rs * g4.y * a16[q * 4 + 1]; x4.z += rs * g4.z * a16[q * 4 + 2]; x4.w += rs * g4.w * a16[q * 4 + 3];
                        *reinterpret_cast<float4*>(xr + q * 4) = x4;
                    }
                }
                __syncthreads();
            }
            PHASE_END
            }
        }
    }
#if defined(PROBE_PH)
    if (lo >= 100) {
        float a0 = (float)otid(), a1 = a0 + 1.f, a2 = a0 + 2.f, a3 = a0 + 3.f, a4 = a0 + 4.f, a5 = a0 + 5.f, a6 = a0 + 6.f, a7 = a0 + 7.f;
        const float m = 0.999f, c = 0.5f;
        for (int it = 0; it < 10000; ++it) {
            if (lo == 100) {
#pragma unroll
                for (int q = 0; q < 64; ++q) asm volatile("v_fma_f32 %0, %0, %1, %2" : "+v"(a0) : "v"(m), "v"(c));
            } else {
#pragma unroll
                for (int q = 0; q < 8; ++q) {
                    asm volatile("v_fma_f32 %0, %0, %1, %2" : "+v"(a0) : "v"(m), "v"(c)); asm volatile("v_fma_f32 %0, %0, %1, %2" : "+v"(a1) : "v"(m), "v"(c));
                    asm volatile("v_fma_f32 %0, %0, %1, %2" : "+v"(a2) : "v"(m), "v"(c)); asm volatile("v_fma_f32 %0, %0, %1, %2" : "+v"(a3) : "v"(m), "v"(c));
                    asm volatile("v_fma_f32 %0, %0, %1, %2" : "+v"(a4) : "v"(m), "v"(c)); asm volatile("v_fma_f32 %0, %0, %1, %2" : "+v"(a5) : "v"(m), "v"(c));
                    asm volatile("v_fma_f32 %0, %0, %1, %2" : "+v"(a6) : "v"(m), "v"(c)); asm volatile("v_fma_f32 %0, %0, %1, %2" : "+v"(a7) : "v"(m), "v"(c));
                }
            }
        }
        if (a0 + a1 + a2 + a3 + a4 + a5 + a6 + a7 == 12345.678f) ctl[60] = 1u;
    }
#endif
    PHASE_BEGIN(27)
        load_tile_bases(ctl, 1, (int*)(smem + 1024));
        strided(4352, [&](int u) { rows_unit<M_FINAL>(p, 1, u, lds); });
    PHASE_END
}

#ifndef N_LAUNCH_MODE
#define N_LAUNCH_MODE 1
#endif
extern "C" void kernel_launch(void* const* d_in, const int* in_sizes, int n_in, void* d_out, int out_size, void* d_ws, size_t ws_size, hipStream_t stream) {
    static int grid = 0;
    if (grid == 0) {
        if (n_in != 52 || out_size != NTL * DM || ws_size < WS_END) { fprintf(stderr, "kernel_launch: unexpected shapes (n_in %d out %d ws %zu need %zu)\n", n_in, out_size, ws_size, (size_t)WS_END); grid = -1; return; }
        int dev = 0, cus = 0, per_cu = 0;
        hipGetDevice(&dev);
        hipDeviceGetAttribute(&cus, hipDeviceAttributeMultiprocessorCount, dev);
        hipFuncSetAttribute((const void*)fwd_kernel, hipFuncAttributeMaxDynamicSharedMemorySize, LDS_BYTES);
        hipOccupancyMaxActiveBlocksPerMultiprocessor(&per_cu, (const void*)fwd_kernel, NTHREADS, LDS_BYTES);
        (void)hipGetLastError();
        if (per_cu < 1) per_cu = 1;
        if (per_cu > 2) per_cu = 2;
        grid = cus * per_cu;
    }
    if (grid < 0) return;
    hipMemsetAsync((char*)d_ws + WS_CTL, 0, CTL_BYTES, stream);
    KP p{};
    for (int i = 0; i < 52; ++i) p.in[i] = (const float*)d_in[i];
    p.out = (float*)d_out; p.ws = (char*)d_ws;
#if defined(PROBE_PH)
    for (int ph = 0; ph < NPHASE; ++ph) {
        const int reps = (ph == PROBE_PH) ? 1 + PROBE_N : 1;
        for (int r = 0; r < reps; ++r) { p.ph_lo = ph; p.ph_hi = ph + 1; p.rep = r; hipLaunchKernelGGL(fwd_kernel, dim3(grid), dim3(NTHREADS), LDS_BYTES, stream, p); }
    }
    if (PROBE_PH >= 100) { p.ph_lo = PROBE_PH; p.ph_hi = PROBE_PH + 1; p.rep = 0; hipLaunchKernelGGL(fwd_kernel, dim3(PROBE_N), dim3(NTHREADS), LDS_BYTES, stream, p); }
#elif N_LAUNCH_MODE == 1
    p.ph_lo = 0; p.ph_hi = NPHASE;
    hipLaunchKernelGGL(fwd_kernel, dim3(grid), dim3(NTHREADS), LDS_BYTES, stream, p);
#else
    for (int ph = 0; ph < NPHASE; ++ph) {
        p.ph_lo = ph; p.ph_hi = ph + 1;
        hipLaunchKernelGGL(fwd_kernel, dim3(grid), dim3(NTHREADS), LDS_BYTES, stream, p);
    }
#endif
}
```

```cpp
#include <hip/hip_runtime.h>
#include <hip/hip_bf16.h>
#include <hip/hip_fp16.h>
#include <stdint.h>
#include <stdio.h>

typedef unsigned short bf16_t;
using bf16x8 = __attribute__((ext_vector_type(8))) short;
using bf16x4 = __attribute__((ext_vector_type(4))) short;
using f32x4 = __attribute__((ext_vector_type(4))) float;
using f32x2 = __attribute__((ext_vector_type(2))) float;

#define NTC 2048
#define NTL 32768
#define NT 34816
#define DM 1024
#define ZS 3024
#define COL_GD 960
#define COL_HY 2000
#define COL_S5 2768
#define NCHUNK 68
#define ALPHA 1.41421356237f
#define NTHREADS 256
#define LDS_BYTES 73728
#define LDS_USER 2048
#define SH_TILE_BASE 2240
#define ACT_ROWS ((SH_TILE_BASE + 272) * 128)

constexpr size_t al256(size_t x) { return (x + 255) & ~(size_t)255; }
constexpr size_t WS_CTL = 0;
constexpr size_t CTL_BYTES = 131072;
constexpr size_t WS_MOD = WS_CTL + CTL_BYTES;
constexpr size_t WS_S5A = al256(WS_MOD + 2 * 9 * 6144 * 4);
constexpr size_t WS_S5B = al256(WS_S5A + 2 * 2 * 16 * 64 * 4 * 4);
constexpr size_t WS_GLUT = al256(WS_S5B + 2 * 2 * 16 * 64 * 32 * 4);
constexpr size_t WS_G2T = al256(WS_GLUT + 2 * 256 * 256 * 2);
constexpr size_t WS_LW2T = al256(WS_G2T + 2 * 256 * 64 * 2);
constexpr size_t WS_LA2T = al256(WS_LW2T + 2 * 256 * 64 * 2);
constexpr size_t SZ_WINT = (size_t)3072 * 1024 * 2, SZ_WOUTT = (size_t)1024 * 1024 * 2, SZ_FILTL = (size_t)4 * 256 * 4096 * 4, SZ_FILTC = (size_t)4 * 256 * 256 * 4;
constexpr size_t WS_WINT = al256(WS_LA2T + 2 * 256 * 64 * 2);
constexpr size_t WS_WOUTT = al256(WS_WINT + 2 * SZ_WINT);
constexpr size_t WS_FILTL = al256(WS_WOUTT + 2 * SZ_WOUTT);
constexpr size_t WS_FILTC = al256(WS_FILTL + 2 * SZ_FILTL);
constexpr size_t WS_XC = al256(WS_FILTC + 2 * SZ_FILTC);
constexpr size_t WS_HBY = al256(WS_XC + (size_t)NTC * DM * 4);
constexpr size_t WS_CAT = al256(WS_HBY + (size_t)NT * DM * 2);
constexpr size_t WS_Z = al256(WS_CAT + (size_t)NT * DM * 2);
constexpr size_t WS_R1 = al256(WS_Z + (size_t)NT * ZS * 2);
constexpr size_t R1_RWP = 0;
constexpr size_t R1_GQ = (size_t)NT * 1024 * 2;
constexpr size_t R1_W13T = 0;
constexpr size_t R1_W2T = (size_t)65 * 512 * 1024 * 2;
constexpr size_t R1_W13T8 = 0;
constexpr size_t R1_W2T8 = (size_t)65 * 512 * 1024;
constexpr size_t R1_BYTES = (size_t)NT * 1024 * 2 + (size_t)NT * 768 * 2;
constexpr size_t WS_KNORM = al256(WS_R1 + R1_BYTES);
constexpr size_t WS_GAB = al256(WS_KNORM + (size_t)NT * 4 * 4);
constexpr size_t WS_S5ST = al256(WS_GAB + (size_t)NT * 16 * 4);
constexpr size_t WS_AEP = al256(WS_S5ST + (size_t)8 * 68 * 2 * 16 * 64 * 2 * 4);
constexpr size_t WS_AW = al256(WS_AEP + (size_t)NT * 8 * 4);
constexpr size_t WS_RTOK = al256(WS_AW + (size_t)NT * 8 * 4);
constexpr size_t WS_HYT = al256(WS_RTOK + (size_t)64 * NT * 4);
constexpr size_t WS_S5G = al256(WS_HYT + (size_t)8 * 768 * 4096 * 2);
constexpr size_t WS_END = al256(WS_S5G + (size_t)NT * 256 * 2);
static_assert(R1_W2T + (size_t)65 * 1024 * 256 * 2 <= R1_BYTES, "expert weights must fit R1");
constexpr size_t ACT_BYTES = (size_t)ACT_ROWS * 256 * 2;
constexpr size_t WS_ACT = WS_Z + ((((size_t)NT * ZS * 2 - ACT_BYTES) >> 8) << 8);
constexpr size_t WS_Y2 = WS_HBY;
static_assert(WS_Y2 + ACT_BYTES <= WS_ACT, "y2 must not reach act");

#define CW_QUEUE(l) (4096 + 64 * (l))
#define CW_CNT(l) (16384 + 2048 * (l))
#define CW_CUCNT(l) (8192 + 4096 * (l))

#define XB_TMO      128
#define XB_XCNT(j)  (256  + 64 * (j))
#define XB_XSUB(j)  (1280 + 64 * (j))
#define XB_XGEN(j)  (2304 + 64 * (j))
#define XB_TOP      3328
#define XB_TOPGEN   3392
#define XCD_BAR_WORDS 3456
#define XB_SPIN_CAP (1u << 18)
#define LAS __attribute__((address_space(3)))

__device__ __forceinline__ unsigned xb_ld(unsigned* p)              { return __hip_atomic_load(p, __ATOMIC_RELAXED, __HIP_MEMORY_SCOPE_AGENT); }
__device__ __forceinline__ unsigned xb_add(unsigned* p, unsigned v) { return __hip_atomic_fetch_add(p, v, __ATOMIC_RELAXED, __HIP_MEMORY_SCOPE_AGENT); }
__device__ __forceinline__ unsigned xb_xcc_id() { return (unsigned)__builtin_amdgcn_s_getreg((3 << 11) | 20) & 0xFu; }
#define XB_SPIN(cond, bar) do { unsigned _sp = 0; while (cond) { __builtin_amdgcn_s_sleep(1); \
    if ((++_sp & 255u) == 0u) { if (xb_ld(&(bar)[XB_TMO])) break; if (_sp > XB_SPIN_CAP) { atomicAdd(&(bar)[XB_TMO], 1u); break; } } } } while (0)

struct XcdBarrier {
    unsigned* bar; unsigned x;
    volatile LAS unsigned* st;
};
__device__ __forceinline__ XcdBarrier xcd_barrier_post(unsigned* bar, volatile LAS unsigned* st) {
    XcdBarrier b; b.bar = bar; b.x = xb_xcc_id(); b.st = st;
    if (threadIdx.x == 0) (void)xb_add(&bar[XB_XCNT(b.x)], 1u);
    return b;
}
__device__ __forceinline__ void xcd_barrier_complete(unsigned* bar, unsigned x, unsigned& nloc, unsigned& nx) {
    const unsigned G = gridDim.x * gridDim.y * gridDim.z;
    unsigned sum, cnt, mine, sp = 0u;
    for (;;) {
        sum = 0u; cnt = 0u; mine = 0u;
#pragma unroll
        for (unsigned j = 0; j < 16; ++j) { const unsigned c = xb_ld(&bar[XB_XCNT(j)]); sum += c; cnt += (c > 0u) ? 1u : 0u; mine = (j == x) ? c : mine; }
        if (sum == G) break;
        __builtin_amdgcn_s_sleep(1);
        if ((++sp & 255u) == 0u) { if (xb_ld(&bar[XB_TMO])) break; if (sp > XB_SPIN_CAP) { atomicAdd(&bar[XB_TMO], 1u); break; } }
    }
    nloc = mine > 0u ? mine : 1u; nx = cnt > 0u ? cnt : 1u;
}
__device__ __forceinline__ void xcd_barrier(const XcdBarrier& b) {
    asm volatile("s_waitcnt vmcnt(0)" ::: "memory");
    __syncthreads();
    if (threadIdx.x == 0) {
        unsigned* bar = b.bar;
        __builtin_amdgcn_s_waitcnt(0);
        unsigned nloc = b.st[0], nx = b.st[1];
        if (nloc == 0u) { xcd_barrier_complete(bar, b.x, nloc, nx); b.st[0] = nloc; b.st[1] = nx; }
        const unsigned old = xb_add(&bar[XB_XSUB(b.x)], 1u);
        const unsigned gen = old / nloc;
        if (old + 1u == (gen + 1u) * nloc) {
            __builtin_amdgcn_fence(__ATOMIC_RELEASE, "agent");
            asm volatile("s_waitcnt vmcnt(0)" ::: "memory");
            const unsigned og = xb_add(&bar[XB_TOP], 1u);
            const unsigned tg = og / nx;
            if (og + 1u == (tg + 1u) * nx) xb_add(&bar[XB_TOPGEN], 1u);
            else XB_SPIN(xb_ld(&bar[XB_TOPGEN]) == tg, bar);
            __builtin_amdgcn_fence(__ATOMIC_ACQUIRE, "agent");
            xb_add(&bar[XB_XGEN(b.x)], 1u);
            asm volatile("s_waitcnt vmcnt(0)" ::: "memory");
        } else {
            XB_SPIN(xb_ld(&bar[XB_XGEN(b.x)]) == gen, bar);
            __builtin_amdgcn_fence(__ATOMIC_ACQUIRE, "agent");
            asm volatile("s_waitcnt vmcnt(0)" ::: "memory");
        }
    }
    __syncthreads();
}

struct KP {
    const float* in[52];
    float* out;
    char* ws;
    int ph_lo, ph_hi, rep, pad_;
};
struct P {
    const __attribute__((address_space(3))) unsigned* tab;
    float* out;
    char* ws;
    __device__ __forceinline__ const float* in(int i) const {
        const unsigned lo = __builtin_amdgcn_readfirstlane(tab[2 * i]);
        const unsigned hi = __builtin_amdgcn_readfirstlane(tab[2 * i + 1]);
        return (const float*)(((unsigned long long)hi << 32) | (unsigned long long)lo);
    }
};
enum { I_X = 0, I_C, I_CTX, I_CCTX, I_ADAW, I_ADAB, I_WIN, I_WOUT, I_LNG, I_LNB,
       I_RW_W0, I_RW_W2, I_RW_A0, I_RW_A2, I_RW_G2, I_RW_KK, I_RW_KA, I_RW_RK, I_RW_GNG, I_RW_GNB,
       I_GD_CONV, I_GD_ALOG, I_GD_DTB, I_GD_NORM,
       I_HY_CONV, I_HY_CONVB, I_HY_W1, I_HY_B1, I_HY_F1, I_HY_W2, I_HY_B2, I_HY_F2, I_HY_W3, I_HY_SKIP,
       I_S5_LRE, I_S5_LIM, I_S5_LOGSTEP, I_S5_BRE, I_S5_BIM, I_S5_CRE, I_S5_CIM, I_S5_D, I_S5_GLUW, I_S5_GLUB,
       I_ROUTER_W, I_ROUTER_B, I_EX_W1, I_EX_W3, I_EX_W2, I_SH_W1, I_SH_W3, I_SH_W2 };

__device__ __forceinline__ bf16_t f2bf(float f) { unsigned u = __float_as_uint(f); u += 0x7fffu + ((u >> 16) & 1u); return (bf16_t)(u >> 16); }
__device__ __forceinline__ float bf2f(bf16_t h) { return __uint_as_float(((unsigned)h) << 16); }
__device__ __forceinline__ float bflo(unsigned u) { return __uint_as_float(u << 16); }
__device__ __forceinline__ float bfhi(unsigned u) { return __uint_as_float(u & 0xffff0000u); }
__device__ __forceinline__ unsigned pack2(float a, float b) { return (unsigned)f2bf(a) | ((unsigned)f2bf(b) << 16); }
__device__ __forceinline__ float sigm(float x) { return 1.f / (1.f + __expf(-x)); }
__device__ __forceinline__ float siluf(float x) { return x / (1.f + __expf(-x)); }
__device__ __forceinline__ float softplusf(float x) { return fmaxf(x, 0.f) + log1pf(__expf(-fabsf(x))); }
template <int CTRL> __device__ __forceinline__ float dppf(float v) {
    return __int_as_float(__builtin_amdgcn_update_dpp(0, __float_as_int(v), CTRL, 0xF, 0xF, true));
}
__device__ __forceinline__ float wave_sum(float v) {
    v += dppf<0xB1>(v); v += dppf<0x4E>(v); v += dppf<0x141>(v); v += dppf<0x140>(v);
    const int iv = __float_as_int(v);
    const float r0 = __int_as_float(__builtin_amdgcn_readlane(iv, 0)), r1 = __int_as_float(__builtin_amdgcn_readlane(iv, 16));
    const float r2 = __int_as_float(__builtin_amdgcn_readlane(iv, 32)), r3 = __int_as_float(__builtin_amdgcn_readlane(iv, 48));
    return (r0 + r1) + (r2 + r3);
}

__device__ __forceinline__ void unpack8(const uint4& v, float (&o)[8]) {
    o[0] = bflo(v.x); o[1] = bfhi(v.x); o[2] = bflo(v.y); o[3] = bfhi(v.y); o[4] = bflo(v.z); o[5] = bfhi(v.z); o[6] = bflo(v.w); o[7] = bfhi(v.w);
}
__device__ __forceinline__ uint4 pack8(const float (&o)[8]) { return make_uint4(pack2(o[0], o[1]), pack2(o[2], o[3]), pack2(o[4], o[5]), pack2(o[6], o[7])); }
__device__ __forceinline__ float sum8lanes(float v) { v += dppf<0xB1>(v); v += dppf<0x4E>(v); v += dppf<0x141>(v); return v; }

#define DPP_ADD_ASM(name, ctrl) __device__ __forceinline__ float name(float x) { float r; asm volatile("s_nop 1\n\tv_add_f32_dpp %0, %1, %1 " ctrl " row_mask:0xf bank_mask:0xf bound_ctrl:1" : "=v"(r) : "v"(x)); return r; }
DPP_ADD_ASM(dadd_x1, "quad_perm:[1,0,3,2]")
DPP_ADD_ASM(dadd_x2, "quad_perm:[2,3,0,1]")
DPP_ADD_ASM(dadd_hm, "row_half_mirror")
DPP_ADD_ASM(dadd_rm, "row_mirror")

__device__ __forceinline__ void dpp_allreduce16_x2(float& a, float& b) {
    asm volatile(
        "s_nop 1\n\t"
        "v_add_f32_dpp %0, %0, %0 quad_perm:[1,0,3,2] row_mask:0xf bank_mask:0xf bound_ctrl:1\n\t"
        "v_add_f32_dpp %1, %1, %1 quad_perm:[1,0,3,2] row_mask:0xf bank_mask:0xf bound_ctrl:1\n\t"
        "s_nop 0\n\t"
        "v_add_f32_dpp %0, %0, %0 quad_perm:[2,3,0,1] row_mask:0xf bank_mask:0xf bound_ctrl:1\n\t"
        "v_add_f32_dpp %1, %1, %1 quad_perm:[2,3,0,1] row_mask:0xf bank_mask:0xf bound_ctrl:1\n\t"
        "s_nop 0\n\t"
        "v_add_f32_dpp %0, %0, %0 row_half_mirror row_mask:0xf bank_mask:0xf bound_ctrl:1\n\t"
        "v_add_f32_dpp %1, %1, %1 row_half_mirror row_mask:0xf bank_mask:0xf bound_ctrl:1\n\t"
        "s_nop 0\n\t"
        "v_add_f32_dpp %0, %0, %0 row_mirror row_mask:0xf bank_mask:0xf bound_ctrl:1\n\t"
        "v_add_f32_dpp %1, %1, %1 row_mirror row_mask:0xf bank_mask:0xf bound_ctrl:1"
        : "+v"(a), "+v"(b));
}
__device__ __forceinline__ int otid() { int t = threadIdx.x; asm volatile("" : "+v"(t)); return t; }
__device__ __forceinline__ float* xrow(const P& p, int row) {
    return row < NTC ? (float*)(p.ws + WS_XC) + (size_t)row * DM : p.out + (size_t)(row - NTC) * DM;
}
__device__ __forceinline__ int row_mod(int row) { return row < NTC ? 8 : ((row - NTC) >> 12); }
__device__ __forceinline__ const float* modp(const P& p, int l, int r, int chunk) {
    return (const float*)(p.ws + WS_MOD) + ((size_t)(l * 9 + r) * 6144 + chunk * 1024);
}

struct ARows { int r[4]; };
__device__ __forceinline__ ARows arows_lin(int base, int tid) { ARows a; a.r[0] = base + (tid >> 3); a.r[1] = a.r[0] + 32; a.r[2] = a.r[0] + 64; a.r[3] = a.r[0] + 96; return a; }
template <bool SWAP = false>
__device__ __forceinline__ void gemm_tile(const bf16_t* __restrict__ A, int lda, const ARows& ar,
                                          const bf16_t* __restrict__ Bt, int ldb, int brow0, int K,
                                          char* lds, f32x4 (&acc)[4][4]) {
    const int tid = otid();
    const int wid = tid >> 6, lane = tid & 63, wr = wid >> 1, wc = wid & 1, fr = lane & 15, fq = lane >> 4;
    const int gc = ((tid & 7) ^ ((tid >> 3) & 7)) * 8;
    const bf16_t* ap[4]; const bf16_t* bp[4];
#pragma unroll
    for (int i = 0; i < 4; ++i) {
        ap[i] = A + (size_t)ar.r[i] * lda + gc;
        bp[i] = Bt + (size_t)(brow0 + (tid >> 3) + 32 * i) * ldb + gc;
    }
#pragma unroll
    for (int m = 0; m < 4; ++m)
#pragma unroll
        for (int n = 0; n < 4; ++n) acc[m][n] = f32x4{0.f, 0.f, 0.f, 0.f};
    const int nk = K >> 6;
    auto stage = [&](int t, int buf) {
        char* SA = lds + buf * 32768; char* SB = SA + 16384;
        const int ko = t * 64;
#pragma unroll
        for (int i = 0; i < 4; ++i) {
            __builtin_amdgcn_global_load_lds((const void*)(ap[i] + ko), (LAS void*)(SA + tid * 16 + i * 4096), 16, 0, 0);
            __builtin_amdgcn_global_load_lds((const void*)(bp[i] + ko), (LAS void*)(SB + tid * 16 + i * 4096), 16, 0, 0);
        }
    };
    stage(0, 0);
    asm volatile("s_waitcnt vmcnt(0)" ::: "memory");
    __syncthreads();
    const int sw = fr & 7;
    for (int t = 0; t < nk; ++t) {
        const int buf = t & 1;
        if (t + 1 < nk) stage(t + 1, buf ^ 1);
        const char* SA = lds + buf * 32768; const char* SB = SA + 16384;
        bf16x8 af[2][4], bfr[2][4];
#pragma unroll
        for (int ks = 0; ks < 2; ++ks) {
            const int co = ((ks * 4 + fq) ^ sw) * 16;
#pragma unroll
            for (int m = 0; m < 4; ++m) af[ks][m] = *reinterpret_cast<const bf16x8*>(SA + (wr * 64 + m * 16 + fr) * 128 + co);
#pragma unroll
            for (int n = 0; n < 4; ++n) bfr[ks][n] = *reinterpret_cast<const bf16x8*>(SB + (wc * 64 + n * 16 + fr) * 128 + co);
        }
        __builtin_amdgcn_s_setprio(1);
#pragma unroll
        for (int ks = 0; ks < 2; ++ks)
#pragma unroll
            for (int m = 0; m < 4; ++m)
#pragma unroll
                for (int n = 0; n < 4; ++n) acc[m][n] = SWAP ? __builtin_amdgcn_mfma_f32_16x16x32_bf16(bfr[ks][n], af[ks][m], acc[m][n], 0, 0, 0)
                                                             : __builtin_amdgcn_mfma_f32_16x16x32_bf16(af[ks][m], bfr[ks][n], acc[m][n], 0, 0, 0);
        __builtin_amdgcn_s_setprio(0);
        asm volatile("s_waitcnt vmcnt(0)" ::: "memory");
        __syncthreads();
    }
}


__device__ __forceinline__ int xmap(int mode, int c);
typedef int v8i __attribute__((ext_vector_type(8)));
__device__ __forceinline__ void gemm_tile8(const unsigned char* __restrict__ A, int lda, const ARows& ar,
                                           const unsigned char* __restrict__ Bt, int ldb, int brow0, int K,
                                           char* lds, f32x4 (&acc)[4][4]) {
    const int tid = otid();
    const int wid = tid >> 6, lane = tid & 63, wr = wid >> 1, wc = wid & 1, fr = lane & 15, fq = lane >> 4;
    const int gc = ((tid & 7) ^ ((tid >> 3) & 7)) * 16;
    const unsigned char* ap[4]; const unsigned char* bp[4];
#pragma unroll
    for (int i = 0; i < 4; ++i) {
        ap[i] = A + (size_t)ar.r[i] * lda + gc;
        bp[i] = Bt + (size_t)(brow0 + (tid >> 3) + 32 * i) * ldb + gc;
    }
#pragma unroll
    for (int m = 0; m < 4; ++m)
#pragma unroll
        for (int n = 0; n < 4; ++n) acc[m][n] = f32x4{0.f, 0.f, 0.f, 0.f};
    const int nk = K >> 7;
    auto stage = [&](int t, int buf) {
        char* SA = lds + buf * 32768; char* SB = SA + 16384;
        const int ko = t * 128;
#pragma unroll
        for (int i = 0; i < 4; ++i) {
            __builtin_amdgcn_global_load_lds((const void*)(ap[i] + ko), (LAS void*)(SA + tid * 16 + i * 4096), 16, 0, 0);
            __builtin_amdgcn_global_load_lds((const void*)(bp[i] + ko), (LAS void*)(SB + tid * 16 + i * 4096), 16, 0, 0);
        }
    };
    stage(0, 0);
    asm volatile("s_waitcnt vmcnt(0)" ::: "memory");
    __syncthreads();
    const int sw = fr & 7;
    for (int t = 0; t < nk; ++t) {
        const int buf = t & 1;
        if (t + 1 < nk) stage(t + 1, buf ^ 1);
        const char* SA = lds + buf * 32768; const char* SB = SA + 16384;
        {
            const int c0 = ((2 * fq) ^ sw) * 16, c1 = c0 ^ 16;
            v8i af[4], bfr[4];
#pragma unroll
            for (int m = 0; m < 4; ++m) {
                const char* q = SA + (wr * 64 + m * 16 + fr) * 128;
                const int4 lo = *reinterpret_cast<const int4*>(q + c0), hi = *reinterpret_cast<const int4*>(q + c1);
                af[m] = v8i{lo.x, lo.y, lo.z, lo.w, hi.x, hi.y, hi.z, hi.w};
            }
#pragma unroll
            for (int n = 0; n < 4; ++n) {
                const char* q = SB + (wc * 64 + n * 16 + fr) * 128;
                const int4 lo = *reinterpret_cast<const int4*>(q + c0), hi = *reinterpret_cast<const int4*>(q + c1);
                bfr[n] = v8i{lo.x, lo.y, lo.z, lo.w, hi.x, hi.y, hi.z, hi.w};
            }
            __builtin_amdgcn_s_setprio(1);
#pragma unroll
            for (int m = 0; m < 4; ++m)
#pragma unroll
                for (int n = 0; n < 4; ++n)
                    acc[m][n] = __builtin_amdgcn_mfma_scale_f32_16x16x128_f8f6f4(af[m], bfr[n], acc[m][n], 0, 0, 0, 0x7F7F7F7F, 0, 0x7F7F7F7F);
            __builtin_amdgcn_s_setprio(0);
        }
        asm volatile("s_waitcnt vmcnt(0)" ::: "memory");
        __syncthreads();
    }
}

__device__ __forceinline__ unsigned pack4_f8(float a, float b, float c, float d) {
    int v = __builtin_amdgcn_cvt_pk_fp8_f32(a, b, 0, false);
    v = __builtin_amdgcn_cvt_pk_fp8_f32(c, d, v, true);
    return (unsigned)v;
}
__device__ __forceinline__ void xpose_strip4_f8(const float* __restrict__ src, int C, unsigned char* __restrict__ dst, int ldd, int mode, int tr, int tc0, float sc, char* lds) {
    float* t = (float*)lds;
    const int tid = otid();
    {
        const int c4 = (tid & 15) * 4;
        float4 v[4][4];
#pragma unroll
        for (int q = 0; q < 4; ++q)
#pragma unroll
            for (int k = 0; k < 4; ++k) { typedef float f32x4n_t __attribute__((ext_vector_type(4)));
                const f32x4n_t t4 = __builtin_nontemporal_load(reinterpret_cast<const f32x4n_t*>(src + (size_t)(tr * 64 + (tid >> 4) + 16 * k) * C + (tc0 + q) * 64 + c4)); v[q][k] = make_float4(t4.x, t4.y, t4.z, t4.w); }
#pragma unroll
        for (int q = 0; q < 4; ++q)
#pragma unroll
            for (int k = 0; k < 4; ++k) {
                const int r = (tid >> 4) + 16 * k;
                float* tq = t + q * (64 * 65);
                tq[(c4 + 0) * 65 + r] = v[q][k].x; tq[(c4 + 1) * 65 + r] = v[q][k].y; tq[(c4 + 2) * 65 + r] = v[q][k].z; tq[(c4 + 3) * 65 + r] = v[q][k].w;
            }
    }
    __syncthreads();
#pragma unroll
    for (int q = 0; q < 4; ++q)
#pragma unroll
        for (int k = 0; k < 2; ++k) {
            const int ci = (tid >> 3) + 32 * k, r8 = (tid & 7) * 8;
            const float* tp = t + q * (64 * 65) + ci * 65 + r8;
            uint2 o;
            o.x = pack4_f8(tp[0] * sc, tp[1] * sc, tp[2] * sc, tp[3] * sc); o.y = pack4_f8(tp[4] * sc, tp[5] * sc, tp[6] * sc, tp[7] * sc);
            *reinterpret_cast<uint2*>(dst + (size_t)xmap(mode, (tc0 + q) * 64 + ci) * ldd + tr * 64 + r8) = o;
        }
    __syncthreads();
}


struct GSrc { unsigned ao[4], bo[4]; };
template <bool FP8, bool SWAP, class SetupF, class EpiF>
__device__ __forceinline__ void gemm_phase(const char* __restrict__ Abase, const char* __restrict__ Bbase, int nkt, int nunits, char* lds, SetupF setup, EpiF epi) {
    const int tid = otid();
    const int wid = tid >> 6, lane = tid & 63, wr = wid >> 1, wc = wid & 1, fr = lane & 15, fq = lane >> 4;
    const int sw = fr & 7;
    const int G = (int)gridDim.x;
    auto stage = [&](const GSrc& sr, int t, int buf) __attribute__((always_inline)) {
        char* SA = lds + buf * 32768; char* SB = SA + 16384;
        const unsigned ko = (unsigned)t * 128u;
#pragma unroll
        for (int i = 0; i < 4; ++i) {
            __builtin_amdgcn_global_load_lds((const void*)(Abase + (size_t)(sr.ao[i] + ko)), (LAS void*)(SA + tid * 16 + i * 4096), 16, 0, 0);
            __builtin_amdgcn_global_load_lds((const void*)(Bbase + (size_t)(sr.bo[i] + ko)), (LAS void*)(SB + tid * 16 + i * 4096), 16, 0, 0);
        }
    };
    int u = (int)blockIdx.x; GSrc cur; bool have = false;
#pragma unroll
    for (int i = 0; i < 4; ++i) { cur.ao[i] = 0u; cur.bo[i] = 0u; }
    while (u < nunits) { if (setup(u, cur)) { have = true; break; } u += G; }
    if (have) { stage(cur, 0, 0); asm volatile("s_waitcnt vmcnt(0)" ::: "memory"); __syncthreads(); }
    while (have) {
        int un = u + G; GSrc nxt = cur; bool hn = false;
        while (un < nunits) { if (setup(un, nxt)) { hn = true; break; } un += G; }
        f32x4 acc[4][4];
#pragma unroll
        for (int m = 0; m < 4; ++m)
#pragma unroll
            for (int n = 0; n < 4; ++n) acc[m][n] = f32x4{0.f, 0.f, 0.f, 0.f};
#pragma unroll 1
        for (int t = 0; t < nkt; ++t) {
            const int buf = t & 1;
            if (t + 1 < nkt) stage(cur, t + 1, buf ^ 1); else if (hn) stage(nxt, 0, buf ^ 1);
            const char* SA = lds + buf * 32768; const char* SB = SA + 16384;
            if (FP8) {
                const int c0 = (((2 * fq) | (fq & 1)) ^ sw) * 16, c1 = c0 ^ 16;
                v8i af[4], bfr[4];
#pragma unroll
                for (int m = 0; m < 4; ++m) {
                    const char* q = SA + (wr * 64 + m * 16 + fr) * 128;
                    const int4 lo_ = *reinterpret_cast<const int4*>(q + c0), hi_ = *reinterpret_cast<const int4*>(q + c1);
                    af[m] = v8i{lo_.x, lo_.y, lo_.z, lo_.w, hi_.x, hi_.y, hi_.z, hi_.w};
                }
#pragma unroll
                for (int n = 0; n < 4; ++n) {
                    const char* q = SB + (wc * 64 + n * 16 + fr) * 128;
                    const int4 lo_ = *reinterpret_cast<const int4*>(q + c0), hi_ = *reinterpret_cast<const int4*>(q + c1);
                    bfr[n] = v8i{lo_.x, lo_.y, lo_.z, lo_.w, hi_.x, hi_.y, hi_.z, hi_.w};
                }
                __builtin_amdgcn_s_setprio(1);
#pragma unroll
                for (int m = 0; m < 4; ++m)
#pragma unroll
                    for (int n = 0; n < 4; ++n)
                        acc[m][n] = SWAP ? __builtin_amdgcn_mfma_scale_f32_16x16x128_f8f6f4(bfr[n], af[m], acc[m][n], 0, 0, 0, 0x7F7F7F7F, 0, 0x7F7F7F7F)
                                         : __builtin_amdgcn_mfma_scale_f32_16x16x128_f8f6f4(af[m], bfr[n], acc[m][n], 0, 0, 0, 0x7F7F7F7F, 0, 0x7F7F7F7F);
                __builtin_amdgcn_s_setprio(0);
            } else {
                bf16x8 af[2][4], bfr[2][4];
#pragma unroll
                for (int ks = 0; ks < 2; ++ks) {
                    const int co = ((ks * 4 + fq) ^ sw) * 16;
#pragma unroll
                    for (int m = 0; m < 4; ++m) af[ks][m] = *reinterpret_cast<const bf16x8*>(SA + (wr * 64 + m * 16 + fr) * 128 + co);
#pragma unroll
                    for (int n = 0; n < 4; ++n) bfr[ks][n] = *reinterpret_cast<const bf16x8*>(SB + (wc * 64 + n * 16 + fr) * 128 + co);
                }
                __builtin_amdgcn_s_setprio(1);
#pragma unroll
                for (int ks = 0; ks < 2; ++ks)
#pragma unroll
                    for (int m = 0; m < 4; ++m)
#pragma unroll
                        for (int n = 0; n < 4; ++n) acc[m][n] = SWAP ? __builtin_amdgcn_mfma_f32_16x16x32_bf16(bfr[ks][n], af[ks][m], acc[m][n], 0, 0, 0)
                                                                     : __builtin_amdgcn_mfma_f32_16x16x32_bf16(af[ks][m], bfr[ks][n], acc[m][n], 0, 0, 0);
                __builtin_amdgcn_s_setprio(0);
            }
            asm volatile("s_waitcnt vmcnt(0)" ::: "memory");
            __syncthreads();
        }
        epi(u, acc);
        cur = nxt; u = un; have = hn;
    }
}

__device__ __forceinline__ void ph0_mod_unit(const P& p, int u, char* lds) {
    const int l = u / 96, cg = u % 96, tid = otid();
    float* s = (float*)lds;
    float* red = s + 9 * 1024;
    const float* c = p.in(I_C); const float* cctx = p.in(I_CCTX);
    for (int i = tid; i < 9 * 1024; i += NTHREADS) { int r = i >> 10, k = i & 1023; float v = r < 8 ? c[r * 1024 + k] : cctx[k]; s[i] = v / (1.f + expf(-v)); }
    __syncthreads();
    const int kq = tid >> 6, j = tid & 63, col = cg * 64 + j;
    const float* w = p.in(I_ADAW) + (size_t)l * 1024 * 6144 + col;
    float acc[9];
#pragma unroll
    for (int r = 0; r < 9; ++r) acc[r] = 0.f;
#pragma unroll 8
    for (int k = kq * 256; k < kq * 256 + 256; ++k) {
        const float wv = w[(size_t)k * 6144];
#pragma unroll
        for (int r = 0; r < 9; ++r) acc[r] += s[r * 1024 + k] * wv;
    }
#pragma unroll
    for (int r = 0; r < 9; ++r) red[(kq * 9 + r) * 64 + j] = acc[r];
    __syncthreads();
    if (tid < 64) {
        float* mod = (float*)(p.ws + WS_MOD);
        const float bb = p.in(I_ADAB)[l * 6144 + col];
#pragma unroll
        for (int r = 0; r < 9; ++r) mod[(size_t)(l * 9 + r) * 6144 + col] = red[r * 64 + j] + red[(9 + r) * 64 + j] + red[(18 + r) * 64 + j] + red[(27 + r) * 64 + j] + bb;
    }
    __syncthreads();
}

__device__ __forceinline__ void ph0_s5tab_unit(const P& p, int u) {
    const int tid = otid();
    if (tid >= 64) return;
    const int ldg = u;
    const int idx = ldg * 64 + tid;
    const double lre = (double)p.in(I_S5_LRE)[idx], lim = (double)p.in(I_S5_LIM)[idx];
    const double dt = (double)expf(p.in(I_S5_LOGSTEP)[ldg]);
    const float mag = expf((float)(lre * dt));
    double rev = lim * dt * 0.15915494309189535; rev -= floor(rev);
    float sn, cs; sincospif(2.f * (float)rev, &sn, &cs);
    const double abr = (double)(mag * cs), abi = (double)(mag * sn);
    const double den = lre * lre + lim * lim;
    const double cor = ((abr - 1.0) * lre + abi * lim) / den;
    const double coi = (abi * lre - (abr - 1.0) * lim) / den;
    const float m64f = expf((float)(64.0 * lre * dt));
    double rev64 = 64.0 * lim * dt * 0.15915494309189535; rev64 -= floor(rev64);
    float sn64, cs64; sincospif(2.f * (float)rev64, &sn64, &cs64);
    float* A = (float*)(p.ws + WS_S5A) + (size_t)idx * 4;
    A[0] = (float)abr; A[1] = (float)abi; A[2] = m64f * cs64; A[3] = m64f * sn64;
    float* B = (float*)(p.ws + WS_S5B) + (size_t)idx * 32;
    const float* bre = p.in(I_S5_BRE) + (size_t)idx * 16; const float* bim = p.in(I_S5_BIM) + (size_t)idx * 16;
#pragma unroll
    for (int h = 0; h < 16; ++h) {
        const double br = bre[h], bi = bim[h];
        B[h] = (float)(cor * br - coi * bi);
        B[16 + h] = (float)(cor * bi + coi * br);
    }
}

__device__ __forceinline__ int xmap(int mode, int c) {
    if (mode == 0) return c;
    const int j = c >> 6, cc = c & 63, wc = cc >> 5, pp = (cc & 31) >> 4, i = cc & 15;
    return j * 128 + wc * 64 + pp * 32 + i + (mode == 2 ? 16 : 0);
}
__device__ __forceinline__ void xpose_tile(const float* __restrict__ src, int C, bf16_t* __restrict__ dst, int ldd, int mode, int tr, int tc, char* lds) {
    float* t = (float*)lds;
    const int tid = otid();
    {
        const int c4 = (tid & 15) * 4, c = tc * 64 + c4;
#pragma unroll
        for (int k = 0; k < 4; ++k) {
            const int r = (tid >> 4) + 16 * k;
            float4 v = make_float4(0.f, 0.f, 0.f, 0.f);
            if (c < C) v = *reinterpret_cast<const float4*>(src + (size_t)(tr * 64 + r) * C + c);
            t[(c4 + 0) * 65 + r] = v.x; t[(c4 + 1) * 65 + r] = v.y; t[(c4 + 2) * 65 + r] = v.z; t[(c4 + 3) * 65 + r] = v.w;
        }
    }
    __syncthreads();
#pragma unroll
    for (int k = 0; k < 2; ++k) {
        const int ci = (tid >> 3) + 32 * k, r8 = (tid & 7) * 8;
        const float* tp = t + ci * 65 + r8;
        uint4 o;
        o.x = pack2(tp[0], tp[1]); o.y = pack2(tp[2], tp[3]); o.z = pack2(tp[4], tp[5]); o.w = pack2(tp[6], tp[7]);
        *reinterpret_cast<uint4*>(dst + (size_t)xmap(mode, tc * 64 + ci) * ldd + tr * 64 + r8) = o;
    }
    __syncthreads();
}

__device__ __forceinline__ void xpose_strip4(const float* __restrict__ src, int C, bf16_t* __restrict__ dst, int ldd, int mode, int tr, int tc0, char* lds) {
    float* t = (float*)lds;
    const int tid = otid();
    {
        const int c4 = (tid & 15) * 4;
        float4 v[4][4];
#pragma unroll
        for (int q = 0; q < 4; ++q)
#pragma unroll
            for (int k = 0; k < 4; ++k) v[q][k] = *reinterpret_cast<const float4*>(src + (size_t)(tr * 64 + (tid >> 4) + 16 * k) * C + (tc0 + q) * 64 + c4);
#pragma unroll
        for (int q = 0; q < 4; ++q)
#pragma unroll
            for (int k = 0; k < 4; ++k) {
                const int r = (tid >> 4) + 16 * k;
                float* tq = t + q * (64 * 65);
                tq[(c4 + 0) * 65 + r] = v[q][k].x; tq[(c4 + 1) * 65 + r] = v[q][k].y; tq[(c4 + 2) * 65 + r] = v[q][k].z; tq[(c4 + 3) * 65 + r] = v[q][k].w;
            }
    }
    __syncthreads();
#pragma unroll
    for (int q = 0; q < 4; ++q)
#pragma unroll
        for (int k = 0; k < 2; ++k) {
            const int ci = (tid >> 3) + 32 * k, r8 = (tid & 7) * 8;
            const float* tp = t + q * (64 * 65) + ci * 65 + r8;
            uint4 o;
            o.x = pack2(tp[0], tp[1]); o.y = pack2(tp[2], tp[3]); o.z = pack2(tp[4], tp[5]); o.w = pack2(tp[6], tp[7]);
            *reinterpret_cast<uint4*>(dst + (size_t)xmap(mode, (tc0 + q) * 64 + ci) * ldd + tr * 64 + r8) = o;
        }
    __syncthreads();
}

enum { M_INIT = 0, M_LN2NEXT = 1, M_LN1 = 2, M_FINAL = 3 };

template <int MODE>
__device__ __forceinline__ void rows_unit(const P& p, int l, int u, char* lds, int dry = 0) {
    const int tid = otid(), w = tid >> 6, lane = tid & 63;
    constexpr int RW = (MODE == M_LN1) ? 4 : 2;
    float* hbuf = (float*)lds;
    bf16_t* hb = (bf16_t*)(p.ws + (MODE == M_LN2NEXT ? WS_R1 : WS_HBY));
#pragma unroll
    for (int rr = 0; rr < RW; ++rr) {
        const int rl = w * RW + rr, row = u * (4 * RW) + rl;
        const int mr = row_mod(row);
        float v[16];
        float* xr = xrow(p, row);
        const float* src = (MODE == M_INIT) ? (row < NTC ? p.in(I_CTX) + (size_t)row * DM : p.in(I_X) + (size_t)(row - NTC) * DM) : xr;
#pragma unroll
        for (int i = 0; i < 4; ++i) {
            const float4 t = *reinterpret_cast<const float4*>(src + i * 256 + lane * 4);
            v[i * 4 + 0] = t.x; v[i * 4 + 1] = t.y; v[i * 4 + 2] = t.z; v[i * 4 + 3] = t.w;
        }
        if (MODE == M_LN2NEXT) {
            const int* tbs = (const int*)(lds - LDS_USER + 1024);
            const unsigned char* y2 = (const unsigned char*)(p.ws + WS_Y2);
            const int* aep = (const int*)(p.ws + WS_AEP); const float* aw = (const float*)(p.ws + WS_AW);
            float r8[8];
            {
                const unsigned char* yr = y2 + ((size_t)(SH_TILE_BASE * 128 + row)) * 512 + lane * 4;
                const int w0 = *reinterpret_cast<const int*>(yr), w1 = *reinterpret_cast<const int*>(yr + 256);
                r8[0] = __builtin_amdgcn_cvt_f32_fp8(w0, 0); r8[1] = __builtin_amdgcn_cvt_f32_fp8(w0, 1); r8[2] = __builtin_amdgcn_cvt_f32_fp8(w0, 2); r8[3] = __builtin_amdgcn_cvt_f32_fp8(w0, 3);
                r8[4] = __builtin_amdgcn_cvt_f32_fp8(w1, 0); r8[5] = __builtin_amdgcn_cvt_f32_fp8(w1, 1); r8[6] = __builtin_amdgcn_cvt_f32_fp8(w1, 2); r8[7] = __builtin_amdgcn_cvt_f32_fp8(w1, 3);
            }
#pragma unroll
            for (int k = 0; k < 8; ++k) {
                const unsigned av = (unsigned)aep[(size_t)row * 8 + k];
                const float wk = aw[(size_t)row * 8 + k];
                const int dest = tbs[av >> 24] * 128 + (int)(av & 0xFFFFFFu);
                const unsigned char* yr = y2 + (size_t)dest * 512 + lane * 4;
                const int w0 = *reinterpret_cast<const int*>(yr), w1 = *reinterpret_cast<const int*>(yr + 256);
                r8[0] += wk * __builtin_amdgcn_cvt_f32_fp8(w0, 0); r8[1] += wk * __builtin_amdgcn_cvt_f32_fp8(w0, 1); r8[2] += wk * __builtin_amdgcn_cvt_f32_fp8(w0, 2); r8[3] += wk * __builtin_amdgcn_cvt_f32_fp8(w0, 3);
                r8[4] += wk * __builtin_amdgcn_cvt_f32_fp8(w1, 0); r8[5] += wk * __builtin_amdgcn_cvt_f32_fp8(w1, 1); r8[6] += wk * __builtin_amdgcn_cvt_f32_fp8(w1, 2); r8[7] += wk * __builtin_amdgcn_cvt_f32_fp8(w1, 3);
            }
            const float4 g2 = *reinterpret_cast<const float4*>(modp(p, l - 1, mr, 5) + 512 + lane * 4);
            const float4 g3 = *reinterpret_cast<const float4*>(modp(p, l - 1, mr, 5) + 768 + lane * 4);
            const float sc16 = 1.f / 16.f;
            v[8] += sc16 * g2.x * r8[0]; v[9] += sc16 * g2.y * r8[1]; v[10] += sc16 * g2.z * r8[2]; v[11] += sc16 * g2.w * r8[3];
            v[12] += sc16 * g3.x * r8[4]; v[13] += sc16 * g3.y * r8[5]; v[14] += sc16 * g3.z * r8[6]; v[15] += sc16 * g3.w * r8[7];
        }
        if (MODE != M_INIT) {
            const int ll = (MODE == M_LN2NEXT) ? l - 1 : l;
            const int which = (MODE == M_LN1) ? 0 : 1;
            float s = 0.f;
#pragma unroll
            for (int i = 0; i < 16; ++i) s += v[i];
            const float mu = wave_sum(s) * (1.f / 1024.f);
            float q = 0.f;
#pragma unroll
            for (int i = 0; i < 16; ++i) { const float d = v[i] - mu; q += d * d; }
            const float rstd = rsqrtf(wave_sum(q) * (1.f / 1024.f) + 1e-5f);
            const float* g = p.in(I_LNG) + (size_t)(ll * 2 + which) * 1024;
            const float* bb = p.in(I_LNB) + (size_t)(ll * 2 + which) * 1024;
#pragma unroll
            for (int i = 0; i < 4; ++i) {
                const float4 gg = *reinterpret_cast<const float4*>(g + i * 256 + lane * 4);
                const float4 b4 = *reinterpret_cast<const float4*>(bb + i * 256 + lane * 4);
                v[i * 4 + 0] = (v[i * 4 + 0] - mu) * rstd * gg.x + b4.x;
                v[i * 4 + 1] = (v[i * 4 + 1] - mu) * rstd * gg.y + b4.y;
                v[i * 4 + 2] = (v[i * 4 + 2] - mu) * rstd * gg.z + b4.z;
                v[i * 4 + 3] = (v[i * 4 + 3] - mu) * rstd * gg.w + b4.w;
            }
        }
        if (MODE == M_FINAL) {
            if (row >= NTC) {
#pragma unroll
                for (int i = 0; i < 4; ++i) *reinterpret_cast<float4*>(xr + i * 256 + lane * 4) = make_float4(v[i * 4], v[i * 4 + 1], v[i * 4 + 2], v[i * 4 + 3]);
            }
            continue;
        }
        const float osc = (MODE == M_LN1) ? ALPHA : 1.f;
#pragma unroll
        for (int i = 0; i < 4; ++i) if (MODE != M_INIT) { float4 o4 = make_float4(osc * v[i * 4], osc * v[i * 4 + 1], osc * v[i * 4 + 2], osc * v[i * 4 + 3]); if (dry) o4 = *reinterpret_cast<const float4*>(src + i * 256 + lane * 4); *reinterpret_cast<float4*>(xr + i * 256 + lane * 4) = o4; }
        const float* sh = modp(p, l, mr, (MODE == M_LN1) ? 3 : 0);
        const float* sc = modp(p, l, mr, (MODE == M_LN1) ? 4 : 1);
#pragma unroll
        for (int i = 0; i < 4; ++i) {
            const float4 s4 = *reinterpret_cast<const float4*>(sc + i * 256 + lane * 4);
            const float4 h4 = *reinterpret_cast<const float4*>(sh + i * 256 + lane * 4);
            const float h0 = v[i * 4 + 0] * (1.f + s4.x) + h4.x, h1 = v[i * 4 + 1] * (1.f + s4.y) + h4.y;
            const float h2 = v[i * 4 + 2] * (1.f + s4.z) + h4.z, h3 = v[i * 4 + 3] * (1.f + s4.w) + h4.w;
            if (MODE == M_LN1) { if (!dry) *reinterpret_cast<unsigned*>((unsigned char*)hb + (size_t)row * DM + i * 256 + lane * 4) = pack4_f8(h0, h1, h2, h3); }
            else { uint2 pk; pk.x = pack2(h0, h1); pk.y = pack2(h2, h3); if (!dry) *reinterpret_cast<uint2*>(hb + (size_t)row * DM + i * 256 + lane * 4) = pk; }
            if (MODE == M_LN1) *reinterpret_cast<float4*>(hbuf + rl * 1028 + i * 256 + lane * 4) = make_float4(h0, h1, h2, h3);
        }
    }
    if (MODE == M_LN1 && dry != 2) {
        float* part = hbuf;
        __syncthreads();
        {
            const int fr = lane & 15, fq = lane >> 4;
            const float* rwb = p.in(I_ROUTER_W) + (size_t)l * 1024 * 64 + fr;
            const float* hrow = hbuf + fr * 1028 + fq;
            f32x4 ac[4];
#pragma unroll
            for (int nf = 0; nf < 4; ++nf) ac[nf] = f32x4{0.f, 0.f, 0.f, 0.f};
#pragma unroll 8
            for (int k = w * 256; k < w * 256 + 256; k += 4) {
                const float av = hrow[k];
                const float* bp = rwb + (size_t)(k + fq) * 64;
#pragma unroll
                for (int nf = 0; nf < 4; ++nf) ac[nf] = __builtin_amdgcn_mfma_f32_16x16x4f32(av, bp[nf * 16], ac[nf], 0, 0, 0);
            }
            __syncthreads();
#pragma unroll
            for (int nf = 0; nf < 4; ++nf)
#pragma unroll
                for (int r = 0; r < 4; ++r) part[(w * 16 + fq * 4 + r) * 64 + nf * 16 + fr] = ac[nf][r];
        }
        __syncthreads();
        float lg[4];
#pragma unroll
        for (int rr = 0; rr < 4; ++rr) {
            const int r0 = w * 4 + rr;
            lg[rr] = part[(0 * 16 + r0) * 64 + lane] + part[(1 * 16 + r0) * 64 + lane] + part[(2 * 16 + r0) * 64 + lane] + part[(3 * 16 + r0) * 64 + lane];
        }
        const float rbias = p.in(I_ROUTER_B)[l * 64 + lane];
        unsigned* cnt = (unsigned*)(p.ws + WS_CTL) + CW_CNT(l);
        int* aep = (int*)(p.ws + WS_AEP); float* aw = (float*)(p.ws + WS_AW);
#pragma unroll 1
        for (int rr = 0; rr < 4; ++rr) {
            const int row = u * 16 + w * 4 + rr;
            const float logit = (rr == 0) ? lg[0] : (rr == 1) ? lg[1] : (rr == 2) ? lg[2] : lg[3];
            const float s = 1.f / (1.f + expf(-logit));
            const float bsd = s + rbias;
            float m1 = bsd;
            m1 = fmaxf(m1, __shfl_xor(m1, 1)); m1 = fmaxf(m1, __shfl_xor(m1, 2)); m1 = fmaxf(m1, __shfl_xor(m1, 4));
            const unsigned long long eqm = __ballot(bsd == m1);
            const int gbase = lane & ~7;
            const unsigned gbits = (unsigned)((eqm >> gbase) & 0xFFull);
            const int first = gbase + __builtin_ctz(gbits);
            float m2 = (lane == first) ? -INFINITY : bsd;
            m2 = fmaxf(m2, __shfl_xor(m2, 1)); m2 = fmaxf(m2, __shfl_xor(m2, 2)); m2 = fmaxf(m2, __shfl_xor(m2, 4));
            const float gs = m1 + m2;
            const int myg = lane >> 3;
            int grank = 0;
#pragma unroll
            for (int g2 = 0; g2 < 8; ++g2) { const float o = __int_as_float(__builtin_amdgcn_readlane(__float_as_int(gs), g2 * 8)); grank += (o > gs || (o == gs && g2 < myg)) ? 1 : 0; }
            const bool gsel = grank < 4;
            const float msk = gsel ? bsd : -INFINITY;
            int erank = 0;
#pragma unroll
            for (int j = 0; j < 64; ++j) { const float o = __int_as_float(__builtin_amdgcn_readlane(__float_as_int(msk), j)); erank += (o > msk || (o == msk && j < lane)) ? 1 : 0; }
            const bool sel = gsel && erank < 8;
            const float wsum = wave_sum(sel ? s : 0.f);
            const unsigned long long selm = __ballot(sel);
            if (sel && !dry) {
                const int slot = __popcll(selm & ((1ull << lane) - 1ull));
                const unsigned pos = atomicAdd(&cnt[lane * 32], 1u);
                aep[(size_t)row * 8 + slot] = (int)((unsigned)lane << 24 | pos);
                ((int*)(p.ws + WS_RTOK))[(size_t)lane * NT + pos] = row;
                aw[(size_t)row * 8 + slot] = s / wsum * 2.5f;
            }
        }
    }
}


__device__ __forceinline__ void ln1_unit(const P& p, int l, int u, char* lds) {
    const int tid = otid(), w = tid >> 6, lane = tid & 63;
    float* hbuf = (float*)lds;
    unsigned char* hb8 = (unsigned char*)(p.ws + WS_HBY);
    const int mr = row_mod(u * 16);
    {
        float v[4][16];
#pragma unroll
        for (int rr = 0; rr < 4; ++rr) {
            const float* xr = xrow(p, u * 16 + w * 4 + rr);
#pragma unroll
            for (int i = 0; i < 4; ++i) {
                const float4 t = *reinterpret_cast<const float4*>(xr + i * 256 + lane * 4);
                v[rr][i * 4 + 0] = t.x; v[rr][i * 4 + 1] = t.y; v[rr][i * 4 + 2] = t.z; v[rr][i * 4 + 3] = t.w;
            }
        }
        float mu[4], rstd[4];
#pragma unroll
        for (int rr = 0; rr < 4; ++rr) {
            float s = 0.f;
#pragma unroll
            for (int i = 0; i < 16; ++i) s += v[rr][i];
            mu[rr] = wave_sum(s) * (1.f / 1024.f);
            float q = 0.f;
#pragma unroll
            for (int i = 0; i < 16; ++i) { const float d = v[rr][i] - mu[rr]; q += d * d; }
            rstd[rr] = rsqrtf(wave_sum(q) * (1.f / 1024.f) + 1e-5f);
        }
        const float* g = p.in(I_LNG) + (size_t)(l * 2) * 1024;
        const float* bb = p.in(I_LNB) + (size_t)(l * 2) * 1024;
        const float* sh = modp(p, l, mr, 3);
        const float* sc = modp(p, l, mr, 4);
#pragma unroll
        for (int i = 0; i < 4; ++i) {
            const float4 gg = *reinterpret_cast<const float4*>(g + i * 256 + lane * 4);
            const float4 b4 = *reinterpret_cast<const float4*>(bb + i * 256 + lane * 4);
            const float4 s4 = *reinterpret_cast<const float4*>(sc + i * 256 + lane * 4);
            const float4 h4 = *reinterpret_cast<const float4*>(sh + i * 256 + lane * 4);
#pragma unroll
            for (int rr = 0; rr < 4; ++rr) {
                const int row = u * 16 + w * 4 + rr;
                const float n0 = (v[rr][i * 4 + 0] - mu[rr]) * rstd[rr] * gg.x + b4.x, n1 = (v[rr][i * 4 + 1] - mu[rr]) * rstd[rr] * gg.y + b4.y;
                const float n2 = (v[rr][i * 4 + 2] - mu[rr]) * rstd[rr] * gg.z + b4.z, n3 = (v[rr][i * 4 + 3] - mu[rr]) * rstd[rr] * gg.w + b4.w;
                *reinterpret_cast<float4*>(xrow(p, row) + i * 256 + lane * 4) = make_float4(ALPHA * n0, ALPHA * n1, ALPHA * n2, ALPHA * n3);
                const float h0 = n0 * (1.f + s4.x) + h4.x, h1 = n1 * (1.f + s4.y) + h4.y, h2 = n2 * (1.f + s4.z) + h4.z, h3 = n3 * (1.f + s4.w) + h4.w;
                *reinterpret_cast<unsigned*>(hb8 + (size_t)row * DM + i * 256 + lane * 4) = pack4_f8(h0, h1, h2, h3);
                *reinterpret_cast<float4*>(hbuf + (w * 4 + rr) * 1028 + i * 256 + lane * 4) = make_float4(h0, h1, h2, h3);
            }
        }
    }
    float* part = hbuf;
    __syncthreads();
    {
        const int fr = lane & 15, fq = lane >> 4;
        const float* rwb = p.in(I_ROUTER_W) + (size_t)l * 1024 * 64 + fr * 4;
        const float* hrow = hbuf + fr * 1028 + fq;
        f32x4 ac[4];
#pragma unroll
        for (int nf = 0; nf < 4; ++nf) ac[nf] = f32x4{0.f, 0.f, 0.f, 0.f};
#pragma unroll 16
        for (int k = w * 256; k < w * 256 + 256; k += 4) {
            const float av = hrow[k];
            const float4 b = *reinterpret_cast<const float4*>(rwb + (size_t)(k + fq) * 64);
            ac[0] = __builtin_amdgcn_mfma_f32_16x16x4f32(av, b.x, ac[0], 0, 0, 0);
            ac[1] = __builtin_amdgcn_mfma_f32_16x16x4f32(av, b.y, ac[1], 0, 0, 0);
            ac[2] = __builtin_amdgcn_mfma_f32_16x16x4f32(av, b.z, ac[2], 0, 0, 0);
            ac[3] = __builtin_amdgcn_mfma_f32_16x16x4f32(av, b.w, ac[3], 0, 0, 0);
        }
        __syncthreads();
#pragma unroll
        for (int r = 0; r < 4; ++r)
            *reinterpret_cast<float4*>(part + (w * 16 + fq * 4 + r) * 64 + fr * 4) = make_float4(ac[0][r], ac[1][r], ac[2][r], ac[3][r]);
    }
    __syncthreads();
    float lg[4];
#pragma unroll
    for (int rr = 0; rr < 4; ++rr) {
        const int r0 = w * 4 + rr;
        lg[rr] = part[(0 * 16 + r0) * 64 + lane] + part[(1 * 16 + r0) * 64 + lane] + part[(2 * 16 + r0) * 64 + lane] + part[(3 * 16 + r0) * 64 + lane];
    }
    const float rbias = p.in(I_ROUTER_B)[l * 64 + lane];
    unsigned* cnt = (unsigned*)(p.ws + WS_CTL) + CW_CNT(l);
    int* aep = (int*)(p.ws + WS_AEP); float* aw = (float*)(p.ws + WS_AW);
    bool selv[4]; int slotv[4]; float wgt[4];
#pragma unroll
    for (int rr = 0; rr < 4; ++rr) {
        const float s = 1.f / (1.f + expf(-lg[rr]));
        const float bsd = s + rbias;
        float m1 = bsd;
        m1 = fmaxf(m1, __shfl_xor(m1, 1)); m1 = fmaxf(m1, __shfl_xor(m1, 2)); m1 = fmaxf(m1, __shfl_xor(m1, 4));
        const unsigned long long eqm = __ballot(bsd == m1);
        const int gbase = lane & ~7;
        const unsigned gbits = (unsigned)((eqm >> gbase) & 0xFFull);
        const int first = gbase + __builtin_ctz(gbits);
        float m2 = (lane == first) ? -INFINITY : bsd;
        m2 = fmaxf(m2, __shfl_xor(m2, 1)); m2 = fmaxf(m2, __shfl_xor(m2, 2)); m2 = fmaxf(m2, __shfl_xor(m2, 4));
        const float gs = m1 + m2;
        const int myg = lane >> 3;
        int grank = 0;
#pragma unroll
        for (int g2 = 0; g2 < 8; ++g2) { const float o = __int_as_float(__builtin_amdgcn_readlane(__float_as_int(gs), g2 * 8)); grank += (o > gs || (o == gs && g2 < myg)) ? 1 : 0; }
        const bool gsel = grank < 4;
        const float msk = gsel ? bsd : -INFINITY;
        int erank = 0;
#pragma unroll
        for (int j = 0; j < 64; ++j) { const float o = __int_as_float(__builtin_amdgcn_readlane(__float_as_int(msk), j)); erank += (o > msk || (o == msk && j < lane)) ? 1 : 0; }
        const bool sel = gsel && erank < 8;
        const float wsum = wave_sum(sel ? s : 0.f);
        const unsigned long long selm = __ballot(sel);
        selv[rr] = sel; slotv[rr] = __popcll(selm & ((1ull << lane) - 1ull)); wgt[rr] = s / wsum * 2.5f;
    }
    unsigned posv[4];
#pragma unroll
    for (int rr = 0; rr < 4; ++rr) posv[rr] = selv[rr] ? atomicAdd(&cnt[lane * 32], 1u) : 0u;
#pragma unroll
    for (int rr = 0; rr < 4; ++rr) {
        const int row = u * 16 + w * 4 + rr;
        if (selv[rr]) {
            aep[(size_t)row * 8 + slotv[rr]] = (int)((unsigned)lane << 24 | posv[rr]);
            ((int*)(p.ws + WS_RTOK))[(size_t)lane * NT + posv[rr]] = row;
            aw[(size_t)row * 8 + slotv[rr]] = wgt[rr];
        }
    }
}


__device__ __forceinline__ void final_unit(const P& p, int u, char* lds) {
    const int tid = otid(), w = tid >> 6, lane = tid & 63;
    const int l = 1;
    const int* tbs = (const int*)(lds - LDS_USER + 1024);
    const unsigned char* y2 = (const unsigned char*)(p.ws + WS_Y2);
    const int* aep = (const int*)(p.ws + WS_AEP); const float* aw = (const float*)(p.ws + WS_AW);
    const int row0 = u * 8 + w * 2;
    const int mr = row_mod(row0);
    uint4 a0[2], a1[2]; float4 w0[2], w1[2];
#pragma unroll
    for (int rr = 0; rr < 2; ++rr) {
        const size_t o = (size_t)(row0 + rr) * 8;
        a0[rr] = *reinterpret_cast<const uint4*>(aep + o); a1[rr] = *reinterpret_cast<const uint4*>(aep + o + 4);
        w0[rr] = *reinterpret_cast<const float4*>(aw + o); w1[rr] = *reinterpret_cast<const float4*>(aw + o + 4);
    }
    float v[2][16];
    uint2 sv[2];
#pragma unroll
    for (int rr = 0; rr < 2; ++rr) {
        const float* xr = xrow(p, row0 + rr);
#pragma unroll
        for (int i = 0; i < 4; ++i) {
            const float4 t = *reinterpret_cast<const float4*>(xr + (i >> 1) * 512 + lane * 8 + (i & 1) * 4);
            v[rr][i * 4 + 0] = t.x; v[rr][i * 4 + 1] = t.y; v[rr][i * 4 + 2] = t.z; v[rr][i * 4 + 3] = t.w;
        }
        sv[rr] = *reinterpret_cast<const uint2*>(y2 + ((size_t)(SH_TILE_BASE * 128 + row0 + rr)) * 512 + lane * 8);
    }
    uint2 yv[2][8];
#pragma unroll
    for (int rr = 0; rr < 2; ++rr) {
        const unsigned cv[8] = {a0[rr].x, a0[rr].y, a0[rr].z, a0[rr].w, a1[rr].x, a1[rr].y, a1[rr].z, a1[rr].w};
#pragma unroll
        for (int k = 0; k < 8; ++k) {
            const int dest = tbs[cv[k] >> 24] * 128 + (int)(cv[k] & 0xFFFFFFu);
            yv[rr][k] = *reinterpret_cast<const uint2*>(y2 + (size_t)dest * 512 + lane * 8);
        }
    }
    const float4 g2 = *reinterpret_cast<const float4*>(modp(p, l, mr, 5) + 512 + lane * 8);
    const float4 g3 = *reinterpret_cast<const float4*>(modp(p, l, mr, 5) + 512 + lane * 8 + 4);
    const float* g = p.in(I_LNG) + (size_t)(l * 2 + 1) * 1024;
    const float* bb = p.in(I_LNB) + (size_t)(l * 2 + 1) * 1024;
    float4 gg[4], b4[4];
#pragma unroll
    for (int i = 0; i < 4; ++i) {
        gg[i] = *reinterpret_cast<const float4*>(g + (i >> 1) * 512 + lane * 8 + (i & 1) * 4);
        b4[i] = *reinterpret_cast<const float4*>(bb + (i >> 1) * 512 + lane * 8 + (i & 1) * 4);
    }
#pragma unroll
    for (int rr = 0; rr < 2; ++rr) {
        const float cw[8] = {w0[rr].x, w0[rr].y, w0[rr].z, w0[rr].w, w1[rr].x, w1[rr].y, w1[rr].z, w1[rr].w};
        float r8[8];
        {
            const int q0 = (int)sv[rr].x, q1 = (int)sv[rr].y;
            r8[0] = __builtin_amdgcn_cvt_f32_fp8(q0, 0); r8[1] = __builtin_amdgcn_cvt_f32_fp8(q0, 1); r8[2] = __builtin_amdgcn_cvt_f32_fp8(q0, 2); r8[3] = __builtin_amdgcn_cvt_f32_fp8(q0, 3);
            r8[4] = __builtin_amdgcn_cvt_f32_fp8(q1, 0); r8[5] = __builtin_amdgcn_cvt_f32_fp8(q1, 1); r8[6] = __builtin_amdgcn_cvt_f32_fp8(q1, 2); r8[7] = __builtin_amdgcn_cvt_f32_fp8(q1, 3);
        }
#pragma unroll
        for (int k = 0; k < 8; ++k) {
            const float wk = cw[k];
            const int q0 = (int)yv[rr][k].x, q1 = (int)yv[rr][k].y;
            r8[0] += wk * __builtin_amdgcn_cvt_f32_fp8(q0, 0); r8[1] += wk * __builtin_amdgcn_cvt_f32_fp8(q0, 1); r8[2] += wk * __builtin_amdgcn_cvt_f32_fp8(q0, 2); r8[3] += wk * __builtin_amdgcn_cvt_f32_fp8(q0, 3);
            r8[4] += wk * __builtin_amdgcn_cvt_f32_fp8(q1, 0); r8[5] += wk * __builtin_amdgcn_cvt_f32_fp8(q1, 1); r8[6] += wk * __builtin_amdgcn_cvt_f32_fp8(q1, 2); r8[7] += wk * __builtin_amdgcn_cvt_f32_fp8(q1, 3);
        }
        const float sc16 = 1.f / 16.f;
        v[rr][8] += sc16 * g2.x * r8[0]; v[rr][9] += sc16 * g2.y * r8[1]; v[rr][10] += sc16 * g2.z * r8[2]; v[rr][11] += sc16 * g2.w * r8[3];
        v[rr][12] += sc16 * g3.x * r8[4]; v[rr][13] += sc16 * g3.y * r8[5]; v[rr][14] += sc16 * g3.z * r8[6]; v[rr][15] += sc16 * g3.w * r8[7];
        float s = 0.f;
#pragma unroll
        for (int i = 0; i < 16; ++i) s += v[rr][i];
        const float mu = wave_sum(s) * (1.f / 1024.f);
        float q = 0.f;
#pragma unroll
        for (int i = 0; i < 16; ++i) { const float d = v[rr][i] - mu; q += d * d; }
        const float rstd = rsqrtf(wave_sum(q) * (1.f / 1024.f) + 1e-5f);
        float* xr = xrow(p, row0 + rr);
#pragma unroll
        for (int i = 0; i < 4; ++i)
            *reinterpret_cast<float4*>(xr + (i >> 1) * 512 + lane * 8 + (i & 1) * 4) =
                make_float4((v[rr][i * 4 + 0] - mu) * rstd * gg[i].x + b4[i].x, (v[rr][i * 4 + 1] - mu) * rstd * gg[i].y + b4[i].y,
                            (v[rr][i * 4 + 2] - mu) * rstd * gg[i].z + b4[i].z, (v[rr][i * 4 + 3] - mu) * rstd * gg[i].w + b4[i].w);
    }
}


__device__ __forceinline__ int s5_chain_row(int b, int d, int q);
__device__ __forceinline__ void s5_tab_unit(const P& p, int l, int u) {
    const int tid = otid();
    const int idx = u * 256 + tid;
    const int sblk = idx & 7, dgk = idx >> 3, dg = dgk >> 6, k = dgk & 63;
    const int tix = (l * 32 + dg) * 64 + k;
    const float4 A = *reinterpret_cast<const float4*>((const float*)(p.ws + WS_S5A) + (size_t)tix * 4);
    const float* Bp = (const float*)(p.ws + WS_S5B) + (size_t)tix * 32;
    float br[16], bi[16];
#pragma unroll
    for (int h = 0; h < 16; ++h) { br[h] = Bp[h]; bi[h] = Bp[16 + h]; }
    float wr_ = 1.f, wi_ = 0.f;
    const int n0 = 56 - 8 * sblk;
#pragma unroll 1
    for (int i = 0; i < n0; ++i) { const float nr = A.x * wr_ - A.y * wi_, ni = A.x * wi_ + A.y * wr_; wr_ = nr; wi_ = ni; }
    bf16_t* WB = (bf16_t*)(p.ws + WS_S5G);
#pragma unroll 1
    for (int q = 7; q >= 0; --q) {
        const int sidx = sblk * 8 + q;
        unsigned re[8], im[8];
#pragma unroll
        for (int h = 0; h < 16; h += 2) {
            re[h >> 1] = pack2(br[h] * wr_ - bi[h] * wi_, br[h + 1] * wr_ - bi[h + 1] * wi_);
            im[h >> 1] = pack2(br[h] * wi_ + bi[h] * wr_, br[h + 1] * wi_ + bi[h + 1] * wr_);
        }
        uint4* d0 = reinterpret_cast<uint4*>(WB + ((size_t)(dg * 128 + k) * 1024 + sidx * 16));
        uint4* d1 = reinterpret_cast<uint4*>(WB + ((size_t)(dg * 128 + 64 + k) * 1024 + sidx * 16));
        d0[0] = make_uint4(re[0], re[1], re[2], re[3]); d0[1] = make_uint4(re[4], re[5], re[6], re[7]);
        d1[0] = make_uint4(im[0], im[1], im[2], im[3]); d1[1] = make_uint4(im[4], im[5], im[6], im[7]);
        const float nr = A.x * wr_ - A.y * wi_, ni = A.x * wi_ + A.y * wr_; wr_ = nr; wi_ = ni;
    }
}
__device__ __forceinline__ void s5_pre_gemm_unit(const P& p, int l, int u, char* lds) {
    const int tid = otid(), w = tid >> 6, lane = tid & 63, fr = lane & 15, fq = lane >> 4;
    const int dg = u / 34, gidx = u % 34, d = dg >> 4, g = dg & 15;
    {
        const bf16_t* zb = (const bf16_t*)(p.ws + WS_Z) + COL_S5 + g * 16;
#pragma unroll
        for (int i = 0; i < 8; ++i) {
            const int id = tid + 256 * i, chunk = id >> 7, sidx = (id & 127) >> 1, hf = id & 1;
            const int cidx = gidx * 16 + chunk, bb = cidx / NCHUNK, cq = cidx % NCHUNK;
            const int row = s5_chain_row(bb, d, cq * 64 + sidx);
            *reinterpret_cast<uint4*>(lds + chunk * 2080 + sidx * 32 + hf * 16) = *reinterpret_cast<const uint4*>(zb + (size_t)row * ZS + hf * 8);
        }
    }
    __syncthreads();
    const int c = gidx * 16 + fr, b = c / NCHUNK, cc = c % NCHUNK;
    const char* ubl = lds + fr * 2080 + (fq >> 1) * 32 + (fq & 1) * 16;
    const bf16_t* WB = (const bf16_t*)(p.ws + WS_S5G) + ((size_t)(dg * 128 + w * 32 + fr) * 1024 + fq * 8);
    f32x4 acc0 = f32x4{0.f, 0.f, 0.f, 0.f}, acc1 = f32x4{0.f, 0.f, 0.f, 0.f};
#pragma unroll 8
    for (int ks = 0; ks < 32; ++ks) {
        const bf16x8 bf = *reinterpret_cast<const bf16x8*>(ubl + ks * 64);
        const bf16x8 a0 = *reinterpret_cast<const bf16x8*>(WB + ks * 32);
        const bf16x8 a1 = *reinterpret_cast<const bf16x8*>(WB + 16 * 1024 + ks * 32);
        acc0 = __builtin_amdgcn_mfma_f32_16x16x32_bf16(a0, bf, acc0, 0, 0, 0);
        acc1 = __builtin_amdgcn_mfma_f32_16x16x32_bf16(a1, bf, acc1, 0, 0, 0);
    }
    float* st = (float*)(p.ws + WS_S5ST) + ((((size_t)(b * NCHUNK + cc) * 2 + d) * 16 + g) * 64) * 2;
    const int part = w >> 1, k0 = (w & 1) * 32 + fq * 4;
    *reinterpret_cast<float4*>(st + part * 64 + k0) = make_float4(acc0[0], acc0[1], acc0[2], acc0[3]);
    *reinterpret_cast<float4*>(st + part * 64 + k0 + 16) = make_float4(acc1[0], acc1[1], acc1[2], acc1[3]);
    __syncthreads();
}

__device__ __forceinline__ void filt_unit(const P& p, int l, int u, char* lds) {
    const int tid = otid();
    float* feat = (float*)lds;
    float* h1 = feat + 4 * 36;
    float* h2 = h1 + 4 * 64;
    const int pp = tid >> 6, j = tid & 63;
    const int pi = u * 4 + pp;
    const int L = pi < 4096 ? 4096 : 256;
    const int t = pi < 4096 ? pi : pi - 4096;
    const float tt = (float)t / (float)(L - 1);
    if (j < 33) {
        float f;
        if (j == 0) f = tt;
        else {
            const int k = (j - 1) & 15;
            const float band = 1e-4f + (float)k * ((15.0f - 1e-4f) / 15.0f);
            float ph = band * (float)t * (1.f / (float)L);
            ph -= floorf(ph);
            float sn, cs; sincospif(2.f * ph, &sn, &cs);
            f = (j <= 16) ? cs : -sn;
        }
        feat[pp * 36 + j] = f;
    }
    __syncthreads();
    {
        const float* w1 = p.in(I_HY_W1) + (size_t)l * 33 * 64;
        float a = p.in(I_HY_B1)[l * 64 + j];
        for (int i = 0; i < 33; ++i) a += feat[pp * 36 + i] * w1[i * 64 + j];
        h1[pp * 64 + j] = sinf(p.in(I_HY_F1)[l * 64 + j] * a);
    }
    __syncthreads();
    {
        const float* w2 = p.in(I_HY_W2) + (size_t)l * 64 * 64;
        float a = p.in(I_HY_B2)[l * 64 + j];
        for (int i = 0; i < 64; ++i) a += h1[pp * 64 + i] * w2[i * 64 + j];
        h2[pp * 64 + j] = sinf(p.in(I_HY_F2)[l * 64 + j] * a);
    }
    __syncthreads();
    {
        const int c = tid;
        const float* w3 = p.in(I_HY_W3) + (size_t)l * 64 * 1024;
        float acc[4][4];
#pragma unroll
        for (int a = 0; a < 4; ++a)
#pragma unroll
            for (int b = 0; b < 4; ++b) acc[a][b] = 0.f;
#pragma unroll 8
        for (int i = 0; i < 64; ++i) {
            float wv[4];
#pragma unroll
            for (int os = 0; os < 4; ++os) wv[os] = w3[i * 1024 + os * 256 + c];
#pragma unroll
            for (int q = 0; q < 4; ++q) {
                const float hv = h2[q * 64 + i];
#pragma unroll
                for (int os = 0; os < 4; ++os) acc[q][os] += hv * wv[os];
            }
        }
        const float d0 = logf(0.01f) / 1.5f, d1 = logf(0.01f) / 0.3f;
        const float delta = fabsf(d0 + (d1 - d0) * ((float)c / 255.f));
        const int pq0 = u * 4;
        const bool lng = pq0 < 4096;
        const int Lq = lng ? 4096 : 256;
        const int tq0 = lng ? pq0 : pq0 - 4096;
        float dec[4];
#pragma unroll
        for (int q = 0; q < 4; ++q) dec[q] = expf(-((float)(tq0 + q) / (float)(Lq - 1)) * delta);
        float* F = lng ? (float*)(p.ws + WS_FILTL + l * SZ_FILTL) : (float*)(p.ws + WS_FILTC + l * SZ_FILTC);
#pragma unroll
        for (int os = 0; os < 4; ++os) {
            const size_t off = lng ? ((size_t)((os >> 1) * 256 + c) * 2 + (os & 1)) * 4096 + tq0 : ((size_t)os * 256 + c) * Lq + tq0;
            *reinterpret_cast<float4*>(F + off) = make_float4(acc[0][os] * dec[0], acc[1][os] * dec[1], acc[2][os] * dec[2], acc[3][os] * dec[3]);
        }
    }
    __syncthreads();
}

__device__ __forceinline__ void rwkv_prep_unit(const P& p, int l, int u, char* lds) {
    const int tid = otid();
    bf16_t* twb = (bf16_t*)lds;
    bf16_t* alb = twb + 32 * 72;
    bf16_t* ot = alb + 32 * 72;
    const bf16_t* z = (const bf16_t*)(p.ws + WS_Z);
    bf16_t* rwp = (bf16_t*)(p.ws + WS_R1 + R1_RWP);
    float* knorm = (float*)(p.ws + WS_KNORM);
    const int row0 = u * 32;
    {
        const int tok = tid >> 3, j0 = (tid & 7) * 8;
        const bf16_t* zr = z + (size_t)(row0 + tok) * ZS;
        float wl[8];
        unpack8(*reinterpret_cast<const uint4*>(zr + 768 + j0), wl);
#pragma unroll
        for (int i = 0; i < 8; ++i) wl[i] = 1.f - 2.f * __frcp_rn(1.f + __expf(2.f * wl[i]));
        *reinterpret_cast<uint4*>(twb + tok * 72 + j0) = pack8(wl);
        *reinterpret_cast<uint4*>(alb + tok * 72 + j0) = *reinterpret_cast<const uint4*>(zr + 832 + j0);
    }
    {
        const int tl = tid >> 5, cg = tid & 31, c0 = cg * 8;
        float kk[8];
#pragma unroll
        for (int i = 0; i < 8; ++i) kk[i] = p.in(I_RW_KK)[l * 256 + c0 + i];
#pragma unroll
        for (int it = 0; it < 4; ++it) {
            const int row = row0 + it * 8 + tl;
            float k[8];
            unpack8(*reinterpret_cast<const uint4*>(z + (size_t)row * ZS + 256 + c0), k);
            float ss = 0.f;
#pragma unroll
            for (int i = 0; i < 8; ++i) { const float kv = k[i] * kk[i]; ss += kv * kv; }
            ss = sum8lanes(ss);
            if ((cg & 7) == 0) knorm[(size_t)row * 4 + (cg >> 3)] = rsqrtf(ss + 1e-12f);
        }
    }
    __syncthreads();
    const int w = tid >> 6, lane = tid & 63, fr = lane & 15, fq = lane >> 4;
#pragma unroll 1
    for (int combo = 0; combo < 4; ++combo) {
        const int kind = combo >> 1, d = combo & 1;
        const bf16_t* At = kind ? alb : twb;
        const bf16_t* Bt = (const bf16_t*)(p.ws + (kind ? WS_LA2T : WS_LW2T)) + (size_t)l * 256 * 64;
        const float* basep = (kind ? p.in(I_RW_A0) : p.in(I_RW_W0)) + (l * 2 + d) * 256;
        bf16x8 af[2], bfr[4];
#pragma unroll
        for (int mf = 0; mf < 2; ++mf) af[mf] = *reinterpret_cast<const bf16x8*>(At + (mf * 16 + fr) * 72 + d * 32 + fq * 8);
#pragma unroll
        for (int nf = 0; nf < 4; ++nf) bfr[nf] = *reinterpret_cast<const bf16x8*>(Bt + (size_t)(w * 64 + nf * 16 + fr) * 64 + d * 32 + fq * 8);
#pragma unroll
        for (int nf = 0; nf < 4; ++nf) {
            const float base = basep[w * 64 + nf * 16 + fr];
#pragma unroll
            for (int mf = 0; mf < 2; ++mf) {
                const f32x4 acc = __builtin_amdgcn_mfma_f32_16x16x32_bf16(af[mf], bfr[nf], f32x4{0.f, 0.f, 0.f, 0.f}, 0, 0, 0);
#pragma unroll
                for (int j = 0; j < 4; ++j) {
                    const float a = base + acc[j];
                    float o;
                    if (kind) o = __frcp_rn(1.f + __expf(-a));
                    else { const float na = -a; const float sp = fmaxf(na, 0.f) + __logf(1.f + __expf(-fabsf(na))); o = __expf(-sp - 0.5f); }
                    ot[(mf * 16 + fq * 4 + j) * 264 + w * 64 + nf * 16 + fr] = f2bf(o);
                }
            }
        }
        __syncthreads();
#pragma unroll
        for (int i = 0; i < 4; ++i) {
            const int id = tid + 256 * i, tok = id >> 5, c8 = (id & 31) * 8;
            *reinterpret_cast<uint4*>(rwp + ((size_t)(row0 + tok) * 4 + combo) * 256 + c8) = *reinterpret_cast<const uint4*>(ot + tok * 264 + c8);
        }
        __syncthreads();
    }
}

__device__ __forceinline__ void gdn_prep_unit(const P& p, int l, int u) {
    const int tid = otid();
    const bf16_t* z = (const bf16_t*)(p.ws + WS_Z);
    bf16_t* gq = (bf16_t*)(p.ws + WS_R1 + R1_GQ);
    float* gab = (float*)(p.ws + WS_GAB);
    const int row0 = u * 32;
    int seq0, seqL;
    if (row0 < NTC) { seq0 = row0 & ~255; seqL = 256; } else { seq0 = NTC + ((row0 - NTC) & ~4095); seqL = 4096; }
    const int tl = tid >> 5, cg = tid & 31;
#pragma unroll 1
    for (int pz = 0; pz < 3; ++pz) {
        const int ch0 = pz * 256 + cg * 8;
        float w0[8], w1[8], w2[8];
        {
            const float* cw = p.in(I_GD_CONV) + (size_t)l * 3 * 768 + ch0;
#pragma unroll
            for (int i = 0; i < 8; i += 4) {
                const float4 a = *reinterpret_cast<const float4*>(cw + i), b = *reinterpret_cast<const float4*>(cw + 768 + i), c = *reinterpret_cast<const float4*>(cw + 1536 + i);
                w0[i] = a.x; w0[i + 1] = a.y; w0[i + 2] = a.z; w0[i + 3] = a.w;
                w1[i] = b.x; w1[i + 1] = b.y; w1[i + 2] = b.z; w1[i + 3] = b.w;
                w2[i] = c.x; w2[i + 1] = c.y; w2[i + 2] = c.z; w2[i + 3] = c.w;
            }
        }
#pragma unroll 4
        for (int it = 0; it < 4; ++it) {
            const int row = row0 + it * 8 + tl;
            const bf16_t* zc = z + (size_t)row * ZS + COL_GD + ch0;
            const uint4 zero4 = make_uint4(0u, 0u, 0u, 0u);
            const uint4 vm = (row - 1 >= seq0) ? *reinterpret_cast<const uint4*>(zc - ZS) : zero4;
            const uint4 v0 = *reinterpret_cast<const uint4*>(zc);
            const uint4 vp = (row + 1 < seq0 + seqL) ? *reinterpret_cast<const uint4*>(zc + ZS) : zero4;
            float xm[8], x0[8], xp[8], o[8];
            unpack8(vm, xm); unpack8(v0, x0); unpack8(vp, xp);
            float ss = 0.f;
#pragma unroll
            for (int i = 0; i < 8; ++i) { o[i] = siluf(w0[i] * xm[i] + w1[i] * x0[i] + w2[i] * xp[i]); ss += o[i] * o[i]; }
            if (pz < 2) {
                ss = sum8lanes(ss);
                const float sc = rsqrtf(ss + 1e-12f) * (pz == 0 ? 0.125f : 1.f);
#pragma unroll
                for (int i = 0; i < 8; ++i) o[i] *= sc;
            }
            *reinterpret_cast<uint4*>(gq + (size_t)row * 768 + ch0) = pack8(o);
        }
    }
    {
        const int tok = tid >> 3, dh = tid & 7;
        const int row = row0 + tok;
        const float alv = bf2f(z[(size_t)row * ZS + COL_GD + 1024 + dh]);
        const float blv = bf2f(z[(size_t)row * ZS + COL_GD + 1032 + dh]);
        const float g = -expf(p.in(I_GD_ALOG)[l * 8 + dh]) * softplusf(alv + p.in(I_GD_DTB)[l * 8 + dh]);
        gab[(size_t)row * 16 + dh] = expf(g);
        gab[(size_t)row * 16 + 8 + dh] = 1.f / (1.f + expf(-blv));
    }
}

__device__ __forceinline__ int s5_chain_row(int b, int d, int q) {
    if (q < 256) return b * 256 + (d ? 255 - q : q);
    int n = q - 256; if (d) n = 4095 - n;
    return NTC + b * 4096 + (n & 63) * 64 + (n >> 6);
}
__device__ __forceinline__ void s5_load_u(const bf16_t* zr, float* dst) {
    const uint4 a = *reinterpret_cast<const uint4*>(zr);
    const uint4 b = *reinterpret_cast<const uint4*>(zr + 8);
    *reinterpret_cast<float4*>(dst + 0) = make_float4(bflo(a.x), bfhi(a.x), bflo(a.y), bfhi(a.y));
    *reinterpret_cast<float4*>(dst + 4) = make_float4(bflo(a.z), bfhi(a.z), bflo(a.w), bfhi(a.w));
    *reinterpret_cast<float4*>(dst + 8) = make_float4(bflo(b.x), bfhi(b.x), bflo(b.y), bfhi(b.y));
    *reinterpret_cast<float4*>(dst + 12) = make_float4(bflo(b.z), bfhi(b.z), bflo(b.w), bfhi(b.w));
}

__device__ __forceinline__ void s5_pre_unit(const P& p, int l, int u, char* lds) {
    const int tid = otid(), w = tid >> 6, lane = tid & 63;
    float* ust = (float*)lds + w * 1024;
    const int wt = u * 4 + w;
    const int d = wt & 1, g = (wt >> 1) & 15, rest = wt >> 5;
    const int cc = rest % NCHUNK, b = rest / NCHUNK;
    const bf16_t* z = (const bf16_t*)(p.ws + WS_Z);
    {
        const int row = s5_chain_row(b, d, cc * 64 + lane);
        s5_load_u(z + (size_t)row * ZS + COL_S5 + g * 16, ust + lane * 16);
    }
    const int tix = ((l * 2 + d) * 16 + g) * 64 + lane;
    const float4 A = *reinterpret_cast<const float4*>((const float*)(p.ws + WS_S5A) + (size_t)tix * 4);
    const float* Bp = (const float*)(p.ws + WS_S5B) + (size_t)tix * 32;
    f32x2 bb[16];
#pragma unroll
    for (int h = 0; h < 16; ++h) bb[h] = f32x2{Bp[h], Bp[16 + h]};
    float xr = 0.f, xi = 0.f;
#pragma unroll 4
    for (int s = 0; s < 64; ++s) {
        f32x2 bu = f32x2{0.f, 0.f};
#pragma unroll
        for (int h4 = 0; h4 < 4; ++h4) {
            const float4 uu = *reinterpret_cast<const float4*>(ust + s * 16 + h4 * 4);
            bu += bb[h4 * 4] * uu.x + bb[h4 * 4 + 1] * uu.y + bb[h4 * 4 + 2] * uu.z + bb[h4 * 4 + 3] * uu.w;
        }
        const float nr = A.x * xr - A.y * xi + bu.x;
        const float ni = A.x * xi + A.y * xr + bu.y;
        xr = nr; xi = ni;
    }
    float* st = (float*)(p.ws + WS_S5ST) + ((((size_t)(b * NCHUNK + cc) * 2 + d) * 16 + g) * 64 + lane) * 2;
    st[0] = xr; st[1] = xi;
}

__device__ __forceinline__ float reduce16(const float (&t)[16], int lane) {
    float a[8];
    const bool hi8 = (lane & 8) != 0;
#pragma unroll
    for (int k = 0; k < 8; ++k) { const float keep = hi8 ? t[k + 8] : t[k]; const float send = hi8 ? t[k] : t[k + 8]; a[k] = keep + dppf<0x140>(send); }
    float b[4];
    const bool hi4 = (lane & 4) != 0;
#pragma unroll
    for (int k = 0; k < 4; ++k) { const float keep = hi4 ? a[k + 4] : a[k]; const float send = hi4 ? a[k] : a[k + 4]; b[k] = keep + dppf<0x141>(send); }
    float c[2];
    const bool hi2 = (lane & 2) != 0;
#pragma unroll
    for (int k = 0; k < 2; ++k) { const float keep = hi2 ? b[k + 2] : b[k]; const float send = hi2 ? b[k] : b[k + 2]; c[k] = keep + dppf<0x4E>(send); }
    const bool hi1 = (lane & 1) != 0;
    float r = (hi1 ? c[1] : c[0]) + dppf<0xB1>(hi1 ? c[0] : c[1]);
    r += __shfl_xor(r, 16);
    r += __shfl_xor(r, 32);
    return r;
}

__device__ __forceinline__ void s5_main_unit(const P& p, int l, int u, char* lds) {
    const int tid = otid(), w = tid >> 6, lane = tid & 63;
    char* wl = lds + w * 12800;
    float* ust = (float*)wl;
    char* xbuf = wl + 4096;
    float* yst = (float*)xbuf;
    const int b = u / NCHUNK, tc = u % NCHUNK;
    bf16_t* z = (bf16_t*)(p.ws + WS_Z);
    const int myrow = (tc < 4) ? (b * 256 + tc * 64 + lane) : (NTC + b * 4096 + lane * 64 + (tc - 4));
    const int fr = lane & 15, fq = lane >> 4;
#pragma unroll 1
    for (int gi = 0; gi < 4; ++gi) {
        const int g = w * 4 + gi;
        s5_load_u(z + (size_t)myrow * ZS + COL_S5 + g * 16, ust + lane * 16);
        bf16x4 ufr[4];
#pragma unroll
        for (int T = 0; T < 4; ++T) {
            const int tk = T * 16 + fr;
            const int trow = (tc < 4) ? (b * 256 + tc * 64 + tk) : (NTC + b * 4096 + tk * 64 + (tc - 4));
            const uint2 uv = *reinterpret_cast<const uint2*>(z + (size_t)trow * ZS + COL_S5 + g * 16 + fq * 4);
            ufr[T][0] = (short)(uv.x & 0xFFFFu); ufr[T][1] = (short)(uv.x >> 16); ufr[T][2] = (short)(uv.y & 0xFFFFu); ufr[T][3] = (short)(uv.y >> 16);
        }
        f32x4 yacc[4];
#pragma unroll
        for (int mf = 0; mf < 4; ++mf) yacc[mf] = f32x4{0.f, 0.f, 0.f, 0.f};
#pragma unroll 1
        for (int d = 0; d < 2; ++d) {
            const int tix = ((l * 2 + d) * 16 + g) * 64 + lane;
            const float4 A = *reinterpret_cast<const float4*>((const float*)(p.ws + WS_S5A) + (size_t)tix * 4);
            bf16x4 bfrag[8];
#pragma unroll
            for (int nt = 0; nt < 8; ++nt) {
                const float4 bv = *reinterpret_cast<const float4*>((const float*)(p.ws + WS_S5B) + (size_t)(((l * 2 + d) * 16 + g) * 64 + (nt & 3) * 16 + fr) * 32 + (nt >> 2) * 16 + fq * 4);
                bfrag[nt][0] = (short)f2bf(bv.x); bfrag[nt][1] = (short)f2bf(bv.y); bfrag[nt][2] = (short)f2bf(bv.z); bfrag[nt][3] = (short)f2bf(bv.w);
            }
            bf16x8 cfrag[4];
            {
                const float* crp = p.in(I_S5_CRE) + (size_t)((l * 2 + d) * 16 + g) * 1024 + fr * 64;
                const float* cip = p.in(I_S5_CIM) + (size_t)((l * 2 + d) * 16 + g) * 1024 + fr * 64;
#pragma unroll
                for (int ks = 0; ks < 4; ++ks) {
                    const int k0 = (ks & 1) * 32 + fq * 8;
                    const float* src = (ks < 2) ? crp + k0 : cip + k0;
                    const float sg = (ks < 2) ? 1.f : -1.f;
                    const float4 c0 = *reinterpret_cast<const float4*>(src), c1 = *reinterpret_cast<const float4*>(src + 4);
                    cfrag[ks][0] = (short)f2bf(sg * c0.x); cfrag[ks][1] = (short)f2bf(sg * c0.y); cfrag[ks][2] = (short)f2bf(sg * c0.z); cfrag[ks][3] = (short)f2bf(sg * c0.w);
                    cfrag[ks][4] = (short)f2bf(sg * c1.x); cfrag[ks][5] = (short)f2bf(sg * c1.y); cfrag[ks][6] = (short)f2bf(sg * c1.z); cfrag[ks][7] = (short)f2bf(sg * c1.w);
                }
            }
            const int cc = d ? ((tc < 4) ? 3 - tc : 71 - tc) : tc;
            float xr = 0.f, xi = 0.f;
            {
                const float* st = (const float*)(p.ws + WS_S5ST) + ((((size_t)(b * NCHUNK) * 2 + d) * 16 + g) * 64) * 2 + lane;
                for (int c0 = 0; c0 < cc; c0 += 8) {
                    float2 sv[8];
#pragma unroll
                    for (int q = 0; q < 8; ++q) {
                        const int c2 = (c0 + q < cc) ? c0 + q : cc - 1;
                        sv[q] = make_float2(st[(size_t)c2 * (2 * 16 * 64 * 2)], st[(size_t)c2 * (2 * 16 * 64 * 2) + 64]);
                    }
#pragma unroll
                    for (int q = 0; q < 8; ++q) {
                        if (c0 + q < cc) {
                            const float nr = A.z * xr - A.w * xi + sv[q].x;
                            const float ni = A.z * xi + A.w * xr + sv[q].y;
                            xr = nr; xi = ni;
                        }
                    }
                }
            }
#pragma unroll 1
            for (int hf = 0; hf < 2; ++hf) {
                const int hbase = (d ? 1 - hf : hf) * 32;
#pragma unroll
                for (int mt = 0; mt < 2; ++mt) {
                    const int T = (hbase >> 4) + mt;
                    const bf16x4 uf = (T == 0) ? ufr[0] : (T == 1) ? ufr[1] : (T == 2) ? ufr[2] : ufr[3];
#pragma unroll
                    for (int nt = 0; nt < 8; ++nt) {
                        const f32x4 dv = __builtin_amdgcn_mfma_f32_16x16x16bf16_1k(bfrag[nt], uf, f32x4{0.f, 0.f, 0.f, 0.f}, 0, 0, 0);
                        uint2 pk; pk.x = pack2(dv[0], dv[1]); pk.y = pack2(dv[2], dv[3]);
                        *reinterpret_cast<uint2*>(xbuf + (mt * 16 + fr) * 272 + (nt >> 2) * 128 + ((nt & 3) * 16 + fq * 4) * 2) = pk;
                    }
                }
#pragma unroll 4
                for (int s = 0; s < 32; ++s) {
                    const int il = d ? 31 - s : s;
                    const float bur = bf2f(*reinterpret_cast<const bf16_t*>(xbuf + il * 272 + lane * 2));
                    const float bui = bf2f(*reinterpret_cast<const bf16_t*>(xbuf + il * 272 + 128 + lane * 2));
                    const float nr = A.x * xr - A.y * xi + bur;
                    const float ni = A.x * xi + A.y * xr + bui;
                    xr = nr; xi = ni;
                    *reinterpret_cast<bf16_t*>(xbuf + il * 272 + lane * 2) = f2bf(xr);
                    *reinterpret_cast<bf16_t*>(xbuf + il * 272 + 128 + lane * 2) = f2bf(xi);
                }
#pragma unroll
                for (int mfl = 0; mfl < 2; ++mfl) {
                    f32x4 acc = yacc[0];
                    const int mf = (hbase >> 4) + mfl;
                    acc = (mf == 0) ? yacc[0] : (mf == 1) ? yacc[1] : (mf == 2) ? yacc[2] : yacc[3];
#pragma unroll
                    for (int ks = 0; ks < 4; ++ks) {
                        const bf16x8 af = *reinterpret_cast<const bf16x8*>(xbuf + (mfl * 16 + fr) * 272 + ks * 64 + fq * 16);
                        acc = __builtin_amdgcn_mfma_f32_16x16x32_bf16(af, cfrag[ks], acc, 0, 0, 0);
                    }
                    if (mf == 0) yacc[0] = acc; else if (mf == 1) yacc[1] = acc; else if (mf == 2) yacc[2] = acc; else yacc[3] = acc;
                }
            }
        }
#pragma unroll
        for (int mf = 0; mf < 4; ++mf)
#pragma unroll
            for (int j = 0; j < 4; ++j) yst[(mf * 16 + fq * 4 + j) * 16 + fr] = yacc[mf][j];
        {
            const float* dsk = p.in(I_S5_D) + l * 256 + g * 16;
            unsigned pk[8];
#pragma unroll
            for (int h = 0; h < 16; h += 2) {
                float y0 = yst[lane * 16 + h] + ust[lane * 16 + h] * dsk[h];
                float y1 = yst[lane * 16 + h + 1] + ust[lane * 16 + h + 1] * dsk[h + 1];
                y0 = 0.5f * y0 * (1.f + erff(y0 * 0.70710678118f));
                y1 = 0.5f * y1 * (1.f + erff(y1 * 0.70710678118f));
                pk[h >> 1] = pack2(y0, y1);
            }
            uint4* dst = reinterpret_cast<uint4*>((bf16_t*)(p.ws + WS_S5G) + (size_t)myrow * 256 + g * 16);
            dst[0] = make_uint4(pk[0], pk[1], pk[2], pk[3]);
            dst[1] = make_uint4(pk[4], pk[5], pk[6], pk[7]);
        }
    }
}

#define SB 16
__device__ __forceinline__ int scan_chain_row(int b, int d, int q) {
    if (q < 256) return b * 256 + (d ? 255 - q : q);
    const int t = q - 256;
    return NTC + b * 4096 + (d ? 4095 - t : t);
}
struct ScanRaw { uint2 r, k, v, e, a; float f0, f1; };

__device__ __forceinline__ void scan_load(const P& p, int m, int b, int h, int d, int q, int cg, ScanRaw& R) {
    const int row = scan_chain_row(b, d, q);
    const int c0 = h * 64 + cg * 4;
    if (m == 0) {
        const bf16_t* z = (const bf16_t*)(p.ws + WS_Z) + (size_t)row * ZS + c0;
        R.r = *reinterpret_cast<const uint2*>(z);
        R.k = *reinterpret_cast<const uint2*>(z + 256);
        R.v = *reinterpret_cast<const uint2*>(z + 512);
        const bf16_t* rw = (const bf16_t*)(p.ws + WS_R1 + R1_RWP) + (size_t)row * 1024 + c0;
        R.e = *reinterpret_cast<const uint2*>(rw + d * 256);
        R.a = *reinterpret_cast<const uint2*>(rw + (2 + d) * 256);
        R.f0 = ((const float*)(p.ws + WS_KNORM))[(size_t)row * 4 + h];
        R.f1 = 0.f;
    } else {
        const bf16_t* gq = (const bf16_t*)(p.ws + WS_R1 + R1_GQ) + (size_t)row * 768 + c0;
        R.r = *reinterpret_cast<const uint2*>(gq);
        R.k = *reinterpret_cast<const uint2*>(gq + 256);
        R.v = *reinterpret_cast<const uint2*>(gq + 512);
        R.e = make_uint2(0u, 0u); R.a = make_uint2(0u, 0u);
        const float* gab = (const float*)(p.ws + WS_GAB) + (size_t)row * 16;
        R.f0 = gab[d * 4 + h];
        R.f1 = gab[8 + d * 4 + h];
    }
}
__device__ __forceinline__ void scan_store(int m, const ScanRaw& R, float* dst  , const float (&kkp)[4], const float (&kap)[4]) {
    float r[4] = {bflo(R.r.x), bfhi(R.r.x), bflo(R.r.y), bfhi(R.r.y)};
    float k[4] = {bflo(R.k.x), bfhi(R.k.x), bflo(R.k.y), bfhi(R.k.y)};
    float v[4] = {bflo(R.v.x), bfhi(R.v.x), bflo(R.v.y), bfhi(R.v.y)};
    float ww[4], aa[4], bb[4], kk[4];
    if (m == 0) {
        float e[4] = {bflo(R.e.x), bfhi(R.e.x), bflo(R.e.y), bfhi(R.e.y)};
        float a[4] = {bflo(R.a.x), bfhi(R.a.x), bflo(R.a.y), bfhi(R.a.y)};
#pragma unroll
        for (int i = 0; i < 4; ++i) {
            ww[i] = __expf(-e[i]);
            kk[i] = k[i] * (1.f + (a[i] - 1.f) * kap[i]);
            const float kn = k[i] * kkp[i] * R.f0;
            aa[i] = -kn;
            bb[i] = kn * a[i];
        }
    } else {
        const float al = R.f0, be = R.f1;
#pragma unroll
        for (int i = 0; i < 4; ++i) { ww[i] = al; aa[i] = k[i]; bb[i] = -al * be * k[i]; kk[i] = be * k[i]; }
    }
    *reinterpret_cast<float4*>(dst + 0 * 64) = make_float4(ww[0], ww[1], ww[2], ww[3]);
    *reinterpret_cast<float4*>(dst + 1 * 64) = make_float4(aa[0], aa[1], aa[2], aa[3]);
    *reinterpret_cast<float4*>(dst + 2 * 64) = make_float4(bb[0], bb[1], bb[2], bb[3]);
    *reinterpret_cast<float4*>(dst + 3 * 64) = make_float4(kk[0], kk[1], kk[2], kk[3]);
    *reinterpret_cast<float4*>(dst + 4 * 64) = make_float4(r[0], r[1], r[2], r[3]);
    *reinterpret_cast<float4*>(dst + 5 * 64) = make_float4(v[0], v[1], v[2], v[3]);
}

__device__ __forceinline__ void scan_unit(const P& p, int l, int u, char* lds) {
    const int tid = otid();
    const int chain = u >> 1, half = u & 1;
    const int m = chain >> 6, rem = chain & 63, b = rem >> 3, h = (rem >> 1) & 3, d = rem & 1;
    float* buf = (float*)lds;
    float* ybuf = buf + 2 * SB * 384;
    const int rp = tid >> 4, sub = tid & 15;
    const int st = tid >> 4, cg = tid & 15;
    float kkp[4], kap[4];
#pragma unroll
    for (int i = 0; i < 4; ++i) { kkp[i] = p.in(I_RW_KK)[l * 256 + h * 64 + cg * 4 + i]; kap[i] = p.in(I_RW_KA)[l * 256 + h * 64 + cg * 4 + i]; }
    bf16_t* ys = (bf16_t*)(p.ws + WS_HBY) + (size_t)(m * 2 + d) * NT * 256;
    f32x2 S2[4];
#pragma unroll
    for (int j = 0; j < 4; ++j) S2[j] = f32x2{0.f, 0.f};
    ScanRaw R, R2;
    scan_load(p, m, b, h, d, st, cg, R);
    scan_store(m, R, buf + (st * 6) * 64 + cg * 4, kkp, kap);
    scan_load(p, m, b, h, d, SB + st, cg, R);
    __syncthreads();
    const int NB = 4352 / SB;
    __builtin_amdgcn_s_setprio(2);
    auto batch = [&](int bt, ScanRaw& Rld, ScanRaw& Rst) {
        const int par = bt & 1;
        if (bt + 2 < NB) scan_load(p, m, b, h, d, (bt + 2) * SB + st, cg, Rld);
        const float* cb = buf + par * (SB * 384);
        float* yb = ybuf + par * (SB * 32);
        {
            const float* sb0 = cb + sub * 4;
            const float* vb0 = cb + 320 + half * 32 + rp;
            float4 nw = *reinterpret_cast<const float4*>(sb0), na = *reinterpret_cast<const float4*>(sb0 + 64), nb = *reinterpret_cast<const float4*>(sb0 + 128);
            float4 nk = *reinterpret_cast<const float4*>(sb0 + 192), nr = *reinterpret_cast<const float4*>(sb0 + 256);
            float nvA = vb0[0], nvB = vb0[16];
            float4 mw = *reinterpret_cast<const float4*>(sb0 + 384), ma = *reinterpret_cast<const float4*>(sb0 + 384 + 64), mb = *reinterpret_cast<const float4*>(sb0 + 384 + 128);
            float4 mk = *reinterpret_cast<const float4*>(sb0 + 384 + 192), mr = *reinterpret_cast<const float4*>(sb0 + 384 + 256);
            float mvA = vb0[384], mvB = vb0[384 + 16];
#pragma unroll
            for (int s = 0; s < SB; ++s) {
                const float4 w = nw, a = na, bq = nb, k = nk, r = nr;
                const float vA = nvA, vB = nvB;
                nw = mw; na = ma; nb = mb; nk = mk; nr = mr; nvA = mvA; nvB = mvB;
                if (s + 2 < SB) {
                    const float* sb = sb0 + (s + 2) * 384;
                    mw = *reinterpret_cast<const float4*>(sb); ma = *reinterpret_cast<const float4*>(sb + 64); mb = *reinterpret_cast<const float4*>(sb + 128);
                    mk = *reinterpret_cast<const float4*>(sb + 192); mr = *reinterpret_cast<const float4*>(sb + 256);
                    mvA = vb0[(s + 2) * 384]; mvB = vb0[(s + 2) * 384 + 16];
                }
                __builtin_amdgcn_sched_barrier(0);
                const f32x2 v2 = {vA, vB};
                f32x2 sa2 = S2[0] * a.x + S2[1] * a.y + S2[2] * a.z + S2[3] * a.w;
                float sa = sa2.x, sb2 = sa2.y;
                dpp_allreduce16_x2(sa, sb2);
                sa2.x = sa; sa2.y = sb2;
                S2[0] = S2[0] * w.x + sa2 * bq.x + v2 * k.x;
                S2[1] = S2[1] * w.y + sa2 * bq.y + v2 * k.y;
                S2[2] = S2[2] * w.z + sa2 * bq.z + v2 * k.z;
                S2[3] = S2[3] * w.w + sa2 * bq.w + v2 * k.w;
                const f32x2 y2 = S2[0] * r.x + S2[1] * r.y + S2[2] * r.z + S2[3] * r.w;
                float yA = y2.x, yB = y2.y;
                dpp_allreduce16_x2(yA, yB);
                yb[s * 32 + rp] = yA; yb[s * 32 + 16 + rp] = yB;
            }
        }
        if (bt + 1 < NB) scan_store(m, Rst, buf + (1 - par) * (SB * 384) + (st * 6) * 64 + cg * 4, kkp, kap);
        __syncthreads();
        {
            const int r2 = cg * 2;
            const int row = scan_chain_row(b, d, bt * SB + st);
            const unsigned pk = pack2(yb[st * 32 + r2], yb[st * 32 + r2 + 1]);
            *reinterpret_cast<unsigned*>(ys + (size_t)row * 256 + h * 64 + half * 32 + r2) = pk;
        }
    };
#pragma unroll 1
    for (int bt = 0; bt < NB; bt += 2) { batch(bt, R2, R); batch(bt + 1, R, R2); }
    __builtin_amdgcn_s_setprio(0);
    __syncthreads();
}

__device__ __forceinline__ void scan_unit_gd2(const P& p, int l, int u, char* lds) {
    const int tid = otid();
    const int chain = 64 + (u >> 1), half = u & 1;
    const int m = chain >> 6, rem = chain & 63, b = rem >> 3, h = (rem >> 1) & 3, d = rem & 1;
    float* buf = (float*)lds;
    float* ybuf = buf + 2 * SB * 384;
    const int rp = tid >> 4, sub = tid & 15;
    const int st = tid >> 4, cg = tid & 15;
    float kkp[4], kap[4];
#pragma unroll
    for (int i = 0; i < 4; ++i) { kkp[i] = p.in(I_RW_KK)[l * 256 + h * 64 + cg * 4 + i]; kap[i] = p.in(I_RW_KA)[l * 256 + h * 64 + cg * 4 + i]; }
    bf16_t* ys = (bf16_t*)(p.ws + WS_HBY) + (size_t)(m * 2 + d) * NT * 256;
    f32x2 S2[4];
#pragma unroll
    for (int j = 0; j < 4; ++j) S2[j] = f32x2{0.f, 0.f};
    ScanRaw R, R2;
    scan_load(p, m, b, h, d, st, cg, R);
    scan_store(m, R, buf + (st * 6) * 64 + cg * 4, kkp, kap);
    scan_load(p, m, b, h, d, SB + st, cg, R);
    __syncthreads();
    const int NB = 4352 / SB;
    __builtin_amdgcn_s_setprio(2);
    auto batch = [&](int bt, ScanRaw& Rld, ScanRaw& Rst) {
        const int par = bt & 1;
        if (bt + 2 < NB) scan_load(p, m, b, h, d, (bt + 2) * SB + st, cg, Rld);
        const float* cb = buf + par * (SB * 384);
        float* yb = ybuf + par * (SB * 32);
        {
            const float* sb0 = cb + sub * 4;
            const float* vb0 = cb + 320 + half * 32 + rp;
            float4 na = *reinterpret_cast<const float4*>(sb0 + 64), nk = *reinterpret_cast<const float4*>(sb0 + 192), nr = *reinterpret_cast<const float4*>(sb0 + 256);
            float nal = cb[0], nvA = vb0[0], nvB = vb0[16];
            float4 ma = *reinterpret_cast<const float4*>(sb0 + 384 + 64), mk = *reinterpret_cast<const float4*>(sb0 + 384 + 192), mr = *reinterpret_cast<const float4*>(sb0 + 384 + 256);
            float mal = cb[384], mvA = vb0[384], mvB = vb0[384 + 16];
#pragma unroll
            for (int s = 0; s < SB; ++s) {
                const float4 a = na, k = nk, r = nr;
                const float al = nal, vA = nvA, vB = nvB;
                na = ma; nk = mk; nr = mr; nal = mal; nvA = mvA; nvB = mvB;
                if (s + 2 < SB) {
                    const float* sb = sb0 + (s + 2) * 384;
                    ma = *reinterpret_cast<const float4*>(sb + 64); mk = *reinterpret_cast<const float4*>(sb + 192); mr = *reinterpret_cast<const float4*>(sb + 256);
                    mal = cb[(s + 2) * 384]; mvA = vb0[(s + 2) * 384]; mvB = vb0[(s + 2) * 384 + 16];
                }
                __builtin_amdgcn_sched_barrier(0);
                const f32x2 v2 = {vA, vB};
                f32x2 d2 = S2[0] * a.x + S2[1] * a.y + S2[2] * a.z + S2[3] * a.w;
                float sa = d2.x, sb2 = d2.y;
                dpp_allreduce16_x2(sa, sb2);
                d2.x = sa; d2.y = sb2;
                const f32x2 e2 = v2 - d2 * al;
                S2[0] = S2[0] * al + e2 * k.x;
                S2[1] = S2[1] * al + e2 * k.y;
                S2[2] = S2[2] * al + e2 * k.z;
                S2[3] = S2[3] * al + e2 * k.w;
                const f32x2 y2 = S2[0] * r.x + S2[1] * r.y + S2[2] * r.z + S2[3] * r.w;
                float yA = y2.x, yB = y2.y;
                dpp_allreduce16_x2(yA, yB);
                yb[s * 32 + rp] = yA; yb[s * 32 + 16 + rp] = yB;
            }
        }
        if (bt + 1 < NB) scan_store(m, Rst, buf + (1 - par) * (SB * 384) + (st * 6) * 64 + cg * 4, kkp, kap);
        __syncthreads();
        {
            const int r2 = cg * 2;
            const int row = scan_chain_row(b, d, bt * SB + st);
            const unsigned pk = pack2(yb[st * 32 + r2], yb[st * 32 + r2 + 1]);
            *reinterpret_cast<unsigned*>(ys + (size_t)row * 256 + h * 64 + half * 32 + r2) = pk;
        }
    };
#pragma unroll 1
    for (int bt = 0; bt < NB; bt += 2) { batch(bt, R2, R); batch(bt + 1, R, R2); }
    __builtin_amdgcn_s_setprio(0);
    __syncthreads();
}

template <int L>
__device__ __forceinline__ void hyena_unit(const P& p, int l, int u, char* lds) {
    constexpr int TPT = L / 256;
    const int tid = otid();
    const int c = u >> 2, bp = u & 3;
    float2* u2 = (float2*)lds;
    float* taps = (float*)(lds + (size_t)L * 8);
    const bf16_t* z = (const bf16_t*)(p.ws + WS_Z);
    bf16_t* cat = (bf16_t*)(p.ws + WS_CAT);
    const float* F = (L == 4096) ? (const float*)(p.ws + WS_FILTL + l * SZ_FILTL) : (const float*)(p.ws + WS_FILTC + l * SZ_FILTC);
    int base[2];
#pragma unroll
    for (int bb = 0; bb < 2; ++bb) { const int b = bp * 2 + bb; base[bb] = (L == 4096) ? NTC + b * 4096 : b * 256; }
    const int t0 = tid * TPT;
    const float* cw = p.in(I_HY_CONV) + (size_t)l * 3 * 768; const float* cb = p.in(I_HY_CONVB) + (size_t)l * 768;
    auto sconv = [&](int part, int bb, float (&o)[TPT]) {
        const int ch = part * 256 + c;
        const float w0 = cw[ch], w1 = cw[768 + ch], w2 = cw[1536 + ch], bs = cb[ch];
        const bf16_t* zc = z + (size_t)base[bb] * ZS + COL_HY + ch;
        float xm = (t0 > 0) ? bf2f(zc[(size_t)(t0 - 1) * ZS]) : 0.f;
        float x0 = bf2f(zc[(size_t)t0 * ZS]);
#pragma unroll
        for (int i = 0; i < TPT; ++i) {
            const int t = t0 + i;
            const float xp = (t + 1 < L) ? bf2f(zc[(size_t)(t + 1) * ZS]) : 0.f;
            o[i] = w0 * xm + w1 * x0 + w2 * xp + bs;
            xm = x0; x0 = xp;
        }
    };
    {
        float v0[TPT], v1[TPT];
        sconv(2, 0, v0); sconv(2, 1, v1);
#pragma unroll
        for (int i = 0; i < TPT; ++i) u2[t0 + i] = make_float2(v0[i], v1[i]);
    }
#pragma unroll 1
    for (int o = 0; o < 2; ++o) {
        const float* hf = F + ((size_t)(o * 2 + 0) * 256 + c) * L;
        const float* hbk = F + ((size_t)(o * 2 + 1) * 256 + c) * L;
        for (int k = tid; k < 2 * L; k += NTHREADS) {
            const int dd = k - (L - 1);
            taps[k] = (dd >= L) ? 0.f : (dd >= 0 ? hf[dd] : hbk[-dd]);
        }
        __syncthreads();
        float acc[TPT][2];
#pragma unroll
        for (int i = 0; i < TPT; ++i) { acc[i][0] = 0.f; acc[i][1] = 0.f; }
        if (L == 4096) {
#pragma unroll 1
            for (int s0 = 0; s0 < L; s0 += 16) {
                const int k0 = t0 - s0 + (L - 16);
                float W[32];
#pragma unroll
                for (int q = 0; q < 8; ++q) {
                    const float4 t4 = *reinterpret_cast<const float4*>(taps + k0 + q * 4);
                    W[q * 4] = t4.x; W[q * 4 + 1] = t4.y; W[q * 4 + 2] = t4.z; W[q * 4 + 3] = t4.w;
                }
#pragma unroll
                for (int j = 0; j < 16; ++j) {
                    const float2 uj = u2[s0 + j];
#pragma unroll
                    for (int i = 0; i < TPT; ++i) {
                        const float wv = W[(i - j + 15) & 31];
                        acc[i][0] += wv * uj.x; acc[i][1] += wv * uj.y;
                    }
                }
            }
        } else {
            for (int s = 0; s < L; ++s) {
                const float2 uj = u2[s];
                const float wv = taps[t0 - s + (L - 1)];
                acc[0][0] += wv * uj.x; acc[0][1] += wv * uj.y;
            }
        }
        const float sk = p.in(I_HY_SKIP)[(size_t)(l * 2 + o) * 256 + c];
        float res[TPT][2];
        {
            float g0[TPT], g1[TPT];
            sconv(o, 0, g0); sconv(o, 1, g1);
#pragma unroll
            for (int i = 0; i < TPT; ++i) {
                const float2 ut = u2[t0 + i];
                res[i][0] = g0[i] * (acc[i][0] + sk * ut.x);
                res[i][1] = g1[i] * (acc[i][1] + sk * ut.y);
            }
        }
        __syncthreads();
        if (o == 0) {
#pragma unroll
            for (int i = 0; i < TPT; ++i) u2[t0 + i] = make_float2(res[i][0], res[i][1]);
        } else {
#pragma unroll
            for (int i = 0; i < TPT; ++i) {
                cat[(size_t)(base[0] + t0 + i) * DM + 512 + c] = f2bf(res[i][0]);
                cat[(size_t)(base[1] + t0 + i) * DM + 512 + c] = f2bf(res[i][1]);
            }
        }
        __syncthreads();
    }
}


#define FFT_BS 272
__device__ __forceinline__ int fphys(int d2, int d1, int d0) { return d2 * FFT_BS + d1 * 17 + d0; }
__device__ __forceinline__ float2 cmulf(float2 a, float2 b) { return make_float2(a.x * b.x - a.y * b.y, a.x * b.y + a.y * b.x); }
__device__ static constexpr float C32T[16] = {1.000000000e+00f, 9.807852804e-01f, 9.238795325e-01f, 8.314696123e-01f, 7.071067812e-01f, 5.555702330e-01f, 3.826834324e-01f, 1.950903220e-01f, 6.123233996e-17f, -1.950903220e-01f, -3.826834324e-01f, -5.555702330e-01f, -7.071067812e-01f, -8.314696123e-01f, -9.238795325e-01f, -9.807852804e-01f};
__device__ static constexpr float S32T[16] = {0.000000000e+00f, 1.950903220e-01f, 3.826834324e-01f, 5.555702330e-01f, 7.071067812e-01f, 8.314696123e-01f, 9.238795325e-01f, 9.807852804e-01f, 1.000000000e+00f, 9.807852804e-01f, 9.238795325e-01f, 8.314696123e-01f, 7.071067812e-01f, 5.555702330e-01f, 3.826834324e-01f, 1.950903220e-01f};
template <int LOG> __device__ __forceinline__ constexpr int brev(int i) { int r = 0; for (int b = 0; b < LOG; ++b) r |= ((i >> b) & 1) << (LOG - 1 - b); return r; }
template <int R, bool INV> __device__ __forceinline__ void dftR(float2 (&v)[R]) {
    constexpr int LOG = (R == 32) ? 5 : 4;
    float2 t[R];
#pragma unroll
    for (int i = 0; i < R; ++i) t[brev<LOG>(i)] = v[i];
#pragma unroll
    for (int st = 1; st <= LOG; ++st) {
        const int len = 1 << st, half = len >> 1;
#pragma unroll
        for (int i = 0; i < R; i += len)
#pragma unroll
            for (int j = 0; j < half; ++j) {
                const int tw = j * (32 / len);
                const float2 a = t[i + j], b = t[i + j + half];
                float2 bw;
                if (tw == 0) bw = b;
                else if (tw == 8) bw = INV ? make_float2(-b.y, b.x) : make_float2(b.y, -b.x);
                else { const float wr = C32T[tw], wi = INV ? S32T[tw] : -S32T[tw]; bw = make_float2(b.x * wr - b.y * wi, b.x * wi + b.y * wr); }
                t[i + j] = make_float2(a.x + bw.x, a.y + bw.y);
                t[i + j + half] = make_float2(a.x - bw.x, a.y - bw.y);
            }
    }
#pragma unroll
    for (int i = 0; i < R; ++i) v[i] = t[i];
}
template <int R> __device__ __forceinline__ void twiddle_pow(float2 (&v)[R], float2 first, float2 base) {
    float2 w = first;
#pragma unroll
    for (int k = 0; k < R; ++k) { v[k] = cmulf(v[k], w); w = cmulf(w, base); }
}
__device__ __forceinline__ float2 cispi(float x) { float sn, cs; sincospif(x, &sn, &cs); return make_float2(cs, sn); }

__device__ __forceinline__ void fft_fwd_A_B1(float2 (&v)[32], float2* buf, int tid_in) {
    int tid = tid_in; asm volatile("" : "+v"(tid));
    const int a = tid >> 4, b = tid & 15;
    dftR<32, false>(v);
    twiddle_pow<32>(v, make_float2(1.f, 0.f), cispi(-2.f * (float)tid * (1.f / 8192.f)));
#pragma unroll
    for (int k1 = 0; k1 < 32; ++k1) buf[fphys(k1, a, b)] = v[k1];
    __syncthreads();
#pragma unroll 1
    for (int j = 0; j < 2; ++j) {
        const int g = tid + 256 * j, k1 = g >> 4, bb = g & 15;
        float2 w[16];
#pragma unroll
        for (int aa = 0; aa < 16; ++aa) w[aa] = buf[fphys(k1, aa, bb)];
        dftR<16, false>(w);
        twiddle_pow<16>(w, make_float2(1.f, 0.f), cispi(-2.f * (float)bb * (1.f / 256.f)));
#pragma unroll
        for (int ka = 0; ka < 16; ++ka) buf[fphys(k1, ka, bb)] = w[ka];
    }
    __syncthreads();
}
__device__ __forceinline__ void fft_inv_B1_A(float2 (&v)[32], float2* buf, int tid_in) {
    int tid = tid_in; asm volatile("" : "+v"(tid));
#pragma unroll 1
    for (int j = 0; j < 2; ++j) {
        const int g = tid + 256 * j, k1 = g >> 4, bb = g & 15;
        float2 w[16];
#pragma unroll
        for (int ka = 0; ka < 16; ++ka) w[ka] = buf[fphys(k1, ka, bb)];
        dftR<16, true>(w);
        twiddle_pow<16>(w, cispi(2.f * (float)(k1 * bb) * (1.f / 8192.f)), cispi(2.f * (float)k1 * (1.f / 512.f)));
#pragma unroll
        for (int aa = 0; aa < 16; ++aa) buf[fphys(k1, aa, bb)] = w[aa];
    }
    __syncthreads();
    const int a = tid >> 4, b = tid & 15;
#pragma unroll
    for (int k1 = 0; k1 < 32; ++k1) v[k1] = buf[fphys(k1, a, b)];
    dftR<32, true>(v);
}

__device__ __forceinline__ void hfft_unit(const P& p, int l, int u, char* lds) {
    const int tid = otid();
    float2* buf = (float2*)lds;
    float* F = (float*)(p.ws + WS_FILTL + l * SZ_FILTL) + (size_t)u * 8192;
    float2 v[32];
#pragma unroll
    for (int n1 = 0; n1 < 32; ++n1) {
        const int n = 256 * n1 + tid;
        float x;
        if (n1 < 16) x = F[n];
        else x = (n == 4096) ? 0.f : F[4096 + (8192 - n)];
        if (n == 0) x += p.in(I_HY_SKIP)[(size_t)l * 512 + u];
        v[n1] = make_float2(x, 0.f);
    }
    fft_fwd_A_B1(v, buf, tid);
    __half2* H = (__half2*)F;
#pragma unroll 1
    for (int j = 0; j < 2; ++j) {
        const int g = tid + 256 * j, k1 = g >> 4, ka = g & 15;
        float2 w[16];
#pragma unroll
        for (int bb = 0; bb < 16; ++bb) w[bb] = buf[fphys(k1, ka, bb)];
        dftR<16, false>(w);
        unsigned pk[16];
#pragma unroll
        for (int kb = 0; kb < 16; ++kb) { const __half2 h = __floats2half2_rn(w[kb].x, w[kb].y); pk[kb] = *reinterpret_cast<const unsigned*>(&h); }
        uint4* dst = reinterpret_cast<uint4*>(H + (size_t)g * 16);
        dst[0] = make_uint4(pk[0], pk[1], pk[2], pk[3]); dst[1] = make_uint4(pk[4], pk[5], pk[6], pk[7]);
        dst[2] = make_uint4(pk[8], pk[9], pk[10], pk[11]); dst[3] = make_uint4(pk[12], pk[13], pk[14], pk[15]);
    }
    __syncthreads();
}

__device__ __forceinline__ void hyena_prep_unit(const P& p, int l, int u, char* lds) {
    const int tid = otid();
    bf16_t* tile = (bf16_t*)lds;
    const int b = u >> 6, t0 = (u & 63) * 64;
    const bf16_t* z = (const bf16_t*)(p.ws + WS_Z) + (size_t)(NTC + b * 4096) * ZS + COL_HY;
    bf16_t* hyT = (bf16_t*)(p.ws + WS_HYT);
    const float* cw = p.in(I_HY_CONV) + (size_t)l * 3 * 768; const float* cb = p.in(I_HY_CONVB) + (size_t)l * 768;
    const int tl = tid >> 5, cg = tid & 31;
#pragma unroll 1
    for (int part = 0; part < 3; ++part) {
        const int ch0 = part * 256 + cg * 8;
        float w0[8], w1[8], w2[8], bs[8];
#pragma unroll
        for (int i = 0; i < 8; ++i) { w0[i] = cw[ch0 + i]; w1[i] = cw[768 + ch0 + i]; w2[i] = cw[1536 + ch0 + i]; bs[i] = cb[ch0 + i]; }
#pragma unroll 8
        for (int it = 0; it < 8; ++it) {
            const int tk = it * 8 + tl, t = t0 + tk;
            const bf16_t* zc = z + (size_t)t * ZS + ch0;
            const uint4 zero4 = make_uint4(0u, 0u, 0u, 0u);
            const uint4 vm = (t > 0) ? *reinterpret_cast<const uint4*>(zc - ZS) : zero4;
            const uint4 v0 = *reinterpret_cast<const uint4*>(zc);
            const uint4 vp = (t + 1 < 4096) ? *reinterpret_cast<const uint4*>(zc + ZS) : zero4;
            float xm[8], x0[8], xp[8];
            unpack8(vm, xm); unpack8(v0, x0); unpack8(vp, xp);
#pragma unroll
            for (int i = 0; i < 8; ++i) tile[(cg * 8 + i) * 72 + tk] = f2bf(w0[i] * xm[i] + w1[i] * x0[i] + w2[i] * xp[i] + bs[i]);
        }
        __syncthreads();
#pragma unroll
        for (int k = 0; k < 8; ++k) {
            const int chl = (tid >> 3) + 32 * k, seg = tid & 7;
            const uint4 val = *reinterpret_cast<const uint4*>(tile + chl * 72 + seg * 8);
            *reinterpret_cast<uint4*>(hyT + ((size_t)(b * 3 + part) * 256 + chl) * 4096 + t0 + seg * 8) = val;
        }
        __syncthreads();
    }
}

template <int O>
__device__ __forceinline__ void hyena_conv_pass(const P& p, int l, int c, int bp, int tid, float2 (&v)[32], float2* buf) {
    const bf16_t* hyT = (const bf16_t*)(p.ws + WS_HYT);
#pragma unroll
    for (int j = 16; j < 32; ++j) v[j] = make_float2(0.f, 0.f);
    fft_fwd_A_B1(v, buf, tid);
    const __half2* H = (const __half2*)((const float*)(p.ws + WS_FILTL + l * SZ_FILTL) + (size_t)(O * 256 + c) * 8192);
    int tm = tid; asm volatile("" : "+v"(tm));
#pragma unroll 1
    for (int j = 0; j < 2; ++j) {
        const int g = tm + 256 * j, k1 = g >> 4, ka = g & 15;
        float2 w[16];
#pragma unroll
        for (int bb = 0; bb < 16; ++bb) w[bb] = buf[fphys(k1, ka, bb)];
        dftR<16, false>(w);
        const uint4* hp = reinterpret_cast<const uint4*>(H + (size_t)g * 16);
        unsigned hk[16];
#pragma unroll
        for (int q = 0; q < 4; ++q) { const uint4 t4 = hp[q]; hk[q * 4] = t4.x; hk[q * 4 + 1] = t4.y; hk[q * 4 + 2] = t4.z; hk[q * 4 + 3] = t4.w; }
#pragma unroll
        for (int kb = 0; kb < 16; ++kb) { const float2 hf = __half22float2(*reinterpret_cast<const __half2*>(&hk[kb])); w[kb] = cmulf(w[kb], hf); }
        dftR<16, true>(w);
        twiddle_pow<16>(w, make_float2(1.f, 0.f), cispi(2.f * (float)ka * (1.f / 256.f)));
#pragma unroll
        for (int bb = 0; bb < 16; ++bb) buf[fphys(k1, ka, bb)] = w[bb];
    }
    __syncthreads();
    fft_inv_B1_A(v, buf, tid);
    asm volatile("" ::: "memory");
    int tq = tid; asm volatile("" : "+v"(tq));
    const bf16_t* g0 = hyT + ((size_t)((bp * 2 + 0) * 3 + O) * 256 + c) * 4096 + tq;
    const bf16_t* g1 = hyT + ((size_t)((bp * 2 + 1) * 3 + O) * 256 + c) * 4096 + tq;
    const float sc = 1.f / 8192.f;
#pragma unroll
    for (int j = 0; j < 16; ++j) {
        const float ga = bf2f(g0[256 * j]) * sc, gb = bf2f(g1[256 * j]) * sc;
        v[j] = make_float2(ga * v[j].x, gb * v[j].y);
    }
    __syncthreads();
}

__device__ __forceinline__ void hyena_fft_unit(const P& p, int l, int u, char* lds) {
    const int tid = otid();
    const int c = u >> 2, bp = u & 3;
    float2* buf = (float2*)lds;
    const bf16_t* hyT = (const bf16_t*)(p.ws + WS_HYT);
    bf16_t* cat = (bf16_t*)(p.ws + WS_CAT);
    float2 v[32];
    {
        const bf16_t* v0p = hyT + ((size_t)((bp * 2 + 0) * 3 + 2) * 256 + c) * 4096 + tid;
        const bf16_t* v1p = hyT + ((size_t)((bp * 2 + 1) * 3 + 2) * 256 + c) * 4096 + tid;
#pragma unroll
        for (int j = 0; j < 16; ++j) v[j] = make_float2(bf2f(v0p[256 * j]), bf2f(v1p[256 * j]));
    }
    hyena_conv_pass<0>(p, l, c, bp, tid, v, buf);
    hyena_conv_pass<1>(p, l, c, bp, tid, v, buf);
    int tq = tid; asm volatile("" : "+v"(tq));
    bf16_t* o0 = (bf16_t*)(p.ws + WS_HYT) + ((size_t)((bp * 2 + 0) * 3 + 2) * 256 + c) * 4096 + tq;
    bf16_t* o1 = (bf16_t*)(p.ws + WS_HYT) + ((size_t)((bp * 2 + 1) * 3 + 2) * 256 + c) * 4096 + tq;
#pragma unroll
    for (int j = 0; j < 16; ++j) { o0[256 * j] = f2bf(v[j].x); o1[256 * j] = f2bf(v[j].y); }
}
__device__ __forceinline__ void hyena_out_unit(const P& p, int u, char* lds) {
    const int tid = otid();
    bf16_t* tile = (bf16_t*)lds;
    const int b = u >> 6, t0 = (u & 63) * 64;
    const bf16_t* hyT = (const bf16_t*)(p.ws + WS_HYT) + (size_t)(b * 3 + 2) * 256 * 4096 + t0;
    bf16_t* cat = (bf16_t*)(p.ws + WS_CAT) + (size_t)(NTC + b * 4096 + t0) * DM + 512;
    __syncthreads();
#pragma unroll
    for (int k = 0; k < 8; ++k) {
        const int chl = (tid >> 3) + 32 * k, seg = tid & 7;
        *reinterpret_cast<uint4*>(tile + chl * 72 + seg * 8) = *reinterpret_cast<const uint4*>(hyT + (size_t)chl * 4096 + seg * 8);
    }
    __syncthreads();
    const int tl = tid >> 5, cg = tid & 31;
#pragma unroll
    for (int it = 0; it < 8; ++it) {
        const int tk = it * 8 + tl;
        unsigned short e[8];
#pragma unroll
        for (int i = 0; i < 8; ++i) e[i] = tile[(cg * 8 + i) * 72 + tk];
        uint4 o;
        o.x = (unsigned)e[0] | ((unsigned)e[1] << 16); o.y = (unsigned)e[2] | ((unsigned)e[3] << 16); o.z = (unsigned)e[4] | ((unsigned)e[5] << 16); o.w = (unsigned)e[6] | ((unsigned)e[7] << 16);
        *reinterpret_cast<uint4*>(cat + (size_t)tk * DM + cg * 8) = o;
    }
    __syncthreads();
}


__device__ __forceinline__ void hyena_ctx_unit(const P& p, int l, int u, char* lds) {
    const int tid = otid();
    const int c0 = (u >> 3) * 4, b = u & 7;
    float4* raw = (float4*)lds;
    float4* u4 = raw + 3 * 258;
    float4* taps4 = u4 + 256;
    const bf16_t* z = (const bf16_t*)(p.ws + WS_Z) + (size_t)(b * 256 + tid) * ZS + COL_HY + c0;
#pragma unroll
    for (int part = 0; part < 3; ++part) {
        const uint2 v = *reinterpret_cast<const uint2*>(z + part * 256);
        raw[part * 258 + tid + 1] = make_float4(bflo(v.x), bfhi(v.x), bflo(v.y), bfhi(v.y));
    }
    if (tid < 3) { raw[tid * 258] = make_float4(0.f, 0.f, 0.f, 0.f); raw[tid * 258 + 257] = make_float4(0.f, 0.f, 0.f, 0.f); }
    __syncthreads();
    const float* cw = p.in(I_HY_CONV) + (size_t)l * 3 * 768; const float* cb = p.in(I_HY_CONVB) + (size_t)l * 768;
    float4 sc[3];
#pragma unroll
    for (int part = 0; part < 3; ++part) {
        const int ch = part * 256 + c0;
        const float4 w0 = *reinterpret_cast<const float4*>(cw + ch), w1 = *reinterpret_cast<const float4*>(cw + 768 + ch), w2 = *reinterpret_cast<const float4*>(cw + 1536 + ch);
        const float4 bs = *reinterpret_cast<const float4*>(cb + ch);
        const float4 xm = raw[part * 258 + tid], x0 = raw[part * 258 + tid + 1], xp = raw[part * 258 + tid + 2];
        sc[part] = make_float4(w0.x * xm.x + w1.x * x0.x + w2.x * xp.x + bs.x, w0.y * xm.y + w1.y * x0.y + w2.y * xp.y + bs.y,
                               w0.z * xm.z + w1.z * x0.z + w2.z * xp.z + bs.z, w0.w * xm.w + w1.w * x0.w + w2.w * xp.w + bs.w);
    }
    u4[tid] = sc[2];
    const float* F = (const float*)(p.ws + WS_FILTC + l * SZ_FILTC);
    bf16_t* cat = (bf16_t*)(p.ws + WS_CAT);
#pragma unroll 1
    for (int o = 0; o < 2; ++o) {
        const float* hf = F + ((size_t)(o * 2 + 0) * 256 + c0) * 256;
        const float* hbk = F + ((size_t)(o * 2 + 1) * 256 + c0) * 256;
#pragma unroll
        for (int kk = 0; kk < 2; ++kk) {
            const int k = tid + kk * 256, dd = k - 255;
            float4 tv = make_float4(0.f, 0.f, 0.f, 0.f);
            if (dd < 256) {
                const float* src = (dd >= 0) ? hf + dd : hbk - dd;
                tv = make_float4(src[0], src[256], src[512], src[768]);
            }
            taps4[k] = tv;
        }
        __syncthreads();
        float4 acc = make_float4(0.f, 0.f, 0.f, 0.f);
        const float4* tp = taps4 + tid + 255;
#pragma unroll 8
        for (int s2 = 0; s2 < 256; ++s2) {
            const float4 uj = u4[s2];
            const float4 wv = tp[-s2];
            acc.x += wv.x * uj.x; acc.y += wv.y * uj.y; acc.z += wv.z * uj.z; acc.w += wv.w * uj.w;
        }
        const float4 sk = *reinterpret_cast<const float4*>(p.in(I_HY_SKIP) + (size_t)(l * 2 + o) * 256 + c0);
        const float4 ut = u4[tid];
        const float4 gt = (o == 0) ? sc[0] : sc[1];
        const float4 res = make_float4(gt.x * (acc.x + sk.x * ut.x), gt.y * (acc.y + sk.y * ut.y), gt.z * (acc.z + sk.z * ut.z), gt.w * (acc.w + sk.w * ut.w));
        __syncthreads();
        if (o == 0) u4[tid] = res;
        else { uint2 pk; pk.x = pack2(res.x, res.y); pk.y = pack2(res.z, res.w); *reinterpret_cast<uint2*>(cat + (size_t)(b * 256 + tid) * DM + 512 + c0) = pk; }
        __syncthreads();
    }
}

__device__ __forceinline__ void rwkv_post_unit(const P& p, int l, int u, char* lds) {
    const int tid = otid();
    bf16_t* sgb = (bf16_t*)lds;
    float* gt = (float*)(lds + 4608);
    const bf16_t* z = (const bf16_t*)(p.ws + WS_Z);
    const bf16_t* rwp = (const bf16_t*)(p.ws + WS_R1 + R1_RWP);
    const bf16_t* ys = (const bf16_t*)(p.ws + WS_HBY);
    bf16_t* cat = (bf16_t*)(p.ws + WS_CAT);
    const int row0 = u * 32;
    {
        const int tok = tid >> 3, j0 = (tid & 7) * 8;
        float gl[8];
        unpack8(*reinterpret_cast<const uint4*>(z + (size_t)(row0 + tok) * ZS + 896 + j0), gl);
#pragma unroll
        for (int i = 0; i < 8; ++i) gl[i] = sigm(gl[i]);
        *reinterpret_cast<uint4*>(sgb + tok * 72 + j0) = pack8(gl);
    }
    __syncthreads();
    {
        const int w = tid >> 6, lane = tid & 63, fr = lane & 15, fq = lane >> 4;
        const bf16_t* g2t = (const bf16_t*)(p.ws + WS_G2T) + (size_t)l * 256 * 64;
        f32x4 acc[2][4];
#pragma unroll
        for (int mf = 0; mf < 2; ++mf)
#pragma unroll
            for (int nf = 0; nf < 4; ++nf) acc[mf][nf] = f32x4{0.f, 0.f, 0.f, 0.f};
#pragma unroll
        for (int ks = 0; ks < 2; ++ks) {
            bf16x8 af[2], bfr[4];
#pragma unroll
            for (int mf = 0; mf < 2; ++mf) af[mf] = *reinterpret_cast<const bf16x8*>(sgb + (mf * 16 + fr) * 72 + ks * 32 + fq * 8);
#pragma unroll
            for (int nf = 0; nf < 4; ++nf) bfr[nf] = *reinterpret_cast<const bf16x8*>(g2t + (size_t)(w * 64 + nf * 16 + fr) * 64 + ks * 32 + fq * 8);
#pragma unroll
            for (int mf = 0; mf < 2; ++mf)
#pragma unroll
                for (int nf = 0; nf < 4; ++nf) acc[mf][nf] = __builtin_amdgcn_mfma_f32_16x16x32_bf16(af[mf], bfr[nf], acc[mf][nf], 0, 0, 0);
        }
#pragma unroll
        for (int mf = 0; mf < 2; ++mf)
#pragma unroll
            for (int nf = 0; nf < 4; ++nf)
#pragma unroll
                for (int j = 0; j < 4; ++j) gt[(mf * 16 + fq * 4 + j) * 264 + w * 64 + nf * 16 + fr] = acc[mf][nf][j];
    }
    __syncthreads();
    {
        const int tl = tid >> 5, cg = tid & 31, c0 = cg * 8;
        float ka[8], rk[8], gng[8], gnb[8];
#pragma unroll
        for (int i = 0; i < 8; ++i) {
            ka[i] = p.in(I_RW_KA)[l * 256 + c0 + i]; rk[i] = p.in(I_RW_RK)[l * 256 + c0 + i];
            gng[i] = p.in(I_RW_GNG)[l * 256 + c0 + i]; gnb[i] = p.in(I_RW_GNB)[l * 256 + c0 + i];
        }
#pragma unroll 4
        for (int it = 0; it < 4; ++it) {
            const int tok = it * 8 + tl, row = row0 + tok;
            float ya[8], yb[8], r[8], k[8], v[8], a0[8], a1[8], o[8];
            unpack8(*reinterpret_cast<const uint4*>(ys + (size_t)row * 256 + c0), ya);
            unpack8(*reinterpret_cast<const uint4*>(ys + (size_t)NT * 256 + (size_t)row * 256 + c0), yb);
            const bf16_t* zr = z + (size_t)row * ZS + c0;
            unpack8(*reinterpret_cast<const uint4*>(zr), r);
            unpack8(*reinterpret_cast<const uint4*>(zr + 256), k);
            unpack8(*reinterpret_cast<const uint4*>(zr + 512), v);
            unpack8(*reinterpret_cast<const uint4*>(rwp + ((size_t)row * 4 + 2) * 256 + c0), a0);
            unpack8(*reinterpret_cast<const uint4*>(rwp + ((size_t)row * 4 + 3) * 256 + c0), a1);
            float sy = 0.f, sd = 0.f;
#pragma unroll
            for (int i = 0; i < 8; ++i) {
                ya[i] += yb[i]; sy += ya[i];
                const float kd = k[i] * (1.f + (a0[i] - 1.f) * ka[i]) + k[i] * (1.f + (a1[i] - 1.f) * ka[i]);
                sd += r[i] * kd * rk[i];
            }
            const float mu = sum8lanes(sy) * (1.f / 64.f);
            const float dot = sum8lanes(sd);
            float sq = 0.f;
#pragma unroll
            for (int i = 0; i < 8; ++i) { ya[i] -= mu; sq += ya[i] * ya[i]; }
            const float rs = rsqrtf(sum8lanes(sq) * (1.f / 64.f) + 64e-5f);
            const float4 g0 = *reinterpret_cast<const float4*>(gt + tok * 264 + c0), g1 = *reinterpret_cast<const float4*>(gt + tok * 264 + c0 + 4);
            const float gg[8] = {g0.x, g0.y, g0.z, g0.w, g1.x, g1.y, g1.z, g1.w};
#pragma unroll
            for (int i = 0; i < 8; ++i) o[i] = (ya[i] * rs * gng[i] + gnb[i] + dot * v[i]) * gg[i];
            *reinterpret_cast<uint4*>(cat + (size_t)row * DM + c0) = pack8(o);
        }
    }
    __syncthreads();
}

__device__ __forceinline__ void gdn_post_unit(const P& p, int l, int u) {
    const int tid = otid();
    const bf16_t* z = (const bf16_t*)(p.ws + WS_Z);
    const bf16_t* ys = (const bf16_t*)(p.ws + WS_HBY) + (size_t)2 * NT * 256;
    bf16_t* cat = (bf16_t*)(p.ws + WS_CAT);
    const int tl = tid >> 5, cg = tid & 31, c0 = cg * 8;
    float ng[8];
#pragma unroll
    for (int i = 0; i < 8; ++i) ng[i] = p.in(I_GD_NORM)[l * 64 + ((c0 + i) & 63)];
    const int row0 = u * 32;
#pragma unroll 4
    for (int it = 0; it < 4; ++it) {
        const int row = row0 + it * 8 + tl;
        const uint4 a4 = *reinterpret_cast<const uint4*>(ys + (size_t)row * 256 + c0);
        const uint4 b4 = *reinterpret_cast<const uint4*>(ys + (size_t)NT * 256 + (size_t)row * 256 + c0);
        const uint4 z4 = *reinterpret_cast<const uint4*>(z + (size_t)row * ZS + COL_GD + 768 + c0);
        float a[8], b[8], zg[8], o[8];
        unpack8(a4, a); unpack8(b4, b); unpack8(z4, zg);
        float ss = 0.f;
#pragma unroll
        for (int i = 0; i < 8; ++i) { o[i] = a[i] + b[i]; ss += o[i] * o[i]; }
        ss = sum8lanes(ss);
        const float sc = rsqrtf(ss * (1.f / 64.f) + 1e-6f);
#pragma unroll
        for (int i = 0; i < 8; ++i) o[i] = o[i] * sc * ng[i] * siluf(zg[i]);
        *reinterpret_cast<uint4*>(cat + (size_t)row * DM + 256 + c0) = pack8(o);
    }
}

__device__ __forceinline__ void load_tile_bases(unsigned* ctl, int l, int* tb) {
    const int tid = otid();
    __syncthreads();
    if (tid < 64) {
        const int c = (int)xb_ld(&ctl[CW_CNT(l) + tid * 32]);
        const int nt = (c + 127) >> 7;
        int incl = nt;
#pragma unroll
        for (int off = 1; off < 64; off <<= 1) { const int v = __shfl_up(incl, off); if (tid >= off) incl += v; }
        tb[130 + tid] = c; tb[66 + tid] = nt; tb[tid] = incl - nt;
        if (tid == 63) tb[64] = incl;
    }
    __syncthreads();
}

#define NPHASE 28
template <typename F>
__device__ __forceinline__ void strided(int n, F f) { for (int u = blockIdx.x; u < n; u += gridDim.x) f(u); }

__global__ void __launch_bounds__(NTHREADS, 2) fwd_kernel(KP kp) {
    extern __shared__ __attribute__((aligned(16))) char smem[];
    char* lds = smem + LDS_USER;
    {
    const int tid = otid();
    if (tid == 0) *reinterpret_cast<uint4*>(smem) = make_uint4(0u, 0u, 0u, 0u);
    if (tid < 52) { const unsigned long long v = (unsigned long long)kp.in[tid]; ((unsigned*)(smem + 512))[2 * tid] = (unsigned)v; ((unsigned*)(smem + 512))[2 * tid + 1] = (unsigned)(v >> 32); }
    }
    __syncthreads();
    P p; p.tab = (const __attribute__((address_space(3))) unsigned*)(smem + 512); p.out = kp.out; p.ws = kp.ws;
    unsigned* ctl = (unsigned*)(p.ws + WS_CTL);
    XcdBarrier bar = xcd_barrier_post(ctl, (volatile LAS unsigned*)smem);
    const int lo = kp.ph_lo, hi = kp.ph_hi;
#define PHASE_BEGIN(ph) if ((ph) >= lo && (ph) < hi) { if ((ph) > lo) { xcd_barrier(bar); }
#define PHASE_END }
#define LANE_IDS const int tid = otid(); const int wid = tid >> 6, lane = tid & 63, wr = wid >> 1, wc = wid & 1, fr = lane & 15, fq = lane >> 4; (void)wid; (void)lane; (void)wr; (void)wc; (void)fr; (void)fq;

    PHASE_BEGIN(0)
        strided(192 + 64 + 32 + 24 + 2 * 2112, [&](int u) {
            if (u >= 312) {
                const int v0 = u - 312, ll = v0 / 2112, v = v0 % 2112;
                if (v < 1088) filt_unit(p, ll, v, lds);
                else if (v < 1856) { const int t = v - 1088; xpose_tile(p.in(I_WIN) + (size_t)ll * 1024 * 3024, 3024, (bf16_t*)(p.ws + WS_WINT + ll * SZ_WINT), 1024, 0, t / 48, t % 48, lds); }
                else { const int t = v - 1856; xpose_tile(p.in(I_WOUT) + (size_t)ll * 1024 * 1024, 1024, (bf16_t*)(p.ws + WS_WOUTT + ll * SZ_WOUTT), 1024, 0, t >> 4, t & 15, lds); }
            }
            else if (u < 192) ph0_mod_unit(p, u, lds);
            else if (u < 256) ph0_s5tab_unit(p, u - 192);
            else if (u >= 288) { const int v = u - 288, which = v >> 3, ll = (v >> 2) & 1, t = v & 3;
                   const float* src = (which == 0 ? p.in(I_RW_G2) : which == 1 ? p.in(I_RW_W2) : p.in(I_RW_A2)) + (size_t)ll * 64 * 256;
                   bf16_t* dst = (bf16_t*)(p.ws + (which == 0 ? WS_G2T : which == 1 ? WS_LW2T : WS_LA2T)) + (size_t)ll * 256 * 64;
                   xpose_tile(src, 256, dst, 64, 0, 0, t, lds); }
            else { const int v = u - 256, ll = v >> 4, t = v & 15;
                   xpose_tile(p.in(I_S5_GLUW) + (size_t)ll * 65536, 256, (bf16_t*)(p.ws + WS_GLUT) + (size_t)ll * 65536, 256, 0, t >> 2, t & 3, lds); }
        });
    PHASE_END

#pragma unroll 1
    for (int l = 0; l < 2; ++l) {
        const int pb = 1 + 13 * l;
        PHASE_BEGIN(pb + 0)
            if (l == 1) load_tile_bases(ctl, 0, (int*)(smem + 1024));
            strided(64 + 4352, [&](int u) { if (u < 64) s5_tab_unit(p, l, u); else if (l == 0) rows_unit<M_INIT>(p, l, u - 64, lds); else rows_unit<M_LN2NEXT>(p, l, u - 64, lds); });
        PHASE_END
        PHASE_BEGIN(pb + 1)
            {
                const int t_ = otid();
                const unsigned gcb = (unsigned)(((t_ & 7) ^ ((t_ >> 3) & 7)) * 16), r0_ = (unsigned)(t_ >> 3);
                gemm_phase<false, true>(p.ws + (l == 0 ? WS_HBY : WS_R1), p.ws + WS_WINT + l * SZ_WINT, 16, 272 * 24, lds,
                    [&](int u, GSrc& sr) __attribute__((always_inline)) {
                        const int q_ = u >> 3, g_ = q_ / 12;
                        const int mt = (g_ % 34) * 8 + (u & 7), nt = (g_ / 34) * 12 + (q_ % 12);
#pragma unroll
                        for (int i = 0; i < 4; ++i) {
                            sr.ao[i] = ((unsigned)(mt * 128) + r0_ + 32u * i) * (unsigned)(DM * 2) + gcb;
                            sr.bo[i] = ((unsigned)(nt * 128) + r0_ + 32u * i) * (unsigned)(DM * 2) + gcb;
                        }
                        return true;
                    },
                    [&](int u, f32x4 (&acc)[4][4]) __attribute__((always_inline)) {
                        LANE_IDS
                        const int q_ = u >> 3, g_ = q_ / 12;
                        const int mt = (g_ % 34) * 8 + (u & 7), nt = (g_ / 34) * 12 + (q_ % 12);
                        bf16_t* z = (bf16_t*)(p.ws + WS_Z);
#pragma unroll
                        for (int m = 0; m < 4; ++m) {
                            bf16_t* zr = z + (size_t)(mt * 128 + wr * 64 + m * 16 + fr) * ZS;
#pragma unroll
                            for (int n = 0; n < 4; ++n) {
                                const int col = nt * 128 + wc * 64 + n * 16 + fq * 4;
                                if (col < ZS) { uint2 pk; pk.x = pack2(acc[m][n][0], acc[m][n][1]); pk.y = pack2(acc[m][n][2], acc[m][n][3]); *reinterpret_cast<uint2*>(zr + col) = pk; }
                            }
                        }
                    });
            }
        PHASE_END
        PHASE_BEGIN(pb + 2)
            strided(512 + 512 + 1088 + 1088 + 1088, [&](int u) {
                if (u < 512) { if (kp.rep == 0) hfft_unit(p, l, u, lds); }
                else if (u < 1024) hyena_prep_unit(p, l, u - 512, lds);
                else if (u < 2112) rwkv_prep_unit(p, l, u - 1024, lds);
                else if (u < 3200) gdn_prep_unit(p, l, u - 2112);
                else s5_pre_gemm_unit(p, l, u - 3200, lds);
            });
        PHASE_END
        PHASE_BEGIN(pb + 3)
            {
                int* qslot = (int*)(smem + 64);
                const int NO = 1024 + 544 + 512;
                if (otid() == 0) {
                    const unsigned hw = (unsigned)__builtin_amdgcn_s_getreg((7 << 11) | (8 << 6) | 4);
                    const unsigned cuix = ((xb_xcc_id() & 15u) << 8) | (hw & 255u);
                    qslot[1] = (atomicAdd(&ctl[CW_CUCNT(l) + cuix], 1u) % 2u == 0u) ? 0 : 1;
                }
                __syncthreads();
                for (;;) {
                    if (otid() == 0) {
                        int stage = qslot[1], t = -1;
                        while (t < 0 && stage < 3) {
                            if (stage == 1) { const int q = (int)atomicAdd(&ctl[CW_QUEUE(l) + 16 + kp.rep], 1u); if (q < NO) t = 256 + (q < 544 ? 1024 + q : (q < 1568 ? q - 544 : q)); else stage = 2; }
                            else { const int q = (int)atomicAdd(&ctl[CW_QUEUE(l) + kp.rep], 1u); if (q < 256) t = q; else stage = (stage == 0) ? 1 : 3; }
                        }
                        qslot[1] = stage; qslot[0] = t;
                    }
                    __syncthreads();
                    const int u = qslot[0];
                    __syncthreads();
                    if (u < 0) break;
                    if (u < 128) { if (kp.rep != 2) scan_unit_gd2(p, l, u, lds); }
                    else if (u < 256) { if (kp.rep != 2) scan_unit(p, l, u - 128, lds); }
                    else if (kp.rep == 1) {}
                    else if (u < 1280) hyena_fft_unit(p, l, u - 256, lds);
                    else if (u < 1824) s5_main_unit(p, l, u - 1280, lds);
                    else hyena_ctx_unit(p, l, u - 1824, lds);
                    __syncthreads();
                }
            }
        PHASE_END
        PHASE_BEGIN(pb + 4)
            strided(1088 + 1088 + 544 + 512, [&](int u) {
                if (u >= 2720) hyena_out_unit(p, u - 2720, lds);
                else if (u < 1088) rwkv_post_unit(p, l, u, lds);
                else if (u < 2176) gdn_post_unit(p, l, u - 1088);
                else {
                    LANE_IDS
                    const int v = u - 2176, mt = v >> 1, nt = v & 1;
                    f32x4 acc[4][4];
                    const bf16_t* A = (const bf16_t*)(p.ws + WS_S5G);
                    gemm_tile<true>(A, 256, arows_lin(mt * 128, tid),
                              (const bf16_t*)(p.ws + WS_GLUT) + (size_t)l * 65536, 256, nt * 128, 256, lds, acc);
                    bf16_t* cat = (bf16_t*)(p.ws + WS_CAT);
#pragma unroll
                    for (int m = 0; m < 4; ++m) {
                        const int row = mt * 128 + wr * 64 + m * 16 + fr;
#pragma unroll
                        for (int n = 0; n < 4; ++n) {
                            const int col = nt * 128 + wc * 64 + n * 16 + fq * 4;
                            const float4 gb = *reinterpret_cast<const float4*>(p.in(I_S5_GLUB) + l * 256 + col);
                            const uint2 yv = *reinterpret_cast<const uint2*>(A + (size_t)row * 256 + col);
                            const float y0 = __uint_as_float(yv.x << 16), y1 = __uint_as_float(yv.x & 0xFFFF0000u), y2_ = __uint_as_float(yv.y << 16), y3 = __uint_as_float(yv.y & 0xFFFF0000u);
                            uint2 pk;
                            pk.x = pack2(y0 * sigm(acc[m][n][0] + gb.x), y1 * sigm(acc[m][n][1] + gb.y));
                            pk.y = pack2(y2_ * sigm(acc[m][n][2] + gb.z), y3 * sigm(acc[m][n][3] + gb.w));
                            *reinterpret_cast<uint2*>(cat + (size_t)row * DM + 768 + col) = pk;
                        }
                    }
                }
            });
        PHASE_END
        PHASE_BEGIN(pb + 5)
            {
                const int t_ = otid();
                const unsigned gcb = (unsigned)(((t_ & 7) ^ ((t_ >> 3) & 7)) * 16), r0_ = (unsigned)(t_ >> 3);
                const bool conv_first = (((blockIdx.x >> 3) ^ (blockIdx.x >> 8)) & 1u) != 0u;
#pragma unroll 1
                for (int pass = 0; pass < 2; ++pass) {
                    if ((pass == 0) == conv_first) {
                        strided(65 * 48, [&](int v) {
                            const int e = v / 48, t = v % 48, which = t >> 4, tt = t & 15;
                            unsigned char* W13 = (unsigned char*)(p.ws + WS_R1 + R1_W13T8) + (size_t)e * 512 * 1024;
                            unsigned char* W2 = (unsigned char*)(p.ws + WS_R1 + R1_W2T8) + (size_t)e * 1024 * 256;
                            if (which == 0) {
                                const float* src = (e < 64) ? p.in(I_EX_W1) + ((size_t)l * 64 + e) * 262144 : p.in(I_SH_W1) + (size_t)l * 262144;
                                xpose_strip4_f8(src, 256, W13, 1024, 1, tt, 0, 32.f, lds);
                            } else if (which == 1) {
                                const float* src = (e < 64) ? p.in(I_EX_W3) + ((size_t)l * 64 + e) * 262144 : p.in(I_SH_W3) + (size_t)l * 262144;
                                xpose_strip4_f8(src, 256, W13, 1024, 2, tt, 0, 32.f, lds);
                            } else {
                                const float* src = (e < 64) ? p.in(I_EX_W2) + ((size_t)l * 64 + e) * 262144 : p.in(I_SH_W2) + (size_t)l * 262144;
                                xpose_strip4_f8(src, 1024, W2, 256, 0, tt >> 2, (tt & 3) * 4, 32.f, lds);
                            }
                        });
                    } else {
                        gemm_phase<false, true>(p.ws + WS_CAT, p.ws + WS_WOUTT + l * SZ_WOUTT, 16, 2176, lds,
                            [&](int u, GSrc& sr) __attribute__((always_inline)) {
                                const int mt = ((u >> 3) >> 3) * 8 + (u & 7), nt = (u >> 3) & 7;
#pragma unroll
                                for (int i = 0; i < 4; ++i) {
                                    sr.ao[i] = ((unsigned)(mt * 128) + r0_ + 32u * i) * (unsigned)(DM * 2) + gcb;
                                    sr.bo[i] = ((unsigned)(nt * 128) + r0_ + 32u * i) * (unsigned)(DM * 2) + gcb;
                                }
                                return true;
                            },
                            [&](int u, f32x4 (&acc)[4][4]) __attribute__((always_inline)) {
                                LANE_IDS
                                const int mt = ((u >> 3) >> 3) * 8 + (u & 7), nt = (u >> 3) & 7;
                                const float ca = kp.rep ? 1.f : ALPHA, cb2 = kp.rep ? 0.f : 1.f;
#pragma unroll
                                for (int m = 0; m < 4; ++m) {
                                    const int row = mt * 128 + wr * 64 + m * 16 + fr;
                                    float* xr = xrow(p, row);
                                    const float* xs = (l == 0 && kp.rep == 0) ? (row < NTC ? p.in(I_CTX) + (size_t)row * DM : p.in(I_X) + (size_t)(row - NTC) * DM) : xr;
                                    const float* ga = modp(p, l, row_mod(row), 2);
#pragma unroll
                                    for (int n = 0; n < 4; ++n) {
                                        const int col = nt * 128 + wc * 64 + n * 16 + fq * 4;
                                        const float4 x4 = *reinterpret_cast<const float4*>(xs + col);
                                        const float4 g4 = *reinterpret_cast<const float4*>(ga + col);
                                        *reinterpret_cast<float4*>(xr + col) = make_float4(ca * x4.x + cb2 * g4.x * acc[m][n][0], ca * x4.y + cb2 * g4.y * acc[m][n][1],
                                                                                           ca * x4.z + cb2 * g4.z * acc[m][n][2], ca * x4.w + cb2 * g4.w * acc[m][n][3]);
                                    }
                                }
                            });
                        __syncthreads();
                    }
                }
            }
        PHASE_END
        PHASE_BEGIN(pb + 6)
            strided(2176, [&](int u) { ln1_unit(p, l, u, lds); __syncthreads(); });
        PHASE_END
        PHASE_BEGIN(pb + 8)
            {
                int* tbs = (int*)(smem + 1024);
                load_tile_bases(ctl, l, tbs);
                const int ntr = tbs[64];
                const int* rtok = (const int*)(p.ws + WS_RTOK);
                const int ntl1 = ntr + 272;
                const int t_ = otid();
                const unsigned gcb = (unsigned)(((t_ & 7) ^ ((t_ >> 3) & 7)) * 16), r0_ = (unsigned)(t_ >> 3);
                gemm_phase<true, true>(p.ws + WS_HBY, p.ws + WS_R1 + R1_W13T8, 8, ((ntl1 + 7) >> 3) * 32, lds,
                    [&](int u, GSrc& sr) __attribute__((always_inline)) {
                        const int tile = ((u >> 3) >> 2) * 8 + (u & 7), jn = (u >> 3) & 3;
                        if (tile >= ntl1) return false;
                        int e;
                        if (tile < ntr) {
                            e = __popcll(__ballot(tbs[t_ & 63] <= tile)) - 1;
                            const int pos0 = (tile - tbs[e]) * 128, ce = tbs[130 + e];
#pragma unroll
                            for (int i = 0; i < 4; ++i) { const int ps = pos0 + (int)r0_ + 32 * i; const int row = (ps < ce) ? rtok[(size_t)e * NT + ps] : 0; sr.ao[i] = (unsigned)row * (unsigned)DM + gcb; }
                        } else {
                            const int stt = tile - ntr; e = 64;
#pragma unroll
                            for (int i = 0; i < 4; ++i) sr.ao[i] = ((unsigned)(stt * 128) + r0_ + 32u * i) * (unsigned)DM + gcb;
                        }
#pragma unroll
                        for (int i = 0; i < 4; ++i) sr.bo[i] = ((unsigned)(e * 512 + jn * 128) + r0_ + 32u * i) * (unsigned)DM + gcb;
                        return true;
                    },
                    [&](int u, f32x4 (&acc)[4][4]) __attribute__((always_inline)) {
                        LANE_IDS
                        const int tile = ((u >> 3) >> 2) * 8 + (u & 7), jn = (u >> 3) & 3;
                        const int obase = (tile < ntr) ? tile * 128 : (SH_TILE_BASE + tile - ntr) * 128;
                        unsigned char* ot = (unsigned char*)lds + 32768;
#pragma unroll
                        for (int m = 0; m < 4; ++m)
#pragma unroll
                            for (int pp = 0; pp < 2; ++pp) {
                                float a8[4];
#pragma unroll
                                for (int j = 0; j < 4; ++j) {
                                    const float g = acc[m][2 * pp][j] * (1.f / 32.f), uu = acc[m][2 * pp + 1][j] * (1.f / 32.f);
                                    a8[j] = fminf(fmaxf(siluf(g) * uu * 8.f, -440.f), 440.f);
                                }
                                *reinterpret_cast<unsigned*>(ot + (wr * 64 + m * 16 + fr) * 80 + wc * 32 + pp * 16 + fq * 4) = pack4_f8(a8[0], a8[1], a8[2], a8[3]);
                            }
                        __syncthreads();
                        unsigned char* act = (unsigned char*)(p.ws + WS_ACT);
#pragma unroll
                        for (int i = 0; i < 2; ++i) {
                            const int id = tid + 256 * i, r = id >> 2, c16 = (id & 3) * 16;
                            *reinterpret_cast<uint4*>(act + (size_t)(obase + r) * 256 + jn * 64 + c16) = *reinterpret_cast<const uint4*>(ot + r * 80 + c16);
                        }
                        __syncthreads();
                    });
            }
        PHASE_END
#pragma unroll 1
        for (int sl = 0; sl < 2; ++sl) {
            PHASE_BEGIN(pb + 9 + 2 * sl)
            {
                int* tbs = (int*)(smem + 1024);
                load_tile_bases(ctl, l, tbs);
                const int ntr = tbs[64];
                const int ntl2 = ntr + 272;
                const int t_ = otid();
                const unsigned gcb = (unsigned)(((t_ & 7) ^ ((t_ >> 3) & 7)) * 16), r0_ = (unsigned)(t_ >> 3);
                gemm_phase<true, true>(p.ws + WS_ACT, p.ws + WS_R1 + R1_W2T8, 2, ((ntl2 + 7) >> 3) * 32, lds,
                    [&](int u, GSrc& sr) __attribute__((always_inline)) {
                        const int tile = ((u >> 3) >> 2) * 8 + (u & 7), nt4 = (u >> 3) & 3;
                        if (tile >= ntl2) return false;
                        int e, obase;
                        if (tile < ntr) {
                            e = __popcll(__ballot(tbs[t_ & 63] <= tile)) - 1;
                            obase = tile * 128;
                        }
                        else { e = 64; obase = (SH_TILE_BASE + tile - ntr) * 128; }
#pragma unroll
                        for (int i = 0; i < 4; ++i) {
                            sr.ao[i] = ((unsigned)obase + r0_ + 32u * i) * 256u + gcb;
                            sr.bo[i] = ((unsigned)(e * 1024 + sl * 512 + nt4 * 128) + r0_ + 32u * i) * 256u + gcb;
                        }
                        return true;
                    },
                    [&](int u, f32x4 (&acc)[4][4]) __attribute__((always_inline)) {
                        LANE_IDS
                        const int tile = ((u >> 3) >> 2) * 8 + (u & 7), nt4 = (u >> 3) & 3;
                        const int obase = (tile < ntr) ? tile * 128 : (SH_TILE_BASE + tile - ntr) * 128;
                        unsigned char* ot = (unsigned char*)lds + 32768;
#pragma unroll
                        for (int m = 0; m < 4; ++m)
#pragma unroll
                            for (int n = 0; n < 4; ++n) {
                                float v16[4];
#pragma unroll
                                for (int j = 0; j < 4; ++j) v16[j] = fminf(fmaxf(acc[m][n][j] * (1.f / 16.f), -440.f), 440.f);
                                *reinterpret_cast<unsigned*>(ot + (wr * 64 + m * 16 + fr) * 144 + wc * 64 + n * 16 + fq * 4) = pack4_f8(v16[0], v16[1], v16[2], v16[3]);
                            }
                        __syncthreads();
                        unsigned char* y2 = (unsigned char*)(p.ws + WS_Y2);
#pragma unroll
                        for (int i = 0; i < 4; ++i) {
                            const int id = tid + 256 * i, r = id >> 3, c16 = (id & 7) * 16;
                            { typedef unsigned u32x4_t __attribute__((ext_vector_type(4)));
                              __builtin_nontemporal_store(*reinterpret_cast<const u32x4_t*>(ot + r * 144 + c16), reinterpret_cast<u32x4_t*>(y2 + (size_t)(obase + r) * 512 + nt4 * 128 + c16)); }
                        }
                        __syncthreads();
                    });
            }
            PHASE_END
            if (sl == 0) {
            PHASE_BEGIN(pb + 10 + 2 * sl)
            {
                int* tb = (int*)lds;
                const int tid = otid();
                load_tile_bases(ctl, l, tb);
                const int* aep = (const int*)(p.ws + WS_AEP); const float* aw = (const float*)(p.ws + WS_AW);
                const unsigned char* y2 = (const unsigned char*)(p.ws + WS_Y2);
                const int tl = tid >> 5, cg = tid & 31;
                uint4 na0, na1; float4 nw0, nw1;
                {
                    const int tok = blockIdx.x * 8 + tl;
                    na0 = *reinterpret_cast<const uint4*>(aep + (size_t)tok * 8); na1 = *reinterpret_cast<const uint4*>(aep + (size_t)tok * 8 + 4);
                    nw0 = *reinterpret_cast<const float4*>(aw + (size_t)tok * 8); nw1 = *reinterpret_cast<const float4*>(aw + (size_t)tok * 8 + 4);
                }
                for (int grp = blockIdx.x; grp < NT / 8; grp += gridDim.x) {
                    const int tok = grp * 8 + tl;
                    const unsigned cv[8] = {na0.x, na0.y, na0.z, na0.w, na1.x, na1.y, na1.z, na1.w};
                    const float cw[8] = {nw0.x, nw0.y, nw0.z, nw0.w, nw1.x, nw1.y, nw1.z, nw1.w};
                    float* xr = xrow(p, tok) + sl * 512 + cg * 16;
                    const float* ga = modp(p, l, row_mod(tok), 5) + sl * 512 + cg * 16;
                    uint4 yv[9];
                    typedef unsigned u32x4_t __attribute__((ext_vector_type(4)));
                    { const u32x4_t t4 = __builtin_nontemporal_load(reinterpret_cast<const u32x4_t*>(y2 + ((size_t)(SH_TILE_BASE * 128 + tok)) * 512 + cg * 16)); yv[8] = make_uint4(t4.x, t4.y, t4.z, t4.w); }
#pragma unroll
                    for (int k = 0; k < 8; ++k) {
                        const int dest = tb[cv[k] >> 24] * 128 + (int)(cv[k] & 0xFFFFFFu);
                        { const u32x4_t t4 = __builtin_nontemporal_load(reinterpret_cast<const u32x4_t*>(y2 + (size_t)dest * 512 + cg * 16)); yv[k] = make_uint4(t4.x, t4.y, t4.z, t4.w); }
                    }
                    float4 x4[4], g4[4];
#pragma unroll
                    for (int q = 0; q < 4; ++q) { x4[q] = *reinterpret_cast<const float4*>(xr + q * 4); g4[q] = *reinterpret_cast<const float4*>(ga + q * 4); }
                    if (grp + (int)gridDim.x < NT / 8) {
                        const int tok2 = (grp + (int)gridDim.x) * 8 + tl;
                        na0 = *reinterpret_cast<const uint4*>(aep + (size_t)tok2 * 8); na1 = *reinterpret_cast<const uint4*>(aep + (size_t)tok2 * 8 + 4);
                        nw0 = *reinterpret_cast<const float4*>(aw + (size_t)tok2 * 8); nw1 = *reinterpret_cast<const float4*>(aw + (size_t)tok2 * 8 + 4);
                    }
                    float a16[16];
                    {
                        const unsigned wv[4] = {yv[8].x, yv[8].y, yv[8].z, yv[8].w};
#pragma unroll
                        for (int q = 0; q < 4; ++q) {
                            a16[q * 4 + 0] = __builtin_amdgcn_cvt_f32_fp8((int)wv[q], 0); a16[q * 4 + 1] = __builtin_amdgcn_cvt_f32_fp8((int)wv[q], 1);
                            a16[q * 4 + 2] = __builtin_amdgcn_cvt_f32_fp8((int)wv[q], 2); a16[q * 4 + 3] = __builtin_amdgcn_cvt_f32_fp8((int)wv[q], 3);
                        }
                    }
#pragma unroll
                    for (int k = 0; k < 8; ++k) {
                        const float wk = cw[k];
                        const unsigned wv[4] = {yv[k].x, yv[k].y, yv[k].z, yv[k].w};
#pragma unroll
                        for (int q = 0; q < 4; ++q) {
                            a16[q * 4 + 0] += wk * __builtin_amdgcn_cvt_f32_fp8((int)wv[q], 0); a16[q * 4 + 1] += wk * __builtin_amdgcn_cvt_f32_fp8((int)wv[q], 1);
                            a16[q * 4 + 2] += wk * __builtin_amdgcn_cvt_f32_fp8((int)wv[q], 2); a16[q * 4 + 3] += wk * __builtin_amdgcn_cvt_f32_fp8((int)wv[q], 3);
                        }
                    }
                    const float rs = kp.rep ? 0.f : (1.f / 16.f);
#pragma unroll
                    for (int q = 0; q < 4; ++q) {
                        x4[q].x += rs * g4[q].x * a16[q * 4 + 0]; x4[q].y += rs * g4[q].y * a16[q * 4 + 1]; x4[q].z += rs * g4[q].z * a16[q * 4 + 2]; x4[q].w += rs * g4[q].w * a16[q * 4 + 3];
                        *reinterpret_cast<float4*>(xr + q * 4) = x4[q];
                    }
                }
                __syncthreads();
            }
            PHASE_END
            }
        }
    }
#if defined(PROBE_PH)
    if (lo >= 100) {
        float a0 = (float)otid(), a1 = a0 + 1.f, a2 = a0 + 2.f, a3 = a0 + 3.f, a4 = a0 + 4.f, a5 = a0 + 5.f, a6 = a0 + 6.f, a7 = a0 + 7.f;
        const float m = 0.999f, c = 0.5f;
        for (int it = 0; it < 10000; ++it) {
            if (lo == 100) {
#pragma unroll
                for (int q = 0; q < 64; ++q) asm volatile("v_fma_f32 %0, %0, %1, %2" : "+v"(a0) : "v"(m), "v"(c));
            } else {
#pragma unroll
                for (int q = 0; q < 8; ++q) {
                    asm volatile("v_fma_f32 %0, %0, %1, %2" : "+v"(a0) : "v"(m), "v"(c)); asm volatile("v_fma_f32 %0, %0, %1, %2" : "+v"(a1) : "v"(m), "v"(c));
                    asm volatile("v_fma_f32 %0, %0, %1, %2" : "+v"(a2) : "v"(m), "v"(c)); asm volatile("v_fma_f32 %0, %0, %1, %2" : "+v"(a3) : "v"(m), "v"(c));
                    asm volatile("v_fma_f32 %0, %0, %1, %2" : "+v"(a4) : "v"(m), "v"(c)); asm volatile("v_fma_f32 %0, %0, %1, %2" : "+v"(a5) : "v"(m), "v"(c));
                    asm volatile("v_fma_f32 %0, %0, %1, %2" : "+v"(a6) : "v"(m), "v"(c)); asm volatile("v_fma_f32 %0, %0, %1, %2" : "+v"(a7) : "v"(m), "v"(c));
                }
            }
        }
        if (a0 + a1 + a2 + a3 + a4 + a5 + a6 + a7 == 12345.678f) ctl[60] = 1u;
    }
#endif
    PHASE_BEGIN(27)
        load_tile_bases(ctl, 1, (int*)(smem + 1024));
        strided(4096, [&](int u) { final_unit(p, u + NTC / 8, lds); });
    PHASE_END
}

#ifndef N_LAUNCH_MODE
#define N_LAUNCH_MODE 1
#endif
extern "C" void kernel_launch(void* const* d_in, const int* in_sizes, int n_in, void* d_out, int out_size, void* d_ws, size_t ws_size, hipStream_t stream) {
    static int grid = 0;
    if (grid == 0) {
        if (n_in != 52 || out_size != NTL * DM || ws_size < WS_END) { fprintf(stderr, "kernel_launch: unexpected shapes (n_in %d out %d ws %zu need %zu)\n", n_in, out_size, ws_size, (size_t)WS_END); grid = -1; return; }
        int dev = 0, cus = 0, per_cu = 0;
        hipGetDevice(&dev);
        hipDeviceGetAttribute(&cus, hipDeviceAttributeMultiprocessorCount, dev);
        hipFuncSetAttribute((const void*)fwd_kernel, hipFuncAttributeMaxDynamicSharedMemorySize, LDS_BYTES);
        hipOccupancyMaxActiveBlocksPerMultiprocessor(&per_cu, (const void*)fwd_kernel, NTHREADS, LDS_BYTES);
        (void)hipGetLastError();
        if (per_cu < 1) per_cu = 1;
        if (per_cu > 2) per_cu = 2;
        grid = cus * per_cu;
    }
    if (grid < 0) return;
    hipMemsetAsync((char*)d_ws + WS_CTL, 0, CTL_BYTES, stream);
    KP p{};
    for (int i = 0; i < 52; ++i) p.in[i] = (const float*)d_in[i];
    p.out = (float*)d_out; p.ws = (char*)d_ws;
#if defined(PROBE_PH)
    for (int ph = 0; ph < NPHASE; ++ph) {
        const int reps = (ph == PROBE_PH) ? 1 + PROBE_N : 1;
        for (int r = 0; r < reps; ++r) { p.ph_lo = ph; p.ph_hi = ph + 1; p.rep = r; hipLaunchKernelGGL(fwd_kernel, dim3(grid), dim3(NTHREADS), LDS_BYTES, stream, p); }
    }
    if (PROBE_PH >= 100) { p.ph_lo = PROBE_PH; p.ph_hi = PROBE_PH + 1; p.rep = 0; hipLaunchKernelGGL(fwd_kernel, dim3(PROBE_N), dim3(NTHREADS), LDS_BYTES, stream, p); }
#elif N_LAUNCH_MODE == 1
    p.ph_lo = 0; p.ph_hi = NPHASE;
    hipLaunchKernelGGL(fwd_kernel, dim3(grid), dim3(NTHREADS), LDS_BYTES, stream, p);
#else
    for (int ph = 0; ph < NPHASE; ++ph) {
        p.ph_lo = ph; p.ph_hi = ph + 1;
        hipLaunchKernelGGL(fwd_kernel, dim3(grid), dim3(NTHREADS), LDS_BYTES, stream, p);
    }
#endif
}
```
